# Optimizing an MI355X kernel written in HIP

```python
import jax, jax.numpy as jnp
from jax import lax
import numpy as np

D_MODEL = 2048
BATCH = 4
SEQ = 4096
DEPTH = 2

RMS_EPS = 1e-6
RET_HEADS = 4
RET_QK_DIM = 256
RET_V_DIM = 256
RET_CHUNK = 128
ROPE_BASE = 10000.0
GMLP_GROUPS = 4
GMLP_GROUP_DIM = 256
GMLP_CHUNK = 128
DSA_HEADS = 8
DSA_HEAD_DIM = 128
DSA_LATENT = 256
IDX_HEADS = 8
IDX_DIM = 64
DSA_TOPK_MAX = 256
DSA_QBLOCK = 128
MOE_GROUPS = 4
MOE_EXPERTS_PER_GROUP = 8
MOE_TOPK = 2
MOE_HIDDEN = 512

RET_QK = RET_HEADS * RET_QK_DIM
RET_V = RET_HEADS * RET_V_DIM
GMLP_WIDTH = GMLP_GROUPS * GMLP_GROUP_DIM
DSA_Q = DSA_HEADS * DSA_HEAD_DIM
IDX_Q = IDX_HEADS * IDX_DIM
IN_SPLITS = (RET_QK, RET_QK, RET_V, RET_V, GMLP_WIDTH, GMLP_WIDTH, DSA_Q, DSA_LATENT,
             IDX_Q, IDX_DIM, IDX_HEADS, D_MODEL, D_MODEL, D_MODEL)
IN_WIDTH = sum(IN_SPLITS)

kernel_name = "hybrid_retention_gmlp_dsa_hmoe"


def rms_norm(x, g):
    xf = x.astype(jnp.float32)
    y = xf * lax.rsqrt(jnp.mean(xf * xf, axis=-1, keepdims=True) + RMS_EPS)
    return (y * g.astype(jnp.float32)).astype(x.dtype)


def layer_norm(x, g, b):
    xf = x.astype(jnp.float32)
    mu = jnp.mean(xf, axis=-1, keepdims=True)
    var = jnp.mean(jnp.square(xf - mu), axis=-1, keepdims=True)
    y = (xf - mu) * lax.rsqrt(var + RMS_EPS)
    return (y * g.astype(jnp.float32) + b.astype(jnp.float32)).astype(x.dtype)


def split_in_projection(proj):
    offsets = np.cumsum(IN_SPLITS)[:-1].tolist()
    return jnp.split(proj, offsets, axis=-1)


def rotary(x, pos):
    half = x.shape[-1] // 2
    inv = ROPE_BASE ** (-jnp.arange(half, dtype=jnp.float32) / half)
    ang = pos.astype(jnp.float32)[:, None] * inv[None, :]
    cos = jnp.cos(ang)[None, :, None, :]
    sin = jnp.sin(ang)[None, :, None, :]
    x1, x2 = x[..., :half].astype(jnp.float32), x[..., half:].astype(jnp.float32)
    return jnp.concatenate([x1 * cos - x2 * sin, x1 * sin + x2 * cos], axis=-1).astype(x.dtype)


def retention(q, k, v, gate):
    B, S, H, dk = q.shape
    dv = v.shape[-1]
    C = RET_CHUNK
    N = S // C
    pos = jnp.arange(S)
    q = rotary(q, pos)
    k = rotary(k, pos) * (dk ** -0.5)
    log_g = jnp.log(1.0 - 2.0 ** (-5.0 - jnp.arange(H, dtype=jnp.float32)))
    i = jnp.arange(C, dtype=jnp.float32)
    diff = i[:, None] - i[None, :]
    decay = jnp.where(diff >= 0, jnp.exp(log_g[:, None, None] * jnp.maximum(diff, 0.0)), 0.0)
    xi = jnp.exp(log_g[None, :] * (i[:, None] + 1.0))[None, :, :, None]
    zeta = jnp.exp(log_g[None, :] * (C - 1.0 - i[:, None]))[None, :, :, None]
    g_chunk = jnp.exp(log_g * C)[None, :, None, None]

    def to_chunks(t):
        return t.reshape(B, N, C, H, t.shape[-1]).swapaxes(0, 1)

    def step(R, inp):
        qc, kc, vc = inp
        inner = jnp.einsum('bihd,bjhd->bhij', qc, kc) * decay
        o = jnp.einsum('bhij,bjhe->bihe', inner, vc) + jnp.einsum('bihd,bhde->bihe', qc, R) * xi
        R = R * g_chunk + jnp.einsum('bjhd,bjhe->bhde', kc * zeta, vc)
        return R, o

    R0 = jnp.zeros((B, H, dk, dv), jnp.float32)
    _, o = lax.scan(step, R0, (to_chunks(q), to_chunks(k), to_chunks(v)))
    o = o.swapaxes(0, 1).reshape(B, S, H, dv).astype(jnp.float32)
    o = o * lax.rsqrt(jnp.mean(o * o, axis=-1, keepdims=True) + RMS_EPS)
    o = o.reshape(B, S, H * dv).astype(gate.dtype)
    return jax.nn.silu(gate) * o


def chunked_spatial_gating(u, v, ln_g, ln_b, w_s, b_s):
    B, S, _ = v.shape
    C = GMLP_CHUNK
    N = S // C
    v = layer_norm(v, ln_g, ln_b)
    vc = v.reshape(B, N, C, GMLP_GROUPS, GMLP_GROUP_DIM)
    mask = jnp.tril(jnp.ones((C, C), dtype=bool))
    w = jnp.where(mask[None], w_s, 0.0).astype(v.dtype)
    mixed = jnp.einsum('gij,bnjgc->bnigc', w, vc) + b_s.T[None, None, :, :, None]
    return u * mixed.reshape(B, S, GMLP_WIDTH)


def dsa_attention(q, c_kv, q_idx, k_idx, w_idx, w_uk, w_uv):
    B, S, H, dh = q.shape
    k_sel = min(DSA_TOPK_MAX, S // 4)
    nb = S // DSA_QBLOCK
    q_abs = jnp.einsum('bshd,hcd->bshc', q, w_uk) * (dh ** -0.5)
    key_pos = jnp.arange(S)

    def blocks(t):
        return t.reshape(B, nb, DSA_QBLOCK, *t.shape[2:]).swapaxes(0, 1)

    def attend_block(args):
        blk, qa, qi, wi = args
        q_pos = blk * DSA_QBLOCK + jnp.arange(DSA_QBLOCK)
        causal = key_pos[None, :] <= q_pos[:, None]
        logits = jnp.einsum('bqhd,bsd->bqhs', qi, k_idx) * (IDX_DIM ** -0.5)
        score = jnp.einsum('bqh,bqhs->bqs', wi.astype(jnp.float32),
                           jax.nn.relu(logits).astype(jnp.float32))
        score = jnp.where(causal[None], score, -jnp.inf)
        _, sel = lax.top_k(score, k_sel)
        valid = sel <= q_pos[None, :, None]
        c_sel = jax.vmap(lambda c, ix: c[ix])(c_kv, sel)
        s = jnp.einsum('bqhc,bqkc->bqhk', qa, c_sel).astype(jnp.float32)
        s = jnp.where(valid[:, :, None, :], s, -jnp.inf)
        p = jax.nn.softmax(s, axis=-1).astype(c_sel.dtype)
        return jnp.einsum('bqhk,bqkc->bqhc', p, c_sel)

    o_lat = lax.map(attend_block, (jnp.arange(nb), blocks(q_abs), blocks(q_idx), blocks(w_idx)))
    o_lat = o_lat.swapaxes(0, 1).reshape(B, S, H, DSA_LATENT)
    o = jnp.einsum('bshc,hcd->bshd', o_lat, w_uv)
    return o.reshape(B, S, H * dh)


def hierarchical_moe(h, w_grp, b_grp, w_exp, b_exp, w1, w3, w2):
    B, S, D = h.shape
    G, E = MOE_GROUPS, MOE_EXPERTS_PER_GROUP
    t = h.reshape(B * S, D)
    grp_prob = jax.nn.softmax((t @ w_grp).astype(jnp.float32) + b_grp.astype(jnp.float32), axis=-1)
    g_sel = jnp.argmax(grp_prob, axis=-1)
    p_g = jnp.max(grp_prob, axis=-1)
    grp_onehot = jax.nn.one_hot(g_sel, G, dtype=jnp.float32)
    exp_logits = jnp.einsum('td,gde->tge', t, w_exp).astype(jnp.float32) + b_exp.astype(jnp.float32)
    logits_sel = jnp.sum(grp_onehot[:, :, None] * exp_logits, axis=1)
    top_v, top_i = lax.top_k(jax.nn.softmax(logits_sel, axis=-1), MOE_TOPK)
    top_v = top_v / jnp.sum(top_v, axis=-1, keepdims=True)
    w_in_group = jnp.sum(jax.nn.one_hot(top_i, E, dtype=jnp.float32) * top_v[..., None], axis=1)
    combine = (grp_onehot[:, :, None] * (p_g[:, None] * w_in_group)[:, None, :]).astype(t.dtype)
    y = jnp.zeros_like(t)
    for g in range(G):
        hid = jax.nn.silu(jnp.einsum('td,edf->tef', t, w1[g])) * jnp.einsum('td,edf->tef', t, w3[g])
        y = y + jnp.einsum('tef,efd->td', hid * combine[:, g, :, None], w2[g])
    return y.reshape(B, S, D)


def setup_inputs(seed: int = 0) -> dict:
    key = jax.random.key(seed)
    ks = jax.random.split(key, 24)
    f32 = jnp.float32
    L, D = DEPTH, D_MODEL
    G, E, F = MOE_GROUPS, MOE_EXPERTS_PER_GROUP, MOE_HIDDEN

    def nrm(k, shape, fan_in):
        return jax.random.normal(k, shape, f32) * (fan_in ** -0.5)

    def gain(k, shape):
        return 1.0 + 0.02 * jax.random.normal(k, shape, f32)

    return {
        "x": jax.random.normal(ks[0], (BATCH, SEQ, D), f32),
        "norm_mix_g": gain(ks[1], (L, D)),
        "w_in": nrm(ks[2], (L, D, IN_WIDTH), D),
        "w_ret_o": nrm(ks[3], (L, RET_V, D), RET_V),
        "gmlp_ln_g": gain(ks[4], (L, GMLP_WIDTH)),
        "gmlp_ln_b": 0.02 * jax.random.normal(ks[5], (L, GMLP_WIDTH), f32),
        "gmlp_w_s": nrm(ks[6], (L, GMLP_GROUPS, GMLP_CHUNK, GMLP_CHUNK), GMLP_CHUNK),
        "gmlp_b_s": gain(ks[7], (L, GMLP_GROUPS, GMLP_CHUNK)),
        "w_gmlp_o": nrm(ks[8], (L, GMLP_WIDTH, D), GMLP_WIDTH),
        "dsa_kv_norm_g": gain(ks[9], (L, DSA_LATENT)),
        "dsa_w_uk": nrm(ks[10], (L, DSA_HEADS, DSA_LATENT, DSA_HEAD_DIM), DSA_LATENT),
        "dsa_w_uv": nrm(ks[11], (L, DSA_HEADS, DSA_LATENT, DSA_HEAD_DIM), DSA_LATENT),
        "w_dsa_o": nrm(ks[12], (L, DSA_Q, D), DSA_Q),
        "w_out": nrm(ks[13], (L, D, D), D),
        "norm_ffn_g": gain(ks[14], (L, D)),
        "moe_w_group": nrm(ks[15], (L, D, G), D),
        "moe_b_group": 0.01 * jax.random.normal(ks[16], (L, G), f32),
        "moe_w_expert": nrm(ks[17], (L, G, D, E), D),
        "moe_b_expert": 0.01 * jax.random.normal(ks[18], (L, G, E), f32),
        "moe_w1": nrm(ks[19], (L, G, E, D, F), D),
        "moe_w3": nrm(ks[20], (L, G, E, D, F), D),
        "moe_w2": nrm(ks[21], (L, G, E, F, D), F),
        "final_norm_g": gain(ks[22], (D,)),
    }


def reference(x, norm_mix_g, w_in, w_ret_o, gmlp_ln_g, gmlp_ln_b, gmlp_w_s, gmlp_b_s, w_gmlp_o,
              dsa_kv_norm_g, dsa_w_uk, dsa_w_uv, w_dsa_o, w_out, norm_ffn_g,
              moe_w_group, moe_b_group, moe_w_expert, moe_b_expert, moe_w1, moe_w3, moe_w2,
              final_norm_g):
    B, S, _ = x.shape
    for l in range(DEPTH):
        h = rms_norm(x, norm_mix_g[l])
        proj = h @ w_in[l]
        (rq, rk, rv, rg, gu, gv, dq, dc, iq, ik, iw,
         gate_a, gate_b, gate_c) = split_in_projection(proj)
        ret = retention(rq.reshape(B, S, RET_HEADS, RET_QK_DIM),
                        rk.reshape(B, S, RET_HEADS, RET_QK_DIM),
                        rv.reshape(B, S, RET_HEADS, RET_V_DIM), rg)
        gm = chunked_spatial_gating(jax.nn.gelu(gu, approximate=False), jax.nn.gelu(gv, approximate=False),
                                    gmlp_ln_g[l], gmlp_ln_b[l], gmlp_w_s[l], gmlp_b_s[l])
        ds = dsa_attention(dq.reshape(B, S, DSA_HEADS, DSA_HEAD_DIM),
                           rms_norm(dc, dsa_kv_norm_g[l]),
                           iq.reshape(B, S, IDX_HEADS, IDX_DIM), ik,
                           iw * (IDX_HEADS ** -0.5), dsa_w_uk[l], dsa_w_uv[l])
        merged = (jax.nn.sigmoid(gate_a) * (ret @ w_ret_o[l])
                  + jax.nn.sigmoid(gate_b) * (gm @ w_gmlp_o[l])
                  + jax.nn.sigmoid(gate_c) * (ds @ w_dsa_o[l]))
        x = x + merged @ w_out[l]
        h = rms_norm(x, norm_ffn_g[l])
        x = x + hierarchical_moe(h, moe_w_group[l], moe_b_group[l], moe_w_expert[l], moe_b_expert[l],
                                 moe_w1[l], moe_w3[l], moe_w2[l])
    return rms_norm(x, final_norm_g)
```

```cpp
#include <hip/hip_runtime.h>
#include <stdint.h>
#include <stdio.h>

#ifndef MK_PER_PHASE
#define MK_PER_PHASE 0
#endif
#ifndef NAIVE_RET
#define NAIVE_RET 1
#endif
#ifndef NAIVE_GMLP
#define NAIVE_GMLP 1
#endif
#ifndef NAIVE_IDX
#define NAIVE_IDX 1
#endif
#ifndef NAIVE_ATT
#define NAIVE_ATT 1
#endif

#define LAS __attribute__((address_space(3)))
typedef unsigned short bf16_t;
typedef short bf16x8 __attribute__((ext_vector_type(8)));
typedef short s16x4 __attribute__((ext_vector_type(4)));
typedef float f32x4 __attribute__((ext_vector_type(4)));
typedef float f32x2 __attribute__((ext_vector_type(2)));
typedef float f32x16 __attribute__((ext_vector_type(16)));
typedef unsigned u32x4 __attribute__((ext_vector_type(4)));
typedef unsigned u32x2 __attribute__((ext_vector_type(2)));

constexpr int DM = 2048, NB = 4, SEQ = 4096, T = NB * SEQ, DEPTH = 2;
constexpr int INW = 14152, NP = 14336;
constexpr int GATE_SRC0 = 8008, GATE_DST0 = 8192;
constexpr int NEXP = 32, FF = 512, MOE_ROWS = 40960;
constexpr float EPS = 1e-6f;

constexpr size_t MiB = 1u << 20;
constexpr size_t WS_CTL = 0, CTL_BYTES = 1 * MiB;
constexpr size_t WS_ROPE = 1 * MiB;
constexpr size_t WS_W = 5 * MiB;
constexpr size_t W_IN = 0, W_RET = 56 * MiB, W_GM = 60 * MiB, W_DS = 64 * MiB, W_OUT = 68 * MiB, W_13 = 76 * MiB, W_2 = 204 * MiB, W_UK = 268 * MiB, W_UV = 269 * MiB, W_END = 270 * MiB;
constexpr size_t WS_H = WS_W + W_END;
constexpr size_t WS_PROJ = WS_H + 64 * MiB;
constexpr size_t P_RQ = 0, P_RK = 32 * MiB, P_RV = 64 * MiB, P_RG = 96 * MiB, P_GU = 128 * MiB, P_GV = 160 * MiB, P_DQ = 192 * MiB, P_DC = 224 * MiB  ,
                 P_IQ = 240 * MiB  , P_IK = 256 * MiB  , P_IW = 258 * MiB  , P_GA = 260 * MiB, P_GB = 324 * MiB, P_GC = 388 * MiB, P_END = 452 * MiB;
constexpr size_t M_HPERM = 0, M_HID = 160 * MiB, M_YC = 200 * MiB;
constexpr size_t WS_KV = WS_PROJ + P_END;
constexpr size_t WS_R = WS_KV + 64 * MiB;
constexpr size_t WS_QABS = WS_R + 64 * MiB;
constexpr size_t WS_OLAT = WS_QABS + 64 * MiB;
constexpr size_t WS_RET = WS_OLAT + 64 * MiB;
constexpr size_t WS_GM = WS_RET + 32 * MiB, WS_DS = WS_GM + 32 * MiB;
constexpr size_t WS_SEL = WS_DS + 32 * MiB;
constexpr size_t WS_CKV = WS_SEL + 8 * MiB;
constexpr size_t WS_STATS = WS_CKV + 8 * MiB;
constexpr size_t WS_ROUTE = WS_STATS + 2 * MiB;
constexpr size_t WS_END = WS_ROUTE + 1 * MiB;
constexpr int CW_BAR = 4096, CW_CNT = 16384;

constexpr int LDS_BYTES = 147456, MISC_OFF = LDS_BYTES - 1024;

__device__ __forceinline__ unsigned f2bf(float f) { unsigned u = __builtin_bit_cast(unsigned, f); return (u + 0x7fffu + ((u >> 16) & 1u)) >> 16; }
__device__ __forceinline__ float bf2f(unsigned b) { return __builtin_bit_cast(float, (b & 0xffffu) << 16); }
__device__ __forceinline__ unsigned cvt_pk_bf16(float lo, float hi) { unsigned r; asm volatile("v_cvt_pk_bf16_f32 %0, %1, %2" : "=v"(r) : "v"(lo), "v"(hi)); return r; }
__device__ __forceinline__ float wave_sum(float v) {
#pragma unroll
    for (int o = 1; o < 64; o <<= 1) v += __shfl_xor(v, o);
    return v;
}
__device__ __forceinline__ float wave_max(float v) {
#pragma unroll
    for (int o = 1; o < 64; o <<= 1) v = fmaxf(v, __shfl_xor(v, o));
    return v;
}
__device__ __forceinline__ float sigmoidf_(float x) { return 1.0f / (1.0f + __expf(-x)); }
__device__ __forceinline__ float siluf_(float x) { return x / (1.0f + __expf(-x)); }
__device__ __forceinline__ f32x2 gelu_pk(f32x2 v) {
    const f32x2 av = __builtin_elementwise_abs(v), d = av * 0.2316418882f + 1.0f;
    f32x2 t; t.x = __builtin_amdgcn_rcpf(d.x); t.y = __builtin_amdgcn_rcpf(d.y);
    f32x2 q = t * 0.5307027145f + (-0.7265760135f); q = q * t + 0.7107068705f; q = q * t + (-0.142248368f); q = q * t + 0.127414796f; q = q * t;
    const f32x2 s = (v * v) * (-0.72134752044f);
    f32x2 e; e.x = __builtin_amdgcn_exp2f(s.x); e.y = __builtin_amdgcn_exp2f(s.y);
    const f32x2 m = v * (q * e), r = v - m;
    f32x2 o; o.x = v.x < 0.f ? m.x : r.x; o.y = v.y < 0.f ? m.y : r.y; return o;
}
template <int ACT> __device__ __forceinline__ f32x4 act4(f32x4 v) {
    if (ACT == 1) { f32x2 a = gelu_pk((f32x2){v[0], v[1]}), b = gelu_pk((f32x2){v[2], v[3]}); return (f32x4){a.x, a.y, b.x, b.y}; }
    if (ACT == 2) return (f32x4){siluf_(v[0]), siluf_(v[1]), siluf_(v[2]), siluf_(v[3])};
    if (ACT == 3) return (f32x4){sigmoidf_(v[0]), sigmoidf_(v[1]), sigmoidf_(v[2]), sigmoidf_(v[3])};
    return v;
}
__device__ __forceinline__ u32x4 pack8(f32x4 a, f32x4 b) { u32x4 w; w.x = cvt_pk_bf16(a[0], a[1]); w.y = cvt_pk_bf16(a[2], a[3]); w.z = cvt_pk_bf16(b[0], b[1]); w.w = cvt_pk_bf16(b[2], b[3]); return w; }
__device__ __forceinline__ void unpack8(u32x4 w, float (&f)[8]) {
    f[0] = bf2f(w.x); f[1] = bf2f(w.x >> 16); f[2] = bf2f(w.y); f[3] = bf2f(w.y >> 16); f[4] = bf2f(w.z); f[5] = bf2f(w.z >> 16); f[6] = bf2f(w.w); f[7] = bf2f(w.w >> 16);
}

#define XB_TMO      128
#define XB_XCNT(j)  (256  + 64 * (j))
#define XB_XSUB(j)  (1280 + 64 * (j))
#define XB_XGEN(j)  (2304 + 64 * (j))
#define XB_TOP      3328
#define XB_TOPGEN   3392
#define XCD_BAR_WORDS 3456
#define XB_SPIN_CAP (1u << 20)
__device__ __forceinline__ unsigned xb_ld(unsigned* p)              { return __hip_atomic_load(p, __ATOMIC_RELAXED, __HIP_MEMORY_SCOPE_AGENT); }
__device__ __forceinline__ unsigned xb_add(unsigned* p, unsigned v) { return __hip_atomic_fetch_add(p, v, __ATOMIC_RELAXED, __HIP_MEMORY_SCOPE_AGENT); }
__device__ __forceinline__ unsigned xb_xcc_id() { return (unsigned)__builtin_amdgcn_s_getreg((3 << 11) | 20) & 0xFu; }
#define XB_SPIN(cond, bar) do { unsigned _sp = 0; while (cond) { __builtin_amdgcn_s_sleep(1); \
    if ((++_sp & 255u) == 0u) { if (xb_ld(&(bar)[XB_TMO])) break; if (_sp > XB_SPIN_CAP) { atomicAdd(&(bar)[XB_TMO], 1u); break; } } } } while (0)
struct XcdBarrier { unsigned* bar; unsigned x; volatile LAS unsigned* st; };
__device__ __forceinline__ XcdBarrier xcd_barrier_post(unsigned* bar, volatile LAS unsigned* st) {
    XcdBarrier b; b.bar = bar; b.x = xb_xcc_id(); b.st = st;
    if (threadIdx.x == 0) (void)xb_add(&bar[XB_XCNT(b.x)], 1u);
    return b;
}
__device__ __forceinline__ void xcd_barrier_complete(unsigned* bar, unsigned x, unsigned& nloc, unsigned& nx) {
    const unsigned G = gridDim.x * gridDim.y * gridDim.z;
    unsigned sum, cnt, mine, sp = 0u;
    for (;;) {
        sum = 0u; cnt = 0u; mine = 0u;
#pragma unroll
        for (unsigned j = 0; j < 16; ++j) { const unsigned c = xb_ld(&bar[XB_XCNT(j)]); sum += c; cnt += (c > 0u) ? 1u : 0u; mine = (j == x) ? c : mine; }
        if (sum == G) break;
        __builtin_amdgcn_s_sleep(1);
        if ((++sp & 255u) == 0u) { if (xb_ld(&bar[XB_TMO])) break; if (sp > XB_SPIN_CAP) { atomicAdd(&bar[XB_TMO], 1u); break; } }
    }
    nloc = mine > 0u ? mine : 1u; nx = cnt > 0u ? cnt : 1u;
}
__device__ __forceinline__ void xcd_barrier(const XcdBarrier& b) {
    asm volatile("s_waitcnt vmcnt(0)" ::: "memory");
    __syncthreads();
    if (threadIdx.x == 0) {
        unsigned* bar = b.bar;
        __builtin_amdgcn_s_waitcnt(0);
        unsigned nloc = b.st[0], nx = b.st[1];
        if (nloc == 0u) { xcd_barrier_complete(bar, b.x, nloc, nx); b.st[0] = nloc; b.st[1] = nx; }
        const unsigned old = xb_add(&bar[XB_XSUB(b.x)], 1u);
        const unsigned gen = old / nloc;
        if (old + 1u == (gen + 1u) * nloc) {
            __builtin_amdgcn_fence(__ATOMIC_RELEASE, "agent");
            asm volatile("s_waitcnt vmcnt(0)" ::: "memory");
            const unsigned og = xb_add(&bar[XB_TOP], 1u);
            const unsigned tg = og / nx;
            if (og + 1u == (tg + 1u) * nx) xb_add(&bar[XB_TOPGEN], 1u);
            else XB_SPIN(xb_ld(&bar[XB_TOPGEN]) == tg, bar);
            __builtin_amdgcn_fence(__ATOMIC_ACQUIRE, "agent");
            xb_add(&bar[XB_XGEN(b.x)], 1u);
            asm volatile("s_waitcnt vmcnt(0)" ::: "memory");
        } else {
            XB_SPIN(xb_ld(&bar[XB_XGEN(b.x)]) == gen, bar);
            __builtin_amdgcn_fence(__ATOMIC_ACQUIRE, "agent");
            asm volatile("s_waitcnt vmcnt(0)" ::: "memory");
        }
    }
    __syncthreads();
}

namespace pg8 {
constexpr int BM = 256, BK = 64, HALF = 128, HTB = HALF * BK * 2, STAGE_BYTES = 8 * HTB, NXCD = 8, WGM = 8;
__host__ __device__ __forceinline__ int lds_byte(int r, int c) { const int st = (r >> 4) * 2 + (c >> 5), rr = r & 15, cc = c & 31, ob = rr * 64 + cc * 2; return st * 1024 + (ob ^ (((ob >> 9) & 1) << 5)); }
__host__ __device__ __forceinline__ void stage_rc(int b, int& R, int& C) { const int st = b / 1024, sb = b % 1024, swz = sb ^ (((sb >> 9) & 1) << 5); R = (st >> 1) * 16 + swz / 64; C = (st & 1) * 32 + (swz % 64) / 2; }
__host__ __device__ __forceinline__ int perm32(int rho) { const int n = rho >> 4, i = rho & 15; return 8 * (i >> 2) + 4 * n + (i & 3); }

struct Unit { int pm, pn; long aoff, boff; };
struct Gemm { const bf16_t* A; const bf16_t* Bt; int lda, ldb, K; };

struct OrderMN {
    int nM, nN, nwg, G, c, ashift; long astep, bstep, abytes;
    __device__ void init(int nM_, int nN_, int G_, int c_, long astep_, long bstep_, int ashift_ = 0, long abytes_ = 0) { nM = nM_; nN = nN_; nwg = nM * nN; G = G_; c = c_; astep = astep_; bstep = bstep_; ashift = ashift_; abytes = abytes_; }
    __device__ bool next(int i, Unit& u) const {
        const long L = (long)i * G + c; if (L >= nwg) return false;
        int wgid = (int)L; { const int q = nwg / NXCD, r = nwg % NXCD, xcd = wgid % NXCD, off = wgid / NXCD; wgid = (xcd < r ? xcd * (q + 1) : r * (q + 1) + (xcd - r) * q) + off; }
        const int nig = WGM * nN, gid = wgid / nig, fm = gid * WGM, gsz = (nM - fm) < WGM ? (nM - fm) : WGM;
        u.pm = fm + ((wgid % nig) % gsz); u.pn = (wgid % nig) / gsz;
        u.aoff = (long)u.pm * astep + (long)(u.pn >> ashift) * abytes; u.boff = (long)u.pn * bstep; return true;
    }
};
struct OrderMoE {
    const volatile LAS int* te; int Mt, nN, G, c; long astep, bstep, estep;
    __device__ bool next(int i, Unit& u) const {
        const long L = (long)i * G + c; if (L >= (long)Mt * nN) return false;
        u.pm = (int)(L / nN); u.pn = (int)(L % nN);
        u.aoff = (long)u.pm * astep; u.boff = (long)te[u.pm] * estep + (long)u.pn * bstep; return true;
    }
};

template <class Epi, class Sched>
__device__ __forceinline__ void gemm_phase(LAS unsigned char* lds, const Gemm g, const Sched& S, const Epi& E) {
    int tid_ = threadIdx.x; asm volatile("" : "+v"(tid_));
    const bf16_t* gA = g.A; const bf16_t* gB = g.Bt; asm volatile("" : "+s"(gA), "+s"(gB));
    const int tid = tid_, wid = __builtin_amdgcn_readfirstlane(tid >> 6), lane = tid & 63, wr = wid >> 2, wc = wid & 3, fr = lane & 15, fq = lane >> 4;
    const int K = g.K, nt = K / BK;
    unsigned voffA[2], voffB[2];
#pragma unroll
    for (int i = 0; i < 2; ++i) { int R, C; stage_rc(tid * 16 + i * 8192, R, C); const int Rb = Epi::PERM ? ((R & ~31) + perm32(R & 31)) : R;
        voffA[i] = (unsigned)(R * g.lda + C) * 2u; voffB[i] = (unsigned)(Rb * g.ldb + C) * 2u; }
    const size_t kstep = (size_t)(BK * 2);
    const size_t hstepA = (size_t)HALF * g.lda * 2, hstepB = (size_t)HALF * g.ldb * 2;
    const unsigned ldsw = (unsigned)wid * 1024u;
    const int aoff = lds_byte(wr * 64 + fr, fq * 8), boff = lds_byte(wc * 32 + fr, fq * 8);
#define PG8_SA(b, h) (((b) * 2 + (h)) * HTB)
#define PG8_SB(b, h) ((4 + (b) * 2 + (h)) * HTB)
#define PG8_STAGE(bufoff, gbase, voff) do { _Pragma("unroll") for (int _i = 0; _i < 2; ++_i) \
        __builtin_amdgcn_global_load_lds((const unsigned*)((const char*)(gbase) + (voff)[_i]), (LAS unsigned*)(lds + (bufoff) + ldsw + _i * 8192), 16, 0, 0); } while (0)
#define PG8_LDA(dst, b, h) do { _Pragma("unroll") for (int m = 0; m < 4; ++m) _Pragma("unroll") for (int k = 0; k < 2; ++k) dst[m][k] = *(const LAS bf16x8*)(lds + PG8_SA(b, h) + aoff + m * 2048 + k * 1024); } while (0)
#define PG8_LDB(dst, b, h) do { _Pragma("unroll") for (int n = 0; n < 2; ++n) _Pragma("unroll") for (int k = 0; k < 2; ++k) dst[n][k] = *(const LAS bf16x8*)(lds + PG8_SB(b, h) + boff + n * 2048 + k * 1024); } while (0)
#define PG8_MMA(ai, bj, At, Bt) do { __builtin_amdgcn_s_setprio(1); _Pragma("unroll") for (int m = 0; m < 4; ++m) _Pragma("unroll") for (int n = 0; n < 2; ++n) _Pragma("unroll") for (int k = 0; k < 2; ++k) \
        acc[ai][bj][m][n] = __builtin_amdgcn_mfma_f32_16x16x32_bf16(Bt[n][k], At[m][k], acc[ai][bj][m][n], 0, 0, 0); __builtin_amdgcn_s_setprio(0); } while (0)
#define PG8_WAIT_V(n) asm volatile("s_waitcnt vmcnt(" #n ")" ::: "memory")
#define PG8_WAIT_L(n) asm volatile("s_waitcnt lgkmcnt(" #n ")" ::: "memory")
#define PG8_BAR __builtin_amdgcn_s_barrier()
#define PG8_SCHED __builtin_amdgcn_sched_barrier(0)
    Unit cur, nxt; int ui = 0;
    if (!S.next(0, cur)) return;
    f32x4 acc[2][2][4][2];
#pragma unroll
    for (int a = 0; a < 2; ++a)
#pragma unroll
        for (int b = 0; b < 2; ++b)
#pragma unroll
            for (int m = 0; m < 4; ++m)
#pragma unroll
                for (int n = 0; n < 2; ++n) acc[a][b][m][n] = (f32x4){0.f, 0.f, 0.f, 0.f};
    bf16x8 At[4][2], B0[2][2], B1[2][2];
    const char* cA = (const char*)gA + cur.aoff; const char* cB = (const char*)gB + cur.boff;
    PG8_STAGE(PG8_SB(0, 0), cB, voffB); PG8_STAGE(PG8_SA(0, 0), cA, voffA); PG8_STAGE(PG8_SB(0, 1), cB + hstepB, voffB); PG8_STAGE(PG8_SA(0, 1), cA + hstepA, voffA);
    if (wr == 1) PG8_BAR;
    PG8_WAIT_V(4); PG8_BAR;
    PG8_STAGE(PG8_SB(1, 0), cB + kstep, voffB); PG8_STAGE(PG8_SA(1, 0), cA + kstep, voffA); PG8_STAGE(PG8_SB(1, 1), cB + hstepB + kstep, voffB);
    PG8_WAIT_V(6); PG8_BAR;
    for (;;) {
        const bool has_next = S.next(ui + 1, nxt);
        const char* nA = has_next ? (const char*)gA + nxt.aoff : cA; const char* nB = has_next ? (const char*)gB + nxt.boff : cB;
        for (int t = 0; t < nt; t += 2) {
            const bool last = (t == nt - 2);
            const char* a1 = cA + (size_t)(t + 1) * kstep;
            const char* a2 = last ? nA : cA + (size_t)(t + 2) * kstep; const char* b2 = last ? nB : cB + (size_t)(t + 2) * kstep;
            const char* a3 = a2 + kstep; const char* b3 = b2 + kstep;
            PG8_LDB(B0, 0, 0); PG8_SCHED; PG8_LDA(At, 0, 0); PG8_STAGE(PG8_SA(1, 1), a1 + hstepA, voffA);
            PG8_WAIT_L(8); PG8_BAR; PG8_WAIT_L(0); PG8_MMA(0, 0, At, B0); PG8_BAR; PG8_SCHED;
            PG8_LDB(B1, 0, 1); PG8_STAGE(PG8_SB(0, 0), b2, voffB);
            PG8_BAR; PG8_WAIT_L(0); PG8_MMA(0, 1, At, B1); PG8_BAR;
            PG8_LDA(At, 0, 1); PG8_STAGE(PG8_SA(0, 0), a2, voffA);
            PG8_BAR; PG8_WAIT_L(0); PG8_MMA(1, 0, At, B0); PG8_BAR; PG8_SCHED;
            PG8_STAGE(PG8_SB(0, 1), b2 + hstepB, voffB);
            PG8_WAIT_V(6); PG8_BAR; PG8_MMA(1, 1, At, B1); PG8_BAR;
            PG8_LDB(B0, 1, 0); PG8_SCHED; PG8_LDA(At, 1, 0); PG8_STAGE(PG8_SA(0, 1), a2 + hstepA, voffA);
            PG8_WAIT_L(8); PG8_BAR; PG8_WAIT_L(0); PG8_MMA(0, 0, At, B0); PG8_BAR; PG8_SCHED;
            PG8_LDB(B1, 1, 1); PG8_STAGE(PG8_SB(1, 0), b3, voffB);
            PG8_BAR; PG8_WAIT_L(0); PG8_MMA(0, 1, At, B1); PG8_BAR;
            PG8_LDA(At, 1, 1); PG8_STAGE(PG8_SA(1, 0), a3, voffA);
            PG8_BAR; PG8_WAIT_L(0); PG8_MMA(1, 0, At, B0); PG8_BAR; PG8_SCHED;
            PG8_STAGE(PG8_SB(1, 1), b3 + hstepB, voffB);
            PG8_WAIT_V(6); PG8_BAR; PG8_MMA(1, 1, At, B1); PG8_BAR;
        }
        E(acc, cur, wr, wc, fr, fq);
        if (!has_next) break;
#pragma unroll
        for (int a = 0; a < 2; ++a)
#pragma unroll
            for (int b = 0; b < 2; ++b)
#pragma unroll
                for (int m = 0; m < 4; ++m)
#pragma unroll
                    for (int n = 0; n < 2; ++n) acc[a][b][m][n] = (f32x4){0.f, 0.f, 0.f, 0.f};
        cur = nxt; cA = nA; cB = nB; ++ui;
    }
    PG8_WAIT_V(0);
    if (wr == 0) PG8_BAR;
    PG8_BAR;
#undef PG8_SA
#undef PG8_SB
#undef PG8_STAGE
#undef PG8_LDA
#undef PG8_LDB
#undef PG8_MMA
#undef PG8_WAIT_V
#undef PG8_WAIT_L
#undef PG8_BAR
#undef PG8_SCHED
}

typedef const f32x4 (&AccT)[2][2][4][2];
template <int ACT> __device__ __forceinline__ void store_tile_bf16(AccT acc, bf16_t* O, int ld, int row0, int colb, float scale) {
#pragma unroll
    for (int ai = 0; ai < 2; ++ai)
#pragma unroll
        for (int m = 0; m < 4; ++m) { bf16_t* rowp = O + (size_t)(row0 + ai * HALF + m * 16) * ld + colb;
#pragma unroll
            for (int bj = 0; bj < 2; ++bj) { const f32x4 v0 = act4<ACT>(acc[ai][bj][m][0] * scale), v1 = act4<ACT>(acc[ai][bj][m][1] * scale);
                *(u32x4*)(rowp + bj * HALF) = pack8(v0, v1); }
            asm volatile("" ::: "memory"); }
}
template <int ACT> struct EpiStore {
    static constexpr bool PERM = true;
    bf16_t* O; int ld; float scale;
    __device__ __forceinline__ void operator()(AccT acc, const Unit& u, int wr, int wc, int fr, int fq) const {
        store_tile_bf16<ACT>(acc, O, ld, u.pm * BM + wr * 64 + fr, u.pn * BM + wc * 32 + 8 * fq, scale);
    }
};
struct EpiInProj {
    static constexpr bool PERM = true;
    unsigned char* ws;
    __device__ __forceinline__ void operator()(AccT acc, const Unit& u, int wr, int wc, int fr, int fq) const {
        const int pn = u.pn, row0 = u.pm * BM + wr * 64 + fr, cw = wc * 32 + 8 * fq;
        unsigned char* pj = ws + WS_PROJ;
        bf16_t *rq = (bf16_t*)(pj + P_RQ), *rk = (bf16_t*)(pj + P_RK), *rv = (bf16_t*)(pj + P_RV), *rg = (bf16_t*)(pj + P_RG), *gu = (bf16_t*)(pj + P_GU), *gv = (bf16_t*)(pj + P_GV), *dq = (bf16_t*)(pj + P_DQ),
               *iq = (bf16_t*)(pj + P_IQ), *ik = (bf16_t*)(pj + P_IK), *ga = (bf16_t*)(pj + P_GA), *gb = (bf16_t*)(pj + P_GB), *gc = (bf16_t*)(pj + P_GC);
        float *dcraw = (float*)(pj + P_DC), *iw = (float*)(pj + P_IW), *gvstats = (float*)(ws + WS_STATS); const float* rope = (const float*)(ws + WS_ROPE);
        if (pn < 8) {
            const bool isk = pn >= 4; bf16_t* dst = (isk ? rk : rq) + (pn & 3) * 256 + cw; const float sc = isk ? 0.0625f : 1.0f;
#pragma unroll
            for (int ai = 0; ai < 2; ++ai)
#pragma unroll
                for (int m = 0; m < 4; ++m) { const int row = row0 + ai * HALF + m * 16, pos = row & (SEQ - 1);
                    const f32x4* cs = (const f32x4*)(rope + ((size_t)pos * 128 + cw) * 2);
                    f32x4 o1[2], o2[2];
#pragma unroll
                    for (int n = 0; n < 2; ++n) { const f32x4 c01 = cs[2 * n], c23 = cs[2 * n + 1]; const f32x4 x1 = acc[ai][0][m][n], x2 = acc[ai][1][m][n];
                        const float co[4] = {c01[0], c01[2], c23[0], c23[2]}, si[4] = {c01[1], c01[3], c23[1], c23[3]};
#pragma unroll
                        for (int j = 0; j < 4; ++j) { o1[n][j] = (x1[j] * co[j] - x2[j] * si[j]) * sc; o2[n][j] = (x1[j] * si[j] + x2[j] * co[j]) * sc; } }
                    bf16_t* rp = dst + (size_t)row * 1024;
                    *(u32x4*)rp = pack8(o1[0], o1[1]); *(u32x4*)(rp + 128) = pack8(o2[0], o2[1]); asm volatile("" ::: "memory"); }
        } else if (pn < 12) { store_tile_bf16<0>(acc, rv, 1024, row0, (pn - 8) * 256 + cw, 1.f);
        } else if (pn < 16) { store_tile_bf16<2>(acc, rg, 1024, row0, (pn - 12) * 256 + cw, 1.f);
        } else if (pn < 20) { store_tile_bf16<1>(acc, gu, 1024, row0, (pn - 16) * 256 + cw, 1.f);
        } else if (pn < 24) {
            const int t4 = pn - 20; bf16_t* dst = gv + t4 * 256 + cw;
#pragma unroll
            for (int ai = 0; ai < 2; ++ai)
#pragma unroll
                for (int m = 0; m < 4; ++m) { const int row = row0 + ai * HALF + m * 16; float s = 0.f, q = 0.f;
#pragma unroll
                    for (int bj = 0; bj < 2; ++bj) { const f32x4 v0 = act4<1>(acc[ai][bj][m][0]), v1 = act4<1>(acc[ai][bj][m][1]);
                        *(u32x4*)(dst + (size_t)row * 1024 + bj * HALF) = pack8(v0, v1);
#pragma unroll
                        for (int j = 0; j < 4; ++j) { s += v0[j] + v1[j]; q += v0[j] * v0[j] + v1[j] * v1[j]; } }
                    s += __shfl_xor(s, 16); s += __shfl_xor(s, 32); q += __shfl_xor(q, 16); q += __shfl_xor(q, 32);
                    if (fq == 0) *(f32x2*)(gvstats + ((size_t)row * 16 + t4 * 4 + wc) * 2) = (f32x2){s, q}; asm volatile("" ::: "memory"); }
        } else if (pn < 28) { store_tile_bf16<0>(acc, dq, 1024, row0, (pn - 24) * 256 + cw, 1.f);
        } else if (pn == 28) {
#pragma unroll
            for (int ai = 0; ai < 2; ++ai)
#pragma unroll
                for (int m = 0; m < 4; ++m) { float* rp = dcraw + (size_t)(row0 + ai * HALF + m * 16) * 256 + cw;
#pragma unroll
                    for (int bj = 0; bj < 2; ++bj) { *(f32x4*)(rp + bj * HALF) = acc[ai][bj][m][0]; *(f32x4*)(rp + bj * HALF + 4) = acc[ai][bj][m][1]; } }
        } else if (pn < 31) { store_tile_bf16<0>(acc, iq, 512, row0, (pn - 29) * 256 + cw, 1.f);
        } else if (pn == 31) {
#pragma unroll
            for (int ai = 0; ai < 2; ++ai)
#pragma unroll
                for (int m = 0; m < 4; ++m) { const int row = row0 + ai * HALF + m * 16;
                    if (wc < 2) *(u32x4*)(ik + (size_t)row * 64 + cw) = pack8(acc[ai][0][m][0], acc[ai][0][m][1]);
                    if (wc == 2 && fq == 0) { *(f32x4*)(iw + (size_t)row * 8) = acc[ai][0][m][0] * 0.35355339059f; *(f32x4*)(iw + (size_t)row * 8 + 4) = acc[ai][0][m][1] * 0.35355339059f; } }
        } else { const int gi = (pn - 32) >> 3; bf16_t* dst = gi == 0 ? ga : (gi == 1 ? gb : gc);
            store_tile_bf16<3>(acc, dst, 2048, row0, ((pn - 32) & 7) * 256 + cw, 1.f); }
    }
};
struct EpiBranch {
    static constexpr bool PERM = true;
    const bf16_t* gate; bf16_t* merged; int first;
    __device__ __forceinline__ void operator()(AccT acc, const Unit& u, int wr, int wc, int fr, int fq) const {
        const int row0 = u.pm * BM + wr * 64 + fr, colb = u.pn * BM + wc * 32 + 8 * fq;
#pragma unroll
        for (int ai = 0; ai < 2; ++ai)
#pragma unroll
            for (int m = 0; m < 4; ++m) { const size_t ro = (size_t)(row0 + ai * HALF + m * 16) * 2048 + colb;
#pragma unroll
                for (int bj = 0; bj < 2; ++bj) { float g8[8], m8[8]; unpack8(*(const u32x4*)(gate + ro + bj * HALF), g8);
                    if (!first) unpack8(*(const u32x4*)(merged + ro + bj * HALF), m8); else {
#pragma unroll
                        for (int j = 0; j < 8; ++j) m8[j] = 0.f; }
                    const f32x4 a0 = acc[ai][bj][m][0], a1 = acc[ai][bj][m][1];
                    f32x4 r0, r1;
#pragma unroll
                    for (int j = 0; j < 4; ++j) { r0[j] = m8[j] + g8[j] * a0[j]; r1[j] = m8[4 + j] + g8[4 + j] * a1[j]; }
                    *(u32x4*)(merged + ro + bj * HALF) = pack8(r0, r1); } }
    }
};
struct EpiResid {
    static constexpr bool PERM = false;
    const float* xsrc; float* xdst;
    __device__ __forceinline__ void operator()(AccT acc, const Unit& u, int wr, int wc, int fr, int fq) const {
        const int row0 = u.pm * BM + wr * 64 + fr, col0 = u.pn * BM + wc * 32 + 4 * fq;
#pragma unroll
        for (int ai = 0; ai < 2; ++ai)
#pragma unroll
            for (int m = 0; m < 4; ++m) { const size_t ro = (size_t)(row0 + ai * HALF + m * 16) * DM + col0;
#pragma unroll
                for (int bj = 0; bj < 2; ++bj)
#pragma unroll
                    for (int n = 0; n < 2; ++n) { const size_t o = ro + bj * HALF + n * 16; *(f32x4*)(xdst + o) = *(const f32x4*)(xsrc + o) + acc[ai][bj][m][n]; } }
    }
};
struct EpiMoeUp {
    static constexpr bool PERM = true;
    bf16_t* hid;
    __device__ __forceinline__ void operator()(AccT acc, const Unit& u, int wr, int wc, int fr, int fq) const {
        const int row0 = u.pm * BM + wr * 64 + fr, colb = u.pn * 128 + wc * 32 + 8 * fq;
#pragma unroll
        for (int ai = 0; ai < 2; ++ai)
#pragma unroll
            for (int m = 0; m < 4; ++m) { f32x4 r0, r1; const f32x4 a0 = acc[ai][0][m][0], a1 = acc[ai][0][m][1], b0 = acc[ai][1][m][0], b1 = acc[ai][1][m][1];
#pragma unroll
                for (int j = 0; j < 4; ++j) { r0[j] = siluf_(a0[j]) * b0[j]; r1[j] = siluf_(a1[j]) * b1[j]; }
                *(u32x4*)(hid + (size_t)(row0 + ai * HALF + m * 16) * FF + colb) = pack8(r0, r1); }
    }
};
}

struct Args { const float* in[23]; float* out; unsigned char* ws; int ph_lo, ph_hi; };
enum { I_X = 0, I_NMIX, I_WIN, I_WRET, I_LNG, I_LNB, I_WS, I_BS, I_WGM, I_KVG, I_WUK, I_WUV, I_WDS, I_WOUT, I_NFFN, I_WGRP, I_BGRP, I_WEXP, I_BEXP, I_W1, I_W3, I_W2, I_FNG };
struct Ctx {
    LAS unsigned char* lds; volatile LAS int* misc; unsigned* ctl; unsigned char* ws;
    int tid, lane, wave, G, bid, gw, NGW;
    const float* const* in; float* out;
};
#define WSP(T_, off) ((T_*)(C.ws + (off)))
__device__ __forceinline__ void refresh(Ctx& C) { int t = threadIdx.x; asm volatile("" : "+v"(t)); C.tid = t; C.lane = t & 63; }

__device__ __forceinline__ void ph_rope(const Ctx& C) {
    float* rope = WSP(float, WS_ROPE);
    const double r1 = 0.9305720409296989;
    for (int idx = C.bid * 512 + C.tid; idx < SEQ * 128; idx += C.G * 512) {
        const int pos = idx >> 7, i = idx & 127;
        double inv = 1.0, b = r1; int e = i;
        while (e) { if (e & 1) inv *= b; b *= b; e >>= 1; }
        const double ang = (double)pos * inv;
        const double n = __builtin_rint(ang * 0.15915494309189533577);
        const double x = ang - n * 6.283185307179586476925;
        const double x2 = x * x;
        double s = 0.0, c = 0.0;
#pragma unroll 1
        for (int k = 14; k >= 1; --k) { s = (s + 1.0) * (-x2 / (double)((2 * k) * (2 * k + 1))); c = (c + 1.0) * (-x2 / (double)((2 * k - 1) * (2 * k))); }
        s = (s + 1.0) * x; c = c + 1.0;
        *(f32x2*)(rope + (size_t)idx * 2) = (f32x2){(float)c, (float)s};
    }
}

template <class Map>
__device__ __forceinline__ void tr_item(const float* W, long srcld, bf16_t* WT, long dstld, int k0, int n0, LAS float* scr, int lane, const Map& map) {
    const int nn = n0 + (lane & 31); const long sc = map(nn);
#pragma unroll 8
    for (int i = 0; i < 32; ++i) { const int kk = 2 * i + (lane >> 5); scr[kk * 33 + (lane & 31)] = sc >= 0 ? W[(size_t)(k0 + kk) * srcld + sc] : 0.f; }
    asm volatile("s_waitcnt lgkmcnt(0)" ::: "memory");
    const int c = lane & 7;
#pragma unroll
    for (int j = 0; j < 4; ++j) { const int n = (lane >> 3) + 8 * j; const LAS float* s = scr + (8 * c) * 33 + n;
        u32x4 o; o.x = cvt_pk_bf16(s[0 * 33], s[1 * 33]); o.y = cvt_pk_bf16(s[2 * 33], s[3 * 33]); o.z = cvt_pk_bf16(s[4 * 33], s[5 * 33]); o.w = cvt_pk_bf16(s[6 * 33], s[7 * 33]);
        *(u32x4*)(WT + (size_t)(n0 + n) * dstld + k0 + 8 * c) = o; }
    asm volatile("s_waitcnt lgkmcnt(0)" ::: "memory");
}
struct MapId { __device__ long operator()(int n) const { return n; } };
struct MapIn { __device__ long operator()(int n) const { return n < GATE_SRC0 ? n : (n < GATE_DST0 ? -1 : n - (GATE_DST0 - GATE_SRC0)); } };
struct MapOff { long off; __device__ long operator()(int n) const { return n + off; } };

__device__ __forceinline__ void ph_weights(const Ctx& C, int l) {
    LAS float* scr = (LAS float*)(C.lds + C.wave * 16384);
    unsigned char* wb = C.ws + WS_W;
    constexpr int N_IN = 32 * 448, N_BR = 16 * 64, N_OUT = 32 * 64, N_13 = 32 * 32 * 32, N_2 = 32 * 8 * 64, N_UV = 8 * 16;
    constexpr int NITEMS = N_IN + 3 * N_BR + N_OUT + N_13 + N_2 + N_UV;
    for (int it = C.gw; it < NITEMS; it += C.NGW) {
        int r = it;
        if (r < N_IN) { const int kb = r / 448, nb = r % 448; tr_item(C.in[I_WIN] + (size_t)l * DM * INW, INW, (bf16_t*)(wb + W_IN), DM, kb * 64, nb * 32, scr, C.lane, MapIn{}); continue; } r -= N_IN;
        if (r < 3 * N_BR) { const int w = r / N_BR, q = r % N_BR, kb = q / 64, nb = q % 64; const float* src = C.in[w == 0 ? I_WRET : (w == 1 ? I_WGM : I_WDS)] + (size_t)l * 1024 * DM;
            tr_item(src, DM, (bf16_t*)(wb + (w == 0 ? W_RET : (w == 1 ? W_GM : W_DS))), 1024, kb * 64, nb * 32, scr, C.lane, MapId{}); continue; } r -= 3 * N_BR;
        if (r < N_OUT) { const int kb = r / 64, nb = r % 64; tr_item(C.in[I_WOUT] + (size_t)l * DM * DM, DM, (bf16_t*)(wb + W_OUT), DM, kb * 64, nb * 32, scr, C.lane, MapId{}); continue; } r -= N_OUT;
        if (r < N_13) { const int e = r / 1024, q = r % 1024, kb = q / 32, nb = q % 32;
            const int row0 = nb * 32, j = row0 >> 8, s = (row0 >> 7) & 1, fp = row0 & 127;
            const float* src = C.in[s ? I_W3 : I_W1] + ((size_t)l * NEXP + e) * DM * FF;
            tr_item(src, FF, (bf16_t*)(wb + W_13) + (size_t)e * 1024 * DM, DM, kb * 64, row0, scr, C.lane, MapOff{(long)(128 * j + fp) - row0}); continue; } r -= N_13;
        if (r < N_2) { const int e = r / 512, q = r % 512, kb = q / 64, nb = q % 64;
            tr_item(C.in[I_W2] + ((size_t)l * NEXP + e) * FF * DM, DM, (bf16_t*)(wb + W_2) + (size_t)e * DM * FF, FF, kb * 64, nb * 32, scr, C.lane, MapId{}); continue; } r -= N_2;
        { const int h = r / 16, q = r % 16, kb = q / 4, nb = q % 4;
            tr_item(C.in[I_WUV] + ((size_t)l * 8 + h) * 256 * 128, 128, (bf16_t*)(wb + W_UV) + (size_t)(h * 128) * 512 + (h & 1) * 256, 512, kb * 64, nb * 32, scr, C.lane, MapId{}); }
    }
    bf16_t* uv = (bf16_t*)(wb + W_UV); bf16_t* uk = (bf16_t*)(wb + W_UK); const float* wuk = C.in[I_WUK] + (size_t)l * 8 * 256 * 128;
    for (int idx = C.bid * 512 + C.tid; idx < 1024 * 256 / 8; idx += C.G * 512) { const int row = idx >> 5, c8 = (idx & 31) * 8, h = row >> 7;
        *(u32x4*)(uv + (size_t)row * 512 + (1 - (h & 1)) * 256 + c8) = (u32x4){0u, 0u, 0u, 0u}; }
    for (int idx = C.bid * 512 + C.tid; idx < 2048 * 256 / 8; idx += C.G * 512) { const int row = idx >> 5, c8 = (idx & 31) * 8, h = row >> 8, half = c8 >> 7;
        u32x4 o = (u32x4){0u, 0u, 0u, 0u};
        if (half == (h & 1)) { const float* s = wuk + (size_t)row * 128 + (c8 & 127); const f32x4 a = *(const f32x4*)s, b = *(const f32x4*)(s + 4); o = pack8(a, b); }
        *(u32x4*)(uk + (size_t)row * 256 + c8) = o; }
}

__device__ __forceinline__ void ph_norm(const Ctx& C, const float* x, const float* g, bf16_t* H) {
    for (int row = C.gw; row < T; row += C.NGW) {
        const f32x4* xr = (const f32x4*)(x + (size_t)row * DM) + C.lane; f32x4 v[8]; float ss = 0.f;
#pragma unroll
        for (int j = 0; j < 8; ++j) { v[j] = xr[64 * j]; ss += v[j][0] * v[j][0] + v[j][1] * v[j][1] + v[j][2] * v[j][2] + v[j][3] * v[j][3]; }
        const float rstd = rsqrtf(wave_sum(ss) * (1.f / DM) + EPS);
        u32x2* o = (u32x2*)(H + (size_t)row * DM) + C.lane;
#pragma unroll
        for (int j = 0; j < 8; ++j) { const f32x4 gg = ((const f32x4*)g)[64 * j + C.lane]; const f32x4 y = v[j] * rstd * gg; u32x2 w; w.x = cvt_pk_bf16(y[0], y[1]); w.y = cvt_pk_bf16(y[2], y[3]); o[64 * j] = w; }
    }
}
__device__ __forceinline__ void ph_ckv(const Ctx& C, const float* dcraw, const float* g, bf16_t* ckv) {
    for (int row = C.gw; row < T; row += C.NGW) {
        const f32x4 v = ((const f32x4*)(dcraw + (size_t)row * 256))[C.lane];
        const float ss = wave_sum(v[0] * v[0] + v[1] * v[1] + v[2] * v[2] + v[3] * v[3]);
        const float rstd = rsqrtf(ss * (1.f / 256.f) + EPS); const f32x4 y = v * rstd * ((const f32x4*)g)[C.lane];
        u32x2 w; w.x = cvt_pk_bf16(y[0], y[1]); w.y = cvt_pk_bf16(y[2], y[3]); ((u32x2*)(ckv + (size_t)row * 256))[C.lane] = w;
    }
}

__device__ __forceinline__ void ph_gmlp_naive(const Ctx& C, int l) {
    const bf16_t* gu = WSP(bf16_t, WS_PROJ + P_GU); const bf16_t* gv = WSP(bf16_t, WS_PROJ + P_GV); const float* stats = WSP(float, WS_STATS); bf16_t* gm = WSP(bf16_t, WS_GM);
    const float* lng = C.in[I_LNG] + l * 1024; const float* lnb = C.in[I_LNB] + l * 1024; const float* Wsp = C.in[I_WS] + (size_t)l * 4 * 128 * 128; const float* bs = C.in[I_BS] + l * 4 * 128;
    LAS float* smean = (LAS float*)C.lds; LAS float* srstd = smean + 128; LAS float* lv = srstd + 128;
    for (int u = C.bid; u < 512; u += C.G) {
        const int g = u & 3, bn = u >> 2, t0 = bn * 128;
        __syncthreads();
        if (C.tid < 128) { const float* sp = stats + (size_t)(t0 + C.tid) * 32; float s = 0.f, q = 0.f;
            for (int k = 0; k < 16; ++k) { s += sp[2 * k]; q += sp[2 * k + 1]; }
            const float mean = s * (1.f / 1024.f), var = q * (1.f / 1024.f) - mean * mean; smean[C.tid] = mean; srstd[C.tid] = rsqrtf(var + EPS); }
        __syncthreads();
        for (int idx = C.tid; idx < 128 * 256; idx += 512) { const int j = idx >> 8, c = idx & 255, ch = g * 256 + c;
            lv[idx] = (bf2f(gv[(size_t)(t0 + j) * 1024 + ch]) - smean[j]) * srstd[j] * lng[ch] + lnb[ch]; }
        __syncthreads();
        for (int idx = C.tid; idx < 128 * 256; idx += 512) { const int i = idx >> 8, c = idx & 255; const float* wr = Wsp + ((size_t)g * 128 + i) * 128; float a = 0.f;
            for (int j = 0; j <= i; ++j) a += wr[j] * lv[j * 256 + c];
            a += bs[g * 128 + i];
            const size_t o = (size_t)(t0 + i) * 1024 + g * 256 + c; gm[o] = (bf16_t)f2bf(bf2f(gu[o]) * a); }
    }
}
__device__ __forceinline__ void ph_ret_naive(const Ctx& C) {
    const bf16_t* rq = WSP(bf16_t, WS_PROJ + P_RQ); const bf16_t* rk = WSP(bf16_t, WS_PROJ + P_RK); const bf16_t* rv = WSP(bf16_t, WS_PROJ + P_RV); const bf16_t* rg = WSP(bf16_t, WS_PROJ + P_RG); bf16_t* ret = WSP(bf16_t, WS_RET);
    LAS float* sq = (LAS float*)C.lds; LAS float* sa = sq + 256; LAS float* red = sa + 4096;
    for (int u = C.bid; u < NB * 4 * SEQ; u += C.G) {
        const int t = (SEQ - 1) - (u / 16), bh = u % 16, b = bh >> 2, h = bh & 3; const size_t rowb = (size_t)b * SEQ;
        const float lg2 = log2f(1.0f - exp2f(-5.0f - (float)h));
        __syncthreads();
        if (C.tid < 256) sq[C.tid] = bf2f(rq[(rowb + t) * 1024 + h * 256 + C.tid]);
        __syncthreads();
        for (int s = C.tid; s <= t; s += 512) { const u32x4* kp = (const u32x4*)(rk + (rowb + s) * 1024 + h * 256); float a = 0.f;
            for (int d8 = 0; d8 < 32; ++d8) { float f[8]; unpack8(kp[d8], f);
#pragma unroll
                for (int j = 0; j < 8; ++j) a += sq[d8 * 8 + j] * f[j]; }
            sa[s] = a * exp2f(lg2 * (float)(t - s)); }
        __syncthreads();
        float o = 0.f;
        if (C.tid < 256) { const bf16_t* vp = rv + rowb * 1024 + h * 256 + C.tid; for (int s = 0; s <= t; ++s) o += sa[s] * bf2f(vp[(size_t)s * 1024]); }
        const float ss = wave_sum(o * o); if (C.lane == 0) red[C.wave] = ss;
        __syncthreads();
        if (C.tid < 256) { const float tot = red[0] + red[1] + red[2] + red[3]; const float y = o * rsqrtf(tot * (1.f / 256.f) + EPS);
            const size_t oi = (rowb + t) * 1024 + h * 256 + C.tid; ret[oi] = (bf16_t)f2bf(bf2f(rg[oi]) * y); }
    }
}
__device__ __forceinline__ void ph_idx_naive(const Ctx& C) {
    const bf16_t* iq = WSP(bf16_t, WS_PROJ + P_IQ); const bf16_t* ik = WSP(bf16_t, WS_PROJ + P_IK); const float* iw = WSP(float, WS_PROJ + P_IW); unsigned short* sel = WSP(unsigned short, WS_SEL);
    LAS float* sq = (LAS float*)C.lds; LAS float* sw = sq + 512; LAS float* sc = sw + 8;
    for (int u = C.bid; u < T; u += C.G) {
        const int tq = (T - 1) - u; const int b = tq >> 12, q = tq & (SEQ - 1), n = q + 1;
        __syncthreads();
        sq[C.tid] = bf2f(iq[(size_t)tq * 512 + C.tid]); if (C.tid < 8) sw[C.tid] = iw[(size_t)tq * 8 + C.tid];
        for (int r = C.tid; r < 256; r += 512) sel[(size_t)tq * 256 + r] = 0xFFFFu;
        __syncthreads();
        for (int s = C.tid; s < n; s += 512) { const u32x4* kp = (const u32x4*)(ik + ((size_t)b * SEQ + s) * 64); float kf[64];
#pragma unroll
            for (int d8 = 0; d8 < 8; ++d8) { float f[8]; unpack8(kp[d8], f);
#pragma unroll
                for (int j = 0; j < 8; ++j) kf[d8 * 8 + j] = f[j]; }
            float score = 0.f;
#pragma unroll 1
            for (int h = 0; h < 8; ++h) { float a = 0.f;
#pragma unroll
                for (int d = 0; d < 64; ++d) a += sq[h * 64 + d] * kf[d];
                score += sw[h] * fmaxf(a * 0.125f, 0.f); }
            sc[s] = score; }
        __syncthreads();
        for (int s = C.tid; s < n; s += 512) { const float v = sc[s]; int rank = 0;
            for (int s2 = 0; s2 < n; ++s2) { const float w = sc[s2]; rank += (w > v || (w == v && s2 < s)) ? 1 : 0; }
            if (rank < 256) sel[(size_t)tq * 256 + rank] = (unsigned short)s; }
    }
}
__device__ __forceinline__ void ph_att_naive(const Ctx& C) {
    const bf16_t* qabs = WSP(bf16_t, WS_QABS); const bf16_t* ckv = WSP(bf16_t, WS_CKV); const unsigned short* sel = WSP(unsigned short, WS_SEL); bf16_t* olat = WSP(bf16_t, WS_OLAT);
    LAS float* sqa = (LAS float*)C.lds; LAS float* sp = sqa + 2048; LAS int* ssel = (LAS int*)(sp + 2048);
    for (int tq = C.bid; tq < T; tq += C.G) {
        const int b = tq >> 12, q = tq & (SEQ - 1);
        __syncthreads();
        for (int i = C.tid; i < 2048; i += 512) sqa[i] = bf2f(qabs[(size_t)tq * 2048 + i]);
        if (C.tid < 256) { const int s = sel[(size_t)tq * 256 + C.tid]; ssel[C.tid] = (s <= q) ? s : -1; }
        __syncthreads();
        const int h = C.wave; float sv[4]; float mx = -INFINITY;
#pragma unroll
        for (int j = 0; j < 4; ++j) { const int k = C.lane + 64 * j, s = ssel[k]; float a = -INFINITY;
            if (s >= 0) { const u32x4* cp = (const u32x4*)(ckv + ((size_t)b * SEQ + s) * 256); a = 0.f;
                for (int c8 = 0; c8 < 32; ++c8) { float f[8]; unpack8(cp[c8], f);
#pragma unroll
                    for (int jj = 0; jj < 8; ++jj) a += sqa[h * 256 + c8 * 8 + jj] * f[jj]; } }
            sv[j] = a; mx = fmaxf(mx, a); }
        mx = wave_max(mx); float sum = 0.f;
#pragma unroll
        for (int j = 0; j < 4; ++j) { sv[j] = __expf(sv[j] - mx); sum += sv[j]; }
        sum = wave_sum(sum); const float inv = 1.f / sum;
#pragma unroll
        for (int j = 0; j < 4; ++j) sp[h * 256 + C.lane + 64 * j] = sv[j] * inv;
        __syncthreads();
        float o[4] = {0.f, 0.f, 0.f, 0.f};
        for (int k = 0; k < 256; ++k) { const int s = ssel[k]; if (s < 0) continue; const float p = sp[h * 256 + k]; const bf16_t* cp = ckv + ((size_t)b * SEQ + s) * 256 + C.lane;
#pragma unroll
            for (int j = 0; j < 4; ++j) o[j] += p * bf2f(cp[64 * j]); }
#pragma unroll
        for (int j = 0; j < 4; ++j) olat[(size_t)tq * 2048 + h * 256 + C.lane + 64 * j] = (bf16_t)f2bf(o[j]);
    }
}

__device__ __forceinline__ void ph_router(const Ctx& C, int l, const float* x) {
    const float* g = C.in[I_NFFN] + l * DM; const float* wg = C.in[I_WGRP] + (size_t)l * DM * 4; const float* bg = C.in[I_BGRP] + l * 4;
    const float* we = C.in[I_WEXP] + (size_t)l * 4 * DM * 8; const float* be = C.in[I_BEXP] + l * 32;
    bf16_t* H = WSP(bf16_t, WS_H); int* rinfo = WSP(int, WS_ROUTE); float* rw = (float*)(rinfo + T * 4); unsigned* cnt = C.ctl + CW_CNT + l * 64;
    for (int row = C.gw; row < T; row += C.NGW) {
        const f32x4* xr = (const f32x4*)(x + (size_t)row * DM) + C.lane; f32x4 v[8]; float ss = 0.f;
#pragma unroll
        for (int j = 0; j < 8; ++j) { v[j] = xr[64 * j]; ss += v[j][0] * v[j][0] + v[j][1] * v[j][1] + v[j][2] * v[j][2] + v[j][3] * v[j][3]; }
        const float rstd = rsqrtf(wave_sum(ss) * (1.f / DM) + EPS);
        u32x2* o = (u32x2*)(H + (size_t)row * DM) + C.lane; float gl[4] = {0.f, 0.f, 0.f, 0.f};
#pragma unroll
        for (int j = 0; j < 8; ++j) { const f32x4 gg = ((const f32x4*)g)[64 * j + C.lane]; v[j] = v[j] * rstd * gg; u32x2 w; w.x = cvt_pk_bf16(v[j][0], v[j][1]); w.y = cvt_pk_bf16(v[j][2], v[j][3]); o[64 * j] = w;
            const int d0 = 256 * j + 4 * C.lane;
#pragma unroll
            for (int e = 0; e < 4; ++e) { const f32x4 w4 = *(const f32x4*)(wg + (size_t)(d0 + e) * 4); gl[0] += v[j][e] * w4[0]; gl[1] += v[j][e] * w4[1]; gl[2] += v[j][e] * w4[2]; gl[3] += v[j][e] * w4[3]; } }
        int gsel = 0; float gmax = -INFINITY, gv4[4];
#pragma unroll
        for (int k = 0; k < 4; ++k) { gv4[k] = wave_sum(gl[k]) + bg[k]; if (gv4[k] > gmax) { gmax = gv4[k]; gsel = k; } }
        float gden = 0.f;
#pragma unroll
        for (int k = 0; k < 4; ++k) gden += __expf(gv4[k] - gmax);
        const float pg = 1.f / gden;
        gsel = __builtin_amdgcn_readfirstlane(gsel);
        const float* wes = we + (size_t)gsel * DM * 8; float el[8] = {0.f, 0.f, 0.f, 0.f, 0.f, 0.f, 0.f, 0.f};
#pragma unroll
        for (int j = 0; j < 8; ++j) { const int d0 = 256 * j + 4 * C.lane;
#pragma unroll
            for (int e = 0; e < 4; ++e) { const f32x4 a = *(const f32x4*)(wes + (size_t)(d0 + e) * 8), b2 = *(const f32x4*)(wes + (size_t)(d0 + e) * 8 + 4);
#pragma unroll
                for (int k = 0; k < 4; ++k) { el[k] += v[j][e] * a[k]; el[4 + k] += v[j][e] * b2[k]; } } }
        float emax = -INFINITY;
#pragma unroll
        for (int k = 0; k < 8; ++k) { el[k] = wave_sum(el[k]) + be[gsel * 8 + k]; emax = fmaxf(emax, el[k]); }
        float eden = 0.f, ep[8];
#pragma unroll
        for (int k = 0; k < 8; ++k) { ep[k] = __expf(el[k] - emax); eden += ep[k]; }
        int i0 = 0; float p0 = -1.f;
#pragma unroll
        for (int k = 0; k < 8; ++k) { ep[k] = ep[k] / eden; if (ep[k] > p0) { p0 = ep[k]; i0 = k; } }
        int i1 = 0; float p1 = -1.f;
#pragma unroll
        for (int k = 0; k < 8; ++k) if (k != i0 && ep[k] > p1) { p1 = ep[k]; i1 = k; }
        const float den = p0 + p1;
        if (C.lane == 0) { const int e0 = gsel * 8 + i0, e1 = gsel * 8 + i1;
            const unsigned r0 = atomicAdd(&cnt[e0], 1u), r1 = atomicAdd(&cnt[e1], 1u);
            *(int4*)(rinfo + (size_t)row * 4) = make_int4(e0, e1, (int)r0, (int)r1); *(f32x2*)(rw + (size_t)row * 2) = (f32x2){pg * (p0 / den), pg * (p1 / den)}; }
    }
}
__device__ __forceinline__ int moe_offsets(const unsigned* cnt, int lane, int& total_tiles) {
    const int c = lane < NEXP ? (int)__hip_atomic_load(cnt + lane, __ATOMIC_RELAXED, __HIP_MEMORY_SCOPE_AGENT) : 0; const int tiles = (c + 255) >> 8;
    int incl = tiles;
#pragma unroll
    for (int o = 1; o < 64; o <<= 1) { const int t = __shfl_up(incl, o); if (lane >= o) incl += t; }
    total_tiles = __shfl(incl, 63);
    return (incl - tiles) * 256;
}
__device__ __forceinline__ void ph_permute(const Ctx& C, int l) {
    const bf16_t* H = WSP(bf16_t, WS_H); bf16_t* hperm = WSP(bf16_t, WS_PROJ + M_HPERM); int* rinfo = WSP(int, WS_ROUTE); int* rpos = rinfo + T * 6;
    int tt; const int myoff = moe_offsets(C.ctl + CW_CNT + l * 64, C.lane, tt);
    for (int row = C.gw; row < T; row += C.NGW) {
        const int4 ri = *(const int4*)(rinfo + (size_t)row * 4);
        const int p0 = __shfl(myoff, ri.x) + ri.z, p1 = __shfl(myoff, ri.y) + ri.w;
        const u32x4* src = (const u32x4*)(H + (size_t)row * DM) + C.lane; u32x4* d0 = (u32x4*)(hperm + (size_t)p0 * DM) + C.lane; u32x4* d1 = (u32x4*)(hperm + (size_t)p1 * DM) + C.lane;
#pragma unroll
        for (int j = 0; j < 4; ++j) { const u32x4 w = src[64 * j]; d0[64 * j] = w; d1[64 * j] = w; }
        if (C.lane == 0) { rpos[(size_t)row * 2] = p0; rpos[(size_t)row * 2 + 1] = p1; }
    }
}
__device__ __forceinline__ int moe_table(const Ctx& C, int l) {
    __syncthreads();
    if (C.wave == 0) { int tt; const int off = moe_offsets(C.ctl + CW_CNT + l * 64, C.lane, tt); const int nxt = __shfl_down(off, 1);
        if (C.lane < NEXP) { const int t0 = off >> 8, t1 = (C.lane == NEXP - 1) ? tt : (nxt >> 8); for (int t = t0; t < t1; ++t) C.misc[16 + t] = C.lane; }
        if (C.lane == 0) C.misc[200] = tt; }
    __syncthreads();
    return C.misc[200];
}
__device__ __forceinline__ void ph_combine(const Ctx& C, float* x, bool last) {
    const bf16_t* yc = WSP(bf16_t, WS_PROJ + M_YC); const int* rinfo = WSP(int, WS_ROUTE); const float* rw = (const float*)(rinfo + T * 4); const int* rpos = rinfo + T * 6; const float* gf = C.in[I_FNG];
    for (int row = C.gw; row < T; row += C.NGW) {
        const int p0 = rpos[(size_t)row * 2], p1 = rpos[(size_t)row * 2 + 1]; const float w0 = rw[(size_t)row * 2], w1 = rw[(size_t)row * 2 + 1];
        f32x4* xr = (f32x4*)(x + (size_t)row * DM) + C.lane; const u32x2* y0 = (const u32x2*)(yc + (size_t)p0 * DM) + C.lane; const u32x2* y1 = (const u32x2*)(yc + (size_t)p1 * DM) + C.lane;
        f32x4 v[8]; float ss = 0.f;
#pragma unroll
        for (int j = 0; j < 8; ++j) { const u32x2 a = y0[64 * j], b = y1[64 * j]; f32x4 xv = xr[64 * j];
            xv[0] += w0 * bf2f(a.x) + w1 * bf2f(b.x); xv[1] += w0 * bf2f(a.x >> 16) + w1 * bf2f(b.x >> 16); xv[2] += w0 * bf2f(a.y) + w1 * bf2f(b.y); xv[3] += w0 * bf2f(a.y >> 16) + w1 * bf2f(b.y >> 16);
            v[j] = xv; ss += xv[0] * xv[0] + xv[1] * xv[1] + xv[2] * xv[2] + xv[3] * xv[3]; }
        if (last) { const float rstd = rsqrtf(wave_sum(ss) * (1.f / DM) + EPS);
#pragma unroll
            for (int j = 0; j < 8; ++j) xr[64 * j] = v[j] * rstd * ((const f32x4*)gf)[64 * j + C.lane]; }
        else {
#pragma unroll
            for (int j = 0; j < 8; ++j) xr[64 * j] = v[j]; }
    }
}

constexpr int NPL = 12, NPHASES = 1 + DEPTH * NPL;
__global__ void __launch_bounds__(512, 2) mk_fwd(Args a) {
    extern __shared__ __attribute__((aligned(16))) unsigned char lds_raw[];
    Ctx C;
    C.lds = (LAS unsigned char*)lds_raw; C.misc = (volatile LAS int*)(C.lds + MISC_OFF); C.ws = a.ws; C.ctl = (unsigned*)(a.ws + WS_CTL);
    C.tid = threadIdx.x; C.lane = C.tid & 63; C.wave = __builtin_amdgcn_readfirstlane(C.tid >> 6); C.G = gridDim.x; C.bid = blockIdx.x;
    C.gw = C.bid * 8 + C.wave; C.NGW = C.G * 8; C.in = a.in; C.out = a.out;
    for (int i = C.tid; i < 256; i += 512) C.misc[i] = 0;
    __syncthreads();
#if MK_PER_PHASE
    XcdBarrier bar; bar.bar = C.ctl + CW_BAR; bar.x = 0; bar.st = (volatile LAS unsigned*)C.misc;
#else
    XcdBarrier bar = xcd_barrier_post(C.ctl + CW_BAR, (volatile LAS unsigned*)C.misc);
#endif
    const int lo = a.ph_lo, hi = a.ph_hi;
#define IN(k) (lo <= (k) && (k) < hi)
#if MK_PER_PHASE
#define SEAM(k) do { } while (0)
#else
#define SEAM(k) do { if (IN(k) && IN((k) + 1)) xcd_barrier(bar); } while (0)
#endif
    unsigned char* wb = C.ws + WS_W;
    bf16_t* H = WSP(bf16_t, WS_H);
    if (IN(0)) ph_rope(C);
#pragma unroll 1
    for (int l = 0; l < DEPTH; ++l) {
        const int pb = 1 + l * NPL;
        const float* xin = (l == 0) ? C.in[I_X] : (const float*)C.out;
        if (IN(pb + 0)) { refresh(C); ph_weights(C, l); ph_norm(C, xin, C.in[I_NMIX] + l * DM, H); }
        SEAM(pb + 0);
        if (IN(pb + 1)) { refresh(C);
            pg8::Gemm g{H, (const bf16_t*)(wb + W_IN), DM, DM, DM}; pg8::OrderMN S; S.init(T / 256, NP / 256, C.G, C.bid, 256L * DM * 2, 256L * DM * 2);
            pg8::EpiInProj E{C.ws};
            pg8::gemm_phase(C.lds, g, S, E);
        }
        SEAM(pb + 1);
        if (IN(pb + 2)) { refresh(C);
            ph_ckv(C, WSP(float, WS_PROJ + P_DC), C.in[I_KVG] + l * 256, WSP(bf16_t, WS_CKV));
            { pg8::Gemm g{WSP(bf16_t, WS_PROJ + P_DQ), (const bf16_t*)(wb + W_UK), 1024, 256, 256}; pg8::OrderMN S; S.init(T / 256, 8, C.G, C.bid, 256L * 1024 * 2, 256L * 256 * 2, 1, 256L * 2);
              pg8::EpiStore<0> E{WSP(bf16_t, WS_QABS), 2048, 0.08838834764831845f}; pg8::gemm_phase(C.lds, g, S, E); }
            ph_gmlp_naive(C, l);
            ph_idx_naive(C);
        }
        SEAM(pb + 2);
        if (IN(pb + 3)) { refresh(C); ph_att_naive(C); }
        SEAM(pb + 3);
        if (IN(pb + 4)) { refresh(C);
            { pg8::Gemm g{WSP(bf16_t, WS_OLAT), (const bf16_t*)(wb + W_UV), 2048, 512, 512}; pg8::OrderMN S; S.init(T / 256, 4, C.G, C.bid, 256L * 2048 * 2, 256L * 512 * 2, 0, 512L * 2);
              pg8::EpiStore<0> E{WSP(bf16_t, WS_DS), 1024, 1.0f}; pg8::gemm_phase(C.lds, g, S, E); }
            ph_ret_naive(C);
        }
        SEAM(pb + 4);
        if (IN(pb + 5)) { refresh(C);
#pragma unroll 1
            for (int br = 0; br < 3; ++br) {
                const bf16_t* A = br == 0 ? WSP(bf16_t, WS_RET) : (br == 1 ? WSP(bf16_t, WS_GM) : WSP(bf16_t, WS_DS));
                const bf16_t* Bt = (const bf16_t*)(wb + (br == 0 ? W_RET : (br == 1 ? W_GM : W_DS)));
                const bf16_t* gate = WSP(bf16_t, WS_PROJ + (br == 0 ? P_GA : (br == 1 ? P_GB : P_GC)));
                pg8::Gemm g{A, Bt, 1024, 1024, 1024}; pg8::OrderMN S; S.init(T / 256, 8, C.G, C.bid, 256L * 1024 * 2, 256L * 1024 * 2);
                pg8::EpiBranch E{gate, H, br == 0 ? 1 : 0}; pg8::gemm_phase(C.lds, g, S, E);
            }
        }
        SEAM(pb + 5);
        if (IN(pb + 6)) { refresh(C);
            pg8::Gemm g{H, (const bf16_t*)(wb + W_OUT), DM, DM, DM}; pg8::OrderMN S; S.init(T / 256, 8, C.G, C.bid, 256L * DM * 2, 256L * DM * 2);
            pg8::EpiResid E{xin, C.out}; pg8::gemm_phase(C.lds, g, S, E);
        }
        SEAM(pb + 6);
        if (IN(pb + 7)) { refresh(C); ph_router(C, l, C.out); }
        SEAM(pb + 7);
        if (IN(pb + 8)) { refresh(C); ph_permute(C, l); }
        SEAM(pb + 8);
        if (IN(pb + 9)) { refresh(C);
            const int Mt = moe_table(C, l);
            pg8::Gemm g{WSP(bf16_t, WS_PROJ + M_HPERM), (const bf16_t*)(wb + W_13), DM, DM, DM};
            pg8::OrderMoE S{C.misc + 16, Mt, 4, C.G, C.bid, 256L * DM * 2, 256L * DM * 2, 1024L * DM * 2};
            pg8::EpiMoeUp E{WSP(bf16_t, WS_PROJ + M_HID)}; pg8::gemm_phase(C.lds, g, S, E);
        }
        SEAM(pb + 9);
        if (IN(pb + 10)) { refresh(C);
            const int Mt = moe_table(C, l);
            pg8::Gemm g{WSP(bf16_t, WS_PROJ + M_HID), (const bf16_t*)(wb + W_2), FF, FF, FF};
            pg8::OrderMoE S{C.misc + 16, Mt, 8, C.G, C.bid, 256L * FF * 2, 256L * FF * 2, (long)DM * FF * 2};
            pg8::EpiStore<0> E{WSP(bf16_t, WS_PROJ + M_YC), DM, 1.0f}; pg8::gemm_phase(C.lds, g, S, E);
        }
        SEAM(pb + 10);
        if (IN(pb + 11)) { refresh(C); ph_combine(C, C.out, l == DEPTH - 1); }
        if (l + 1 < DEPTH) SEAM(pb + 11);
    }
#undef IN
#undef SEAM
}

extern "C" void kernel_launch(void* const* d_in, const int* in_sizes, int n_in, void* d_out, int out_size, void* d_ws, size_t ws_size, hipStream_t stream) {
    static int grid = 0;
    if (grid == 0) {
        if (n_in != 23 || out_size != T * DM || ws_size < WS_END) { fprintf(stderr, "kernel_launch: unexpected shapes / workspace (n_in %d out %d ws %zu need %zu)\n", n_in, out_size, ws_size, (size_t)WS_END); grid = -1; return; }
        int dev = 0, cus = 0, per_cu = 0;
        if (hipGetDevice(&dev) != hipSuccess || hipDeviceGetAttribute(&cus, hipDeviceAttributeMultiprocessorCount, dev) != hipSuccess) { grid = -1; return; }
        if (hipFuncSetAttribute((const void*)mk_fwd, hipFuncAttributeMaxDynamicSharedMemorySize, LDS_BYTES) != hipSuccess) { fprintf(stderr, "kernel_launch: hipFuncSetAttribute failed\n"); grid = -1; return; }
        if (hipOccupancyMaxActiveBlocksPerMultiprocessor(&per_cu, (const void*)mk_fwd, 512, LDS_BYTES) != hipSuccess || per_cu < 1) { fprintf(stderr, "kernel_launch: occupancy query says %d\n", per_cu); (void)hipGetLastError(); grid = -1; return; }
        grid = cus;
    }
    if (grid < 0) return;
    (void)hipMemsetAsync((char*)d_ws + WS_CTL, 0, CTL_BYTES, stream);
    Args a{};
    for (int i = 0; i < 23; ++i) a.in[i] = (const float*)d_in[i];
    a.out = (float*)d_out; a.ws = (unsigned char*)d_ws;
#if MK_PER_PHASE
    for (int p = 0; p < NPHASES; ++p) { a.ph_lo = p; a.ph_hi = p + 1; hipLaunchKernelGGL(mk_fwd, dim3(grid), dim3(512), LDS_BYTES, stream, a); }
#else
    a.ph_lo = 0; a.ph_hi = NPHASES;
    hipLaunchKernelGGL(mk_fwd, dim3(grid), dim3(512), LDS_BYTES, stream, a);
#endif
}
```

```cpp
#include <hip/hip_runtime.h>
#include <stdint.h>
#include <stdio.h>

#ifndef MK_PER_PHASE
#define MK_PER_PHASE 0
#endif
#ifndef NAIVE_RET
#define NAIVE_RET 0
#endif
#ifndef NAIVE_GMLP
#define NAIVE_GMLP 0
#endif
#ifndef NAIVE_IDX
#define NAIVE_IDX 0
#endif
#ifndef NAIVE_ATT
#define NAIVE_ATT 0
#endif

#define LAS __attribute__((address_space(3)))
typedef unsigned short bf16_t;
typedef short bf16x8 __attribute__((ext_vector_type(8)));
typedef short s16x4 __attribute__((ext_vector_type(4)));
typedef float f32x4 __attribute__((ext_vector_type(4)));
typedef float f32x2 __attribute__((ext_vector_type(2)));
typedef float f32x16 __attribute__((ext_vector_type(16)));
typedef unsigned u32x4 __attribute__((ext_vector_type(4)));
typedef unsigned u32x2 __attribute__((ext_vector_type(2)));

constexpr int DM = 2048, NB = 4, SEQ = 4096, T = NB * SEQ, DEPTH = 2;
constexpr int INW = 14152, NP = 14336;
constexpr int GATE_SRC0 = 8008, GATE_DST0 = 8192;
constexpr int NEXP = 32, FF = 512, MOE_ROWS = 40960;
constexpr float EPS = 1e-6f;

constexpr size_t MiB = 1u << 20;
constexpr size_t WS_CTL = 0, CTL_BYTES = 1 * MiB;
constexpr size_t WS_ROPE = 1 * MiB;
constexpr size_t WS_W = 5 * MiB;
constexpr size_t W_IN = 0, W_RET = 56 * MiB, W_GM = 60 * MiB, W_DS = 64 * MiB, W_OUT = 68 * MiB, W_13 = 76 * MiB, W_2 = 204 * MiB, W_UK = 268 * MiB, W_UV = 269 * MiB, W_END = 270 * MiB;
constexpr size_t WS_H = WS_W + W_END;
constexpr size_t WS_PROJ = WS_H + 64 * MiB;
constexpr size_t P_RQ = 0, P_RK = 32 * MiB, P_RV = 64 * MiB, P_RG = 96 * MiB, P_GU = 128 * MiB, P_GV = 160 * MiB, P_DQ = 192 * MiB, P_DC = 224 * MiB  ,
                 P_IQ = 240 * MiB  , P_IK = 256 * MiB  , P_IW = 258 * MiB  , P_GA = 260 * MiB, P_GB = 324 * MiB, P_GC = 388 * MiB, P_END = 452 * MiB;
constexpr size_t M_HPERM = 0, M_HID = 160 * MiB, M_YC = 200 * MiB;
constexpr size_t WS_KV = WS_PROJ + P_END;
constexpr size_t WS_R = WS_KV + 64 * MiB;
constexpr size_t WS_QABS = WS_R + 64 * MiB;
constexpr size_t WS_OLAT = WS_QABS + 64 * MiB;
constexpr size_t WS_RET = WS_OLAT + 64 * MiB;
constexpr size_t WS_GM = WS_RET + 32 * MiB, WS_DS = WS_GM + 32 * MiB;
constexpr size_t WS_SEL = WS_DS + 32 * MiB;
constexpr size_t WS_CKV = WS_SEL + 8 * MiB;
constexpr size_t WS_STATS = WS_CKV + 8 * MiB;
constexpr size_t WS_ROUTE = WS_STATS + 2 * MiB;
constexpr size_t WS_END = WS_ROUTE + 1 * MiB;
constexpr int CW_BAR = 4096, CW_CNT = 16384;

constexpr int LDS_BYTES = 147456, MISC_OFF = LDS_BYTES - 1024;

__device__ __forceinline__ unsigned f2bf(float f) { unsigned u = __builtin_bit_cast(unsigned, f); return (u + 0x7fffu + ((u >> 16) & 1u)) >> 16; }
__device__ __forceinline__ float bf2f(unsigned b) { return __builtin_bit_cast(float, (b & 0xffffu) << 16); }
__device__ __forceinline__ unsigned cvt_pk_bf16(float lo, float hi) { unsigned r; asm volatile("v_cvt_pk_bf16_f32 %0, %1, %2" : "=v"(r) : "v"(lo), "v"(hi)); return r; }
__device__ __forceinline__ float shx(float v, int k, int lane) { return __builtin_bit_cast(float, __builtin_amdgcn_ds_bpermute((lane ^ k) << 2, __builtin_bit_cast(int, v))); }
__device__ __forceinline__ int shi(int v, int src) { return __builtin_amdgcn_ds_bpermute(src << 2, v); }
__device__ __forceinline__ float wave_sum(float v, int lane) {
#pragma unroll
    for (int o = 1; o < 64; o <<= 1) v += shx(v, o, lane);
    return v;
}
__device__ __forceinline__ float wave_max(float v, int lane) {
#pragma unroll
    for (int o = 1; o < 64; o <<= 1) v = fmaxf(v, shx(v, o, lane));
    return v;
}
__device__ __forceinline__ float sigmoidf_(float x) { return 1.0f / (1.0f + __expf(-x)); }
__device__ __forceinline__ float siluf_(float x) { return x / (1.0f + __expf(-x)); }
__device__ __forceinline__ f32x2 gelu_pk(f32x2 v) {
    const f32x2 av = __builtin_elementwise_abs(v), d = av * 0.2316418882f + 1.0f;
    f32x2 t; t.x = __builtin_amdgcn_rcpf(d.x); t.y = __builtin_amdgcn_rcpf(d.y);
    f32x2 q = t * 0.5307027145f + (-0.7265760135f); q = q * t + 0.7107068705f; q = q * t + (-0.142248368f); q = q * t + 0.127414796f; q = q * t;
    const f32x2 s = (v * v) * (-0.72134752044f);
    f32x2 e; e.x = __builtin_amdgcn_exp2f(s.x); e.y = __builtin_amdgcn_exp2f(s.y);
    const f32x2 m = v * (q * e), r = v - m;
    f32x2 o; o.x = v.x < 0.f ? m.x : r.x; o.y = v.y < 0.f ? m.y : r.y; return o;
}
template <int ACT> __device__ __forceinline__ f32x4 act4(f32x4 v) {
    if (ACT == 1) { f32x2 a = gelu_pk((f32x2){v[0], v[1]}), b = gelu_pk((f32x2){v[2], v[3]}); return (f32x4){a.x, a.y, b.x, b.y}; }
    if (ACT == 2) return (f32x4){siluf_(v[0]), siluf_(v[1]), siluf_(v[2]), siluf_(v[3])};
    if (ACT == 3) return (f32x4){sigmoidf_(v[0]), sigmoidf_(v[1]), sigmoidf_(v[2]), sigmoidf_(v[3])};
    return v;
}
__device__ __forceinline__ u32x4 pack8(f32x4 a, f32x4 b) { u32x4 w; w.x = cvt_pk_bf16(a[0], a[1]); w.y = cvt_pk_bf16(a[2], a[3]); w.z = cvt_pk_bf16(b[0], b[1]); w.w = cvt_pk_bf16(b[2], b[3]); return w; }
__device__ __forceinline__ void unpack8(u32x4 w, float (&f)[8]) {
    f[0] = bf2f(w.x); f[1] = bf2f(w.x >> 16); f[2] = bf2f(w.y); f[3] = bf2f(w.y >> 16); f[4] = bf2f(w.z); f[5] = bf2f(w.z >> 16); f[6] = bf2f(w.w); f[7] = bf2f(w.w >> 16);
}

#define XB_TMO      128
#define XB_XCNT(j)  (256  + 64 * (j))
#define XB_XSUB(j)  (1280 + 64 * (j))
#define XB_XGEN(j)  (2304 + 64 * (j))
#define XB_TOP      3328
#define XB_TOPGEN   3392
#define XCD_BAR_WORDS 3456
#define XB_SPIN_CAP (1u << 20)
__device__ __forceinline__ unsigned xb_ld(unsigned* p)              { return __hip_atomic_load(p, __ATOMIC_RELAXED, __HIP_MEMORY_SCOPE_AGENT); }
__device__ __forceinline__ unsigned xb_add(unsigned* p, unsigned v) { return __hip_atomic_fetch_add(p, v, __ATOMIC_RELAXED, __HIP_MEMORY_SCOPE_AGENT); }
__device__ __forceinline__ unsigned xb_xcc_id() { return (unsigned)__builtin_amdgcn_s_getreg((3 << 11) | 20) & 0xFu; }
#define XB_SPIN(cond, bar) do { unsigned _sp = 0; while (cond) { __builtin_amdgcn_s_sleep(1); \
    if ((++_sp & 255u) == 0u) { if (xb_ld(&(bar)[XB_TMO])) break; if (_sp > XB_SPIN_CAP) { atomicAdd(&(bar)[XB_TMO], 1u); break; } } } } while (0)
struct XcdBarrier { unsigned* bar; unsigned x; volatile LAS unsigned* st; };
__device__ __forceinline__ XcdBarrier xcd_barrier_post(unsigned* bar, volatile LAS unsigned* st) {
    XcdBarrier b; b.bar = bar; b.x = xb_xcc_id(); b.st = st;
    if (threadIdx.x == 0) (void)xb_add(&bar[XB_XCNT(b.x)], 1u);
    return b;
}
__device__ __forceinline__ void xcd_barrier_complete(unsigned* bar, unsigned x, unsigned& nloc, unsigned& nx) {
    const unsigned G = gridDim.x * gridDim.y * gridDim.z;
    unsigned sum, cnt, mine, sp = 0u;
    for (;;) {
        sum = 0u; cnt = 0u; mine = 0u;
#pragma unroll
        for (unsigned j = 0; j < 16; ++j) { const unsigned c = xb_ld(&bar[XB_XCNT(j)]); sum += c; cnt += (c > 0u) ? 1u : 0u; mine = (j == x) ? c : mine; }
        if (sum == G) break;
        __builtin_amdgcn_s_sleep(1);
        if ((++sp & 255u) == 0u) { if (xb_ld(&bar[XB_TMO])) break; if (sp > XB_SPIN_CAP) { atomicAdd(&bar[XB_TMO], 1u); break; } }
    }
    nloc = mine > 0u ? mine : 1u; nx = cnt > 0u ? cnt : 1u;
}
__device__ __forceinline__ void xcd_barrier(const XcdBarrier& b) {
    asm volatile("s_waitcnt vmcnt(0)" ::: "memory");
    __syncthreads();
    if (threadIdx.x == 0) {
        unsigned* bar = b.bar;
        __builtin_amdgcn_s_waitcnt(0);
        unsigned nloc = b.st[0], nx = b.st[1];
        if (nloc == 0u) { xcd_barrier_complete(bar, b.x, nloc, nx); b.st[0] = nloc; b.st[1] = nx; }
        const unsigned old = xb_add(&bar[XB_XSUB(b.x)], 1u);
        const unsigned gen = old / nloc;
        if (old + 1u == (gen + 1u) * nloc) {
            __builtin_amdgcn_fence(__ATOMIC_RELEASE, "agent");
            asm volatile("s_waitcnt vmcnt(0)" ::: "memory");
            const unsigned og = xb_add(&bar[XB_TOP], 1u);
            const unsigned tg = og / nx;
            if (og + 1u == (tg + 1u) * nx) xb_add(&bar[XB_TOPGEN], 1u);
            else XB_SPIN(xb_ld(&bar[XB_TOPGEN]) == tg, bar);
            __builtin_amdgcn_fence(__ATOMIC_ACQUIRE, "agent");
            xb_add(&bar[XB_XGEN(b.x)], 1u);
            asm volatile("s_waitcnt vmcnt(0)" ::: "memory");
        } else {
            XB_SPIN(xb_ld(&bar[XB_XGEN(b.x)]) == gen, bar);
            __builtin_amdgcn_fence(__ATOMIC_ACQUIRE, "agent");
            asm volatile("s_waitcnt vmcnt(0)" ::: "memory");
        }
    }
    __syncthreads();
}

namespace pg8 {
constexpr int BM = 256, BK = 64, HALF = 128, HTB = HALF * BK * 2, STAGE_BYTES = 8 * HTB, NXCD = 8, WGM = 8;
__host__ __device__ __forceinline__ int lds_byte(int r, int c) { const int st = (r >> 4) * 2 + (c >> 5), rr = r & 15, cc = c & 31, ob = rr * 64 + cc * 2; return st * 1024 + (ob ^ (((ob >> 9) & 1) << 5)); }
__host__ __device__ __forceinline__ void stage_rc(int b, int& R, int& C) { const int st = b / 1024, sb = b % 1024, swz = sb ^ (((sb >> 9) & 1) << 5); R = (st >> 1) * 16 + swz / 64; C = (st & 1) * 32 + (swz % 64) / 2; }
__host__ __device__ __forceinline__ int perm32(int rho) { const int n = rho >> 4, i = rho & 15; return 8 * (i >> 2) + 4 * n + (i & 3); }

struct Unit { int pm, pn; long aoff, boff; };
struct Gemm { const bf16_t* A; const bf16_t* Bt; int lda, ldb, K; };

struct OrderMN {
    int nM, nN, nwg, G, c, ashift; long astep, bstep, abytes;
    __device__ void init(int nM_, int nN_, int G_, int c_, long astep_, long bstep_, int ashift_ = 0, long abytes_ = 0) { nM = nM_; nN = nN_; nwg = nM * nN; G = G_; c = c_; astep = astep_; bstep = bstep_; ashift = ashift_; abytes = abytes_; }
    __device__ bool next(int i, Unit& u) const {
        const long L = (long)i * G + c; if (L >= nwg) return false;
        int wgid = (int)L; { const int q = nwg / NXCD, r = nwg % NXCD, xcd = wgid % NXCD, off = wgid / NXCD; wgid = (xcd < r ? xcd * (q + 1) : r * (q + 1) + (xcd - r) * q) + off; }
        const int nig = WGM * nN, gid = wgid / nig, fm = gid * WGM, gsz = (nM - fm) < WGM ? (nM - fm) : WGM;
        u.pm = fm + ((wgid % nig) % gsz); u.pn = (wgid % nig) / gsz;
        u.aoff = (long)u.pm * astep + (long)(u.pn >> ashift) * abytes; u.boff = (long)u.pn * bstep; return true;
    }
};
struct OrderMoE {
    const volatile LAS int* te; int Mt, nN, G, c; long astep, bstep, estep;
    __device__ bool next(int i, Unit& u) const {
        const long L = (long)i * G + c; if (L >= (long)Mt * nN) return false;
        u.pm = (int)(L / nN); u.pn = (int)(L % nN);
        u.aoff = (long)u.pm * astep; u.boff = (long)te[u.pm] * estep + (long)u.pn * bstep; return true;
    }
};

template <class Epi, class Sched>
__device__ __forceinline__ void gemm_phase(LAS unsigned char* lds, const Gemm g, const Sched& S, const Epi& E) {
    int tid_ = threadIdx.x; asm volatile("" : "+v"(tid_));
    const bf16_t* gA = g.A; const bf16_t* gB = g.Bt; asm volatile("" : "+s"(gA), "+s"(gB));
    const int tid = tid_, wid = __builtin_amdgcn_readfirstlane(tid >> 6), lane = tid & 63, wr = wid >> 2, wc = wid & 3, fr = lane & 15, fq = lane >> 4;
    const int K = g.K, nt = K / BK;
    unsigned voffA[2], voffB[2];
#pragma unroll
    for (int i = 0; i < 2; ++i) { int R, C; stage_rc(tid * 16 + i * 8192, R, C); const int Rb = Epi::PERM ? ((R & ~31) + perm32(R & 31)) : R;
        voffA[i] = (unsigned)(R * g.lda + C) * 2u; voffB[i] = (unsigned)(Rb * g.ldb + C) * 2u; }
    const size_t kstep = (size_t)(BK * 2);
    const size_t hstepA = (size_t)HALF * g.lda * 2, hstepB = (size_t)HALF * g.ldb * 2;
    const unsigned ldsw = (unsigned)wid * 1024u;
    const int aoff = lds_byte(wr * 64 + fr, fq * 8), boff = lds_byte(wc * 32 + fr, fq * 8);
#define PG8_SA(b, h) (((b) * 2 + (h)) * HTB)
#define PG8_SB(b, h) ((4 + (b) * 2 + (h)) * HTB)
#define PG8_STAGE(bufoff, gbase, voff) do { _Pragma("unroll") for (int _i = 0; _i < 2; ++_i) \
        __builtin_amdgcn_global_load_lds((const unsigned*)((const char*)(gbase) + (voff)[_i]), (LAS unsigned*)(lds + (bufoff) + ldsw + _i * 8192), 16, 0, 0); } while (0)
#define PG8_LDA(dst, b, h) do { _Pragma("unroll") for (int m = 0; m < 4; ++m) _Pragma("unroll") for (int k = 0; k < 2; ++k) dst[m][k] = *(const LAS bf16x8*)(lds + PG8_SA(b, h) + aoff + m * 2048 + k * 1024); } while (0)
#define PG8_LDB(dst, b, h) do { _Pragma("unroll") for (int n = 0; n < 2; ++n) _Pragma("unroll") for (int k = 0; k < 2; ++k) dst[n][k] = *(const LAS bf16x8*)(lds + PG8_SB(b, h) + boff + n * 2048 + k * 1024); } while (0)
#define PG8_MMA(ai, bj, At, Bt) do { __builtin_amdgcn_s_setprio(1); _Pragma("unroll") for (int m = 0; m < 4; ++m) _Pragma("unroll") for (int n = 0; n < 2; ++n) _Pragma("unroll") for (int k = 0; k < 2; ++k) \
        acc[ai][bj][m][n] = __builtin_amdgcn_mfma_f32_16x16x32_bf16(Bt[n][k], At[m][k], acc[ai][bj][m][n], 0, 0, 0); __builtin_amdgcn_s_setprio(0); } while (0)
#define PG8_WAIT_V(n) asm volatile("s_waitcnt vmcnt(" #n ")" ::: "memory")
#define PG8_WAIT_L(n) asm volatile("s_waitcnt lgkmcnt(" #n ")" ::: "memory")
#define PG8_BAR __builtin_amdgcn_s_barrier()
#define PG8_SCHED __builtin_amdgcn_sched_barrier(0)
    Unit cur, nxt; int ui = 0;
    if (!S.next(0, cur)) return;
    f32x4 acc[2][2][4][2];
#pragma unroll
    for (int a = 0; a < 2; ++a)
#pragma unroll
        for (int b = 0; b < 2; ++b)
#pragma unroll
            for (int m = 0; m < 4; ++m)
#pragma unroll
                for (int n = 0; n < 2; ++n) acc[a][b][m][n] = (f32x4){0.f, 0.f, 0.f, 0.f};
    bf16x8 At[4][2], B0[2][2], B1[2][2];
    const char* cA = (const char*)gA + cur.aoff; const char* cB = (const char*)gB + cur.boff;
    PG8_STAGE(PG8_SB(0, 0), cB, voffB); PG8_STAGE(PG8_SA(0, 0), cA, voffA); PG8_STAGE(PG8_SB(0, 1), cB + hstepB, voffB); PG8_STAGE(PG8_SA(0, 1), cA + hstepA, voffA);
    if (wr == 1) PG8_BAR;
    PG8_WAIT_V(4); PG8_BAR;
    PG8_STAGE(PG8_SB(1, 0), cB + kstep, voffB); PG8_STAGE(PG8_SA(1, 0), cA + kstep, voffA); PG8_STAGE(PG8_SB(1, 1), cB + hstepB + kstep, voffB);
    PG8_WAIT_V(6); PG8_BAR;
    for (;;) {
        const bool has_next = S.next(ui + 1, nxt);
        const char* nA = has_next ? (const char*)gA + nxt.aoff : cA; const char* nB = has_next ? (const char*)gB + nxt.boff : cB;
        for (int t = 0; t < nt; t += 2) {
            const bool last = (t == nt - 2);
            const char* a1 = cA + (size_t)(t + 1) * kstep;
            const char* a2 = last ? nA : cA + (size_t)(t + 2) * kstep; const char* b2 = last ? nB : cB + (size_t)(t + 2) * kstep;
            const char* a3 = a2 + kstep; const char* b3 = b2 + kstep;
            PG8_LDB(B0, 0, 0); PG8_SCHED; PG8_LDA(At, 0, 0); PG8_STAGE(PG8_SA(1, 1), a1 + hstepA, voffA);
            PG8_WAIT_L(8); PG8_BAR; PG8_WAIT_L(0); PG8_MMA(0, 0, At, B0); PG8_BAR; PG8_SCHED;
            PG8_LDB(B1, 0, 1); PG8_STAGE(PG8_SB(0, 0), b2, voffB);
            PG8_BAR; PG8_WAIT_L(0); PG8_MMA(0, 1, At, B1); PG8_BAR;
            PG8_LDA(At, 0, 1); PG8_STAGE(PG8_SA(0, 0), a2, voffA);
            PG8_BAR; PG8_WAIT_L(0); PG8_MMA(1, 0, At, B0); PG8_BAR; PG8_SCHED;
            PG8_STAGE(PG8_SB(0, 1), b2 + hstepB, voffB);
            PG8_WAIT_V(6); PG8_BAR; PG8_MMA(1, 1, At, B1); PG8_BAR;
            PG8_LDB(B0, 1, 0); PG8_SCHED; PG8_LDA(At, 1, 0); PG8_STAGE(PG8_SA(0, 1), a2 + hstepA, voffA);
            PG8_WAIT_L(8); PG8_BAR; PG8_WAIT_L(0); PG8_MMA(0, 0, At, B0); PG8_BAR; PG8_SCHED;
            PG8_LDB(B1, 1, 1); PG8_STAGE(PG8_SB(1, 0), b3, voffB);
            PG8_BAR; PG8_WAIT_L(0); PG8_MMA(0, 1, At, B1); PG8_BAR;
            PG8_LDA(At, 1, 1); PG8_STAGE(PG8_SA(1, 0), a3, voffA);
            PG8_BAR; PG8_WAIT_L(0); PG8_MMA(1, 0, At, B0); PG8_BAR; PG8_SCHED;
            PG8_STAGE(PG8_SB(1, 1), b3 + hstepB, voffB);
            PG8_WAIT_V(6); PG8_BAR; PG8_MMA(1, 1, At, B1); PG8_BAR;
        }
        E(acc, cur, wr, wc, fr, fq);
        if (!has_next) break;
#pragma unroll
        for (int a = 0; a < 2; ++a)
#pragma unroll
            for (int b = 0; b < 2; ++b)
#pragma unroll
                for (int m = 0; m < 4; ++m)
#pragma unroll
                    for (int n = 0; n < 2; ++n) acc[a][b][m][n] = (f32x4){0.f, 0.f, 0.f, 0.f};
        cur = nxt; cA = nA; cB = nB; ++ui;
    }
    PG8_WAIT_V(0);
    if (wr == 0) PG8_BAR;
    PG8_BAR;
#undef PG8_SA
#undef PG8_SB
#undef PG8_STAGE
#undef PG8_LDA
#undef PG8_LDB
#undef PG8_MMA
#undef PG8_WAIT_V
#undef PG8_WAIT_L
#undef PG8_BAR
#undef PG8_SCHED
}

typedef const f32x4 (&AccT)[2][2][4][2];
template <int ACT> __device__ __forceinline__ void store_tile_bf16(AccT acc, bf16_t* O, int ld, int row0, int colb, float scale) {
#pragma unroll
    for (int ai = 0; ai < 2; ++ai)
#pragma unroll
        for (int m = 0; m < 4; ++m) { bf16_t* rowp = O + (size_t)(row0 + ai * HALF + m * 16) * ld + colb;
#pragma unroll
            for (int bj = 0; bj < 2; ++bj) { const f32x4 v0 = act4<ACT>(acc[ai][bj][m][0] * scale), v1 = act4<ACT>(acc[ai][bj][m][1] * scale);
                *(u32x4*)(rowp + bj * HALF) = pack8(v0, v1); }
            asm volatile("" ::: "memory"); }
}
template <int ACT> struct EpiStore {
    static constexpr bool PERM = true;
    bf16_t* O; int ld; float scale;
    __device__ __forceinline__ void operator()(AccT acc, const Unit& u, int wr, int wc, int fr, int fq) const {
        store_tile_bf16<ACT>(acc, O, ld, u.pm * BM + wr * 64 + fr, u.pn * BM + wc * 32 + 8 * fq, scale);
    }
};
struct EpiInProj {
    static constexpr bool PERM = true;
    unsigned char* ws;
    __device__ __forceinline__ void operator()(AccT acc, const Unit& u, int wr, int wc, int fr, int fq) const {
        const int pn = u.pn, row0 = u.pm * BM + wr * 64 + fr, cw = wc * 32 + 8 * fq;
        unsigned char* pj = ws + WS_PROJ;
        bf16_t *rq = (bf16_t*)(pj + P_RQ), *rk = (bf16_t*)(pj + P_RK), *rv = (bf16_t*)(pj + P_RV), *rg = (bf16_t*)(pj + P_RG), *gu = (bf16_t*)(pj + P_GU), *gv = (bf16_t*)(pj + P_GV), *dq = (bf16_t*)(pj + P_DQ),
               *iq = (bf16_t*)(pj + P_IQ), *ik = (bf16_t*)(pj + P_IK), *ga = (bf16_t*)(pj + P_GA), *gb = (bf16_t*)(pj + P_GB), *gc = (bf16_t*)(pj + P_GC);
        float *dcraw = (float*)(pj + P_DC), *iw = (float*)(pj + P_IW), *gvstats = (float*)(ws + WS_STATS); const float* rope = (const float*)(ws + WS_ROPE);
        if (pn < 8) {
            const bool isk = pn >= 4; bf16_t* dst = (isk ? rk : rq) + (pn & 3) * 256 + cw; const float sc = isk ? 0.0625f : 1.0f;
#pragma unroll
            for (int ai = 0; ai < 2; ++ai)
#pragma unroll
                for (int m = 0; m < 4; ++m) { const int row = row0 + ai * HALF + m * 16, pos = row & (SEQ - 1);
                    const f32x4* cs = (const f32x4*)(rope + ((size_t)pos * 128 + cw) * 2);
                    f32x4 o1[2], o2[2];
#pragma unroll
                    for (int n = 0; n < 2; ++n) { const f32x4 c01 = cs[2 * n], c23 = cs[2 * n + 1]; const f32x4 x1 = acc[ai][0][m][n], x2 = acc[ai][1][m][n];
                        const float co[4] = {c01[0], c01[2], c23[0], c23[2]}, si[4] = {c01[1], c01[3], c23[1], c23[3]};
#pragma unroll
                        for (int j = 0; j < 4; ++j) { o1[n][j] = (x1[j] * co[j] - x2[j] * si[j]) * sc; o2[n][j] = (x1[j] * si[j] + x2[j] * co[j]) * sc; } }
                    bf16_t* rp = dst + (size_t)row * 1024;
                    *(u32x4*)rp = pack8(o1[0], o1[1]); *(u32x4*)(rp + 128) = pack8(o2[0], o2[1]); asm volatile("" ::: "memory"); }
        } else if (pn < 12) { store_tile_bf16<0>(acc, rv, 1024, row0, (pn - 8) * 256 + cw, 1.f);
        } else if (pn < 16) { store_tile_bf16<2>(acc, rg, 1024, row0, (pn - 12) * 256 + cw, 1.f);
        } else if (pn < 20) { store_tile_bf16<1>(acc, gu, 1024, row0, (pn - 16) * 256 + cw, 1.f);
        } else if (pn < 24) {
            const int t4 = pn - 20; bf16_t* dst = gv + t4 * 256 + cw;
#pragma unroll
            for (int ai = 0; ai < 2; ++ai)
#pragma unroll
                for (int m = 0; m < 4; ++m) { const int row = row0 + ai * HALF + m * 16; float s = 0.f, q = 0.f;
#pragma unroll
                    for (int bj = 0; bj < 2; ++bj) { const f32x4 v0 = act4<1>(acc[ai][bj][m][0]), v1 = act4<1>(acc[ai][bj][m][1]);
                        *(u32x4*)(dst + (size_t)row * 1024 + bj * HALF) = pack8(v0, v1);
#pragma unroll
                        for (int j = 0; j < 4; ++j) { s += v0[j] + v1[j]; q += v0[j] * v0[j] + v1[j] * v1[j]; } }
                    { const int ln = fq * 16 + fr; s += shx(s, 16, ln); s += shx(s, 32, ln); q += shx(q, 16, ln); q += shx(q, 32, ln); }
                    if (fq == 0) *(f32x2*)(gvstats + ((size_t)row * 16 + t4 * 4 + wc) * 2) = (f32x2){s, q}; asm volatile("" ::: "memory"); }
        } else if (pn < 28) { store_tile_bf16<0>(acc, dq, 1024, row0, (pn - 24) * 256 + cw, 1.f);
        } else if (pn == 28) {
#pragma unroll
            for (int ai = 0; ai < 2; ++ai)
#pragma unroll
                for (int m = 0; m < 4; ++m) { float* rp = dcraw + (size_t)(row0 + ai * HALF + m * 16) * 256 + cw;
#pragma unroll
                    for (int bj = 0; bj < 2; ++bj) { *(f32x4*)(rp + bj * HALF) = acc[ai][bj][m][0]; *(f32x4*)(rp + bj * HALF + 4) = acc[ai][bj][m][1]; } }
        } else if (pn < 31) { store_tile_bf16<0>(acc, iq, 512, row0, (pn - 29) * 256 + cw, 1.f);
        } else if (pn == 31) {
#pragma unroll
            for (int ai = 0; ai < 2; ++ai)
#pragma unroll
                for (int m = 0; m < 4; ++m) { const int row = row0 + ai * HALF + m * 16;
                    if (wc < 2) *(u32x4*)(ik + (size_t)row * 64 + cw) = pack8(acc[ai][0][m][0], acc[ai][0][m][1]);
                    if (wc == 2 && fq == 0) { *(f32x4*)(iw + (size_t)row * 8) = acc[ai][0][m][0] * 0.35355339059f; *(f32x4*)(iw + (size_t)row * 8 + 4) = acc[ai][0][m][1] * 0.35355339059f; } }
        } else { const int gi = (pn - 32) >> 3; bf16_t* dst = gi == 0 ? ga : (gi == 1 ? gb : gc);
            store_tile_bf16<3>(acc, dst, 2048, row0, ((pn - 32) & 7) * 256 + cw, 1.f); }
    }
};
struct EpiBranch {
    static constexpr bool PERM = true;
    const bf16_t* gate; bf16_t* merged; int first;
    __device__ __forceinline__ void operator()(AccT acc, const Unit& u, int wr, int wc, int fr, int fq) const {
        const int row0 = u.pm * BM + wr * 64 + fr, colb = u.pn * BM + wc * 32 + 8 * fq;
#pragma unroll
        for (int ai = 0; ai < 2; ++ai)
#pragma unroll
            for (int m = 0; m < 4; ++m) { const size_t ro = (size_t)(row0 + ai * HALF + m * 16) * 2048 + colb;
#pragma unroll
                for (int bj = 0; bj < 2; ++bj) { float g8[8], m8[8]; unpack8(*(const u32x4*)(gate + ro + bj * HALF), g8);
                    if (!first) unpack8(*(const u32x4*)(merged + ro + bj * HALF), m8); else {
#pragma unroll
                        for (int j = 0; j < 8; ++j) m8[j] = 0.f; }
                    const f32x4 a0 = acc[ai][bj][m][0], a1 = acc[ai][bj][m][1];
                    f32x4 r0, r1;
#pragma unroll
                    for (int j = 0; j < 4; ++j) { r0[j] = m8[j] + g8[j] * a0[j]; r1[j] = m8[4 + j] + g8[4 + j] * a1[j]; }
                    *(u32x4*)(merged + ro + bj * HALF) = pack8(r0, r1); } }
    }
};
struct EpiResid {
    static constexpr bool PERM = false;
    const float* xsrc; float* xdst;
    __device__ __forceinline__ void operator()(AccT acc, const Unit& u, int wr, int wc, int fr, int fq) const {
        const int row0 = u.pm * BM + wr * 64 + fr, col0 = u.pn * BM + wc * 32 + 4 * fq;
#pragma unroll
        for (int ai = 0; ai < 2; ++ai)
#pragma unroll
            for (int m = 0; m < 4; ++m) { const size_t ro = (size_t)(row0 + ai * HALF + m * 16) * DM + col0;
#pragma unroll
                for (int bj = 0; bj < 2; ++bj)
#pragma unroll
                    for (int n = 0; n < 2; ++n) { const size_t o = ro + bj * HALF + n * 16; *(f32x4*)(xdst + o) = *(const f32x4*)(xsrc + o) + acc[ai][bj][m][n]; } }
    }
};
struct EpiMoeUp {
    static constexpr bool PERM = true;
    bf16_t* hid;
    __device__ __forceinline__ void operator()(AccT acc, const Unit& u, int wr, int wc, int fr, int fq) const {
        const int row0 = u.pm * BM + wr * 64 + fr, colb = u.pn * 128 + wc * 32 + 8 * fq;
#pragma unroll
        for (int ai = 0; ai < 2; ++ai)
#pragma unroll
            for (int m = 0; m < 4; ++m) { f32x4 r0, r1; const f32x4 a0 = acc[ai][0][m][0], a1 = acc[ai][0][m][1], b0 = acc[ai][1][m][0], b1 = acc[ai][1][m][1];
#pragma unroll
                for (int j = 0; j < 4; ++j) { r0[j] = siluf_(a0[j]) * b0[j]; r1[j] = siluf_(a1[j]) * b1[j]; }
                *(u32x4*)(hid + (size_t)(row0 + ai * HALF + m * 16) * FF + colb) = pack8(r0, r1); }
    }
};
}

struct Args { const float* in[23]; float* out; unsigned char* ws; int ph_lo, ph_hi; };
enum { I_X = 0, I_NMIX, I_WIN, I_WRET, I_LNG, I_LNB, I_WS, I_BS, I_WGM, I_KVG, I_WUK, I_WUV, I_WDS, I_WOUT, I_NFFN, I_WGRP, I_BGRP, I_WEXP, I_BEXP, I_W1, I_W3, I_W2, I_FNG };
struct Ctx {
    LAS unsigned char* lds; volatile LAS int* misc; unsigned* ctl; unsigned char* ws;
    int tid, lane, wave, G, bid, gw, NGW;
    const float* const* in; float* out;
};
#define WSP(T_, off) ((T_*)(C.ws + (off)))
__device__ __forceinline__ void refresh(Ctx& C) { int t = threadIdx.x; asm volatile("" : "+v"(t)); C.tid = t; C.lane = t & 63;
    unsigned char* w = C.ws; asm volatile("" : "+s"(w)); C.ws = w; C.ctl = (unsigned*)w; }

__device__ __forceinline__ void ph_rope(const Ctx& C) {
    float* rope = WSP(float, WS_ROPE);
    const double r1 = 0.9305720409296989;
    for (int idx = C.bid * 512 + C.tid; idx < SEQ * 128; idx += C.G * 512) {
        const int pos = idx >> 7, i = idx & 127;
        double inv = 1.0, b = r1; int e = i;
        while (e) { if (e & 1) inv *= b; b *= b; e >>= 1; }
        const double ang = (double)pos * inv;
        const double n = __builtin_rint(ang * 0.15915494309189533577);
        const double x = ang - n * 6.283185307179586476925;
        const double x2 = x * x;
        double s = 0.0, c = 0.0;
#pragma unroll 1
        for (int k = 14; k >= 1; --k) { s = (s + 1.0) * (-x2 / (double)((2 * k) * (2 * k + 1))); c = (c + 1.0) * (-x2 / (double)((2 * k - 1) * (2 * k))); }
        s = (s + 1.0) * x; c = c + 1.0;
        *(f32x2*)(rope + (size_t)idx * 2) = (f32x2){(float)c, (float)s};
    }
}

template <class Map>
__device__ __forceinline__ void tr_item(const float* W, long srcld, bf16_t* WT, long dstld, int k0, int n0, LAS float* scr, int lane, const Map& map) {
    const int nn = n0 + (lane & 31); const long sc = map(nn);
#pragma unroll 8
    for (int i = 0; i < 32; ++i) { const int kk = 2 * i + (lane >> 5); scr[kk * 33 + (lane & 31)] = sc >= 0 ? W[(size_t)(k0 + kk) * srcld + sc] : 0.f; }
    asm volatile("s_waitcnt lgkmcnt(0)" ::: "memory");
    const int c = lane & 7;
#pragma unroll
    for (int j = 0; j < 4; ++j) { const int n = (lane >> 3) + 8 * j; const LAS float* s = scr + (8 * c) * 33 + n;
        u32x4 o; o.x = cvt_pk_bf16(s[0 * 33], s[1 * 33]); o.y = cvt_pk_bf16(s[2 * 33], s[3 * 33]); o.z = cvt_pk_bf16(s[4 * 33], s[5 * 33]); o.w = cvt_pk_bf16(s[6 * 33], s[7 * 33]);
        *(u32x4*)(WT + (size_t)(n0 + n) * dstld + k0 + 8 * c) = o; }
    asm volatile("s_waitcnt lgkmcnt(0)" ::: "memory");
}
struct MapId { __device__ long operator()(int n) const { return n; } };
struct MapIn { __device__ long operator()(int n) const { return n < GATE_SRC0 ? n : (n < GATE_DST0 ? -1 : n - (GATE_DST0 - GATE_SRC0)); } };
struct MapOff { long off; __device__ long operator()(int n) const { return n + off; } };

__device__ __forceinline__ void ph_weights(const Ctx& C, int l) {
    LAS float* scr = (LAS float*)(C.lds + C.wave * 16384);
    unsigned char* wb = C.ws + WS_W;
    constexpr int N_IN = 32 * 448, N_BR = 16 * 64, N_OUT = 32 * 64, N_13 = 32 * 32 * 32, N_2 = 32 * 8 * 64, N_UV = 8 * 16;
    constexpr int NITEMS = N_IN + 3 * N_BR + N_OUT + N_13 + N_2 + N_UV;
    for (int it = C.gw; it < NITEMS; it += C.NGW) {
        int r = it;
        if (r < N_IN) { const int kb = r / 448, nb = r % 448; tr_item(C.in[I_WIN] + (size_t)l * DM * INW, INW, (bf16_t*)(wb + W_IN), DM, kb * 64, nb * 32, scr, C.lane, MapIn{}); continue; } r -= N_IN;
        if (r < 3 * N_BR) { const int w = r / N_BR, q = r % N_BR, kb = q / 64, nb = q % 64; const float* src = C.in[w == 0 ? I_WRET : (w == 1 ? I_WGM : I_WDS)] + (size_t)l * 1024 * DM;
            tr_item(src, DM, (bf16_t*)(wb + (w == 0 ? W_RET : (w == 1 ? W_GM : W_DS))), 1024, kb * 64, nb * 32, scr, C.lane, MapId{}); continue; } r -= 3 * N_BR;
        if (r < N_OUT) { const int kb = r / 64, nb = r % 64; tr_item(C.in[I_WOUT] + (size_t)l * DM * DM, DM, (bf16_t*)(wb + W_OUT), DM, kb * 64, nb * 32, scr, C.lane, MapId{}); continue; } r -= N_OUT;
        if (r < N_13) { const int e = r / 1024, q = r % 1024, kb = q / 32, nb = q % 32;
            const int row0 = nb * 32, j = row0 >> 8, s = (row0 >> 7) & 1, fp = row0 & 127;
            const float* src = C.in[s ? I_W3 : I_W1] + ((size_t)l * NEXP + e) * DM * FF;
            tr_item(src, FF, (bf16_t*)(wb + W_13) + (size_t)e * 1024 * DM, DM, kb * 64, row0, scr, C.lane, MapOff{(long)(128 * j + fp) - row0}); continue; } r -= N_13;
        if (r < N_2) { const int e = r / 512, q = r % 512, kb = q / 64, nb = q % 64;
            tr_item(C.in[I_W2] + ((size_t)l * NEXP + e) * FF * DM, DM, (bf16_t*)(wb + W_2) + (size_t)e * DM * FF, FF, kb * 64, nb * 32, scr, C.lane, MapId{}); continue; } r -= N_2;
        { const int h = r / 16, q = r % 16, kb = q / 4, nb = q % 4;
            tr_item(C.in[I_WUV] + ((size_t)l * 8 + h) * 256 * 128, 128, (bf16_t*)(wb + W_UV) + (size_t)(h * 128) * 512 + (h & 1) * 256, 512, kb * 64, nb * 32, scr, C.lane, MapId{}); }
    }
    bf16_t* uv = (bf16_t*)(wb + W_UV); bf16_t* uk = (bf16_t*)(wb + W_UK); const float* wuk = C.in[I_WUK] + (size_t)l * 8 * 256 * 128;
    for (int idx = C.bid * 512 + C.tid; idx < 1024 * 256 / 8; idx += C.G * 512) { const int row = idx >> 5, c8 = (idx & 31) * 8, h = row >> 7;
        *(u32x4*)(uv + (size_t)row * 512 + (1 - (h & 1)) * 256 + c8) = (u32x4){0u, 0u, 0u, 0u}; }
    for (int idx = C.bid * 512 + C.tid; idx < 2048 * 256 / 8; idx += C.G * 512) { const int row = idx >> 5, c8 = (idx & 31) * 8, h = row >> 8, half = c8 >> 7;
        u32x4 o = (u32x4){0u, 0u, 0u, 0u};
        if (half == (h & 1)) { const float* s = wuk + (size_t)row * 128 + (c8 & 127); const f32x4 a = *(const f32x4*)s, b = *(const f32x4*)(s + 4); o = pack8(a, b); }
        *(u32x4*)(uk + (size_t)row * 256 + c8) = o; }
}

__device__ __forceinline__ void ph_norm(const Ctx& C, const float* x, const float* g, bf16_t* H) {
    for (int row = C.gw; row < T; row += C.NGW) {
        const f32x4* xr = (const f32x4*)(x + (size_t)row * DM) + C.lane; f32x4 v[8]; float ss = 0.f;
#pragma unroll
        for (int j = 0; j < 8; ++j) { v[j] = xr[64 * j]; ss += v[j][0] * v[j][0] + v[j][1] * v[j][1] + v[j][2] * v[j][2] + v[j][3] * v[j][3]; }
        const float rstd = rsqrtf(wave_sum(ss, C.lane) * (1.f / DM) + EPS);
        u32x2* o = (u32x2*)(H + (size_t)row * DM) + C.lane;
#pragma unroll
        for (int j = 0; j < 8; ++j) { const f32x4 gg = ((const f32x4*)g)[64 * j + C.lane]; const f32x4 y = v[j] * rstd * gg; u32x2 w; w.x = cvt_pk_bf16(y[0], y[1]); w.y = cvt_pk_bf16(y[2], y[3]); o[64 * j] = w; }
    }
}
__device__ __forceinline__ void ph_ckv(const Ctx& C, const float* dcraw, const float* g, bf16_t* ckv) {
    for (int row = C.gw; row < T; row += C.NGW) {
        const f32x4 v = ((const f32x4*)(dcraw + (size_t)row * 256))[C.lane];
        const float ss = wave_sum(v[0] * v[0] + v[1] * v[1] + v[2] * v[2] + v[3] * v[3], C.lane);
        const float rstd = rsqrtf(ss * (1.f / 256.f) + EPS); const f32x4 y = v * rstd * ((const f32x4*)g)[C.lane];
        u32x2 w; w.x = cvt_pk_bf16(y[0], y[1]); w.y = cvt_pk_bf16(y[2], y[3]); ((u32x2*)(ckv + (size_t)row * 256))[C.lane] = w;
    }
}

__device__ __forceinline__ void ph_gmlp_naive(const Ctx& C, int l) {
    const bf16_t* gu = WSP(bf16_t, WS_PROJ + P_GU); const bf16_t* gv = WSP(bf16_t, WS_PROJ + P_GV); const float* stats = WSP(float, WS_STATS); bf16_t* gm = WSP(bf16_t, WS_GM);
    const float* lng = C.in[I_LNG] + l * 1024; const float* lnb = C.in[I_LNB] + l * 1024; const float* Wsp = C.in[I_WS] + (size_t)l * 4 * 128 * 128; const float* bs = C.in[I_BS] + l * 4 * 128;
    LAS float* smean = (LAS float*)C.lds; LAS float* srstd = smean + 128; LAS float* lv = srstd + 128;
    for (int u = C.bid; u < 512; u += C.G) {
        const int g = u & 3, bn = u >> 2, t0 = bn * 128;
        __syncthreads();
        if (C.tid < 128) { const float* sp = stats + (size_t)(t0 + C.tid) * 32; float s = 0.f, q = 0.f;
            for (int k = 0; k < 16; ++k) { s += sp[2 * k]; q += sp[2 * k + 1]; }
            const float mean = s * (1.f / 1024.f), var = q * (1.f / 1024.f) - mean * mean; smean[C.tid] = mean; srstd[C.tid] = rsqrtf(var + EPS); }
        __syncthreads();
        for (int idx = C.tid; idx < 128 * 256; idx += 512) { const int j = idx >> 8, c = idx & 255, ch = g * 256 + c;
            lv[idx] = (bf2f(gv[(size_t)(t0 + j) * 1024 + ch]) - smean[j]) * srstd[j] * lng[ch] + lnb[ch]; }
        __syncthreads();
        for (int idx = C.tid; idx < 128 * 256; idx += 512) { const int i = idx >> 8, c = idx & 255; const float* wr = Wsp + ((size_t)g * 128 + i) * 128; float a = 0.f;
            for (int j = 0; j <= i; ++j) a += wr[j] * lv[j * 256 + c];
            a += bs[g * 128 + i];
            const size_t o = (size_t)(t0 + i) * 1024 + g * 256 + c; gm[o] = (bf16_t)f2bf(bf2f(gu[o]) * a); }
    }
}
__device__ __forceinline__ void ph_ret_naive(const Ctx& C) {
    const bf16_t* rq = WSP(bf16_t, WS_PROJ + P_RQ); const bf16_t* rk = WSP(bf16_t, WS_PROJ + P_RK); const bf16_t* rv = WSP(bf16_t, WS_PROJ + P_RV); const bf16_t* rg = WSP(bf16_t, WS_PROJ + P_RG); bf16_t* ret = WSP(bf16_t, WS_RET);
    LAS float* sq = (LAS float*)C.lds; LAS float* sa = sq + 256; LAS float* red = sa + 4096;
    for (int u = C.bid; u < NB * 4 * SEQ; u += C.G) {
        const int t = (SEQ - 1) - (u / 16), bh = u % 16, b = bh >> 2, h = bh & 3; const size_t rowb = (size_t)b * SEQ;
        const float lg2 = log2f(1.0f - exp2f(-5.0f - (float)h));
        __syncthreads();
        if (C.tid < 256) sq[C.tid] = bf2f(rq[(rowb + t) * 1024 + h * 256 + C.tid]);
        __syncthreads();
        for (int s = C.tid; s <= t; s += 512) { const u32x4* kp = (const u32x4*)(rk + (rowb + s) * 1024 + h * 256); float a = 0.f;
            for (int d8 = 0; d8 < 32; ++d8) { float f[8]; unpack8(kp[d8], f);
#pragma unroll
                for (int j = 0; j < 8; ++j) a += sq[d8 * 8 + j] * f[j]; }
            sa[s] = a * exp2f(lg2 * (float)(t - s)); }
        __syncthreads();
        float o = 0.f;
        if (C.tid < 256) { const bf16_t* vp = rv + rowb * 1024 + h * 256 + C.tid; for (int s = 0; s <= t; ++s) o += sa[s] * bf2f(vp[(size_t)s * 1024]); }
        const float ss = wave_sum(o * o, C.lane); if (C.lane == 0) red[C.wave] = ss;
        __syncthreads();
        if (C.tid < 256) { const float tot = red[0] + red[1] + red[2] + red[3]; const float y = o * rsqrtf(tot * (1.f / 256.f) + EPS);
            const size_t oi = (rowb + t) * 1024 + h * 256 + C.tid; ret[oi] = (bf16_t)f2bf(bf2f(rg[oi]) * y); }
    }
}
__device__ __forceinline__ void ph_idx_naive(const Ctx& C) {
    const bf16_t* iq = WSP(bf16_t, WS_PROJ + P_IQ); const bf16_t* ik = WSP(bf16_t, WS_PROJ + P_IK); const float* iw = WSP(float, WS_PROJ + P_IW); unsigned short* sel = WSP(unsigned short, WS_SEL);
    LAS float* sq = (LAS float*)C.lds; LAS float* sw = sq + 512; LAS float* sc = sw + 8;
    for (int u = C.bid; u < T; u += C.G) {
        const int tq = (T - 1) - u; const int b = tq >> 12, q = tq & (SEQ - 1), n = q + 1;
        __syncthreads();
        sq[C.tid] = bf2f(iq[(size_t)tq * 512 + C.tid]); if (C.tid < 8) sw[C.tid] = iw[(size_t)tq * 8 + C.tid];
        for (int r = C.tid; r < 256; r += 512) sel[(size_t)tq * 256 + r] = 0xFFFFu;
        __syncthreads();
        for (int s = C.tid; s < n; s += 512) { const u32x4* kp = (const u32x4*)(ik + ((size_t)b * SEQ + s) * 64); float kf[64];
#pragma unroll
            for (int d8 = 0; d8 < 8; ++d8) { float f[8]; unpack8(kp[d8], f);
#pragma unroll
                for (int j = 0; j < 8; ++j) kf[d8 * 8 + j] = f[j]; }
            float score = 0.f;
#pragma unroll 1
            for (int h = 0; h < 8; ++h) { float a = 0.f;
#pragma unroll
                for (int d = 0; d < 64; ++d) a += sq[h * 64 + d] * kf[d];
                score += sw[h] * fmaxf(a * 0.125f, 0.f); }
            sc[s] = score; }
        __syncthreads();
        for (int s = C.tid; s < n; s += 512) { const float v = sc[s]; int rank = 0;
            for (int s2 = 0; s2 < n; ++s2) { const float w = sc[s2]; rank += (w > v || (w == v && s2 < s)) ? 1 : 0; }
            if (rank < 256) sel[(size_t)tq * 256 + rank] = (unsigned short)s; }
    }
}
__device__ __forceinline__ void ph_att_naive(const Ctx& C) {
    const bf16_t* qabs = WSP(bf16_t, WS_QABS); const bf16_t* ckv = WSP(bf16_t, WS_CKV); const unsigned short* sel = WSP(unsigned short, WS_SEL); bf16_t* olat = WSP(bf16_t, WS_OLAT);
    LAS float* sqa = (LAS float*)C.lds; LAS float* sp = sqa + 2048; LAS int* ssel = (LAS int*)(sp + 2048);
    for (int tq = C.bid; tq < T; tq += C.G) {
        const int b = tq >> 12, q = tq & (SEQ - 1);
        __syncthreads();
        for (int i = C.tid; i < 2048; i += 512) sqa[i] = bf2f(qabs[(size_t)tq * 2048 + i]);
        if (C.tid < 256) { const int s = sel[(size_t)tq * 256 + C.tid]; ssel[C.tid] = (s <= q) ? s : -1; }
        __syncthreads();
        const int h = C.wave; float sv[4]; float mx = -INFINITY;
#pragma unroll
        for (int j = 0; j < 4; ++j) { const int k = C.lane + 64 * j, s = ssel[k]; float a = -INFINITY;
            if (s >= 0) { const u32x4* cp = (const u32x4*)(ckv + ((size_t)b * SEQ + s) * 256); a = 0.f;
                for (int c8 = 0; c8 < 32; ++c8) { float f[8]; unpack8(cp[c8], f);
#pragma unroll
                    for (int jj = 0; jj < 8; ++jj) a += sqa[h * 256 + c8 * 8 + jj] * f[jj]; } }
            sv[j] = a; mx = fmaxf(mx, a); }
        mx = wave_max(mx, C.lane); float sum = 0.f;
#pragma unroll
        for (int j = 0; j < 4; ++j) { sv[j] = __expf(sv[j] - mx); sum += sv[j]; }
        sum = wave_sum(sum, C.lane); const float inv = 1.f / sum;
#pragma unroll
        for (int j = 0; j < 4; ++j) sp[h * 256 + C.lane + 64 * j] = sv[j] * inv;
        __syncthreads();
        float o[4] = {0.f, 0.f, 0.f, 0.f};
        for (int k = 0; k < 256; ++k) { const int s = ssel[k]; if (s < 0) continue; const float p = sp[h * 256 + k]; const bf16_t* cp = ckv + ((size_t)b * SEQ + s) * 256 + C.lane;
#pragma unroll
            for (int j = 0; j < 4; ++j) o[j] += p * bf2f(cp[64 * j]); }
#pragma unroll
        for (int j = 0; j < 4; ++j) olat[(size_t)tq * 2048 + h * 256 + C.lane + 64 * j] = (bf16_t)f2bf(o[j]);
    }
}

typedef short v4i16_t __attribute__((ext_vector_type(4)));
__device__ __forceinline__ s16x4 tr_read(const LAS unsigned char* p) { return __builtin_bit_cast(s16x4, __builtin_amdgcn_ds_read_tr16_b64_v4i16((LAS v4i16_t*)p)); }
__device__ __forceinline__ bf16x8 tr_frag(const LAS unsigned char* X, int LDX, int rowA, int rowB, int n0, int lane) {
    const int q = (lane & 15) >> 2, p = lane & 3;
    const s16x4 lo = tr_read(X + (rowA + q) * LDX + (n0 + 4 * p) * 2), hi = tr_read(X + (rowB + q) * LDX + (n0 + 4 * p) * 2);
    return (bf16x8){lo[0], lo[1], lo[2], lo[3], hi[0], hi[1], hi[2], hi[3]};
}
constexpr int TLD = 544;
__device__ __forceinline__ bf16x8 as_bf16x8(u32x4 w) { return __builtin_bit_cast(bf16x8, w); }

__device__ __forceinline__ void ph_ret_kv(const Ctx& C) {
    const bf16_t* rk = WSP(bf16_t, WS_PROJ + P_RK); const bf16_t* rv = WSP(bf16_t, WS_PROJ + P_RV); bf16_t* KV = WSP(bf16_t, WS_KV);
    const LAS unsigned char* Vt = C.lds; const LAS unsigned char* Kt = C.lds + 128 * TLD;
    const int g = C.lane >> 4, fr = C.lane & 15, wr = C.wave >> 2, wc = C.wave & 3;
    for (int u = C.bid; u < 512; u += C.G) {
        const int n = u & 31, h = (u >> 5) & 3, b = u >> 7; const size_t row0 = (size_t)b * SEQ + n * 128;
        const float lg2 = log2f(1.0f - exp2f(-5.0f - (float)h));
        __syncthreads();
#pragma unroll
        for (int p = 0; p < 8; ++p) { const int idx = p * 512 + C.tid, row = idx >> 5, ch = idx & 31; const size_t go = (row0 + row) * 1024 + h * 256 + ch * 8;
            const u32x4 vv = *(const u32x4*)(rv + go); *(LAS u32x4*)(C.lds + row * TLD + ch * 16) = vv;
            float f[8]; unpack8(*(const u32x4*)(rk + go), f); const float z = exp2f(lg2 * (float)(127 - row));
            *(LAS u32x4*)(C.lds + 128 * TLD + row * TLD + ch * 16) = pack8((f32x4){f[0] * z, f[1] * z, f[2] * z, f[3] * z}, (f32x4){f[4] * z, f[5] * z, f[6] * z, f[7] * z}); }
        __syncthreads();
        f32x4 acc[8][4];
#pragma unroll
        for (int m = 0; m < 8; ++m)
#pragma unroll
            for (int nn = 0; nn < 4; ++nn) acc[m][nn] = (f32x4){0.f, 0.f, 0.f, 0.f};
#pragma unroll 1
        for (int ks = 0; ks < 4; ++ks) { bf16x8 Bv[4];
#pragma unroll
            for (int nn = 0; nn < 4; ++nn) Bv[nn] = tr_frag(Vt, TLD, 32 * ks + 8 * g, 32 * ks + 8 * g + 4, 64 * wc + 16 * nn, C.lane);
#pragma unroll
            for (int m = 0; m < 8; ++m) { const bf16x8 Ak = tr_frag(Kt, TLD, 32 * ks + 8 * g, 32 * ks + 8 * g + 4, 128 * wr + 16 * m, C.lane);
#pragma unroll
                for (int nn = 0; nn < 4; ++nn) acc[m][nn] = __builtin_amdgcn_mfma_f32_16x16x32_bf16(Ak, Bv[nn], acc[m][nn], 0, 0, 0); } }
        bf16_t* out = KV + (size_t)u * 65536;
#pragma unroll
        for (int m = 0; m < 8; ++m)
#pragma unroll
            for (int nn = 0; nn < 4; ++nn) { const int e = 64 * wc + 16 * nn + fr, d = 128 * wr + 16 * m + 4 * g; u32x2 w; w.x = cvt_pk_bf16(acc[m][nn][0], acc[m][nn][1]); w.y = cvt_pk_bf16(acc[m][nn][2], acc[m][nn][3]);
                *(u32x2*)(out + e * 256 + d) = w; }
    }
}
__device__ __forceinline__ void ph_ret_scan(const Ctx& C) {
    const bf16_t* KV = WSP(bf16_t, WS_KV); bf16_t* Rb = WSP(bf16_t, WS_R);
    for (int idx = C.bid * 512 + C.tid; idx < 16 * 8192; idx += C.G * 512) {
        const int bh = idx >> 13, off = (idx & 8191) * 8, h = bh & 3; const float gc = exp2f(128.0f * log2f(1.0f - exp2f(-5.0f - (float)h)));
        float R[8] = {0.f, 0.f, 0.f, 0.f, 0.f, 0.f, 0.f, 0.f};
#pragma unroll 4
        for (int n = 0; n < 32; ++n) { const size_t o = ((size_t)bh * 32 + n) * 65536 + off;
            *(u32x4*)(Rb + o) = pack8((f32x4){R[0], R[1], R[2], R[3]}, (f32x4){R[4], R[5], R[6], R[7]});
            float f[8]; unpack8(*(const u32x4*)(KV + o), f);
#pragma unroll
            for (int j = 0; j < 8; ++j) R[j] = R[j] * gc + f[j]; }
    }
}
__device__ __forceinline__ void ph_ret_out(const Ctx& C) {
    const bf16_t* rq = WSP(bf16_t, WS_PROJ + P_RQ); const bf16_t* rk = WSP(bf16_t, WS_PROJ + P_RK); const bf16_t* rv = WSP(bf16_t, WS_PROJ + P_RV); const bf16_t* rg = WSP(bf16_t, WS_PROJ + P_RG);
    const bf16_t* Rb = WSP(bf16_t, WS_R); bf16_t* ret = WSP(bf16_t, WS_RET);
    const LAS unsigned char* Vt = C.lds;
    const int g = C.lane >> 4, fr = C.lane & 15, w = C.wave;
    for (int u = C.bid; u < 512; u += C.G) {
        const int n = u & 31, h = (u >> 5) & 3, b = u >> 7; const size_t row0 = (size_t)b * SEQ + n * 128;
        const float lg2 = log2f(1.0f - exp2f(-5.0f - (float)h));
        __syncthreads();
#pragma unroll
        for (int p = 0; p < 8; ++p) { const int idx = p * 512 + C.tid, row = idx >> 5, ch = idx & 31;
            *(LAS u32x4*)(C.lds + row * TLD + ch * 16) = *(const u32x4*)(rv + (row0 + row) * 1024 + h * 256 + ch * 8); }
        __syncthreads();
        const int i = 16 * w + fr;
        bf16x8 Bq[8];
        { const bf16_t* qp = rq + (row0 + i) * 1024 + h * 256 + 8 * g;
#pragma unroll
          for (int ks = 0; ks < 8; ++ks) Bq[ks] = as_bf16x8(*(const u32x4*)(qp + 32 * ks)); }
        f32x4 acc[16];
#pragma unroll
        for (int nt = 0; nt < 16; ++nt) acc[nt] = (f32x4){0.f, 0.f, 0.f, 0.f};
        if (n > 0) {
            const bf16_t* rp = Rb + (size_t)u * 65536 + (size_t)fr * 256 + 8 * g;
#pragma unroll
            for (int ks = 0; ks < 8; ++ks)
#pragma unroll
                for (int nt = 0; nt < 16; ++nt) { const bf16x8 Ar = as_bf16x8(*(const u32x4*)(rp + nt * 16 * 256 + 32 * ks)); acc[nt] = __builtin_amdgcn_mfma_f32_16x16x32_bf16(Ar, Bq[ks], acc[nt], 0, 0, 0); }
            const float xi = exp2f(lg2 * (float)(i + 1));
#pragma unroll
            for (int nt = 0; nt < 16; ++nt) acc[nt] = acc[nt] * xi;
        }
        f32x4 ST[8];
#pragma unroll
        for (int jt = 0; jt < 8; ++jt) { ST[jt] = (f32x4){0.f, 0.f, 0.f, 0.f};
            if (jt <= w) { const bf16_t* kp = rk + (row0 + 16 * jt + fr) * 1024 + h * 256 + 8 * g;
#pragma unroll
                for (int ks = 0; ks < 8; ++ks) { const bf16x8 Ak = as_bf16x8(*(const u32x4*)(kp + 32 * ks)); ST[jt] = __builtin_amdgcn_mfma_f32_16x16x32_bf16(Ak, Bq[ks], ST[jt], 0, 0, 0); }
#pragma unroll
                for (int r = 0; r < 4; ++r) { const int j = 16 * jt + 4 * g + r; ST[jt][r] = (i >= j) ? ST[jt][r] * exp2f(lg2 * (float)(i - j)) : 0.f; } } }
#pragma unroll
        for (int t = 0; t < 4; ++t) if (2 * t <= w) {
            u32x4 sw; sw.x = cvt_pk_bf16(ST[2 * t][0], ST[2 * t][1]); sw.y = cvt_pk_bf16(ST[2 * t][2], ST[2 * t][3]); sw.z = cvt_pk_bf16(ST[2 * t + 1][0], ST[2 * t + 1][1]); sw.w = cvt_pk_bf16(ST[2 * t + 1][2], ST[2 * t + 1][3]);
            const bf16x8 Bs = as_bf16x8(sw);
#pragma unroll
            for (int nt = 0; nt < 16; ++nt) { const bf16x8 Av = tr_frag(Vt, TLD, 32 * t + 4 * g, 32 * t + 16 + 4 * g, 16 * nt, C.lane); acc[nt] = __builtin_amdgcn_mfma_f32_16x16x32_bf16(Av, Bs, acc[nt], 0, 0, 0); } }
        float ss = 0.f;
#pragma unroll
        for (int nt = 0; nt < 16; ++nt) ss += acc[nt][0] * acc[nt][0] + acc[nt][1] * acc[nt][1] + acc[nt][2] * acc[nt][2] + acc[nt][3] * acc[nt][3];
        ss += shx(ss, 16, C.lane); ss += shx(ss, 32, C.lane);
        const float rstd = rsqrtf(ss * (1.f / 256.f) + EPS);
        const size_t ob = (row0 + i) * 1024 + h * 256 + 4 * g;
#pragma unroll
        for (int nt = 0; nt < 16; ++nt) { const u32x2 gw = *(const u32x2*)(rg + ob + 16 * nt); u32x2 o;
            o.x = cvt_pk_bf16(acc[nt][0] * rstd * bf2f(gw.x), acc[nt][1] * rstd * bf2f(gw.x >> 16)); o.y = cvt_pk_bf16(acc[nt][2] * rstd * bf2f(gw.y), acc[nt][3] * rstd * bf2f(gw.y >> 16));
            *(u32x2*)(ret + ob + 16 * nt) = o; }
    }
}
__device__ __forceinline__ void ph_gmlp(const Ctx& C, int l) {
    const bf16_t* gu = WSP(bf16_t, WS_PROJ + P_GU); const bf16_t* gv = WSP(bf16_t, WS_PROJ + P_GV); const float* stats = WSP(float, WS_STATS); bf16_t* gm = WSP(bf16_t, WS_GM);
    const float* lng = C.in[I_LNG] + l * 1024; const float* lnb = C.in[I_LNB] + l * 1024; const float* Wsp = C.in[I_WS] + (size_t)l * 4 * 128 * 128; const float* bs = C.in[I_BS] + l * 4 * 128;
    constexpr int WLD = 272, W_OFF = 128 * TLD, ST_OFF = W_OFF + 128 * WLD;
    const LAS unsigned char* Lt = C.lds; LAS float* sst = (LAS float*)(C.lds + ST_OFF);
    const int g4 = C.lane >> 4, fr = C.lane & 15, w = C.wave;
    for (int u = C.bid; u < 512; u += C.G) {
        const int gg = u & 3, bn = u >> 2, t0 = bn * 128;
        __syncthreads();
        if (C.tid < 128) { const float* sp = stats + (size_t)(t0 + C.tid) * 32; float s = 0.f, q = 0.f;
#pragma unroll
            for (int k = 0; k < 16; ++k) { s += sp[2 * k]; q += sp[2 * k + 1]; }
            const float mean = s * (1.f / 1024.f), var = q * (1.f / 1024.f) - mean * mean; sst[2 * C.tid] = mean; sst[2 * C.tid + 1] = rsqrtf(var + EPS); }
#pragma unroll
        for (int p = 0; p < 4; ++p) { const int idx = p * 512 + C.tid, i = idx >> 4, j8 = (idx & 15) * 8; const float* wp = Wsp + ((size_t)gg * 128 + i) * 128 + j8;
            f32x4 a = *(const f32x4*)wp, b2 = *(const f32x4*)(wp + 4);
#pragma unroll
            for (int j = 0; j < 4; ++j) { if (j8 + j > i) a[j] = 0.f; if (j8 + 4 + j > i) b2[j] = 0.f; }
            *(LAS u32x4*)(C.lds + W_OFF + i * WLD + j8 * 2) = pack8(a, b2); }
        __syncthreads();
#pragma unroll
        for (int p = 0; p < 8; ++p) { const int idx = p * 512 + C.tid, row = idx >> 5, ch = idx & 31, cg = gg * 256 + ch * 8;
            float f[8]; unpack8(*(const u32x4*)(gv + (size_t)(t0 + row) * 1024 + cg), f); const float mean = sst[2 * row], rstd = sst[2 * row + 1];
            const f32x4 g0 = *(const f32x4*)(lng + cg), g1 = *(const f32x4*)(lng + cg + 4), b0 = *(const f32x4*)(lnb + cg), b1 = *(const f32x4*)(lnb + cg + 4);
            f32x4 y0, y1;
#pragma unroll
            for (int j = 0; j < 4; ++j) { y0[j] = (f[j] - mean) * rstd * g0[j] + b0[j]; y1[j] = (f[4 + j] - mean) * rstd * g1[j] + b1[j]; }
            *(LAS u32x4*)(C.lds + row * TLD + ch * 16) = pack8(y0, y1); }
        __syncthreads();
        f32x4 acc[16];
#pragma unroll
        for (int nt = 0; nt < 16; ++nt) acc[nt] = (f32x4){0.f, 0.f, 0.f, 0.f};
#pragma unroll
        for (int ks = 0; ks < 4; ++ks) if (2 * ks <= w) {
            const bf16x8 Bw = as_bf16x8(*(const LAS u32x4*)(C.lds + W_OFF + (16 * w + fr) * WLD + (32 * ks + 8 * g4) * 2));
#pragma unroll
            for (int nt = 0; nt < 16; ++nt) { const bf16x8 Av = tr_frag(Lt, TLD, 32 * ks + 8 * g4, 32 * ks + 8 * g4 + 4, 16 * nt, C.lane); acc[nt] = __builtin_amdgcn_mfma_f32_16x16x32_bf16(Av, Bw, acc[nt], 0, 0, 0); } }
        const int i = 16 * w + fr; const float bias = bs[gg * 128 + i]; const size_t ob = (size_t)(t0 + i) * 1024 + gg * 256 + 4 * g4;
#pragma unroll
        for (int nt = 0; nt < 16; ++nt) { const u32x2 uw = *(const u32x2*)(gu + ob + 16 * nt); u32x2 o;
            o.x = cvt_pk_bf16((acc[nt][0] + bias) * bf2f(uw.x), (acc[nt][1] + bias) * bf2f(uw.x >> 16)); o.y = cvt_pk_bf16((acc[nt][2] + bias) * bf2f(uw.y), (acc[nt][3] + bias) * bf2f(uw.y >> 16));
            *(u32x2*)(gm + ob + 16 * nt) = o; }
    }
}

__device__ __forceinline__ void ph_idx(const Ctx& C) {
    const bf16_t* iq = WSP(bf16_t, WS_PROJ + P_IQ); const bf16_t* ik = WSP(bf16_t, WS_PROJ + P_IK); const float* iw = WSP(float, WS_PROJ + P_IW); unsigned short* sel = WSP(unsigned short, WS_SEL);
    LAS unsigned* sc = (LAS unsigned*)C.lds;
    const int lane = C.lane, n32 = lane & 31, hh = lane >> 5, w = C.wave;
    for (int u = C.bid; u < T / 8; u += C.G) {
        const int b = u & 3, q0 = (SEQ / 8 - 1 - (u >> 2)) * 8, tq0 = b * SEQ + q0, nk = q0 + 8, nkt = (nk + 31) >> 5;
        __syncthreads();
        bf16x8 Aq[2][4]; float wq[2][16];
        { const int r = n32, qi = 2 * ((r >> 2) & 1) + (r >> 4), hd = (r & 3) + 4 * ((r >> 3) & 1);
#pragma unroll
          for (int mt = 0; mt < 2; ++mt) { const bf16_t* qp = iq + (size_t)(tq0 + 4 * mt + qi) * 512 + hd * 64 + 8 * hh;
#pragma unroll
              for (int ks = 0; ks < 4; ++ks) Aq[mt][ks] = as_bf16x8(*(const u32x4*)(qp + 16 * ks));
#pragma unroll
              for (int a = 0; a < 2; ++a) { const float* wp = iw + (size_t)(tq0 + 4 * mt + 2 * hh + a) * 8; const f32x4 w0 = *(const f32x4*)wp, w1 = *(const f32x4*)(wp + 4);
#pragma unroll
                  for (int j = 0; j < 4; ++j) { wq[mt][8 * a + j] = w0[j] * 0.125f; wq[mt][8 * a + 4 + j] = w1[j] * 0.125f; } } } }
        for (int kt = w; kt < nkt; kt += 8) {
            const bf16_t* kp = ik + ((size_t)b * SEQ + 32 * kt + n32) * 64 + 8 * hh; bf16x8 Bk[4];
#pragma unroll
            for (int ks = 0; ks < 4; ++ks) Bk[ks] = as_bf16x8(*(const u32x4*)(kp + 16 * ks));
#pragma unroll
            for (int mt = 0; mt < 2; ++mt) { f32x16 acc;
#pragma unroll
                for (int j = 0; j < 16; ++j) acc[j] = 0.f;
#pragma unroll
                for (int ks = 0; ks < 4; ++ks) acc = __builtin_amdgcn_mfma_f32_32x32x16_bf16(Aq[mt][ks], Bk[ks], acc, 0, 0, 0);
#pragma unroll
                for (int a = 0; a < 2; ++a) { float s = 0.f;
#pragma unroll
                    for (int rr = 0; rr < 8; ++rr) s += wq[mt][8 * a + rr] * fmaxf(acc[8 * a + rr], 0.f);
                    const int qu = 4 * mt + 2 * hh + a, key = 32 * kt + n32; unsigned bits = __builtin_bit_cast(unsigned, s);
                    bits = (bits & 0x80000000u) ? ~bits : (bits | 0x80000000u);
                    sc[qu * 4096 + key] = (key <= q0 + qu) ? bits : 0u; } }
        }
        __syncthreads();
        { const int q = q0 + w, n = q + 1; const size_t so = (size_t)(tq0 + w) * 256;
          if (n <= 256) { for (int r = lane; r < 256; r += 64) sel[so + r] = (r < n) ? (unsigned short)r : (unsigned short)0xFFFFu; }
          else {
            unsigned uu[64];
#pragma unroll
            for (int i = 0; i < 64; ++i) uu[i] = (64 * i + lane < nkt * 32) ? sc[w * 4096 + 64 * i + lane] : 0u;
            unsigned Tv = 0u;
#pragma unroll 1
            for (int bit = 31; bit >= 0; --bit) { const unsigned cand = Tv | (1u << bit); int cnt = 0;
#pragma unroll
                for (int i = 0; i < 64; ++i) cnt += __builtin_popcountll(__ballot(uu[i] >= cand));
                if (cnt >= 256) Tv = cand; }
            int cgt = 0;
#pragma unroll
            for (int i = 0; i < 64; ++i) cgt += __builtin_popcountll(__ballot(uu[i] > Tv));
            const int need = 256 - cgt; int base = 0, eqs = 0; const unsigned long long lt = (1ull << lane) - 1ull;
#pragma unroll
            for (int i = 0; i < 64; ++i) { const bool gt = uu[i] > Tv, eq = uu[i] == Tv; const unsigned long long em = __ballot(eq);
                const bool take = gt || (eq && (eqs + __builtin_popcountll(em & lt)) < need); const unsigned long long tm = __ballot(take);
                if (take) sel[so + base + __builtin_popcountll(tm & lt)] = (unsigned short)(64 * i + lane);
                base += __builtin_popcountll(tm); eqs += __builtin_popcountll(em); }
          } }
    }
}
__device__ __forceinline__ void ph_att(const Ctx& C) {
    const bf16_t* qabs = WSP(bf16_t, WS_QABS); const bf16_t* ckv = WSP(bf16_t, WS_CKV); const unsigned short* sel = WSP(unsigned short, WS_SEL); bf16_t* olat = WSP(bf16_t, WS_OLAT);
    const int lane = C.lane, g = lane >> 4, fr = lane & 15;
    LAS unsigned char* ch = C.lds + C.wave * (32 * TLD);
    for (int tq = C.gw; tq < T; tq += C.NGW) {
        const int b = tq >> 12, q = tq & (SEQ - 1), nv = (q + 1) < 256 ? (q + 1) : 256, nch = (nv + 31) >> 5;
        const bf16_t* cb = ckv + (size_t)b * SEQ * 256; const unsigned short* sp = sel + (size_t)tq * 256;
        bf16x8 Bqa[8];
        { const bf16_t* qp = qabs + (size_t)tq * 2048 + (fr & 7) * 256 + 8 * g;
#pragma unroll
          for (int ks = 0; ks < 8; ++ks) { u32x4 v = *(const u32x4*)(qp + 32 * ks); if (fr >= 8) v = (u32x4){0u, 0u, 0u, 0u}; Bqa[ks] = as_bf16x8(v); } }
        f32x4 acc[16];
#pragma unroll
        for (int nt = 0; nt < 16; ++nt) acc[nt] = (f32x4){0.f, 0.f, 0.f, 0.f};
        float mrun = -INFINITY, lrun = 0.f;
#pragma unroll 1
        for (int t = 0; t < nch; ++t) {
#pragma unroll
            for (int p = 0; p < 16; ++p) { const int idx = p * 64 + lane, row = idx >> 5, c16 = idx & 31, ki = 32 * t + row; const int s = (ki < nv) ? (int)sp[ki] : 0;
                *(LAS u32x4*)(ch + row * TLD + c16 * 16) = *(const u32x4*)(cb + (size_t)s * 256 + c16 * 8); }
            asm volatile("s_waitcnt lgkmcnt(0)" ::: "memory");
            f32x4 s2[2];
#pragma unroll
            for (int hf = 0; hf < 2; ++hf) { s2[hf] = (f32x4){0.f, 0.f, 0.f, 0.f};
#pragma unroll
                for (int ks = 0; ks < 8; ++ks) { const bf16x8 Ac = as_bf16x8(*(const LAS u32x4*)(ch + (16 * hf + fr) * TLD + (32 * ks + 8 * g) * 2)); s2[hf] = __builtin_amdgcn_mfma_f32_16x16x32_bf16(Ac, Bqa[ks], s2[hf], 0, 0, 0); } }
            float cm = -INFINITY;
#pragma unroll
            for (int hf = 0; hf < 2; ++hf)
#pragma unroll
                for (int r = 0; r < 4; ++r) { const int ki = 32 * t + 16 * hf + 4 * g + r; if (ki >= nv) s2[hf][r] = -INFINITY; cm = fmaxf(cm, s2[hf][r]); }
            cm = fmaxf(cm, shx(cm, 16, lane)); cm = fmaxf(cm, shx(cm, 32, lane));
            const float mnew = fmaxf(mrun, cm), scale = __expf(mrun - mnew); float ps = 0.f;
#pragma unroll
            for (int hf = 0; hf < 2; ++hf)
#pragma unroll
                for (int r = 0; r < 4; ++r) { s2[hf][r] = __expf(s2[hf][r] - mnew); ps += s2[hf][r]; }
            ps += shx(ps, 16, lane); ps += shx(ps, 32, lane);
            lrun = lrun * scale + ps; mrun = mnew;
            u32x4 pw; pw.x = cvt_pk_bf16(s2[0][0], s2[0][1]); pw.y = cvt_pk_bf16(s2[0][2], s2[0][3]); pw.z = cvt_pk_bf16(s2[1][0], s2[1][1]); pw.w = cvt_pk_bf16(s2[1][2], s2[1][3]);
            const bf16x8 Bp = as_bf16x8(pw);
#pragma unroll
            for (int nt = 0; nt < 16; ++nt) { const bf16x8 Av = tr_frag(ch, TLD, 4 * g, 16 + 4 * g, 16 * nt, lane); acc[nt] = __builtin_amdgcn_mfma_f32_16x16x32_bf16(Av, Bp, acc[nt] * scale, 0, 0, 0); }
            asm volatile("s_waitcnt lgkmcnt(0)" ::: "memory");
        }
        const float inv = 1.0f / lrun;
        if (fr < 8) { bf16_t* op = olat + (size_t)tq * 2048 + fr * 256 + 4 * g;
#pragma unroll
            for (int nt = 0; nt < 16; ++nt) { u32x2 o; o.x = cvt_pk_bf16(acc[nt][0] * inv, acc[nt][1] * inv); o.y = cvt_pk_bf16(acc[nt][2] * inv, acc[nt][3] * inv); *(u32x2*)(op + 16 * nt) = o; } }
    }
}

__device__ __forceinline__ void ph_router(const Ctx& C, int l, const float* x) {
    const float* g = C.in[I_NFFN] + l * DM; const float* wg = C.in[I_WGRP] + (size_t)l * DM * 4; const float* bg = C.in[I_BGRP] + l * 4;
    const float* we = C.in[I_WEXP] + (size_t)l * 4 * DM * 8; const float* be = C.in[I_BEXP] + l * 32;
    bf16_t* H = WSP(bf16_t, WS_H); int* rinfo = WSP(int, WS_ROUTE); float* rw = (float*)(rinfo + T * 4); unsigned* cnt = C.ctl + CW_CNT + l * 64;
    for (int row = C.gw; row < T; row += C.NGW) {
        const f32x4* xr = (const f32x4*)(x + (size_t)row * DM) + C.lane; f32x4 v[8]; float ss = 0.f;
#pragma unroll
        for (int j = 0; j < 8; ++j) { v[j] = xr[64 * j]; ss += v[j][0] * v[j][0] + v[j][1] * v[j][1] + v[j][2] * v[j][2] + v[j][3] * v[j][3]; }
        const float rstd = rsqrtf(wave_sum(ss, C.lane) * (1.f / DM) + EPS);
        u32x2* o = (u32x2*)(H + (size_t)row * DM) + C.lane; float gl[4] = {0.f, 0.f, 0.f, 0.f};
#pragma unroll
        for (int j = 0; j < 8; ++j) { const f32x4 gg = ((const f32x4*)g)[64 * j + C.lane]; v[j] = v[j] * rstd * gg; u32x2 w; w.x = cvt_pk_bf16(v[j][0], v[j][1]); w.y = cvt_pk_bf16(v[j][2], v[j][3]); o[64 * j] = w;
            const int d0 = 256 * j + 4 * C.lane;
#pragma unroll
            for (int e = 0; e < 4; ++e) { const f32x4 w4 = *(const f32x4*)(wg + (size_t)(d0 + e) * 4); gl[0] += v[j][e] * w4[0]; gl[1] += v[j][e] * w4[1]; gl[2] += v[j][e] * w4[2]; gl[3] += v[j][e] * w4[3]; } }
        int gsel = 0; float gmax = -INFINITY, gv4[4];
#pragma unroll
        for (int k = 0; k < 4; ++k) { gv4[k] = wave_sum(gl[k], C.lane) + bg[k]; if (gv4[k] > gmax) { gmax = gv4[k]; gsel = k; } }
        float gden = 0.f;
#pragma unroll
        for (int k = 0; k < 4; ++k) gden += __expf(gv4[k] - gmax);
        const float pg = 1.f / gden;
        gsel = __builtin_amdgcn_readfirstlane(gsel);
        const float* wes = we + (size_t)gsel * DM * 8; float el[8] = {0.f, 0.f, 0.f, 0.f, 0.f, 0.f, 0.f, 0.f};
#pragma unroll
        for (int j = 0; j < 8; ++j) { const int d0 = 256 * j + 4 * C.lane;
#pragma unroll
            for (int e = 0; e < 4; ++e) { const f32x4 a = *(const f32x4*)(wes + (size_t)(d0 + e) * 8), b2 = *(const f32x4*)(wes + (size_t)(d0 + e) * 8 + 4);
#pragma unroll
                for (int k = 0; k < 4; ++k) { el[k] += v[j][e] * a[k]; el[4 + k] += v[j][e] * b2[k]; } } }
        float emax = -INFINITY;
#pragma unroll
        for (int k = 0; k < 8; ++k) { el[k] = wave_sum(el[k], C.lane) + be[gsel * 8 + k]; emax = fmaxf(emax, el[k]); }
        float eden = 0.f, ep[8];
#pragma unroll
        for (int k = 0; k < 8; ++k) { ep[k] = __expf(el[k] - emax); eden += ep[k]; }
        int i0 = 0; float p0 = -1.f;
#pragma unroll
        for (int k = 0; k < 8; ++k) { ep[k] = ep[k] / eden; if (ep[k] > p0) { p0 = ep[k]; i0 = k; } }
        int i1 = 0; float p1 = -1.f;
#pragma unroll
        for (int k = 0; k < 8; ++k) if (k != i0 && ep[k] > p1) { p1 = ep[k]; i1 = k; }
        const float den = p0 + p1;
        if (C.lane == 0) { const int e0 = gsel * 8 + i0, e1 = gsel * 8 + i1;
            const unsigned r0 = atomicAdd(&cnt[e0], 1u), r1 = atomicAdd(&cnt[e1], 1u);
            *(int4*)(rinfo + (size_t)row * 4) = make_int4(e0, e1, (int)r0, (int)r1); *(f32x2*)(rw + (size_t)row * 2) = (f32x2){pg * (p0 / den), pg * (p1 / den)}; }
    }
}
__device__ __forceinline__ int moe_offsets(const unsigned* cnt, int lane, int& total_tiles) {
    const int c = lane < NEXP ? (int)__hip_atomic_load(cnt + lane, __ATOMIC_RELAXED, __HIP_MEMORY_SCOPE_AGENT) : 0; const int tiles = (c + 255) >> 8;
    int incl = tiles;
#pragma unroll
    for (int o = 1; o < 64; o <<= 1) { const int t = shi(incl, (lane - o) & 63); if (lane >= o) incl += t; }
    total_tiles = shi(incl, 63);
    return (incl - tiles) * 256;
}
__device__ __forceinline__ void ph_permute(const Ctx& C, int l) {
    const bf16_t* H = WSP(bf16_t, WS_H); bf16_t* hperm = WSP(bf16_t, WS_PROJ + M_HPERM); int* rinfo = WSP(int, WS_ROUTE); int* rpos = rinfo + T * 6;
    int tt; const int myoff = moe_offsets(C.ctl + CW_CNT + l * 64, C.lane, tt);
    for (int row = C.gw; row < T; row += C.NGW) {
        const int4 ri = *(const int4*)(rinfo + (size_t)row * 4);
        const int p0 = shi(myoff, ri.x) + ri.z, p1 = shi(myoff, ri.y) + ri.w;
        const u32x4* src = (const u32x4*)(H + (size_t)row * DM) + C.lane; u32x4* d0 = (u32x4*)(hperm + (size_t)p0 * DM) + C.lane; u32x4* d1 = (u32x4*)(hperm + (size_t)p1 * DM) + C.lane;
#pragma unroll
        for (int j = 0; j < 4; ++j) { const u32x4 w = src[64 * j]; d0[64 * j] = w; d1[64 * j] = w; }
        if (C.lane == 0) { rpos[(size_t)row * 2] = p0; rpos[(size_t)row * 2 + 1] = p1; }
    }
}
__device__ __forceinline__ int moe_table(const Ctx& C, int l) {
    __syncthreads();
    if (C.wave == 0) { int tt; const int off = moe_offsets(C.ctl + CW_CNT + l * 64, C.lane, tt); const int nxt = shi(off, (C.lane + 1) & 63);
        if (C.lane < NEXP) { const int t0 = off >> 8, t1 = (C.lane == NEXP - 1) ? tt : (nxt >> 8); for (int t = t0; t < t1; ++t) C.misc[16 + t] = C.lane; }
        if (C.lane == 0) C.misc[200] = tt; }
    __syncthreads();
    return C.misc[200];
}
__device__ __forceinline__ void ph_combine(const Ctx& C, float* x, bool last) {
    const bf16_t* yc = WSP(bf16_t, WS_PROJ + M_YC); const int* rinfo = WSP(int, WS_ROUTE); const float* rw = (const float*)(rinfo + T * 4); const int* rpos = rinfo + T * 6; const float* gf = C.in[I_FNG];
    for (int row = C.gw; row < T; row += C.NGW) {
        const int p0 = rpos[(size_t)row * 2], p1 = rpos[(size_t)row * 2 + 1]; const float w0 = rw[(size_t)row * 2], w1 = rw[(size_t)row * 2 + 1];
        f32x4* xr = (f32x4*)(x + (size_t)row * DM) + C.lane; const u32x2* y0 = (const u32x2*)(yc + (size_t)p0 * DM) + C.lane; const u32x2* y1 = (const u32x2*)(yc + (size_t)p1 * DM) + C.lane;
        f32x4 v[8]; float ss = 0.f;
#pragma unroll
        for (int j = 0; j < 8; ++j) { const u32x2 a = y0[64 * j], b = y1[64 * j]; f32x4 xv = xr[64 * j];
            xv[0] += w0 * bf2f(a.x) + w1 * bf2f(b.x); xv[1] += w0 * bf2f(a.x >> 16) + w1 * bf2f(b.x >> 16); xv[2] += w0 * bf2f(a.y) + w1 * bf2f(b.y); xv[3] += w0 * bf2f(a.y >> 16) + w1 * bf2f(b.y >> 16);
            v[j] = xv; ss += xv[0] * xv[0] + xv[1] * xv[1] + xv[2] * xv[2] + xv[3] * xv[3]; }
        if (last) { const float rstd = rsqrtf(wave_sum(ss, C.lane) * (1.f / DM) + EPS);
#pragma unroll
            for (int j = 0; j < 8; ++j) xr[64 * j] = v[j] * rstd * ((const f32x4*)gf)[64 * j + C.lane]; }
        else {
#pragma unroll
            for (int j = 0; j < 8; ++j) xr[64 * j] = v[j]; }
    }
}

constexpr int NPL = 12, NPHASES = 1 + DEPTH * NPL;
__global__ void __launch_bounds__(512, 2) mk_fwd(Args a) {
    extern __shared__ __attribute__((aligned(16))) unsigned char lds_raw[];
    Ctx C;
    C.lds = (LAS unsigned char*)lds_raw; C.misc = (volatile LAS int*)(C.lds + MISC_OFF); C.ws = a.ws; C.ctl = (unsigned*)(a.ws + WS_CTL);
    C.tid = threadIdx.x; C.lane = C.tid & 63; C.wave = __builtin_amdgcn_readfirstlane(C.tid >> 6); C.G = gridDim.x; C.bid = blockIdx.x;
    C.gw = C.bid * 8 + C.wave; C.NGW = C.G * 8; C.in = a.in; C.out = a.out;
    for (int i = C.tid; i < 256; i += 512) C.misc[i] = 0;
    __syncthreads();
#if MK_PER_PHASE
    XcdBarrier bar; bar.bar = C.ctl + CW_BAR; bar.x = 0; bar.st = (volatile LAS unsigned*)C.misc;
#else
    XcdBarrier bar = xcd_barrier_post(C.ctl + CW_BAR, (volatile LAS unsigned*)C.misc);
#endif
    const int lo = a.ph_lo, hi = a.ph_hi;
#define IN(k) (lo <= (k) && (k) < hi)
#if MK_PER_PHASE
#define SEAM(k) do { } while (0)
#else
#define SEAM(k) do { if (IN(k) && IN((k) + 1)) xcd_barrier(bar); } while (0)
#endif
    unsigned char* wb = C.ws + WS_W;
    bf16_t* H = WSP(bf16_t, WS_H);
    if (IN(0)) ph_rope(C);
#pragma unroll 1
    for (int l = 0; l < DEPTH; ++l) {
        const int pb = 1 + l * NPL;
        const float* xin = (l == 0) ? C.in[I_X] : (const float*)C.out;
        if (IN(pb + 0)) { refresh(C); ph_weights(C, l); ph_norm(C, xin, C.in[I_NMIX] + l * DM, H); }
        SEAM(pb + 0);
        if (IN(pb + 1)) { refresh(C);
            pg8::Gemm g{H, (const bf16_t*)(wb + W_IN), DM, DM, DM}; pg8::OrderMN S; S.init(T / 256, NP / 256, C.G, C.bid, 256L * DM * 2, 256L * DM * 2);
            pg8::EpiInProj E{C.ws};
            pg8::gemm_phase(C.lds, g, S, E);
        }
        SEAM(pb + 1);
        if (IN(pb + 2)) { refresh(C);
            ph_ckv(C, WSP(float, WS_PROJ + P_DC), C.in[I_KVG] + l * 256, WSP(bf16_t, WS_CKV));
            { pg8::Gemm g{WSP(bf16_t, WS_PROJ + P_DQ), (const bf16_t*)(wb + W_UK), 1024, 256, 256}; pg8::OrderMN S; S.init(T / 256, 8, C.G, C.bid, 256L * 1024 * 2, 256L * 256 * 2, 1, 256L * 2);
              pg8::EpiStore<0> E{WSP(bf16_t, WS_QABS), 2048, 0.08838834764831845f}; pg8::gemm_phase(C.lds, g, S, E); }
            refresh(C);
#if NAIVE_GMLP
            ph_gmlp_naive(C, l);
#else
            ph_gmlp(C, l);
#endif
            refresh(C);
#if !NAIVE_RET
            ph_ret_kv(C);
#endif
            refresh(C);
#if NAIVE_IDX
            ph_idx_naive(C);
#else
            ph_idx(C);
#endif
        }
        SEAM(pb + 2);
        if (IN(pb + 3)) { refresh(C);
#if !NAIVE_RET
            ph_ret_scan(C);
#endif
#if NAIVE_ATT
            ph_att_naive(C);
#else
            ph_att(C);
#endif
        }
        SEAM(pb + 3);
        if (IN(pb + 4)) { refresh(C);
            { pg8::Gemm g{WSP(bf16_t, WS_OLAT), (const bf16_t*)(wb + W_UV), 2048, 512, 512}; pg8::OrderMN S; S.init(T / 256, 4, C.G, C.bid, 256L * 2048 * 2, 256L * 512 * 2, 0, 512L * 2);
              pg8::EpiStore<0> E{WSP(bf16_t, WS_DS), 1024, 1.0f}; pg8::gemm_phase(C.lds, g, S, E); }
#if NAIVE_RET
            ph_ret_naive(C);
#else
            ph_ret_out(C);
#endif
        }
        SEAM(pb + 4);
        if (IN(pb + 5)) { refresh(C);
#pragma unroll 1
            for (int br = 0; br < 3; ++br) {
                const bf16_t* A = br == 0 ? WSP(bf16_t, WS_RET) : (br == 1 ? WSP(bf16_t, WS_GM) : WSP(bf16_t, WS_DS));
                const bf16_t* Bt = (const bf16_t*)(wb + (br == 0 ? W_RET : (br == 1 ? W_GM : W_DS)));
                const bf16_t* gate = WSP(bf16_t, WS_PROJ + (br == 0 ? P_GA : (br == 1 ? P_GB : P_GC)));
                pg8::Gemm g{A, Bt, 1024, 1024, 1024}; pg8::OrderMN S; S.init(T / 256, 8, C.G, C.bid, 256L * 1024 * 2, 256L * 1024 * 2);
                pg8::EpiBranch E{gate, H, br == 0 ? 1 : 0}; pg8::gemm_phase(C.lds, g, S, E);
            }
        }
        SEAM(pb + 5);
        if (IN(pb + 6)) { refresh(C);
            pg8::Gemm g{H, (const bf16_t*)(wb + W_OUT), DM, DM, DM}; pg8::OrderMN S; S.init(T / 256, 8, C.G, C.bid, 256L * DM * 2, 256L * DM * 2);
            pg8::EpiResid E{xin, C.out}; pg8::gemm_phase(C.lds, g, S, E);
        }
        SEAM(pb + 6);
        if (IN(pb + 7)) { refresh(C); ph_router(C, l, C.out); }
        SEAM(pb + 7);
        if (IN(pb + 8)) { refresh(C); ph_permute(C, l); }
        SEAM(pb + 8);
        if (IN(pb + 9)) { refresh(C);
            const int Mt = moe_table(C, l);
            pg8::Gemm g{WSP(bf16_t, WS_PROJ + M_HPERM), (const bf16_t*)(wb + W_13), DM, DM, DM};
            pg8::OrderMoE S{C.misc + 16, Mt, 4, C.G, C.bid, 256L * DM * 2, 256L * DM * 2, 1024L * DM * 2};
            pg8::EpiMoeUp E{WSP(bf16_t, WS_PROJ + M_HID)}; pg8::gemm_phase(C.lds, g, S, E);
        }
        SEAM(pb + 9);
        if (IN(pb + 10)) { refresh(C);
            const int Mt = moe_table(C, l);
            pg8::Gemm g{WSP(bf16_t, WS_PROJ + M_HID), (const bf16_t*)(wb + W_2), FF, FF, FF};
            pg8::OrderMoE S{C.misc + 16, Mt, 8, C.G, C.bid, 256L * FF * 2, 256L * FF * 2, (long)DM * FF * 2};
            pg8::EpiStore<0> E{WSP(bf16_t, WS_PROJ + M_YC), DM, 1.0f}; pg8::gemm_phase(C.lds, g, S, E);
        }
        SEAM(pb + 10);
        if (IN(pb + 11)) { refresh(C); ph_combine(C, C.out, l == DEPTH - 1); }
        if (l + 1 < DEPTH) SEAM(pb + 11);
    }
#undef IN
#undef SEAM
}

extern "C" void kernel_launch(void* const* d_in, const int* in_sizes, int n_in, void* d_out, int out_size, void* d_ws, size_t ws_size, hipStream_t stream) {
    static int grid = 0;
    if (grid == 0) {
        if (n_in != 23 || out_size != T * DM || ws_size < WS_END) { fprintf(stderr, "kernel_launch: unexpected shapes / workspace (n_in %d out %d ws %zu need %zu)\n", n_in, out_size, ws_size, (size_t)WS_END); grid = -1; return; }
        int dev = 0, cus = 0, per_cu = 0;
        if (hipGetDevice(&dev) != hipSuccess || hipDeviceGetAttribute(&cus, hipDeviceAttributeMultiprocessorCount, dev) != hipSuccess) { grid = -1; return; }
        if (hipFuncSetAttribute((const void*)mk_fwd, hipFuncAttributeMaxDynamicSharedMemorySize, LDS_BYTES) != hipSuccess) { fprintf(stderr, "kernel_launch: hipFuncSetAttribute failed\n"); grid = -1; return; }
        if (hipOccupancyMaxActiveBlocksPerMultiprocessor(&per_cu, (const void*)mk_fwd, 512, LDS_BYTES) != hipSuccess || per_cu < 1) { fprintf(stderr, "kernel_launch: occupancy query says %d\n", per_cu); (void)hipGetLastError(); grid = -1; return; }
        grid = cus;
    }
    if (grid < 0) return;
    (void)hipMemsetAsync((char*)d_ws + WS_CTL, 0, CTL_BYTES, stream);
    Args a{};
    for (int i = 0; i < 23; ++i) a.in[i] = (const float*)d_in[i];
    a.out = (float*)d_out; a.ws = (unsigned char*)d_ws;
#if MK_PER_PHASE
    for (int p = 0; p < NPHASES; ++p) { a.ph_lo = p; a.ph_hi = p + 1; hipLaunchKernelGGL(mk_fwd, dim3(grid), dim3(512), LDS_BYTES, stream, a); }
#else
    a.ph_lo = 0; a.ph_hi = NPHASES;
    hipLaunchKernelGGL(mk_fwd, dim3(grid), dim3(512), LDS_BYTES, stream, a);
#endif
}
```

```cpp
#include <hip/hip_runtime.h>
#include <stdint.h>
#include <stdio.h>

#ifndef MK_PER_PHASE
#define MK_PER_PHASE 0
#endif
#ifndef PROBE_MASK
#define PROBE_MASK 0
#endif
#define REP(k) for (int rep_ = 0; rep_ <= ((PROBE_MASK >> (k)) & 1); ++rep_)
#ifndef NAIVE_RET
#define NAIVE_RET 0
#endif
#ifndef NAIVE_GMLP
#define NAIVE_GMLP 0
#endif
#ifndef NAIVE_IDX
#define NAIVE_IDX 0
#endif
#ifndef NAIVE_ATT
#define NAIVE_ATT 0
#endif

#define LAS __attribute__((address_space(3)))
typedef unsigned short bf16_t;
typedef short bf16x8 __attribute__((ext_vector_type(8)));
typedef short s16x4 __attribute__((ext_vector_type(4)));
typedef float f32x4 __attribute__((ext_vector_type(4)));
typedef float f32x2 __attribute__((ext_vector_type(2)));
typedef float f32x16 __attribute__((ext_vector_type(16)));
typedef unsigned u32x4 __attribute__((ext_vector_type(4)));
typedef unsigned u32x2 __attribute__((ext_vector_type(2)));

constexpr int DM = 2048, NB = 4, SEQ = 4096, T = NB * SEQ, DEPTH = 2;
constexpr int INW = 14152, NP = 14336;
constexpr int GATE_SRC0 = 8008, GATE_DST0 = 8192;
constexpr int NEXP = 32, FF = 512, MOE_ROWS = 40960;
constexpr float EPS = 1e-6f;

constexpr size_t MiB = 1u << 20;
constexpr size_t WS_CTL = 0, CTL_BYTES = 1 * MiB;
constexpr size_t WS_ROPE = 1 * MiB;
constexpr size_t WS_W = 5 * MiB;
constexpr size_t W_IN = 0, W_RET = 56 * MiB, W_GM = 60 * MiB, W_DS = 64 * MiB, W_OUT = 68 * MiB, W_13 = 76 * MiB, W_2 = 204 * MiB, W_UK = 268 * MiB, W_UV = 269 * MiB, W_END = 270 * MiB;
constexpr size_t WS_H = WS_W + W_END;
constexpr size_t WS_PROJ = WS_H + 64 * MiB;
constexpr size_t P_RQ = 0, P_RK = 32 * MiB, P_RV = 64 * MiB, P_RG = 96 * MiB, P_GU = 128 * MiB, P_GV = 160 * MiB, P_DQ = 192 * MiB, P_DC = 224 * MiB  ,
                 P_IQ = 240 * MiB  , P_IK = 256 * MiB  , P_IW = 258 * MiB  , P_GA = 260 * MiB, P_GB = 324 * MiB, P_GC = 388 * MiB, P_END = 452 * MiB;
constexpr size_t M_HPERM = 0, M_HID = 160 * MiB, M_YC = 200 * MiB;
constexpr size_t WS_KV = WS_PROJ + P_END;
constexpr size_t WS_R = WS_KV + 64 * MiB;
constexpr size_t WS_QABS = WS_R + 64 * MiB;
constexpr size_t WS_OLAT = WS_QABS + 64 * MiB;
constexpr size_t WS_RET = WS_OLAT + 64 * MiB;
constexpr size_t WS_GM = WS_RET + 32 * MiB, WS_DS = WS_GM + 32 * MiB;
constexpr size_t WS_SEL = WS_DS + 32 * MiB;
constexpr size_t WS_CKV = WS_SEL + 8 * MiB;
constexpr size_t WS_STATS = WS_CKV + 8 * MiB;
constexpr size_t WS_ROUTE = WS_STATS + 2 * MiB;
constexpr size_t WS_END = WS_ROUTE + 1 * MiB;
constexpr int CW_BAR = 4096, CW_CNT = 16384;

constexpr int LDS_BYTES = 147456, MISC_OFF = LDS_BYTES - 1024;

__device__ __forceinline__ unsigned f2bf(float f) { unsigned u = __builtin_bit_cast(unsigned, f); return (u + 0x7fffu + ((u >> 16) & 1u)) >> 16; }
__device__ __forceinline__ float bf2f(unsigned b) { return __builtin_bit_cast(float, (b & 0xffffu) << 16); }
typedef __bf16 bf16x2_t __attribute__((ext_vector_type(2)));
__device__ __forceinline__ unsigned cvt_pk_bf16(float lo, float hi) { const f32x2 v = {lo, hi}; return __builtin_bit_cast(unsigned, __builtin_convertvector(v, bf16x2_t)); }
__device__ __forceinline__ float shx(float v, int k, int lane) { return __builtin_bit_cast(float, __builtin_amdgcn_ds_bpermute((lane ^ k) << 2, __builtin_bit_cast(int, v))); }
__device__ __forceinline__ int shi(int v, int src) { return __builtin_amdgcn_ds_bpermute(src << 2, v); }
__device__ __forceinline__ float wave_sum(float v, int lane) {
#pragma unroll
    for (int o = 1; o < 64; o <<= 1) v += shx(v, o, lane);
    return v;
}
__device__ __forceinline__ float wave_max(float v, int lane) {
#pragma unroll
    for (int o = 1; o < 64; o <<= 1) v = fmaxf(v, shx(v, o, lane));
    return v;
}
__device__ __forceinline__ float sigmoidf_(float x) { return __builtin_amdgcn_rcpf(1.0f + __builtin_amdgcn_exp2f(x * -1.44269504089f)); }
__device__ __forceinline__ float siluf_(float x) { return x * sigmoidf_(x); }
__device__ __forceinline__ f32x2 gelu_pk(f32x2 v) {
    const f32x2 av = __builtin_elementwise_abs(v), d = av * 0.2316418882f + 1.0f;
    f32x2 t; t.x = __builtin_amdgcn_rcpf(d.x); t.y = __builtin_amdgcn_rcpf(d.y);
    f32x2 q = t * 0.5307027145f + (-0.7265760135f); q = q * t + 0.7107068705f; q = q * t + (-0.142248368f); q = q * t + 0.127414796f; q = q * t;
    const f32x2 s = (v * v) * (-0.72134752044f);
    f32x2 e; e.x = __builtin_amdgcn_exp2f(s.x); e.y = __builtin_amdgcn_exp2f(s.y);
    const f32x2 m = v * (q * e), r = v - m;
    f32x2 o; o.x = v.x < 0.f ? m.x : r.x; o.y = v.y < 0.f ? m.y : r.y; return o;
}
template <int ACT> __device__ __forceinline__ f32x4 act4(f32x4 v) {
    if (ACT == 1) { f32x2 a = gelu_pk((f32x2){v[0], v[1]}), b = gelu_pk((f32x2){v[2], v[3]}); return (f32x4){a.x, a.y, b.x, b.y}; }
    if (ACT == 2) return (f32x4){siluf_(v[0]), siluf_(v[1]), siluf_(v[2]), siluf_(v[3])};
    if (ACT == 3) return (f32x4){sigmoidf_(v[0]), sigmoidf_(v[1]), sigmoidf_(v[2]), sigmoidf_(v[3])};
    return v;
}
__device__ __forceinline__ u32x4 pack8(f32x4 a, f32x4 b) { u32x4 w; w.x = cvt_pk_bf16(a[0], a[1]); w.y = cvt_pk_bf16(a[2], a[3]); w.z = cvt_pk_bf16(b[0], b[1]); w.w = cvt_pk_bf16(b[2], b[3]); return w; }
__device__ __forceinline__ void unpack8(u32x4 w, float (&f)[8]) {
    f[0] = bf2f(w.x); f[1] = bf2f(w.x >> 16); f[2] = bf2f(w.y); f[3] = bf2f(w.y >> 16); f[4] = bf2f(w.z); f[5] = bf2f(w.z >> 16); f[6] = bf2f(w.w); f[7] = bf2f(w.w >> 16);
}

#define XB_TMO      128
#define XB_XCNT(j)  (256  + 64 * (j))
#define XB_XSUB(j)  (1280 + 64 * (j))
#define XB_XGEN(j)  (2304 + 64 * (j))
#define XB_TOP      3328
#define XB_TOPGEN   3392
#define XCD_BAR_WORDS 3456
#define XB_SPIN_CAP (1u << 20)
__device__ __forceinline__ unsigned xb_ld(unsigned* p)              { return __hip_atomic_load(p, __ATOMIC_RELAXED, __HIP_MEMORY_SCOPE_AGENT); }
__device__ __forceinline__ unsigned xb_add(unsigned* p, unsigned v) { return __hip_atomic_fetch_add(p, v, __ATOMIC_RELAXED, __HIP_MEMORY_SCOPE_AGENT); }
__device__ __forceinline__ unsigned xb_xcc_id() { return (unsigned)__builtin_amdgcn_s_getreg((3 << 11) | 20) & 0xFu; }
#define XB_SPIN(cond, bar) do { unsigned _sp = 0; while (cond) { __builtin_amdgcn_s_sleep(1); \
    if ((++_sp & 255u) == 0u) { if (xb_ld(&(bar)[XB_TMO])) break; if (_sp > XB_SPIN_CAP) { atomicAdd(&(bar)[XB_TMO], 1u); break; } } } } while (0)
struct XcdBarrier { unsigned* bar; unsigned x; volatile LAS unsigned* st; };
__device__ __forceinline__ XcdBarrier xcd_barrier_post(unsigned* bar, volatile LAS unsigned* st) {
    XcdBarrier b; b.bar = bar; b.x = xb_xcc_id(); b.st = st;
    if (threadIdx.x == 0) (void)xb_add(&bar[XB_XCNT(b.x)], 1u);
    return b;
}
__device__ __forceinline__ void xcd_barrier_complete(unsigned* bar, unsigned x, unsigned& nloc, unsigned& nx) {
    const unsigned G = gridDim.x * gridDim.y * gridDim.z;
    unsigned sum, cnt, mine, sp = 0u;
    for (;;) {
        sum = 0u; cnt = 0u; mine = 0u;
#pragma unroll
        for (unsigned j = 0; j < 16; ++j) { const unsigned c = xb_ld(&bar[XB_XCNT(j)]); sum += c; cnt += (c > 0u) ? 1u : 0u; mine = (j == x) ? c : mine; }
        if (sum == G) break;
        __builtin_amdgcn_s_sleep(1);
        if ((++sp & 255u) == 0u) { if (xb_ld(&bar[XB_TMO])) break; if (sp > XB_SPIN_CAP) { atomicAdd(&bar[XB_TMO], 1u); break; } }
    }
    nloc = mine > 0u ? mine : 1u; nx = cnt > 0u ? cnt : 1u;
}
__device__ __forceinline__ void xcd_barrier(const XcdBarrier& b) {
    asm volatile("s_waitcnt vmcnt(0)" ::: "memory");
    __syncthreads();
    if (threadIdx.x == 0) {
        unsigned* bar = b.bar;
        __builtin_amdgcn_s_waitcnt(0);
        unsigned nloc = b.st[0], nx = b.st[1];
        if (nloc == 0u) { xcd_barrier_complete(bar, b.x, nloc, nx); b.st[0] = nloc; b.st[1] = nx; }
        const unsigned old = xb_add(&bar[XB_XSUB(b.x)], 1u);
        const unsigned gen = old / nloc;
        if (old + 1u == (gen + 1u) * nloc) {
            __builtin_amdgcn_fence(__ATOMIC_RELEASE, "agent");
            asm volatile("s_waitcnt vmcnt(0)" ::: "memory");
            const unsigned og = xb_add(&bar[XB_TOP], 1u);
            const unsigned tg = og / nx;
            if (og + 1u == (tg + 1u) * nx) xb_add(&bar[XB_TOPGEN], 1u);
            else XB_SPIN(xb_ld(&bar[XB_TOPGEN]) == tg, bar);
            __builtin_amdgcn_fence(__ATOMIC_ACQUIRE, "agent");
            xb_add(&bar[XB_XGEN(b.x)], 1u);
            asm volatile("s_waitcnt vmcnt(0)" ::: "memory");
        } else {
            XB_SPIN(xb_ld(&bar[XB_XGEN(b.x)]) == gen, bar);
            __builtin_amdgcn_fence(__ATOMIC_ACQUIRE, "agent");
            asm volatile("s_waitcnt vmcnt(0)" ::: "memory");
        }
    }
    __syncthreads();
}

namespace pg8 {
constexpr int BM = 256, BK = 64, HALF = 128, HTB = HALF * BK * 2, STAGE_BYTES = 8 * HTB, NXCD = 8, WGM = 8;
__host__ __device__ __forceinline__ int lds_byte(int r, int c) { const int st = (r >> 4) * 2 + (c >> 5), rr = r & 15, cc = c & 31, ob = rr * 64 + cc * 2; return st * 1024 + (ob ^ (((ob >> 9) & 1) << 5)); }
__host__ __device__ __forceinline__ void stage_rc(int b, int& R, int& C) { const int st = b / 1024, sb = b % 1024, swz = sb ^ (((sb >> 9) & 1) << 5); R = (st >> 1) * 16 + swz / 64; C = (st & 1) * 32 + (swz % 64) / 2; }
__host__ __device__ __forceinline__ int perm32(int rho) { const int n = rho >> 4, i = rho & 15; return 8 * (i >> 2) + 4 * n + (i & 3); }

struct Unit { int pm, pn; long aoff, boff; };
struct Gemm { const bf16_t* A; const bf16_t* Bt; int lda, ldb, K; };

struct OrderMN {
    int nM, nN, nwg, G, c, ashift; long astep, bstep, abytes;
    __device__ void init(int nM_, int nN_, int G_, int c_, long astep_, long bstep_, int ashift_ = 0, long abytes_ = 0) { nM = nM_; nN = nN_; nwg = nM * nN; G = G_; c = c_; astep = astep_; bstep = bstep_; ashift = ashift_; abytes = abytes_; }
    __device__ bool next(int i, Unit& u) const {
        const long L = (long)i * G + c; if (L >= nwg) return false;
        int wgid = (int)L; { const int q = nwg / NXCD, r = nwg % NXCD, xcd = wgid % NXCD, off = wgid / NXCD; wgid = (xcd < r ? xcd * (q + 1) : r * (q + 1) + (xcd - r) * q) + off; }
        const int nig = WGM * nN, gid = wgid / nig, fm = gid * WGM, gsz = (nM - fm) < WGM ? (nM - fm) : WGM;
        u.pm = fm + ((wgid % nig) % gsz); u.pn = (wgid % nig) / gsz;
        u.aoff = (long)u.pm * astep + (long)(u.pn >> ashift) * abytes; u.boff = (long)u.pn * bstep; return true;
    }
};
struct OrderMoE {
    const volatile LAS int* te; int Mt, nN, G, c; long astep, bstep, estep;
    __device__ bool next(int i, Unit& u) const {
        const long L = (long)i * G + c; if (L >= (long)Mt * nN) return false;
        u.pm = (int)(L / nN); u.pn = (int)(L % nN);
        u.aoff = (long)u.pm * astep; u.boff = (long)te[u.pm] * estep + (long)u.pn * bstep; return true;
    }
};

template <class Epi, class Sched>
__device__ __forceinline__ void gemm_phase(LAS unsigned char* lds, const Gemm g, const Sched& S, const Epi& E) {
    int tid_ = threadIdx.x; asm volatile("" : "+v"(tid_));
    const bf16_t* gA = g.A; const bf16_t* gB = g.Bt; asm volatile("" : "+s"(gA), "+s"(gB));
    const int tid = tid_, wid = __builtin_amdgcn_readfirstlane(tid >> 6), lane = tid & 63, wr = wid >> 2, wc = wid & 3, fr = lane & 15, fq = lane >> 4;
    const int K = g.K, nt = K / BK;
    unsigned voffA[2], voffB[2];
#pragma unroll
    for (int i = 0; i < 2; ++i) { int R, C; stage_rc(tid * 16 + i * 8192, R, C); const int Rb = Epi::PERM ? ((R & ~31) + perm32(R & 31)) : R;
        voffA[i] = (unsigned)(R * g.lda + C) * 2u; voffB[i] = (unsigned)(Rb * g.ldb + C) * 2u; }
    const size_t kstep = (size_t)(BK * 2);
    const size_t hstepA = (size_t)HALF * g.lda * 2, hstepB = (size_t)HALF * g.ldb * 2;
    const unsigned ldsw = (unsigned)wid * 1024u;
    const int aoff = lds_byte(wr * 64 + fr, fq * 8), boff = lds_byte(wc * 32 + fr, fq * 8);
#define PG8_SA(b, h) (((b) * 2 + (h)) * HTB)
#define PG8_SB(b, h) ((4 + (b) * 2 + (h)) * HTB)
#define PG8_STAGE(bufoff, gbase, voff) do { _Pragma("unroll") for (int _i = 0; _i < 2; ++_i) \
        __builtin_amdgcn_global_load_lds((const unsigned*)((const char*)(gbase) + (voff)[_i]), (LAS unsigned*)(lds + (bufoff) + ldsw + _i * 8192), 16, 0, 0); } while (0)
#define PG8_LDA(dst, b, h) do { _Pragma("unroll") for (int m = 0; m < 4; ++m) _Pragma("unroll") for (int k = 0; k < 2; ++k) dst[m][k] = *(const LAS bf16x8*)(lds + PG8_SA(b, h) + aoff + m * 2048 + k * 1024); } while (0)
#define PG8_LDB(dst, b, h) do { _Pragma("unroll") for (int n = 0; n < 2; ++n) _Pragma("unroll") for (int k = 0; k < 2; ++k) dst[n][k] = *(const LAS bf16x8*)(lds + PG8_SB(b, h) + boff + n * 2048 + k * 1024); } while (0)
#define PG8_MMA(ai, bj, At, Bt) do { __builtin_amdgcn_s_setprio(1); _Pragma("unroll") for (int m = 0; m < 4; ++m) _Pragma("unroll") for (int n = 0; n < 2; ++n) _Pragma("unroll") for (int k = 0; k < 2; ++k) \
        acc[ai][bj][m][n] = __builtin_amdgcn_mfma_f32_16x16x32_bf16(Bt[n][k], At[m][k], acc[ai][bj][m][n], 0, 0, 0); __builtin_amdgcn_s_setprio(0); } while (0)
#define PG8_WAIT_V(n) asm volatile("s_waitcnt vmcnt(" #n ")" ::: "memory")
#define PG8_WAIT_L(n) asm volatile("s_waitcnt lgkmcnt(" #n ")" ::: "memory")
#define PG8_BAR __builtin_amdgcn_s_barrier()
#define PG8_SCHED __builtin_amdgcn_sched_barrier(0)
    Unit cur, nxt; int ui = 0;
    if (!S.next(0, cur)) return;
    f32x4 acc[2][2][4][2];
#pragma unroll
    for (int a = 0; a < 2; ++a)
#pragma unroll
        for (int b = 0; b < 2; ++b)
#pragma unroll
            for (int m = 0; m < 4; ++m)
#pragma unroll
                for (int n = 0; n < 2; ++n) acc[a][b][m][n] = (f32x4){0.f, 0.f, 0.f, 0.f};
    bf16x8 At[4][2], B0[2][2], B1[2][2];
    const char* cA = (const char*)gA + cur.aoff; const char* cB = (const char*)gB + cur.boff;
    PG8_STAGE(PG8_SB(0, 0), cB, voffB); PG8_STAGE(PG8_SA(0, 0), cA, voffA); PG8_STAGE(PG8_SB(0, 1), cB + hstepB, voffB); PG8_STAGE(PG8_SA(0, 1), cA + hstepA, voffA);
    if (wr == 1) PG8_BAR;
    PG8_WAIT_V(4); PG8_BAR;
    PG8_STAGE(PG8_SB(1, 0), cB + kstep, voffB); PG8_STAGE(PG8_SA(1, 0), cA + kstep, voffA); PG8_STAGE(PG8_SB(1, 1), cB + hstepB + kstep, voffB);
    PG8_WAIT_V(6); PG8_BAR;
    for (;;) {
        const bool has_next = S.next(ui + 1, nxt);
        const char* nA = has_next ? (const char*)gA + nxt.aoff : cA; const char* nB = has_next ? (const char*)gB + nxt.boff : cB;
        for (int t = 0; t < nt; t += 2) {
            const bool last = (t == nt - 2);
            const char* a1 = cA + (size_t)(t + 1) * kstep;
            const char* a2 = last ? nA : cA + (size_t)(t + 2) * kstep; const char* b2 = last ? nB : cB + (size_t)(t + 2) * kstep;
            const char* a3 = a2 + kstep; const char* b3 = b2 + kstep;
            PG8_LDB(B0, 0, 0); PG8_SCHED; PG8_LDA(At, 0, 0); PG8_STAGE(PG8_SA(1, 1), a1 + hstepA, voffA);
            PG8_WAIT_L(8); PG8_BAR; PG8_WAIT_L(0); PG8_MMA(0, 0, At, B0); PG8_BAR; PG8_SCHED;
            PG8_LDB(B1, 0, 1); PG8_STAGE(PG8_SB(0, 0), b2, voffB);
            PG8_BAR; PG8_WAIT_L(0); PG8_MMA(0, 1, At, B1); PG8_BAR;
            PG8_LDA(At, 0, 1); PG8_STAGE(PG8_SA(0, 0), a2, voffA);
            PG8_BAR; PG8_WAIT_L(0); PG8_MMA(1, 0, At, B0); PG8_BAR; PG8_SCHED;
            PG8_STAGE(PG8_SB(0, 1), b2 + hstepB, voffB);
            PG8_WAIT_V(6); PG8_BAR; PG8_MMA(1, 1, At, B1); PG8_BAR;
            PG8_LDB(B0, 1, 0); PG8_SCHED; PG8_LDA(At, 1, 0); PG8_STAGE(PG8_SA(0, 1), a2 + hstepA, voffA);
            PG8_WAIT_L(8); PG8_BAR; PG8_WAIT_L(0); PG8_MMA(0, 0, At, B0); PG8_BAR; PG8_SCHED;
            PG8_LDB(B1, 1, 1); PG8_STAGE(PG8_SB(1, 0), b3, voffB);
            PG8_BAR; PG8_WAIT_L(0); PG8_MMA(0, 1, At, B1); PG8_BAR;
            PG8_LDA(At, 1, 1); PG8_STAGE(PG8_SA(1, 0), a3, voffA);
            PG8_BAR; PG8_WAIT_L(0); PG8_MMA(1, 0, At, B0); PG8_BAR; PG8_SCHED;
            PG8_STAGE(PG8_SB(1, 1), b3 + hstepB, voffB);
            PG8_WAIT_V(6); PG8_BAR; PG8_MMA(1, 1, At, B1); PG8_BAR;
        }
        E(acc, cur, wr, wc, fr, fq);
        if (!has_next) break;
#pragma unroll
        for (int a = 0; a < 2; ++a)
#pragma unroll
            for (int b = 0; b < 2; ++b)
#pragma unroll
                for (int m = 0; m < 4; ++m)
#pragma unroll
                    for (int n = 0; n < 2; ++n) acc[a][b][m][n] = (f32x4){0.f, 0.f, 0.f, 0.f};
        cur = nxt; cA = nA; cB = nB; ++ui;
    }
    PG8_WAIT_V(0);
    if (wr == 0) PG8_BAR;
    PG8_BAR;
#undef PG8_SA
#undef PG8_SB
#undef PG8_STAGE
#undef PG8_LDA
#undef PG8_LDB
#undef PG8_MMA
#undef PG8_WAIT_V
#undef PG8_WAIT_L
#undef PG8_BAR
#undef PG8_SCHED
}

typedef const f32x4 (&AccT)[2][2][4][2];
template <int ACT> __device__ __forceinline__ void store_tile_bf16(AccT acc, bf16_t* O, int ld, int row0, int colb, float scale) {
#pragma unroll
    for (int ai = 0; ai < 2; ++ai)
#pragma unroll
        for (int m = 0; m < 4; ++m) { bf16_t* rowp = O + (size_t)(row0 + ai * HALF + m * 16) * ld + colb;
#pragma unroll
            for (int bj = 0; bj < 2; ++bj) { const f32x4 v0 = act4<ACT>(acc[ai][bj][m][0] * scale), v1 = act4<ACT>(acc[ai][bj][m][1] * scale);
                *(u32x4*)(rowp + bj * HALF) = pack8(v0, v1); }
            asm volatile("" ::: "memory"); }
}
template <int ACT> struct EpiStore {
    static constexpr bool PERM = true;
    bf16_t* O; int ld; float scale;
    __device__ __forceinline__ void operator()(AccT acc, const Unit& u, int wr, int wc, int fr, int fq) const {
        store_tile_bf16<ACT>(acc, O, ld, u.pm * BM + wr * 64 + fr, u.pn * BM + wc * 32 + 8 * fq, scale);
    }
};
struct EpiInProj {
    static constexpr bool PERM = true;
    unsigned char* ws;
    __device__ __forceinline__ void operator()(AccT acc, const Unit& u, int wr, int wc, int fr, int fq) const {
        const int pn = u.pn, row0 = u.pm * BM + wr * 64 + fr, cw = wc * 32 + 8 * fq;
        unsigned char* pj = ws + WS_PROJ;
        bf16_t *rq = (bf16_t*)(pj + P_RQ), *rk = (bf16_t*)(pj + P_RK), *rv = (bf16_t*)(pj + P_RV), *rg = (bf16_t*)(pj + P_RG), *gu = (bf16_t*)(pj + P_GU), *gv = (bf16_t*)(pj + P_GV), *dq = (bf16_t*)(pj + P_DQ),
               *iq = (bf16_t*)(pj + P_IQ), *ik = (bf16_t*)(pj + P_IK), *ga = (bf16_t*)(pj + P_GA), *gb = (bf16_t*)(pj + P_GB), *gc = (bf16_t*)(pj + P_GC);
        float *dcraw = (float*)(pj + P_DC), *iw = (float*)(pj + P_IW), *gvstats = (float*)(ws + WS_STATS); const float* rope = (const float*)(ws + WS_ROPE);
        if (pn < 8) {
            const bool isk = pn >= 4; bf16_t* dst = (isk ? rk : rq) + (pn & 3) * 256 + cw; const float sc = isk ? 0.0625f : 1.0f;
#pragma unroll
            for (int ai = 0; ai < 2; ++ai)
#pragma unroll
                for (int m = 0; m < 4; ++m) { const int row = row0 + ai * HALF + m * 16, pos = row & (SEQ - 1);
                    const f32x4* cs = (const f32x4*)(rope + ((size_t)pos * 128 + cw) * 2);
                    f32x4 o1[2], o2[2];
#pragma unroll
                    for (int n = 0; n < 2; ++n) { const f32x4 c01 = cs[2 * n], c23 = cs[2 * n + 1]; const f32x4 x1 = acc[ai][0][m][n], x2 = acc[ai][1][m][n];
                        const float co[4] = {c01[0], c01[2], c23[0], c23[2]}, si[4] = {c01[1], c01[3], c23[1], c23[3]};
#pragma unroll
                        for (int j = 0; j < 4; ++j) { o1[n][j] = (x1[j] * co[j] - x2[j] * si[j]) * sc; o2[n][j] = (x1[j] * si[j] + x2[j] * co[j]) * sc; } }
                    bf16_t* rp = dst + (size_t)row * 1024;
                    *(u32x4*)rp = pack8(o1[0], o1[1]); *(u32x4*)(rp + 128) = pack8(o2[0], o2[1]); asm volatile("" ::: "memory"); }
        } else if (pn < 12) { store_tile_bf16<0>(acc, rv, 1024, row0, (pn - 8) * 256 + cw, 1.f);
        } else if (pn < 16) { store_tile_bf16<2>(acc, rg, 1024, row0, (pn - 12) * 256 + cw, 1.f);
        } else if (pn < 20) { store_tile_bf16<1>(acc, gu, 1024, row0, (pn - 16) * 256 + cw, 1.f);
        } else if (pn < 24) {
            const int t4 = pn - 20; bf16_t* dst = gv + t4 * 256 + cw;
#pragma unroll
            for (int ai = 0; ai < 2; ++ai)
#pragma unroll
                for (int m = 0; m < 4; ++m) { const int row = row0 + ai * HALF + m * 16; float s = 0.f, q = 0.f;
#pragma unroll
                    for (int bj = 0; bj < 2; ++bj) { const f32x4 v0 = act4<1>(acc[ai][bj][m][0]), v1 = act4<1>(acc[ai][bj][m][1]);
                        *(u32x4*)(dst + (size_t)row * 1024 + bj * HALF) = pack8(v0, v1);
#pragma unroll
                        for (int j = 0; j < 4; ++j) { s += v0[j] + v1[j]; q += v0[j] * v0[j] + v1[j] * v1[j]; } }
                    { const int ln = fq * 16 + fr; s += shx(s, 16, ln); s += shx(s, 32, ln); q += shx(q, 16, ln); q += shx(q, 32, ln); }
                    if (fq == 0) *(f32x2*)(gvstats + ((size_t)row * 16 + t4 * 4 + wc) * 2) = (f32x2){s, q}; asm volatile("" ::: "memory"); }
        } else if (pn < 28) { store_tile_bf16<0>(acc, dq, 1024, row0, (pn - 24) * 256 + cw, 1.f);
        } else if (pn == 28) {
#pragma unroll
            for (int ai = 0; ai < 2; ++ai)
#pragma unroll
                for (int m = 0; m < 4; ++m) { float* rp = dcraw + (size_t)(row0 + ai * HALF + m * 16) * 256 + cw;
#pragma unroll
                    for (int bj = 0; bj < 2; ++bj) { *(f32x4*)(rp + bj * HALF) = acc[ai][bj][m][0]; *(f32x4*)(rp + bj * HALF + 4) = acc[ai][bj][m][1]; } }
        } else if (pn < 31) { store_tile_bf16<0>(acc, iq, 512, row0, (pn - 29) * 256 + cw, 1.f);
        } else if (pn == 31) {
#pragma unroll
            for (int ai = 0; ai < 2; ++ai)
#pragma unroll
                for (int m = 0; m < 4; ++m) { const int row = row0 + ai * HALF + m * 16;
                    if (wc < 2) *(u32x4*)(ik + (size_t)row * 64 + cw) = pack8(acc[ai][0][m][0], acc[ai][0][m][1]);
                    if (wc == 2 && fq == 0) { *(f32x4*)(iw + (size_t)row * 8) = acc[ai][0][m][0] * 0.35355339059f; *(f32x4*)(iw + (size_t)row * 8 + 4) = acc[ai][0][m][1] * 0.35355339059f; } }
        } else { const int gi = (pn - 32) >> 3; bf16_t* dst = gi == 0 ? ga : (gi == 1 ? gb : gc);
            store_tile_bf16<3>(acc, dst, 2048, row0, ((pn - 32) & 7) * 256 + cw, 1.f); }
    }
};
struct EpiBranch {
    static constexpr bool PERM = true;
    const bf16_t* gate; bf16_t* merged; int first;
    __device__ __forceinline__ void operator()(AccT acc, const Unit& u, int wr, int wc, int fr, int fq) const {
        const int row0 = u.pm * BM + wr * 64 + fr, colb = u.pn * BM + wc * 32 + 8 * fq;
#pragma unroll
        for (int ai = 0; ai < 2; ++ai)
#pragma unroll
            for (int m = 0; m < 4; ++m) { const size_t ro = (size_t)(row0 + ai * HALF + m * 16) * 2048 + colb;
#pragma unroll
                for (int bj = 0; bj < 2; ++bj) { float g8[8], m8[8]; unpack8(*(const u32x4*)(gate + ro + bj * HALF), g8);
                    if (!first) unpack8(*(const u32x4*)(merged + ro + bj * HALF), m8); else {
#pragma unroll
                        for (int j = 0; j < 8; ++j) m8[j] = 0.f; }
                    const f32x4 a0 = acc[ai][bj][m][0], a1 = acc[ai][bj][m][1];
                    f32x4 r0, r1;
#pragma unroll
                    for (int j = 0; j < 4; ++j) { r0[j] = m8[j] + g8[j] * a0[j]; r1[j] = m8[4 + j] + g8[4 + j] * a1[j]; }
                    *(u32x4*)(merged + ro + bj * HALF) = pack8(r0, r1); } }
    }
};
struct EpiResid {
    static constexpr bool PERM = false;
    const float* xsrc; float* xdst;
    __device__ __forceinline__ void operator()(AccT acc, const Unit& u, int wr, int wc, int fr, int fq) const {
        const int row0 = u.pm * BM + wr * 64 + fr, col0 = u.pn * BM + wc * 32 + 4 * fq;
#pragma unroll
        for (int ai = 0; ai < 2; ++ai)
#pragma unroll
            for (int m = 0; m < 4; ++m) { const size_t ro = (size_t)(row0 + ai * HALF + m * 16) * DM + col0;
#pragma unroll
                for (int bj = 0; bj < 2; ++bj)
#pragma unroll
                    for (int n = 0; n < 2; ++n) { const size_t o = ro + bj * HALF + n * 16; *(f32x4*)(xdst + o) = *(const f32x4*)(xsrc + o) + acc[ai][bj][m][n]; } }
    }
};
struct EpiMoeUp {
    static constexpr bool PERM = true;
    bf16_t* hid;
    __device__ __forceinline__ void operator()(AccT acc, const Unit& u, int wr, int wc, int fr, int fq) const {
        const int row0 = u.pm * BM + wr * 64 + fr, colb = u.pn * 128 + wc * 32 + 8 * fq;
#pragma unroll
        for (int ai = 0; ai < 2; ++ai)
#pragma unroll
            for (int m = 0; m < 4; ++m) { f32x4 r0, r1; const f32x4 a0 = acc[ai][0][m][0], a1 = acc[ai][0][m][1], b0 = acc[ai][1][m][0], b1 = acc[ai][1][m][1];
#pragma unroll
                for (int j = 0; j < 4; ++j) { r0[j] = siluf_(a0[j]) * b0[j]; r1[j] = siluf_(a1[j]) * b1[j]; }
                *(u32x4*)(hid + (size_t)(row0 + ai * HALF + m * 16) * FF + colb) = pack8(r0, r1); }
    }
};
}

struct Args { const float* in[23]; float* out; unsigned char* ws; int ph_lo, ph_hi; };
enum { I_X = 0, I_NMIX, I_WIN, I_WRET, I_LNG, I_LNB, I_WS, I_BS, I_WGM, I_KVG, I_WUK, I_WUV, I_WDS, I_WOUT, I_NFFN, I_WGRP, I_BGRP, I_WEXP, I_BEXP, I_W1, I_W3, I_W2, I_FNG };
struct Ctx {
    LAS unsigned char* lds; volatile LAS int* misc; unsigned* ctl; unsigned char* ws;
    int tid, lane, wave, G, bid, gw, NGW;
    const float* const* in; float* out;
};
#define WSP(T_, off) ((T_*)(C.ws + (off)))
__device__ __forceinline__ void refresh(Ctx& C) { int t = threadIdx.x; asm volatile("" : "+v"(t)); C.tid = t; C.lane = t & 63;
    unsigned char* w = C.ws; asm volatile("" : "+s"(w)); C.ws = w; C.ctl = (unsigned*)w; }

__device__ __forceinline__ void ph_rope(const Ctx& C) {
    float* rope = WSP(float, WS_ROPE);
    const double r1 = 0.9305720409296989;
    for (int idx = C.bid * 512 + C.tid; idx < SEQ * 128; idx += C.G * 512) {
        const int pos = idx >> 7, i = idx & 127;
        double inv = 1.0, b = r1; int e = i;
        while (e) { if (e & 1) inv *= b; b *= b; e >>= 1; }
        const double ang = (double)pos * inv;
        const double n = __builtin_rint(ang * 0.15915494309189533577);
        const double x = ang - n * 6.283185307179586476925;
        const double x2 = x * x;
        double s = 0.0, c = 0.0;
#pragma unroll 1
        for (int k = 14; k >= 1; --k) { s = (s + 1.0) * (-x2 / (double)((2 * k) * (2 * k + 1))); c = (c + 1.0) * (-x2 / (double)((2 * k - 1) * (2 * k))); }
        s = (s + 1.0) * x; c = c + 1.0;
        *(f32x2*)(rope + (size_t)idx * 2) = (f32x2){(float)c, (float)s};
    }
}

template <class Map>
__device__ __forceinline__ void tr_item(const float* W, long srcld, bf16_t* WT, long dstld, int k0, int n0, LAS float* scr, int lane, const Map& map) {
    const int nn = n0 + (lane & 31); const long sc = map(nn);
#pragma unroll 8
    for (int i = 0; i < 32; ++i) { const int kk = 2 * i + (lane >> 5); scr[kk * 33 + (lane & 31)] = sc >= 0 ? W[(size_t)(k0 + kk) * srcld + sc] : 0.f; }
    asm volatile("s_waitcnt lgkmcnt(0)" ::: "memory");
    const int c = lane & 7;
#pragma unroll
    for (int j = 0; j < 4; ++j) { const int n = (lane >> 3) + 8 * j; const LAS float* s = scr + (8 * c) * 33 + n;
        u32x4 o; o.x = cvt_pk_bf16(s[0 * 33], s[1 * 33]); o.y = cvt_pk_bf16(s[2 * 33], s[3 * 33]); o.z = cvt_pk_bf16(s[4 * 33], s[5 * 33]); o.w = cvt_pk_bf16(s[6 * 33], s[7 * 33]);
        *(u32x4*)(WT + (size_t)(n0 + n) * dstld + k0 + 8 * c) = o; }
    asm volatile("s_waitcnt lgkmcnt(0)" ::: "memory");
}
struct MapId { __device__ long operator()(int n) const { return n; } };
struct MapIn { __device__ long operator()(int n) const { return n < GATE_SRC0 ? n : (n < GATE_DST0 ? -1 : n - (GATE_DST0 - GATE_SRC0)); } };
struct MapOff { long off; __device__ long operator()(int n) const { return n + off; } };

__device__ __forceinline__ void ph_weights(const Ctx& C, int l) {
    LAS float* scr = (LAS float*)(C.lds + C.wave * 16384);
    unsigned char* wb = C.ws + WS_W;
    constexpr int N_IN = 32 * 448, N_BR = 16 * 64, N_OUT = 32 * 64, N_13 = 32 * 32 * 32, N_2 = 32 * 8 * 64, N_UV = 8 * 16;
    constexpr int NITEMS = N_IN + 3 * N_BR + N_OUT + N_13 + N_2 + N_UV;
    for (int it = C.gw; it < NITEMS; it += C.NGW) {
        int r = it;
        if (r < N_IN) { const int kb = r / 448, nb = r % 448; tr_item(C.in[I_WIN] + (size_t)l * DM * INW, INW, (bf16_t*)(wb + W_IN), DM, kb * 64, nb * 32, scr, C.lane, MapIn{}); continue; } r -= N_IN;
        if (r < 3 * N_BR) { const int w = r / N_BR, q = r % N_BR, kb = q / 64, nb = q % 64; const float* src = C.in[w == 0 ? I_WRET : (w == 1 ? I_WGM : I_WDS)] + (size_t)l * 1024 * DM;
            tr_item(src, DM, (bf16_t*)(wb + (w == 0 ? W_RET : (w == 1 ? W_GM : W_DS))), 1024, kb * 64, nb * 32, scr, C.lane, MapId{}); continue; } r -= 3 * N_BR;
        if (r < N_OUT) { const int kb = r / 64, nb = r % 64; tr_item(C.in[I_WOUT] + (size_t)l * DM * DM, DM, (bf16_t*)(wb + W_OUT), DM, kb * 64, nb * 32, scr, C.lane, MapId{}); continue; } r -= N_OUT;
        if (r < N_13) { const int e = r / 1024, q = r % 1024, kb = q / 32, nb = q % 32;
            const int row0 = nb * 32, j = row0 >> 8, s = (row0 >> 7) & 1, fp = row0 & 127;
            const float* src = C.in[s ? I_W3 : I_W1] + ((size_t)l * NEXP + e) * DM * FF;
            tr_item(src, FF, (bf16_t*)(wb + W_13) + (size_t)e * 1024 * DM, DM, kb * 64, row0, scr, C.lane, MapOff{(long)(128 * j + fp) - row0}); continue; } r -= N_13;
        if (r < N_2) { const int e = r / 512, q = r % 512, kb = q / 64, nb = q % 64;
            tr_item(C.in[I_W2] + ((size_t)l * NEXP + e) * FF * DM, DM, (bf16_t*)(wb + W_2) + (size_t)e * DM * FF, FF, kb * 64, nb * 32, scr, C.lane, MapId{}); continue; } r -= N_2;
        { const int h = r / 16, q = r % 16, kb = q / 4, nb = q % 4;
            tr_item(C.in[I_WUV] + ((size_t)l * 8 + h) * 256 * 128, 128, (bf16_t*)(wb + W_UV) + (size_t)(h * 128) * 512 + (h & 1) * 256, 512, kb * 64, nb * 32, scr, C.lane, MapId{}); }
    }
    bf16_t* uv = (bf16_t*)(wb + W_UV); bf16_t* uk = (bf16_t*)(wb + W_UK); const float* wuk = C.in[I_WUK] + (size_t)l * 8 * 256 * 128;
    for (int idx = C.bid * 512 + C.tid; idx < 1024 * 256 / 8; idx += C.G * 512) { const int row = idx >> 5, c8 = (idx & 31) * 8, h = row >> 7;
        *(u32x4*)(uv + (size_t)row * 512 + (1 - (h & 1)) * 256 + c8) = (u32x4){0u, 0u, 0u, 0u}; }
    for (int idx = C.bid * 512 + C.tid; idx < 2048 * 256 / 8; idx += C.G * 512) { const int row = idx >> 5, c8 = (idx & 31) * 8, h = row >> 8, half = c8 >> 7;
        u32x4 o = (u32x4){0u, 0u, 0u, 0u};
        if (half == (h & 1)) { const float* s = wuk + (size_t)row * 128 + (c8 & 127); const f32x4 a = *(const f32x4*)s, b = *(const f32x4*)(s + 4); o = pack8(a, b); }
        *(u32x4*)(uk + (size_t)row * 256 + c8) = o; }
}

__device__ __forceinline__ void ph_norm(const Ctx& C, const float* x, const float* g, bf16_t* H) {
    for (int row = C.gw; row < T; row += C.NGW) {
        const f32x4* xr = (const f32x4*)(x + (size_t)row * DM) + C.lane; f32x4 v[8]; float ss = 0.f;
#pragma unroll
        for (int j = 0; j < 8; ++j) { v[j] = xr[64 * j]; ss += v[j][0] * v[j][0] + v[j][1] * v[j][1] + v[j][2] * v[j][2] + v[j][3] * v[j][3]; }
        const float rstd = rsqrtf(wave_sum(ss, C.lane) * (1.f / DM) + EPS);
        u32x2* o = (u32x2*)(H + (size_t)row * DM) + C.lane;
#pragma unroll
        for (int j = 0; j < 8; ++j) { const f32x4 gg = ((const f32x4*)g)[64 * j + C.lane]; const f32x4 y = v[j] * rstd * gg; u32x2 w; w.x = cvt_pk_bf16(y[0], y[1]); w.y = cvt_pk_bf16(y[2], y[3]); o[64 * j] = w; }
    }
}
__device__ __forceinline__ void ph_ckv(const Ctx& C, const float* dcraw, const float* g, bf16_t* ckv) {
    for (int row = C.gw; row < T; row += C.NGW) {
        const f32x4 v = ((const f32x4*)(dcraw + (size_t)row * 256))[C.lane];
        const float ss = wave_sum(v[0] * v[0] + v[1] * v[1] + v[2] * v[2] + v[3] * v[3], C.lane);
        const float rstd = rsqrtf(ss * (1.f / 256.f) + EPS); const f32x4 y = v * rstd * ((const f32x4*)g)[C.lane];
        u32x2 w; w.x = cvt_pk_bf16(y[0], y[1]); w.y = cvt_pk_bf16(y[2], y[3]); ((u32x2*)(ckv + (size_t)row * 256))[C.lane] = w;
    }
}

__device__ __forceinline__ void ph_gmlp_naive(const Ctx& C, int l) {
    const bf16_t* gu = WSP(bf16_t, WS_PROJ + P_GU); const bf16_t* gv = WSP(bf16_t, WS_PROJ + P_GV); const float* stats = WSP(float, WS_STATS); bf16_t* gm = WSP(bf16_t, WS_GM);
    const float* lng = C.in[I_LNG] + l * 1024; const float* lnb = C.in[I_LNB] + l * 1024; const float* Wsp = C.in[I_WS] + (size_t)l * 4 * 128 * 128; const float* bs = C.in[I_BS] + l * 4 * 128;
    LAS float* smean = (LAS float*)C.lds; LAS float* srstd = smean + 128; LAS float* lv = srstd + 128;
    for (int u = C.bid; u < 512; u += C.G) {
        const int g = u & 3, bn = u >> 2, t0 = bn * 128;
        __syncthreads();
        if (C.tid < 128) { const float* sp = stats + (size_t)(t0 + C.tid) * 32; float s = 0.f, q = 0.f;
            for (int k = 0; k < 16; ++k) { s += sp[2 * k]; q += sp[2 * k + 1]; }
            const float mean = s * (1.f / 1024.f), var = q * (1.f / 1024.f) - mean * mean; smean[C.tid] = mean; srstd[C.tid] = rsqrtf(var + EPS); }
        __syncthreads();
        for (int idx = C.tid; idx < 128 * 256; idx += 512) { const int j = idx >> 8, c = idx & 255, ch = g * 256 + c;
            lv[idx] = (bf2f(gv[(size_t)(t0 + j) * 1024 + ch]) - smean[j]) * srstd[j] * lng[ch] + lnb[ch]; }
        __syncthreads();
        for (int idx = C.tid; idx < 128 * 256; idx += 512) { const int i = idx >> 8, c = idx & 255; const float* wr = Wsp + ((size_t)g * 128 + i) * 128; float a = 0.f;
            for (int j = 0; j <= i; ++j) a += wr[j] * lv[j * 256 + c];
            a += bs[g * 128 + i];
            const size_t o = (size_t)(t0 + i) * 1024 + g * 256 + c; gm[o] = (bf16_t)f2bf(bf2f(gu[o]) * a); }
    }
}
__device__ __forceinline__ void ph_ret_naive(const Ctx& C) {
    const bf16_t* rq = WSP(bf16_t, WS_PROJ + P_RQ); const bf16_t* rk = WSP(bf16_t, WS_PROJ + P_RK); const bf16_t* rv = WSP(bf16_t, WS_PROJ + P_RV); const bf16_t* rg = WSP(bf16_t, WS_PROJ + P_RG); bf16_t* ret = WSP(bf16_t, WS_RET);
    LAS float* sq = (LAS float*)C.lds; LAS float* sa = sq + 256; LAS float* red = sa + 4096;
    for (int u = C.bid; u < NB * 4 * SEQ; u += C.G) {
        const int t = (SEQ - 1) - (u / 16), bh = u % 16, b = bh >> 2, h = bh & 3; const size_t rowb = (size_t)b * SEQ;
        const float lg2 = log2f(1.0f - exp2f(-5.0f - (float)h));
        __syncthreads();
        if (C.tid < 256) sq[C.tid] = bf2f(rq[(rowb + t) * 1024 + h * 256 + C.tid]);
        __syncthreads();
        for (int s = C.tid; s <= t; s += 512) { const u32x4* kp = (const u32x4*)(rk + (rowb + s) * 1024 + h * 256); float a = 0.f;
            for (int d8 = 0; d8 < 32; ++d8) { float f[8]; unpack8(kp[d8], f);
#pragma unroll
                for (int j = 0; j < 8; ++j) a += sq[d8 * 8 + j] * f[j]; }
            sa[s] = a * exp2f(lg2 * (float)(t - s)); }
        __syncthreads();
        float o = 0.f;
        if (C.tid < 256) { const bf16_t* vp = rv + rowb * 1024 + h * 256 + C.tid; for (int s = 0; s <= t; ++s) o += sa[s] * bf2f(vp[(size_t)s * 1024]); }
        const float ss = wave_sum(o * o, C.lane); if (C.lane == 0) red[C.wave] = ss;
        __syncthreads();
        if (C.tid < 256) { const float tot = red[0] + red[1] + red[2] + red[3]; const float y = o * rsqrtf(tot * (1.f / 256.f) + EPS);
            const size_t oi = (rowb + t) * 1024 + h * 256 + C.tid; ret[oi] = (bf16_t)f2bf(bf2f(rg[oi]) * y); }
    }
}
__device__ __forceinline__ void ph_idx_naive(const Ctx& C) {
    const bf16_t* iq = WSP(bf16_t, WS_PROJ + P_IQ); const bf16_t* ik = WSP(bf16_t, WS_PROJ + P_IK); const float* iw = WSP(float, WS_PROJ + P_IW); unsigned short* sel = WSP(unsigned short, WS_SEL);
    LAS float* sq = (LAS float*)C.lds; LAS float* sw = sq + 512; LAS float* sc = sw + 8;
    for (int u = C.bid; u < T; u += C.G) {
        const int tq = (T - 1) - u; const int b = tq >> 12, q = tq & (SEQ - 1), n = q + 1;
        __syncthreads();
        sq[C.tid] = bf2f(iq[(size_t)tq * 512 + C.tid]); if (C.tid < 8) sw[C.tid] = iw[(size_t)tq * 8 + C.tid];
        for (int r = C.tid; r < 256; r += 512) sel[(size_t)tq * 256 + r] = 0xFFFFu;
        __syncthreads();
        for (int s = C.tid; s < n; s += 512) { const u32x4* kp = (const u32x4*)(ik + ((size_t)b * SEQ + s) * 64); float kf[64];
#pragma unroll
            for (int d8 = 0; d8 < 8; ++d8) { float f[8]; unpack8(kp[d8], f);
#pragma unroll
                for (int j = 0; j < 8; ++j) kf[d8 * 8 + j] = f[j]; }
            float score = 0.f;
#pragma unroll 1
            for (int h = 0; h < 8; ++h) { float a = 0.f;
#pragma unroll
                for (int d = 0; d < 64; ++d) a += sq[h * 64 + d] * kf[d];
                score += sw[h] * fmaxf(a * 0.125f, 0.f); }
            sc[s] = score; }
        __syncthreads();
        for (int s = C.tid; s < n; s += 512) { const float v = sc[s]; int rank = 0;
            for (int s2 = 0; s2 < n; ++s2) { const float w = sc[s2]; rank += (w > v || (w == v && s2 < s)) ? 1 : 0; }
            if (rank < 256) sel[(size_t)tq * 256 + rank] = (unsigned short)s; }
    }
}
__device__ __forceinline__ void ph_att_naive(const Ctx& C) {
    const bf16_t* qabs = WSP(bf16_t, WS_QABS); const bf16_t* ckv = WSP(bf16_t, WS_CKV); const unsigned short* sel = WSP(unsigned short, WS_SEL); bf16_t* olat = WSP(bf16_t, WS_OLAT);
    LAS float* sqa = (LAS float*)C.lds; LAS float* sp = sqa + 2048; LAS int* ssel = (LAS int*)(sp + 2048);
    for (int tq = C.bid; tq < T; tq += C.G) {
        const int b = tq >> 12, q = tq & (SEQ - 1);
        __syncthreads();
        for (int i = C.tid; i < 2048; i += 512) sqa[i] = bf2f(qabs[(size_t)tq * 2048 + i]);
        if (C.tid < 256) { const int s = sel[(size_t)tq * 256 + C.tid]; ssel[C.tid] = (s <= q) ? s : -1; }
        __syncthreads();
        const int h = C.wave; float sv[4]; float mx = -INFINITY;
#pragma unroll
        for (int j = 0; j < 4; ++j) { const int k = C.lane + 64 * j, s = ssel[k]; float a = -INFINITY;
            if (s >= 0) { const u32x4* cp = (const u32x4*)(ckv + ((size_t)b * SEQ + s) * 256); a = 0.f;
                for (int c8 = 0; c8 < 32; ++c8) { float f[8]; unpack8(cp[c8], f);
#pragma unroll
                    for (int jj = 0; jj < 8; ++jj) a += sqa[h * 256 + c8 * 8 + jj] * f[jj]; } }
            sv[j] = a; mx = fmaxf(mx, a); }
        mx = wave_max(mx, C.lane); float sum = 0.f;
#pragma unroll
        for (int j = 0; j < 4; ++j) { sv[j] = __expf(sv[j] - mx); sum += sv[j]; }
        sum = wave_sum(sum, C.lane); const float inv = 1.f / sum;
#pragma unroll
        for (int j = 0; j < 4; ++j) sp[h * 256 + C.lane + 64 * j] = sv[j] * inv;
        __syncthreads();
        float o[4] = {0.f, 0.f, 0.f, 0.f};
        for (int k = 0; k < 256; ++k) { const int s = ssel[k]; if (s < 0) continue; const float p = sp[h * 256 + k]; const bf16_t* cp = ckv + ((size_t)b * SEQ + s) * 256 + C.lane;
#pragma unroll
            for (int j = 0; j < 4; ++j) o[j] += p * bf2f(cp[64 * j]); }
#pragma unroll
        for (int j = 0; j < 4; ++j) olat[(size_t)tq * 2048 + h * 256 + C.lane + 64 * j] = (bf16_t)f2bf(o[j]);
    }
}

typedef short v4i16_t __attribute__((ext_vector_type(4)));
__device__ __forceinline__ s16x4 tr_read(const LAS unsigned char* p) { return __builtin_bit_cast(s16x4, __builtin_amdgcn_ds_read_tr16_b64_v4i16((LAS v4i16_t*)p)); }
__device__ __forceinline__ bf16x8 tr_frag(const LAS unsigned char* X, int LDX, int rowA, int rowB, int n0, int lane) {
    const int q = (lane & 15) >> 2, p = lane & 3;
    const s16x4 lo = tr_read(X + (rowA + q) * LDX + (n0 + 4 * p) * 2), hi = tr_read(X + (rowB + q) * LDX + (n0 + 4 * p) * 2);
    return (bf16x8){lo[0], lo[1], lo[2], lo[3], hi[0], hi[1], hi[2], hi[3]};
}
constexpr int TLD = 544;
__device__ __forceinline__ bf16x8 as_bf16x8(u32x4 w) { return __builtin_bit_cast(bf16x8, w); }

__device__ __forceinline__ void ph_ret_kv(const Ctx& C) {
    const bf16_t* rk = WSP(bf16_t, WS_PROJ + P_RK); const bf16_t* rv = WSP(bf16_t, WS_PROJ + P_RV); bf16_t* KV = WSP(bf16_t, WS_KV);
    const LAS unsigned char* Vt = C.lds; const LAS unsigned char* Kt = C.lds + 128 * TLD;
    const int g = C.lane >> 4, fr = C.lane & 15, wr = C.wave >> 2, wc = C.wave & 3;
    for (int u = C.bid; u < 512; u += C.G) {
        const int n = u & 31, h = (u >> 5) & 3, b = u >> 7; const size_t row0 = (size_t)b * SEQ + n * 128;
        const float lg2 = log2f(1.0f - exp2f(-5.0f - (float)h));
        __syncthreads();
#pragma unroll
        for (int p = 0; p < 8; ++p) { const int idx = p * 512 + C.tid, row = idx >> 5, ch = idx & 31; const size_t go = (row0 + row) * 1024 + h * 256 + ch * 8;
            const u32x4 vv = *(const u32x4*)(rv + go); *(LAS u32x4*)(C.lds + row * TLD + ch * 16) = vv;
            float f[8]; unpack8(*(const u32x4*)(rk + go), f); const float z = exp2f(lg2 * (float)(127 - row));
            *(LAS u32x4*)(C.lds + 128 * TLD + row * TLD + ch * 16) = pack8((f32x4){f[0] * z, f[1] * z, f[2] * z, f[3] * z}, (f32x4){f[4] * z, f[5] * z, f[6] * z, f[7] * z}); }
        __syncthreads();
        f32x4 acc[8][4];
#pragma unroll
        for (int m = 0; m < 8; ++m)
#pragma unroll
            for (int nn = 0; nn < 4; ++nn) acc[m][nn] = (f32x4){0.f, 0.f, 0.f, 0.f};
#pragma unroll 1
        for (int ks = 0; ks < 4; ++ks) { bf16x8 Bv[4];
#pragma unroll
            for (int nn = 0; nn < 4; ++nn) Bv[nn] = tr_frag(Vt, TLD, 32 * ks + 8 * g, 32 * ks + 8 * g + 4, 64 * wc + 16 * nn, C.lane);
#pragma unroll
            for (int m = 0; m < 8; ++m) { const bf16x8 Ak = tr_frag(Kt, TLD, 32 * ks + 8 * g, 32 * ks + 8 * g + 4, 128 * wr + 16 * m, C.lane);
#pragma unroll
                for (int nn = 0; nn < 4; ++nn) acc[m][nn] = __builtin_amdgcn_mfma_f32_16x16x32_bf16(Ak, Bv[nn], acc[m][nn], 0, 0, 0); } }
        bf16_t* out = KV + (size_t)u * 65536;
#pragma unroll
        for (int m = 0; m < 8; ++m)
#pragma unroll
            for (int nn = 0; nn < 4; ++nn) { const int e = 64 * wc + 16 * nn + fr, d = 128 * wr + 16 * m + 4 * g; u32x2 w; w.x = cvt_pk_bf16(acc[m][nn][0], acc[m][nn][1]); w.y = cvt_pk_bf16(acc[m][nn][2], acc[m][nn][3]);
                *(u32x2*)(out + e * 256 + d) = w; }
    }
}
__device__ __forceinline__ void ph_ret_scan(const Ctx& C) {
    const bf16_t* KV = WSP(bf16_t, WS_KV); bf16_t* Rb = WSP(bf16_t, WS_R);
    for (int idx = C.bid * 512 + C.tid; idx < 16 * 8192; idx += C.G * 512) {
        const int bh = idx >> 13, off = (idx & 8191) * 8, h = bh & 3; const float gc = exp2f(128.0f * log2f(1.0f - exp2f(-5.0f - (float)h)));
        float R[8] = {0.f, 0.f, 0.f, 0.f, 0.f, 0.f, 0.f, 0.f};
#pragma unroll 4
        for (int n = 0; n < 32; ++n) { const size_t o = ((size_t)bh * 32 + n) * 65536 + off;
            *(u32x4*)(Rb + o) = pack8((f32x4){R[0], R[1], R[2], R[3]}, (f32x4){R[4], R[5], R[6], R[7]});
            float f[8]; unpack8(*(const u32x4*)(KV + o), f);
#pragma unroll
            for (int j = 0; j < 8; ++j) R[j] = R[j] * gc + f[j]; }
    }
}
__device__ __forceinline__ void ph_ret_out(const Ctx& C) {
    const bf16_t* rq = WSP(bf16_t, WS_PROJ + P_RQ); const bf16_t* rk = WSP(bf16_t, WS_PROJ + P_RK); const bf16_t* rv = WSP(bf16_t, WS_PROJ + P_RV); const bf16_t* rg = WSP(bf16_t, WS_PROJ + P_RG);
    const bf16_t* Rb = WSP(bf16_t, WS_R); bf16_t* ret = WSP(bf16_t, WS_RET);
    const LAS unsigned char* Vt = C.lds;
    const int g = C.lane >> 4, fr = C.lane & 15, w = C.wave;
    for (int u = C.bid; u < 512; u += C.G) {
        const int n = u & 31, h = (u >> 5) & 3, b = u >> 7; const size_t row0 = (size_t)b * SEQ + n * 128;
        const float lg2 = log2f(1.0f - exp2f(-5.0f - (float)h));
        __syncthreads();
#pragma unroll
        for (int p = 0; p < 8; ++p) { const int idx = p * 512 + C.tid, row = idx >> 5, ch = idx & 31;
            *(LAS u32x4*)(C.lds + row * TLD + ch * 16) = *(const u32x4*)(rv + (row0 + row) * 1024 + h * 256 + ch * 8); }
        __syncthreads();
        const int i = 16 * w + fr;
        bf16x8 Bq[8];
        { const bf16_t* qp = rq + (row0 + i) * 1024 + h * 256 + 8 * g;
#pragma unroll
          for (int ks = 0; ks < 8; ++ks) Bq[ks] = as_bf16x8(*(const u32x4*)(qp + 32 * ks)); }
        f32x4 acc[16];
#pragma unroll
        for (int nt = 0; nt < 16; ++nt) acc[nt] = (f32x4){0.f, 0.f, 0.f, 0.f};
        if (n > 0) {
            const bf16_t* rp = Rb + (size_t)u * 65536 + (size_t)fr * 256 + 8 * g;
#pragma unroll
            for (int ks = 0; ks < 8; ++ks)
#pragma unroll
                for (int nt = 0; nt < 16; ++nt) { const bf16x8 Ar = as_bf16x8(*(const u32x4*)(rp + nt * 16 * 256 + 32 * ks)); acc[nt] = __builtin_amdgcn_mfma_f32_16x16x32_bf16(Ar, Bq[ks], acc[nt], 0, 0, 0); }
            const float xi = exp2f(lg2 * (float)(i + 1));
#pragma unroll
            for (int nt = 0; nt < 16; ++nt) acc[nt] = acc[nt] * xi;
        }
        f32x4 ST[8];
#pragma unroll
        for (int jt = 0; jt < 8; ++jt) { ST[jt] = (f32x4){0.f, 0.f, 0.f, 0.f};
            if (jt <= w) { const bf16_t* kp = rk + (row0 + 16 * jt + fr) * 1024 + h * 256 + 8 * g;
#pragma unroll
                for (int ks = 0; ks < 8; ++ks) { const bf16x8 Ak = as_bf16x8(*(const u32x4*)(kp + 32 * ks)); ST[jt] = __builtin_amdgcn_mfma_f32_16x16x32_bf16(Ak, Bq[ks], ST[jt], 0, 0, 0); }
#pragma unroll
                for (int r = 0; r < 4; ++r) { const int j = 16 * jt + 4 * g + r; ST[jt][r] = (i >= j) ? ST[jt][r] * exp2f(lg2 * (float)(i - j)) : 0.f; } } }
#pragma unroll
        for (int t = 0; t < 4; ++t) if (2 * t <= w) {
            u32x4 sw; sw.x = cvt_pk_bf16(ST[2 * t][0], ST[2 * t][1]); sw.y = cvt_pk_bf16(ST[2 * t][2], ST[2 * t][3]); sw.z = cvt_pk_bf16(ST[2 * t + 1][0], ST[2 * t + 1][1]); sw.w = cvt_pk_bf16(ST[2 * t + 1][2], ST[2 * t + 1][3]);
            const bf16x8 Bs = as_bf16x8(sw);
#pragma unroll
            for (int nt = 0; nt < 16; ++nt) { const bf16x8 Av = tr_frag(Vt, TLD, 32 * t + 4 * g, 32 * t + 16 + 4 * g, 16 * nt, C.lane); acc[nt] = __builtin_amdgcn_mfma_f32_16x16x32_bf16(Av, Bs, acc[nt], 0, 0, 0); } }
        float ss = 0.f;
#pragma unroll
        for (int nt = 0; nt < 16; ++nt) ss += acc[nt][0] * acc[nt][0] + acc[nt][1] * acc[nt][1] + acc[nt][2] * acc[nt][2] + acc[nt][3] * acc[nt][3];
        ss += shx(ss, 16, C.lane); ss += shx(ss, 32, C.lane);
        const float rstd = rsqrtf(ss * (1.f / 256.f) + EPS);
        const size_t ob = (row0 + i) * 1024 + h * 256 + 4 * g;
#pragma unroll
        for (int nt = 0; nt < 16; ++nt) { const u32x2 gw = *(const u32x2*)(rg + ob + 16 * nt); u32x2 o;
            o.x = cvt_pk_bf16(acc[nt][0] * rstd * bf2f(gw.x), acc[nt][1] * rstd * bf2f(gw.x >> 16)); o.y = cvt_pk_bf16(acc[nt][2] * rstd * bf2f(gw.y), acc[nt][3] * rstd * bf2f(gw.y >> 16));
            *(u32x2*)(ret + ob + 16 * nt) = o; }
    }
}
__device__ __forceinline__ void ph_gmlp(const Ctx& C, int l) {
    const bf16_t* gu = WSP(bf16_t, WS_PROJ + P_GU); const bf16_t* gv = WSP(bf16_t, WS_PROJ + P_GV); const float* stats = WSP(float, WS_STATS); bf16_t* gm = WSP(bf16_t, WS_GM);
    const float* lng = C.in[I_LNG] + l * 1024; const float* lnb = C.in[I_LNB] + l * 1024; const float* Wsp = C.in[I_WS] + (size_t)l * 4 * 128 * 128; const float* bs = C.in[I_BS] + l * 4 * 128;
    constexpr int WLD = 272, W_OFF = 128 * TLD, ST_OFF = W_OFF + 128 * WLD;
    const LAS unsigned char* Lt = C.lds; LAS float* sst = (LAS float*)(C.lds + ST_OFF);
    const int g4 = C.lane >> 4, fr = C.lane & 15, w = C.wave;
    for (int u = C.bid; u < 512; u += C.G) {
        const int gg = u & 3, bn = u >> 2, t0 = bn * 128;
        __syncthreads();
        if (C.tid < 128) { const float* sp = stats + (size_t)(t0 + C.tid) * 32; float s = 0.f, q = 0.f;
#pragma unroll
            for (int k = 0; k < 16; ++k) { s += sp[2 * k]; q += sp[2 * k + 1]; }
            const float mean = s * (1.f / 1024.f), var = q * (1.f / 1024.f) - mean * mean; sst[2 * C.tid] = mean; sst[2 * C.tid + 1] = rsqrtf(var + EPS); }
#pragma unroll
        for (int p = 0; p < 4; ++p) { const int idx = p * 512 + C.tid, i = idx >> 4, j8 = (idx & 15) * 8; const float* wp = Wsp + ((size_t)gg * 128 + i) * 128 + j8;
            f32x4 a = *(const f32x4*)wp, b2 = *(const f32x4*)(wp + 4);
#pragma unroll
            for (int j = 0; j < 4; ++j) { if (j8 + j > i) a[j] = 0.f; if (j8 + 4 + j > i) b2[j] = 0.f; }
            *(LAS u32x4*)(C.lds + W_OFF + i * WLD + j8 * 2) = pack8(a, b2); }
        __syncthreads();
#pragma unroll
        for (int p = 0; p < 8; ++p) { const int idx = p * 512 + C.tid, row = idx >> 5, ch = idx & 31, cg = gg * 256 + ch * 8;
            float f[8]; unpack8(*(const u32x4*)(gv + (size_t)(t0 + row) * 1024 + cg), f); const float mean = sst[2 * row], rstd = sst[2 * row + 1];
            const f32x4 g0 = *(const f32x4*)(lng + cg), g1 = *(const f32x4*)(lng + cg + 4), b0 = *(const f32x4*)(lnb + cg), b1 = *(const f32x4*)(lnb + cg + 4);
            f32x4 y0, y1;
#pragma unroll
            for (int j = 0; j < 4; ++j) { y0[j] = (f[j] - mean) * rstd * g0[j] + b0[j]; y1[j] = (f[4 + j] - mean) * rstd * g1[j] + b1[j]; }
            *(LAS u32x4*)(C.lds + row * TLD + ch * 16) = pack8(y0, y1); }
        __syncthreads();
        f32x4 acc[16];
#pragma unroll
        for (int nt = 0; nt < 16; ++nt) acc[nt] = (f32x4){0.f, 0.f, 0.f, 0.f};
#pragma unroll
        for (int ks = 0; ks < 4; ++ks) if (2 * ks <= w) {
            const bf16x8 Bw = as_bf16x8(*(const LAS u32x4*)(C.lds + W_OFF + (16 * w + fr) * WLD + (32 * ks + 8 * g4) * 2));
#pragma unroll
            for (int nt = 0; nt < 16; ++nt) { const bf16x8 Av = tr_frag(Lt, TLD, 32 * ks + 8 * g4, 32 * ks + 8 * g4 + 4, 16 * nt, C.lane); acc[nt] = __builtin_amdgcn_mfma_f32_16x16x32_bf16(Av, Bw, acc[nt], 0, 0, 0); } }
        const int i = 16 * w + fr; const float bias = bs[gg * 128 + i]; const size_t ob = (size_t)(t0 + i) * 1024 + gg * 256 + 4 * g4;
#pragma unroll
        for (int nt = 0; nt < 16; ++nt) { const u32x2 uw = *(const u32x2*)(gu + ob + 16 * nt); u32x2 o;
            o.x = cvt_pk_bf16((acc[nt][0] + bias) * bf2f(uw.x), (acc[nt][1] + bias) * bf2f(uw.x >> 16)); o.y = cvt_pk_bf16((acc[nt][2] + bias) * bf2f(uw.y), (acc[nt][3] + bias) * bf2f(uw.y >> 16));
            *(u32x2*)(gm + ob + 16 * nt) = o; }
    }
}

__device__ __forceinline__ void ph_idx(const Ctx& C) {
    const bf16_t* iq = WSP(bf16_t, WS_PROJ + P_IQ); const bf16_t* ik = WSP(bf16_t, WS_PROJ + P_IK); const float* iw = WSP(float, WS_PROJ + P_IW); unsigned short* sel = WSP(unsigned short, WS_SEL);
    LAS unsigned* sc = (LAS unsigned*)C.lds;
    const int lane = C.lane, n32 = lane & 31, hh = lane >> 5, w = C.wave;
    for (int u = C.bid; u < T / 8; u += C.G) {
        const int b = u & 3, q0 = (SEQ / 8 - 1 - (u >> 2)) * 8, tq0 = b * SEQ + q0, nk = q0 + 8, nkt = (nk + 31) >> 5;
        __syncthreads();
        bf16x8 Aq[2][4]; float wq[2][16];
        { const int r = n32, qi = 2 * ((r >> 2) & 1) + (r >> 4), hd = (r & 3) + 4 * ((r >> 3) & 1);
#pragma unroll
          for (int mt = 0; mt < 2; ++mt) { const bf16_t* qp = iq + (size_t)(tq0 + 4 * mt + qi) * 512 + hd * 64 + 8 * hh;
#pragma unroll
              for (int ks = 0; ks < 4; ++ks) Aq[mt][ks] = as_bf16x8(*(const u32x4*)(qp + 16 * ks));
#pragma unroll
              for (int a = 0; a < 2; ++a) { const float* wp = iw + (size_t)(tq0 + 4 * mt + 2 * hh + a) * 8; const f32x4 w0 = *(const f32x4*)wp, w1 = *(const f32x4*)(wp + 4);
#pragma unroll
                  for (int j = 0; j < 4; ++j) { wq[mt][8 * a + j] = w0[j] * 0.125f; wq[mt][8 * a + 4 + j] = w1[j] * 0.125f; } } } }
        u32x4 Bn[4];
        { const bf16_t* kp = ik + ((size_t)b * SEQ + 32 * (w < nkt ? w : 0) + n32) * 64 + 8 * hh;
#pragma unroll
          for (int ks = 0; ks < 4; ++ks) Bn[ks] = *(const u32x4*)(kp + 16 * ks); }
        for (int kt = w; kt < nkt; kt += 8) {
            bf16x8 Bk[4];
#pragma unroll
            for (int ks = 0; ks < 4; ++ks) Bk[ks] = as_bf16x8(Bn[ks]);
            { const int k2 = (kt + 8 < nkt) ? kt + 8 : kt; const bf16_t* kp = ik + ((size_t)b * SEQ + 32 * k2 + n32) * 64 + 8 * hh;
#pragma unroll
              for (int ks = 0; ks < 4; ++ks) Bn[ks] = *(const u32x4*)(kp + 16 * ks); }
#pragma unroll
            for (int mt = 0; mt < 2; ++mt) { f32x16 acc;
#pragma unroll
                for (int j = 0; j < 16; ++j) acc[j] = 0.f;
#pragma unroll
                for (int ks = 0; ks < 4; ++ks) acc = __builtin_amdgcn_mfma_f32_32x32x16_bf16(Aq[mt][ks], Bk[ks], acc, 0, 0, 0);
#pragma unroll
                for (int a = 0; a < 2; ++a) { float s = 0.f;
#pragma unroll
                    for (int rr = 0; rr < 8; ++rr) s += wq[mt][8 * a + rr] * fmaxf(acc[8 * a + rr], 0.f);
                    const int qu = 4 * mt + 2 * hh + a, key = 32 * kt + n32; unsigned bits = __builtin_bit_cast(unsigned, s);
                    bits = (bits & 0x80000000u) ? ~bits : (bits | 0x80000000u);
                    sc[qu * 4096 + key] = (key <= q0 + qu) ? bits : 0u; } }
        }
        __syncthreads();
        { const int q = q0 + w, n = q + 1; const size_t so = (size_t)(tq0 + w) * 256;
          if (n <= 256) { for (int r = lane; r < 256; r += 64) sel[so + r] = (r < n) ? (unsigned short)r : (unsigned short)0xFFFFu; }
          else {
            unsigned uu[64];
#pragma unroll
            for (int i = 0; i < 64; ++i) uu[i] = (64 * i + lane < nkt * 32) ? sc[w * 4096 + 64 * i + lane] : 0u;
            unsigned Tv = 0u;
#pragma unroll 1
            for (int bit = 31; bit >= 0; --bit) { const unsigned cand = Tv | (1u << bit); int cnt = 0;
#pragma unroll
                for (int i = 0; i < 64; ++i) cnt += __builtin_popcountll(__ballot(uu[i] >= cand));
                if (cnt >= 256) Tv = cand; }
            int cgt = 0;
#pragma unroll
            for (int i = 0; i < 64; ++i) cgt += __builtin_popcountll(__ballot(uu[i] > Tv));
            const int need = 256 - cgt; int base = 0, eqs = 0; const unsigned long long lt = (1ull << lane) - 1ull;
#pragma unroll
            for (int i = 0; i < 64; ++i) { const bool gt = uu[i] > Tv, eq = uu[i] == Tv; const unsigned long long em = __ballot(eq);
                const bool take = gt || (eq && (eqs + __builtin_popcountll(em & lt)) < need); const unsigned long long tm = __ballot(take);
                if (take) sel[so + base + __builtin_popcountll(tm & lt)] = (unsigned short)(64 * i + lane);
                base += __builtin_popcountll(tm); eqs += __builtin_popcountll(em); }
          } }
    }
}
__device__ __forceinline__ void ph_att(const Ctx& C) {
    const bf16_t* qabs = WSP(bf16_t, WS_QABS); const bf16_t* ckv = WSP(bf16_t, WS_CKV); const unsigned short* sel = WSP(unsigned short, WS_SEL); bf16_t* olat = WSP(bf16_t, WS_OLAT);
    const int lane = C.lane, g = lane >> 4, fr = lane & 15;
    LAS unsigned char* ch = C.lds + C.wave * (32 * TLD + 512);
    LAS unsigned short* ssel = (LAS unsigned short*)(ch + 32 * TLD);
    for (int tq = C.gw; tq < T; tq += C.NGW) {
        const int b = tq >> 12, q = tq & (SEQ - 1), nv = (q + 1) < 256 ? (q + 1) : 256, nch = (nv + 31) >> 5;
        const bf16_t* cb = ckv + (size_t)b * SEQ * 256;
        { u32x2 sv = *(const u32x2*)(sel + (size_t)tq * 256 + 4 * lane);
          unsigned s0 = sv.x & 0xffffu, s1 = sv.x >> 16, s2_ = sv.y & 0xffffu, s3 = sv.y >> 16;
          if (4 * lane + 0 >= nv) s0 = 0; if (4 * lane + 1 >= nv) s1 = 0; if (4 * lane + 2 >= nv) s2_ = 0; if (4 * lane + 3 >= nv) s3 = 0;
          *(LAS u32x2*)(ssel + 4 * lane) = (u32x2){s0 | (s1 << 16), s2_ | (s3 << 16)}; }
        bf16x8 Bqa[8];
        { const bf16_t* qp = qabs + (size_t)tq * 2048 + (fr & 7) * 256 + 8 * g;
#pragma unroll
          for (int ks = 0; ks < 8; ++ks) { u32x4 v = *(const u32x4*)(qp + 32 * ks); if (fr >= 8) v = (u32x4){0u, 0u, 0u, 0u}; Bqa[ks] = as_bf16x8(v); } }
        f32x4 acc[16];
#pragma unroll
        for (int nt = 0; nt < 16; ++nt) acc[nt] = (f32x4){0.f, 0.f, 0.f, 0.f};
        float mrun = -INFINITY, lrun = 0.f;
        asm volatile("s_waitcnt lgkmcnt(0)" ::: "memory");
        u32x4 G[16];
#pragma unroll
        for (int p = 0; p < 16; ++p) { const int s = ssel[2 * p + (lane >> 5)]; G[p] = *(const u32x4*)(cb + (size_t)s * 256 + (lane & 31) * 8); }
#pragma unroll 1
        for (int t = 0; t < nch; ++t) {
#pragma unroll
            for (int p = 0; p < 16; ++p) *(LAS u32x4*)(ch + (2 * p + (lane >> 5)) * TLD + (lane & 31) * 16) = G[p];
            if (t + 1 < nch) {
#pragma unroll
                for (int p = 0; p < 16; ++p) { const int s = ssel[32 * (t + 1) + 2 * p + (lane >> 5)]; G[p] = *(const u32x4*)(cb + (size_t)s * 256 + (lane & 31) * 8); } }
            asm volatile("s_waitcnt lgkmcnt(0)" ::: "memory");
            f32x4 s2[2];
#pragma unroll
            for (int hf = 0; hf < 2; ++hf) { s2[hf] = (f32x4){0.f, 0.f, 0.f, 0.f};
#pragma unroll
                for (int ks = 0; ks < 8; ++ks) { const bf16x8 Ac = as_bf16x8(*(const LAS u32x4*)(ch + (16 * hf + fr) * TLD + (32 * ks + 8 * g) * 2)); s2[hf] = __builtin_amdgcn_mfma_f32_16x16x32_bf16(Ac, Bqa[ks], s2[hf], 0, 0, 0); } }
            float cm = -INFINITY;
#pragma unroll
            for (int hf = 0; hf < 2; ++hf)
#pragma unroll
                for (int r = 0; r < 4; ++r) { const int ki = 32 * t + 16 * hf + 4 * g + r; if (ki >= nv) s2[hf][r] = -INFINITY; cm = fmaxf(cm, s2[hf][r]); }
            cm = fmaxf(cm, shx(cm, 16, lane)); cm = fmaxf(cm, shx(cm, 32, lane));
            const float mnew = fmaxf(mrun, cm), scale = __expf(mrun - mnew); float ps = 0.f;
#pragma unroll
            for (int hf = 0; hf < 2; ++hf)
#pragma unroll
                for (int r = 0; r < 4; ++r) { s2[hf][r] = __expf(s2[hf][r] - mnew); ps += s2[hf][r]; }
            ps += shx(ps, 16, lane); ps += shx(ps, 32, lane);
            lrun = lrun * scale + ps; mrun = mnew;
            u32x4 pw; pw.x = cvt_pk_bf16(s2[0][0], s2[0][1]); pw.y = cvt_pk_bf16(s2[0][2], s2[0][3]); pw.z = cvt_pk_bf16(s2[1][0], s2[1][1]); pw.w = cvt_pk_bf16(s2[1][2], s2[1][3]);
            const bf16x8 Bp = as_bf16x8(pw);
#pragma unroll
            for (int nt = 0; nt < 16; ++nt) { const bf16x8 Av = tr_frag(ch, TLD, 4 * g, 16 + 4 * g, 16 * nt, lane); acc[nt] = __builtin_amdgcn_mfma_f32_16x16x32_bf16(Av, Bp, acc[nt] * scale, 0, 0, 0); }
            asm volatile("s_waitcnt lgkmcnt(0)" ::: "memory");
        }
        const float inv = 1.0f / lrun;
        if (fr < 8) { bf16_t* op = olat + (size_t)tq * 2048 + fr * 256 + 4 * g;
#pragma unroll
            for (int nt = 0; nt < 16; ++nt) { u32x2 o; o.x = cvt_pk_bf16(acc[nt][0] * inv, acc[nt][1] * inv); o.y = cvt_pk_bf16(acc[nt][2] * inv, acc[nt][3] * inv); *(u32x2*)(op + 16 * nt) = o; } }
    }
}

__device__ __forceinline__ void ph_router(const Ctx& C, int l, const float* x) {
    const float* g = C.in[I_NFFN] + l * DM; const float* wg = C.in[I_WGRP] + (size_t)l * DM * 4; const float* bg = C.in[I_BGRP] + l * 4;
    const float* we = C.in[I_WEXP] + (size_t)l * 4 * DM * 8; const float* be = C.in[I_BEXP] + l * 32;
    bf16_t* H = WSP(bf16_t, WS_H); int* rinfo = WSP(int, WS_ROUTE); float* rw = (float*)(rinfo + T * 4); unsigned* cnt = C.ctl + CW_CNT + l * 64;
    for (int row = C.gw; row < T; row += C.NGW) {
        const f32x4* xr = (const f32x4*)(x + (size_t)row * DM) + C.lane; f32x4 v[8]; float ss = 0.f;
#pragma unroll
        for (int j = 0; j < 8; ++j) { v[j] = xr[64 * j]; ss += v[j][0] * v[j][0] + v[j][1] * v[j][1] + v[j][2] * v[j][2] + v[j][3] * v[j][3]; }
        const float rstd = rsqrtf(wave_sum(ss, C.lane) * (1.f / DM) + EPS);
        u32x2* o = (u32x2*)(H + (size_t)row * DM) + C.lane; float gl[4] = {0.f, 0.f, 0.f, 0.f};
#pragma unroll
        for (int j = 0; j < 8; ++j) { const f32x4 gg = ((const f32x4*)g)[64 * j + C.lane]; v[j] = v[j] * rstd * gg; u32x2 w; w.x = cvt_pk_bf16(v[j][0], v[j][1]); w.y = cvt_pk_bf16(v[j][2], v[j][3]); o[64 * j] = w;
            const int d0 = 256 * j + 4 * C.lane;
#pragma unroll
            for (int e = 0; e < 4; ++e) { const f32x4 w4 = *(const f32x4*)(wg + (size_t)(d0 + e) * 4); gl[0] += v[j][e] * w4[0]; gl[1] += v[j][e] * w4[1]; gl[2] += v[j][e] * w4[2]; gl[3] += v[j][e] * w4[3]; } }
        int gsel = 0; float gmax = -INFINITY, gv4[4];
#pragma unroll
        for (int k = 0; k < 4; ++k) { gv4[k] = wave_sum(gl[k], C.lane) + bg[k]; if (gv4[k] > gmax) { gmax = gv4[k]; gsel = k; } }
        float gden = 0.f;
#pragma unroll
        for (int k = 0; k < 4; ++k) gden += __expf(gv4[k] - gmax);
        const float pg = 1.f / gden;
        gsel = __builtin_amdgcn_readfirstlane(gsel);
        const float* wes = we + (size_t)gsel * DM * 8; float el[8] = {0.f, 0.f, 0.f, 0.f, 0.f, 0.f, 0.f, 0.f};
#pragma unroll
        for (int j = 0; j < 8; ++j) { const int d0 = 256 * j + 4 * C.lane;
#pragma unroll
            for (int e = 0; e < 4; ++e) { const f32x4 a = *(const f32x4*)(wes + (size_t)(d0 + e) * 8), b2 = *(const f32x4*)(wes + (size_t)(d0 + e) * 8 + 4);
#pragma unroll
                for (int k = 0; k < 4; ++k) { el[k] += v[j][e] * a[k]; el[4 + k] += v[j][e] * b2[k]; } } }
        float emax = -INFINITY;
#pragma unroll
        for (int k = 0; k < 8; ++k) { el[k] = wave_sum(el[k], C.lane) + be[gsel * 8 + k]; emax = fmaxf(emax, el[k]); }
        float eden = 0.f, ep[8];
#pragma unroll
        for (int k = 0; k < 8; ++k) { ep[k] = __expf(el[k] - emax); eden += ep[k]; }
        int i0 = 0; float p0 = -1.f;
#pragma unroll
        for (int k = 0; k < 8; ++k) { ep[k] = ep[k] / eden; if (ep[k] > p0) { p0 = ep[k]; i0 = k; } }
        int i1 = 0; float p1 = -1.f;
#pragma unroll
        for (int k = 0; k < 8; ++k) if (k != i0 && ep[k] > p1) { p1 = ep[k]; i1 = k; }
        const float den = p0 + p1;
        if (C.lane == 0) { const int e0 = gsel * 8 + i0, e1 = gsel * 8 + i1;
            const unsigned r0 = atomicAdd(&cnt[e0], 1u), r1 = atomicAdd(&cnt[e1], 1u);
            *(int4*)(rinfo + (size_t)row * 4) = make_int4(e0, e1, (int)r0, (int)r1); *(f32x2*)(rw + (size_t)row * 2) = (f32x2){pg * (p0 / den), pg * (p1 / den)}; }
    }
}
__device__ __forceinline__ int moe_offsets(const unsigned* cnt, int lane, int& total_tiles) {
    const int c = lane < NEXP ? (int)__hip_atomic_load(cnt + lane, __ATOMIC_RELAXED, __HIP_MEMORY_SCOPE_AGENT) : 0; const int tiles = (c + 255) >> 8;
    int incl = tiles;
#pragma unroll
    for (int o = 1; o < 64; o <<= 1) { const int t = shi(incl, (lane - o) & 63); if (lane >= o) incl += t; }
    total_tiles = shi(incl, 63);
    return (incl - tiles) * 256;
}
__device__ __forceinline__ void ph_permute(const Ctx& C, int l) {
    const bf16_t* H = WSP(bf16_t, WS_H); bf16_t* hperm = WSP(bf16_t, WS_PROJ + M_HPERM); int* rinfo = WSP(int, WS_ROUTE); int* rpos = rinfo + T * 6;
    int tt; const int myoff = moe_offsets(C.ctl + CW_CNT + l * 64, C.lane, tt);
    for (int row = C.gw; row < T; row += C.NGW) {
        const int4 ri = *(const int4*)(rinfo + (size_t)row * 4);
        const int p0 = shi(myoff, ri.x) + ri.z, p1 = shi(myoff, ri.y) + ri.w;
        const u32x4* src = (const u32x4*)(H + (size_t)row * DM) + C.lane; u32x4* d0 = (u32x4*)(hperm + (size_t)p0 * DM) + C.lane; u32x4* d1 = (u32x4*)(hperm + (size_t)p1 * DM) + C.lane;
#pragma unroll
        for (int j = 0; j < 4; ++j) { const u32x4 w = src[64 * j]; d0[64 * j] = w; d1[64 * j] = w; }
        if (C.lane == 0) { rpos[(size_t)row * 2] = p0; rpos[(size_t)row * 2 + 1] = p1; }
    }
}
__device__ __forceinline__ int moe_table(const Ctx& C, int l) {
    __syncthreads();
    if (C.wave == 0) { int tt; const int off = moe_offsets(C.ctl + CW_CNT + l * 64, C.lane, tt); const int nxt = shi(off, (C.lane + 1) & 63);
        if (C.lane < NEXP) { const int t0 = off >> 8, t1 = (C.lane == NEXP - 1) ? tt : (nxt >> 8); for (int t = t0; t < t1; ++t) C.misc[16 + t] = C.lane; }
        if (C.lane == 0) C.misc[200] = tt; }
    __syncthreads();
    return C.misc[200];
}
__device__ __forceinline__ void ph_combine(const Ctx& C, float* x, bool last) {
    const bf16_t* yc = WSP(bf16_t, WS_PROJ + M_YC); const int* rinfo = WSP(int, WS_ROUTE); const float* rw = (const float*)(rinfo + T * 4); const int* rpos = rinfo + T * 6; const float* gf = C.in[I_FNG];
    for (int row = C.gw; row < T; row += C.NGW) {
        const int p0 = rpos[(size_t)row * 2], p1 = rpos[(size_t)row * 2 + 1]; const float w0 = rw[(size_t)row * 2], w1 = rw[(size_t)row * 2 + 1];
        f32x4* xr = (f32x4*)(x + (size_t)row * DM) + C.lane; const u32x2* y0 = (const u32x2*)(yc + (size_t)p0 * DM) + C.lane; const u32x2* y1 = (const u32x2*)(yc + (size_t)p1 * DM) + C.lane;
        f32x4 v[8]; float ss = 0.f;
#pragma unroll
        for (int j = 0; j < 8; ++j) { const u32x2 a = y0[64 * j], b = y1[64 * j]; f32x4 xv = xr[64 * j];
            xv[0] += w0 * bf2f(a.x) + w1 * bf2f(b.x); xv[1] += w0 * bf2f(a.x >> 16) + w1 * bf2f(b.x >> 16); xv[2] += w0 * bf2f(a.y) + w1 * bf2f(b.y); xv[3] += w0 * bf2f(a.y >> 16) + w1 * bf2f(b.y >> 16);
            v[j] = xv; ss += xv[0] * xv[0] + xv[1] * xv[1] + xv[2] * xv[2] + xv[3] * xv[3]; }
        if (last) { const float rstd = rsqrtf(wave_sum(ss, C.lane) * (1.f / DM) + EPS);
#pragma unroll
            for (int j = 0; j < 8; ++j) xr[64 * j] = v[j] * rstd * ((const f32x4*)gf)[64 * j + C.lane]; }
        else {
#pragma unroll
            for (int j = 0; j < 8; ++j) xr[64 * j] = v[j]; }
    }
}

constexpr int NPL = 12, NPHASES = 1 + DEPTH * NPL;
__global__ void __launch_bounds__(512, 2) mk_fwd(Args a) {
    extern __shared__ __attribute__((aligned(16))) unsigned char lds_raw[];
    Ctx C;
    C.lds = (LAS unsigned char*)lds_raw; C.misc = (volatile LAS int*)(C.lds + MISC_OFF); C.ws = a.ws; C.ctl = (unsigned*)(a.ws + WS_CTL);
    C.tid = threadIdx.x; C.lane = C.tid & 63; C.wave = __builtin_amdgcn_readfirstlane(C.tid >> 6); C.G = gridDim.x; C.bid = blockIdx.x;
    C.gw = C.bid * 8 + C.wave; C.NGW = C.G * 8; C.in = a.in; C.out = a.out;
    for (int i = C.tid; i < 256; i += 512) C.misc[i] = 0;
    __syncthreads();
#if MK_PER_PHASE
    XcdBarrier bar; bar.bar = C.ctl + CW_BAR; bar.x = 0; bar.st = (volatile LAS unsigned*)C.misc;
#else
    XcdBarrier bar = xcd_barrier_post(C.ctl + CW_BAR, (volatile LAS unsigned*)C.misc);
#endif
    const int lo = a.ph_lo, hi = a.ph_hi;
#define IN(k) (lo <= (k) && (k) < hi)
#if MK_PER_PHASE
#define SEAM(k) do { } while (0)
#else
#define SEAM(k) do { if (IN(k) && IN((k) + 1)) xcd_barrier(bar); } while (0)
#endif
    unsigned char* wb = C.ws + WS_W;
    bf16_t* H = WSP(bf16_t, WS_H);
    if (IN(0)) ph_rope(C);
#pragma unroll 1
    for (int l = 0; l < DEPTH; ++l) {
        const int pb = 1 + l * NPL;
        const float* xin = (l == 0) ? C.in[I_X] : (const float*)C.out;
        if (IN(pb + 0)) { refresh(C); REP(1) ph_weights(C, l); REP(2) ph_norm(C, xin, C.in[I_NMIX] + l * DM, H); }
        SEAM(pb + 0);
        if (IN(pb + 1)) { refresh(C);
            pg8::Gemm g{H, (const bf16_t*)(wb + W_IN), DM, DM, DM}; pg8::OrderMN S; S.init(T / 256, NP / 256, C.G, C.bid, 256L * DM * 2, 256L * DM * 2);
            pg8::EpiInProj E{C.ws};
            REP(3) pg8::gemm_phase(C.lds, g, S, E);
        }
        SEAM(pb + 1);
        if (IN(pb + 2)) { refresh(C);
            ph_ckv(C, WSP(float, WS_PROJ + P_DC), C.in[I_KVG] + l * 256, WSP(bf16_t, WS_CKV));
            { pg8::Gemm g{WSP(bf16_t, WS_PROJ + P_DQ), (const bf16_t*)(wb + W_UK), 1024, 256, 256}; pg8::OrderMN S; S.init(T / 256, 8, C.G, C.bid, 256L * 1024 * 2, 256L * 256 * 2, 1, 256L * 2);
              pg8::EpiStore<0> E{WSP(bf16_t, WS_QABS), 2048, 0.08838834764831845f}; REP(4) pg8::gemm_phase(C.lds, g, S, E); }
            refresh(C);
#if NAIVE_GMLP
            ph_gmlp_naive(C, l);
#else
            REP(5) ph_gmlp(C, l);
#endif
            refresh(C);
#if !NAIVE_RET
            REP(6) ph_ret_kv(C);
#endif
            refresh(C);
#if NAIVE_IDX
            ph_idx_naive(C);
#else
            REP(7) ph_idx(C);
#endif
        }
        SEAM(pb + 2);
        if (IN(pb + 3)) { refresh(C);
#if !NAIVE_RET
            REP(8) ph_ret_scan(C);
#endif
#if NAIVE_ATT
            ph_att_naive(C);
#else
            REP(9) ph_att(C);
#endif
        }
        SEAM(pb + 3);
        if (IN(pb + 4)) { refresh(C);
            { pg8::Gemm g{WSP(bf16_t, WS_OLAT), (const bf16_t*)(wb + W_UV), 2048, 512, 512}; pg8::OrderMN S; S.init(T / 256, 4, C.G, C.bid, 256L * 2048 * 2, 256L * 512 * 2, 0, 512L * 2);
              pg8::EpiStore<0> E{WSP(bf16_t, WS_DS), 1024, 1.0f}; REP(10) pg8::gemm_phase(C.lds, g, S, E); }
#if NAIVE_RET
            ph_ret_naive(C);
#else
            REP(11) ph_ret_out(C);
#endif
        }
        SEAM(pb + 4);
        if (IN(pb + 5)) { refresh(C);
            REP(12)
#pragma unroll 1
            for (int br = 0; br < 3; ++br) {
                const bf16_t* A = br == 0 ? WSP(bf16_t, WS_RET) : (br == 1 ? WSP(bf16_t, WS_GM) : WSP(bf16_t, WS_DS));
                const bf16_t* Bt = (const bf16_t*)(wb + (br == 0 ? W_RET : (br == 1 ? W_GM : W_DS)));
                const bf16_t* gate = WSP(bf16_t, WS_PROJ + (br == 0 ? P_GA : (br == 1 ? P_GB : P_GC)));
                pg8::Gemm g{A, Bt, 1024, 1024, 1024}; pg8::OrderMN S; S.init(T / 256, 8, C.G, C.bid, 256L * 1024 * 2, 256L * 1024 * 2);
                pg8::EpiBranch E{gate, H, br == 0 ? 1 : 0}; pg8::gemm_phase(C.lds, g, S, E);
            }
        }
        SEAM(pb + 5);
        if (IN(pb + 6)) { refresh(C);
            pg8::Gemm g{H, (const bf16_t*)(wb + W_OUT), DM, DM, DM}; pg8::OrderMN S; S.init(T / 256, 8, C.G, C.bid, 256L * DM * 2, 256L * DM * 2);
            pg8::EpiResid E{xin, C.out}; pg8::gemm_phase(C.lds, g, S, E);
        }
        SEAM(pb + 6);
        if (IN(pb + 7)) { refresh(C); ph_router(C, l, C.out); }
        SEAM(pb + 7);
        if (IN(pb + 8)) { refresh(C); REP(13) ph_permute(C, l); }
        SEAM(pb + 8);
        if (IN(pb + 9)) { refresh(C);
            const int Mt = moe_table(C, l);
            pg8::Gemm g{WSP(bf16_t, WS_PROJ + M_HPERM), (const bf16_t*)(wb + W_13), DM, DM, DM};
            pg8::OrderMoE S{C.misc + 16, Mt, 4, C.G, C.bid, 256L * DM * 2, 256L * DM * 2, 1024L * DM * 2};
            pg8::EpiMoeUp E{WSP(bf16_t, WS_PROJ + M_HID)}; REP(14) pg8::gemm_phase(C.lds, g, S, E);
        }
        SEAM(pb + 9);
        if (IN(pb + 10)) { refresh(C);
            const int Mt = moe_table(C, l);
            pg8::Gemm g{WSP(bf16_t, WS_PROJ + M_HID), (const bf16_t*)(wb + W_2), FF, FF, FF};
            pg8::OrderMoE S{C.misc + 16, Mt, 8, C.G, C.bid, 256L * FF * 2, 256L * FF * 2, (long)DM * FF * 2};
            pg8::EpiStore<0> E{WSP(bf16_t, WS_PROJ + M_YC), DM, 1.0f}; REP(15) pg8::gemm_phase(C.lds, g, S, E);
        }
        SEAM(pb + 10);
        if (IN(pb + 11)) { refresh(C); ph_combine(C, C.out, l == DEPTH - 1); }
        if (l + 1 < DEPTH) SEAM(pb + 11);
    }
#undef IN
#undef SEAM
}

extern "C" void kernel_launch(void* const* d_in, const int* in_sizes, int n_in, void* d_out, int out_size, void* d_ws, size_t ws_size, hipStream_t stream) {
    static int grid = 0;
    if (grid == 0) {
        if (n_in != 23 || out_size != T * DM || ws_size < WS_END) { fprintf(stderr, "kernel_launch: unexpected shapes / workspace (n_in %d out %d ws %zu need %zu)\n", n_in, out_size, ws_size, (size_t)WS_END); grid = -1; return; }
        int dev = 0, cus = 0, per_cu = 0;
        if (hipGetDevice(&dev) != hipSuccess || hipDeviceGetAttribute(&cus, hipDeviceAttributeMultiprocessorCount, dev) != hipSuccess) { grid = -1; return; }
        if (hipFuncSetAttribute((const void*)mk_fwd, hipFuncAttributeMaxDynamicSharedMemorySize, LDS_BYTES) != hipSuccess) { fprintf(stderr, "kernel_launch: hipFuncSetAttribute failed\n"); grid = -1; return; }
        if (hipOccupancyMaxActiveBlocksPerMultiprocessor(&per_cu, (const void*)mk_fwd, 512, LDS_BYTES) != hipSuccess || per_cu < 1) { fprintf(stderr, "kernel_launch: occupancy query says %d\n", per_cu); (void)hipGetLastError(); grid = -1; return; }
        grid = cus;
    }
    if (grid < 0) return;
    (void)hipMemsetAsync((char*)d_ws + WS_CTL, 0, CTL_BYTES, stream);
    Args a{};
    for (int i = 0; i < 23; ++i) a.in[i] = (const float*)d_in[i];
    a.out = (float*)d_out; a.ws = (unsigned char*)d_ws;
#if MK_PER_PHASE
    for (int p = 0; p < NPHASES; ++p) { a.ph_lo = p; a.ph_hi = p + 1; hipLaunchKernelGGL(mk_fwd, dim3(grid), dim3(512), LDS_BYTES, stream, a); }
#else
    a.ph_lo = 0; a.ph_hi = NPHASES;
    hipLaunchKernelGGL(mk_fwd, dim3(grid), dim3(512), LDS_BYTES, stream, a);
#endif
}
```

```cpp
#include <hip/hip_runtime.h>
#include <stdint.h>
#include <stdio.h>

#ifndef MK_PER_PHASE
#define MK_PER_PHASE 0
#endif
#ifndef PROBE_MASK
#define PROBE_MASK 0
#endif
#define CNT_BANK (((PROBE_MASK >> 16) & 1) * 128)
#define REP(k) for (int rep_ = 0; rep_ <= ((PROBE_MASK >> (k)) & 1); ++rep_)
#ifndef NAIVE_RET
#define NAIVE_RET 0
#endif
#ifndef NAIVE_GMLP
#define NAIVE_GMLP 0
#endif
#ifndef NAIVE_IDX
#define NAIVE_IDX 0
#endif
#ifndef NAIVE_ATT
#define NAIVE_ATT 0
#endif

#define LAS __attribute__((address_space(3)))
#define GAS __attribute__((address_space(1)))
typedef unsigned short bf16_t;
typedef short bf16x8 __attribute__((ext_vector_type(8)));
typedef short s16x4 __attribute__((ext_vector_type(4)));
typedef float f32x4 __attribute__((ext_vector_type(4)));
typedef float f32x2 __attribute__((ext_vector_type(2)));
typedef float f32x16 __attribute__((ext_vector_type(16)));
typedef unsigned u32x4 __attribute__((ext_vector_type(4)));
typedef unsigned u32x2 __attribute__((ext_vector_type(2)));

constexpr int DM = 2048, NB = 4, SEQ = 4096, T = NB * SEQ, DEPTH = 2;
constexpr int INW = 14152, NP = 14336;
constexpr int GATE_SRC0 = 8008, GATE_DST0 = 8192;
constexpr int NEXP = 32, FF = 512, MOE_ROWS = 40960;
constexpr float EPS = 1e-6f;

constexpr size_t MiB = 1u << 20;
constexpr size_t WS_CTL = 0, CTL_BYTES = 1 * MiB;
constexpr size_t WS_ROPE = 1 * MiB;
constexpr size_t WS_W = 5 * MiB;
constexpr size_t W_IN = 0, W_RET = 56 * MiB, W_GM = 60 * MiB, W_DS = 64 * MiB, W_OUT = 68 * MiB, W_13 = 76 * MiB, W_2 = 204 * MiB, W_UK = 268 * MiB, W_UV = 269 * MiB, W_RT = 270 * MiB  , W_END = 271 * MiB;
constexpr size_t WS_H = WS_W + W_END;
constexpr size_t WS_PROJ = WS_H + 64 * MiB;
constexpr size_t P_RQ = 0, P_RK = 32 * MiB, P_RV = 64 * MiB, P_RG = 96 * MiB, P_GU = 128 * MiB, P_GV = 160 * MiB, P_DQ = 192 * MiB, P_DC = 224 * MiB  ,
                 P_IQ = 240 * MiB  , P_IK = 256 * MiB  , P_IW = 258 * MiB  , P_GA = 260 * MiB, P_GB = 324 * MiB, P_GC = 388 * MiB, P_END = 452 * MiB;
constexpr size_t M_HPERM = 0, M_HID = 160 * MiB, M_YC = 200 * MiB;
constexpr size_t WS_KV = WS_PROJ + P_END;
constexpr size_t WS_R = WS_KV + 64 * MiB;
constexpr size_t WS_QABS = WS_R + 64 * MiB;
constexpr size_t WS_OLAT = WS_QABS + 64 * MiB;
constexpr size_t WS_RET = WS_OLAT + 64 * MiB;
constexpr size_t WS_GM = WS_RET + 32 * MiB, WS_DS = WS_GM + 32 * MiB;
constexpr size_t WS_SEL = WS_DS + 32 * MiB;
constexpr size_t WS_CKV = WS_SEL + 8 * MiB;
constexpr size_t WS_STATS = WS_CKV + 8 * MiB;
constexpr size_t WS_ROUTE = WS_STATS + 2 * MiB;
constexpr size_t WS_END = WS_ROUTE + 1 * MiB;
constexpr int CW_BAR = 4096, CW_CNT = 16384;

constexpr int LDS_BYTES = 147456, MISC_OFF = LDS_BYTES - 1024;

__device__ __forceinline__ unsigned f2bf(float f) { unsigned u = __builtin_bit_cast(unsigned, f); return (u + 0x7fffu + ((u >> 16) & 1u)) >> 16; }
__device__ __forceinline__ float bf2f(unsigned b) { return __builtin_bit_cast(float, (b & 0xffffu) << 16); }
typedef __bf16 bf16x2_t __attribute__((ext_vector_type(2)));
__device__ __forceinline__ unsigned cvt_pk_bf16(float lo, float hi) { const f32x2 v = {lo, hi}; return __builtin_bit_cast(unsigned, __builtin_convertvector(v, bf16x2_t)); }
__device__ __forceinline__ float shx(float v, int k, int lane) { return __builtin_bit_cast(float, __builtin_amdgcn_ds_bpermute((lane ^ k) << 2, __builtin_bit_cast(int, v))); }
__device__ __forceinline__ int shi(int v, int src) { return __builtin_amdgcn_ds_bpermute(src << 2, v); }
__device__ __forceinline__ int wave_total_dpp(int x) {
    x += __builtin_amdgcn_update_dpp(0, x, 0x111, 0xf, 0xf, false);
    x += __builtin_amdgcn_update_dpp(0, x, 0x112, 0xf, 0xf, false);
    x += __builtin_amdgcn_update_dpp(0, x, 0x114, 0xf, 0xf, false);
    x += __builtin_amdgcn_update_dpp(0, x, 0x118, 0xf, 0xf, false);
    x += __builtin_amdgcn_update_dpp(0, x, 0x142, 0xa, 0xf, false);
    x += __builtin_amdgcn_update_dpp(0, x, 0x143, 0xc, 0xf, false);
    return __builtin_amdgcn_readlane(x, 63);
}
__device__ __forceinline__ float wave_sum(float v, int lane) {
#pragma unroll
    for (int o = 1; o < 64; o <<= 1) v += shx(v, o, lane);
    return v;
}
__device__ __forceinline__ float wave_max(float v, int lane) {
#pragma unroll
    for (int o = 1; o < 64; o <<= 1) v = fmaxf(v, shx(v, o, lane));
    return v;
}
__device__ __forceinline__ float sigmoidf_(float x) { return __builtin_amdgcn_rcpf(1.0f + __builtin_amdgcn_exp2f(x * -1.44269504089f)); }
__device__ __forceinline__ float siluf_(float x) { return x * sigmoidf_(x); }
__device__ __forceinline__ f32x2 gelu_pk(f32x2 v) {
    const f32x2 av = __builtin_elementwise_abs(v), d = av * 0.2316418882f + 1.0f;
    f32x2 t; t.x = __builtin_amdgcn_rcpf(d.x); t.y = __builtin_amdgcn_rcpf(d.y);
    f32x2 q = t * 0.5307027145f + (-0.7265760135f); q = q * t + 0.7107068705f; q = q * t + (-0.142248368f); q = q * t + 0.127414796f; q = q * t;
    const f32x2 s = (v * v) * (-0.72134752044f);
    f32x2 e; e.x = __builtin_amdgcn_exp2f(s.x); e.y = __builtin_amdgcn_exp2f(s.y);
    const f32x2 m = v * (q * e), r = v - m;
    f32x2 o; o.x = v.x < 0.f ? m.x : r.x; o.y = v.y < 0.f ? m.y : r.y; return o;
}
template <int ACT> __device__ __forceinline__ f32x4 act4(f32x4 v) {
    if (ACT == 1) { f32x2 a = gelu_pk((f32x2){v[0], v[1]}), b = gelu_pk((f32x2){v[2], v[3]}); return (f32x4){a.x, a.y, b.x, b.y}; }
    if (ACT == 2) return (f32x4){siluf_(v[0]), siluf_(v[1]), siluf_(v[2]), siluf_(v[3])};
    if (ACT == 3) return (f32x4){sigmoidf_(v[0]), sigmoidf_(v[1]), sigmoidf_(v[2]), sigmoidf_(v[3])};
    return v;
}
__device__ __forceinline__ u32x4 pack8(f32x4 a, f32x4 b) { u32x4 w; w.x = cvt_pk_bf16(a[0], a[1]); w.y = cvt_pk_bf16(a[2], a[3]); w.z = cvt_pk_bf16(b[0], b[1]); w.w = cvt_pk_bf16(b[2], b[3]); return w; }
__device__ __forceinline__ void unpack8(u32x4 w, float (&f)[8]) {
    f[0] = bf2f(w.x); f[1] = bf2f(w.x >> 16); f[2] = bf2f(w.y); f[3] = bf2f(w.y >> 16); f[4] = bf2f(w.z); f[5] = bf2f(w.z >> 16); f[6] = bf2f(w.w); f[7] = bf2f(w.w >> 16);
}

#define XB_TMO      128
#define XB_XCNT(j)  (256  + 64 * (j))
#define XB_XSUB(j)  (1280 + 64 * (j))
#define XB_XGEN(j)  (2304 + 64 * (j))
#define XB_TOP      3328
#define XB_TOPGEN   3392
#define XCD_BAR_WORDS 3456
#define XB_SPIN_CAP (1u << 20)
__device__ __forceinline__ unsigned xb_ld(unsigned* p)              { return __hip_atomic_load(p, __ATOMIC_RELAXED, __HIP_MEMORY_SCOPE_AGENT); }
__device__ __forceinline__ unsigned xb_add(unsigned* p, unsigned v) { return __hip_atomic_fetch_add(p, v, __ATOMIC_RELAXED, __HIP_MEMORY_SCOPE_AGENT); }
__device__ __forceinline__ unsigned xb_xcc_id() { return (unsigned)__builtin_amdgcn_s_getreg((3 << 11) | 20) & 0xFu; }
#define XB_SPIN(cond, bar) do { unsigned _sp = 0; while (cond) { __builtin_amdgcn_s_sleep(1); \
    if ((++_sp & 255u) == 0u) { if (xb_ld(&(bar)[XB_TMO])) break; if (_sp > XB_SPIN_CAP) { atomicAdd(&(bar)[XB_TMO], 1u); break; } } } } while (0)
struct XcdBarrier { unsigned* bar; unsigned x; volatile LAS unsigned* st; };
__device__ __forceinline__ XcdBarrier xcd_barrier_post(unsigned* bar, volatile LAS unsigned* st) {
    XcdBarrier b; b.bar = bar; b.x = xb_xcc_id(); b.st = st;
    if (threadIdx.x == 0) (void)xb_add(&bar[XB_XCNT(b.x)], 1u);
    return b;
}
__device__ __forceinline__ void xcd_barrier_complete(unsigned* bar, unsigned x, unsigned& nloc, unsigned& nx) {
    const unsigned G = gridDim.x * gridDim.y * gridDim.z;
    unsigned sum, cnt, mine, sp = 0u;
    for (;;) {
        sum = 0u; cnt = 0u; mine = 0u;
#pragma unroll
        for (unsigned j = 0; j < 16; ++j) { const unsigned c = xb_ld(&bar[XB_XCNT(j)]); sum += c; cnt += (c > 0u) ? 1u : 0u; mine = (j == x) ? c : mine; }
        if (sum == G) break;
        __builtin_amdgcn_s_sleep(1);
        if ((++sp & 255u) == 0u) { if (xb_ld(&bar[XB_TMO])) break; if (sp > XB_SPIN_CAP) { atomicAdd(&bar[XB_TMO], 1u); break; } }
    }
    nloc = mine > 0u ? mine : 1u; nx = cnt > 0u ? cnt : 1u;
}
__device__ __forceinline__ void xcd_barrier(const XcdBarrier& b) {
    asm volatile("s_waitcnt vmcnt(0)" ::: "memory");
    __syncthreads();
    if (threadIdx.x == 0) {
        unsigned* bar = b.bar; asm volatile("" : "+s"(bar));
        __builtin_amdgcn_s_waitcnt(0);
        unsigned nloc = b.st[0], nx = b.st[1];
        if (nloc == 0u) { xcd_barrier_complete(bar, b.x, nloc, nx); b.st[0] = nloc; b.st[1] = nx; }
        const unsigned old = xb_add(&bar[XB_XSUB(b.x)], 1u);
        const unsigned gen = old / nloc;
        if (old + 1u == (gen + 1u) * nloc) {
            __builtin_amdgcn_fence(__ATOMIC_RELEASE, "agent");
            asm volatile("s_waitcnt vmcnt(0)" ::: "memory");
            const unsigned og = xb_add(&bar[XB_TOP], 1u);
            const unsigned tg = og / nx;
            if (og + 1u == (tg + 1u) * nx) xb_add(&bar[XB_TOPGEN], 1u);
            else XB_SPIN(xb_ld(&bar[XB_TOPGEN]) == tg, bar);
            __builtin_amdgcn_fence(__ATOMIC_ACQUIRE, "agent");
            xb_add(&bar[XB_XGEN(b.x)], 1u);
            asm volatile("s_waitcnt vmcnt(0)" ::: "memory");
        } else {
            XB_SPIN(xb_ld(&bar[XB_XGEN(b.x)]) == gen, bar);
            __builtin_amdgcn_fence(__ATOMIC_ACQUIRE, "agent");
            asm volatile("s_waitcnt vmcnt(0)" ::: "memory");
        }
    }
    __syncthreads();
}

namespace pg8 {
constexpr int BM = 256, BK = 64, HALF = 128, HTB = HALF * BK * 2, STAGE_BYTES = 8 * HTB, NXCD = 8, WGM = 8;
__host__ __device__ __forceinline__ int lds_byte(int r, int c) { const int st = (r >> 4) * 2 + (c >> 5), rr = r & 15, cc = c & 31, ob = rr * 64 + cc * 2; return st * 1024 + (ob ^ (((ob >> 9) & 1) << 5)); }
__host__ __device__ __forceinline__ void stage_rc(int b, int& R, int& C) { const int st = b / 1024, sb = b % 1024, swz = sb ^ (((sb >> 9) & 1) << 5); R = (st >> 1) * 16 + swz / 64; C = (st & 1) * 32 + (swz % 64) / 2; }
__host__ __device__ __forceinline__ int perm32(int rho) { const int n = rho >> 4, i = rho & 15; return 8 * (i >> 2) + 4 * n + (i & 3); }

struct Unit { int pm, pn; long aoff, boff; };
struct Gemm { const bf16_t* A; const bf16_t* Bt; int lda, ldb, K; };

struct OrderMN {
    int nM, nN, nwg, G, c, ashift; long astep, bstep, abytes;
    __device__ void init(int nM_, int nN_, int G_, int c_, long astep_, long bstep_, int ashift_ = 0, long abytes_ = 0) { nM = nM_; nN = nN_; nwg = nM * nN; G = G_; c = c_; astep = astep_; bstep = bstep_; ashift = ashift_; abytes = abytes_; }
    __device__ bool next(int i, Unit& u) const {
        const long L = (long)i * G + c; if (L >= nwg) return false;
        int wgid = (int)L; { const int q = nwg / NXCD, r = nwg % NXCD, xcd = wgid % NXCD, off = wgid / NXCD; wgid = (xcd < r ? xcd * (q + 1) : r * (q + 1) + (xcd - r) * q) + off; }
        const int nig = WGM * nN, gid = wgid / nig, fm = gid * WGM, gsz = (nM - fm) < WGM ? (nM - fm) : WGM;
        u.pm = fm + ((wgid % nig) % gsz); u.pn = (wgid % nig) / gsz;
        u.aoff = (long)u.pm * astep + (long)(u.pn >> ashift) * abytes; u.boff = (long)u.pn * bstep; return true;
    }
};
struct OrderMoE {
    const volatile LAS int* te; int Mt, nN, G, c; long astep, bstep, estep;
    __device__ bool next(int i, Unit& u) const {
        const long L = (long)i * G + c; if (L >= (long)Mt * nN) return false;
        u.pm = (int)(L / nN); u.pn = (int)(L % nN);
        u.aoff = (long)u.pm * astep; u.boff = (long)te[u.pm] * estep + (long)u.pn * bstep; return true;
    }
};

template <class Epi, class Sched>
__device__ __forceinline__ void gemm_phase(LAS unsigned char* lds, const Gemm g, const Sched& S, const Epi& E) {
    int tid_ = threadIdx.x; asm volatile("" : "+v"(tid_));
    const GAS bf16_t* gA = (const GAS bf16_t*)g.A; const GAS bf16_t* gB = (const GAS bf16_t*)g.Bt; asm volatile("" : "+s"(gA), "+s"(gB));
    const int tid = tid_, wid = __builtin_amdgcn_readfirstlane(tid >> 6), lane = tid & 63, wr = wid >> 2, wc = wid & 3, fr = lane & 15, fq = lane >> 4;
    const int K = g.K, nt = K / BK;
    unsigned voffA[2], voffB[2];
#pragma unroll
    for (int i = 0; i < 2; ++i) { int R, C; stage_rc(tid * 16 + i * 8192, R, C); const int Rb = Epi::PERM ? ((R & ~31) + perm32(R & 31)) : R;
        voffA[i] = (unsigned)(R * g.lda + C) * 2u; voffB[i] = (unsigned)(Rb * g.ldb + C) * 2u; }
    const size_t kstep = (size_t)(BK * 2);
    const size_t hstepA = (size_t)HALF * g.lda * 2, hstepB = (size_t)HALF * g.ldb * 2;
    const unsigned ldsw = (unsigned)wid * 1024u;
    const int aoff = lds_byte(wr * 64 + fr, fq * 8), boff = lds_byte(wc * 32 + fr, fq * 8);
#define PG8_SA(b, h) (((b) * 2 + (h)) * HTB)
#define PG8_SB(b, h) ((4 + (b) * 2 + (h)) * HTB)
#define PG8_STAGE(bufoff, gbase, voff) do { _Pragma("unroll") for (int _i = 0; _i < 2; ++_i) \
        __builtin_amdgcn_global_load_lds((const GAS unsigned*)((gbase) + (voff)[_i]), (LAS unsigned*)(lds + (bufoff) + ldsw + _i * 8192), 16, 0, 0); } while (0)
#define PG8_LDA(dst, b, h) do { _Pragma("unroll") for (int m = 0; m < 4; ++m) _Pragma("unroll") for (int k = 0; k < 2; ++k) dst[m][k] = *(const LAS bf16x8*)(lds + PG8_SA(b, h) + aoff + m * 2048 + k * 1024); } while (0)
#define PG8_LDB(dst, b, h) do { _Pragma("unroll") for (int n = 0; n < 2; ++n) _Pragma("unroll") for (int k = 0; k < 2; ++k) dst[n][k] = *(const LAS bf16x8*)(lds + PG8_SB(b, h) + boff + n * 2048 + k * 1024); } while (0)
#define PG8_MMA(ai, bj, At, Bt) do { __builtin_amdgcn_s_setprio(1); _Pragma("unroll") for (int m = 0; m < 4; ++m) _Pragma("unroll") for (int n = 0; n < 2; ++n) _Pragma("unroll") for (int k = 0; k < 2; ++k) \
        acc[ai][bj][m][n] = __builtin_amdgcn_mfma_f32_16x16x32_bf16(Bt[n][k], At[m][k], acc[ai][bj][m][n], 0, 0, 0); __builtin_amdgcn_s_setprio(0); } while (0)
#define PG8_WAIT_V(n) asm volatile("s_waitcnt vmcnt(" #n ")" ::: "memory")
#define PG8_WAIT_L(n) asm volatile("s_waitcnt lgkmcnt(" #n ")" ::: "memory")
#define PG8_BAR __builtin_amdgcn_s_barrier()
#define PG8_SCHED __builtin_amdgcn_sched_barrier(0)
    Unit cur, nxt; int ui = 0;
    if (!S.next(0, cur)) return;
    f32x4 acc[2][2][4][2];
#pragma unroll
    for (int a = 0; a < 2; ++a)
#pragma unroll
        for (int b = 0; b < 2; ++b)
#pragma unroll
            for (int m = 0; m < 4; ++m)
#pragma unroll
                for (int n = 0; n < 2; ++n) acc[a][b][m][n] = (f32x4){0.f, 0.f, 0.f, 0.f};
    bf16x8 At[4][2], B0[2][2], B1[2][2];
    const GAS char* cA = (const GAS char*)gA + cur.aoff; const GAS char* cB = (const GAS char*)gB + cur.boff;
    PG8_STAGE(PG8_SB(0, 0), cB, voffB); PG8_STAGE(PG8_SA(0, 0), cA, voffA); PG8_STAGE(PG8_SB(0, 1), cB + hstepB, voffB); PG8_STAGE(PG8_SA(0, 1), cA + hstepA, voffA);
    if (wr == 1) PG8_BAR;
    PG8_WAIT_V(4); PG8_BAR;
    PG8_STAGE(PG8_SB(1, 0), cB + kstep, voffB); PG8_STAGE(PG8_SA(1, 0), cA + kstep, voffA); PG8_STAGE(PG8_SB(1, 1), cB + hstepB + kstep, voffB);
    PG8_WAIT_V(6); PG8_BAR;
    for (;;) {
        const bool has_next = S.next(ui + 1, nxt);
        const GAS char* nA = has_next ? (const GAS char*)gA + nxt.aoff : cA; const GAS char* nB = has_next ? (const GAS char*)gB + nxt.boff : cB;
        for (int t = 0; t < nt; t += 2) {
            const bool last = (t == nt - 2);
            const GAS char* a1 = cA + (size_t)(t + 1) * kstep;
            const GAS char* a2 = last ? nA : cA + (size_t)(t + 2) * kstep; const GAS char* b2 = last ? nB : cB + (size_t)(t + 2) * kstep;
            const GAS char* a3 = a2 + kstep; const GAS char* b3 = b2 + kstep;
            PG8_LDB(B0, 0, 0); PG8_SCHED; PG8_LDA(At, 0, 0); PG8_STAGE(PG8_SA(1, 1), a1 + hstepA, voffA);
            PG8_WAIT_L(8); PG8_BAR; PG8_WAIT_L(0); PG8_MMA(0, 0, At, B0); PG8_BAR; PG8_SCHED;
            PG8_LDB(B1, 0, 1); PG8_STAGE(PG8_SB(0, 0), b2, voffB);
            PG8_BAR; PG8_WAIT_L(0); PG8_MMA(0, 1, At, B1); PG8_BAR;
            PG8_LDA(At, 0, 1); PG8_STAGE(PG8_SA(0, 0), a2, voffA);
            PG8_BAR; PG8_WAIT_L(0); PG8_MMA(1, 0, At, B0); PG8_BAR; PG8_SCHED;
            PG8_STAGE(PG8_SB(0, 1), b2 + hstepB, voffB);
            PG8_WAIT_V(6); PG8_BAR; PG8_MMA(1, 1, At, B1); PG8_BAR;
            PG8_LDB(B0, 1, 0); PG8_SCHED; PG8_LDA(At, 1, 0); PG8_STAGE(PG8_SA(0, 1), a2 + hstepA, voffA);
            PG8_WAIT_L(8); PG8_BAR; PG8_WAIT_L(0); PG8_MMA(0, 0, At, B0); PG8_BAR; PG8_SCHED;
            PG8_LDB(B1, 1, 1); PG8_STAGE(PG8_SB(1, 0), b3, voffB);
            PG8_BAR; PG8_WAIT_L(0); PG8_MMA(0, 1, At, B1); PG8_BAR;
            PG8_LDA(At, 1, 1); PG8_STAGE(PG8_SA(1, 0), a3, voffA);
            PG8_BAR; PG8_WAIT_L(0); PG8_MMA(1, 0, At, B0); PG8_BAR; PG8_SCHED;
            PG8_STAGE(PG8_SB(1, 1), b3 + hstepB, voffB);
            PG8_WAIT_V(6); PG8_BAR; PG8_MMA(1, 1, At, B1); PG8_BAR;
        }
        E(acc, cur, wr, wc, fr, fq);
        if (!has_next) break;
#pragma unroll
        for (int a = 0; a < 2; ++a)
#pragma unroll
            for (int b = 0; b < 2; ++b)
#pragma unroll
                for (int m = 0; m < 4; ++m)
#pragma unroll
                    for (int n = 0; n < 2; ++n) acc[a][b][m][n] = (f32x4){0.f, 0.f, 0.f, 0.f};
        cur = nxt; cA = nA; cB = nB; ++ui;
    }
    PG8_WAIT_V(0);
    if (wr == 0) PG8_BAR;
    PG8_BAR;
#undef PG8_SA
#undef PG8_SB
#undef PG8_STAGE
#undef PG8_LDA
#undef PG8_LDB
#undef PG8_MMA
#undef PG8_WAIT_V
#undef PG8_WAIT_L
#undef PG8_BAR
#undef PG8_SCHED
}

typedef const f32x4 (&AccT)[2][2][4][2];
template <int ACT> __device__ __forceinline__ void store_tile_bf16(AccT acc, bf16_t* O, int ld, int row0, int colb, float scale) {
#pragma unroll
    for (int ai = 0; ai < 2; ++ai)
#pragma unroll
        for (int m = 0; m < 4; ++m) { bf16_t* rowp = O + (size_t)(row0 + ai * HALF + m * 16) * ld + colb;
#pragma unroll
            for (int bj = 0; bj < 2; ++bj) { const f32x4 v0 = act4<ACT>(acc[ai][bj][m][0] * scale), v1 = act4<ACT>(acc[ai][bj][m][1] * scale);
                *(u32x4*)(rowp + bj * HALF) = pack8(v0, v1); }
            asm volatile("" ::: "memory"); }
}
template <int ACT> struct EpiStore {
    static constexpr bool PERM = true;
    bf16_t* O; int ld; float scale;
    __device__ __forceinline__ void operator()(AccT acc, const Unit& u, int wr, int wc, int fr, int fq) const {
        store_tile_bf16<ACT>(acc, O, ld, u.pm * BM + wr * 64 + fr, u.pn * BM + wc * 32 + 8 * fq, scale);
    }
};
struct EpiInProj {
    static constexpr bool PERM = true;
    unsigned char* ws;
    __device__ __forceinline__ void operator()(AccT acc, const Unit& u, int wr, int wc, int fr, int fq) const {
        const int pn = u.pn, row0 = u.pm * BM + wr * 64 + fr, cw = wc * 32 + 8 * fq;
        unsigned char* pj = ws + WS_PROJ;
        bf16_t *rq = (bf16_t*)(pj + P_RQ), *rk = (bf16_t*)(pj + P_RK), *rv = (bf16_t*)(pj + P_RV), *rg = (bf16_t*)(pj + P_RG), *gu = (bf16_t*)(pj + P_GU), *gv = (bf16_t*)(pj + P_GV), *dq = (bf16_t*)(pj + P_DQ),
               *iq = (bf16_t*)(pj + P_IQ), *ik = (bf16_t*)(pj + P_IK), *ga = (bf16_t*)(pj + P_GA), *gb = (bf16_t*)(pj + P_GB), *gc = (bf16_t*)(pj + P_GC);
        float *dcraw = (float*)(pj + P_DC), *iw = (float*)(pj + P_IW), *gvstats = (float*)(ws + WS_STATS); const float* rope = (const float*)(ws + WS_ROPE);
        if (pn < 8) {
            const bool isk = pn >= 4; bf16_t* dst = (isk ? rk : rq) + (pn & 3) * 256 + cw; const float sc = isk ? 0.0625f : 1.0f;
#pragma unroll
            for (int ai = 0; ai < 2; ++ai)
#pragma unroll
                for (int m = 0; m < 4; ++m) { const int row = row0 + ai * HALF + m * 16, pos = row & (SEQ - 1);
                    const f32x4* cs = (const f32x4*)(rope + ((size_t)pos * 128 + cw) * 2);
                    f32x4 o1[2], o2[2];
#pragma unroll
                    for (int n = 0; n < 2; ++n) { const f32x4 c01 = cs[2 * n], c23 = cs[2 * n + 1]; const f32x4 x1 = acc[ai][0][m][n], x2 = acc[ai][1][m][n];
                        const float co[4] = {c01[0], c01[2], c23[0], c23[2]}, si[4] = {c01[1], c01[3], c23[1], c23[3]};
#pragma unroll
                        for (int j = 0; j < 4; ++j) { o1[n][j] = (x1[j] * co[j] - x2[j] * si[j]) * sc; o2[n][j] = (x1[j] * si[j] + x2[j] * co[j]) * sc; } }
                    bf16_t* rp = dst + (size_t)row * 1024;
                    *(u32x4*)rp = pack8(o1[0], o1[1]); *(u32x4*)(rp + 128) = pack8(o2[0], o2[1]); asm volatile("" ::: "memory"); }
        } else if (pn < 12) { store_tile_bf16<0>(acc, rv, 1024, row0, (pn - 8) * 256 + cw, 1.f);
        } else if (pn < 16) { store_tile_bf16<2>(acc, rg, 1024, row0, (pn - 12) * 256 + cw, 1.f);
        } else if (pn < 20) { store_tile_bf16<1>(acc, gu, 1024, row0, (pn - 16) * 256 + cw, 1.f);
        } else if (pn < 24) {
            const int t4 = pn - 20; bf16_t* dst = gv + t4 * 256 + cw;
#pragma unroll
            for (int ai = 0; ai < 2; ++ai)
#pragma unroll
                for (int m = 0; m < 4; ++m) { const int row = row0 + ai * HALF + m * 16; float s = 0.f, q = 0.f;
#pragma unroll
                    for (int bj = 0; bj < 2; ++bj) { const f32x4 v0 = act4<1>(acc[ai][bj][m][0]), v1 = act4<1>(acc[ai][bj][m][1]);
                        *(u32x4*)(dst + (size_t)row * 1024 + bj * HALF) = pack8(v0, v1);
#pragma unroll
                        for (int j = 0; j < 4; ++j) { s += v0[j] + v1[j]; q += v0[j] * v0[j] + v1[j] * v1[j]; } }
                    { const int ln = fq * 16 + fr; s += shx(s, 16, ln); s += shx(s, 32, ln); q += shx(q, 16, ln); q += shx(q, 32, ln); }
                    if (fq == 0) *(f32x2*)(gvstats + ((size_t)row * 16 + t4 * 4 + wc) * 2) = (f32x2){s, q}; asm volatile("" ::: "memory"); }
        } else if (pn < 28) { store_tile_bf16<0>(acc, dq, 1024, row0, (pn - 24) * 256 + cw, 1.f);
        } else if (pn == 28) {
#pragma unroll
            for (int ai = 0; ai < 2; ++ai)
#pragma unroll
                for (int m = 0; m < 4; ++m) { float* rp = dcraw + (size_t)(row0 + ai * HALF + m * 16) * 256 + cw;
#pragma unroll
                    for (int bj = 0; bj < 2; ++bj) { *(f32x4*)(rp + bj * HALF) = acc[ai][bj][m][0]; *(f32x4*)(rp + bj * HALF + 4) = acc[ai][bj][m][1]; } }
        } else if (pn < 31) { store_tile_bf16<0>(acc, iq, 512, row0, (pn - 29) * 256 + cw, 1.f);
        } else if (pn == 31) {
#pragma unroll
            for (int ai = 0; ai < 2; ++ai)
#pragma unroll
                for (int m = 0; m < 4; ++m) { const int row = row0 + ai * HALF + m * 16;
                    if (wc < 2) *(u32x4*)(ik + (size_t)row * 64 + cw) = pack8(acc[ai][0][m][0], acc[ai][0][m][1]);
                    if (wc == 2 && fq == 0) { *(f32x4*)(iw + (size_t)row * 8) = acc[ai][0][m][0] * 0.35355339059f; *(f32x4*)(iw + (size_t)row * 8 + 4) = acc[ai][0][m][1] * 0.35355339059f; } }
        } else { const int gi = (pn - 32) >> 3; bf16_t* dst = gi == 0 ? ga : (gi == 1 ? gb : gc);
            store_tile_bf16<3>(acc, dst, 2048, row0, ((pn - 32) & 7) * 256 + cw, 1.f); }
    }
};
struct EpiBranch {
    static constexpr bool PERM = true;
    const bf16_t* gate; bf16_t* merged; int first;
    __device__ __forceinline__ void operator()(AccT acc, const Unit& u, int wr, int wc, int fr, int fq) const {
        const int row0 = u.pm * BM + wr * 64 + fr, colb = u.pn * BM + wc * 32 + 8 * fq;
#pragma unroll
        for (int ai = 0; ai < 2; ++ai)
#pragma unroll
            for (int m = 0; m < 4; ++m) { const size_t ro = (size_t)(row0 + ai * HALF + m * 16) * 2048 + colb;
#pragma unroll
                for (int bj = 0; bj < 2; ++bj) { float g8[8], m8[8]; unpack8(*(const u32x4*)(gate + ro + bj * HALF), g8);
                    if (!first) unpack8(*(const u32x4*)(merged + ro + bj * HALF), m8); else {
#pragma unroll
                        for (int j = 0; j < 8; ++j) m8[j] = 0.f; }
                    const f32x4 a0 = acc[ai][bj][m][0], a1 = acc[ai][bj][m][1];
                    f32x4 r0, r1;
#pragma unroll
                    for (int j = 0; j < 4; ++j) { r0[j] = m8[j] + g8[j] * a0[j]; r1[j] = m8[4 + j] + g8[4 + j] * a1[j]; }
                    *(u32x4*)(merged + ro + bj * HALF) = pack8(r0, r1); } }
    }
};
struct EpiResid {
    static constexpr bool PERM = false;
    const float* xsrc; float* xdst;
    __device__ __forceinline__ void operator()(AccT acc, const Unit& u, int wr, int wc, int fr, int fq) const {
        const int row0 = u.pm * BM + wr * 64 + fr, col0 = u.pn * BM + wc * 32 + 4 * fq;
#pragma unroll
        for (int ai = 0; ai < 2; ++ai)
#pragma unroll
            for (int m = 0; m < 4; ++m) { const size_t ro = (size_t)(row0 + ai * HALF + m * 16) * DM + col0;
#pragma unroll
                for (int bj = 0; bj < 2; ++bj)
#pragma unroll
                    for (int n = 0; n < 2; ++n) { const size_t o = ro + bj * HALF + n * 16; *(f32x4*)(xdst + o) = *(const f32x4*)(xsrc + o) + acc[ai][bj][m][n]; } }
    }
};
struct EpiMoeUp {
    static constexpr bool PERM = true;
    bf16_t* hid;
    __device__ __forceinline__ void operator()(AccT acc, const Unit& u, int wr, int wc, int fr, int fq) const {
        const int row0 = u.pm * BM + wr * 64 + fr, colb = u.pn * 128 + wc * 32 + 8 * fq;
#pragma unroll
        for (int ai = 0; ai < 2; ++ai)
#pragma unroll
            for (int m = 0; m < 4; ++m) { f32x4 r0, r1; const f32x4 a0 = acc[ai][0][m][0], a1 = acc[ai][0][m][1], b0 = acc[ai][1][m][0], b1 = acc[ai][1][m][1];
#pragma unroll
                for (int j = 0; j < 4; ++j) { r0[j] = siluf_(a0[j]) * b0[j]; r1[j] = siluf_(a1[j]) * b1[j]; }
                *(u32x4*)(hid + (size_t)(row0 + ai * HALF + m * 16) * FF + colb) = pack8(r0, r1); }
    }
};
struct OrderRouter {
    int G, c; long hlo_off;
    __device__ bool next(int i, Unit& u) const { const int L = i * G + c; if (L >= 256) return false; const int pm = L >> 2, which = (L >> 1) & 1, kh = L & 1;
        u.pm = pm; u.pn = which * 2 + kh; u.aoff = (long)pm * 256 * DM * 2 + (long)which * hlo_off + (long)kh * 1024 * 2; u.boff = (long)kh * 1024 * 2; return true; }
};
struct EpiRouter {
    static constexpr bool PERM = false;
    float* LOG;
    __device__ __forceinline__ void operator()(AccT acc, const Unit& u, int wr, int wc, int fr, int fq) const {
        float* base = LOG + ((size_t)u.pn * T + (size_t)u.pm * BM + wr * 64 + fr) * 128 + wc * 32 + 4 * fq;
#pragma unroll
        for (int ai = 0; ai < 2; ++ai)
#pragma unroll
            for (int m = 0; m < 4; ++m)
#pragma unroll
                for (int n = 0; n < 2; ++n) *(f32x4*)(base + (size_t)(ai * HALF + m * 16) * 128 + n * 16) = acc[ai][0][m][n];
    }
};
}

struct Args { const float* in[23]; float* out; unsigned char* ws; int ph_lo, ph_hi; };
enum { I_X = 0, I_NMIX, I_WIN, I_WRET, I_LNG, I_LNB, I_WS, I_BS, I_WGM, I_KVG, I_WUK, I_WUV, I_WDS, I_WOUT, I_NFFN, I_WGRP, I_BGRP, I_WEXP, I_BEXP, I_W1, I_W3, I_W2, I_FNG };
struct Ctx {
    LAS unsigned char* lds; volatile LAS int* misc; unsigned* ctl; GAS unsigned char* ws;
    int tid, lane, wave, G, bid, gw, NGW;
    const float* const* in; float* out;
};
#define WSP(T_, off) ((T_*)(C.ws + (off)))
__device__ __forceinline__ void refresh(Ctx& C) { int t = threadIdx.x; asm volatile("" : "+v"(t)); C.tid = t; C.lane = t & 63;
    GAS unsigned char* w = C.ws; asm volatile("" : "+s"(w)); C.ws = w; C.ctl = (unsigned*)w; }

__device__ __forceinline__ void ph_rope(const Ctx& C) {
    float* rope = WSP(float, WS_ROPE);
    const double r1 = 0.9305720409296989;
    for (int idx = C.bid * 512 + C.tid; idx < SEQ * 128; idx += C.G * 512) {
        const int pos = idx >> 7, i = idx & 127;
        double inv = 1.0, b = r1; int e = i;
        while (e) { if (e & 1) inv *= b; b *= b; e >>= 1; }
        const double ang = (double)pos * inv;
        const double n = __builtin_rint(ang * 0.15915494309189533577);
        const double x = ang - n * 6.283185307179586476925;
        const double x2 = x * x;
        double s = 0.0, c = 0.0;
#pragma unroll 1
        for (int k = 14; k >= 1; --k) { s = (s + 1.0) * (-x2 / (double)((2 * k) * (2 * k + 1))); c = (c + 1.0) * (-x2 / (double)((2 * k - 1) * (2 * k))); }
        s = (s + 1.0) * x; c = c + 1.0;
        *(f32x2*)(rope + (size_t)idx * 2) = (f32x2){(float)c, (float)s};
    }
}

template <class Map>
__device__ __forceinline__ void tr_item(const float* W, long srcld, bf16_t* WT, long dstld, int k0, int n0, LAS float* scr, int lane, const Map& map) {
    const int nn = n0 + (lane & 31); const long sc = map(nn);
#pragma unroll 8
    for (int i = 0; i < 32; ++i) { const int kk = 2 * i + (lane >> 5); scr[kk * 33 + (lane & 31)] = sc >= 0 ? W[(size_t)(k0 + kk) * srcld + sc] : 0.f; }
    asm volatile("s_waitcnt lgkmcnt(0)" ::: "memory");
    const int c = lane & 7;
#pragma unroll
    for (int j = 0; j < 4; ++j) { const int n = (lane >> 3) + 8 * j; const LAS float* s = scr + (8 * c) * 33 + n;
        u32x4 o; o.x = cvt_pk_bf16(s[0 * 33], s[1 * 33]); o.y = cvt_pk_bf16(s[2 * 33], s[3 * 33]); o.z = cvt_pk_bf16(s[4 * 33], s[5 * 33]); o.w = cvt_pk_bf16(s[6 * 33], s[7 * 33]);
        *(u32x4*)(WT + (size_t)(n0 + n) * dstld + k0 + 8 * c) = o; }
    asm volatile("s_waitcnt lgkmcnt(0)" ::: "memory");
}
struct MapId { __device__ long operator()(int n) const { return n; } };
struct MapIn { __device__ long operator()(int n) const { return n < GATE_SRC0 ? n : (n < GATE_DST0 ? -1 : n - (GATE_DST0 - GATE_SRC0)); } };
struct MapOff { long off; __device__ long operator()(int n) const { return n + off; } };

struct WItem { const float* src; bf16_t* dst; int srcld, dstld, k0, n0, mode; long off; };
__device__ __forceinline__ WItem w_item(const Ctx& C, int l, int r) {
    unsigned char* wb = (unsigned char*)(C.ws + WS_W); WItem w; w.mode = 0; w.off = 0;
    constexpr int N_IN = 32 * 224, N_BR = 16 * 32, N_OUT = 32 * 32, N_13 = 32 * 32 * 16, N_2 = 32 * 8 * 32;
    if (r < N_IN) { const int kb = r / 224, nb = r % 224; w.src = C.in[I_WIN] + (size_t)l * DM * INW; w.srcld = INW; w.dst = (bf16_t*)(wb + W_IN); w.dstld = DM; w.k0 = kb * 64; w.n0 = nb * 64; w.mode = 1; return w; } r -= N_IN;
    if (r < 3 * N_BR) { const int ww = r / N_BR, q = r % N_BR, kb = q / 32, nb = q % 32; w.src = C.in[ww == 0 ? I_WRET : (ww == 1 ? I_WGM : I_WDS)] + (size_t)l * 1024 * DM; w.srcld = DM;
        w.dst = (bf16_t*)(wb + (ww == 0 ? W_RET : (ww == 1 ? W_GM : W_DS))); w.dstld = 1024; w.k0 = kb * 64; w.n0 = nb * 64; return w; } r -= 3 * N_BR;
    if (r < N_OUT) { const int kb = r / 32, nb = r % 32; w.src = C.in[I_WOUT] + (size_t)l * DM * DM; w.srcld = DM; w.dst = (bf16_t*)(wb + W_OUT); w.dstld = DM; w.k0 = kb * 64; w.n0 = nb * 64; return w; } r -= N_OUT;
    if (r < N_13) { const int e = r / 512, q = r % 512, kb = q / 16, nb = q % 16, row0 = nb * 64, j = row0 >> 8, sft = (row0 >> 7) & 1, fp = row0 & 127;
        w.src = C.in[sft ? I_W3 : I_W1] + ((size_t)l * NEXP + e) * DM * FF; w.srcld = FF; w.dst = (bf16_t*)(wb + W_13) + (size_t)e * 1024 * DM; w.dstld = DM; w.k0 = kb * 64; w.n0 = row0; w.off = (long)(128 * j + fp) - row0; return w; } r -= N_13;
    if (r < N_2) { const int e = r / 256, q = r % 256, kb = q / 32, nb = q % 32; w.src = C.in[I_W2] + ((size_t)l * NEXP + e) * FF * DM; w.srcld = DM; w.dst = (bf16_t*)(wb + W_2) + (size_t)e * DM * FF; w.dstld = FF; w.k0 = kb * 64; w.n0 = nb * 64; return w; } r -= N_2;
    { const int h = r / 8, q = r % 8, kb = q / 2, nb = q % 2;
      w.src = C.in[I_WUV] + ((size_t)l * 8 + h) * 256 * 128; w.srcld = 128; w.dst = (bf16_t*)(wb + W_UV) + (size_t)(h * 128) * 512 + (h & 1) * 256; w.dstld = 512; w.k0 = kb * 64; w.n0 = nb * 64; return w; }
}
__device__ __forceinline__ void w_load(const WItem& w, int lane, f32x4 (&R)[16]) {
    const int nq = lane & 15, kq = lane >> 4, n = w.n0 + 4 * nq;
    const long sc = (w.mode == 1) ? (n < GATE_SRC0 ? (long)n : (n < GATE_DST0 ? -1L : (long)(n - (GATE_DST0 - GATE_SRC0)))) : (long)n + w.off;
    const float* p = w.src + (size_t)(w.k0 + 2 * kq) * w.srcld + (sc >= 0 ? sc : 0);
#pragma unroll
    for (int i = 0; i < 8; ++i)
#pragma unroll
        for (int s2 = 0; s2 < 2; ++s2) { f32x4 v = *(const f32x4*)(p + (size_t)(8 * i + s2) * w.srcld); if (sc < 0) v = (f32x4){0.f, 0.f, 0.f, 0.f}; R[2 * i + s2] = v; }
}
__device__ __forceinline__ void w_store(const WItem& w, int lane, const f32x4 (&R)[16], LAS unsigned* scr) {
    const int nq = lane & 15, kq = lane >> 4;
#pragma unroll
    for (int i = 0; i < 8; ++i)
#pragma unroll
        for (int e = 0; e < 4; ++e) scr[(4 * nq + e) * 33 + 4 * i + kq] = cvt_pk_bf16(R[2 * i][e], R[2 * i + 1][e]);
    asm volatile("s_waitcnt lgkmcnt(0)" ::: "memory");
    const int c = lane & 7;
#pragma unroll
    for (int j = 0; j < 8; ++j) { const int n = (lane >> 3) + 8 * j; const LAS unsigned* sp = scr + n * 33 + 4 * c;
        u32x4 o; o.x = sp[0]; o.y = sp[1]; o.z = sp[2]; o.w = sp[3];
        *(u32x4*)(w.dst + (size_t)(w.n0 + n) * w.dstld + w.k0 + 8 * c) = o; }
    asm volatile("s_waitcnt lgkmcnt(0)" ::: "memory");
}
__device__ __forceinline__ void ph_weights(const Ctx& C, int l) {
    LAS unsigned* scr = (LAS unsigned*)(C.lds + C.wave * 16384);
    unsigned char* wb = (unsigned char*)(C.ws + WS_W);
    constexpr int NITEMS = 32 * 224 + 3 * 16 * 32 + 32 * 32 + 32 * 32 * 16 + 32 * 8 * 32 + 8 * 8;
    { int it = C.gw; f32x4 R[16], Rn[16]; WItem w, wn;
      if (it < NITEMS) { w = w_item(C, l, it); w_load(w, C.lane, R); }
#pragma unroll 1
      while (it < NITEMS) { const int itn = it + C.NGW;
          if (itn < NITEMS) { wn = w_item(C, l, itn); w_load(wn, C.lane, Rn); }
          w_store(w, C.lane, R, scr);
#pragma unroll
          for (int i = 0; i < 16; ++i) R[i] = Rn[i];
          w = wn; it = itn; } }
    bf16_t* uv = (bf16_t*)(wb + W_UV); bf16_t* uk = (bf16_t*)(wb + W_UK); const float* wuk = C.in[I_WUK] + (size_t)l * 8 * 256 * 128;
    for (int idx = C.bid * 512 + C.tid; idx < 1024 * 256 / 8; idx += C.G * 512) { const int row = idx >> 5, c8 = (idx & 31) * 8, h = row >> 7;
        *(u32x4*)(uv + (size_t)row * 512 + (1 - (h & 1)) * 256 + c8) = (u32x4){0u, 0u, 0u, 0u}; }
    for (int idx = C.bid * 512 + C.tid; idx < 2048 * 256 / 8; idx += C.G * 512) { const int row = idx >> 5, c8 = (idx & 31) * 8, h = row >> 8, half = c8 >> 7;
        u32x4 o = (u32x4){0u, 0u, 0u, 0u};
        if (half == (h & 1)) { const float* s = wuk + (size_t)row * 128 + (c8 & 127); const f32x4 a = *(const f32x4*)s, b = *(const f32x4*)(s + 4); o = pack8(a, b); }
        *(u32x4*)(uk + (size_t)row * 256 + c8) = o; }
    bf16_t* rt = (bf16_t*)(wb + W_RT); const float* wgr = C.in[I_WGRP] + (size_t)l * DM * 4; const float* wex = C.in[I_WEXP] + (size_t)l * 4 * DM * 8;
    for (int idx = C.bid * 512 + C.tid; idx < 256 * 256; idx += C.G * 512) { const int r = idx >> 8, k8 = (idx & 255) * 8, c = r & 63, part = r >> 6;
        u32x4 o = (u32x4){0u, 0u, 0u, 0u};
        if (part < 2 && c < 36) { float v[8];
#pragma unroll
            for (int j = 0; j < 8; ++j) { const float wv = (c < 4) ? wgr[(size_t)(k8 + j) * 4 + c] : wex[((size_t)((c - 4) >> 3) * DM + (k8 + j)) * 8 + ((c - 4) & 7)];
                const float hi = bf2f(f2bf(wv)); v[j] = part == 0 ? hi : (wv - hi); }
            o = pack8((f32x4){v[0], v[1], v[2], v[3]}, (f32x4){v[4], v[5], v[6], v[7]}); }
        *(u32x4*)(rt + (size_t)r * DM + k8) = o; }
}

__device__ __forceinline__ void ph_norm(const Ctx& C, const float* x, const float* g, bf16_t* H) {
    for (int row = C.gw; row < T; row += C.NGW) {
        const f32x4* xr = (const f32x4*)(x + (size_t)row * DM) + C.lane; f32x4 v[8]; float ss = 0.f;
#pragma unroll
        for (int j = 0; j < 8; ++j) { v[j] = xr[64 * j]; ss += v[j][0] * v[j][0] + v[j][1] * v[j][1] + v[j][2] * v[j][2] + v[j][3] * v[j][3]; }
        const float rstd = rsqrtf(wave_sum(ss, C.lane) * (1.f / DM) + EPS);
        u32x2* o = (u32x2*)(H + (size_t)row * DM) + C.lane;
#pragma unroll
        for (int j = 0; j < 8; ++j) { const f32x4 gg = ((const f32x4*)g)[64 * j + C.lane]; const f32x4 y = v[j] * rstd * gg; u32x2 w; w.x = cvt_pk_bf16(y[0], y[1]); w.y = cvt_pk_bf16(y[2], y[3]); o[64 * j] = w; }
    }
}
__device__ __forceinline__ void ph_ckv(const Ctx& C, const float* dcraw, const float* g, bf16_t* ckv) {
    for (int row = C.gw; row < T; row += C.NGW) {
        const f32x4 v = ((const f32x4*)(dcraw + (size_t)row * 256))[C.lane];
        const float ss = wave_sum(v[0] * v[0] + v[1] * v[1] + v[2] * v[2] + v[3] * v[3], C.lane);
        const float rstd = rsqrtf(ss * (1.f / 256.f) + EPS); const f32x4 y = v * rstd * ((const f32x4*)g)[C.lane];
        u32x2 w; w.x = cvt_pk_bf16(y[0], y[1]); w.y = cvt_pk_bf16(y[2], y[3]); ((u32x2*)(ckv + (size_t)row * 256))[C.lane] = w;
    }
}

__device__ __forceinline__ void ph_gmlp_naive(const Ctx& C, int l) {
    const bf16_t* gu = WSP(bf16_t, WS_PROJ + P_GU); const bf16_t* gv = WSP(bf16_t, WS_PROJ + P_GV); const float* stats = WSP(float, WS_STATS); bf16_t* gm = WSP(bf16_t, WS_GM);
    const float* lng = C.in[I_LNG] + l * 1024; const float* lnb = C.in[I_LNB] + l * 1024; const float* Wsp = C.in[I_WS] + (size_t)l * 4 * 128 * 128; const float* bs = C.in[I_BS] + l * 4 * 128;
    LAS float* smean = (LAS float*)C.lds; LAS float* srstd = smean + 128; LAS float* lv = srstd + 128;
    for (int u = C.bid; u < 512; u += C.G) {
        const int g = u & 3, bn = u >> 2, t0 = bn * 128;
        __syncthreads();
        if (C.tid < 128) { const float* sp = stats + (size_t)(t0 + C.tid) * 32; float s = 0.f, q = 0.f;
            for (int k = 0; k < 16; ++k) { s += sp[2 * k]; q += sp[2 * k + 1]; }
            const float mean = s * (1.f / 1024.f), var = q * (1.f / 1024.f) - mean * mean; smean[C.tid] = mean; srstd[C.tid] = rsqrtf(var + EPS); }
        __syncthreads();
        for (int idx = C.tid; idx < 128 * 256; idx += 512) { const int j = idx >> 8, c = idx & 255, ch = g * 256 + c;
            lv[idx] = (bf2f(gv[(size_t)(t0 + j) * 1024 + ch]) - smean[j]) * srstd[j] * lng[ch] + lnb[ch]; }
        __syncthreads();
        for (int idx = C.tid; idx < 128 * 256; idx += 512) { const int i = idx >> 8, c = idx & 255; const float* wr = Wsp + ((size_t)g * 128 + i) * 128; float a = 0.f;
            for (int j = 0; j <= i; ++j) a += wr[j] * lv[j * 256 + c];
            a += bs[g * 128 + i];
            const size_t o = (size_t)(t0 + i) * 1024 + g * 256 + c; gm[o] = (bf16_t)f2bf(bf2f(gu[o]) * a); }
    }
}
__device__ __forceinline__ void ph_ret_naive(const Ctx& C) {
    const bf16_t* rq = WSP(bf16_t, WS_PROJ + P_RQ); const bf16_t* rk = WSP(bf16_t, WS_PROJ + P_RK); const bf16_t* rv = WSP(bf16_t, WS_PROJ + P_RV); const bf16_t* rg = WSP(bf16_t, WS_PROJ + P_RG); bf16_t* ret = WSP(bf16_t, WS_RET);
    LAS float* sq = (LAS float*)C.lds; LAS float* sa = sq + 256; LAS float* red = sa + 4096;
    for (int u = C.bid; u < NB * 4 * SEQ; u += C.G) {
        const int t = (SEQ - 1) - (u / 16), bh = u % 16, b = bh >> 2, h = bh & 3; const size_t rowb = (size_t)b * SEQ;
        const float lg2 = log2f(1.0f - exp2f(-5.0f - (float)h));
        __syncthreads();
        if (C.tid < 256) sq[C.tid] = bf2f(rq[(rowb + t) * 1024 + h * 256 + C.tid]);
        __syncthreads();
        for (int s = C.tid; s <= t; s += 512) { const u32x4* kp = (const u32x4*)(rk + (rowb + s) * 1024 + h * 256); float a = 0.f;
            for (int d8 = 0; d8 < 32; ++d8) { float f[8]; unpack8(kp[d8], f);
#pragma unroll
                for (int j = 0; j < 8; ++j) a += sq[d8 * 8 + j] * f[j]; }
            sa[s] = a * exp2f(lg2 * (float)(t - s)); }
        __syncthreads();
        float o = 0.f;
        if (C.tid < 256) { const bf16_t* vp = rv + rowb * 1024 + h * 256 + C.tid; for (int s = 0; s <= t; ++s) o += sa[s] * bf2f(vp[(size_t)s * 1024]); }
        const float ss = wave_sum(o * o, C.lane); if (C.lane == 0) red[C.wave] = ss;
        __syncthreads();
        if (C.tid < 256) { const float tot = red[0] + red[1] + red[2] + red[3]; const float y = o * rsqrtf(tot * (1.f / 256.f) + EPS);
            const size_t oi = (rowb + t) * 1024 + h * 256 + C.tid; ret[oi] = (bf16_t)f2bf(bf2f(rg[oi]) * y); }
    }
}
__device__ __forceinline__ void ph_idx_naive(const Ctx& C) {
    const bf16_t* iq = WSP(bf16_t, WS_PROJ + P_IQ); const bf16_t* ik = WSP(bf16_t, WS_PROJ + P_IK); const float* iw = WSP(float, WS_PROJ + P_IW); unsigned short* sel = WSP(unsigned short, WS_SEL);
    LAS float* sq = (LAS float*)C.lds; LAS float* sw = sq + 512; LAS float* sc = sw + 8;
    for (int u = C.bid; u < T; u += C.G) {
        const int tq = (T - 1) - u; const int b = tq >> 12, q = tq & (SEQ - 1), n = q + 1;
        __syncthreads();
        sq[C.tid] = bf2f(iq[(size_t)tq * 512 + C.tid]); if (C.tid < 8) sw[C.tid] = iw[(size_t)tq * 8 + C.tid];
        for (int r = C.tid; r < 256; r += 512) sel[(size_t)tq * 256 + r] = 0xFFFFu;
        __syncthreads();
        for (int s = C.tid; s < n; s += 512) { const u32x4* kp = (const u32x4*)(ik + ((size_t)b * SEQ + s) * 64); float kf[64];
#pragma unroll
            for (int d8 = 0; d8 < 8; ++d8) { float f[8]; unpack8(kp[d8], f);
#pragma unroll
                for (int j = 0; j < 8; ++j) kf[d8 * 8 + j] = f[j]; }
            float score = 0.f;
#pragma unroll 1
            for (int h = 0; h < 8; ++h) { float a = 0.f;
#pragma unroll
                for (int d = 0; d < 64; ++d) a += sq[h * 64 + d] * kf[d];
                score += sw[h] * fmaxf(a * 0.125f, 0.f); }
            sc[s] = score; }
        __syncthreads();
        for (int s = C.tid; s < n; s += 512) { const float v = sc[s]; int rank = 0;
            for (int s2 = 0; s2 < n; ++s2) { const float w = sc[s2]; rank += (w > v || (w == v && s2 < s)) ? 1 : 0; }
            if (rank < 256) sel[(size_t)tq * 256 + rank] = (unsigned short)s; }
    }
}
__device__ __forceinline__ void ph_att_naive(const Ctx& C) {
    const bf16_t* qabs = WSP(bf16_t, WS_QABS); const bf16_t* ckv = WSP(bf16_t, WS_CKV); const unsigned short* sel = WSP(unsigned short, WS_SEL); bf16_t* olat = WSP(bf16_t, WS_OLAT);
    LAS float* sqa = (LAS float*)C.lds; LAS float* sp = sqa + 2048; LAS int* ssel = (LAS int*)(sp + 2048);
    for (int tq = C.bid; tq < T; tq += C.G) {
        const int b = tq >> 12, q = tq & (SEQ - 1);
        __syncthreads();
        for (int i = C.tid; i < 2048; i += 512) sqa[i] = bf2f(qabs[(size_t)tq * 2048 + i]);
        if (C.tid < 256) { const int s = sel[(size_t)tq * 256 + C.tid]; ssel[C.tid] = (s <= q) ? s : -1; }
        __syncthreads();
        const int h = C.wave; float sv[4]; float mx = -INFINITY;
#pragma unroll
        for (int j = 0; j < 4; ++j) { const int k = C.lane + 64 * j, s = ssel[k]; float a = -INFINITY;
            if (s >= 0) { const u32x4* cp = (const u32x4*)(ckv + ((size_t)b * SEQ + s) * 256); a = 0.f;
                for (int c8 = 0; c8 < 32; ++c8) { float f[8]; unpack8(cp[c8], f);
#pragma unroll
                    for (int jj = 0; jj < 8; ++jj) a += sqa[h * 256 + c8 * 8 + jj] * f[jj]; } }
            sv[j] = a; mx = fmaxf(mx, a); }
        mx = wave_max(mx, C.lane); float sum = 0.f;
#pragma unroll
        for (int j = 0; j < 4; ++j) { sv[j] = __expf(sv[j] - mx); sum += sv[j]; }
        sum = wave_sum(sum, C.lane); const float inv = 1.f / sum;
#pragma unroll
        for (int j = 0; j < 4; ++j) sp[h * 256 + C.lane + 64 * j] = sv[j] * inv;
        __syncthreads();
        float o[4] = {0.f, 0.f, 0.f, 0.f};
        for (int k = 0; k < 256; ++k) { const int s = ssel[k]; if (s < 0) continue; const float p = sp[h * 256 + k]; const bf16_t* cp = ckv + ((size_t)b * SEQ + s) * 256 + C.lane;
#pragma unroll
            for (int j = 0; j < 4; ++j) o[j] += p * bf2f(cp[64 * j]); }
#pragma unroll
        for (int j = 0; j < 4; ++j) olat[(size_t)tq * 2048 + h * 256 + C.lane + 64 * j] = (bf16_t)f2bf(o[j]);
    }
}

typedef short v4i16_t __attribute__((ext_vector_type(4)));
__device__ __forceinline__ s16x4 tr_read(const LAS unsigned char* p) { return __builtin_bit_cast(s16x4, __builtin_amdgcn_ds_read_tr16_b64_v4i16((LAS v4i16_t*)p)); }
__device__ __forceinline__ bf16x8 tr_frag(const LAS unsigned char* X, int LDX, int rowA, int rowB, int n0, int lane) {
    const int q = (lane & 15) >> 2, p = lane & 3;
    const s16x4 lo = tr_read(X + (rowA + q) * LDX + (n0 + 4 * p) * 2), hi = tr_read(X + (rowB + q) * LDX + (n0 + 4 * p) * 2);
    return (bf16x8){lo[0], lo[1], lo[2], lo[3], hi[0], hi[1], hi[2], hi[3]};
}
constexpr int TLD = 544;
__device__ __forceinline__ bf16x8 as_bf16x8(u32x4 w) { return __builtin_bit_cast(bf16x8, w); }

__device__ __forceinline__ void ph_ret_kv(const Ctx& C) {
    const bf16_t* rk = WSP(bf16_t, WS_PROJ + P_RK); const bf16_t* rv = WSP(bf16_t, WS_PROJ + P_RV); bf16_t* KV = WSP(bf16_t, WS_KV);
    const LAS unsigned char* Vt = C.lds; const LAS unsigned char* Kt = C.lds + 128 * TLD;
    const int g = C.lane >> 4, fr = C.lane & 15, wr = C.wave >> 2, wc = C.wave & 3;
    for (int u = C.bid; u < 512; u += C.G) {
        const int n = u & 31, h = (u >> 5) & 3, b = u >> 7; const size_t row0 = (size_t)b * SEQ + n * 128;
        const float lg2 = log2f(1.0f - exp2f(-5.0f - (float)h));
        __syncthreads();
#pragma unroll
        for (int p = 0; p < 8; ++p) { const int idx = p * 512 + C.tid, row = idx >> 5, ch = idx & 31; const size_t go = (row0 + row) * 1024 + h * 256 + ch * 8;
            const u32x4 vv = *(const u32x4*)(rv + go); *(LAS u32x4*)(C.lds + row * TLD + ch * 16) = vv;
            float f[8]; unpack8(*(const u32x4*)(rk + go), f); const float z = exp2f(lg2 * (float)(127 - row));
            *(LAS u32x4*)(C.lds + 128 * TLD + row * TLD + ch * 16) = pack8((f32x4){f[0] * z, f[1] * z, f[2] * z, f[3] * z}, (f32x4){f[4] * z, f[5] * z, f[6] * z, f[7] * z}); }
        __syncthreads();
        f32x4 acc[8][4];
#pragma unroll
        for (int m = 0; m < 8; ++m)
#pragma unroll
            for (int nn = 0; nn < 4; ++nn) acc[m][nn] = (f32x4){0.f, 0.f, 0.f, 0.f};
#pragma unroll 1
        for (int ks = 0; ks < 4; ++ks) { bf16x8 Bv[4];
#pragma unroll
            for (int nn = 0; nn < 4; ++nn) Bv[nn] = tr_frag(Vt, TLD, 32 * ks + 8 * g, 32 * ks + 8 * g + 4, 64 * wc + 16 * nn, C.lane);
#pragma unroll
            for (int m = 0; m < 8; ++m) { const bf16x8 Ak = tr_frag(Kt, TLD, 32 * ks + 8 * g, 32 * ks + 8 * g + 4, 128 * wr + 16 * m, C.lane);
#pragma unroll
                for (int nn = 0; nn < 4; ++nn) acc[m][nn] = __builtin_amdgcn_mfma_f32_16x16x32_bf16(Ak, Bv[nn], acc[m][nn], 0, 0, 0); } }
        bf16_t* out = KV + (size_t)u * 65536;
#pragma unroll
        for (int m = 0; m < 8; ++m)
#pragma unroll
            for (int nn = 0; nn < 4; ++nn) { const int e = 64 * wc + 16 * nn + fr, d = 128 * wr + 16 * m + 4 * g; u32x2 w; w.x = cvt_pk_bf16(acc[m][nn][0], acc[m][nn][1]); w.y = cvt_pk_bf16(acc[m][nn][2], acc[m][nn][3]);
                *(u32x2*)(out + e * 256 + d) = w; }
    }
}
__device__ __forceinline__ void ph_ret_scan(const Ctx& C) {
    const bf16_t* KV = WSP(bf16_t, WS_KV); bf16_t* Rb = WSP(bf16_t, WS_R);
    for (int idx = C.bid * 512 + C.tid; idx < 16 * 8192; idx += C.G * 512) {
        const int bh = idx >> 13, off = (idx & 8191) * 8, h = bh & 3; const float gc = exp2f(128.0f * log2f(1.0f - exp2f(-5.0f - (float)h)));
        float R[8] = {0.f, 0.f, 0.f, 0.f, 0.f, 0.f, 0.f, 0.f};
#pragma unroll 4
        for (int n = 0; n < 32; ++n) { const size_t o = ((size_t)bh * 32 + n) * 65536 + off;
            *(u32x4*)(Rb + o) = pack8((f32x4){R[0], R[1], R[2], R[3]}, (f32x4){R[4], R[5], R[6], R[7]});
            float f[8]; unpack8(*(const u32x4*)(KV + o), f);
#pragma unroll
            for (int j = 0; j < 8; ++j) R[j] = R[j] * gc + f[j]; }
    }
}
__device__ __forceinline__ void ph_ret_out(const Ctx& C) {
    const bf16_t* rq = WSP(bf16_t, WS_PROJ + P_RQ); const bf16_t* rk = WSP(bf16_t, WS_PROJ + P_RK); const bf16_t* rv = WSP(bf16_t, WS_PROJ + P_RV); const bf16_t* rg = WSP(bf16_t, WS_PROJ + P_RG);
    const bf16_t* Rb = WSP(bf16_t, WS_R); bf16_t* ret = WSP(bf16_t, WS_RET);
    const LAS unsigned char* Vt = C.lds;
    const int g = C.lane >> 4, fr = C.lane & 15, w = C.wave;
    for (int u = C.bid; u < 512; u += C.G) {
        const int n = u & 31, h = (u >> 5) & 3, b = u >> 7; const size_t row0 = (size_t)b * SEQ + n * 128;
        const float lg2 = log2f(1.0f - exp2f(-5.0f - (float)h));
        __syncthreads();
#pragma unroll
        for (int p = 0; p < 8; ++p) { const int idx = p * 512 + C.tid, row = idx >> 5, ch = idx & 31;
            *(LAS u32x4*)(C.lds + row * TLD + ch * 16) = *(const u32x4*)(rv + (row0 + row) * 1024 + h * 256 + ch * 8); }
        __syncthreads();
        const int i = 16 * w + fr;
        bf16x8 Bq[8];
        { const bf16_t* qp = rq + (row0 + i) * 1024 + h * 256 + 8 * g;
#pragma unroll
          for (int ks = 0; ks < 8; ++ks) Bq[ks] = as_bf16x8(*(const u32x4*)(qp + 32 * ks)); }
        f32x4 acc[16];
#pragma unroll
        for (int nt = 0; nt < 16; ++nt) acc[nt] = (f32x4){0.f, 0.f, 0.f, 0.f};
        if (n > 0) {
            const bf16_t* rp = Rb + (size_t)u * 65536 + (size_t)fr * 256 + 8 * g;
#pragma unroll
            for (int ks = 0; ks < 8; ++ks)
#pragma unroll
                for (int nt = 0; nt < 16; ++nt) { const bf16x8 Ar = as_bf16x8(*(const u32x4*)(rp + nt * 16 * 256 + 32 * ks)); acc[nt] = __builtin_amdgcn_mfma_f32_16x16x32_bf16(Ar, Bq[ks], acc[nt], 0, 0, 0); }
            const float xi = exp2f(lg2 * (float)(i + 1));
#pragma unroll
            for (int nt = 0; nt < 16; ++nt) acc[nt] = acc[nt] * xi;
        }
        f32x4 ST[8];
#pragma unroll
        for (int jt = 0; jt < 8; ++jt) { ST[jt] = (f32x4){0.f, 0.f, 0.f, 0.f};
            if (jt <= w) { const bf16_t* kp = rk + (row0 + 16 * jt + fr) * 1024 + h * 256 + 8 * g;
#pragma unroll
                for (int ks = 0; ks < 8; ++ks) { const bf16x8 Ak = as_bf16x8(*(const u32x4*)(kp + 32 * ks)); ST[jt] = __builtin_amdgcn_mfma_f32_16x16x32_bf16(Ak, Bq[ks], ST[jt], 0, 0, 0); }
#pragma unroll
                for (int r = 0; r < 4; ++r) { const int j = 16 * jt + 4 * g + r; ST[jt][r] = (i >= j) ? ST[jt][r] * exp2f(lg2 * (float)(i - j)) : 0.f; } } }
#pragma unroll
        for (int t = 0; t < 4; ++t) if (2 * t <= w) {
            u32x4 sw; sw.x = cvt_pk_bf16(ST[2 * t][0], ST[2 * t][1]); sw.y = cvt_pk_bf16(ST[2 * t][2], ST[2 * t][3]); sw.z = cvt_pk_bf16(ST[2 * t + 1][0], ST[2 * t + 1][1]); sw.w = cvt_pk_bf16(ST[2 * t + 1][2], ST[2 * t + 1][3]);
            const bf16x8 Bs = as_bf16x8(sw);
#pragma unroll
            for (int nt = 0; nt < 16; ++nt) { const bf16x8 Av = tr_frag(Vt, TLD, 32 * t + 4 * g, 32 * t + 16 + 4 * g, 16 * nt, C.lane); acc[nt] = __builtin_amdgcn_mfma_f32_16x16x32_bf16(Av, Bs, acc[nt], 0, 0, 0); } }
        float ss = 0.f;
#pragma unroll
        for (int nt = 0; nt < 16; ++nt) ss += acc[nt][0] * acc[nt][0] + acc[nt][1] * acc[nt][1] + acc[nt][2] * acc[nt][2] + acc[nt][3] * acc[nt][3];
        ss += shx(ss, 16, C.lane); ss += shx(ss, 32, C.lane);
        const float rstd = rsqrtf(ss * (1.f / 256.f) + EPS);
        const size_t ob = (row0 + i) * 1024 + h * 256 + 4 * g;
#pragma unroll
        for (int nt = 0; nt < 16; ++nt) { const u32x2 gw = *(const u32x2*)(rg + ob + 16 * nt); u32x2 o;
            o.x = cvt_pk_bf16(acc[nt][0] * rstd * bf2f(gw.x), acc[nt][1] * rstd * bf2f(gw.x >> 16)); o.y = cvt_pk_bf16(acc[nt][2] * rstd * bf2f(gw.y), acc[nt][3] * rstd * bf2f(gw.y >> 16));
            *(u32x2*)(ret + ob + 16 * nt) = o; }
    }
}
__device__ __forceinline__ void ph_gmlp(const Ctx& C, int l) {
    const bf16_t* gu = WSP(bf16_t, WS_PROJ + P_GU); const bf16_t* gv = WSP(bf16_t, WS_PROJ + P_GV); const float* stats = WSP(float, WS_STATS); bf16_t* gm = WSP(bf16_t, WS_GM);
    const float* lng = C.in[I_LNG] + l * 1024; const float* lnb = C.in[I_LNB] + l * 1024; const float* Wsp = C.in[I_WS] + (size_t)l * 4 * 128 * 128; const float* bs = C.in[I_BS] + l * 4 * 128;
    constexpr int WLD = 272, W_OFF = 128 * TLD, ST_OFF = W_OFF + 128 * WLD;
    const LAS unsigned char* Lt = C.lds; LAS float* sst = (LAS float*)(C.lds + ST_OFF);
    const int g4 = C.lane >> 4, fr = C.lane & 15, w = C.wave;
    for (int u = C.bid; u < 512; u += C.G) {
        const int gg = u & 3, bn = u >> 2, t0 = bn * 128;
        __syncthreads();
        if (C.tid < 128) { const float* sp = stats + (size_t)(t0 + C.tid) * 32; float s = 0.f, q = 0.f;
#pragma unroll
            for (int k = 0; k < 16; ++k) { s += sp[2 * k]; q += sp[2 * k + 1]; }
            const float mean = s * (1.f / 1024.f), var = q * (1.f / 1024.f) - mean * mean; sst[2 * C.tid] = mean; sst[2 * C.tid + 1] = rsqrtf(var + EPS); }
#pragma unroll
        for (int p = 0; p < 4; ++p) { const int idx = p * 512 + C.tid, i = idx >> 4, j8 = (idx & 15) * 8; const float* wp = Wsp + ((size_t)gg * 128 + i) * 128 + j8;
            f32x4 a = *(const f32x4*)wp, b2 = *(const f32x4*)(wp + 4);
#pragma unroll
            for (int j = 0; j < 4; ++j) { if (j8 + j > i) a[j] = 0.f; if (j8 + 4 + j > i) b2[j] = 0.f; }
            *(LAS u32x4*)(C.lds + W_OFF + i * WLD + j8 * 2) = pack8(a, b2); }
        __syncthreads();
#pragma unroll
        for (int p = 0; p < 8; ++p) { const int idx = p * 512 + C.tid, row = idx >> 5, ch = idx & 31, cg = gg * 256 + ch * 8;
            float f[8]; unpack8(*(const u32x4*)(gv + (size_t)(t0 + row) * 1024 + cg), f); const float mean = sst[2 * row], rstd = sst[2 * row + 1];
            const f32x4 g0 = *(const f32x4*)(lng + cg), g1 = *(const f32x4*)(lng + cg + 4), b0 = *(const f32x4*)(lnb + cg), b1 = *(const f32x4*)(lnb + cg + 4);
            f32x4 y0, y1;
#pragma unroll
            for (int j = 0; j < 4; ++j) { y0[j] = (f[j] - mean) * rstd * g0[j] + b0[j]; y1[j] = (f[4 + j] - mean) * rstd * g1[j] + b1[j]; }
            *(LAS u32x4*)(C.lds + row * TLD + ch * 16) = pack8(y0, y1); }
        __syncthreads();
        f32x4 acc[16];
#pragma unroll
        for (int nt = 0; nt < 16; ++nt) acc[nt] = (f32x4){0.f, 0.f, 0.f, 0.f};
#pragma unroll
        for (int ks = 0; ks < 4; ++ks) if (2 * ks <= w) {
            const bf16x8 Bw = as_bf16x8(*(const LAS u32x4*)(C.lds + W_OFF + (16 * w + fr) * WLD + (32 * ks + 8 * g4) * 2));
#pragma unroll
            for (int nt = 0; nt < 16; ++nt) { const bf16x8 Av = tr_frag(Lt, TLD, 32 * ks + 8 * g4, 32 * ks + 8 * g4 + 4, 16 * nt, C.lane); acc[nt] = __builtin_amdgcn_mfma_f32_16x16x32_bf16(Av, Bw, acc[nt], 0, 0, 0); } }
        const int i = 16 * w + fr; const float bias = bs[gg * 128 + i]; const size_t ob = (size_t)(t0 + i) * 1024 + gg * 256 + 4 * g4;
#pragma unroll
        for (int nt = 0; nt < 16; ++nt) { const u32x2 uw = *(const u32x2*)(gu + ob + 16 * nt); u32x2 o;
            o.x = cvt_pk_bf16((acc[nt][0] + bias) * bf2f(uw.x), (acc[nt][1] + bias) * bf2f(uw.x >> 16)); o.y = cvt_pk_bf16((acc[nt][2] + bias) * bf2f(uw.y), (acc[nt][3] + bias) * bf2f(uw.y >> 16));
            *(u32x2*)(gm + ob + 16 * nt) = o; }
    }
}

__device__ __forceinline__ void ph_idx(const Ctx& C) {
    const bf16_t* iq = WSP(bf16_t, WS_PROJ + P_IQ); const bf16_t* ik = WSP(bf16_t, WS_PROJ + P_IK); const float* iw = WSP(float, WS_PROJ + P_IW); unsigned short* sel = WSP(unsigned short, WS_SEL);
    LAS unsigned* sc = (LAS unsigned*)C.lds;
    const int lane = C.lane, n32 = lane & 31, hh = lane >> 5, w = C.wave;
    for (int u = C.bid; u < T / 8; u += C.G) {
        const int b = u & 3, q0 = (SEQ / 8 - 1 - (u >> 2)) * 8, tq0 = b * SEQ + q0, nk = q0 + 8, nkt = (nk + 31) >> 5;
        __syncthreads();
        bf16x8 Aq[2][4]; float wq[2][16];
        { const int r = n32, qi = 2 * ((r >> 2) & 1) + (r >> 4), hd = (r & 3) + 4 * ((r >> 3) & 1);
#pragma unroll
          for (int mt = 0; mt < 2; ++mt) { const bf16_t* qp = iq + (size_t)(tq0 + 4 * mt + qi) * 512 + hd * 64 + 8 * hh;
#pragma unroll
              for (int ks = 0; ks < 4; ++ks) Aq[mt][ks] = as_bf16x8(*(const u32x4*)(qp + 16 * ks));
#pragma unroll
              for (int a = 0; a < 2; ++a) { const float* wp = iw + (size_t)(tq0 + 4 * mt + 2 * hh + a) * 8; const f32x4 w0 = *(const f32x4*)wp, w1 = *(const f32x4*)(wp + 4);
#pragma unroll
                  for (int j = 0; j < 4; ++j) { wq[mt][8 * a + j] = w0[j] * 0.125f; wq[mt][8 * a + 4 + j] = w1[j] * 0.125f; } } } }
        u32x4 Bn[4];
        { const bf16_t* kp = ik + ((size_t)b * SEQ + 32 * (w < nkt ? w : 0) + n32) * 64 + 8 * hh;
#pragma unroll
          for (int ks = 0; ks < 4; ++ks) Bn[ks] = *(const u32x4*)(kp + 16 * ks); }
        for (int kt = w; kt < nkt; kt += 8) {
            bf16x8 Bk[4];
#pragma unroll
            for (int ks = 0; ks < 4; ++ks) Bk[ks] = as_bf16x8(Bn[ks]);
            { const int k2 = (kt + 8 < nkt) ? kt + 8 : kt; const bf16_t* kp = ik + ((size_t)b * SEQ + 32 * k2 + n32) * 64 + 8 * hh;
#pragma unroll
              for (int ks = 0; ks < 4; ++ks) Bn[ks] = *(const u32x4*)(kp + 16 * ks); }
#pragma unroll
            for (int mt = 0; mt < 2; ++mt) { f32x16 acc;
#pragma unroll
                for (int j = 0; j < 16; ++j) acc[j] = 0.f;
#pragma unroll
                for (int ks = 0; ks < 4; ++ks) acc = __builtin_amdgcn_mfma_f32_32x32x16_bf16(Aq[mt][ks], Bk[ks], acc, 0, 0, 0);
#pragma unroll
                for (int a = 0; a < 2; ++a) { float s = 0.f;
#pragma unroll
                    for (int rr = 0; rr < 8; ++rr) s += wq[mt][8 * a + rr] * fmaxf(acc[8 * a + rr], 0.f);
                    const int qu = 4 * mt + 2 * hh + a, key = 32 * kt + n32; unsigned bits = __builtin_bit_cast(unsigned, s);
                    bits = (bits & 0x80000000u) ? ~bits : (bits | 0x80000000u);
                    sc[qu * 4096 + key] = (key <= q0 + qu) ? bits : 0u; } }
        }
        __syncthreads();
        { const int q = q0 + w, n = q + 1; const size_t so = (size_t)(tq0 + w) * 256;
          if (n <= 256) { for (int r = lane; r < 256; r += 64) sel[so + r] = (r < n) ? (unsigned short)r : (unsigned short)0xFFFFu; }
          else {
            const int ni = (n + 63) >> 6;
            unsigned uu[64];
#pragma unroll
            for (int i = 0; i < 64; ++i) uu[i] = (i < ni && 64 * i + lane < nkt * 32) ? sc[w * 4096 + 64 * i + lane] : 0u;
            unsigned Tv = 0u;
#pragma unroll 1
            for (int bit = 31; bit >= 0; --bit) { const unsigned cand = Tv | (1u << bit); int c = 0;
#pragma unroll
                for (int g4 = 0; g4 < 4; ++g4) if (16 * g4 < ni) {
#pragma unroll
                    for (int i = 16 * g4; i < 16 * g4 + 16; ++i) c += (uu[i] >= cand) ? 1 : 0; }
                if (wave_total_dpp(c) >= 256) Tv = cand; }
            int cg = 0;
#pragma unroll
            for (int i = 0; i < 64; ++i) cg += (uu[i] > Tv) ? 1 : 0;
            const int need = 256 - wave_total_dpp(cg); int base = 0, eqs = 0; const unsigned long long lt = (1ull << lane) - 1ull;
#pragma unroll
            for (int i = 0; i < 64; ++i) if (16 * (i >> 4) < ni) { const bool gt = uu[i] > Tv, eq = uu[i] == Tv; const unsigned long long em = __ballot(eq);
                const bool take = gt || (eq && (eqs + __builtin_popcountll(em & lt)) < need); const unsigned long long tm = __ballot(take);
                if (take) sel[so + base + __builtin_popcountll(tm & lt)] = (unsigned short)(64 * i + lane);
                base += __builtin_popcountll(tm); eqs += __builtin_popcountll(em); }
          } }
    }
}
__device__ __forceinline__ void ph_att(const Ctx& C) {
    const bf16_t* qabs = WSP(bf16_t, WS_QABS); const bf16_t* ckv = WSP(bf16_t, WS_CKV); const unsigned short* sel = WSP(unsigned short, WS_SEL); bf16_t* olat = WSP(bf16_t, WS_OLAT);
    const int lane = C.lane, g = lane >> 4, fr = lane & 15;
    LAS unsigned char* ch = C.lds + C.wave * (32 * TLD + 512);
    LAS unsigned short* ssel = (LAS unsigned short*)(ch + 32 * TLD);
    for (int tq = C.gw; tq < T; tq += C.NGW) {
        const int b = tq >> 12, q = tq & (SEQ - 1), nv = (q + 1) < 256 ? (q + 1) : 256, nch = (nv + 31) >> 5;
        const bf16_t* cb = ckv + (size_t)b * SEQ * 256;
        { u32x2 sv = *(const u32x2*)(sel + (size_t)tq * 256 + 4 * lane);
          unsigned s0 = sv.x & 0xffffu, s1 = sv.x >> 16, s2_ = sv.y & 0xffffu, s3 = sv.y >> 16;
          if (4 * lane + 0 >= nv) s0 = 0; if (4 * lane + 1 >= nv) s1 = 0; if (4 * lane + 2 >= nv) s2_ = 0; if (4 * lane + 3 >= nv) s3 = 0;
          *(LAS u32x2*)(ssel + 4 * lane) = (u32x2){s0 | (s1 << 16), s2_ | (s3 << 16)}; }
        bf16x8 Bqa[8];
        { const bf16_t* qp = qabs + (size_t)tq * 2048 + (fr & 7) * 256 + 8 * g;
#pragma unroll
          for (int ks = 0; ks < 8; ++ks) { u32x4 v = *(const u32x4*)(qp + 32 * ks); if (fr >= 8) v = (u32x4){0u, 0u, 0u, 0u}; Bqa[ks] = as_bf16x8(v); } }
        f32x4 acc[16];
#pragma unroll
        for (int nt = 0; nt < 16; ++nt) acc[nt] = (f32x4){0.f, 0.f, 0.f, 0.f};
        float mrun = -INFINITY, lrun = 0.f;
        asm volatile("s_waitcnt lgkmcnt(0)" ::: "memory");
        u32x4 G[16];
#pragma unroll
        for (int p = 0; p < 16; ++p) { const int s = ssel[2 * p + (lane >> 5)]; G[p] = *(const u32x4*)(cb + (size_t)s * 256 + (lane & 31) * 8); }
#pragma unroll 1
        for (int t = 0; t < nch; ++t) {
#pragma unroll
            for (int p = 0; p < 16; ++p) *(LAS u32x4*)(ch + (2 * p + (lane >> 5)) * TLD + (lane & 31) * 16) = G[p];
            if (t + 1 < nch) {
#pragma unroll
                for (int p = 0; p < 16; ++p) { const int s = ssel[32 * (t + 1) + 2 * p + (lane >> 5)]; G[p] = *(const u32x4*)(cb + (size_t)s * 256 + (lane & 31) * 8); } }
            asm volatile("s_waitcnt lgkmcnt(0)" ::: "memory");
            f32x4 s2[2];
#pragma unroll
            for (int hf = 0; hf < 2; ++hf) { s2[hf] = (f32x4){0.f, 0.f, 0.f, 0.f};
#pragma unroll
                for (int ks = 0; ks < 8; ++ks) { const bf16x8 Ac = as_bf16x8(*(const LAS u32x4*)(ch + (16 * hf + fr) * TLD + (32 * ks + 8 * g) * 2)); s2[hf] = __builtin_amdgcn_mfma_f32_16x16x32_bf16(Ac, Bqa[ks], s2[hf], 0, 0, 0); } }
            float cm = -INFINITY;
#pragma unroll
            for (int hf = 0; hf < 2; ++hf)
#pragma unroll
                for (int r = 0; r < 4; ++r) { const int ki = 32 * t + 16 * hf + 4 * g + r; if (ki >= nv) s2[hf][r] = -INFINITY; cm = fmaxf(cm, s2[hf][r]); }
            cm = fmaxf(cm, shx(cm, 16, lane)); cm = fmaxf(cm, shx(cm, 32, lane));
            const float mnew = fmaxf(mrun, cm), scale = __expf(mrun - mnew); float ps = 0.f;
#pragma unroll
            for (int hf = 0; hf < 2; ++hf)
#pragma unroll
                for (int r = 0; r < 4; ++r) { s2[hf][r] = __expf(s2[hf][r] - mnew); ps += s2[hf][r]; }
            ps += shx(ps, 16, lane); ps += shx(ps, 32, lane);
            lrun = lrun * scale + ps; mrun = mnew;
            u32x4 pw; pw.x = cvt_pk_bf16(s2[0][0], s2[0][1]); pw.y = cvt_pk_bf16(s2[0][2], s2[0][3]); pw.z = cvt_pk_bf16(s2[1][0], s2[1][1]); pw.w = cvt_pk_bf16(s2[1][2], s2[1][3]);
            const bf16x8 Bp = as_bf16x8(pw);
#pragma unroll
            for (int nt = 0; nt < 16; ++nt) { const bf16x8 Av = tr_frag(ch, TLD, 4 * g, 16 + 4 * g, 16 * nt, lane); acc[nt] = __builtin_amdgcn_mfma_f32_16x16x32_bf16(Av, Bp, acc[nt] * scale, 0, 0, 0); }
            asm volatile("s_waitcnt lgkmcnt(0)" ::: "memory");
        }
        const float inv = 1.0f / lrun;
        if (fr < 8) { bf16_t* op = olat + (size_t)tq * 2048 + fr * 256 + 4 * g;
#pragma unroll
            for (int nt = 0; nt < 16; ++nt) { u32x2 o; o.x = cvt_pk_bf16(acc[nt][0] * inv, acc[nt][1] * inv); o.y = cvt_pk_bf16(acc[nt][2] * inv, acc[nt][3] * inv); *(u32x2*)(op + 16 * nt) = o; } }
    }
}

__device__ __forceinline__ void ph_norm_hilo(const Ctx& C, const float* x, const float* g, bf16_t* H, bf16_t* HLO) {
    for (int row = C.gw; row < T; row += C.NGW) {
        const f32x4* xr = (const f32x4*)(x + (size_t)row * DM) + C.lane; f32x4 v[8]; float ss = 0.f;
#pragma unroll
        for (int j = 0; j < 8; ++j) { v[j] = xr[64 * j]; ss += v[j][0] * v[j][0] + v[j][1] * v[j][1] + v[j][2] * v[j][2] + v[j][3] * v[j][3]; }
        const float rstd = rsqrtf(wave_sum(ss, C.lane) * (1.f / DM) + EPS);
        u32x2* oh = (u32x2*)(H + (size_t)row * DM) + C.lane; u32x2* ol = (u32x2*)(HLO + (size_t)row * DM) + C.lane;
#pragma unroll
        for (int j = 0; j < 8; ++j) { const f32x4 gg = ((const f32x4*)g)[64 * j + C.lane]; const f32x4 y = v[j] * rstd * gg; u32x2 wh; wh.x = cvt_pk_bf16(y[0], y[1]); wh.y = cvt_pk_bf16(y[2], y[3]);
            u32x2 wl; wl.x = cvt_pk_bf16(y[0] - bf2f(wh.x), y[1] - bf2f(wh.x >> 16)); wl.y = cvt_pk_bf16(y[2] - bf2f(wh.y), y[3] - bf2f(wh.y >> 16)); oh[64 * j] = wh; ol[64 * j] = wl; }
    }
}
__device__ __forceinline__ void ph_route(const Ctx& C, int l) {
    const float* LOG = WSP(float, WS_OLAT); const float* bg = C.in[I_BGRP] + l * 4; const float* be = C.in[I_BEXP] + l * 32;
    int* rinfo = WSP(int, WS_ROUTE); float* rw = (float*)(rinfo + T * 4); unsigned* cnt = C.ctl + CW_CNT + l * 64;
    for (int t = C.bid * 512 + C.tid; t < T; t += C.G * 512) {
        float lg[36];
#pragma unroll
        for (int c = 0; c < 36; ++c) lg[c] = 0.f;
#pragma unroll
        for (int part = 0; part < 4; ++part) { const f32x4* p = (const f32x4*)(LOG + ((size_t)part * T + t) * 128);
#pragma unroll
            for (int c4 = 0; c4 < 9; ++c4) { const f32x4 a = p[c4];
#pragma unroll
                for (int j = 0; j < 4; ++j) lg[4 * c4 + j] += a[j];
                if (part < 2) { const f32x4 b2 = p[16 + c4];
#pragma unroll
                    for (int j = 0; j < 4; ++j) lg[4 * c4 + j] += b2[j]; } } }
        int gsel = 0; float gmax = -INFINITY, gv4[4];
#pragma unroll
        for (int k = 0; k < 4; ++k) { gv4[k] = lg[k] + bg[k]; if (gv4[k] > gmax) { gmax = gv4[k]; gsel = k; } }
        float gden = 0.f;
#pragma unroll
        for (int k = 0; k < 4; ++k) gden += __expf(gv4[k] - gmax);
        const float pg = 1.f / gden;
        float el[8], emax = -INFINITY;
#pragma unroll
        for (int k = 0; k < 8; ++k) { const float v0 = lg[4 + k] + be[k], v1 = lg[12 + k] + be[8 + k], v2 = lg[20 + k] + be[16 + k], v3 = lg[28 + k] + be[24 + k];
            el[k] = gsel == 0 ? v0 : (gsel == 1 ? v1 : (gsel == 2 ? v2 : v3)); emax = fmaxf(emax, el[k]); }
        float eden = 0.f, ep[8];
#pragma unroll
        for (int k = 0; k < 8; ++k) { ep[k] = __expf(el[k] - emax); eden += ep[k]; }
        int i0 = 0; float p0 = -1.f;
#pragma unroll
        for (int k = 0; k < 8; ++k) { ep[k] = ep[k] / eden; if (ep[k] > p0) { p0 = ep[k]; i0 = k; } }
        int i1 = 0; float p1 = -1.f;
#pragma unroll
        for (int k = 0; k < 8; ++k) if (k != i0 && ep[k] > p1) { p1 = ep[k]; i1 = k; }
        const float den = p0 + p1; const int e0 = gsel * 8 + i0, e1 = gsel * 8 + i1;
        const unsigned r0 = atomicAdd(&cnt[e0], 1u), r1 = atomicAdd(&cnt[e1], 1u);
        *(int4*)(rinfo + (size_t)t * 4) = make_int4(e0, e1, (int)r0, (int)r1); *(f32x2*)(rw + (size_t)t * 2) = (f32x2){pg * (p0 / den), pg * (p1 / den)};
    }
}
__device__ __forceinline__ int moe_offsets(const unsigned* cnt, int lane, int& total_tiles) {
    const int c = lane < NEXP ? (int)__hip_atomic_load(cnt + lane, __ATOMIC_RELAXED, __HIP_MEMORY_SCOPE_AGENT) : 0; const int tiles = (c + 255) >> 8;
    int incl = tiles;
#pragma unroll
    for (int o = 1; o < 64; o <<= 1) { const int t = shi(incl, (lane - o) & 63); if (lane >= o) incl += t; }
    total_tiles = shi(incl, 63);
    return (incl - tiles) * 256;
}
__device__ __forceinline__ void ph_permute(const Ctx& C, int l) {
    const bf16_t* H = WSP(bf16_t, WS_H); bf16_t* hperm = WSP(bf16_t, WS_PROJ + M_HPERM); int* rinfo = WSP(int, WS_ROUTE); int* rpos = rinfo + T * 6;
    int tt; const int myoff = moe_offsets(C.ctl + CW_CNT + l * 64 + CNT_BANK, C.lane, tt);
    for (int row = C.gw; row < T; row += C.NGW) {
        const int4 ri = *(const int4*)(rinfo + (size_t)row * 4);
        const int p0 = shi(myoff, ri.x) + ri.z, p1 = shi(myoff, ri.y) + ri.w;
        const u32x4* src = (const u32x4*)(H + (size_t)row * DM) + C.lane; u32x4* d0 = (u32x4*)(hperm + (size_t)p0 * DM) + C.lane; u32x4* d1 = (u32x4*)(hperm + (size_t)p1 * DM) + C.lane;
#pragma unroll
        for (int j = 0; j < 4; ++j) { const u32x4 w = src[64 * j]; d0[64 * j] = w; d1[64 * j] = w; }
        if (C.lane == 0) { rpos[(size_t)row * 2] = p0; rpos[(size_t)row * 2 + 1] = p1; }
    }
}
__device__ __forceinline__ int moe_table(const Ctx& C, int l) {
    __syncthreads();
    if (C.wave == 0) { int tt; const int off = moe_offsets(C.ctl + CW_CNT + l * 64 + CNT_BANK, C.lane, tt); const int nxt = shi(off, (C.lane + 1) & 63);
        if (C.lane < NEXP) { const int t0 = off >> 8, t1 = (C.lane == NEXP - 1) ? tt : (nxt >> 8); for (int t = t0; t < t1; ++t) C.misc[16 + t] = C.lane; }
        if (C.lane == 0) C.misc[200] = tt; }
    __syncthreads();
    return C.misc[200];
}
__device__ __forceinline__ void ph_combine(const Ctx& C, float* x, bool last) {
    const bf16_t* yc = WSP(bf16_t, WS_PROJ + M_YC); const int* rinfo = WSP(int, WS_ROUTE); const float* rw = (const float*)(rinfo + T * 4); const int* rpos = rinfo + T * 6; const float* gf = C.in[I_FNG];
    for (int row = C.gw; row < T; row += C.NGW) {
        const int p0 = rpos[(size_t)row * 2], p1 = rpos[(size_t)row * 2 + 1]; const float w0 = rw[(size_t)row * 2], w1 = rw[(size_t)row * 2 + 1];
        f32x4* xr = (f32x4*)(x + (size_t)row * DM) + C.lane; const u32x2* y0 = (const u32x2*)(yc + (size_t)p0 * DM) + C.lane; const u32x2* y1 = (const u32x2*)(yc + (size_t)p1 * DM) + C.lane;
        f32x4 v[8]; float ss = 0.f;
#pragma unroll
        for (int j = 0; j < 8; ++j) { const u32x2 a = y0[64 * j], b = y1[64 * j]; f32x4 xv = xr[64 * j];
            xv[0] += w0 * bf2f(a.x) + w1 * bf2f(b.x); xv[1] += w0 * bf2f(a.x >> 16) + w1 * bf2f(b.x >> 16); xv[2] += w0 * bf2f(a.y) + w1 * bf2f(b.y); xv[3] += w0 * bf2f(a.y >> 16) + w1 * bf2f(b.y >> 16);
            v[j] = xv; ss += xv[0] * xv[0] + xv[1] * xv[1] + xv[2] * xv[2] + xv[3] * xv[3]; }
        if (last) { const float rstd = rsqrtf(wave_sum(ss, C.lane) * (1.f / DM) + EPS);
#pragma unroll
            for (int j = 0; j < 8; ++j) xr[64 * j] = v[j] * rstd * ((const f32x4*)gf)[64 * j + C.lane]; }
        else {
#pragma unroll
            for (int j = 0; j < 8; ++j) xr[64 * j] = v[j]; }
    }
}

constexpr int NPL = 14, NPHASES = 1 + DEPTH * NPL;
#if MK_PER_PHASE
#define IN(k) (lo <= (k) && (k) < hi)
#else
#define IN(k) true
#endif
#if MK_PER_PHASE
#define SEAM(k) do { } while (0)
#else
#define SEAM(k) xcd_barrier(bar)
#endif
template <int l> __device__ __forceinline__ void run_layer(Ctx& C, const XcdBarrier& bar, const int lo, const int hi) {
    unsigned char* wb = (unsigned char*)(C.ws + WS_W);
    bf16_t* H = WSP(bf16_t, WS_H);
        const int pb = 1 + l * NPL;
        const float* xin = (l == 0) ? C.in[I_X] : (const float*)C.out;
        if (IN(pb + 0)) { refresh(C); REP(1) ph_weights(C, l); REP(2) ph_norm(C, xin, C.in[I_NMIX] + l * DM, H); }
        SEAM(pb + 0);
        if (IN(pb + 1)) { refresh(C);
            pg8::Gemm g{H, (const bf16_t*)(wb + W_IN), DM, DM, DM}; pg8::OrderMN S; S.init(T / 256, NP / 256, C.G, C.bid, 256L * DM * 2, 256L * DM * 2);
            pg8::EpiInProj E{(unsigned char*)C.ws};
            REP(3) pg8::gemm_phase(C.lds, g, S, E);
        }
        SEAM(pb + 1);
        if (IN(pb + 2)) { refresh(C);
            ph_ckv(C, WSP(float, WS_PROJ + P_DC), C.in[I_KVG] + l * 256, WSP(bf16_t, WS_CKV));
            { pg8::Gemm g{WSP(bf16_t, WS_PROJ + P_DQ), (const bf16_t*)(wb + W_UK), 1024, 256, 256}; pg8::OrderMN S; S.init(T / 256, 8, C.G, C.bid, 256L * 1024 * 2, 256L * 256 * 2, 1, 256L * 2);
              pg8::EpiStore<0> E{WSP(bf16_t, WS_QABS), 2048, 0.08838834764831845f}; REP(4) pg8::gemm_phase(C.lds, g, S, E); }
            refresh(C);
#if NAIVE_GMLP
            ph_gmlp_naive(C, l);
#else
            REP(5) ph_gmlp(C, l);
#endif
            refresh(C);
#if !NAIVE_RET
            REP(6) ph_ret_kv(C);
#endif
            refresh(C);
#if NAIVE_IDX
            ph_idx_naive(C);
#else
            REP(7) ph_idx(C);
#endif
        }
        SEAM(pb + 2);
        if (IN(pb + 3)) { refresh(C);
#if !NAIVE_RET
            REP(8) ph_ret_scan(C);
#endif
#if NAIVE_ATT
            ph_att_naive(C);
#else
            REP(9) ph_att(C);
#endif
        }
        SEAM(pb + 3);
        if (IN(pb + 4)) { refresh(C);
            { pg8::Gemm g{WSP(bf16_t, WS_OLAT), (const bf16_t*)(wb + W_UV), 2048, 512, 512}; pg8::OrderMN S; S.init(T / 256, 4, C.G, C.bid, 256L * 2048 * 2, 256L * 512 * 2, 0, 512L * 2);
              pg8::EpiStore<0> E{WSP(bf16_t, WS_DS), 1024, 1.0f}; REP(10) pg8::gemm_phase(C.lds, g, S, E); }
#if NAIVE_RET
            ph_ret_naive(C);
#else
            REP(11) ph_ret_out(C);
#endif
        }
        SEAM(pb + 4);
        if (IN(pb + 5)) { refresh(C);
            REP(12)
#pragma unroll 1
            for (int br = 0; br < 3; ++br) {
                const bf16_t* A = br == 0 ? WSP(bf16_t, WS_RET) : (br == 1 ? WSP(bf16_t, WS_GM) : WSP(bf16_t, WS_DS));
                const bf16_t* Bt = (const bf16_t*)(wb + (br == 0 ? W_RET : (br == 1 ? W_GM : W_DS)));
                const bf16_t* gate = WSP(bf16_t, WS_PROJ + (br == 0 ? P_GA : (br == 1 ? P_GB : P_GC)));
                pg8::Gemm g{A, Bt, 1024, 1024, 1024}; pg8::OrderMN S; S.init(T / 256, 8, C.G, C.bid, 256L * 1024 * 2, 256L * 1024 * 2);
                pg8::EpiBranch E{gate, H, br == 0 ? 1 : 0}; pg8::gemm_phase(C.lds, g, S, E);
            }
        }
        SEAM(pb + 5);
        if (IN(pb + 6)) { refresh(C);
            pg8::Gemm g{H, (const bf16_t*)(wb + W_OUT), DM, DM, DM}; pg8::OrderMN S; S.init(T / 256, 8, C.G, C.bid, 256L * DM * 2, 256L * DM * 2);
            pg8::EpiResid E{xin, C.out}; for (int rep_ = 0; rep_ <= ((l == 0) ? ((PROBE_MASK >> 17) & 1) : 0); ++rep_) pg8::gemm_phase(C.lds, g, S, E);
        }
        SEAM(pb + 6);
        if (IN(pb + 7)) { refresh(C); ph_norm_hilo(C, C.out, C.in[I_NFFN] + l * DM, H, WSP(bf16_t, WS_QABS)); }
        SEAM(pb + 7);
        if (IN(pb + 8)) { refresh(C);
            pg8::Gemm g{H, (const bf16_t*)(wb + W_RT), DM, DM, 1024}; pg8::OrderRouter S{C.G, C.bid, (long)(WS_QABS - WS_H)};
            pg8::EpiRouter E{WSP(float, WS_OLAT)}; pg8::gemm_phase(C.lds, g, S, E);
        }
        SEAM(pb + 8);
        if (IN(pb + 9)) { refresh(C); ph_route(C, l); }
        SEAM(pb + 9);
        if (IN(pb + 10)) { refresh(C); REP(13) ph_permute(C, l); }
        SEAM(pb + 10);
        if (IN(pb + 11)) { refresh(C);
            const int Mt = moe_table(C, l);
            pg8::Gemm g{WSP(bf16_t, WS_PROJ + M_HPERM), (const bf16_t*)(wb + W_13), DM, DM, DM};
            pg8::OrderMoE S{C.misc + 16, Mt, 4, C.G, C.bid, 256L * DM * 2, 256L * DM * 2, 1024L * DM * 2};
            pg8::EpiMoeUp E{WSP(bf16_t, WS_PROJ + M_HID)}; REP(14) pg8::gemm_phase(C.lds, g, S, E);
        }
        SEAM(pb + 11);
        if (IN(pb + 12)) { refresh(C);
            const int Mt = moe_table(C, l);
            pg8::Gemm g{WSP(bf16_t, WS_PROJ + M_HID), (const bf16_t*)(wb + W_2), FF, FF, FF};
            pg8::OrderMoE S{C.misc + 16, Mt, 8, C.G, C.bid, 256L * FF * 2, 256L * FF * 2, (long)DM * FF * 2};
            pg8::EpiStore<0> E{WSP(bf16_t, WS_PROJ + M_YC), DM, 1.0f}; REP(15) pg8::gemm_phase(C.lds, g, S, E);
        }
        SEAM(pb + 12);
        if (IN(pb + 13)) { refresh(C); ph_combine(C, C.out, l == DEPTH - 1); }
        if (l + 1 < DEPTH) SEAM(pb + 13);

}
__global__ void __launch_bounds__(512, 2) mk_fwd(Args a) {
    extern __shared__ __attribute__((aligned(16))) unsigned char lds_raw[];
    Ctx C;
    C.lds = (LAS unsigned char*)lds_raw; C.misc = (volatile LAS int*)(C.lds + MISC_OFF); C.ws = (GAS unsigned char*)a.ws; C.ctl = (unsigned*)(a.ws + WS_CTL);
    C.tid = threadIdx.x; C.lane = C.tid & 63; C.wave = __builtin_amdgcn_readfirstlane(C.tid >> 6); C.G = gridDim.x; C.bid = blockIdx.x;
    C.gw = C.bid * 8 + C.wave; C.NGW = C.G * 8; C.in = a.in; C.out = a.out;
    for (int i = C.tid; i < 256; i += 512) C.misc[i] = 0;
    __syncthreads();
#if MK_PER_PHASE
    XcdBarrier bar; bar.bar = C.ctl + CW_BAR; bar.x = 0; bar.st = (volatile LAS unsigned*)C.misc;
#else
    XcdBarrier bar = xcd_barrier_post(C.ctl + CW_BAR, (volatile LAS unsigned*)C.misc);
#endif
    const int lo = a.ph_lo, hi = a.ph_hi;
    if (IN(0)) ph_rope(C);
    run_layer<0>(C, bar, lo, hi);
    run_layer<1>(C, bar, lo, hi);
}

extern "C" void kernel_launch(void* const* d_in, const int* in_sizes, int n_in, void* d_out, int out_size, void* d_ws, size_t ws_size, hipStream_t stream) {
    static int grid = 0;
    if (grid == 0) {
        if (n_in != 23 || out_size != T * DM || ws_size < WS_END) { fprintf(stderr, "kernel_launch: unexpected shapes / workspace (n_in %d out %d ws %zu need %zu)\n", n_in, out_size, ws_size, (size_t)WS_END); grid = -1; return; }
        int dev = 0, cus = 0, per_cu = 0;
        if (hipGetDevice(&dev) != hipSuccess || hipDeviceGetAttribute(&cus, hipDeviceAttributeMultiprocessorCount, dev) != hipSuccess) { grid = -1; return; }
        if (hipFuncSetAttribute((const void*)mk_fwd, hipFuncAttributeMaxDynamicSharedMemorySize, LDS_BYTES) != hipSuccess) { fprintf(stderr, "kernel_launch: hipFuncSetAttribute failed\n"); grid = -1; return; }
        if (hipOccupancyMaxActiveBlocksPerMultiprocessor(&per_cu, (const void*)mk_fwd, 512, LDS_BYTES) != hipSuccess || per_cu < 1) { fprintf(stderr, "kernel_launch: occupancy query says %d\n", per_cu); (void)hipGetLastError(); grid = -1; return; }
        grid = cus;
    }
    if (grid < 0) return;
    (void)hipMemsetAsync((char*)d_ws + WS_CTL, 0, CTL_BYTES, stream);
    Args a{};
    for (int i = 0; i < 23; ++i) a.in[i] = (const float*)d_in[i];
    a.out = (float*)d_out; a.ws = (unsigned char*)d_ws;
#if MK_PER_PHASE
    for (int p = 0; p < NPHASES; ++p) { a.ph_lo = p; a.ph_hi = p + 1; hipLaunchKernelGGL(mk_fwd, dim3(grid), dim3(512), LDS_BYTES, stream, a); }
#else
    a.ph_lo = 0; a.ph_hi = NPHASES;
    hipLaunchKernelGGL(mk_fwd, dim3(grid), dim3(512), LDS_BYTES, stream, a);
#endif
}
```

```cpp
#include <hip/hip_runtime.h>
#include <stdint.h>
#include <stdio.h>

#ifndef MK_PER_PHASE
#define MK_PER_PHASE 0
#endif
#ifndef PROBE_MASK
#define PROBE_MASK 0
#endif
#define CNT_BANK (((PROBE_MASK >> 16) & 1) * 128)
#define REP(k) for (int rep_ = 0; rep_ <= ((PROBE_MASK >> (k)) & 1); ++rep_)
#ifndef NAIVE_RET
#define NAIVE_RET 0
#endif
#ifndef NAIVE_GMLP
#define NAIVE_GMLP 0
#endif
#ifndef NAIVE_IDX
#define NAIVE_IDX 0
#endif
#ifndef NAIVE_ATT
#define NAIVE_ATT 0
#endif

#define LAS __attribute__((address_space(3)))
#define GAS __attribute__((address_space(1)))
typedef unsigned short bf16_t;
typedef short bf16x8 __attribute__((ext_vector_type(8)));
typedef short s16x4 __attribute__((ext_vector_type(4)));
typedef float f32x4 __attribute__((ext_vector_type(4)));
typedef float f32x2 __attribute__((ext_vector_type(2)));
typedef float f32x16 __attribute__((ext_vector_type(16)));
typedef unsigned u32x4 __attribute__((ext_vector_type(4)));
typedef unsigned u32x2 __attribute__((ext_vector_type(2)));

constexpr int DM = 2048, NB = 4, SEQ = 4096, T = NB * SEQ, DEPTH = 2;
constexpr int INW = 14152, NP = 14336;
constexpr int GATE_SRC0 = 8008, GATE_DST0 = 8192;
constexpr int NEXP = 32, FF = 512, MOE_ROWS = 40960;
constexpr float EPS = 1e-6f;

constexpr size_t MiB = 1u << 20;
constexpr size_t WS_CTL = 0, CTL_BYTES = 1 * MiB;
constexpr size_t WS_ROPE = 1 * MiB;
constexpr size_t WS_W = 5 * MiB;
constexpr size_t W_IN = 0, W_RET = 56 * MiB, W_GM = 60 * MiB, W_DS = 64 * MiB, W_OUT = 68 * MiB, W_13 = 76 * MiB, W_2 = 204 * MiB, W_UK = 268 * MiB, W_UV = 269 * MiB, W_RT = 270 * MiB  , W_END = 271 * MiB;
constexpr size_t WS_H = WS_W + W_END;
constexpr size_t WS_PROJ = WS_H + 64 * MiB;
constexpr size_t P_RQ = 0, P_RK = 32 * MiB, P_RV = 64 * MiB, P_RG = 96 * MiB, P_GU = 128 * MiB, P_GV = 160 * MiB, P_DQ = 192 * MiB, P_DC = 224 * MiB  ,
                 P_IQ = 240 * MiB  , P_IK = 256 * MiB  , P_IW = 258 * MiB  , P_GA = 260 * MiB, P_GB = 324 * MiB, P_GC = 388 * MiB, P_END = 452 * MiB;
constexpr size_t M_HPERM = 0, M_HID = 160 * MiB, M_YC = 200 * MiB;
constexpr size_t WS_KV = WS_PROJ + P_END;
constexpr size_t WS_R = WS_KV + 64 * MiB;
constexpr size_t WS_QABS = WS_R + 64 * MiB;
constexpr size_t WS_OLAT = WS_QABS + 64 * MiB;
constexpr size_t WS_RET = WS_OLAT + 64 * MiB;
constexpr size_t WS_GM = WS_RET + 32 * MiB, WS_DS = WS_GM + 32 * MiB;
constexpr size_t WS_SEL = WS_DS + 32 * MiB;
constexpr size_t WS_CKV = WS_SEL + 8 * MiB;
constexpr size_t WS_STATS = WS_CKV + 8 * MiB;
constexpr size_t WS_ROUTE = WS_STATS + 2 * MiB;
constexpr size_t WS_END = WS_ROUTE + 1 * MiB;
constexpr int CW_BAR = 4096, CW_CNT = 16384;

constexpr int LDS_BYTES = 147456, MISC_OFF = LDS_BYTES - 1024;

__device__ __forceinline__ unsigned f2bf(float f) { unsigned u = __builtin_bit_cast(unsigned, f); return (u + 0x7fffu + ((u >> 16) & 1u)) >> 16; }
__device__ __forceinline__ float bf2f(unsigned b) { return __builtin_bit_cast(float, (b & 0xffffu) << 16); }
typedef __bf16 bf16x2_t __attribute__((ext_vector_type(2)));
__device__ __forceinline__ unsigned cvt_pk_bf16(float lo, float hi) { const f32x2 v = {lo, hi}; return __builtin_bit_cast(unsigned, __builtin_convertvector(v, bf16x2_t)); }
__device__ __forceinline__ float shx(float v, int k, int lane) { return __builtin_bit_cast(float, __builtin_amdgcn_ds_bpermute((lane ^ k) << 2, __builtin_bit_cast(int, v))); }
__device__ __forceinline__ int shi(int v, int src) { return __builtin_amdgcn_ds_bpermute(src << 2, v); }
typedef unsigned short u16x2 __attribute__((ext_vector_type(2)));
__device__ __forceinline__ unsigned pk_below(unsigned x, unsigned cm1, unsigned cnt) {
    u16x2 r = __builtin_elementwise_sub_sat(__builtin_bit_cast(u16x2, x), __builtin_bit_cast(u16x2, cm1)); unsigned ru = __builtin_bit_cast(unsigned, r); asm volatile("" : "+v"(ru));
    r = __builtin_elementwise_sub_sat((u16x2){1, 1}, __builtin_bit_cast(u16x2, ru)); ru = __builtin_bit_cast(unsigned, r); asm volatile("" : "+v"(ru));
    return __builtin_bit_cast(unsigned, (u16x2)(__builtin_bit_cast(u16x2, cnt) + __builtin_bit_cast(u16x2, ru)));
}
__device__ __forceinline__ int wave_total_dpp(int x) {
    x += __builtin_amdgcn_update_dpp(0, x, 0x111, 0xf, 0xf, false);
    x += __builtin_amdgcn_update_dpp(0, x, 0x112, 0xf, 0xf, false);
    x += __builtin_amdgcn_update_dpp(0, x, 0x114, 0xf, 0xf, false);
    x += __builtin_amdgcn_update_dpp(0, x, 0x118, 0xf, 0xf, false);
    x += __builtin_amdgcn_update_dpp(0, x, 0x142, 0xa, 0xf, false);
    x += __builtin_amdgcn_update_dpp(0, x, 0x143, 0xc, 0xf, false);
    return __builtin_amdgcn_readlane(x, 63);
}
__device__ __forceinline__ float wave_sum(float v, int lane) {
#pragma unroll
    for (int o = 1; o < 64; o <<= 1) v += shx(v, o, lane);
    return v;
}
__device__ __forceinline__ float wave_max(float v, int lane) {
#pragma unroll
    for (int o = 1; o < 64; o <<= 1) v = fmaxf(v, shx(v, o, lane));
    return v;
}
__device__ __forceinline__ float sigmoidf_(float x) { return __builtin_amdgcn_rcpf(1.0f + __builtin_amdgcn_exp2f(x * -1.44269504089f)); }
__device__ __forceinline__ float siluf_(float x) { return x * sigmoidf_(x); }
__device__ __forceinline__ f32x2 gelu_pk(f32x2 v) {
    const f32x2 av = __builtin_elementwise_abs(v), d = av * 0.2316418882f + 1.0f;
    f32x2 t; t.x = __builtin_amdgcn_rcpf(d.x); t.y = __builtin_amdgcn_rcpf(d.y);
    f32x2 q = t * 0.5307027145f + (-0.7265760135f); q = q * t + 0.7107068705f; q = q * t + (-0.142248368f); q = q * t + 0.127414796f; q = q * t;
    const f32x2 s = (v * v) * (-0.72134752044f);
    f32x2 e; e.x = __builtin_amdgcn_exp2f(s.x); e.y = __builtin_amdgcn_exp2f(s.y);
    const f32x2 m = v * (q * e), r = v - m;
    f32x2 o; o.x = v.x < 0.f ? m.x : r.x; o.y = v.y < 0.f ? m.y : r.y; return o;
}
template <int ACT> __device__ __forceinline__ f32x4 act4(f32x4 v) {
    if (ACT == 1) { f32x2 a = gelu_pk((f32x2){v[0], v[1]}), b = gelu_pk((f32x2){v[2], v[3]}); return (f32x4){a.x, a.y, b.x, b.y}; }
    if (ACT == 2) return (f32x4){siluf_(v[0]), siluf_(v[1]), siluf_(v[2]), siluf_(v[3])};
    if (ACT == 3) return (f32x4){sigmoidf_(v[0]), sigmoidf_(v[1]), sigmoidf_(v[2]), sigmoidf_(v[3])};
    return v;
}
__device__ __forceinline__ u32x4 pack8(f32x4 a, f32x4 b) { u32x4 w; w.x = cvt_pk_bf16(a[0], a[1]); w.y = cvt_pk_bf16(a[2], a[3]); w.z = cvt_pk_bf16(b[0], b[1]); w.w = cvt_pk_bf16(b[2], b[3]); return w; }
__device__ __forceinline__ void unpack8(u32x4 w, float (&f)[8]) {
    f[0] = bf2f(w.x); f[1] = bf2f(w.x >> 16); f[2] = bf2f(w.y); f[3] = bf2f(w.y >> 16); f[4] = bf2f(w.z); f[5] = bf2f(w.z >> 16); f[6] = bf2f(w.w); f[7] = bf2f(w.w >> 16);
}

#define XB_TMO      128
#define XB_XCNT(j)  (256  + 64 * (j))
#define XB_XSUB(j)  (1280 + 64 * (j))
#define XB_XGEN(j)  (2304 + 64 * (j))
#define XB_TOP      3328
#define XB_TOPGEN   3392
#define XCD_BAR_WORDS 3456
#define XB_SPIN_CAP (1u << 20)
__device__ __forceinline__ unsigned xb_ld(unsigned* p)              { return __hip_atomic_load(p, __ATOMIC_RELAXED, __HIP_MEMORY_SCOPE_AGENT); }
__device__ __forceinline__ unsigned xb_add(unsigned* p, unsigned v) { return __hip_atomic_fetch_add(p, v, __ATOMIC_RELAXED, __HIP_MEMORY_SCOPE_AGENT); }
__device__ __forceinline__ unsigned xb_xcc_id() { return (unsigned)__builtin_amdgcn_s_getreg((3 << 11) | 20) & 0xFu; }
#define XB_SPIN(cond, bar) do { unsigned _sp = 0; while (cond) { __builtin_amdgcn_s_sleep(1); \
    if ((++_sp & 255u) == 0u) { if (xb_ld(&(bar)[XB_TMO])) break; if (_sp > XB_SPIN_CAP) { atomicAdd(&(bar)[XB_TMO], 1u); break; } } } } while (0)
struct XcdBarrier { unsigned* bar; unsigned x; volatile LAS unsigned* st; };
__device__ __forceinline__ XcdBarrier xcd_barrier_post(unsigned* bar, volatile LAS unsigned* st) {
    XcdBarrier b; b.bar = bar; b.x = xb_xcc_id(); b.st = st;
    if (threadIdx.x == 0) (void)xb_add(&bar[XB_XCNT(b.x)], 1u);
    return b;
}
__device__ __forceinline__ void xcd_barrier_complete(unsigned* bar, unsigned x, unsigned& nloc, unsigned& nx) {
    const unsigned G = gridDim.x * gridDim.y * gridDim.z;
    unsigned sum, cnt, mine, sp = 0u;
    for (;;) {
        sum = 0u; cnt = 0u; mine = 0u;
#pragma unroll
        for (unsigned j = 0; j < 16; ++j) { const unsigned c = xb_ld(&bar[XB_XCNT(j)]); sum += c; cnt += (c > 0u) ? 1u : 0u; mine = (j == x) ? c : mine; }
        if (sum == G) break;
        __builtin_amdgcn_s_sleep(1);
        if ((++sp & 255u) == 0u) { if (xb_ld(&bar[XB_TMO])) break; if (sp > XB_SPIN_CAP) { atomicAdd(&bar[XB_TMO], 1u); break; } }
    }
    nloc = mine > 0u ? mine : 1u; nx = cnt > 0u ? cnt : 1u;
}
__device__ __forceinline__ void xcd_barrier(const XcdBarrier& b) {
    asm volatile("s_waitcnt vmcnt(0)" ::: "memory");
    __syncthreads();
    if (threadIdx.x == 0) {
        unsigned* bar = b.bar; asm volatile("" : "+s"(bar));
        __builtin_amdgcn_s_waitcnt(0);
        unsigned nloc = b.st[0], nx = b.st[1];
        if (nloc == 0u) { xcd_barrier_complete(bar, b.x, nloc, nx); b.st[0] = nloc; b.st[1] = nx; }
        const unsigned old = xb_add(&bar[XB_XSUB(b.x)], 1u);
        const unsigned gen = old / nloc;
        if (old + 1u == (gen + 1u) * nloc) {
            __builtin_amdgcn_fence(__ATOMIC_RELEASE, "agent");
            asm volatile("s_waitcnt vmcnt(0)" ::: "memory");
            const unsigned og = xb_add(&bar[XB_TOP], 1u);
            const unsigned tg = og / nx;
            if (og + 1u == (tg + 1u) * nx) xb_add(&bar[XB_TOPGEN], 1u);
            else XB_SPIN(xb_ld(&bar[XB_TOPGEN]) == tg, bar);
            __builtin_amdgcn_fence(__ATOMIC_ACQUIRE, "agent");
            xb_add(&bar[XB_XGEN(b.x)], 1u);
            asm volatile("s_waitcnt vmcnt(0)" ::: "memory");
        } else {
            XB_SPIN(xb_ld(&bar[XB_XGEN(b.x)]) == gen, bar);
            __builtin_amdgcn_fence(__ATOMIC_ACQUIRE, "agent");
            asm volatile("s_waitcnt vmcnt(0)" ::: "memory");
        }
    }
    __syncthreads();
}

namespace pg8 {
constexpr int BM = 256, BK = 64, HALF = 128, HTB = HALF * BK * 2, STAGE_BYTES = 8 * HTB, NXCD = 8, WGM = 8;
__host__ __device__ __forceinline__ int lds_byte(int r, int c) { const int st = (r >> 4) * 2 + (c >> 5), rr = r & 15, cc = c & 31, ob = rr * 64 + cc * 2; return st * 1024 + (ob ^ (((ob >> 9) & 1) << 5)); }
__host__ __device__ __forceinline__ void stage_rc(int b, int& R, int& C) { const int st = b / 1024, sb = b % 1024, swz = sb ^ (((sb >> 9) & 1) << 5); R = (st >> 1) * 16 + swz / 64; C = (st & 1) * 32 + (swz % 64) / 2; }
__host__ __device__ __forceinline__ int perm32(int rho) { const int n = rho >> 4, i = rho & 15; return 8 * (i >> 2) + 4 * n + (i & 3); }

struct Unit { int pm, pn; long aoff, boff; };
struct Gemm { const bf16_t* A; const bf16_t* Bt; int lda, ldb, K; };

struct OrderMN {
    int nM, nN, nwg, G, c, ashift; long astep, bstep, abytes;
    __device__ void init(int nM_, int nN_, int G_, int c_, long astep_, long bstep_, int ashift_ = 0, long abytes_ = 0) { nM = nM_; nN = nN_; nwg = nM * nN; G = G_; c = c_; astep = astep_; bstep = bstep_; ashift = ashift_; abytes = abytes_; }
    __device__ bool next(int i, Unit& u) const {
        const long L = (long)i * G + c; if (L >= nwg) return false;
        int wgid = (int)L; { const int q = nwg / NXCD, r = nwg % NXCD, xcd = wgid % NXCD, off = wgid / NXCD; wgid = (xcd < r ? xcd * (q + 1) : r * (q + 1) + (xcd - r) * q) + off; }
        const int nig = WGM * nN, gid = wgid / nig, fm = gid * WGM, gsz = (nM - fm) < WGM ? (nM - fm) : WGM;
        u.pm = fm + ((wgid % nig) % gsz); u.pn = (wgid % nig) / gsz;
        u.aoff = (long)u.pm * astep + (long)(u.pn >> ashift) * abytes; u.boff = (long)u.pn * bstep; return true;
    }
};
struct OrderMoE {
    const volatile LAS int* te; int Mt, nN, G, c; long astep, bstep, estep;
    __device__ bool next(int i, Unit& u) const {
        const long L = (long)i * G + c; if (L >= (long)Mt * nN) return false;
        u.pm = (int)(L / nN); u.pn = (int)(L % nN);
        u.aoff = (long)u.pm * astep; u.boff = (long)te[u.pm] * estep + (long)u.pn * bstep; return true;
    }
};

template <class Epi, class Sched>
__device__ __forceinline__ void gemm_phase(LAS unsigned char* lds, const Gemm g, const Sched& S, const Epi& E) {
    int tid_ = threadIdx.x; asm volatile("" : "+v"(tid_));
    const GAS bf16_t* gA = (const GAS bf16_t*)g.A; const GAS bf16_t* gB = (const GAS bf16_t*)g.Bt; asm volatile("" : "+s"(gA), "+s"(gB));
    const int tid = tid_, wid = __builtin_amdgcn_readfirstlane(tid >> 6), lane = tid & 63, wr = wid >> 2, wc = wid & 3, fr = lane & 15, fq = lane >> 4;
    const int K = g.K, nt = K / BK;
    unsigned voffA[2], voffB[2];
#pragma unroll
    for (int i = 0; i < 2; ++i) { int R, C; stage_rc(tid * 16 + i * 8192, R, C); const int Rb = Epi::PERM ? ((R & ~31) + perm32(R & 31)) : R;
        voffA[i] = (unsigned)(R * g.lda + C) * 2u; voffB[i] = (unsigned)(Rb * g.ldb + C) * 2u; }
    const size_t kstep = (size_t)(BK * 2);
    const size_t hstepA = (size_t)HALF * g.lda * 2, hstepB = (size_t)HALF * g.ldb * 2;
    const unsigned ldsw = (unsigned)wid * 1024u;
    const int aoff = lds_byte(wr * 64 + fr, fq * 8), boff = lds_byte(wc * 32 + fr, fq * 8);
#define PG8_SA(b, h) (((b) * 2 + (h)) * HTB)
#define PG8_SB(b, h) ((4 + (b) * 2 + (h)) * HTB)
#define PG8_STAGE(bufoff, gbase, voff) do { _Pragma("unroll") for (int _i = 0; _i < 2; ++_i) \
        __builtin_amdgcn_global_load_lds((const GAS unsigned*)((gbase) + (voff)[_i]), (LAS unsigned*)(lds + (bufoff) + ldsw + _i * 8192), 16, 0, 0); } while (0)
#define PG8_LDA(dst, b, h) do { _Pragma("unroll") for (int m = 0; m < 4; ++m) _Pragma("unroll") for (int k = 0; k < 2; ++k) dst[m][k] = *(const LAS bf16x8*)(lds + PG8_SA(b, h) + aoff + m * 2048 + k * 1024); } while (0)
#define PG8_LDB(dst, b, h) do { _Pragma("unroll") for (int n = 0; n < 2; ++n) _Pragma("unroll") for (int k = 0; k < 2; ++k) dst[n][k] = *(const LAS bf16x8*)(lds + PG8_SB(b, h) + boff + n * 2048 + k * 1024); } while (0)
#define PG8_MMA(ai, bj, At, Bt) do { __builtin_amdgcn_s_setprio(1); _Pragma("unroll") for (int m = 0; m < 4; ++m) _Pragma("unroll") for (int n = 0; n < 2; ++n) _Pragma("unroll") for (int k = 0; k < 2; ++k) \
        acc[ai][bj][m][n] = __builtin_amdgcn_mfma_f32_16x16x32_bf16(Bt[n][k], At[m][k], acc[ai][bj][m][n], 0, 0, 0); __builtin_amdgcn_s_setprio(0); } while (0)
#define PG8_WAIT_V(n) asm volatile("s_waitcnt vmcnt(" #n ")" ::: "memory")
#define PG8_WAIT_L(n) asm volatile("s_waitcnt lgkmcnt(" #n ")" ::: "memory")
#define PG8_BAR __builtin_amdgcn_s_barrier()
#define PG8_SCHED __builtin_amdgcn_sched_barrier(0)
    Unit cur, nxt; int ui = 0;
    if (!S.next(0, cur)) return;
    f32x4 acc[2][2][4][2];
#pragma unroll
    for (int a = 0; a < 2; ++a)
#pragma unroll
        for (int b = 0; b < 2; ++b)
#pragma unroll
            for (int m = 0; m < 4; ++m)
#pragma unroll
                for (int n = 0; n < 2; ++n) acc[a][b][m][n] = (f32x4){0.f, 0.f, 0.f, 0.f};
    bf16x8 At[4][2], B0[2][2], B1[2][2];
    const GAS char* cA = (const GAS char*)gA + cur.aoff; const GAS char* cB = (const GAS char*)gB + cur.boff;
    PG8_STAGE(PG8_SB(0, 0), cB, voffB); PG8_STAGE(PG8_SA(0, 0), cA, voffA); PG8_STAGE(PG8_SB(0, 1), cB + hstepB, voffB); PG8_STAGE(PG8_SA(0, 1), cA + hstepA, voffA);
    if (wr == 1) PG8_BAR;
    PG8_WAIT_V(4); PG8_BAR;
    PG8_STAGE(PG8_SB(1, 0), cB + kstep, voffB); PG8_STAGE(PG8_SA(1, 0), cA + kstep, voffA); PG8_STAGE(PG8_SB(1, 1), cB + hstepB + kstep, voffB);
    PG8_WAIT_V(6); PG8_BAR;
    for (;;) {
        const bool has_next = S.next(ui + 1, nxt);
        const GAS char* nA = has_next ? (const GAS char*)gA + nxt.aoff : cA; const GAS char* nB = has_next ? (const GAS char*)gB + nxt.boff : cB;
        for (int t = 0; t < nt; t += 2) {
            const bool last = (t == nt - 2);
            const GAS char* a1 = cA + (size_t)(t + 1) * kstep;
            const GAS char* a2 = last ? nA : cA + (size_t)(t + 2) * kstep; const GAS char* b2 = last ? nB : cB + (size_t)(t + 2) * kstep;
            const GAS char* a3 = a2 + kstep; const GAS char* b3 = b2 + kstep;
            PG8_LDB(B0, 0, 0); PG8_SCHED; PG8_LDA(At, 0, 0); PG8_STAGE(PG8_SA(1, 1), a1 + hstepA, voffA);
            PG8_WAIT_L(8); PG8_BAR; PG8_WAIT_L(0); PG8_MMA(0, 0, At, B0); PG8_BAR; PG8_SCHED;
            PG8_LDB(B1, 0, 1); PG8_STAGE(PG8_SB(0, 0), b2, voffB);
            PG8_BAR; PG8_WAIT_L(0); PG8_MMA(0, 1, At, B1); PG8_BAR;
            PG8_LDA(At, 0, 1); PG8_STAGE(PG8_SA(0, 0), a2, voffA);
            PG8_BAR; PG8_WAIT_L(0); PG8_MMA(1, 0, At, B0); PG8_BAR; PG8_SCHED;
            PG8_STAGE(PG8_SB(0, 1), b2 + hstepB, voffB);
            PG8_WAIT_V(6); PG8_BAR; PG8_MMA(1, 1, At, B1); PG8_BAR;
            PG8_LDB(B0, 1, 0); PG8_SCHED; PG8_LDA(At, 1, 0); PG8_STAGE(PG8_SA(0, 1), a2 + hstepA, voffA);
            PG8_WAIT_L(8); PG8_BAR; PG8_WAIT_L(0); PG8_MMA(0, 0, At, B0); PG8_BAR; PG8_SCHED;
            PG8_LDB(B1, 1, 1); PG8_STAGE(PG8_SB(1, 0), b3, voffB);
            PG8_BAR; PG8_WAIT_L(0); PG8_MMA(0, 1, At, B1); PG8_BAR;
            PG8_LDA(At, 1, 1); PG8_STAGE(PG8_SA(1, 0), a3, voffA);
            PG8_BAR; PG8_WAIT_L(0); PG8_MMA(1, 0, At, B0); PG8_BAR; PG8_SCHED;
            PG8_STAGE(PG8_SB(1, 1), b3 + hstepB, voffB);
            PG8_WAIT_V(6); PG8_BAR; PG8_MMA(1, 1, At, B1); PG8_BAR;
        }
        E(acc, cur, wr, wc, fr, fq);
        if (!has_next) break;
#pragma unroll
        for (int a = 0; a < 2; ++a)
#pragma unroll
            for (int b = 0; b < 2; ++b)
#pragma unroll
                for (int m = 0; m < 4; ++m)
#pragma unroll
                    for (int n = 0; n < 2; ++n) acc[a][b][m][n] = (f32x4){0.f, 0.f, 0.f, 0.f};
        cur = nxt; cA = nA; cB = nB; ++ui;
    }
    PG8_WAIT_V(0);
    if (wr == 0) PG8_BAR;
    PG8_BAR;
#undef PG8_SA
#undef PG8_SB
#undef PG8_STAGE
#undef PG8_LDA
#undef PG8_LDB
#undef PG8_MMA
#undef PG8_WAIT_V
#undef PG8_WAIT_L
#undef PG8_BAR
#undef PG8_SCHED
}

typedef const f32x4 (&AccT)[2][2][4][2];
template <int ACT> __device__ __forceinline__ void store_tile_bf16(AccT acc, bf16_t* O, int ld, int row0, int colb, float scale) {
#pragma unroll
    for (int ai = 0; ai < 2; ++ai)
#pragma unroll
        for (int m = 0; m < 4; ++m) { bf16_t* rowp = O + (size_t)(row0 + ai * HALF + m * 16) * ld + colb;
#pragma unroll
            for (int bj = 0; bj < 2; ++bj) { const f32x4 v0 = act4<ACT>(acc[ai][bj][m][0] * scale), v1 = act4<ACT>(acc[ai][bj][m][1] * scale);
                *(u32x4*)(rowp + bj * HALF) = pack8(v0, v1); }
            asm volatile("" ::: "memory"); }
}
template <int ACT> struct EpiStore {
    static constexpr bool PERM = true;
    bf16_t* O; int ld; float scale;
    __device__ __forceinline__ void operator()(AccT acc, const Unit& u, int wr, int wc, int fr, int fq) const {
        store_tile_bf16<ACT>(acc, O, ld, u.pm * BM + wr * 64 + fr, u.pn * BM + wc * 32 + 8 * fq, scale);
    }
};
struct EpiInProj {
    static constexpr bool PERM = true;
    unsigned char* ws;
    __device__ __forceinline__ void operator()(AccT acc, const Unit& u, int wr, int wc, int fr, int fq) const {
        const int pn = u.pn, row0 = u.pm * BM + wr * 64 + fr, cw = wc * 32 + 8 * fq;
        unsigned char* pj = ws + WS_PROJ;
        bf16_t *rq = (bf16_t*)(pj + P_RQ), *rk = (bf16_t*)(pj + P_RK), *rv = (bf16_t*)(pj + P_RV), *rg = (bf16_t*)(pj + P_RG), *gu = (bf16_t*)(pj + P_GU), *gv = (bf16_t*)(pj + P_GV), *dq = (bf16_t*)(pj + P_DQ),
               *iq = (bf16_t*)(pj + P_IQ), *ik = (bf16_t*)(pj + P_IK), *ga = (bf16_t*)(pj + P_GA), *gb = (bf16_t*)(pj + P_GB), *gc = (bf16_t*)(pj + P_GC);
        float *dcraw = (float*)(pj + P_DC), *iw = (float*)(pj + P_IW), *gvstats = (float*)(ws + WS_STATS); const float* rope = (const float*)(ws + WS_ROPE);
        if (pn < 8) {
            const bool isk = pn >= 4; bf16_t* dst = (isk ? rk : rq) + (pn & 3) * 256 + cw; const float sc = isk ? 0.0625f : 1.0f;
#pragma unroll
            for (int ai = 0; ai < 2; ++ai) { f32x4 csq[4][4];
#pragma unroll
                for (int m = 0; m < 4; ++m) { const int pos = (row0 + ai * HALF + m * 16) & (SEQ - 1); const f32x4* cs = (const f32x4*)(rope + ((size_t)pos * 128 + cw) * 2);
#pragma unroll
                    for (int q4 = 0; q4 < 4; ++q4) csq[m][q4] = cs[q4]; }
                asm volatile("" ::: "memory");
#pragma unroll
                for (int m = 0; m < 4; ++m) { const int row = row0 + ai * HALF + m * 16;
                    f32x4 o1[2], o2[2];
#pragma unroll
                    for (int n = 0; n < 2; ++n) { const f32x4 c01 = csq[m][2 * n], c23 = csq[m][2 * n + 1]; const f32x4 x1 = acc[ai][0][m][n], x2 = acc[ai][1][m][n];
                        const float co[4] = {c01[0], c01[2], c23[0], c23[2]}, si[4] = {c01[1], c01[3], c23[1], c23[3]};
#pragma unroll
                        for (int j = 0; j < 4; ++j) { o1[n][j] = (x1[j] * co[j] - x2[j] * si[j]) * sc; o2[n][j] = (x1[j] * si[j] + x2[j] * co[j]) * sc; } }
                    bf16_t* rp = dst + (size_t)row * 1024;
                    *(u32x4*)rp = pack8(o1[0], o1[1]); *(u32x4*)(rp + 128) = pack8(o2[0], o2[1]); }
                asm volatile("" ::: "memory"); }
        } else if (pn < 12) { store_tile_bf16<0>(acc, rv, 1024, row0, (pn - 8) * 256 + cw, 1.f);
        } else if (pn < 16) { store_tile_bf16<2>(acc, rg, 1024, row0, (pn - 12) * 256 + cw, 1.f);
        } else if (pn < 20) { store_tile_bf16<1>(acc, gu, 1024, row0, (pn - 16) * 256 + cw, 1.f);
        } else if (pn < 24) {
            const int t4 = pn - 20; bf16_t* dst = gv + t4 * 256 + cw;
#pragma unroll
            for (int ai = 0; ai < 2; ++ai)
#pragma unroll
                for (int m = 0; m < 4; ++m) { const int row = row0 + ai * HALF + m * 16; float s = 0.f, q = 0.f;
#pragma unroll
                    for (int bj = 0; bj < 2; ++bj) { const f32x4 v0 = act4<1>(acc[ai][bj][m][0]), v1 = act4<1>(acc[ai][bj][m][1]);
                        *(u32x4*)(dst + (size_t)row * 1024 + bj * HALF) = pack8(v0, v1);
#pragma unroll
                        for (int j = 0; j < 4; ++j) { s += v0[j] + v1[j]; q += v0[j] * v0[j] + v1[j] * v1[j]; } }
                    { const int ln = fq * 16 + fr; s += shx(s, 16, ln); s += shx(s, 32, ln); q += shx(q, 16, ln); q += shx(q, 32, ln); }
                    if (fq == 0) *(f32x2*)(gvstats + ((size_t)row * 16 + t4 * 4 + wc) * 2) = (f32x2){s, q}; asm volatile("" ::: "memory"); }
        } else if (pn < 28) { store_tile_bf16<0>(acc, dq, 1024, row0, (pn - 24) * 256 + cw, 1.f);
        } else if (pn == 28) {
#pragma unroll
            for (int ai = 0; ai < 2; ++ai)
#pragma unroll
                for (int m = 0; m < 4; ++m) { float* rp = dcraw + (size_t)(row0 + ai * HALF + m * 16) * 256 + cw;
#pragma unroll
                    for (int bj = 0; bj < 2; ++bj) { *(f32x4*)(rp + bj * HALF) = acc[ai][bj][m][0]; *(f32x4*)(rp + bj * HALF + 4) = acc[ai][bj][m][1]; } }
        } else if (pn < 31) { store_tile_bf16<0>(acc, iq, 512, row0, (pn - 29) * 256 + cw, 1.f);
        } else if (pn == 31) {
#pragma unroll
            for (int ai = 0; ai < 2; ++ai)
#pragma unroll
                for (int m = 0; m < 4; ++m) { const int row = row0 + ai * HALF + m * 16;
                    if (wc < 2) *(u32x4*)(ik + (size_t)row * 64 + cw) = pack8(acc[ai][0][m][0], acc[ai][0][m][1]);
                    if (wc == 2 && fq == 0) { *(f32x4*)(iw + (size_t)row * 8) = acc[ai][0][m][0] * 0.35355339059f; *(f32x4*)(iw + (size_t)row * 8 + 4) = acc[ai][0][m][1] * 0.35355339059f; } }
        } else { const int gi = (pn - 32) >> 3; bf16_t* dst = gi == 0 ? ga : (gi == 1 ? gb : gc);
            store_tile_bf16<3>(acc, dst, 2048, row0, ((pn - 32) & 7) * 256 + cw, 1.f); }
    }
};
struct EpiBranch {
    static constexpr bool PERM = true;
    const bf16_t* gate; bf16_t* merged; int first;
    __device__ __forceinline__ void operator()(AccT acc, const Unit& u, int wr, int wc, int fr, int fq) const {
        const int row0 = u.pm * BM + wr * 64 + fr, colb = u.pn * BM + wc * 32 + 8 * fq;
#pragma unroll
        for (int ai = 0; ai < 2; ++ai) {
            u32x4 gq[4][2], mq[4][2];
#pragma unroll
            for (int m = 0; m < 4; ++m)
#pragma unroll
                for (int bj = 0; bj < 2; ++bj) { const size_t ro = (size_t)(row0 + ai * HALF + m * 16) * 2048 + colb + bj * HALF; gq[m][bj] = *(const u32x4*)(gate + ro); mq[m][bj] = *(const u32x4*)(merged + ro); }
            asm volatile("" ::: "memory");
#pragma unroll
            for (int m = 0; m < 4; ++m)
#pragma unroll
                for (int bj = 0; bj < 2; ++bj) { const size_t ro = (size_t)(row0 + ai * HALF + m * 16) * 2048 + colb + bj * HALF; float g8[8], m8[8]; unpack8(gq[m][bj], g8); unpack8(mq[m][bj], m8);
                    const f32x4 a0 = acc[ai][bj][m][0], a1 = acc[ai][bj][m][1]; f32x4 r0, r1;
#pragma unroll
                    for (int j = 0; j < 4; ++j) { r0[j] = (first ? 0.f : m8[j]) + g8[j] * a0[j]; r1[j] = (first ? 0.f : m8[4 + j]) + g8[4 + j] * a1[j]; }
                    *(u32x4*)(merged + ro) = pack8(r0, r1); }
            asm volatile("" ::: "memory");
        }
    }
};
struct EpiResid {
    static constexpr bool PERM = false;
    const float* xsrc; float* xdst;
    __device__ __forceinline__ void operator()(AccT acc, const Unit& u, int wr, int wc, int fr, int fq) const {
        const int row0 = u.pm * BM + wr * 64 + fr, col0 = u.pn * BM + wc * 32 + 4 * fq;
#pragma unroll
        for (int ai = 0; ai < 2; ++ai)
#pragma unroll
            for (int mp = 0; mp < 2; ++mp) { f32x4 xv[2][2][2];
#pragma unroll
                for (int mm = 0; mm < 2; ++mm)
#pragma unroll
                    for (int bj = 0; bj < 2; ++bj)
#pragma unroll
                        for (int n = 0; n < 2; ++n) xv[mm][bj][n] = *(const f32x4*)(xsrc + (size_t)(row0 + ai * HALF + (2 * mp + mm) * 16) * DM + col0 + bj * HALF + n * 16);
                asm volatile("" ::: "memory");
#pragma unroll
                for (int mm = 0; mm < 2; ++mm)
#pragma unroll
                    for (int bj = 0; bj < 2; ++bj)
#pragma unroll
                        for (int n = 0; n < 2; ++n) *(f32x4*)(xdst + (size_t)(row0 + ai * HALF + (2 * mp + mm) * 16) * DM + col0 + bj * HALF + n * 16) = xv[mm][bj][n] + acc[ai][bj][2 * mp + mm][n];
                asm volatile("" ::: "memory"); }
    }
};
struct EpiMoeUp {
    static constexpr bool PERM = true;
    bf16_t* hid;
    __device__ __forceinline__ void operator()(AccT acc, const Unit& u, int wr, int wc, int fr, int fq) const {
        const int row0 = u.pm * BM + wr * 64 + fr, colb = u.pn * 128 + wc * 32 + 8 * fq;
#pragma unroll
        for (int ai = 0; ai < 2; ++ai)
#pragma unroll
            for (int m = 0; m < 4; ++m) { f32x4 r0, r1; const f32x4 a0 = acc[ai][0][m][0], a1 = acc[ai][0][m][1], b0 = acc[ai][1][m][0], b1 = acc[ai][1][m][1];
#pragma unroll
                for (int j = 0; j < 4; ++j) { r0[j] = siluf_(a0[j]) * b0[j]; r1[j] = siluf_(a1[j]) * b1[j]; }
                *(u32x4*)(hid + (size_t)(row0 + ai * HALF + m * 16) * FF + colb) = pack8(r0, r1); }
    }
};
struct OrderRouter {
    int G, c; long hlo_off;
    __device__ bool next(int i, Unit& u) const { const int L = i * G + c; if (L >= 256) return false; const int pm = L >> 2, which = (L >> 1) & 1, kh = L & 1;
        u.pm = pm; u.pn = which * 2 + kh; u.aoff = (long)pm * 256 * DM * 2 + (long)which * hlo_off + (long)kh * 1024 * 2; u.boff = (long)kh * 1024 * 2; return true; }
};
struct EpiRouter {
    static constexpr bool PERM = false;
    float* LOG;
    __device__ __forceinline__ void operator()(AccT acc, const Unit& u, int wr, int wc, int fr, int fq) const {
        float* base = LOG + ((size_t)u.pn * T + (size_t)u.pm * BM + wr * 64 + fr) * 128 + wc * 32 + 4 * fq;
#pragma unroll
        for (int ai = 0; ai < 2; ++ai)
#pragma unroll
            for (int m = 0; m < 4; ++m)
#pragma unroll
                for (int n = 0; n < 2; ++n) *(f32x4*)(base + (size_t)(ai * HALF + m * 16) * 128 + n * 16) = acc[ai][0][m][n];
    }
};
}

struct Args { const float* in[23]; float* out; unsigned char* ws; int ph_lo, ph_hi; };
enum { I_X = 0, I_NMIX, I_WIN, I_WRET, I_LNG, I_LNB, I_WS, I_BS, I_WGM, I_KVG, I_WUK, I_WUV, I_WDS, I_WOUT, I_NFFN, I_WGRP, I_BGRP, I_WEXP, I_BEXP, I_W1, I_W3, I_W2, I_FNG };
struct Ctx {
    LAS unsigned char* lds; volatile LAS int* misc; unsigned* ctl; GAS unsigned char* ws;
    int tid, lane, wave, G, bid, gw, NGW;
    const float* const* in; float* out;
};
#define WSP(T_, off) ((T_*)(C.ws + (off)))
__device__ __forceinline__ void refresh(Ctx& C) { int t = threadIdx.x; asm volatile("" : "+v"(t)); C.tid = t; C.lane = t & 63;
    GAS unsigned char* w = C.ws; asm volatile("" : "+s"(w)); C.ws = w; C.ctl = (unsigned*)w; }

__device__ __forceinline__ void ph_rope(const Ctx& C) {
    float* rope = WSP(float, WS_ROPE);
    const double r1 = 0.9305720409296989;
    for (int idx = C.bid * 512 + C.tid; idx < SEQ * 128; idx += C.G * 512) {
        const int pos = idx >> 7, i = idx & 127;
        double inv = 1.0, b = r1; int e = i;
        while (e) { if (e & 1) inv *= b; b *= b; e >>= 1; }
        const double ang = (double)pos * inv;
        const double n = __builtin_rint(ang * 0.15915494309189533577);
        const double x = ang - n * 6.283185307179586476925;
        const double x2 = x * x;
        double s = 0.0, c = 0.0;
#pragma unroll 1
        for (int k = 14; k >= 1; --k) { s = (s + 1.0) * (-x2 / (double)((2 * k) * (2 * k + 1))); c = (c + 1.0) * (-x2 / (double)((2 * k - 1) * (2 * k))); }
        s = (s + 1.0) * x; c = c + 1.0;
        *(f32x2*)(rope + (size_t)idx * 2) = (f32x2){(float)c, (float)s};
    }
}

template <class Map>
__device__ __forceinline__ void tr_item(const float* W, long srcld, bf16_t* WT, long dstld, int k0, int n0, LAS float* scr, int lane, const Map& map) {
    const int nn = n0 + (lane & 31); const long sc = map(nn);
#pragma unroll 8
    for (int i = 0; i < 32; ++i) { const int kk = 2 * i + (lane >> 5); scr[kk * 33 + (lane & 31)] = sc >= 0 ? W[(size_t)(k0 + kk) * srcld + sc] : 0.f; }
    asm volatile("s_waitcnt lgkmcnt(0)" ::: "memory");
    const int c = lane & 7;
#pragma unroll
    for (int j = 0; j < 4; ++j) { const int n = (lane >> 3) + 8 * j; const LAS float* s = scr + (8 * c) * 33 + n;
        u32x4 o; o.x = cvt_pk_bf16(s[0 * 33], s[1 * 33]); o.y = cvt_pk_bf16(s[2 * 33], s[3 * 33]); o.z = cvt_pk_bf16(s[4 * 33], s[5 * 33]); o.w = cvt_pk_bf16(s[6 * 33], s[7 * 33]);
        *(u32x4*)(WT + (size_t)(n0 + n) * dstld + k0 + 8 * c) = o; }
    asm volatile("s_waitcnt lgkmcnt(0)" ::: "memory");
}
struct MapId { __device__ long operator()(int n) const { return n; } };
struct MapIn { __device__ long operator()(int n) const { return n < GATE_SRC0 ? n : (n < GATE_DST0 ? -1 : n - (GATE_DST0 - GATE_SRC0)); } };
struct MapOff { long off; __device__ long operator()(int n) const { return n + off; } };

struct WItem { const float* src; bf16_t* dst; int srcld, dstld, k0, n0, mode; long off; };
__device__ __forceinline__ WItem w_item(const Ctx& C, int l, int r) {
    unsigned char* wb = (unsigned char*)(C.ws + WS_W); WItem w; w.mode = 0; w.off = 0;
    constexpr int N_IN = 32 * 224, N_BR = 16 * 32, N_OUT = 32 * 32, N_13 = 32 * 32 * 16, N_2 = 32 * 8 * 32;
    if (r < N_IN) { const int kb = r / 224, nb = r % 224; w.src = C.in[I_WIN] + (size_t)l * DM * INW; w.srcld = INW; w.dst = (bf16_t*)(wb + W_IN); w.dstld = DM; w.k0 = kb * 64; w.n0 = nb * 64; w.mode = 1; return w; } r -= N_IN;
    if (r < 3 * N_BR) { const int ww = r / N_BR, q = r % N_BR, kb = q / 32, nb = q % 32; w.src = C.in[ww == 0 ? I_WRET : (ww == 1 ? I_WGM : I_WDS)] + (size_t)l * 1024 * DM; w.srcld = DM;
        w.dst = (bf16_t*)(wb + (ww == 0 ? W_RET : (ww == 1 ? W_GM : W_DS))); w.dstld = 1024; w.k0 = kb * 64; w.n0 = nb * 64; return w; } r -= 3 * N_BR;
    if (r < N_OUT) { const int kb = r / 32, nb = r % 32; w.src = C.in[I_WOUT] + (size_t)l * DM * DM; w.srcld = DM; w.dst = (bf16_t*)(wb + W_OUT); w.dstld = DM; w.k0 = kb * 64; w.n0 = nb * 64; return w; } r -= N_OUT;
    if (r < N_13) { const int e = r / 512, q = r % 512, kb = q / 16, nb = q % 16, row0 = nb * 64, j = row0 >> 8, sft = (row0 >> 7) & 1, fp = row0 & 127;
        w.src = C.in[sft ? I_W3 : I_W1] + ((size_t)l * NEXP + e) * DM * FF; w.srcld = FF; w.dst = (bf16_t*)(wb + W_13) + (size_t)e * 1024 * DM; w.dstld = DM; w.k0 = kb * 64; w.n0 = row0; w.off = (long)(128 * j + fp) - row0; return w; } r -= N_13;
    if (r < N_2) { const int e = r / 256, q = r % 256, kb = q / 32, nb = q % 32; w.src = C.in[I_W2] + ((size_t)l * NEXP + e) * FF * DM; w.srcld = DM; w.dst = (bf16_t*)(wb + W_2) + (size_t)e * DM * FF; w.dstld = FF; w.k0 = kb * 64; w.n0 = nb * 64; return w; } r -= N_2;
    { const int h = r / 8, q = r % 8, kb = q / 2, nb = q % 2;
      w.src = C.in[I_WUV] + ((size_t)l * 8 + h) * 256 * 128; w.srcld = 128; w.dst = (bf16_t*)(wb + W_UV) + (size_t)(h * 128) * 512 + (h & 1) * 256; w.dstld = 512; w.k0 = kb * 64; w.n0 = nb * 64; return w; }
}
__device__ __forceinline__ void w_load(const WItem& w, int lane, f32x4 (&R)[16]) {
    const int nq = lane & 15, kq = lane >> 4, n = w.n0 + 4 * nq;
    const long sc = (w.mode == 1) ? (n < GATE_SRC0 ? (long)n : (n < GATE_DST0 ? -1L : (long)(n - (GATE_DST0 - GATE_SRC0)))) : (long)n + w.off;
    const float* p = w.src + (size_t)(w.k0 + 2 * kq) * w.srcld + (sc >= 0 ? sc : 0);
#pragma unroll
    for (int i = 0; i < 8; ++i)
#pragma unroll
        for (int s2 = 0; s2 < 2; ++s2) { f32x4 v = *(const f32x4*)(p + (size_t)(8 * i + s2) * w.srcld); if (sc < 0) v = (f32x4){0.f, 0.f, 0.f, 0.f}; R[2 * i + s2] = v; }
}
__device__ __forceinline__ void w_store(const WItem& w, int lane, const f32x4 (&R)[16], LAS unsigned* scr) {
    const int nq = lane & 15, kq = lane >> 4;
#pragma unroll
    for (int i = 0; i < 8; ++i)
#pragma unroll
        for (int e = 0; e < 4; ++e) scr[(4 * nq + e) * 33 + 4 * i + kq] = cvt_pk_bf16(R[2 * i][e], R[2 * i + 1][e]);
    asm volatile("s_waitcnt lgkmcnt(0)" ::: "memory");
    const int c = lane & 7;
#pragma unroll
    for (int j = 0; j < 8; ++j) { const int n = (lane >> 3) + 8 * j; const LAS unsigned* sp = scr + n * 33 + 4 * c;
        u32x4 o; o.x = sp[0]; o.y = sp[1]; o.z = sp[2]; o.w = sp[3];
        *(u32x4*)(w.dst + (size_t)(w.n0 + n) * w.dstld + w.k0 + 8 * c) = o; }
    asm volatile("s_waitcnt lgkmcnt(0)" ::: "memory");
}
__device__ __forceinline__ void ph_weights(const Ctx& C, int l) {
    LAS unsigned* scr = (LAS unsigned*)(C.lds + C.wave * 16384);
    unsigned char* wb = (unsigned char*)(C.ws + WS_W);
    constexpr int NITEMS = 32 * 224 + 3 * 16 * 32 + 32 * 32 + 32 * 32 * 16 + 32 * 8 * 32 + 8 * 8;
    { int it = C.gw; f32x4 R[16], Rn[16]; WItem w, wn;
      if (it < NITEMS) { w = w_item(C, l, it); w_load(w, C.lane, R); }
#pragma unroll 1
      while (it < NITEMS) { const int itn = it + C.NGW;
          if (itn < NITEMS) { wn = w_item(C, l, itn); w_load(wn, C.lane, Rn); }
          w_store(w, C.lane, R, scr);
#pragma unroll
          for (int i = 0; i < 16; ++i) R[i] = Rn[i];
          w = wn; it = itn; } }
    bf16_t* uv = (bf16_t*)(wb + W_UV); bf16_t* uk = (bf16_t*)(wb + W_UK); const float* wuk = C.in[I_WUK] + (size_t)l * 8 * 256 * 128;
    for (int idx = C.bid * 512 + C.tid; idx < 1024 * 256 / 8; idx += C.G * 512) { const int row = idx >> 5, c8 = (idx & 31) * 8, h = row >> 7;
        *(u32x4*)(uv + (size_t)row * 512 + (1 - (h & 1)) * 256 + c8) = (u32x4){0u, 0u, 0u, 0u}; }
    for (int idx = C.bid * 512 + C.tid; idx < 2048 * 256 / 8; idx += C.G * 512) { const int row = idx >> 5, c8 = (idx & 31) * 8, h = row >> 8, half = c8 >> 7;
        u32x4 o = (u32x4){0u, 0u, 0u, 0u};
        if (half == (h & 1)) { const float* s = wuk + (size_t)row * 128 + (c8 & 127); const f32x4 a = *(const f32x4*)s, b = *(const f32x4*)(s + 4); o = pack8(a, b); }
        *(u32x4*)(uk + (size_t)row * 256 + c8) = o; }
    bf16_t* rt = (bf16_t*)(wb + W_RT); const float* wgr = C.in[I_WGRP] + (size_t)l * DM * 4; const float* wex = C.in[I_WEXP] + (size_t)l * 4 * DM * 8;
    for (int idx = C.bid * 512 + C.tid; idx < 256 * 256; idx += C.G * 512) { const int r = idx >> 8, k8 = (idx & 255) * 8, c = r & 63, part = r >> 6;
        u32x4 o = (u32x4){0u, 0u, 0u, 0u};
        if (part < 2 && c < 36) { float v[8];
#pragma unroll
            for (int j = 0; j < 8; ++j) { const float wv = (c < 4) ? wgr[(size_t)(k8 + j) * 4 + c] : wex[((size_t)((c - 4) >> 3) * DM + (k8 + j)) * 8 + ((c - 4) & 7)];
                const float hi = bf2f(f2bf(wv)); v[j] = part == 0 ? hi : (wv - hi); }
            o = pack8((f32x4){v[0], v[1], v[2], v[3]}, (f32x4){v[4], v[5], v[6], v[7]}); }
        *(u32x4*)(rt + (size_t)r * DM + k8) = o; }
}

__device__ __forceinline__ void ph_norm(const Ctx& C, const float* x, const float* g, bf16_t* H) {
    for (int row = C.gw; row < T; row += C.NGW) {
        const f32x4* xr = (const f32x4*)(x + (size_t)row * DM) + C.lane; f32x4 v[8]; float ss = 0.f;
#pragma unroll
        for (int j = 0; j < 8; ++j) { v[j] = xr[64 * j]; ss += v[j][0] * v[j][0] + v[j][1] * v[j][1] + v[j][2] * v[j][2] + v[j][3] * v[j][3]; }
        const float rstd = rsqrtf(wave_sum(ss, C.lane) * (1.f / DM) + EPS);
        u32x2* o = (u32x2*)(H + (size_t)row * DM) + C.lane;
#pragma unroll
        for (int j = 0; j < 8; ++j) { const f32x4 gg = ((const f32x4*)g)[64 * j + C.lane]; const f32x4 y = v[j] * rstd * gg; u32x2 w; w.x = cvt_pk_bf16(y[0], y[1]); w.y = cvt_pk_bf16(y[2], y[3]); o[64 * j] = w; }
    }
}
__device__ __forceinline__ void ph_ckv(const Ctx& C, const float* dcraw, const float* g, bf16_t* ckv) {
    for (int row = C.gw; row < T; row += C.NGW) {
        const f32x4 v = ((const f32x4*)(dcraw + (size_t)row * 256))[C.lane];
        const float ss = wave_sum(v[0] * v[0] + v[1] * v[1] + v[2] * v[2] + v[3] * v[3], C.lane);
        const float rstd = rsqrtf(ss * (1.f / 256.f) + EPS); const f32x4 y = v * rstd * ((const f32x4*)g)[C.lane];
        u32x2 w; w.x = cvt_pk_bf16(y[0], y[1]); w.y = cvt_pk_bf16(y[2], y[3]); ((u32x2*)(ckv + (size_t)row * 256))[C.lane] = w;
    }
}

__device__ __forceinline__ void ph_gmlp_naive(const Ctx& C, int l) {
    const bf16_t* gu = WSP(bf16_t, WS_PROJ + P_GU); const bf16_t* gv = WSP(bf16_t, WS_PROJ + P_GV); const float* stats = WSP(float, WS_STATS); bf16_t* gm = WSP(bf16_t, WS_GM);
    const float* lng = C.in[I_LNG] + l * 1024; const float* lnb = C.in[I_LNB] + l * 1024; const float* Wsp = C.in[I_WS] + (size_t)l * 4 * 128 * 128; const float* bs = C.in[I_BS] + l * 4 * 128;
    LAS float* smean = (LAS float*)C.lds; LAS float* srstd = smean + 128; LAS float* lv = srstd + 128;
    for (int u = C.bid; u < 512; u += C.G) {
        const int g = u & 3, bn = u >> 2, t0 = bn * 128;
        __syncthreads();
        if (C.tid < 128) { const float* sp = stats + (size_t)(t0 + C.tid) * 32; float s = 0.f, q = 0.f;
            for (int k = 0; k < 16; ++k) { s += sp[2 * k]; q += sp[2 * k + 1]; }
            const float mean = s * (1.f / 1024.f), var = q * (1.f / 1024.f) - mean * mean; smean[C.tid] = mean; srstd[C.tid] = rsqrtf(var + EPS); }
        __syncthreads();
        for (int idx = C.tid; idx < 128 * 256; idx += 512) { const int j = idx >> 8, c = idx & 255, ch = g * 256 + c;
            lv[idx] = (bf2f(gv[(size_t)(t0 + j) * 1024 + ch]) - smean[j]) * srstd[j] * lng[ch] + lnb[ch]; }
        __syncthreads();
        for (int idx = C.tid; idx < 128 * 256; idx += 512) { const int i = idx >> 8, c = idx & 255; const float* wr = Wsp + ((size_t)g * 128 + i) * 128; float a = 0.f;
            for (int j = 0; j <= i; ++j) a += wr[j] * lv[j * 256 + c];
            a += bs[g * 128 + i];
            const size_t o = (size_t)(t0 + i) * 1024 + g * 256 + c; gm[o] = (bf16_t)f2bf(bf2f(gu[o]) * a); }
    }
}
__device__ __forceinline__ void ph_ret_naive(const Ctx& C) {
    const bf16_t* rq = WSP(bf16_t, WS_PROJ + P_RQ); const bf16_t* rk = WSP(bf16_t, WS_PROJ + P_RK); const bf16_t* rv = WSP(bf16_t, WS_PROJ + P_RV); const bf16_t* rg = WSP(bf16_t, WS_PROJ + P_RG); bf16_t* ret = WSP(bf16_t, WS_RET);
    LAS float* sq = (LAS float*)C.lds; LAS float* sa = sq + 256; LAS float* red = sa + 4096;
    for (int u = C.bid; u < NB * 4 * SEQ; u += C.G) {
        const int t = (SEQ - 1) - (u / 16), bh = u % 16, b = bh >> 2, h = bh & 3; const size_t rowb = (size_t)b * SEQ;
        const float lg2 = log2f(1.0f - exp2f(-5.0f - (float)h));
        __syncthreads();
        if (C.tid < 256) sq[C.tid] = bf2f(rq[(rowb + t) * 1024 + h * 256 + C.tid]);
        __syncthreads();
        for (int s = C.tid; s <= t; s += 512) { const u32x4* kp = (const u32x4*)(rk + (rowb + s) * 1024 + h * 256); float a = 0.f;
            for (int d8 = 0; d8 < 32; ++d8) { float f[8]; unpack8(kp[d8], f);
#pragma unroll
                for (int j = 0; j < 8; ++j) a += sq[d8 * 8 + j] * f[j]; }
            sa[s] = a * exp2f(lg2 * (float)(t - s)); }
        __syncthreads();
        float o = 0.f;
        if (C.tid < 256) { const bf16_t* vp = rv + rowb * 1024 + h * 256 + C.tid; for (int s = 0; s <= t; ++s) o += sa[s] * bf2f(vp[(size_t)s * 1024]); }
        const float ss = wave_sum(o * o, C.lane); if (C.lane == 0) red[C.wave] = ss;
        __syncthreads();
        if (C.tid < 256) { const float tot = red[0] + red[1] + red[2] + red[3]; const float y = o * rsqrtf(tot * (1.f / 256.f) + EPS);
            const size_t oi = (rowb + t) * 1024 + h * 256 + C.tid; ret[oi] = (bf16_t)f2bf(bf2f(rg[oi]) * y); }
    }
}
__device__ __forceinline__ void ph_idx_naive(const Ctx& C) {
    const bf16_t* iq = WSP(bf16_t, WS_PROJ + P_IQ); const bf16_t* ik = WSP(bf16_t, WS_PROJ + P_IK); const float* iw = WSP(float, WS_PROJ + P_IW); unsigned short* sel = WSP(unsigned short, WS_SEL);
    LAS float* sq = (LAS float*)C.lds; LAS float* sw = sq + 512; LAS float* sc = sw + 8;
    for (int u = C.bid; u < T; u += C.G) {
        const int tq = (T - 1) - u; const int b = tq >> 12, q = tq & (SEQ - 1), n = q + 1;
        __syncthreads();
        sq[C.tid] = bf2f(iq[(size_t)tq * 512 + C.tid]); if (C.tid < 8) sw[C.tid] = iw[(size_t)tq * 8 + C.tid];
        for (int r = C.tid; r < 256; r += 512) sel[(size_t)tq * 256 + r] = 0xFFFFu;
        __syncthreads();
        for (int s = C.tid; s < n; s += 512) { const u32x4* kp = (const u32x4*)(ik + ((size_t)b * SEQ + s) * 64); float kf[64];
#pragma unroll
            for (int d8 = 0; d8 < 8; ++d8) { float f[8]; unpack8(kp[d8], f);
#pragma unroll
                for (int j = 0; j < 8; ++j) kf[d8 * 8 + j] = f[j]; }
            float score = 0.f;
#pragma unroll 1
            for (int h = 0; h < 8; ++h) { float a = 0.f;
#pragma unroll
                for (int d = 0; d < 64; ++d) a += sq[h * 64 + d] * kf[d];
                score += sw[h] * fmaxf(a * 0.125f, 0.f); }
            sc[s] = score; }
        __syncthreads();
        for (int s = C.tid; s < n; s += 512) { const float v = sc[s]; int rank = 0;
            for (int s2 = 0; s2 < n; ++s2) { const float w = sc[s2]; rank += (w > v || (w == v && s2 < s)) ? 1 : 0; }
            if (rank < 256) sel[(size_t)tq * 256 + rank] = (unsigned short)s; }
    }
}
__device__ __forceinline__ void ph_att_naive(const Ctx& C) {
    const bf16_t* qabs = WSP(bf16_t, WS_QABS); const bf16_t* ckv = WSP(bf16_t, WS_CKV); const unsigned short* sel = WSP(unsigned short, WS_SEL); bf16_t* olat = WSP(bf16_t, WS_OLAT);
    LAS float* sqa = (LAS float*)C.lds; LAS float* sp = sqa + 2048; LAS int* ssel = (LAS int*)(sp + 2048);
    for (int tq = C.bid; tq < T; tq += C.G) {
        const int b = tq >> 12, q = tq & (SEQ - 1);
        __syncthreads();
        for (int i = C.tid; i < 2048; i += 512) sqa[i] = bf2f(qabs[(size_t)tq * 2048 + i]);
        if (C.tid < 256) { const int s = sel[(size_t)tq * 256 + C.tid]; ssel[C.tid] = (s <= q) ? s : -1; }
        __syncthreads();
        const int h = C.wave; float sv[4]; float mx = -INFINITY;
#pragma unroll
        for (int j = 0; j < 4; ++j) { const int k = C.lane + 64 * j, s = ssel[k]; float a = -INFINITY;
            if (s >= 0) { const u32x4* cp = (const u32x4*)(ckv + ((size_t)b * SEQ + s) * 256); a = 0.f;
                for (int c8 = 0; c8 < 32; ++c8) { float f[8]; unpack8(cp[c8], f);
#pragma unroll
                    for (int jj = 0; jj < 8; ++jj) a += sqa[h * 256 + c8 * 8 + jj] * f[jj]; } }
            sv[j] = a; mx = fmaxf(mx, a); }
        mx = wave_max(mx, C.lane); float sum = 0.f;
#pragma unroll
        for (int j = 0; j < 4; ++j) { sv[j] = __expf(sv[j] - mx); sum += sv[j]; }
        sum = wave_sum(sum, C.lane); const float inv = 1.f / sum;
#pragma unroll
        for (int j = 0; j < 4; ++j) sp[h * 256 + C.lane + 64 * j] = sv[j] * inv;
        __syncthreads();
        float o[4] = {0.f, 0.f, 0.f, 0.f};
        for (int k = 0; k < 256; ++k) { const int s = ssel[k]; if (s < 0) continue; const float p = sp[h * 256 + k]; const bf16_t* cp = ckv + ((size_t)b * SEQ + s) * 256 + C.lane;
#pragma unroll
            for (int j = 0; j < 4; ++j) o[j] += p * bf2f(cp[64 * j]); }
#pragma unroll
        for (int j = 0; j < 4; ++j) olat[(size_t)tq * 2048 + h * 256 + C.lane + 64 * j] = (bf16_t)f2bf(o[j]);
    }
}

typedef short v4i16_t __attribute__((ext_vector_type(4)));
__device__ __forceinline__ s16x4 tr_read(const LAS unsigned char* p) { return __builtin_bit_cast(s16x4, __builtin_amdgcn_ds_read_tr16_b64_v4i16((LAS v4i16_t*)p)); }
__device__ __forceinline__ bf16x8 tr_frag(const LAS unsigned char* X, int LDX, int rowA, int rowB, int n0, int lane) {
    const int q = (lane & 15) >> 2, p = lane & 3;
    const s16x4 lo = tr_read(X + (rowA + q) * LDX + (n0 + 4 * p) * 2), hi = tr_read(X + (rowB + q) * LDX + (n0 + 4 * p) * 2);
    return (bf16x8){lo[0], lo[1], lo[2], lo[3], hi[0], hi[1], hi[2], hi[3]};
}
constexpr int TLD = 544;
__device__ __forceinline__ bf16x8 as_bf16x8(u32x4 w) { return __builtin_bit_cast(bf16x8, w); }

__device__ __forceinline__ void ph_ret_kv(const Ctx& C) {
    const bf16_t* rk = WSP(bf16_t, WS_PROJ + P_RK); const bf16_t* rv = WSP(bf16_t, WS_PROJ + P_RV); bf16_t* KV = WSP(bf16_t, WS_KV);
    const LAS unsigned char* Vt = C.lds; const LAS unsigned char* Kt = C.lds + 128 * TLD;
    const int g = C.lane >> 4, fr = C.lane & 15, wr = C.wave >> 2, wc = C.wave & 3;
    for (int u = C.bid; u < 512; u += C.G) {
        const int n = u & 31, h = (u >> 5) & 3, b = u >> 7; const size_t row0 = (size_t)b * SEQ + n * 128;
        const float lg2 = log2f(1.0f - exp2f(-5.0f - (float)h));
        __syncthreads();
#pragma unroll
        for (int p = 0; p < 8; ++p) { const int idx = p * 512 + C.tid, row = idx >> 5, ch = idx & 31; const size_t go = (row0 + row) * 1024 + h * 256 + ch * 8;
            const u32x4 vv = *(const u32x4*)(rv + go); *(LAS u32x4*)(C.lds + row * TLD + ch * 16) = vv;
            float f[8]; unpack8(*(const u32x4*)(rk + go), f); const float z = exp2f(lg2 * (float)(127 - row));
            *(LAS u32x4*)(C.lds + 128 * TLD + row * TLD + ch * 16) = pack8((f32x4){f[0] * z, f[1] * z, f[2] * z, f[3] * z}, (f32x4){f[4] * z, f[5] * z, f[6] * z, f[7] * z}); }
        __syncthreads();
        f32x4 acc[8][4];
#pragma unroll
        for (int m = 0; m < 8; ++m)
#pragma unroll
            for (int nn = 0; nn < 4; ++nn) acc[m][nn] = (f32x4){0.f, 0.f, 0.f, 0.f};
#pragma unroll 1
        for (int ks = 0; ks < 4; ++ks) { bf16x8 Bv[4];
#pragma unroll
            for (int nn = 0; nn < 4; ++nn) Bv[nn] = tr_frag(Vt, TLD, 32 * ks + 8 * g, 32 * ks + 8 * g + 4, 64 * wc + 16 * nn, C.lane);
#pragma unroll
            for (int m = 0; m < 8; ++m) { const bf16x8 Ak = tr_frag(Kt, TLD, 32 * ks + 8 * g, 32 * ks + 8 * g + 4, 128 * wr + 16 * m, C.lane);
#pragma unroll
                for (int nn = 0; nn < 4; ++nn) acc[m][nn] = __builtin_amdgcn_mfma_f32_16x16x32_bf16(Ak, Bv[nn], acc[m][nn], 0, 0, 0); } }
        bf16_t* out = KV + (size_t)u * 65536;
#pragma unroll
        for (int m = 0; m < 8; ++m)
#pragma unroll
            for (int nn = 0; nn < 4; ++nn) { const int e = 64 * wc + 16 * nn + fr, d = 128 * wr + 16 * m + 4 * g; u32x2 w; w.x = cvt_pk_bf16(acc[m][nn][0], acc[m][nn][1]); w.y = cvt_pk_bf16(acc[m][nn][2], acc[m][nn][3]);
                *(u32x2*)(out + e * 256 + d) = w; }
    }
}
__device__ __forceinline__ void ph_ret_scan(const Ctx& C) {
    const bf16_t* KV = WSP(bf16_t, WS_KV); bf16_t* Rb = WSP(bf16_t, WS_R);
    for (int idx = C.bid * 512 + C.tid; idx < 16 * 8192; idx += C.G * 512) {
        const int bh = idx >> 13, off = (idx & 8191) * 8, h = bh & 3; const float gc = exp2f(128.0f * log2f(1.0f - exp2f(-5.0f - (float)h)));
        float R[8] = {0.f, 0.f, 0.f, 0.f, 0.f, 0.f, 0.f, 0.f};
#pragma unroll 4
        for (int n = 0; n < 32; ++n) { const size_t o = ((size_t)bh * 32 + n) * 65536 + off;
            *(u32x4*)(Rb + o) = pack8((f32x4){R[0], R[1], R[2], R[3]}, (f32x4){R[4], R[5], R[6], R[7]});
            float f[8]; unpack8(*(const u32x4*)(KV + o), f);
#pragma unroll
            for (int j = 0; j < 8; ++j) R[j] = R[j] * gc + f[j]; }
    }
}
__device__ __forceinline__ void ph_ret_out(const Ctx& C) {
    const bf16_t* rq = WSP(bf16_t, WS_PROJ + P_RQ); const bf16_t* rk = WSP(bf16_t, WS_PROJ + P_RK); const bf16_t* rv = WSP(bf16_t, WS_PROJ + P_RV); const bf16_t* rg = WSP(bf16_t, WS_PROJ + P_RG);
    const bf16_t* Rb = WSP(bf16_t, WS_R); bf16_t* ret = WSP(bf16_t, WS_RET);
    const LAS unsigned char* Vt = C.lds;
    const int g = C.lane >> 4, fr = C.lane & 15, w = C.wave;
    for (int u = C.bid; u < 512; u += C.G) {
        const int n = u & 31, h = (u >> 5) & 3, b = u >> 7; const size_t row0 = (size_t)b * SEQ + n * 128;
        const float lg2 = log2f(1.0f - exp2f(-5.0f - (float)h));
        __syncthreads();
#pragma unroll
        for (int p = 0; p < 8; ++p) { const int idx = p * 512 + C.tid, row = idx >> 5, ch = idx & 31;
            *(LAS u32x4*)(C.lds + row * TLD + ch * 16) = *(const u32x4*)(rv + (row0 + row) * 1024 + h * 256 + ch * 8); }
        __syncthreads();
        const int i = 16 * w + fr;
        bf16x8 Bq[8];
        { const bf16_t* qp = rq + (row0 + i) * 1024 + h * 256 + 8 * g;
#pragma unroll
          for (int ks = 0; ks < 8; ++ks) Bq[ks] = as_bf16x8(*(const u32x4*)(qp + 32 * ks)); }
        f32x4 acc[16];
#pragma unroll
        for (int nt = 0; nt < 16; ++nt) acc[nt] = (f32x4){0.f, 0.f, 0.f, 0.f};
        if (n > 0) {
            constexpr int R_OFF = 128 * TLD, RLD = 272;
#pragma unroll
            for (int dh = 0; dh < 2; ++dh) {
                if (dh) __syncthreads();
#pragma unroll
                for (int p = 0; p < 8; ++p) { const int idx = p * 512 + C.tid, e = idx >> 4, c16 = idx & 15;
                    *(LAS u32x4*)(C.lds + R_OFF + e * RLD + c16 * 16) = *(const u32x4*)(Rb + (size_t)u * 65536 + (size_t)e * 256 + dh * 128 + c16 * 8); }
                __syncthreads();
#pragma unroll
                for (int k4 = 0; k4 < 4; ++k4)
#pragma unroll
                    for (int nt = 0; nt < 16; ++nt) { const bf16x8 Ar = as_bf16x8(*(const LAS u32x4*)(C.lds + R_OFF + (16 * nt + fr) * RLD + (32 * k4 + 8 * g) * 2));
                        acc[nt] = __builtin_amdgcn_mfma_f32_16x16x32_bf16(Ar, Bq[4 * dh + k4], acc[nt], 0, 0, 0); }
            }
            const float xi = exp2f(lg2 * (float)(i + 1));
#pragma unroll
            for (int nt = 0; nt < 16; ++nt) acc[nt] = acc[nt] * xi;
        }
        f32x4 ST[8];
#pragma unroll
        for (int jt = 0; jt < 8; ++jt) { ST[jt] = (f32x4){0.f, 0.f, 0.f, 0.f};
            if (jt <= w) { const bf16_t* kp = rk + (row0 + 16 * jt + fr) * 1024 + h * 256 + 8 * g;
#pragma unroll
                for (int ks = 0; ks < 8; ++ks) { const bf16x8 Ak = as_bf16x8(*(const u32x4*)(kp + 32 * ks)); ST[jt] = __builtin_amdgcn_mfma_f32_16x16x32_bf16(Ak, Bq[ks], ST[jt], 0, 0, 0); }
#pragma unroll
                for (int r = 0; r < 4; ++r) { const int j = 16 * jt + 4 * g + r; ST[jt][r] = (i >= j) ? ST[jt][r] * exp2f(lg2 * (float)(i - j)) : 0.f; } } }
#pragma unroll
        for (int t = 0; t < 4; ++t) if (2 * t <= w) {
            u32x4 sw; sw.x = cvt_pk_bf16(ST[2 * t][0], ST[2 * t][1]); sw.y = cvt_pk_bf16(ST[2 * t][2], ST[2 * t][3]); sw.z = cvt_pk_bf16(ST[2 * t + 1][0], ST[2 * t + 1][1]); sw.w = cvt_pk_bf16(ST[2 * t + 1][2], ST[2 * t + 1][3]);
            const bf16x8 Bs = as_bf16x8(sw);
#pragma unroll
            for (int nt = 0; nt < 16; ++nt) { const bf16x8 Av = tr_frag(Vt, TLD, 32 * t + 4 * g, 32 * t + 16 + 4 * g, 16 * nt, C.lane); acc[nt] = __builtin_amdgcn_mfma_f32_16x16x32_bf16(Av, Bs, acc[nt], 0, 0, 0); } }
        float ss = 0.f;
#pragma unroll
        for (int nt = 0; nt < 16; ++nt) ss += acc[nt][0] * acc[nt][0] + acc[nt][1] * acc[nt][1] + acc[nt][2] * acc[nt][2] + acc[nt][3] * acc[nt][3];
        ss += shx(ss, 16, C.lane); ss += shx(ss, 32, C.lane);
        const float rstd = rsqrtf(ss * (1.f / 256.f) + EPS);
        const size_t ob = (row0 + i) * 1024 + h * 256 + 4 * g;
#pragma unroll
        for (int nt = 0; nt < 16; ++nt) { const u32x2 gw = *(const u32x2*)(rg + ob + 16 * nt); u32x2 o;
            o.x = cvt_pk_bf16(acc[nt][0] * rstd * bf2f(gw.x), acc[nt][1] * rstd * bf2f(gw.x >> 16)); o.y = cvt_pk_bf16(acc[nt][2] * rstd * bf2f(gw.y), acc[nt][3] * rstd * bf2f(gw.y >> 16));
            *(u32x2*)(ret + ob + 16 * nt) = o; }
    }
}
__device__ __forceinline__ void ph_gmlp(const Ctx& C, int l) {
    const bf16_t* gu = WSP(bf16_t, WS_PROJ + P_GU); const bf16_t* gv = WSP(bf16_t, WS_PROJ + P_GV); const float* stats = WSP(float, WS_STATS); bf16_t* gm = WSP(bf16_t, WS_GM);
    const float* lng = C.in[I_LNG] + l * 1024; const float* lnb = C.in[I_LNB] + l * 1024; const float* Wsp = C.in[I_WS] + (size_t)l * 4 * 128 * 128; const float* bs = C.in[I_BS] + l * 4 * 128;
    constexpr int WLD = 272, W_OFF = 128 * TLD, ST_OFF = W_OFF + 128 * WLD;
    const LAS unsigned char* Lt = C.lds; LAS float* sst = (LAS float*)(C.lds + ST_OFF);
    const int g4 = C.lane >> 4, fr = C.lane & 15, w = C.wave;
    for (int u = C.bid; u < 512; u += C.G) {
        const int gg = u & 3, bn = u >> 2, t0 = bn * 128;
        __syncthreads();
        if (C.tid < 128) { const float* sp = stats + (size_t)(t0 + C.tid) * 32; float s = 0.f, q = 0.f;
#pragma unroll
            for (int k = 0; k < 16; ++k) { s += sp[2 * k]; q += sp[2 * k + 1]; }
            const float mean = s * (1.f / 1024.f), var = q * (1.f / 1024.f) - mean * mean; sst[2 * C.tid] = mean; sst[2 * C.tid + 1] = rsqrtf(var + EPS); }
#pragma unroll
        for (int p = 0; p < 4; ++p) { const int idx = p * 512 + C.tid, i = idx >> 4, j8 = (idx & 15) * 8; const float* wp = Wsp + ((size_t)gg * 128 + i) * 128 + j8;
            f32x4 a = *(const f32x4*)wp, b2 = *(const f32x4*)(wp + 4);
#pragma unroll
            for (int j = 0; j < 4; ++j) { if (j8 + j > i) a[j] = 0.f; if (j8 + 4 + j > i) b2[j] = 0.f; }
            *(LAS u32x4*)(C.lds + W_OFF + i * WLD + j8 * 2) = pack8(a, b2); }
        __syncthreads();
#pragma unroll
        for (int p = 0; p < 8; ++p) { const int idx = p * 512 + C.tid, row = idx >> 5, ch = idx & 31, cg = gg * 256 + ch * 8;
            float f[8]; unpack8(*(const u32x4*)(gv + (size_t)(t0 + row) * 1024 + cg), f); const float mean = sst[2 * row], rstd = sst[2 * row + 1];
            const f32x4 g0 = *(const f32x4*)(lng + cg), g1 = *(const f32x4*)(lng + cg + 4), b0 = *(const f32x4*)(lnb + cg), b1 = *(const f32x4*)(lnb + cg + 4);
            f32x4 y0, y1;
#pragma unroll
            for (int j = 0; j < 4; ++j) { y0[j] = (f[j] - mean) * rstd * g0[j] + b0[j]; y1[j] = (f[4 + j] - mean) * rstd * g1[j] + b1[j]; }
            *(LAS u32x4*)(C.lds + row * TLD + ch * 16) = pack8(y0, y1); }
        __syncthreads();
        f32x4 acc[16];
#pragma unroll
        for (int nt = 0; nt < 16; ++nt) acc[nt] = (f32x4){0.f, 0.f, 0.f, 0.f};
#pragma unroll
        for (int ks = 0; ks < 4; ++ks) if (2 * ks <= w) {
            const bf16x8 Bw = as_bf16x8(*(const LAS u32x4*)(C.lds + W_OFF + (16 * w + fr) * WLD + (32 * ks + 8 * g4) * 2));
#pragma unroll
            for (int nt = 0; nt < 16; ++nt) { const bf16x8 Av = tr_frag(Lt, TLD, 32 * ks + 8 * g4, 32 * ks + 8 * g4 + 4, 16 * nt, C.lane); acc[nt] = __builtin_amdgcn_mfma_f32_16x16x32_bf16(Av, Bw, acc[nt], 0, 0, 0); } }
        const int i = 16 * w + fr; const float bias = bs[gg * 128 + i]; const size_t ob = (size_t)(t0 + i) * 1024 + gg * 256 + 4 * g4;
#pragma unroll
        for (int nt = 0; nt < 16; ++nt) { const u32x2 uw = *(const u32x2*)(gu + ob + 16 * nt); u32x2 o;
            o.x = cvt_pk_bf16((acc[nt][0] + bias) * bf2f(uw.x), (acc[nt][1] + bias) * bf2f(uw.x >> 16)); o.y = cvt_pk_bf16((acc[nt][2] + bias) * bf2f(uw.y), (acc[nt][3] + bias) * bf2f(uw.y >> 16));
            *(u32x2*)(gm + ob + 16 * nt) = o; }
    }
}

__device__ __forceinline__ void ph_idx(const Ctx& C) {
    const bf16_t* iq = WSP(bf16_t, WS_PROJ + P_IQ); const bf16_t* ik = WSP(bf16_t, WS_PROJ + P_IK); const float* iw = WSP(float, WS_PROJ + P_IW); unsigned short* sel = WSP(unsigned short, WS_SEL);
    LAS unsigned* sc = (LAS unsigned*)C.lds;
    const int lane = C.lane, n32 = lane & 31, hh = lane >> 5, w = C.wave;
    for (int u = C.bid; u < T / 8; u += C.G) {
        const int b = u & 3, q0 = (SEQ / 8 - 1 - (u >> 2)) * 8, tq0 = b * SEQ + q0, nk = q0 + 8, nkt = (nk + 31) >> 5;
        __syncthreads();
        bf16x8 Aq[2][4]; float wq[2][16];
        { const int r = n32, qi = 2 * ((r >> 2) & 1) + (r >> 4), hd = (r & 3) + 4 * ((r >> 3) & 1);
#pragma unroll
          for (int mt = 0; mt < 2; ++mt) { const bf16_t* qp = iq + (size_t)(tq0 + 4 * mt + qi) * 512 + hd * 64 + 8 * hh;
#pragma unroll
              for (int ks = 0; ks < 4; ++ks) Aq[mt][ks] = as_bf16x8(*(const u32x4*)(qp + 16 * ks));
#pragma unroll
              for (int a = 0; a < 2; ++a) { const float* wp = iw + (size_t)(tq0 + 4 * mt + 2 * hh + a) * 8; const f32x4 w0 = *(const f32x4*)wp, w1 = *(const f32x4*)(wp + 4);
#pragma unroll
                  for (int j = 0; j < 4; ++j) { wq[mt][8 * a + j] = w0[j] * 0.125f; wq[mt][8 * a + 4 + j] = w1[j] * 0.125f; } } } }
        u32x4 Bn[4];
        { const bf16_t* kp = ik + ((size_t)b * SEQ + 32 * (w < nkt ? w : 0) + n32) * 64 + 8 * hh;
#pragma unroll
          for (int ks = 0; ks < 4; ++ks) Bn[ks] = *(const u32x4*)(kp + 16 * ks); }
        for (int kt = w; kt < nkt; kt += 8) {
            bf16x8 Bk[4];
#pragma unroll
            for (int ks = 0; ks < 4; ++ks) Bk[ks] = as_bf16x8(Bn[ks]);
            { const int k2 = (kt + 8 < nkt) ? kt + 8 : kt; const bf16_t* kp = ik + ((size_t)b * SEQ + 32 * k2 + n32) * 64 + 8 * hh;
#pragma unroll
              for (int ks = 0; ks < 4; ++ks) Bn[ks] = *(const u32x4*)(kp + 16 * ks); }
#pragma unroll
            for (int mt = 0; mt < 2; ++mt) { f32x16 acc;
#pragma unroll
                for (int j = 0; j < 16; ++j) acc[j] = 0.f;
#pragma unroll
                for (int ks = 0; ks < 4; ++ks) acc = __builtin_amdgcn_mfma_f32_32x32x16_bf16(Aq[mt][ks], Bk[ks], acc, 0, 0, 0);
#pragma unroll
                for (int a = 0; a < 2; ++a) { float s = 0.f;
#pragma unroll
                    for (int rr = 0; rr < 8; ++rr) s += wq[mt][8 * a + rr] * fmaxf(acc[8 * a + rr], 0.f);
                    const int qu = 4 * mt + 2 * hh + a, key = 32 * kt + n32; unsigned bits = __builtin_bit_cast(unsigned, s);
                    bits = (bits & 0x80000000u) ? ~bits : (bits | 0x80000000u);
                    sc[qu * 4096 + key] = (key <= q0 + qu) ? bits : 0u; } }
        }
        __syncthreads();
        { const int q = q0 + w, n = q + 1; const size_t so = (size_t)(tq0 + w) * 256;
          if (n <= 256) { for (int r = lane; r < 256; r += 64) sel[so + r] = (r < n) ? (unsigned short)r : (unsigned short)0xFFFFu; }
          else {
            const int ni = (n + 63) >> 6;
            unsigned uu[64];
#pragma unroll
            for (int i = 0; i < 64; ++i) uu[i] = (i < ni && 64 * i + lane < nkt * 32) ? sc[w * 4096 + 64 * i + lane] : 0u;
            const int nact = (ni + 15) >> 4, below_const = (4 - nact) * 1024;
            LAS unsigned* slot = sc + w * 4096;
            unsigned Hp[32];
#pragma unroll
            for (int j = 0; j < 32; ++j) Hp[j] = (uu[2 * j] >> 16) | (uu[2 * j + 1] & 0xffff0000u);
#define IDX_BELOW(dst, cval) do { const unsigned cm1_ = ((cval) - 1u) * 0x00010001u; unsigned cnt_ = 0u; \
            _Pragma("unroll") for (int g4 = 0; g4 < 4; ++g4) if (g4 < nact) { _Pragma("unroll") for (int j = 8 * g4; j < 8 * g4 + 8; ++j) cnt_ = pk_below(Hp[j], cm1_, cnt_); } \
            (dst) = wave_total_dpp((int)((cnt_ & 0xffffu) + (cnt_ >> 16))) + below_const; } while (0)
            unsigned Th = 0u; int geT = 4096;
#pragma unroll 1
            for (int bit = 15; bit >= 0; --bit) { const unsigned c = Th | (1u << bit); int bl; IDX_BELOW(bl, c); if (4096 - bl >= 256) { Th = c; geT = 4096 - bl; } }
            int gtT = 0; if (Th != 0xffffu) { int bl; IDX_BELOW(bl, Th + 1u); gtT = 4096 - bl; }
            const int krem = 256 - gtT, nc = geT - gtT;
            unsigned Tv; int need; bool simple;
            if (nc <= 64) {
                int base = 0; const unsigned long long lt = (1ull << lane) - 1ull;
#pragma unroll
                for (int i = 0; i < 64; ++i) { const bool eq = (uu[i] >> 16) == Th; const unsigned long long em = __ballot(eq);
                    if (em) { if (eq) slot[base + __builtin_popcountll(em & lt)] = (uu[i] & 0xffffu) + 1u; base += __builtin_popcountll(em); } }
                asm volatile("s_waitcnt lgkmcnt(0)" ::: "memory");
                const unsigned tv = (lane < nc) ? slot[lane] : 0u;
                unsigned Tl = 0u;
#pragma unroll 1
                for (int bit = 16; bit >= 0; --bit) { const unsigned c = Tl | (1u << bit); if (__builtin_popcountll(__ballot(tv >= c)) >= krem) Tl = c; }
                need = krem - __builtin_popcountll(__ballot(tv > Tl)); simple = (need == __builtin_popcountll(__ballot(tv == Tl)));
                Tv = (Th << 16) | (Tl - 1u);
                asm volatile("s_waitcnt lgkmcnt(0)" ::: "memory");
            } else {
#pragma unroll
                for (int j = 0; j < 32; ++j) { const unsigned a = uu[2 * j], b2 = uu[2 * j + 1]; Hp[j] = (((a >> 16) == Th) ? (a & 0xffffu) : 0u) | (((b2 >> 16) == Th) ? (b2 << 16) : 0u); }
                unsigned Tl = 0u;
#pragma unroll 1
                for (int bit = 15; bit >= 0; --bit) { const unsigned c = Tl | (1u << bit); int bl; IDX_BELOW(bl, c); if (4096 - bl >= krem) Tl = c; }
                Tv = (Th << 16) | Tl; int cg = 0;
#pragma unroll
                for (int i = 0; i < 64; ++i) cg += (uu[i] > Tv) ? 1 : 0;
                need = 256 - wave_total_dpp(cg); simple = false;
            }
#undef IDX_BELOW
            if (simple) {
                int base = 0;
#pragma unroll
                for (int i = 0; i < 64; ++i) if (16 * (i >> 4) < ni) { const bool take = uu[i] >= Tv; const unsigned long long tm = __ballot(take);
                    const int pos = base + (int)__builtin_amdgcn_mbcnt_hi((unsigned)(tm >> 32), __builtin_amdgcn_mbcnt_lo((unsigned)tm, 0u));
                    if (take) sel[so + pos] = (unsigned short)(64 * i + lane);
                    base += __builtin_popcountll(tm); }
            } else {
                int base = 0, eqs = 0; const unsigned long long lt = (1ull << lane) - 1ull;
#pragma unroll
                for (int i = 0; i < 64; ++i) if (16 * (i >> 4) < ni) { const bool gt = uu[i] > Tv, eq = uu[i] == Tv; const unsigned long long em = __ballot(eq);
                    const bool take = gt || (eq && (eqs + __builtin_popcountll(em & lt)) < need); const unsigned long long tm = __ballot(take);
                    if (take) sel[so + base + __builtin_popcountll(tm & lt)] = (unsigned short)(64 * i + lane);
                    base += __builtin_popcountll(tm); eqs += __builtin_popcountll(em); }
            }
          } }
    }
}
__device__ __forceinline__ void ph_att(const Ctx& C) {
    const bf16_t* qabs = WSP(bf16_t, WS_QABS); const bf16_t* ckv = WSP(bf16_t, WS_CKV); const unsigned short* sel = WSP(unsigned short, WS_SEL); bf16_t* olat = WSP(bf16_t, WS_OLAT);
    const int lane = C.lane, g = lane >> 4, fr = lane & 15;
    LAS unsigned char* ch = C.lds + C.wave * (32 * TLD + 512);
    LAS unsigned short* ssel = (LAS unsigned short*)(ch + 32 * TLD);
    for (int tq = C.gw; tq < T; tq += C.NGW) {
        const int b = tq >> 12, q = tq & (SEQ - 1), nv = (q + 1) < 256 ? (q + 1) : 256, nch = (nv + 31) >> 5;
        const bf16_t* cb = ckv + (size_t)b * SEQ * 256;
        { u32x2 sv = *(const u32x2*)(sel + (size_t)tq * 256 + 4 * lane);
          unsigned s0 = sv.x & 0xffffu, s1 = sv.x >> 16, s2_ = sv.y & 0xffffu, s3 = sv.y >> 16;
          if (4 * lane + 0 >= nv) s0 = 0; if (4 * lane + 1 >= nv) s1 = 0; if (4 * lane + 2 >= nv) s2_ = 0; if (4 * lane + 3 >= nv) s3 = 0;
          *(LAS u32x2*)(ssel + 4 * lane) = (u32x2){s0 | (s1 << 16), s2_ | (s3 << 16)}; }
        bf16x8 Bqa[8];
        { const bf16_t* qp = qabs + (size_t)tq * 2048 + (fr & 7) * 256 + 8 * g;
#pragma unroll
          for (int ks = 0; ks < 8; ++ks) { u32x4 v = *(const u32x4*)(qp + 32 * ks); if (fr >= 8) v = (u32x4){0u, 0u, 0u, 0u}; Bqa[ks] = as_bf16x8(v); } }
        f32x4 acc[16];
#pragma unroll
        for (int nt = 0; nt < 16; ++nt) acc[nt] = (f32x4){0.f, 0.f, 0.f, 0.f};
        float mrun = -INFINITY, lrun = 0.f;
        asm volatile("s_waitcnt lgkmcnt(0)" ::: "memory");
        u32x4 G[16];
#pragma unroll
        for (int p = 0; p < 16; ++p) { const int s = ssel[2 * p + (lane >> 5)]; G[p] = *(const u32x4*)(cb + (size_t)s * 256 + (lane & 31) * 8); }
#pragma unroll 1
        for (int t = 0; t < nch; ++t) {
#pragma unroll
            for (int p = 0; p < 16; ++p) *(LAS u32x4*)(ch + (2 * p + (lane >> 5)) * TLD + (lane & 31) * 16) = G[p];
            if (t + 1 < nch) {
#pragma unroll
                for (int p = 0; p < 16; ++p) { const int s = ssel[32 * (t + 1) + 2 * p + (lane >> 5)]; G[p] = *(const u32x4*)(cb + (size_t)s * 256 + (lane & 31) * 8); } }
            asm volatile("s_waitcnt lgkmcnt(0)" ::: "memory");
            f32x4 s2[2];
#pragma unroll
            for (int hf = 0; hf < 2; ++hf) { s2[hf] = (f32x4){0.f, 0.f, 0.f, 0.f};
#pragma unroll
                for (int ks = 0; ks < 8; ++ks) { const bf16x8 Ac = as_bf16x8(*(const LAS u32x4*)(ch + (16 * hf + fr) * TLD + (32 * ks + 8 * g) * 2)); s2[hf] = __builtin_amdgcn_mfma_f32_16x16x32_bf16(Ac, Bqa[ks], s2[hf], 0, 0, 0); } }
            float cm = -INFINITY;
#pragma unroll
            for (int hf = 0; hf < 2; ++hf)
#pragma unroll
                for (int r = 0; r < 4; ++r) { const int ki = 32 * t + 16 * hf + 4 * g + r; if (ki >= nv) s2[hf][r] = -INFINITY; cm = fmaxf(cm, s2[hf][r]); }
            cm = fmaxf(cm, shx(cm, 16, lane)); cm = fmaxf(cm, shx(cm, 32, lane));
            const float mnew = fmaxf(mrun, cm), scale = __expf(mrun - mnew); float ps = 0.f;
#pragma unroll
            for (int hf = 0; hf < 2; ++hf)
#pragma unroll
                for (int r = 0; r < 4; ++r) { s2[hf][r] = __expf(s2[hf][r] - mnew); ps += s2[hf][r]; }
            ps += shx(ps, 16, lane); ps += shx(ps, 32, lane);
            lrun = lrun * scale + ps; mrun = mnew;
            u32x4 pw; pw.x = cvt_pk_bf16(s2[0][0], s2[0][1]); pw.y = cvt_pk_bf16(s2[0][2], s2[0][3]); pw.z = cvt_pk_bf16(s2[1][0], s2[1][1]); pw.w = cvt_pk_bf16(s2[1][2], s2[1][3]);
            const bf16x8 Bp = as_bf16x8(pw);
#pragma unroll
            for (int nt = 0; nt < 16; ++nt) { const bf16x8 Av = tr_frag(ch, TLD, 4 * g, 16 + 4 * g, 16 * nt, lane); acc[nt] = __builtin_amdgcn_mfma_f32_16x16x32_bf16(Av, Bp, acc[nt] * scale, 0, 0, 0); }
            asm volatile("s_waitcnt lgkmcnt(0)" ::: "memory");
        }
        const float inv = 1.0f / lrun;
        if (fr < 8) { bf16_t* op = olat + (size_t)tq * 2048 + fr * 256 + 4 * g;
#pragma unroll
            for (int nt = 0; nt < 16; ++nt) { u32x2 o; o.x = cvt_pk_bf16(acc[nt][0] * inv, acc[nt][1] * inv); o.y = cvt_pk_bf16(acc[nt][2] * inv, acc[nt][3] * inv); *(u32x2*)(op + 16 * nt) = o; } }
    }
}

__device__ __forceinline__ void ph_norm_hilo(const Ctx& C, const float* x, const float* g, bf16_t* H, bf16_t* HLO) {
    for (int row = C.gw; row < T; row += C.NGW) {
        const f32x4* xr = (const f32x4*)(x + (size_t)row * DM) + C.lane; f32x4 v[8]; float ss = 0.f;
#pragma unroll
        for (int j = 0; j < 8; ++j) { v[j] = xr[64 * j]; ss += v[j][0] * v[j][0] + v[j][1] * v[j][1] + v[j][2] * v[j][2] + v[j][3] * v[j][3]; }
        const float rstd = rsqrtf(wave_sum(ss, C.lane) * (1.f / DM) + EPS);
        u32x2* oh = (u32x2*)(H + (size_t)row * DM) + C.lane; u32x2* ol = (u32x2*)(HLO + (size_t)row * DM) + C.lane;
#pragma unroll
        for (int j = 0; j < 8; ++j) { const f32x4 gg = ((const f32x4*)g)[64 * j + C.lane]; const f32x4 y = v[j] * rstd * gg; u32x2 wh; wh.x = cvt_pk_bf16(y[0], y[1]); wh.y = cvt_pk_bf16(y[2], y[3]);
            u32x2 wl; wl.x = cvt_pk_bf16(y[0] - bf2f(wh.x), y[1] - bf2f(wh.x >> 16)); wl.y = cvt_pk_bf16(y[2] - bf2f(wh.y), y[3] - bf2f(wh.y >> 16)); oh[64 * j] = wh; ol[64 * j] = wl; }
    }
}
__device__ __forceinline__ void ph_route(const Ctx& C, int l) {
    const float* LOG = WSP(float, WS_OLAT); const float* bg = C.in[I_BGRP] + l * 4; const float* be = C.in[I_BEXP] + l * 32;
    int* rinfo = WSP(int, WS_ROUTE); float* rw = (float*)(rinfo + T * 4); unsigned* cnt = C.ctl + CW_CNT + l * 64;
    for (int t = C.bid * 512 + C.tid; t < T; t += C.G * 512) {
        float lg[36];
#pragma unroll
        for (int c = 0; c < 36; ++c) lg[c] = 0.f;
#pragma unroll
        for (int part = 0; part < 4; ++part) { const f32x4* p = (const f32x4*)(LOG + ((size_t)part * T + t) * 128);
#pragma unroll
            for (int c4 = 0; c4 < 9; ++c4) { const f32x4 a = p[c4];
#pragma unroll
                for (int j = 0; j < 4; ++j) lg[4 * c4 + j] += a[j];
                if (part < 2) { const f32x4 b2 = p[16 + c4];
#pragma unroll
                    for (int j = 0; j < 4; ++j) lg[4 * c4 + j] += b2[j]; } } }
        int gsel = 0; float gmax = -INFINITY, gv4[4];
#pragma unroll
        for (int k = 0; k < 4; ++k) { gv4[k] = lg[k] + bg[k]; if (gv4[k] > gmax) { gmax = gv4[k]; gsel = k; } }
        float gden = 0.f;
#pragma unroll
        for (int k = 0; k < 4; ++k) gden += __expf(gv4[k] - gmax);
        const float pg = 1.f / gden;
        float el[8], emax = -INFINITY;
#pragma unroll
        for (int k = 0; k < 8; ++k) { const float v0 = lg[4 + k] + be[k], v1 = lg[12 + k] + be[8 + k], v2 = lg[20 + k] + be[16 + k], v3 = lg[28 + k] + be[24 + k];
            el[k] = gsel == 0 ? v0 : (gsel == 1 ? v1 : (gsel == 2 ? v2 : v3)); emax = fmaxf(emax, el[k]); }
        float eden = 0.f, ep[8];
#pragma unroll
        for (int k = 0; k < 8; ++k) { ep[k] = __expf(el[k] - emax); eden += ep[k]; }
        int i0 = 0; float p0 = -1.f;
#pragma unroll
        for (int k = 0; k < 8; ++k) { ep[k] = ep[k] / eden; if (ep[k] > p0) { p0 = ep[k]; i0 = k; } }
        int i1 = 0; float p1 = -1.f;
#pragma unroll
        for (int k = 0; k < 8; ++k) if (k != i0 && ep[k] > p1) { p1 = ep[k]; i1 = k; }
        const float den = p0 + p1; const int e0 = gsel * 8 + i0, e1 = gsel * 8 + i1;
        const unsigned r0 = atomicAdd(&cnt[e0], 1u), r1 = atomicAdd(&cnt[e1], 1u);
        *(int4*)(rinfo + (size_t)t * 4) = make_int4(e0, e1, (int)r0, (int)r1); *(f32x2*)(rw + (size_t)t * 2) = (f32x2){pg * (p0 / den), pg * (p1 / den)};
    }
}
__device__ __forceinline__ int moe_offsets(const unsigned* cnt, int lane, int& total_tiles) {
    const int c = lane < NEXP ? (int)__hip_atomic_load(cnt + lane, __ATOMIC_RELAXED, __HIP_MEMORY_SCOPE_AGENT) : 0; const int tiles = (c + 255) >> 8;
    int incl = tiles;
#pragma unroll
    for (int o = 1; o < 64; o <<= 1) { const int t = shi(incl, (lane - o) & 63); if (lane >= o) incl += t; }
    total_tiles = shi(incl, 63);
    return (incl - tiles) * 256;
}
__device__ __forceinline__ void ph_permute(const Ctx& C, int l) {
    const bf16_t* H = WSP(bf16_t, WS_H); bf16_t* hperm = WSP(bf16_t, WS_PROJ + M_HPERM); int* rinfo = WSP(int, WS_ROUTE); int* rpos = rinfo + T * 6;
    int tt; const int myoff = moe_offsets(C.ctl + CW_CNT + l * 64 + CNT_BANK, C.lane, tt);
    for (int row = C.gw; row < T; row += C.NGW) {
        const int4 ri = *(const int4*)(rinfo + (size_t)row * 4);
        const int p0 = shi(myoff, ri.x) + ri.z, p1 = shi(myoff, ri.y) + ri.w;
        const u32x4* src = (const u32x4*)(H + (size_t)row * DM) + C.lane; u32x4* d0 = (u32x4*)(hperm + (size_t)p0 * DM) + C.lane; u32x4* d1 = (u32x4*)(hperm + (size_t)p1 * DM) + C.lane;
#pragma unroll
        for (int j = 0; j < 4; ++j) { const u32x4 w = src[64 * j]; d0[64 * j] = w; d1[64 * j] = w; }
        if (C.lane == 0) { rpos[(size_t)row * 2] = p0; rpos[(size_t)row * 2 + 1] = p1; }
    }
}
__device__ __forceinline__ int moe_table(const Ctx& C, int l) {
    __syncthreads();
    if (C.wave == 0) { int tt; const int off = moe_offsets(C.ctl + CW_CNT + l * 64 + CNT_BANK, C.lane, tt); const int nxt = shi(off, (C.lane + 1) & 63);
        if (C.lane < NEXP) { const int t0 = off >> 8, t1 = (C.lane == NEXP - 1) ? tt : (nxt >> 8); for (int t = t0; t < t1; ++t) C.misc[16 + t] = C.lane; }
        if (C.lane == 0) C.misc[200] = tt; }
    __syncthreads();
    return C.misc[200];
}
__device__ __forceinline__ void ph_combine(const Ctx& C, float* x, bool last, const float* gnext, bf16_t* Hn) {
    const bf16_t* yc = WSP(bf16_t, WS_PROJ + M_YC); const int* rinfo = WSP(int, WS_ROUTE); const float* rw = (const float*)(rinfo + T * 4); const int* rpos = rinfo + T * 6; const float* gf = C.in[I_FNG];
    for (int row = C.gw; row < T; row += C.NGW) {
        const int p0 = rpos[(size_t)row * 2], p1 = rpos[(size_t)row * 2 + 1]; const float w0 = rw[(size_t)row * 2], w1 = rw[(size_t)row * 2 + 1];
        f32x4* xr = (f32x4*)(x + (size_t)row * DM) + C.lane; const u32x2* y0 = (const u32x2*)(yc + (size_t)p0 * DM) + C.lane; const u32x2* y1 = (const u32x2*)(yc + (size_t)p1 * DM) + C.lane;
        f32x4 v[8]; float ss = 0.f;
#pragma unroll
        for (int j = 0; j < 8; ++j) { const u32x2 a = y0[64 * j], b = y1[64 * j]; f32x4 xv = xr[64 * j];
            xv[0] += w0 * bf2f(a.x) + w1 * bf2f(b.x); xv[1] += w0 * bf2f(a.x >> 16) + w1 * bf2f(b.x >> 16); xv[2] += w0 * bf2f(a.y) + w1 * bf2f(b.y); xv[3] += w0 * bf2f(a.y >> 16) + w1 * bf2f(b.y >> 16);
            v[j] = xv; ss += xv[0] * xv[0] + xv[1] * xv[1] + xv[2] * xv[2] + xv[3] * xv[3]; }
        if (last) { const float rstd = rsqrtf(wave_sum(ss, C.lane) * (1.f / DM) + EPS);
#pragma unroll
            for (int j = 0; j < 8; ++j) xr[64 * j] = v[j] * rstd * ((const f32x4*)gf)[64 * j + C.lane]; }
        else { const float rstd = rsqrtf(wave_sum(ss, C.lane) * (1.f / DM) + EPS); u32x2* o = (u32x2*)(Hn + (size_t)row * DM) + C.lane;
#pragma unroll
            for (int j = 0; j < 8; ++j) { xr[64 * j] = v[j]; const f32x4 y = v[j] * rstd * ((const f32x4*)gnext)[64 * j + C.lane]; u32x2 w; w.x = cvt_pk_bf16(y[0], y[1]); w.y = cvt_pk_bf16(y[2], y[3]); o[64 * j] = w; } }
    }
}

constexpr int NPL = 14, NPHASES = 1 + DEPTH * NPL;
#if MK_PER_PHASE
#define IN(k) (lo <= (k) && (k) < hi)
#else
#define IN(k) true
#endif
#if MK_PER_PHASE
#define SEAM(k) do { } while (0)
#else
#define SEAM(k) xcd_barrier(bar)
#endif
template <int l> __device__ __forceinline__ void run_layer(Ctx& C, const XcdBarrier& bar, const int lo, const int hi) {
    unsigned char* wb = (unsigned char*)(C.ws + WS_W);
    bf16_t* H = WSP(bf16_t, WS_H);
        const int pb = 1 + l * NPL;
        const float* xin = (l == 0) ? C.in[I_X] : (const float*)C.out;
        if (l == 0) { if (IN(pb + 0)) { refresh(C); ph_rope(C); refresh(C); REP(1) ph_weights(C, 0); REP(2) ph_norm(C, xin, C.in[I_NMIX], H); }
            SEAM(pb + 0); }
        if (IN(pb + 1)) { refresh(C);
            pg8::Gemm g{H, (const bf16_t*)(wb + W_IN), DM, DM, DM}; pg8::OrderMN S; S.init(T / 256, NP / 256, C.G, C.bid, 256L * DM * 2, 256L * DM * 2);
            pg8::EpiInProj E{(unsigned char*)C.ws};
            REP(3) pg8::gemm_phase(C.lds, g, S, E);
        }
        SEAM(pb + 1);
        if (IN(pb + 2)) { refresh(C);
            ph_ckv(C, WSP(float, WS_PROJ + P_DC), C.in[I_KVG] + l * 256, WSP(bf16_t, WS_CKV));
            { pg8::Gemm g{WSP(bf16_t, WS_PROJ + P_DQ), (const bf16_t*)(wb + W_UK), 1024, 256, 256}; pg8::OrderMN S; S.init(T / 256, 8, C.G, C.bid, 256L * 1024 * 2, 256L * 256 * 2, 1, 256L * 2);
              pg8::EpiStore<0> E{WSP(bf16_t, WS_QABS), 2048, 0.08838834764831845f}; REP(4) pg8::gemm_phase(C.lds, g, S, E); }
            refresh(C);
#if NAIVE_GMLP
            ph_gmlp_naive(C, l);
#else
            REP(5) ph_gmlp(C, l);
#endif
            refresh(C);
#if !NAIVE_RET
            REP(6) ph_ret_kv(C);
#endif
            refresh(C);
#if NAIVE_IDX
            ph_idx_naive(C);
#else
            REP(7) ph_idx(C);
#endif
        }
        SEAM(pb + 2);
        if (IN(pb + 3)) { refresh(C);
#if !NAIVE_RET
            REP(8) ph_ret_scan(C);
#endif
#if NAIVE_ATT
            ph_att_naive(C);
#else
            REP(9) ph_att(C);
#endif
        }
        SEAM(pb + 3);
        if (IN(pb + 4)) { refresh(C);
            { pg8::Gemm g{WSP(bf16_t, WS_OLAT), (const bf16_t*)(wb + W_UV), 2048, 512, 512}; pg8::OrderMN S; S.init(T / 256, 4, C.G, C.bid, 256L * 2048 * 2, 256L * 512 * 2, 0, 512L * 2);
              pg8::EpiStore<0> E{WSP(bf16_t, WS_DS), 1024, 1.0f}; REP(10) pg8::gemm_phase(C.lds, g, S, E); }
#if NAIVE_RET
            ph_ret_naive(C);
#else
            REP(11) ph_ret_out(C);
#endif
        }
        SEAM(pb + 4);
        if (IN(pb + 5)) { refresh(C);
            REP(12)
#pragma unroll 1
            for (int br = 0; br < 3; ++br) {
                const bf16_t* A = br == 0 ? WSP(bf16_t, WS_RET) : (br == 1 ? WSP(bf16_t, WS_GM) : WSP(bf16_t, WS_DS));
                const bf16_t* Bt = (const bf16_t*)(wb + (br == 0 ? W_RET : (br == 1 ? W_GM : W_DS)));
                const bf16_t* gate = WSP(bf16_t, WS_PROJ + (br == 0 ? P_GA : (br == 1 ? P_GB : P_GC)));
                pg8::Gemm g{A, Bt, 1024, 1024, 1024}; pg8::OrderMN S; S.init(T / 256, 8, C.G, C.bid, 256L * 1024 * 2, 256L * 1024 * 2);
                pg8::EpiBranch E{gate, H, br == 0 ? 1 : 0}; pg8::gemm_phase(C.lds, g, S, E);
            }
        }
        SEAM(pb + 5);
        if (IN(pb + 6)) { refresh(C);
            pg8::Gemm g{H, (const bf16_t*)(wb + W_OUT), DM, DM, DM}; pg8::OrderMN S; S.init(T / 256, 8, C.G, C.bid, 256L * DM * 2, 256L * DM * 2);
            pg8::EpiResid E{xin, C.out}; for (int rep_ = 0; rep_ <= ((l == 0) ? ((PROBE_MASK >> 17) & 1) : 0); ++rep_) pg8::gemm_phase(C.lds, g, S, E);
        }
        SEAM(pb + 6);
        if (IN(pb + 7)) { refresh(C); ph_norm_hilo(C, C.out, C.in[I_NFFN] + l * DM, H, WSP(bf16_t, WS_QABS)); }
        SEAM(pb + 7);
        if (IN(pb + 8)) { refresh(C);
            pg8::Gemm g{H, (const bf16_t*)(wb + W_RT), DM, DM, 1024}; pg8::OrderRouter S{C.G, C.bid, (long)(WS_QABS - WS_H)};
            pg8::EpiRouter E{WSP(float, WS_OLAT)}; pg8::gemm_phase(C.lds, g, S, E);
        }
        SEAM(pb + 8);
        if (IN(pb + 9)) { refresh(C); ph_route(C, l); }
        SEAM(pb + 9);
        if (IN(pb + 10)) { refresh(C); REP(13) ph_permute(C, l); }
        SEAM(pb + 10);
        if (IN(pb + 11)) { refresh(C);
            const int Mt = moe_table(C, l);
            pg8::Gemm g{WSP(bf16_t, WS_PROJ + M_HPERM), (const bf16_t*)(wb + W_13), DM, DM, DM};
            pg8::OrderMoE S{C.misc + 16, Mt, 4, C.G, C.bid, 256L * DM * 2, 256L * DM * 2, 1024L * DM * 2};
            pg8::EpiMoeUp E{WSP(bf16_t, WS_PROJ + M_HID)}; REP(14) pg8::gemm_phase(C.lds, g, S, E);
        }
        SEAM(pb + 11);
        if (IN(pb + 12)) { refresh(C);
            const int Mt = moe_table(C, l);
            pg8::Gemm g{WSP(bf16_t, WS_PROJ + M_HID), (const bf16_t*)(wb + W_2), FF, FF, FF};
            pg8::OrderMoE S{C.misc + 16, Mt, 8, C.G, C.bid, 256L * FF * 2, 256L * FF * 2, (long)DM * FF * 2};
            pg8::EpiStore<0> E{WSP(bf16_t, WS_PROJ + M_YC), DM, 1.0f}; REP(15) pg8::gemm_phase(C.lds, g, S, E);
        }
        SEAM(pb + 12);
        if (IN(pb + 13)) { refresh(C); ph_combine(C, C.out, l == DEPTH - 1, C.in[I_NMIX] + (l + 1 < DEPTH ? l + 1 : l) * DM, H); if (l + 1 < DEPTH) { refresh(C); ph_weights(C, l + 1); } }
        if (l + 1 < DEPTH) SEAM(pb + 13);

}
__global__ void __launch_bounds__(512, 2) mk_fwd(Args a) {
    extern __shared__ __attribute__((aligned(16))) unsigned char lds_raw[];
    Ctx C;
    C.lds = (LAS unsigned char*)lds_raw; C.misc = (volatile LAS int*)(C.lds + MISC_OFF); C.ws = (GAS unsigned char*)a.ws; C.ctl = (unsigned*)(a.ws + WS_CTL);
    C.tid = threadIdx.x; C.lane = C.tid & 63; C.wave = __builtin_amdgcn_readfirstlane(C.tid >> 6); C.G = gridDim.x; C.bid = blockIdx.x;
    C.gw = C.bid * 8 + C.wave; C.NGW = C.G * 8; C.in = a.in; C.out = a.out;
    for (int i = C.tid; i < 256; i += 512) C.misc[i] = 0;
    __syncthreads();
#if MK_PER_PHASE
    XcdBarrier bar; bar.bar = C.ctl + CW_BAR; bar.x = 0; bar.st = (volatile LAS unsigned*)C.misc;
#else
    XcdBarrier bar = xcd_barrier_post(C.ctl + CW_BAR, (volatile LAS unsigned*)C.misc);
#endif
    const int lo = a.ph_lo, hi = a.ph_hi;
    run_layer<0>(C, bar, lo, hi);
    run_layer<1>(C, bar, lo, hi);
}

extern "C" void kernel_launch(void* const* d_in, const int* in_sizes, int n_in, void* d_out, int out_size, void* d_ws, size_t ws_size, hipStream_t stream) {
    static int grid = 0;
    if (grid == 0) {
        if (n_in != 23 || out_size != T * DM || ws_size < WS_END) { fprintf(stderr, "kernel_launch: unexpected shapes / workspace (n_in %d out %d ws %zu need %zu)\n", n_in, out_size, ws_size, (size_t)WS_END); grid = -1; return; }
        int dev = 0, cus = 0, per_cu = 0;
        if (hipGetDevice(&dev) != hipSuccess || hipDeviceGetAttribute(&cus, hipDeviceAttributeMultiprocessorCount, dev) != hipSuccess) { grid = -1; return; }
        if (hipFuncSetAttribute((const void*)mk_fwd, hipFuncAttributeMaxDynamicSharedMemorySize, LDS_BYTES) != hipSuccess) { fprintf(stderr, "kernel_launch: hipFuncSetAttribute failed\n"); grid = -1; return; }
        if (hipOccupancyMaxActiveBlocksPerMultiprocessor(&per_cu, (const void*)mk_fwd, 512, LDS_BYTES) != hipSuccess || per_cu < 1) { fprintf(stderr, "kernel_launch: occupancy query says %d\n", per_cu); (void)hipGetLastError(); grid = -1; return; }
        grid = cus;
    }
    if (grid < 0) return;
    (void)hipMemsetAsync((char*)d_ws + WS_CTL, 0, CTL_BYTES, stream);
    Args a{};
    for (int i = 0; i < 23; ++i) a.in[i] = (const float*)d_in[i];
    a.out = (float*)d_out; a.ws = (unsigned char*)d_ws;
#if MK_PER_PHASE
    for (int p = 0; p < NPHASES; ++p) { a.ph_lo = p; a.ph_hi = p + 1; hipLaunchKernelGGL(mk_fwd, dim3(grid), dim3(512), LDS_BYTES, stream, a); }
#else
    a.ph_lo = 0; a.ph_hi = NPHASES;
    hipLaunchKernelGGL(mk_fwd, dim3(grid), dim3(512), LDS_BYTES, stream, a);
#endif
}
```

```cpp
#include <hip/hip_runtime.h>
#include <stdint.h>
#include <stdio.h>

#ifndef MK_PER_PHASE
#define MK_PER_PHASE 0
#endif
#ifndef PROBE_MASK
#define PROBE_MASK 0
#endif
#define CNT_BANK (((PROBE_MASK >> 16) & 1) * 128)
#define REP(k) for (int rep_ = 0; rep_ <= ((PROBE_MASK >> (k)) & 1); ++rep_)
#ifndef NAIVE_RET
#define NAIVE_RET 0
#endif
#ifndef NAIVE_GMLP
#define NAIVE_GMLP 0
#endif
#ifndef NAIVE_IDX
#define NAIVE_IDX 0
#endif
#ifndef NAIVE_ATT
#define NAIVE_ATT 0
#endif

#define LAS __attribute__((address_space(3)))
#define GAS __attribute__((address_space(1)))
typedef unsigned short bf16_t;
typedef short bf16x8 __attribute__((ext_vector_type(8)));
typedef short s16x4 __attribute__((ext_vector_type(4)));
typedef float f32x4 __attribute__((ext_vector_type(4)));
typedef float f32x2 __attribute__((ext_vector_type(2)));
typedef float f32x16 __attribute__((ext_vector_type(16)));
typedef unsigned u32x4 __attribute__((ext_vector_type(4)));
typedef unsigned u32x2 __attribute__((ext_vector_type(2)));

constexpr int DM = 2048, NB = 4, SEQ = 4096, T = NB * SEQ, DEPTH = 2;
constexpr int INW = 14152, NP = 14336;
constexpr int GATE_SRC0 = 8008, GATE_DST0 = 8192;
constexpr int NEXP = 32, FF = 512, MOE_ROWS = 40960;
constexpr float EPS = 1e-6f;

constexpr size_t MiB = 1u << 20;
constexpr size_t WS_CTL = 0, CTL_BYTES = 1 * MiB;
constexpr size_t WS_ROPE = 1 * MiB;
constexpr size_t WS_W = 5 * MiB;
constexpr size_t W_IN = 0, W_RET = 56 * MiB, W_GM = 60 * MiB, W_DS = 64 * MiB, W_OUT = 68 * MiB, W_13 = 76 * MiB, W_2 = 204 * MiB, W_UK = 268 * MiB, W_UV = 269 * MiB, W_RT = 270 * MiB  , W_END = 271 * MiB;
constexpr size_t WS_H = WS_W + W_END;
constexpr size_t WS_PROJ = WS_H + 64 * MiB;
constexpr size_t P_RQ = 0, P_RK = 32 * MiB, P_RV = 64 * MiB, P_RG = 96 * MiB, P_GU = 128 * MiB, P_GV = 160 * MiB, P_DQ = 192 * MiB, P_DC = 224 * MiB  ,
                 P_IQ = 240 * MiB  , P_IK = 256 * MiB  , P_IW = 258 * MiB  , P_GA = 260 * MiB, P_GB = 324 * MiB, P_GC = 388 * MiB, P_END = 452 * MiB;
constexpr size_t M_HPERM = 0, M_HID = 160 * MiB, M_YC = 200 * MiB;
constexpr size_t WS_KV = WS_PROJ + P_END;
constexpr size_t WS_R = WS_KV + 64 * MiB;
constexpr size_t WS_QABS = WS_R + 64 * MiB;
constexpr size_t WS_OLAT = WS_QABS + 64 * MiB;
constexpr size_t WS_RET = WS_OLAT + 64 * MiB;
constexpr size_t WS_GM = WS_RET + 32 * MiB, WS_DS = WS_GM + 32 * MiB;
constexpr size_t WS_SEL = WS_DS + 32 * MiB;
constexpr size_t WS_CKV = WS_SEL + 8 * MiB;
constexpr size_t WS_STATS = WS_CKV + 8 * MiB;
constexpr size_t WS_ROUTE = WS_STATS + 2 * MiB;
constexpr size_t WS_LIST = WS_ROUTE + 1 * MiB;
constexpr size_t WS_END = WS_LIST + 2 * MiB;
constexpr int CW_BAR = 4096, CW_CNT = 16384;

constexpr int LDS_BYTES = 147456, MISC_OFF = LDS_BYTES - 4096;

__device__ __forceinline__ unsigned f2bf(float f) { unsigned u = __builtin_bit_cast(unsigned, f); return (u + 0x7fffu + ((u >> 16) & 1u)) >> 16; }
__device__ __forceinline__ float bf2f(unsigned b) { return __builtin_bit_cast(float, (b & 0xffffu) << 16); }
typedef __bf16 bf16x2_t __attribute__((ext_vector_type(2)));
__device__ __forceinline__ unsigned cvt_pk_bf16(float lo, float hi) { const f32x2 v = {lo, hi}; return __builtin_bit_cast(unsigned, __builtin_convertvector(v, bf16x2_t)); }
__device__ __forceinline__ float shx(float v, int k, int lane) { return __builtin_bit_cast(float, __builtin_amdgcn_ds_bpermute((lane ^ k) << 2, __builtin_bit_cast(int, v))); }
__device__ __forceinline__ void swap32_(float& a, float& b) { asm volatile("v_nop\n\tv_nop\n\tv_permlane32_swap_b32 %0, %1\n\tv_nop" : "+v"(a), "+v"(b)); }
__device__ __forceinline__ void swap16_(float& a, float& b) { asm volatile("v_nop\n\tv_nop\n\tv_permlane16_swap_b32 %0, %1\n\tv_nop" : "+v"(a), "+v"(b)); }
__device__ __forceinline__ float quad_sum(float v) { float a = v, b = v; swap32_(a, b); v = a + b; a = v; b = v; swap16_(a, b); return a + b; }
__device__ __forceinline__ float quad_max(float v) { float a = v, b = v; swap32_(a, b); v = fmaxf(a, b); a = v; b = v; swap16_(a, b); return fmaxf(a, b); }
__device__ __forceinline__ int shi(int v, int src) { return __builtin_amdgcn_ds_bpermute(src << 2, v); }
typedef unsigned short u16x2 __attribute__((ext_vector_type(2)));
__device__ __forceinline__ unsigned pk_below(unsigned x, unsigned cm1, unsigned cnt) {
    u16x2 r = __builtin_elementwise_sub_sat(__builtin_bit_cast(u16x2, x), __builtin_bit_cast(u16x2, cm1)); unsigned ru = __builtin_bit_cast(unsigned, r); asm volatile("" : "+v"(ru));
    r = __builtin_elementwise_sub_sat((u16x2){1, 1}, __builtin_bit_cast(u16x2, ru)); ru = __builtin_bit_cast(unsigned, r); asm volatile("" : "+v"(ru));
    return __builtin_bit_cast(unsigned, (u16x2)(__builtin_bit_cast(u16x2, cnt) + __builtin_bit_cast(u16x2, ru)));
}
__device__ __forceinline__ int wave_total_dpp(int x) {
    x += __builtin_amdgcn_update_dpp(0, x, 0x111, 0xf, 0xf, false);
    x += __builtin_amdgcn_update_dpp(0, x, 0x112, 0xf, 0xf, false);
    x += __builtin_amdgcn_update_dpp(0, x, 0x114, 0xf, 0xf, false);
    x += __builtin_amdgcn_update_dpp(0, x, 0x118, 0xf, 0xf, false);
    x += __builtin_amdgcn_update_dpp(0, x, 0x142, 0xa, 0xf, false);
    x += __builtin_amdgcn_update_dpp(0, x, 0x143, 0xc, 0xf, false);
    return __builtin_amdgcn_readlane(x, 63);
}
__device__ __forceinline__ float wave_sum(float v, int lane) {
#pragma unroll
    for (int o = 1; o < 64; o <<= 1) v += shx(v, o, lane);
    return v;
}
__device__ __forceinline__ float wave_max(float v, int lane) {
#pragma unroll
    for (int o = 1; o < 64; o <<= 1) v = fmaxf(v, shx(v, o, lane));
    return v;
}
__device__ __forceinline__ float sigmoidf_(float x) { return __builtin_amdgcn_rcpf(1.0f + __builtin_amdgcn_exp2f(x * -1.44269504089f)); }
__device__ __forceinline__ float siluf_(float x) { return x * sigmoidf_(x); }
__device__ __forceinline__ f32x2 gelu_pk(f32x2 v) {
    const f32x2 av = __builtin_elementwise_abs(v), d = av * 0.2316418882f + 1.0f;
    f32x2 t; t.x = __builtin_amdgcn_rcpf(d.x); t.y = __builtin_amdgcn_rcpf(d.y);
    f32x2 q = t * 0.5307027145f + (-0.7265760135f); q = q * t + 0.7107068705f; q = q * t + (-0.142248368f); q = q * t + 0.127414796f; q = q * t;
    const f32x2 s = (v * v) * (-0.72134752044f);
    f32x2 e; e.x = __builtin_amdgcn_exp2f(s.x); e.y = __builtin_amdgcn_exp2f(s.y);
    const f32x2 m = v * (q * e), r = v - m;
    f32x2 o; o.x = v.x < 0.f ? m.x : r.x; o.y = v.y < 0.f ? m.y : r.y; return o;
}
template <int ACT> __device__ __forceinline__ f32x4 act4(f32x4 v) {
    if (ACT == 1) { f32x2 a = gelu_pk((f32x2){v[0], v[1]}), b = gelu_pk((f32x2){v[2], v[3]}); return (f32x4){a.x, a.y, b.x, b.y}; }
    if (ACT == 2) return (f32x4){siluf_(v[0]), siluf_(v[1]), siluf_(v[2]), siluf_(v[3])};
    if (ACT == 3) return (f32x4){sigmoidf_(v[0]), sigmoidf_(v[1]), sigmoidf_(v[2]), sigmoidf_(v[3])};
    return v;
}
__device__ __forceinline__ u32x4 pack8(f32x4 a, f32x4 b) { u32x4 w; w.x = cvt_pk_bf16(a[0], a[1]); w.y = cvt_pk_bf16(a[2], a[3]); w.z = cvt_pk_bf16(b[0], b[1]); w.w = cvt_pk_bf16(b[2], b[3]); return w; }
__device__ __forceinline__ void unpack8(u32x4 w, float (&f)[8]) {
    f[0] = bf2f(w.x); f[1] = bf2f(w.x >> 16); f[2] = bf2f(w.y); f[3] = bf2f(w.y >> 16); f[4] = bf2f(w.z); f[5] = bf2f(w.z >> 16); f[6] = bf2f(w.w); f[7] = bf2f(w.w >> 16);
}

#define XB_TMO      128
#define XB_XCNT(j)  (256  + 64 * (j))
#define XB_XSUB(j)  (1280 + 64 * (j))
#define XB_XGEN(j)  (2304 + 64 * (j))
#define XB_TOP      3328
#define XB_TOPGEN   3392
#define XCD_BAR_WORDS 3456
#define XB_SPIN_CAP (1u << 20)
__device__ __forceinline__ unsigned xb_ld(unsigned* p)              { return __hip_atomic_load(p, __ATOMIC_RELAXED, __HIP_MEMORY_SCOPE_AGENT); }
__device__ __forceinline__ unsigned xb_add(unsigned* p, unsigned v) { return __hip_atomic_fetch_add(p, v, __ATOMIC_RELAXED, __HIP_MEMORY_SCOPE_AGENT); }
__device__ __forceinline__ unsigned xb_xcc_id() { return (unsigned)__builtin_amdgcn_s_getreg((3 << 11) | 20) & 0xFu; }
#define XB_SPIN(cond, bar) do { unsigned _sp = 0; while (cond) { __builtin_amdgcn_s_sleep(1); \
    if ((++_sp & 255u) == 0u) { if (xb_ld(&(bar)[XB_TMO])) break; if (_sp > XB_SPIN_CAP) { atomicAdd(&(bar)[XB_TMO], 1u); break; } } } } while (0)
struct XcdBarrier { unsigned* bar; unsigned x; volatile LAS unsigned* st; };
__device__ __forceinline__ XcdBarrier xcd_barrier_post(unsigned* bar, volatile LAS unsigned* st) {
    XcdBarrier b; b.bar = bar; b.x = xb_xcc_id(); b.st = st;
    if (threadIdx.x == 0) (void)xb_add(&bar[XB_XCNT(b.x)], 1u);
    return b;
}
__device__ __forceinline__ void xcd_barrier_complete(unsigned* bar, unsigned x, unsigned& nloc, unsigned& nx) {
    const unsigned G = gridDim.x * gridDim.y * gridDim.z;
    unsigned sum, cnt, mine, sp = 0u;
    for (;;) {
        sum = 0u; cnt = 0u; mine = 0u;
#pragma unroll
        for (unsigned j = 0; j < 16; ++j) { const unsigned c = xb_ld(&bar[XB_XCNT(j)]); sum += c; cnt += (c > 0u) ? 1u : 0u; mine = (j == x) ? c : mine; }
        if (sum == G) break;
        __builtin_amdgcn_s_sleep(1);
        if ((++sp & 255u) == 0u) { if (xb_ld(&bar[XB_TMO])) break; if (sp > XB_SPIN_CAP) { atomicAdd(&bar[XB_TMO], 1u); break; } }
    }
    nloc = mine > 0u ? mine : 1u; nx = cnt > 0u ? cnt : 1u;
}
__device__ __forceinline__ void xcd_barrier(const XcdBarrier& b) {
    asm volatile("s_waitcnt vmcnt(0)" ::: "memory");
    __syncthreads();
    if (threadIdx.x == 0) {
        unsigned* bar = b.bar; asm volatile("" : "+s"(bar));
        __builtin_amdgcn_s_waitcnt(0);
        unsigned nloc = b.st[0], nx = b.st[1];
        if (nloc == 0u) { xcd_barrier_complete(bar, b.x, nloc, nx); b.st[0] = nloc; b.st[1] = nx; }
        const unsigned old = xb_add(&bar[XB_XSUB(b.x)], 1u);
        const unsigned gen = old / nloc;
        if (old + 1u == (gen + 1u) * nloc) {
            __builtin_amdgcn_fence(__ATOMIC_RELEASE, "agent");
            asm volatile("s_waitcnt vmcnt(0)" ::: "memory");
            const unsigned og = xb_add(&bar[XB_TOP], 1u);
            const unsigned tg = og / nx;
            if (og + 1u == (tg + 1u) * nx) xb_add(&bar[XB_TOPGEN], 1u);
            else XB_SPIN(xb_ld(&bar[XB_TOPGEN]) == tg, bar);
            __builtin_amdgcn_fence(__ATOMIC_ACQUIRE, "agent");
            xb_add(&bar[XB_XGEN(b.x)], 1u);
            asm volatile("s_waitcnt vmcnt(0)" ::: "memory");
        } else {
            XB_SPIN(xb_ld(&bar[XB_XGEN(b.x)]) == gen, bar);
            __builtin_amdgcn_fence(__ATOMIC_ACQUIRE, "agent");
            asm volatile("s_waitcnt vmcnt(0)" ::: "memory");
        }
    }
    __syncthreads();
}

namespace pg8 {
constexpr int BM = 256, BK = 64, HALF = 128, HTB = HALF * BK * 2, STAGE_BYTES = 8 * HTB, NXCD = 8, WGM = 8;
__host__ __device__ __forceinline__ int lds_byte(int r, int c) { const int st = (r >> 4) * 2 + (c >> 5), rr = r & 15, cc = c & 31, ob = rr * 64 + cc * 2; return st * 1024 + (ob ^ (((ob >> 9) & 1) << 5)); }
__host__ __device__ __forceinline__ void stage_rc(int b, int& R, int& C) { const int st = b / 1024, sb = b % 1024, swz = sb ^ (((sb >> 9) & 1) << 5); R = (st >> 1) * 16 + swz / 64; C = (st & 1) * 32 + (swz % 64) / 2; }
__host__ __device__ __forceinline__ int perm32(int rho) { const int n = rho >> 4, i = rho & 15; return 8 * (i >> 2) + 4 * n + (i & 3); }

struct Unit { int pm, pn; long aoff, boff; };
struct Gemm { const bf16_t* A; const bf16_t* Bt; int lda, ldb, K; };

struct OrderMN {
    int nM, nN, nwg, G, c, ashift; long astep, bstep, abytes;
    __device__ __forceinline__ int gather_row(const Unit&, int) const { return 0; }
    __device__ void init(int nM_, int nN_, int G_, int c_, long astep_, long bstep_, int ashift_ = 0, long abytes_ = 0) { nM = nM_; nN = nN_; nwg = nM * nN; G = G_; c = c_; astep = astep_; bstep = bstep_; ashift = ashift_; abytes = abytes_; }
    __device__ bool next(int i, Unit& u) const {
        const long L = (long)i * G + c; if (L >= nwg) return false;
        int wgid = (int)L; { const int q = nwg / NXCD, r = nwg % NXCD, xcd = wgid % NXCD, off = wgid / NXCD; wgid = (xcd < r ? xcd * (q + 1) : r * (q + 1) + (xcd - r) * q) + off; }
        const int nig = WGM * nN, gid = wgid / nig, fm = gid * WGM, gsz = (nM - fm) < WGM ? (nM - fm) : WGM;
        u.pm = fm + ((wgid % nig) % gsz); u.pn = (wgid % nig) / gsz;
        u.aoff = (long)u.pm * astep + (long)(u.pn >> ashift) * abytes; u.boff = (long)u.pn * bstep; return true;
    }
};
struct OrderMoE {
    const volatile LAS int* te; int Mt, nN, G, c; long astep, bstep, estep; const int* list;
    __device__ __forceinline__ int gather_row(const Unit& u, int r) const { const int e = te[u.pm], rb = te[160 + u.pm] + r; return rb < te[320 + u.pm] ? list[(size_t)e * T + rb] : 0; }
    __device__ bool next(int i, Unit& u) const {
        const long L = (long)i * G + c; if (L >= (long)Mt * nN) return false;
        u.pm = (int)(L / nN); u.pn = (int)(L % nN);
        u.aoff = (long)u.pm * astep; u.boff = (long)te[u.pm] * estep + (long)u.pn * bstep; return true;
    }
};

template <class Epi, class Sched, bool GATH = false>
__device__ __forceinline__ void gemm_phase(LAS unsigned char* lds, const Gemm g, const Sched& S, const Epi& E) {
    int tid_ = threadIdx.x; asm volatile("" : "+v"(tid_));
    const GAS bf16_t* gA = (const GAS bf16_t*)g.A; const GAS bf16_t* gB = (const GAS bf16_t*)g.Bt; asm volatile("" : "+s"(gA), "+s"(gB));
    const int tid = tid_, wid = __builtin_amdgcn_readfirstlane(tid >> 6), lane = tid & 63, wr = wid >> 2, wc = wid & 3, fr = lane & 15, fq = lane >> 4;
    const int K = g.K, nt = K / BK;
    unsigned voffA[2], voffB[2];
#pragma unroll
    for (int i = 0; i < 2; ++i) { int R, C; stage_rc(tid * 16 + i * 8192, R, C); const int Rb = Epi::PERM ? ((R & ~31) + perm32(R & 31)) : R;
        voffA[i] = (unsigned)(R * g.lda + C) * 2u; voffB[i] = (unsigned)(Rb * g.ldb + C) * 2u; }
    const size_t kstep = (size_t)(BK * 2);
    const size_t hstepA = GATH ? (size_t)0 : (size_t)HALF * g.lda * 2, hstepB = (size_t)HALF * g.ldb * 2;
    unsigned gAc[2][2], gAn[2][2]; int gR[2], gC[2];
#pragma unroll
    for (int i = 0; i < 2; ++i) { stage_rc(tid * 16 + i * 8192, gR[i], gC[i]); gAc[0][i] = gAc[1][i] = gAn[0][i] = gAn[1][i] = 0u; }
#define PG8_GLOAD(dst, un) do { _Pragma("unroll") for (int h_ = 0; h_ < 2; ++h_) _Pragma("unroll") for (int i_ = 0; i_ < 2; ++i_) \
        dst[h_][i_] = (unsigned)S.gather_row(un, h_ * HALF + gR[i_]) * (unsigned)(g.lda * 2) + (unsigned)(gC[i_] * 2); } while (0)
#define PG8_STAGE_A(bufoff, kptr, h, nx) do { if (GATH) { unsigned vo_[2]; vo_[0] = (nx) ? gAn[h][0] : gAc[h][0]; vo_[1] = (nx) ? gAn[h][1] : gAc[h][1]; PG8_STAGE(bufoff, kptr, vo_); } \
        else PG8_STAGE(bufoff, (kptr) + (h) * hstepA, voffA); } while (0)
    const unsigned ldsw = (unsigned)wid * 1024u;
    const int aoff = lds_byte(wr * 64 + fr, fq * 8), boff = lds_byte(wc * 32 + fr, fq * 8);
#define PG8_SA(b, h) (((b) * 2 + (h)) * HTB)
#define PG8_SB(b, h) ((4 + (b) * 2 + (h)) * HTB)
#define PG8_STAGE(bufoff, gbase, voff) do { _Pragma("unroll") for (int _i = 0; _i < 2; ++_i) \
        __builtin_amdgcn_global_load_lds((const GAS unsigned*)((gbase) + (voff)[_i]), (LAS unsigned*)(lds + (bufoff) + ldsw + _i * 8192), 16, 0, 0); } while (0)
#define PG8_LDA(dst, b, h) do { _Pragma("unroll") for (int m = 0; m < 4; ++m) _Pragma("unroll") for (int k = 0; k < 2; ++k) dst[m][k] = *(const LAS bf16x8*)(lds + PG8_SA(b, h) + aoff + m * 2048 + k * 1024); } while (0)
#define PG8_LDB(dst, b, h) do { _Pragma("unroll") for (int n = 0; n < 2; ++n) _Pragma("unroll") for (int k = 0; k < 2; ++k) dst[n][k] = *(const LAS bf16x8*)(lds + PG8_SB(b, h) + boff + n * 2048 + k * 1024); } while (0)
#define PG8_MMA(ai, bj, At, Bt) do { __builtin_amdgcn_s_setprio(1); _Pragma("unroll") for (int m = 0; m < 4; ++m) _Pragma("unroll") for (int n = 0; n < 2; ++n) _Pragma("unroll") for (int k = 0; k < 2; ++k) \
        acc[ai][bj][m][n] = __builtin_amdgcn_mfma_f32_16x16x32_bf16(Bt[n][k], At[m][k], acc[ai][bj][m][n], 0, 0, 0); __builtin_amdgcn_s_setprio(0); } while (0)
#define PG8_WAIT_V(n) asm volatile("s_waitcnt vmcnt(" #n ")" ::: "memory")
#define PG8_WAIT_L(n) asm volatile("s_waitcnt lgkmcnt(" #n ")" ::: "memory")
#define PG8_BAR __builtin_amdgcn_s_barrier()
#define PG8_SCHED __builtin_amdgcn_sched_barrier(0)
    Unit cur, nxt; int ui = 0;
    if (!S.next(0, cur)) return;
    f32x4 acc[2][2][4][2];
#pragma unroll
    for (int a = 0; a < 2; ++a)
#pragma unroll
        for (int b = 0; b < 2; ++b)
#pragma unroll
            for (int m = 0; m < 4; ++m)
#pragma unroll
                for (int n = 0; n < 2; ++n) acc[a][b][m][n] = (f32x4){0.f, 0.f, 0.f, 0.f};
    bf16x8 At[4][2], B0[2][2], B1[2][2];
    const GAS char* cA = (const GAS char*)gA + (GATH ? 0L : cur.aoff); const GAS char* cB = (const GAS char*)gB + cur.boff;
    if (GATH) PG8_GLOAD(gAc, cur);
    PG8_STAGE(PG8_SB(0, 0), cB, voffB); PG8_STAGE_A(PG8_SA(0, 0), cA, 0, false); PG8_STAGE(PG8_SB(0, 1), cB + hstepB, voffB); PG8_STAGE_A(PG8_SA(0, 1), cA, 1, false);
    if (wr == 1) PG8_BAR;
    PG8_WAIT_V(4); PG8_BAR;
    PG8_STAGE(PG8_SB(1, 0), cB + kstep, voffB); PG8_STAGE_A(PG8_SA(1, 0), cA + kstep, 0, false); PG8_STAGE(PG8_SB(1, 1), cB + hstepB + kstep, voffB);
    PG8_WAIT_V(6); PG8_BAR;
    for (;;) {
        const bool has_next = S.next(ui + 1, nxt);
        const GAS char* nA = (has_next && !GATH) ? (const GAS char*)gA + nxt.aoff : cA; const GAS char* nB = has_next ? (const GAS char*)gB + nxt.boff : cB;
        if (GATH) { if (has_next) PG8_GLOAD(gAn, nxt); else { gAn[0][0] = gAc[0][0]; gAn[0][1] = gAc[0][1]; gAn[1][0] = gAc[1][0]; gAn[1][1] = gAc[1][1]; } }
        for (int t = 0; t < nt; t += 2) {
            const bool last = (t == nt - 2);
            const GAS char* a1 = cA + (size_t)(t + 1) * kstep;
            const GAS char* a2 = last ? nA : cA + (size_t)(t + 2) * kstep; const GAS char* b2 = last ? nB : cB + (size_t)(t + 2) * kstep;
            const GAS char* a3 = a2 + kstep; const GAS char* b3 = b2 + kstep;
            PG8_LDB(B0, 0, 0); PG8_SCHED; PG8_LDA(At, 0, 0); PG8_STAGE_A(PG8_SA(1, 1), a1, 1, false);
            PG8_WAIT_L(8); PG8_BAR; PG8_WAIT_L(0); PG8_MMA(0, 0, At, B0); PG8_BAR; PG8_SCHED;
            PG8_LDB(B1, 0, 1); PG8_STAGE(PG8_SB(0, 0), b2, voffB);
            PG8_BAR; PG8_WAIT_L(0); PG8_MMA(0, 1, At, B1); PG8_BAR;
            PG8_LDA(At, 0, 1); PG8_STAGE_A(PG8_SA(0, 0), a2, 0, last);
            PG8_BAR; PG8_WAIT_L(0); PG8_MMA(1, 0, At, B0); PG8_BAR; PG8_SCHED;
            PG8_STAGE(PG8_SB(0, 1), b2 + hstepB, voffB);
            PG8_WAIT_V(6); PG8_BAR; PG8_MMA(1, 1, At, B1); PG8_BAR;
            PG8_LDB(B0, 1, 0); PG8_SCHED; PG8_LDA(At, 1, 0); PG8_STAGE_A(PG8_SA(0, 1), a2, 1, last);
            PG8_WAIT_L(8); PG8_BAR; PG8_WAIT_L(0); PG8_MMA(0, 0, At, B0); PG8_BAR; PG8_SCHED;
            PG8_LDB(B1, 1, 1); PG8_STAGE(PG8_SB(1, 0), b3, voffB);
            PG8_BAR; PG8_WAIT_L(0); PG8_MMA(0, 1, At, B1); PG8_BAR;
            PG8_LDA(At, 1, 1); PG8_STAGE_A(PG8_SA(1, 0), a3, 0, last);
            PG8_BAR; PG8_WAIT_L(0); PG8_MMA(1, 0, At, B0); PG8_BAR; PG8_SCHED;
            PG8_STAGE(PG8_SB(1, 1), b3 + hstepB, voffB);
            PG8_WAIT_V(6); PG8_BAR; PG8_MMA(1, 1, At, B1); PG8_BAR;
        }
        E(acc, cur, wr, wc, fr, fq);
        if (!has_next) break;
#pragma unroll
        for (int a = 0; a < 2; ++a)
#pragma unroll
            for (int b = 0; b < 2; ++b)
#pragma unroll
                for (int m = 0; m < 4; ++m)
#pragma unroll
                    for (int n = 0; n < 2; ++n) acc[a][b][m][n] = (f32x4){0.f, 0.f, 0.f, 0.f};
        cur = nxt; cA = nA; cB = nB; ++ui;
        if (GATH) { gAc[0][0] = gAn[0][0]; gAc[0][1] = gAn[0][1]; gAc[1][0] = gAn[1][0]; gAc[1][1] = gAn[1][1]; }
    }
    PG8_WAIT_V(0);
    if (wr == 0) PG8_BAR;
    PG8_BAR;
#undef PG8_SA
#undef PG8_SB
#undef PG8_STAGE
#undef PG8_STAGE_A
#undef PG8_GLOAD
#undef PG8_LDA
#undef PG8_LDB
#undef PG8_MMA
#undef PG8_WAIT_V
#undef PG8_WAIT_L
#undef PG8_BAR
#undef PG8_SCHED
}

typedef const f32x4 (&AccT)[2][2][4][2];
template <int ACT> __device__ __forceinline__ void store_tile_bf16(AccT acc, bf16_t* O, int ld, int row0, int colb, float scale) {
#pragma unroll
    for (int ai = 0; ai < 2; ++ai)
#pragma unroll
        for (int m = 0; m < 4; ++m) { bf16_t* rowp = O + (size_t)(row0 + ai * HALF + m * 16) * ld + colb;
#pragma unroll
            for (int bj = 0; bj < 2; ++bj) { const f32x4 v0 = act4<ACT>(acc[ai][bj][m][0] * scale), v1 = act4<ACT>(acc[ai][bj][m][1] * scale);
                *(u32x4*)(rowp + bj * HALF) = pack8(v0, v1); }
            asm volatile("" ::: "memory"); }
}
template <int ACT> struct EpiStore {
    static constexpr bool PERM = true;
    bf16_t* O; int ld; float scale;
    __device__ __forceinline__ void operator()(AccT acc, const Unit& u, int wr, int wc, int fr, int fq) const {
        store_tile_bf16<ACT>(acc, O, ld, u.pm * BM + wr * 64 + fr, u.pn * BM + wc * 32 + 8 * fq, scale);
    }
};
struct EpiInProj {
    static constexpr bool PERM = true;
    unsigned char* ws;
    __device__ __forceinline__ void operator()(AccT acc, const Unit& u, int wr, int wc, int fr, int fq) const {
        const int pn = u.pn, row0 = u.pm * BM + wr * 64 + fr, cw = wc * 32 + 8 * fq;
        unsigned char* pj = ws + WS_PROJ;
        bf16_t *rq = (bf16_t*)(pj + P_RQ), *rk = (bf16_t*)(pj + P_RK), *rv = (bf16_t*)(pj + P_RV), *rg = (bf16_t*)(pj + P_RG), *gu = (bf16_t*)(pj + P_GU), *gv = (bf16_t*)(pj + P_GV), *dq = (bf16_t*)(pj + P_DQ),
               *iq = (bf16_t*)(pj + P_IQ), *ik = (bf16_t*)(pj + P_IK), *ga = (bf16_t*)(pj + P_GA), *gb = (bf16_t*)(pj + P_GB), *gc = (bf16_t*)(pj + P_GC);
        float *dcraw = (float*)(pj + P_DC), *iw = (float*)(pj + P_IW), *gvstats = (float*)(ws + WS_STATS); const float* rope = (const float*)(ws + WS_ROPE);
        if (pn < 8) {
            const bool isk = pn >= 4; bf16_t* dst = (isk ? rk : rq) + (pn & 3) * 256 + cw; const float sc = isk ? 0.0625f : 1.0f;
#pragma unroll
            for (int ai = 0; ai < 2; ++ai) { f32x4 csq[4][4];
#pragma unroll
                for (int m = 0; m < 4; ++m) { const int pos = (row0 + ai * HALF + m * 16) & (SEQ - 1); const f32x4* cs = (const f32x4*)(rope + ((size_t)pos * 128 + cw) * 2);
#pragma unroll
                    for (int q4 = 0; q4 < 4; ++q4) csq[m][q4] = cs[q4]; }
                asm volatile("" ::: "memory");
#pragma unroll
                for (int m = 0; m < 4; ++m) { const int row = row0 + ai * HALF + m * 16;
                    f32x4 o1[2], o2[2];
#pragma unroll
                    for (int n = 0; n < 2; ++n) { const f32x4 c01 = csq[m][2 * n], c23 = csq[m][2 * n + 1]; const f32x4 x1 = acc[ai][0][m][n], x2 = acc[ai][1][m][n];
                        const float co[4] = {c01[0], c01[2], c23[0], c23[2]}, si[4] = {c01[1], c01[3], c23[1], c23[3]};
#pragma unroll
                        for (int j = 0; j < 4; ++j) { o1[n][j] = (x1[j] * co[j] - x2[j] * si[j]) * sc; o2[n][j] = (x1[j] * si[j] + x2[j] * co[j]) * sc; } }
                    bf16_t* rp = dst + (size_t)row * 1024;
                    *(u32x4*)rp = pack8(o1[0], o1[1]); *(u32x4*)(rp + 128) = pack8(o2[0], o2[1]); }
                asm volatile("" ::: "memory"); }
        } else if (pn < 12) { store_tile_bf16<0>(acc, rv, 1024, row0, (pn - 8) * 256 + cw, 1.f);
        } else if (pn < 16) { store_tile_bf16<2>(acc, rg, 1024, row0, (pn - 12) * 256 + cw, 1.f);
        } else if (pn < 20) { store_tile_bf16<1>(acc, gu, 1024, row0, (pn - 16) * 256 + cw, 1.f);
        } else if (pn < 24) {
            const int t4 = pn - 20; bf16_t* dst = gv + t4 * 256 + cw;
#pragma unroll
            for (int ai = 0; ai < 2; ++ai)
#pragma unroll
                for (int m = 0; m < 4; ++m) { const int row = row0 + ai * HALF + m * 16; float s = 0.f, q = 0.f;
#pragma unroll
                    for (int bj = 0; bj < 2; ++bj) { const f32x4 v0 = act4<1>(acc[ai][bj][m][0]), v1 = act4<1>(acc[ai][bj][m][1]);
                        *(u32x4*)(dst + (size_t)row * 1024 + bj * HALF) = pack8(v0, v1);
#pragma unroll
                        for (int j = 0; j < 4; ++j) { s += v0[j] + v1[j]; q += v0[j] * v0[j] + v1[j] * v1[j]; } }
                    s = quad_sum(s); q = quad_sum(q);
                    if (fq == 0) *(f32x2*)(gvstats + ((size_t)row * 16 + t4 * 4 + wc) * 2) = (f32x2){s, q}; asm volatile("" ::: "memory"); }
        } else if (pn < 28) { store_tile_bf16<0>(acc, dq, 1024, row0, (pn - 24) * 256 + cw, 1.f);
        } else if (pn == 28) {
#pragma unroll
            for (int ai = 0; ai < 2; ++ai)
#pragma unroll
                for (int m = 0; m < 4; ++m) { float* rp = dcraw + (size_t)(row0 + ai * HALF + m * 16) * 256 + cw;
#pragma unroll
                    for (int bj = 0; bj < 2; ++bj) { *(f32x4*)(rp + bj * HALF) = acc[ai][bj][m][0]; *(f32x4*)(rp + bj * HALF + 4) = acc[ai][bj][m][1]; } }
        } else if (pn < 31) { store_tile_bf16<0>(acc, iq, 512, row0, (pn - 29) * 256 + cw, 1.f);
        } else if (pn == 31) {
#pragma unroll
            for (int ai = 0; ai < 2; ++ai)
#pragma unroll
                for (int m = 0; m < 4; ++m) { const int row = row0 + ai * HALF + m * 16;
                    if (wc < 2) *(u32x4*)(ik + (size_t)row * 64 + cw) = pack8(acc[ai][0][m][0], acc[ai][0][m][1]);
                    if (wc == 2 && fq == 0) { *(f32x4*)(iw + (size_t)row * 8) = acc[ai][0][m][0] * 0.35355339059f; *(f32x4*)(iw + (size_t)row * 8 + 4) = acc[ai][0][m][1] * 0.35355339059f; } }
        } else { const int gi = (pn - 32) >> 3; bf16_t* dst = gi == 0 ? ga : (gi == 1 ? gb : gc);
            store_tile_bf16<3>(acc, dst, 2048, row0, ((pn - 32) & 7) * 256 + cw, 1.f); }
    }
};
struct EpiBranch {
    static constexpr bool PERM = true;
    const bf16_t* gate0; bf16_t* merged;
    __device__ __forceinline__ void operator()(AccT acc, const Unit& u, int wr, int wc, int fr, int fq) const {
        const int br = u.pn >> 8, first = (br == 0); const bf16_t* gate = gate0 + (size_t)br * (32u << 20);
        const int row0 = u.pm * BM + wr * 64 + fr, colb = (u.pn & 255) * BM + wc * 32 + 8 * fq;
#pragma unroll
        for (int ai = 0; ai < 2; ++ai) {
            u32x4 gq[4][2], mq[4][2];
#pragma unroll
            for (int m = 0; m < 4; ++m)
#pragma unroll
                for (int bj = 0; bj < 2; ++bj) { const size_t ro = (size_t)(row0 + ai * HALF + m * 16) * 2048 + colb + bj * HALF; gq[m][bj] = *(const u32x4*)(gate + ro); mq[m][bj] = *(const u32x4*)(merged + ro); }
            asm volatile("" ::: "memory");
#pragma unroll
            for (int m = 0; m < 4; ++m)
#pragma unroll
                for (int bj = 0; bj < 2; ++bj) { const size_t ro = (size_t)(row0 + ai * HALF + m * 16) * 2048 + colb + bj * HALF; float g8[8], m8[8]; unpack8(gq[m][bj], g8); unpack8(mq[m][bj], m8);
                    const f32x4 a0 = acc[ai][bj][m][0], a1 = acc[ai][bj][m][1]; f32x4 r0, r1;
#pragma unroll
                    for (int j = 0; j < 4; ++j) { r0[j] = (first ? 0.f : m8[j]) + g8[j] * a0[j]; r1[j] = (first ? 0.f : m8[4 + j]) + g8[4 + j] * a1[j]; }
                    *(u32x4*)(merged + ro) = pack8(r0, r1); }
            asm volatile("" ::: "memory");
        }
    }
};
struct EpiResid {
    static constexpr bool PERM = false;
    const float* xsrc; float* xdst;
    __device__ __forceinline__ void operator()(AccT acc, const Unit& u, int wr, int wc, int fr, int fq) const {
        const int row0 = u.pm * BM + wr * 64 + fr, col0 = u.pn * BM + wc * 32 + 4 * fq;
#pragma unroll
        for (int ai = 0; ai < 2; ++ai)
#pragma unroll
            for (int mp = 0; mp < 2; ++mp) { f32x4 xv[2][2][2];
#pragma unroll
                for (int mm = 0; mm < 2; ++mm)
#pragma unroll
                    for (int bj = 0; bj < 2; ++bj)
#pragma unroll
                        for (int n = 0; n < 2; ++n) xv[mm][bj][n] = *(const f32x4*)(xsrc + (size_t)(row0 + ai * HALF + (2 * mp + mm) * 16) * DM + col0 + bj * HALF + n * 16);
                asm volatile("" ::: "memory");
#pragma unroll
                for (int mm = 0; mm < 2; ++mm)
#pragma unroll
                    for (int bj = 0; bj < 2; ++bj)
#pragma unroll
                        for (int n = 0; n < 2; ++n) *(f32x4*)(xdst + (size_t)(row0 + ai * HALF + (2 * mp + mm) * 16) * DM + col0 + bj * HALF + n * 16) = xv[mm][bj][n] + acc[ai][bj][2 * mp + mm][n];
                asm volatile("" ::: "memory"); }
    }
};
struct EpiMoeUp {
    static constexpr bool PERM = true;
    bf16_t* hid;
    __device__ __forceinline__ void operator()(AccT acc, const Unit& u, int wr, int wc, int fr, int fq) const {
        const int row0 = u.pm * BM + wr * 64 + fr, colb = u.pn * 128 + wc * 32 + 8 * fq;
#pragma unroll
        for (int ai = 0; ai < 2; ++ai)
#pragma unroll
            for (int m = 0; m < 4; ++m) { f32x4 r0, r1; const f32x4 a0 = acc[ai][0][m][0], a1 = acc[ai][0][m][1], b0 = acc[ai][1][m][0], b1 = acc[ai][1][m][1];
#pragma unroll
                for (int j = 0; j < 4; ++j) { r0[j] = siluf_(a0[j]) * b0[j]; r1[j] = siluf_(a1[j]) * b1[j]; }
                *(u32x4*)(hid + (size_t)(row0 + ai * HALF + m * 16) * FF + colb) = pack8(r0, r1); }
    }
};
struct OrderBranch {
    OrderMN base; long astride, bstride;
    __device__ __forceinline__ int gather_row(const Unit&, int) const { return 0; }
    __device__ bool next(int i, Unit& u) const { if (!base.next(i / 3, u)) return false; const int br = i % 3; u.aoff += br * astride; u.boff += br * bstride; u.pn |= br << 8; return true; }
};
struct OrderRouter {
    int G, c; long hlo_off;
    __device__ __forceinline__ int gather_row(const Unit&, int) const { return 0; }
    __device__ bool next(int i, Unit& u) const { const int L = i * G + c; if (L >= 256) return false; const int pm = L >> 2, which = (L >> 1) & 1, kh = L & 1;
        u.pm = pm; u.pn = which * 2 + kh; u.aoff = (long)pm * 256 * DM * 2 + (long)which * hlo_off + (long)kh * 1024 * 2; u.boff = (long)kh * 1024 * 2; return true; }
};
struct EpiRouter {
    static constexpr bool PERM = false;
    float* LOG;
    __device__ __forceinline__ void operator()(AccT acc, const Unit& u, int wr, int wc, int fr, int fq) const {
        float* base = LOG + ((size_t)u.pn * T + (size_t)u.pm * BM + wr * 64 + fr) * 128 + wc * 32 + 4 * fq;
#pragma unroll
        for (int ai = 0; ai < 2; ++ai)
#pragma unroll
            for (int m = 0; m < 4; ++m)
#pragma unroll
                for (int n = 0; n < 2; ++n) *(f32x4*)(base + (size_t)(ai * HALF + m * 16) * 128 + n * 16) = acc[ai][0][m][n];
    }
};
}

struct Args { const float* in[23]; float* out; unsigned char* ws; int ph_lo, ph_hi; };
enum { I_X = 0, I_NMIX, I_WIN, I_WRET, I_LNG, I_LNB, I_WS, I_BS, I_WGM, I_KVG, I_WUK, I_WUV, I_WDS, I_WOUT, I_NFFN, I_WGRP, I_BGRP, I_WEXP, I_BEXP, I_W1, I_W3, I_W2, I_FNG };
struct Ctx {
    LAS unsigned char* lds; volatile LAS int* misc; unsigned* ctl; GAS unsigned char* ws;
    int tid, lane, wave, G, bid, gw, NGW;
    const float* const* in; float* out;
};
#define WSP(T_, off) ((T_*)(C.ws + (off)))
__device__ __forceinline__ void refresh(Ctx& C) { int t = threadIdx.x; asm volatile("" : "+v"(t)); C.tid = t; C.lane = t & 63;
    GAS unsigned char* w = C.ws; asm volatile("" : "+s"(w)); C.ws = w; C.ctl = (unsigned*)w; }

__device__ __forceinline__ void ph_rope(const Ctx& C) {
    float* rope = WSP(float, WS_ROPE);
    const double r1 = 0.9305720409296989;
    for (int idx = C.bid * 512 + C.tid; idx < SEQ * 128; idx += C.G * 512) {
        const int pos = idx >> 7, i = idx & 127;
        double inv = 1.0, b = r1; int e = i;
        while (e) { if (e & 1) inv *= b; b *= b; e >>= 1; }
        const double ang = (double)pos * inv;
        const double n = __builtin_rint(ang * 0.15915494309189533577);
        const double x = ang - n * 6.283185307179586476925;
        const double x2 = x * x;
        double s = 0.0, c = 0.0;
#pragma unroll 1
        for (int k = 14; k >= 1; --k) { s = (s + 1.0) * (-x2 / (double)((2 * k) * (2 * k + 1))); c = (c + 1.0) * (-x2 / (double)((2 * k - 1) * (2 * k))); }
        s = (s + 1.0) * x; c = c + 1.0;
        *(f32x2*)(rope + (size_t)idx * 2) = (f32x2){(float)c, (float)s};
    }
}

template <class Map>
__device__ __forceinline__ void tr_item(const float* W, long srcld, bf16_t* WT, long dstld, int k0, int n0, LAS float* scr, int lane, const Map& map) {
    const int nn = n0 + (lane & 31); const long sc = map(nn);
#pragma unroll 8
    for (int i = 0; i < 32; ++i) { const int kk = 2 * i + (lane >> 5); scr[kk * 33 + (lane & 31)] = sc >= 0 ? W[(size_t)(k0 + kk) * srcld + sc] : 0.f; }
    asm volatile("s_waitcnt lgkmcnt(0)" ::: "memory");
    const int c = lane & 7;
#pragma unroll
    for (int j = 0; j < 4; ++j) { const int n = (lane >> 3) + 8 * j; const LAS float* s = scr + (8 * c) * 33 + n;
        u32x4 o; o.x = cvt_pk_bf16(s[0 * 33], s[1 * 33]); o.y = cvt_pk_bf16(s[2 * 33], s[3 * 33]); o.z = cvt_pk_bf16(s[4 * 33], s[5 * 33]); o.w = cvt_pk_bf16(s[6 * 33], s[7 * 33]);
        *(u32x4*)(WT + (size_t)(n0 + n) * dstld + k0 + 8 * c) = o; }
    asm volatile("s_waitcnt lgkmcnt(0)" ::: "memory");
}
struct MapId { __device__ long operator()(int n) const { return n; } };
struct MapIn { __device__ long operator()(int n) const { return n < GATE_SRC0 ? n : (n < GATE_DST0 ? -1 : n - (GATE_DST0 - GATE_SRC0)); } };
struct MapOff { long off; __device__ long operator()(int n) const { return n + off; } };

struct WItem { const float* src; bf16_t* dst; int srcld, dstld, k0, n0, mode; long off; };
__device__ __forceinline__ WItem w_item(const Ctx& C, int l, int r) {
    unsigned char* wb = (unsigned char*)(C.ws + WS_W); WItem w; w.mode = 0; w.off = 0;
    constexpr int N_IN = 32 * 224, N_BR = 16 * 32, N_OUT = 32 * 32, N_13 = 32 * 32 * 16, N_2 = 32 * 8 * 32;
    if (r < N_IN) { const int kb = r / 224, nb = r % 224; w.src = C.in[I_WIN] + (size_t)l * DM * INW; w.srcld = INW; w.dst = (bf16_t*)(wb + W_IN); w.dstld = DM; w.k0 = kb * 64; w.n0 = nb * 64; w.mode = 1; return w; } r -= N_IN;
    if (r < 3 * N_BR) { const int ww = r / N_BR, q = r % N_BR, kb = q / 32, nb = q % 32; w.src = C.in[ww == 0 ? I_WRET : (ww == 1 ? I_WGM : I_WDS)] + (size_t)l * 1024 * DM; w.srcld = DM;
        w.dst = (bf16_t*)(wb + (ww == 0 ? W_RET : (ww == 1 ? W_GM : W_DS))); w.dstld = 1024; w.k0 = kb * 64; w.n0 = nb * 64; return w; } r -= 3 * N_BR;
    if (r < N_OUT) { const int kb = r / 32, nb = r % 32; w.src = C.in[I_WOUT] + (size_t)l * DM * DM; w.srcld = DM; w.dst = (bf16_t*)(wb + W_OUT); w.dstld = DM; w.k0 = kb * 64; w.n0 = nb * 64; return w; } r -= N_OUT;
    if (r < N_13) { const int e = r / 512, q = r % 512, kb = q / 16, nb = q % 16, row0 = nb * 64, j = row0 >> 8, sft = (row0 >> 7) & 1, fp = row0 & 127;
        w.src = C.in[sft ? I_W3 : I_W1] + ((size_t)l * NEXP + e) * DM * FF; w.srcld = FF; w.dst = (bf16_t*)(wb + W_13) + (size_t)e * 1024 * DM; w.dstld = DM; w.k0 = kb * 64; w.n0 = row0; w.off = (long)(128 * j + fp) - row0; return w; } r -= N_13;
    if (r < N_2) { const int e = r / 256, q = r % 256, kb = q / 32, nb = q % 32; w.src = C.in[I_W2] + ((size_t)l * NEXP + e) * FF * DM; w.srcld = DM; w.dst = (bf16_t*)(wb + W_2) + (size_t)e * DM * FF; w.dstld = FF; w.k0 = kb * 64; w.n0 = nb * 64; return w; } r -= N_2;
    { const int h = r / 8, q = r % 8, kb = q / 2, nb = q % 2;
      w.src = C.in[I_WUV] + ((size_t)l * 8 + h) * 256 * 128; w.srcld = 128; w.dst = (bf16_t*)(wb + W_UV) + (size_t)(h * 128) * 512 + (h & 1) * 256; w.dstld = 512; w.k0 = kb * 64; w.n0 = nb * 64; return w; }
}
__device__ __forceinline__ void w_load(const WItem& w, int lane, f32x4 (&R)[16]) {
    const int nq = lane & 15, kq = lane >> 4, n = w.n0 + 4 * nq;
    const long sc = (w.mode == 1) ? (n < GATE_SRC0 ? (long)n : (n < GATE_DST0 ? -1L : (long)(n - (GATE_DST0 - GATE_SRC0)))) : (long)n + w.off;
    const float* p = w.src + (size_t)(w.k0 + 2 * kq) * w.srcld + (sc >= 0 ? sc : 0);
#pragma unroll
    for (int i = 0; i < 8; ++i)
#pragma unroll
        for (int s2 = 0; s2 < 2; ++s2) { f32x4 v = __builtin_nontemporal_load((const f32x4*)(p + (size_t)(8 * i + s2) * w.srcld)); if (sc < 0) v = (f32x4){0.f, 0.f, 0.f, 0.f}; R[2 * i + s2] = v; }
}
__device__ __forceinline__ void w_store(const WItem& w, int lane, const f32x4 (&R)[16], LAS unsigned* scr) {
    const int nq = lane & 15, kq = lane >> 4;
#pragma unroll
    for (int i = 0; i < 8; ++i)
#pragma unroll
        for (int e = 0; e < 4; ++e) scr[(4 * nq + e) * 33 + 4 * i + kq] = cvt_pk_bf16(R[2 * i][e], R[2 * i + 1][e]);
    asm volatile("s_waitcnt lgkmcnt(0)" ::: "memory");
    const int c = lane & 7;
#pragma unroll
    for (int j = 0; j < 8; ++j) { const int n = (lane >> 3) + 8 * j; const LAS unsigned* sp = scr + n * 33 + 4 * c;
        u32x4 o; o.x = sp[0]; o.y = sp[1]; o.z = sp[2]; o.w = sp[3];
        *(u32x4*)(w.dst + (size_t)(w.n0 + n) * w.dstld + w.k0 + 8 * c) = o; }
    asm volatile("s_waitcnt lgkmcnt(0)" ::: "memory");
}
__device__ __forceinline__ void ph_weights(const Ctx& C, int l) {
    LAS unsigned* scr = (LAS unsigned*)(C.lds + C.wave * 16384);
    unsigned char* wb = (unsigned char*)(C.ws + WS_W);
    constexpr int NITEMS = 32 * 224 + 3 * 16 * 32 + 32 * 32 + 32 * 32 * 16 + 32 * 8 * 32 + 8 * 8;
    { int it = C.gw; f32x4 R[16], Rn[16]; WItem w, wn;
      if (it < NITEMS) { w = w_item(C, l, it); w_load(w, C.lane, R); }
#pragma unroll 1
      while (it < NITEMS) { const int itn = it + C.NGW;
          if (itn < NITEMS) { wn = w_item(C, l, itn); w_load(wn, C.lane, Rn); }
          w_store(w, C.lane, R, scr);
#pragma unroll
          for (int i = 0; i < 16; ++i) R[i] = Rn[i];
          w = wn; it = itn; } }
    bf16_t* uv = (bf16_t*)(wb + W_UV); bf16_t* uk = (bf16_t*)(wb + W_UK); const float* wuk = C.in[I_WUK] + (size_t)l * 8 * 256 * 128;
    for (int idx = C.bid * 512 + C.tid; idx < 1024 * 256 / 8; idx += C.G * 512) { const int row = idx >> 5, c8 = (idx & 31) * 8, h = row >> 7;
        *(u32x4*)(uv + (size_t)row * 512 + (1 - (h & 1)) * 256 + c8) = (u32x4){0u, 0u, 0u, 0u}; }
    for (int idx = C.bid * 512 + C.tid; idx < 2048 * 256 / 8; idx += C.G * 512) { const int row = idx >> 5, c8 = (idx & 31) * 8, h = row >> 8, half = c8 >> 7;
        u32x4 o = (u32x4){0u, 0u, 0u, 0u};
        if (half == (h & 1)) { const float* s = wuk + (size_t)row * 128 + (c8 & 127); const f32x4 a = *(const f32x4*)s, b = *(const f32x4*)(s + 4); o = pack8(a, b); }
        *(u32x4*)(uk + (size_t)row * 256 + c8) = o; }
    bf16_t* rt = (bf16_t*)(wb + W_RT); const float* wgr = C.in[I_WGRP] + (size_t)l * DM * 4; const float* wex = C.in[I_WEXP] + (size_t)l * 4 * DM * 8;
    for (int idx = C.bid * 512 + C.tid; idx < 256 * 256; idx += C.G * 512) { const int r = idx >> 8, k8 = (idx & 255) * 8, c = r & 63, part = r >> 6;
        u32x4 o = (u32x4){0u, 0u, 0u, 0u};
        if (part < 2 && c < 36) { float v[8];
#pragma unroll
            for (int j = 0; j < 8; ++j) { const float wv = (c < 4) ? wgr[(size_t)(k8 + j) * 4 + c] : wex[((size_t)((c - 4) >> 3) * DM + (k8 + j)) * 8 + ((c - 4) & 7)];
                const float hi = bf2f(f2bf(wv)); v[j] = part == 0 ? hi : (wv - hi); }
            o = pack8((f32x4){v[0], v[1], v[2], v[3]}, (f32x4){v[4], v[5], v[6], v[7]}); }
        *(u32x4*)(rt + (size_t)r * DM + k8) = o; }
}

__device__ __forceinline__ void ph_norm(const Ctx& C, const float* x, const float* g, bf16_t* H) {
    for (int row = C.gw; row < T; row += C.NGW) {
        const f32x4* xr = (const f32x4*)(x + (size_t)row * DM) + C.lane; f32x4 v[8]; float ss = 0.f;
#pragma unroll
        for (int j = 0; j < 8; ++j) { v[j] = xr[64 * j]; ss += v[j][0] * v[j][0] + v[j][1] * v[j][1] + v[j][2] * v[j][2] + v[j][3] * v[j][3]; }
        const float rstd = rsqrtf(wave_sum(ss, C.lane) * (1.f / DM) + EPS);
        u32x2* o = (u32x2*)(H + (size_t)row * DM) + C.lane;
#pragma unroll
        for (int j = 0; j < 8; ++j) { const f32x4 gg = ((const f32x4*)g)[64 * j + C.lane]; const f32x4 y = v[j] * rstd * gg; u32x2 w; w.x = cvt_pk_bf16(y[0], y[1]); w.y = cvt_pk_bf16(y[2], y[3]); o[64 * j] = w; }
    }
}
__device__ __forceinline__ void ph_ckv(const Ctx& C, const float* dcraw, const float* g, bf16_t* ckv) {
    for (int row = C.gw; row < T; row += C.NGW) {
        const f32x4 v = ((const f32x4*)(dcraw + (size_t)row * 256))[C.lane];
        const float ss = wave_sum(v[0] * v[0] + v[1] * v[1] + v[2] * v[2] + v[3] * v[3], C.lane);
        const float rstd = rsqrtf(ss * (1.f / 256.f) + EPS); const f32x4 y = v * rstd * ((const f32x4*)g)[C.lane];
        u32x2 w; w.x = cvt_pk_bf16(y[0], y[1]); w.y = cvt_pk_bf16(y[2], y[3]); ((u32x2*)(ckv + (size_t)row * 256))[C.lane] = w;
    }
}

__device__ __forceinline__ void ph_gmlp_naive(const Ctx& C, int l) {
    const bf16_t* gu = WSP(bf16_t, WS_PROJ + P_GU); const bf16_t* gv = WSP(bf16_t, WS_PROJ + P_GV); const float* stats = WSP(float, WS_STATS); bf16_t* gm = WSP(bf16_t, WS_GM);
    const float* lng = C.in[I_LNG] + l * 1024; const float* lnb = C.in[I_LNB] + l * 1024; const float* Wsp = C.in[I_WS] + (size_t)l * 4 * 128 * 128; const float* bs = C.in[I_BS] + l * 4 * 128;
    LAS float* smean = (LAS float*)C.lds; LAS float* srstd = smean + 128; LAS float* lv = srstd + 128;
    for (int u = C.bid; u < 512; u += C.G) {
        const int g = u & 3, bn = u >> 2, t0 = bn * 128;
        __syncthreads();
        if (C.tid < 128) { const float* sp = stats + (size_t)(t0 + C.tid) * 32; float s = 0.f, q = 0.f;
            for (int k = 0; k < 16; ++k) { s += sp[2 * k]; q += sp[2 * k + 1]; }
            const float mean = s * (1.f / 1024.f), var = q * (1.f / 1024.f) - mean * mean; smean[C.tid] = mean; srstd[C.tid] = rsqrtf(var + EPS); }
        __syncthreads();
        for (int idx = C.tid; idx < 128 * 256; idx += 512) { const int j = idx >> 8, c = idx & 255, ch = g * 256 + c;
            lv[idx] = (bf2f(gv[(size_t)(t0 + j) * 1024 + ch]) - smean[j]) * srstd[j] * lng[ch] + lnb[ch]; }
        __syncthreads();
        for (int idx = C.tid; idx < 128 * 256; idx += 512) { const int i = idx >> 8, c = idx & 255; const float* wr = Wsp + ((size_t)g * 128 + i) * 128; float a = 0.f;
            for (int j = 0; j <= i; ++j) a += wr[j] * lv[j * 256 + c];
            a += bs[g * 128 + i];
            const size_t o = (size_t)(t0 + i) * 1024 + g * 256 + c; gm[o] = (bf16_t)f2bf(bf2f(gu[o]) * a); }
    }
}
__device__ __forceinline__ void ph_ret_naive(const Ctx& C) {
    const bf16_t* rq = WSP(bf16_t, WS_PROJ + P_RQ); const bf16_t* rk = WSP(bf16_t, WS_PROJ + P_RK); const bf16_t* rv = WSP(bf16_t, WS_PROJ + P_RV); const bf16_t* rg = WSP(bf16_t, WS_PROJ + P_RG); bf16_t* ret = WSP(bf16_t, WS_RET);
    LAS float* sq = (LAS float*)C.lds; LAS float* sa = sq + 256; LAS float* red = sa + 4096;
    for (int u = C.bid; u < NB * 4 * SEQ; u += C.G) {
        const int t = (SEQ - 1) - (u / 16), bh = u % 16, b = bh >> 2, h = bh & 3; const size_t rowb = (size_t)b * SEQ;
        const float lg2 = log2f(1.0f - exp2f(-5.0f - (float)h));
        __syncthreads();
        if (C.tid < 256) sq[C.tid] = bf2f(rq[(rowb + t) * 1024 + h * 256 + C.tid]);
        __syncthreads();
        for (int s = C.tid; s <= t; s += 512) { const u32x4* kp = (const u32x4*)(rk + (rowb + s) * 1024 + h * 256); float a = 0.f;
            for (int d8 = 0; d8 < 32; ++d8) { float f[8]; unpack8(kp[d8], f);
#pragma unroll
                for (int j = 0; j < 8; ++j) a += sq[d8 * 8 + j] * f[j]; }
            sa[s] = a * exp2f(lg2 * (float)(t - s)); }
        __syncthreads();
        float o = 0.f;
        if (C.tid < 256) { const bf16_t* vp = rv + rowb * 1024 + h * 256 + C.tid; for (int s = 0; s <= t; ++s) o += sa[s] * bf2f(vp[(size_t)s * 1024]); }
        const float ss = wave_sum(o * o, C.lane); if (C.lane == 0) red[C.wave] = ss;
        __syncthreads();
        if (C.tid < 256) { const float tot = red[0] + red[1] + red[2] + red[3]; const float y = o * rsqrtf(tot * (1.f / 256.f) + EPS);
            const size_t oi = (rowb + t) * 1024 + h * 256 + C.tid; ret[oi] = (bf16_t)f2bf(bf2f(rg[oi]) * y); }
    }
}
__device__ __forceinline__ void ph_idx_naive(const Ctx& C) {
    const bf16_t* iq = WSP(bf16_t, WS_PROJ + P_IQ); const bf16_t* ik = WSP(bf16_t, WS_PROJ + P_IK); const float* iw = WSP(float, WS_PROJ + P_IW); unsigned short* sel = WSP(unsigned short, WS_SEL);
    LAS float* sq = (LAS float*)C.lds; LAS float* sw = sq + 512; LAS float* sc = sw + 8;
    for (int u = C.bid; u < T; u += C.G) {
        const int tq = (T - 1) - u; const int b = tq >> 12, q = tq & (SEQ - 1), n = q + 1;
        __syncthreads();
        sq[C.tid] = bf2f(iq[(size_t)tq * 512 + C.tid]); if (C.tid < 8) sw[C.tid] = iw[(size_t)tq * 8 + C.tid];
        for (int r = C.tid; r < 256; r += 512) sel[(size_t)tq * 256 + r] = 0xFFFFu;
        __syncthreads();
        for (int s = C.tid; s < n; s += 512) { const u32x4* kp = (const u32x4*)(ik + ((size_t)b * SEQ + s) * 64); float kf[64];
#pragma unroll
            for (int d8 = 0; d8 < 8; ++d8) { float f[8]; unpack8(kp[d8], f);
#pragma unroll
                for (int j = 0; j < 8; ++j) kf[d8 * 8 + j] = f[j]; }
            float score = 0.f;
#pragma unroll 1
            for (int h = 0; h < 8; ++h) { float a = 0.f;
#pragma unroll
                for (int d = 0; d < 64; ++d) a += sq[h * 64 + d] * kf[d];
                score += sw[h] * fmaxf(a * 0.125f, 0.f); }
            sc[s] = score; }
        __syncthreads();
        for (int s = C.tid; s < n; s += 512) { const float v = sc[s]; int rank = 0;
            for (int s2 = 0; s2 < n; ++s2) { const float w = sc[s2]; rank += (w > v || (w == v && s2 < s)) ? 1 : 0; }
            if (rank < 256) sel[(size_t)tq * 256 + rank] = (unsigned short)s; }
    }
}
__device__ __forceinline__ void ph_att_naive(const Ctx& C) {
    const bf16_t* qabs = WSP(bf16_t, WS_QABS); const bf16_t* ckv = WSP(bf16_t, WS_CKV); const unsigned short* sel = WSP(unsigned short, WS_SEL); bf16_t* olat = WSP(bf16_t, WS_OLAT);
    LAS float* sqa = (LAS float*)C.lds; LAS float* sp = sqa + 2048; LAS int* ssel = (LAS int*)(sp + 2048);
    for (int tq = C.bid; tq < T; tq += C.G) {
        const int b = tq >> 12, q = tq & (SEQ - 1);
        __syncthreads();
        for (int i = C.tid; i < 2048; i += 512) sqa[i] = bf2f(qabs[(size_t)tq * 2048 + i]);
        if (C.tid < 256) { const int s = sel[(size_t)tq * 256 + C.tid]; ssel[C.tid] = (s <= q) ? s : -1; }
        __syncthreads();
        const int h = C.wave; float sv[4]; float mx = -INFINITY;
#pragma unroll
        for (int j = 0; j < 4; ++j) { const int k = C.lane + 64 * j, s = ssel[k]; float a = -INFINITY;
            if (s >= 0) { const u32x4* cp = (const u32x4*)(ckv + ((size_t)b * SEQ + s) * 256); a = 0.f;
                for (int c8 = 0; c8 < 32; ++c8) { float f[8]; unpack8(cp[c8], f);
#pragma unroll
                    for (int jj = 0; jj < 8; ++jj) a += sqa[h * 256 + c8 * 8 + jj] * f[jj]; } }
            sv[j] = a; mx = fmaxf(mx, a); }
        mx = wave_max(mx, C.lane); float sum = 0.f;
#pragma unroll
        for (int j = 0; j < 4; ++j) { sv[j] = __expf(sv[j] - mx); sum += sv[j]; }
        sum = wave_sum(sum, C.lane); const float inv = 1.f / sum;
#pragma unroll
        for (int j = 0; j < 4; ++j) sp[h * 256 + C.lane + 64 * j] = sv[j] * inv;
        __syncthreads();
        float o[4] = {0.f, 0.f, 0.f, 0.f};
        for (int k = 0; k < 256; ++k) { const int s = ssel[k]; if (s < 0) continue; const float p = sp[h * 256 + k]; const bf16_t* cp = ckv + ((size_t)b * SEQ + s) * 256 + C.lane;
#pragma unroll
            for (int j = 0; j < 4; ++j) o[j] += p * bf2f(cp[64 * j]); }
#pragma unroll
        for (int j = 0; j < 4; ++j) olat[(size_t)tq * 2048 + h * 256 + C.lane + 64 * j] = (bf16_t)f2bf(o[j]);
    }
}

typedef short v4i16_t __attribute__((ext_vector_type(4)));
__device__ __forceinline__ s16x4 tr_read(const LAS unsigned char* p) { return __builtin_bit_cast(s16x4, __builtin_amdgcn_ds_read_tr16_b64_v4i16((LAS v4i16_t*)p)); }
__device__ __forceinline__ bf16x8 tr_frag(const LAS unsigned char* X, int LDX, int rowA, int rowB, int n0, int lane) {
    const int q = (lane & 15) >> 2, p = lane & 3;
    const s16x4 lo = tr_read(X + (rowA + q) * LDX + (n0 + 4 * p) * 2), hi = tr_read(X + (rowB + q) * LDX + (n0 + 4 * p) * 2);
    return (bf16x8){lo[0], lo[1], lo[2], lo[3], hi[0], hi[1], hi[2], hi[3]};
}
constexpr int TLD = 544;
__device__ __forceinline__ bf16x8 as_bf16x8(u32x4 w) { return __builtin_bit_cast(bf16x8, w); }

__device__ __forceinline__ void ph_ret_kv(const Ctx& C) {
    const bf16_t* rk = WSP(bf16_t, WS_PROJ + P_RK); const bf16_t* rv = WSP(bf16_t, WS_PROJ + P_RV); bf16_t* KV = WSP(bf16_t, WS_KV);
    const LAS unsigned char* Vt = C.lds; const LAS unsigned char* Kt = C.lds + 128 * TLD;
    const int g = C.lane >> 4, fr = C.lane & 15, wr = C.wave >> 2, wc = C.wave & 3;
    for (int u = C.bid; u < 512; u += C.G) {
        const int n = u & 31, h = (u >> 5) & 3, b = u >> 7; const size_t row0 = (size_t)b * SEQ + n * 128;
        const float lg2 = log2f(1.0f - exp2f(-5.0f - (float)h));
        __syncthreads();
#pragma unroll
        for (int p = 0; p < 8; ++p) { const int idx = p * 512 + C.tid, row = idx >> 5, ch = idx & 31; const size_t go = (row0 + row) * 1024 + h * 256 + ch * 8;
            const u32x4 vv = *(const u32x4*)(rv + go); *(LAS u32x4*)(C.lds + row * TLD + ch * 16) = vv;
            float f[8]; unpack8(*(const u32x4*)(rk + go), f); const float z = exp2f(lg2 * (float)(127 - row));
            *(LAS u32x4*)(C.lds + 128 * TLD + row * TLD + ch * 16) = pack8((f32x4){f[0] * z, f[1] * z, f[2] * z, f[3] * z}, (f32x4){f[4] * z, f[5] * z, f[6] * z, f[7] * z}); }
        __syncthreads();
        f32x4 acc[8][4];
#pragma unroll
        for (int m = 0; m < 8; ++m)
#pragma unroll
            for (int nn = 0; nn < 4; ++nn) acc[m][nn] = (f32x4){0.f, 0.f, 0.f, 0.f};
#pragma unroll 1
        for (int ks = 0; ks < 4; ++ks) { bf16x8 Bv[4];
#pragma unroll
            for (int nn = 0; nn < 4; ++nn) Bv[nn] = tr_frag(Vt, TLD, 32 * ks + 8 * g, 32 * ks + 8 * g + 4, 64 * wc + 16 * nn, C.lane);
#pragma unroll
            for (int m = 0; m < 8; ++m) { const bf16x8 Ak = tr_frag(Kt, TLD, 32 * ks + 8 * g, 32 * ks + 8 * g + 4, 128 * wr + 16 * m, C.lane);
#pragma unroll
                for (int nn = 0; nn < 4; ++nn) acc[m][nn] = __builtin_amdgcn_mfma_f32_16x16x32_bf16(Ak, Bv[nn], acc[m][nn], 0, 0, 0); } }
        bf16_t* out = KV + (size_t)u * 65536;
#pragma unroll
        for (int m = 0; m < 8; ++m)
#pragma unroll
            for (int nn = 0; nn < 4; ++nn) { const int e = 64 * wc + 16 * nn + fr, d = 128 * wr + 16 * m + 4 * g; u32x2 w; w.x = cvt_pk_bf16(acc[m][nn][0], acc[m][nn][1]); w.y = cvt_pk_bf16(acc[m][nn][2], acc[m][nn][3]);
                *(u32x2*)(out + e * 256 + d) = w; }
    }
}
__device__ __forceinline__ void ph_ret_scan(const Ctx& C) {
    const bf16_t* KV = WSP(bf16_t, WS_KV); bf16_t* Rb = WSP(bf16_t, WS_R);
    for (int idx = C.bid * 512 + C.tid; idx < 16 * 8192; idx += C.G * 512) {
        const int bh = idx >> 13, off = (idx & 8191) * 8, h = bh & 3; const float gc = exp2f(128.0f * log2f(1.0f - exp2f(-5.0f - (float)h)));
        float R[8] = {0.f, 0.f, 0.f, 0.f, 0.f, 0.f, 0.f, 0.f};
#pragma unroll 4
        for (int n = 0; n < 32; ++n) { const size_t o = ((size_t)bh * 32 + n) * 65536 + off;
            *(u32x4*)(Rb + o) = pack8((f32x4){R[0], R[1], R[2], R[3]}, (f32x4){R[4], R[5], R[6], R[7]});
            float f[8]; unpack8(*(const u32x4*)(KV + o), f);
#pragma unroll
            for (int j = 0; j < 8; ++j) R[j] = R[j] * gc + f[j]; }
    }
}
__device__ __forceinline__ void ph_ret_out(const Ctx& C) {
    const bf16_t* rq = WSP(bf16_t, WS_PROJ + P_RQ); const bf16_t* rk = WSP(bf16_t, WS_PROJ + P_RK); const bf16_t* rv = WSP(bf16_t, WS_PROJ + P_RV); const bf16_t* rg = WSP(bf16_t, WS_PROJ + P_RG);
    const bf16_t* Rb = WSP(bf16_t, WS_R); bf16_t* ret = WSP(bf16_t, WS_RET);
    const LAS unsigned char* Vt = C.lds;
    const int g = C.lane >> 4, fr = C.lane & 15, w = C.wave;
    for (int u = C.bid; u < 512; u += C.G) {
        const int n = u & 31, h = (u >> 5) & 3, b = u >> 7; const size_t row0 = (size_t)b * SEQ + n * 128;
        const float lg2 = log2f(1.0f - exp2f(-5.0f - (float)h));
        __syncthreads();
#pragma unroll
        for (int p = 0; p < 8; ++p) { const int idx = p * 512 + C.tid, row = idx >> 5, ch = idx & 31;
            *(LAS u32x4*)(C.lds + row * TLD + ch * 16) = *(const u32x4*)(rv + (row0 + row) * 1024 + h * 256 + ch * 8); }
        __syncthreads();
        const int i = 16 * w + fr;
        bf16x8 Bq[8];
        { const bf16_t* qp = rq + (row0 + i) * 1024 + h * 256 + 8 * g;
#pragma unroll
          for (int ks = 0; ks < 8; ++ks) Bq[ks] = as_bf16x8(*(const u32x4*)(qp + 32 * ks)); }
        f32x4 acc[16];
#pragma unroll
        for (int nt = 0; nt < 16; ++nt) acc[nt] = (f32x4){0.f, 0.f, 0.f, 0.f};
        if (n > 0) {
            constexpr int R_OFF = 128 * TLD, RLD = 272;
#pragma unroll
            for (int dh = 0; dh < 2; ++dh) {
                if (dh) __syncthreads();
#pragma unroll
                for (int p = 0; p < 8; ++p) { const int idx = p * 512 + C.tid, e = idx >> 4, c16 = idx & 15;
                    *(LAS u32x4*)(C.lds + R_OFF + e * RLD + c16 * 16) = *(const u32x4*)(Rb + (size_t)u * 65536 + (size_t)e * 256 + dh * 128 + c16 * 8); }
                __syncthreads();
#pragma unroll
                for (int k4 = 0; k4 < 4; ++k4)
#pragma unroll
                    for (int nt = 0; nt < 16; ++nt) { const bf16x8 Ar = as_bf16x8(*(const LAS u32x4*)(C.lds + R_OFF + (16 * nt + fr) * RLD + (32 * k4 + 8 * g) * 2));
                        acc[nt] = __builtin_amdgcn_mfma_f32_16x16x32_bf16(Ar, Bq[4 * dh + k4], acc[nt], 0, 0, 0); }
            }
            const float xi = exp2f(lg2 * (float)(i + 1));
#pragma unroll
            for (int nt = 0; nt < 16; ++nt) acc[nt] = acc[nt] * xi;
        }
        f32x4 ST[8];
#pragma unroll
        for (int jt = 0; jt < 8; ++jt) { ST[jt] = (f32x4){0.f, 0.f, 0.f, 0.f};
            if (jt <= w) { const bf16_t* kp = rk + (row0 + 16 * jt + fr) * 1024 + h * 256 + 8 * g;
#pragma unroll
                for (int ks = 0; ks < 8; ++ks) { const bf16x8 Ak = as_bf16x8(*(const u32x4*)(kp + 32 * ks)); ST[jt] = __builtin_amdgcn_mfma_f32_16x16x32_bf16(Ak, Bq[ks], ST[jt], 0, 0, 0); }
#pragma unroll
                for (int r = 0; r < 4; ++r) { const int j = 16 * jt + 4 * g + r; ST[jt][r] = (i >= j) ? ST[jt][r] * exp2f(lg2 * (float)(i - j)) : 0.f; } } }
#pragma unroll
        for (int t = 0; t < 4; ++t) if (2 * t <= w) {
            u32x4 sw; sw.x = cvt_pk_bf16(ST[2 * t][0], ST[2 * t][1]); sw.y = cvt_pk_bf16(ST[2 * t][2], ST[2 * t][3]); sw.z = cvt_pk_bf16(ST[2 * t + 1][0], ST[2 * t + 1][1]); sw.w = cvt_pk_bf16(ST[2 * t + 1][2], ST[2 * t + 1][3]);
            const bf16x8 Bs = as_bf16x8(sw);
#pragma unroll
            for (int nt = 0; nt < 16; ++nt) { const bf16x8 Av = tr_frag(Vt, TLD, 32 * t + 4 * g, 32 * t + 16 + 4 * g, 16 * nt, C.lane); acc[nt] = __builtin_amdgcn_mfma_f32_16x16x32_bf16(Av, Bs, acc[nt], 0, 0, 0); } }
        float ss = 0.f;
#pragma unroll
        for (int nt = 0; nt < 16; ++nt) ss += acc[nt][0] * acc[nt][0] + acc[nt][1] * acc[nt][1] + acc[nt][2] * acc[nt][2] + acc[nt][3] * acc[nt][3];
        ss = quad_sum(ss);
        const float rstd = rsqrtf(ss * (1.f / 256.f) + EPS);
        const size_t ob = (row0 + i) * 1024 + h * 256 + 4 * g;
#pragma unroll
        for (int nt = 0; nt < 16; ++nt) { const u32x2 gw = *(const u32x2*)(rg + ob + 16 * nt); u32x2 o;
            o.x = cvt_pk_bf16(acc[nt][0] * rstd * bf2f(gw.x), acc[nt][1] * rstd * bf2f(gw.x >> 16)); o.y = cvt_pk_bf16(acc[nt][2] * rstd * bf2f(gw.y), acc[nt][3] * rstd * bf2f(gw.y >> 16));
            *(u32x2*)(ret + ob + 16 * nt) = o; }
    }
}
__device__ __forceinline__ void ph_gmlp(const Ctx& C, int l) {
    const bf16_t* gu = WSP(bf16_t, WS_PROJ + P_GU); const bf16_t* gv = WSP(bf16_t, WS_PROJ + P_GV); const float* stats = WSP(float, WS_STATS); bf16_t* gm = WSP(bf16_t, WS_GM);
    const float* lng = C.in[I_LNG] + l * 1024; const float* lnb = C.in[I_LNB] + l * 1024; const float* Wsp = C.in[I_WS] + (size_t)l * 4 * 128 * 128; const float* bs = C.in[I_BS] + l * 4 * 128;
    constexpr int WLD = 272, W_OFF = 128 * TLD, ST_OFF = W_OFF + 128 * WLD;
    const LAS unsigned char* Lt = C.lds; LAS float* sst = (LAS float*)(C.lds + ST_OFF);
    const int g4 = C.lane >> 4, fr = C.lane & 15, w = C.wave;
    for (int u = C.bid; u < 512; u += C.G) {
        const int gg = u & 3, bn = u >> 2, t0 = bn * 128;
        __syncthreads();
        if (C.tid < 128) { const float* sp = stats + (size_t)(t0 + C.tid) * 32; float s = 0.f, q = 0.f;
#pragma unroll
            for (int k = 0; k < 16; ++k) { s += sp[2 * k]; q += sp[2 * k + 1]; }
            const float mean = s * (1.f / 1024.f), var = q * (1.f / 1024.f) - mean * mean; sst[2 * C.tid] = mean; sst[2 * C.tid + 1] = rsqrtf(var + EPS); }
#pragma unroll
        for (int p = 0; p < 4; ++p) { const int idx = p * 512 + C.tid, i = idx >> 4, j8 = (idx & 15) * 8; const float* wp = Wsp + ((size_t)gg * 128 + i) * 128 + j8;
            f32x4 a = *(const f32x4*)wp, b2 = *(const f32x4*)(wp + 4);
#pragma unroll
            for (int j = 0; j < 4; ++j) { if (j8 + j > i) a[j] = 0.f; if (j8 + 4 + j > i) b2[j] = 0.f; }
            *(LAS u32x4*)(C.lds + W_OFF + i * WLD + j8 * 2) = pack8(a, b2); }
        __syncthreads();
#pragma unroll
        for (int p = 0; p < 8; ++p) { const int idx = p * 512 + C.tid, row = idx >> 5, ch = idx & 31, cg = gg * 256 + ch * 8;
            float f[8]; unpack8(*(const u32x4*)(gv + (size_t)(t0 + row) * 1024 + cg), f); const float mean = sst[2 * row], rstd = sst[2 * row + 1];
            const f32x4 g0 = *(const f32x4*)(lng + cg), g1 = *(const f32x4*)(lng + cg + 4), b0 = *(const f32x4*)(lnb + cg), b1 = *(const f32x4*)(lnb + cg + 4);
            f32x4 y0, y1;
#pragma unroll
            for (int j = 0; j < 4; ++j) { y0[j] = (f[j] - mean) * rstd * g0[j] + b0[j]; y1[j] = (f[4 + j] - mean) * rstd * g1[j] + b1[j]; }
            *(LAS u32x4*)(C.lds + row * TLD + ch * 16) = pack8(y0, y1); }
        __syncthreads();
        f32x4 acc[16];
#pragma unroll
        for (int nt = 0; nt < 16; ++nt) acc[nt] = (f32x4){0.f, 0.f, 0.f, 0.f};
#pragma unroll
        for (int ks = 0; ks < 4; ++ks) if (2 * ks <= w) {
            const bf16x8 Bw = as_bf16x8(*(const LAS u32x4*)(C.lds + W_OFF + (16 * w + fr) * WLD + (32 * ks + 8 * g4) * 2));
#pragma unroll
            for (int nt = 0; nt < 16; ++nt) { const bf16x8 Av = tr_frag(Lt, TLD, 32 * ks + 8 * g4, 32 * ks + 8 * g4 + 4, 16 * nt, C.lane); acc[nt] = __builtin_amdgcn_mfma_f32_16x16x32_bf16(Av, Bw, acc[nt], 0, 0, 0); } }
        const int i = 16 * w + fr; const float bias = bs[gg * 128 + i]; const size_t ob = (size_t)(t0 + i) * 1024 + gg * 256 + 4 * g4;
#pragma unroll
        for (int nt = 0; nt < 16; ++nt) { const u32x2 uw = *(const u32x2*)(gu + ob + 16 * nt); u32x2 o;
            o.x = cvt_pk_bf16((acc[nt][0] + bias) * bf2f(uw.x), (acc[nt][1] + bias) * bf2f(uw.x >> 16)); o.y = cvt_pk_bf16((acc[nt][2] + bias) * bf2f(uw.y), (acc[nt][3] + bias) * bf2f(uw.y >> 16));
            *(u32x2*)(gm + ob + 16 * nt) = o; }
    }
}

__device__ __forceinline__ void ph_idx(const Ctx& C) {
    const bf16_t* iq = WSP(bf16_t, WS_PROJ + P_IQ); const bf16_t* ik = WSP(bf16_t, WS_PROJ + P_IK); const float* iw = WSP(float, WS_PROJ + P_IW); unsigned short* sel = WSP(unsigned short, WS_SEL);
    LAS unsigned* sc = (LAS unsigned*)C.lds;
    const int lane = C.lane, n32 = lane & 31, hh = lane >> 5, w = C.wave;
    for (int u = C.bid; u < T / 8; u += C.G) {
        const int b = u & 3, q0 = (SEQ / 8 - 1 - (u >> 2)) * 8, tq0 = b * SEQ + q0, nk = q0 + 8, nkt = (nk + 31) >> 5;
        __syncthreads();
        bf16x8 Aq[2][4]; float wq[2][16];
        { const int r = n32, qi = 2 * ((r >> 2) & 1) + (r >> 4), hd = (r & 3) + 4 * ((r >> 3) & 1);
#pragma unroll
          for (int mt = 0; mt < 2; ++mt) { const bf16_t* qp = iq + (size_t)(tq0 + 4 * mt + qi) * 512 + hd * 64 + 8 * hh;
#pragma unroll
              for (int ks = 0; ks < 4; ++ks) Aq[mt][ks] = as_bf16x8(*(const u32x4*)(qp + 16 * ks));
#pragma unroll
              for (int a = 0; a < 2; ++a) { const float* wp = iw + (size_t)(tq0 + 4 * mt + 2 * hh + a) * 8; const f32x4 w0 = *(const f32x4*)wp, w1 = *(const f32x4*)(wp + 4);
#pragma unroll
                  for (int j = 0; j < 4; ++j) { wq[mt][8 * a + j] = w0[j] * 0.125f; wq[mt][8 * a + 4 + j] = w1[j] * 0.125f; } } } }
        u32x4 Bn[4];
        { const bf16_t* kp = ik + ((size_t)b * SEQ + 32 * (w < nkt ? w : 0) + n32) * 64 + 8 * hh;
#pragma unroll
          for (int ks = 0; ks < 4; ++ks) Bn[ks] = *(const u32x4*)(kp + 16 * ks); }
        for (int kt = w; kt < nkt; kt += 8) {
            bf16x8 Bk[4];
#pragma unroll
            for (int ks = 0; ks < 4; ++ks) Bk[ks] = as_bf16x8(Bn[ks]);
            { const int k2 = (kt + 8 < nkt) ? kt + 8 : kt; const bf16_t* kp = ik + ((size_t)b * SEQ + 32 * k2 + n32) * 64 + 8 * hh;
#pragma unroll
              for (int ks = 0; ks < 4; ++ks) Bn[ks] = *(const u32x4*)(kp + 16 * ks); }
#pragma unroll
            for (int mt = 0; mt < 2; ++mt) { f32x16 acc;
#pragma unroll
                for (int j = 0; j < 16; ++j) acc[j] = 0.f;
#pragma unroll
                for (int ks = 0; ks < 4; ++ks) acc = __builtin_amdgcn_mfma_f32_32x32x16_bf16(Aq[mt][ks], Bk[ks], acc, 0, 0, 0);
#pragma unroll
                for (int a = 0; a < 2; ++a) { float s = 0.f;
#pragma unroll
                    for (int rr = 0; rr < 8; ++rr) s += wq[mt][8 * a + rr] * fmaxf(acc[8 * a + rr], 0.f);
                    const int qu = 4 * mt + 2 * hh + a, key = 32 * kt + n32; unsigned bits = __builtin_bit_cast(unsigned, s);
                    bits = (bits & 0x80000000u) ? ~bits : (bits | 0x80000000u);
                    sc[qu * 4096 + key] = (key <= q0 + qu) ? bits : 0u; } }
        }
        __syncthreads();
        { const int q = q0 + w, n = q + 1; const size_t so = (size_t)(tq0 + w) * 256;
          if (n <= 256) { for (int r = lane; r < 256; r += 64) sel[so + r] = (r < n) ? (unsigned short)r : (unsigned short)0xFFFFu; }
          else {
            const int ni = (n + 63) >> 6;
            unsigned uu[64];
#pragma unroll
            for (int i = 0; i < 64; ++i) uu[i] = (i < ni && 64 * i + lane < nkt * 32) ? sc[w * 4096 + 64 * i + lane] : 0u;
            const int nact = (ni + 15) >> 4, below_const = (4 - nact) * 1024;
            LAS unsigned* slot = sc + w * 4096;
            unsigned Hp[32];
#pragma unroll
            for (int j = 0; j < 32; ++j) Hp[j] = (uu[2 * j] >> 16) | (uu[2 * j + 1] & 0xffff0000u);
#define IDX_BELOW(dst, cval) do { const unsigned cm1_ = ((cval) - 1u) * 0x00010001u; unsigned cnt_ = 0u; \
            _Pragma("unroll") for (int g4 = 0; g4 < 4; ++g4) if (g4 < nact) { _Pragma("unroll") for (int j = 8 * g4; j < 8 * g4 + 8; ++j) cnt_ = pk_below(Hp[j], cm1_, cnt_); } \
            (dst) = wave_total_dpp((int)((cnt_ & 0xffffu) + (cnt_ >> 16))) + below_const; } while (0)
            unsigned Th = 0u; int geT = 4096;
#pragma unroll 1
            for (int bit = 15; bit >= 0; --bit) { const unsigned c = Th | (1u << bit); int bl; IDX_BELOW(bl, c); if (4096 - bl >= 256) { Th = c; geT = 4096 - bl; } }
            int gtT = 0; if (Th != 0xffffu) { int bl; IDX_BELOW(bl, Th + 1u); gtT = 4096 - bl; }
            const int krem = 256 - gtT, nc = geT - gtT;
            unsigned Tv; int need; bool simple;
            if (nc <= 64) {
                int base = 0; const unsigned long long lt = (1ull << lane) - 1ull;
#pragma unroll
                for (int i = 0; i < 64; ++i) { const bool eq = (uu[i] >> 16) == Th; const unsigned long long em = __ballot(eq);
                    if (em) { if (eq) slot[base + __builtin_popcountll(em & lt)] = (uu[i] & 0xffffu) + 1u; base += __builtin_popcountll(em); } }
                asm volatile("s_waitcnt lgkmcnt(0)" ::: "memory");
                const unsigned tv = (lane < nc) ? slot[lane] : 0u;
                unsigned Tl = 0u;
#pragma unroll 1
                for (int bit = 16; bit >= 0; --bit) { const unsigned c = Tl | (1u << bit); if (__builtin_popcountll(__ballot(tv >= c)) >= krem) Tl = c; }
                need = krem - __builtin_popcountll(__ballot(tv > Tl)); simple = (need == __builtin_popcountll(__ballot(tv == Tl)));
                Tv = (Th << 16) | (Tl - 1u);
                asm volatile("s_waitcnt lgkmcnt(0)" ::: "memory");
            } else {
#pragma unroll
                for (int j = 0; j < 32; ++j) { const unsigned a = uu[2 * j], b2 = uu[2 * j + 1]; Hp[j] = (((a >> 16) == Th) ? (a & 0xffffu) : 0u) | (((b2 >> 16) == Th) ? (b2 << 16) : 0u); }
                unsigned Tl = 0u;
#pragma unroll 1
                for (int bit = 15; bit >= 0; --bit) { const unsigned c = Tl | (1u << bit); int bl; IDX_BELOW(bl, c); if (4096 - bl >= krem) Tl = c; }
                Tv = (Th << 16) | Tl; int cg = 0;
#pragma unroll
                for (int i = 0; i < 64; ++i) cg += (uu[i] > Tv) ? 1 : 0;
                need = 256 - wave_total_dpp(cg); simple = false;
            }
#undef IDX_BELOW
            if (simple) {
                int base = 0;
#pragma unroll
                for (int i = 0; i < 64; ++i) if (16 * (i >> 4) < ni) { const bool take = uu[i] >= Tv; const unsigned long long tm = __ballot(take);
                    const int pos = base + (int)__builtin_amdgcn_mbcnt_hi((unsigned)(tm >> 32), __builtin_amdgcn_mbcnt_lo((unsigned)tm, 0u));
                    if (take) sel[so + pos] = (unsigned short)(64 * i + lane);
                    base += __builtin_popcountll(tm); }
            } else {
                int base = 0, eqs = 0; const unsigned long long lt = (1ull << lane) - 1ull;
#pragma unroll
                for (int i = 0; i < 64; ++i) if (16 * (i >> 4) < ni) { const bool gt = uu[i] > Tv, eq = uu[i] == Tv; const unsigned long long em = __ballot(eq);
                    const bool take = gt || (eq && (eqs + __builtin_popcountll(em & lt)) < need); const unsigned long long tm = __ballot(take);
                    if (take) sel[so + base + __builtin_popcountll(tm & lt)] = (unsigned short)(64 * i + lane);
                    base += __builtin_popcountll(tm); eqs += __builtin_popcountll(em); }
            }
          } }
    }
}
__device__ __forceinline__ void ph_att(const Ctx& C) {
    const bf16_t* qabs = WSP(bf16_t, WS_QABS); const bf16_t* ckv = WSP(bf16_t, WS_CKV); const unsigned short* sel = WSP(unsigned short, WS_SEL); bf16_t* olat = WSP(bf16_t, WS_OLAT);
    const int lane = C.lane, g = lane >> 4, fr = lane & 15;
    LAS unsigned char* ch = C.lds + C.wave * (32 * TLD + 512);
    LAS unsigned short* ssel = (LAS unsigned short*)(ch + 32 * TLD);
    for (int tq = C.gw; tq < T; tq += C.NGW) {
        const int b = tq >> 12, q = tq & (SEQ - 1), nv = (q + 1) < 256 ? (q + 1) : 256, nch = (nv + 31) >> 5;
        const bf16_t* cb = ckv + (size_t)b * SEQ * 256;
        { u32x2 sv = *(const u32x2*)(sel + (size_t)tq * 256 + 4 * lane);
          unsigned s0 = sv.x & 0xffffu, s1 = sv.x >> 16, s2_ = sv.y & 0xffffu, s3 = sv.y >> 16;
          if (4 * lane + 0 >= nv) s0 = 0; if (4 * lane + 1 >= nv) s1 = 0; if (4 * lane + 2 >= nv) s2_ = 0; if (4 * lane + 3 >= nv) s3 = 0;
          *(LAS u32x2*)(ssel + 4 * lane) = (u32x2){s0 | (s1 << 16), s2_ | (s3 << 16)}; }
        bf16x8 Bqa[8];
        { const bf16_t* qp = qabs + (size_t)tq * 2048 + (fr & 7) * 256 + 8 * g;
#pragma unroll
          for (int ks = 0; ks < 8; ++ks) { u32x4 v = *(const u32x4*)(qp + 32 * ks); if (fr >= 8) v = (u32x4){0u, 0u, 0u, 0u}; Bqa[ks] = as_bf16x8(v); } }
        f32x4 acc[16];
#pragma unroll
        for (int nt = 0; nt < 16; ++nt) acc[nt] = (f32x4){0.f, 0.f, 0.f, 0.f};
        float mrun = -INFINITY, lrun = 0.f;
        asm volatile("s_waitcnt lgkmcnt(0)" ::: "memory");
        u32x4 G[16];
#pragma unroll
        for (int p = 0; p < 16; ++p) { const int s = ssel[2 * p + (lane >> 5)]; G[p] = *(const u32x4*)(cb + (size_t)s * 256 + (lane & 31) * 8); }
#pragma unroll 1
        for (int t = 0; t < nch; ++t) {
#pragma unroll
            for (int p = 0; p < 16; ++p) *(LAS u32x4*)(ch + (2 * p + (lane >> 5)) * TLD + (lane & 31) * 16) = G[p];
            if (t + 1 < nch) {
#pragma unroll
                for (int p = 0; p < 16; ++p) { const int s = ssel[32 * (t + 1) + 2 * p + (lane >> 5)]; G[p] = *(const u32x4*)(cb + (size_t)s * 256 + (lane & 31) * 8); } }
            asm volatile("s_waitcnt lgkmcnt(0)" ::: "memory");
            f32x4 s2[2];
#pragma unroll
            for (int hf = 0; hf < 2; ++hf) { s2[hf] = (f32x4){0.f, 0.f, 0.f, 0.f};
#pragma unroll
                for (int ks = 0; ks < 8; ++ks) { const bf16x8 Ac = as_bf16x8(*(const LAS u32x4*)(ch + (16 * hf + fr) * TLD + (32 * ks + 8 * g) * 2)); s2[hf] = __builtin_amdgcn_mfma_f32_16x16x32_bf16(Ac, Bqa[ks], s2[hf], 0, 0, 0); } }
            float cm = -INFINITY;
#pragma unroll
            for (int hf = 0; hf < 2; ++hf)
#pragma unroll
                for (int r = 0; r < 4; ++r) { const int ki = 32 * t + 16 * hf + 4 * g + r; if (ki >= nv) s2[hf][r] = -INFINITY; cm = fmaxf(cm, s2[hf][r]); }
            cm = quad_max(cm);
            const float mnew = fmaxf(mrun, cm), scale = __expf(mrun - mnew); float ps = 0.f;
#pragma unroll
            for (int hf = 0; hf < 2; ++hf)
#pragma unroll
                for (int r = 0; r < 4; ++r) { s2[hf][r] = __expf(s2[hf][r] - mnew); ps += s2[hf][r]; }
            ps = quad_sum(ps);
            lrun = lrun * scale + ps; mrun = mnew;
            u32x4 pw; pw.x = cvt_pk_bf16(s2[0][0], s2[0][1]); pw.y = cvt_pk_bf16(s2[0][2], s2[0][3]); pw.z = cvt_pk_bf16(s2[1][0], s2[1][1]); pw.w = cvt_pk_bf16(s2[1][2], s2[1][3]);
            const bf16x8 Bp = as_bf16x8(pw);
#pragma unroll
            for (int nt = 0; nt < 16; ++nt) { const bf16x8 Av = tr_frag(ch, TLD, 4 * g, 16 + 4 * g, 16 * nt, lane); acc[nt] = __builtin_amdgcn_mfma_f32_16x16x32_bf16(Av, Bp, acc[nt] * scale, 0, 0, 0); }
            asm volatile("s_waitcnt lgkmcnt(0)" ::: "memory");
        }
        const float inv = 1.0f / lrun;
        if (fr < 8) { bf16_t* op = olat + (size_t)tq * 2048 + fr * 256 + 4 * g;
#pragma unroll
            for (int nt = 0; nt < 16; ++nt) { u32x2 o; o.x = cvt_pk_bf16(acc[nt][0] * inv, acc[nt][1] * inv); o.y = cvt_pk_bf16(acc[nt][2] * inv, acc[nt][3] * inv); *(u32x2*)(op + 16 * nt) = o; } }
    }
}

__device__ __forceinline__ void ph_norm_hilo(const Ctx& C, const float* x, const float* g, bf16_t* H, bf16_t* HLO) {
    for (int row = C.gw; row < T; row += C.NGW) {
        const f32x4* xr = (const f32x4*)(x + (size_t)row * DM) + C.lane; f32x4 v[8]; float ss = 0.f;
#pragma unroll
        for (int j = 0; j < 8; ++j) { v[j] = xr[64 * j]; ss += v[j][0] * v[j][0] + v[j][1] * v[j][1] + v[j][2] * v[j][2] + v[j][3] * v[j][3]; }
        const float rstd = rsqrtf(wave_sum(ss, C.lane) * (1.f / DM) + EPS);
        u32x2* oh = (u32x2*)(H + (size_t)row * DM) + C.lane; u32x2* ol = (u32x2*)(HLO + (size_t)row * DM) + C.lane;
#pragma unroll
        for (int j = 0; j < 8; ++j) { const f32x4 gg = ((const f32x4*)g)[64 * j + C.lane]; const f32x4 y = v[j] * rstd * gg; u32x2 wh; wh.x = cvt_pk_bf16(y[0], y[1]); wh.y = cvt_pk_bf16(y[2], y[3]);
            u32x2 wl; wl.x = cvt_pk_bf16(y[0] - bf2f(wh.x), y[1] - bf2f(wh.x >> 16)); wl.y = cvt_pk_bf16(y[2] - bf2f(wh.y), y[3] - bf2f(wh.y >> 16)); oh[64 * j] = wh; ol[64 * j] = wl; }
    }
}
__device__ __forceinline__ void ph_route(const Ctx& C, int l) {
    const float* LOG = WSP(float, WS_OLAT); const float* bg = C.in[I_BGRP] + l * 4; const float* be = C.in[I_BEXP] + l * 32;
    int* rinfo = WSP(int, WS_ROUTE); float* rw = (float*)(rinfo + T * 4); unsigned* cnt = C.ctl + CW_CNT + l * 64;
    for (int t0 = C.gw * 8; t0 < T; t0 += C.NGW * 8) if (C.lane < 8) {
        const int t = t0 + C.lane;
        float lg[36];
#pragma unroll
        for (int c = 0; c < 36; ++c) lg[c] = 0.f;
#pragma unroll
        for (int part = 0; part < 4; ++part) { const f32x4* p = (const f32x4*)(LOG + ((size_t)part * T + t) * 128);
#pragma unroll
            for (int c4 = 0; c4 < 9; ++c4) { const f32x4 a = p[c4];
#pragma unroll
                for (int j = 0; j < 4; ++j) lg[4 * c4 + j] += a[j];
                if (part < 2) { const f32x4 b2 = p[16 + c4];
#pragma unroll
                    for (int j = 0; j < 4; ++j) lg[4 * c4 + j] += b2[j]; } } }
        int gsel = 0; float gmax = -INFINITY, gv4[4];
#pragma unroll
        for (int k = 0; k < 4; ++k) { gv4[k] = lg[k] + bg[k]; if (gv4[k] > gmax) { gmax = gv4[k]; gsel = k; } }
        float gden = 0.f;
#pragma unroll
        for (int k = 0; k < 4; ++k) gden += __expf(gv4[k] - gmax);
        const float pg = 1.f / gden;
        float el[8], emax = -INFINITY;
#pragma unroll
        for (int k = 0; k < 8; ++k) { const float v0 = lg[4 + k] + be[k], v1 = lg[12 + k] + be[8 + k], v2 = lg[20 + k] + be[16 + k], v3 = lg[28 + k] + be[24 + k];
            el[k] = gsel == 0 ? v0 : (gsel == 1 ? v1 : (gsel == 2 ? v2 : v3)); emax = fmaxf(emax, el[k]); }
        float eden = 0.f, ep[8];
#pragma unroll
        for (int k = 0; k < 8; ++k) { ep[k] = __expf(el[k] - emax); eden += ep[k]; }
        int i0 = 0; float p0 = -1.f;
#pragma unroll
        for (int k = 0; k < 8; ++k) { ep[k] = ep[k] / eden; if (ep[k] > p0) { p0 = ep[k]; i0 = k; } }
        int i1 = 0; float p1 = -1.f;
#pragma unroll
        for (int k = 0; k < 8; ++k) if (k != i0 && ep[k] > p1) { p1 = ep[k]; i1 = k; }
        const float den = p0 + p1; const int e0 = gsel * 8 + i0, e1 = gsel * 8 + i1;
        const unsigned r0 = atomicAdd(&cnt[e0], 1u), r1 = atomicAdd(&cnt[e1], 1u);
        int* list = WSP(int, WS_LIST); list[(size_t)e0 * T + r0] = t; list[(size_t)e1 * T + r1] = t;
        *(int4*)(rinfo + (size_t)t * 4) = make_int4(e0, e1, (int)r0, (int)r1); *(f32x2*)(rw + (size_t)t * 2) = (f32x2){pg * (p0 / den), pg * (p1 / den)};
    }
}
__device__ __forceinline__ int moe_offsets(const unsigned* cnt, int lane, int& total_tiles) {
    const int c = lane < NEXP ? (int)__hip_atomic_load(cnt + lane, __ATOMIC_RELAXED, __HIP_MEMORY_SCOPE_AGENT) : 0; const int tiles = (c + 255) >> 8;
    int incl = tiles;
#pragma unroll
    for (int o = 1; o < 64; o <<= 1) { const int t = shi(incl, (lane - o) & 63); if (lane >= o) incl += t; }
    total_tiles = shi(incl, 63);
    return (incl - tiles) * 256;
}
__device__ __forceinline__ void ph_permute(const Ctx& C, int l) {
    const bf16_t* H = WSP(bf16_t, WS_H); bf16_t* hperm = WSP(bf16_t, WS_PROJ + M_HPERM); int* rinfo = WSP(int, WS_ROUTE); int* rpos = rinfo + T * 6;
    int tt; const int myoff = moe_offsets(C.ctl + CW_CNT + l * 64 + CNT_BANK, C.lane, tt);
    for (int row = C.gw; row < T; row += C.NGW) {
        const int4 ri = *(const int4*)(rinfo + (size_t)row * 4);
        const int p0 = shi(myoff, ri.x) + ri.z, p1 = shi(myoff, ri.y) + ri.w;
        const u32x4* src = (const u32x4*)(H + (size_t)row * DM) + C.lane; u32x4* d0 = (u32x4*)(hperm + (size_t)p0 * DM) + C.lane; u32x4* d1 = (u32x4*)(hperm + (size_t)p1 * DM) + C.lane;
#pragma unroll
        for (int j = 0; j < 4; ++j) { const u32x4 w = src[64 * j]; d0[64 * j] = w; d1[64 * j] = w; }
        if (C.lane == 0) { rpos[(size_t)row * 2] = p0; rpos[(size_t)row * 2 + 1] = p1; }
    }
}
__device__ __forceinline__ int moe_table(const Ctx& C, int l) {
    __syncthreads();
    if (C.wave == 0) { int tt; const int off = moe_offsets(C.ctl + CW_CNT + l * 64 + CNT_BANK, C.lane, tt); const int nxt = shi(off, (C.lane + 1) & 63);
        if (C.lane < NEXP) { const int t0 = off >> 8, t1 = (C.lane == NEXP - 1) ? tt : (nxt >> 8); const int cn = (int)__hip_atomic_load(C.ctl + CW_CNT + l * 64 + CNT_BANK + C.lane, __ATOMIC_RELAXED, __HIP_MEMORY_SCOPE_AGENT);
            for (int t = t0; t < t1; ++t) { C.misc[16 + t] = C.lane; C.misc[176 + t] = (t - t0) * 256; C.misc[336 + t] = cn; } }
        if (C.lane == 0) C.misc[500] = tt; }
    __syncthreads();
    return C.misc[500];
}
__device__ __forceinline__ void ph_combine(const Ctx& C, int l, float* x, bool last, const float* gnext, bf16_t* Hn) {
    const bf16_t* yc = WSP(bf16_t, WS_PROJ + M_YC); const int* rinfo = WSP(int, WS_ROUTE); const float* rw = (const float*)(rinfo + T * 4); const int* rpos = rinfo + T * 6; const float* gf = C.in[I_FNG];
    int tt_; const int myoff = moe_offsets(C.ctl + CW_CNT + l * 64 + CNT_BANK, C.lane, tt_);
    for (int row = C.gw; row < T; row += C.NGW) {
        const int4 ri = *(const int4*)(rinfo + (size_t)row * 4); const int p0 = shi(myoff, ri.x) + ri.z, p1 = shi(myoff, ri.y) + ri.w; const float w0 = rw[(size_t)row * 2], w1 = rw[(size_t)row * 2 + 1];
        f32x4* xr = (f32x4*)(x + (size_t)row * DM) + C.lane; const u32x2* y0 = (const u32x2*)(yc + (size_t)p0 * DM) + C.lane; const u32x2* y1 = (const u32x2*)(yc + (size_t)p1 * DM) + C.lane;
        f32x4 v[8]; float ss = 0.f;
#pragma unroll
        for (int j = 0; j < 8; ++j) { const u32x2 a = y0[64 * j], b = y1[64 * j]; f32x4 xv = xr[64 * j];
            xv[0] += w0 * bf2f(a.x) + w1 * bf2f(b.x); xv[1] += w0 * bf2f(a.x >> 16) + w1 * bf2f(b.x >> 16); xv[2] += w0 * bf2f(a.y) + w1 * bf2f(b.y); xv[3] += w0 * bf2f(a.y >> 16) + w1 * bf2f(b.y >> 16);
            v[j] = xv; ss += xv[0] * xv[0] + xv[1] * xv[1] + xv[2] * xv[2] + xv[3] * xv[3]; }
        if (last) { const float rstd = rsqrtf(wave_sum(ss, C.lane) * (1.f / DM) + EPS);
#pragma unroll
            for (int j = 0; j < 8; ++j) xr[64 * j] = v[j] * rstd * ((const f32x4*)gf)[64 * j + C.lane]; }
        else { const float rstd = rsqrtf(wave_sum(ss, C.lane) * (1.f / DM) + EPS); u32x2* o = (u32x2*)(Hn + (size_t)row * DM) + C.lane;
#pragma unroll
            for (int j = 0; j < 8; ++j) { xr[64 * j] = v[j]; const f32x4 y = v[j] * rstd * ((const f32x4*)gnext)[64 * j + C.lane]; u32x2 w; w.x = cvt_pk_bf16(y[0], y[1]); w.y = cvt_pk_bf16(y[2], y[3]); o[64 * j] = w; } }
    }
}

constexpr int NPL = 14, NPHASES = 1 + DEPTH * NPL;
#if MK_PER_PHASE
#define IN(k) (lo <= (k) && (k) < hi)
#else
#define IN(k) true
#endif
#if MK_PER_PHASE
#define SEAM(k) do { } while (0)
#else
#define SEAM(k) xcd_barrier(bar)
#endif
template <int l> __device__ __forceinline__ void run_layer(Ctx& C, const XcdBarrier& bar, const int lo, const int hi) {
    unsigned char* wb = (unsigned char*)(C.ws + WS_W);
    bf16_t* H = WSP(bf16_t, WS_H);
        const int pb = 1 + l * NPL;
        const float* xin = (l == 0) ? C.in[I_X] : (const float*)C.out;
        if (l == 0) { if (IN(pb + 0)) { refresh(C); ph_rope(C); refresh(C); REP(1) ph_weights(C, 0); REP(2) ph_norm(C, xin, C.in[I_NMIX], H); }
            SEAM(pb + 0); }
        if (IN(pb + 1)) { refresh(C);
            pg8::Gemm g{H, (const bf16_t*)(wb + W_IN), DM, DM, DM}; pg8::OrderMN S; S.init(T / 256, NP / 256, C.G, C.bid, 256L * DM * 2, 256L * DM * 2);
            pg8::EpiInProj E{(unsigned char*)C.ws};
            REP(3) pg8::gemm_phase(C.lds, g, S, E);
        }
        SEAM(pb + 1);
        if (IN(pb + 2)) { refresh(C);
            ph_ckv(C, WSP(float, WS_PROJ + P_DC), C.in[I_KVG] + l * 256, WSP(bf16_t, WS_CKV));
            { pg8::Gemm g{WSP(bf16_t, WS_PROJ + P_DQ), (const bf16_t*)(wb + W_UK), 1024, 256, 256}; pg8::OrderMN S; S.init(T / 256, 8, C.G, C.bid, 256L * 1024 * 2, 256L * 256 * 2, 1, 256L * 2);
              pg8::EpiStore<0> E{WSP(bf16_t, WS_QABS), 2048, 0.08838834764831845f}; REP(4) pg8::gemm_phase(C.lds, g, S, E); }
            refresh(C);
#if NAIVE_GMLP
            ph_gmlp_naive(C, l);
#else
            REP(5) ph_gmlp(C, l);
#endif
            refresh(C);
#if !NAIVE_RET
            REP(6) ph_ret_kv(C);
#endif
            refresh(C);
#if NAIVE_IDX
            ph_idx_naive(C);
#else
            REP(7) ph_idx(C);
#endif
        }
        SEAM(pb + 2);
        if (IN(pb + 3)) { refresh(C);
#if !NAIVE_RET
            REP(8) ph_ret_scan(C);
#endif
#if NAIVE_ATT
            ph_att_naive(C);
#else
            REP(9) ph_att(C);
#endif
        }
        SEAM(pb + 3);
        if (IN(pb + 4)) { refresh(C);
            { pg8::Gemm g{WSP(bf16_t, WS_OLAT), (const bf16_t*)(wb + W_UV), 2048, 512, 512}; pg8::OrderMN S; S.init(T / 256, 4, C.G, C.bid, 256L * 2048 * 2, 256L * 512 * 2, 0, 512L * 2);
              pg8::EpiStore<0> E{WSP(bf16_t, WS_DS), 1024, 1.0f}; REP(10) pg8::gemm_phase(C.lds, g, S, E); }
#if NAIVE_RET
            ph_ret_naive(C);
#else
            REP(11) ph_ret_out(C);
#endif
        }
        SEAM(pb + 4);
        if (IN(pb + 5)) { refresh(C);
            pg8::Gemm g{WSP(bf16_t, WS_RET), (const bf16_t*)(wb + W_RET), 1024, 1024, 1024}; pg8::OrderBranch S; S.base.init(T / 256, 8, C.G, C.bid, 256L * 1024 * 2, 256L * 1024 * 2); S.astride = 32L << 20; S.bstride = 4L << 20;
            pg8::EpiBranch E{WSP(bf16_t, WS_PROJ + P_GA), H}; REP(12) pg8::gemm_phase(C.lds, g, S, E);
        }
        SEAM(pb + 5);
        if (IN(pb + 6)) { refresh(C);
            pg8::Gemm g{H, (const bf16_t*)(wb + W_OUT), DM, DM, DM}; pg8::OrderMN S; S.init(T / 256, 8, C.G, C.bid, 256L * DM * 2, 256L * DM * 2);
            pg8::EpiResid E{xin, C.out}; for (int rep_ = 0; rep_ <= ((l == 0) ? ((PROBE_MASK >> 17) & 1) : 0); ++rep_) pg8::gemm_phase(C.lds, g, S, E);
        }
        SEAM(pb + 6);
        if (IN(pb + 7)) { refresh(C); ph_norm_hilo(C, C.out, C.in[I_NFFN] + l * DM, H, WSP(bf16_t, WS_QABS)); }
        SEAM(pb + 7);
        if (IN(pb + 8)) { refresh(C);
            pg8::Gemm g{H, (const bf16_t*)(wb + W_RT), DM, DM, 1024}; pg8::OrderRouter S{C.G, C.bid, (long)(WS_QABS - WS_H)};
            pg8::EpiRouter E{WSP(float, WS_OLAT)}; pg8::gemm_phase(C.lds, g, S, E);
        }
        SEAM(pb + 8);
        if (IN(pb + 9)) { refresh(C); ph_route(C, l); }
        SEAM(pb + 9);
        if (IN(pb + 11)) { refresh(C);
            const int Mt = moe_table(C, l);
            pg8::Gemm g{H, (const bf16_t*)(wb + W_13), DM, DM, DM};
            pg8::OrderMoE S{C.misc + 16, Mt, 4, C.G, C.bid, 256L * DM * 2, 256L * DM * 2, 1024L * DM * 2, WSP(int, WS_LIST)};
            pg8::EpiMoeUp E{WSP(bf16_t, WS_PROJ + M_HID)}; REP(14) pg8::gemm_phase<pg8::EpiMoeUp, pg8::OrderMoE, true>(C.lds, g, S, E);
        }
        SEAM(pb + 11);
        if (IN(pb + 12)) { refresh(C);
            const int Mt = moe_table(C, l);
            pg8::Gemm g{WSP(bf16_t, WS_PROJ + M_HID), (const bf16_t*)(wb + W_2), FF, FF, FF};
            pg8::OrderMoE S{C.misc + 16, Mt, 8, C.G, C.bid, 256L * FF * 2, 256L * FF * 2, (long)DM * FF * 2, nullptr};
            pg8::EpiStore<0> E{WSP(bf16_t, WS_PROJ + M_YC), DM, 1.0f}; REP(15) pg8::gemm_phase(C.lds, g, S, E);
        }
        SEAM(pb + 12);
        if (IN(pb + 13)) { refresh(C); ph_combine(C, l, C.out, l == DEPTH - 1, C.in[I_NMIX] + (l + 1 < DEPTH ? l + 1 : l) * DM, H); if (l + 1 < DEPTH) { refresh(C); ph_weights(C, l + 1); } }
        if (l + 1 < DEPTH) SEAM(pb + 13);

}
__global__ void __launch_bounds__(512, 2) mk_fwd(Args a) {
    extern __shared__ __attribute__((aligned(16))) unsigned char lds_raw[];
    Ctx C;
    C.lds = (LAS unsigned char*)lds_raw; C.misc = (volatile LAS int*)(C.lds + MISC_OFF); C.ws = (GAS unsigned char*)a.ws; C.ctl = (unsigned*)(a.ws + WS_CTL);
    C.tid = threadIdx.x; C.lane = C.tid & 63; C.wave = __builtin_amdgcn_readfirstlane(C.tid >> 6); C.G = gridDim.x; C.bid = blockIdx.x;
    C.gw = C.bid * 8 + C.wave; C.NGW = C.G * 8; C.in = a.in; C.out = a.out;
    for (int i = C.tid; i < 1024; i += 512) C.misc[i] = 0;
    __syncthreads();
#if MK_PER_PHASE
    XcdBarrier bar; bar.bar = C.ctl + CW_BAR; bar.x = 0; bar.st = (volatile LAS unsigned*)C.misc;
#else
    XcdBarrier bar = xcd_barrier_post(C.ctl + CW_BAR, (volatile LAS unsigned*)C.misc);
#endif
    const int lo = a.ph_lo, hi = a.ph_hi;
    run_layer<0>(C, bar, lo, hi);
    run_layer<1>(C, bar, lo, hi);
}

extern "C" void kernel_launch(void* const* d_in, const int* in_sizes, int n_in, void* d_out, int out_size, void* d_ws, size_t ws_size, hipStream_t stream) {
    static int grid = 0;
    if (grid == 0) {
        if (n_in != 23 || out_size != T * DM || ws_size < WS_END) { fprintf(stderr, "kernel_launch: unexpected shapes / workspace (n_in %d out %d ws %zu need %zu)\n", n_in, out_size, ws_size, (size_t)WS_END); grid = -1; return; }
        int dev = 0, cus = 0, per_cu = 0;
        if (hipGetDevice(&dev) != hipSuccess || hipDeviceGetAttribute(&cus, hipDeviceAttributeMultiprocessorCount, dev) != hipSuccess) { grid = -1; return; }
        if (hipFuncSetAttribute((const void*)mk_fwd, hipFuncAttributeMaxDynamicSharedMemorySize, LDS_BYTES) != hipSuccess) { fprintf(stderr, "kernel_launch: hipFuncSetAttribute failed\n"); grid = -1; return; }
        if (hipOccupancyMaxActiveBlocksPerMultiprocessor(&per_cu, (const void*)mk_fwd, 512, LDS_BYTES) != hipSuccess || per_cu < 1) { fprintf(stderr, "kernel_launch: occupancy query says %d\n", per_cu); (void)hipGetLastError(); grid = -1; return; }
        grid = cus;
    }
    if (grid < 0) return;
    (void)hipMemsetAsync((char*)d_ws + WS_CTL, 0, CTL_BYTES, stream);
    Args a{};
    for (int i = 0; i < 23; ++i) a.in[i] = (const float*)d_in[i];
    a.out = (float*)d_out; a.ws = (unsigned char*)d_ws;
#if MK_PER_PHASE
    for (int p = 0; p < NPHASES; ++p) { a.ph_lo = p; a.ph_hi = p + 1; hipLaunchKernelGGL(mk_fwd, dim3(grid), dim3(512), LDS_BYTES, stream, a); }
#else
    a.ph_lo = 0; a.ph_hi = NPHASES;
    hipLaunchKernelGGL(mk_fwd, dim3(grid), dim3(512), LDS_BYTES, stream, a);
#endif
}
```

```cpp
#include <hip/hip_runtime.h>
#include <stdint.h>
#include <stdio.h>

#ifndef MK_PER_PHASE
#define MK_PER_PHASE 0
#endif
#ifndef PROBE_MASK
#define PROBE_MASK 0
#endif
#define CNT_BANK (((PROBE_MASK >> 16) & 1) * 128)
#define REP(k) for (int rep_ = 0; rep_ <= ((PROBE_MASK >> (k)) & 1); ++rep_)
#ifndef NAIVE_RET
#define NAIVE_RET 0
#endif
#ifndef NAIVE_GMLP
#define NAIVE_GMLP 0
#endif
#ifndef NAIVE_IDX
#define NAIVE_IDX 0
#endif
#ifndef NAIVE_ATT
#define NAIVE_ATT 0
#endif

#define LAS __attribute__((address_space(3)))
#define GAS __attribute__((address_space(1)))
typedef unsigned short bf16_t;
typedef short bf16x8 __attribute__((ext_vector_type(8)));
typedef short s16x4 __attribute__((ext_vector_type(4)));
typedef float f32x4 __attribute__((ext_vector_type(4)));
typedef float f32x2 __attribute__((ext_vector_type(2)));
typedef float f32x16 __attribute__((ext_vector_type(16)));
typedef unsigned u32x4 __attribute__((ext_vector_type(4)));
typedef unsigned u32x2 __attribute__((ext_vector_type(2)));

constexpr int DM = 2048, NB = 4, SEQ = 4096, T = NB * SEQ, DEPTH = 2;
constexpr int INW = 14152, NP = 14336;
constexpr int GATE_SRC0 = 8008, GATE_DST0 = 8192;
constexpr int NEXP = 32, FF = 512, MOE_ROWS = 40960;
constexpr float EPS = 1e-6f;

constexpr size_t MiB = 1u << 20;
constexpr size_t WS_CTL = 0, CTL_BYTES = 1 * MiB;
constexpr size_t WS_ROPE = 1 * MiB;
constexpr size_t WS_W = 5 * MiB;
constexpr size_t W_IN = 0, W_RET = 56 * MiB, W_GM = 60 * MiB, W_DS = 64 * MiB, W_OUT = 68 * MiB, W_13 = 76 * MiB, W_2 = 204 * MiB, W_UK = 268 * MiB, W_UV = 269 * MiB, W_RT = 270 * MiB  , W_END = 271 * MiB;
constexpr size_t WS_H = WS_W + W_END;
constexpr size_t WS_PROJ = WS_H + 64 * MiB;
constexpr size_t P_RQ = 0, P_RK = 32 * MiB, P_RV = 64 * MiB, P_RG = 96 * MiB, P_GU = 128 * MiB, P_GV = 160 * MiB, P_DQ = 192 * MiB, P_DC = 224 * MiB  ,
                 P_IQ = 240 * MiB  , P_IK = 256 * MiB  , P_IW = 258 * MiB  , P_GA = 260 * MiB, P_GB = 324 * MiB, P_GC = 388 * MiB, P_END = 452 * MiB;
constexpr size_t M_HPERM = 0, M_HID = 160 * MiB, M_YC = 200 * MiB;
constexpr size_t WS_KV = WS_PROJ + P_END;
constexpr size_t WS_R = WS_KV + 64 * MiB;
constexpr size_t WS_QABS = WS_R + 64 * MiB;
constexpr size_t WS_OLAT = WS_QABS + 64 * MiB;
constexpr size_t WS_RET = WS_OLAT + 64 * MiB;
constexpr size_t WS_GM = WS_RET + 32 * MiB, WS_DS = WS_GM + 32 * MiB;
constexpr size_t WS_SEL = WS_DS + 32 * MiB;
constexpr size_t WS_CKV = WS_SEL + 8 * MiB;
constexpr size_t WS_STATS = WS_CKV + 8 * MiB;
constexpr size_t WS_ROUTE = WS_STATS + 2 * MiB;
constexpr size_t WS_LIST = WS_ROUTE + 1 * MiB;
constexpr size_t WS_END = WS_LIST + 2 * MiB;
constexpr int CW_BAR = 4096, CW_CNT = 16384;

constexpr int LDS_BYTES = 147456, MISC_OFF = LDS_BYTES - 4096;

__device__ __forceinline__ unsigned f2bf(float f) { unsigned u = __builtin_bit_cast(unsigned, f); return (u + 0x7fffu + ((u >> 16) & 1u)) >> 16; }
__device__ __forceinline__ float bf2f(unsigned b) { return __builtin_bit_cast(float, (b & 0xffffu) << 16); }
typedef __bf16 bf16x2_t __attribute__((ext_vector_type(2)));
__device__ __forceinline__ unsigned cvt_pk_bf16(float lo, float hi) { const f32x2 v = {lo, hi}; return __builtin_bit_cast(unsigned, __builtin_convertvector(v, bf16x2_t)); }
__device__ __forceinline__ float shx(float v, int k, int lane) { return __builtin_bit_cast(float, __builtin_amdgcn_ds_bpermute((lane ^ k) << 2, __builtin_bit_cast(int, v))); }
__device__ __forceinline__ void swap32_(float& a, float& b) { asm volatile("v_nop\n\tv_nop\n\tv_permlane32_swap_b32 %0, %1\n\tv_nop" : "+v"(a), "+v"(b)); }
__device__ __forceinline__ void swap16_(float& a, float& b) { asm volatile("v_nop\n\tv_nop\n\tv_permlane16_swap_b32 %0, %1\n\tv_nop" : "+v"(a), "+v"(b)); }
__device__ __forceinline__ float quad_sum(float v) { float a = v, b = v; swap32_(a, b); v = a + b; a = v; b = v; swap16_(a, b); return a + b; }
__device__ __forceinline__ float quad_max(float v) { float a = v, b = v; swap32_(a, b); v = fmaxf(a, b); a = v; b = v; swap16_(a, b); return fmaxf(a, b); }
__device__ __forceinline__ int shi(int v, int src) { return __builtin_amdgcn_ds_bpermute(src << 2, v); }
typedef unsigned short u16x2 __attribute__((ext_vector_type(2)));
__device__ __forceinline__ unsigned pk_below(unsigned x, unsigned cm1, unsigned cnt) {
    u16x2 r = __builtin_elementwise_sub_sat(__builtin_bit_cast(u16x2, x), __builtin_bit_cast(u16x2, cm1)); unsigned ru = __builtin_bit_cast(unsigned, r); asm volatile("" : "+v"(ru));
    r = __builtin_elementwise_sub_sat((u16x2){1, 1}, __builtin_bit_cast(u16x2, ru)); ru = __builtin_bit_cast(unsigned, r); asm volatile("" : "+v"(ru));
    return __builtin_bit_cast(unsigned, (u16x2)(__builtin_bit_cast(u16x2, cnt) + __builtin_bit_cast(u16x2, ru)));
}
__device__ __forceinline__ int wave_total_dpp(int x) {
    x += __builtin_amdgcn_update_dpp(0, x, 0x111, 0xf, 0xf, false);
    x += __builtin_amdgcn_update_dpp(0, x, 0x112, 0xf, 0xf, false);
    x += __builtin_amdgcn_update_dpp(0, x, 0x114, 0xf, 0xf, false);
    x += __builtin_amdgcn_update_dpp(0, x, 0x118, 0xf, 0xf, false);
    x += __builtin_amdgcn_update_dpp(0, x, 0x142, 0xa, 0xf, false);
    x += __builtin_amdgcn_update_dpp(0, x, 0x143, 0xc, 0xf, false);
    return __builtin_amdgcn_readlane(x, 63);
}
__device__ __forceinline__ float wave_sum(float v, int lane) {
#pragma unroll
    for (int o = 1; o < 64; o <<= 1) v += shx(v, o, lane);
    return v;
}
__device__ __forceinline__ float wave_max(float v, int lane) {
#pragma unroll
    for (int o = 1; o < 64; o <<= 1) v = fmaxf(v, shx(v, o, lane));
    return v;
}
__device__ __forceinline__ float sigmoidf_(float x) { return __builtin_amdgcn_rcpf(1.0f + __builtin_amdgcn_exp2f(x * -1.44269504089f)); }
__device__ __forceinline__ float siluf_(float x) { return x * sigmoidf_(x); }
__device__ __forceinline__ f32x2 gelu_pk(f32x2 v) {
    const f32x2 av = __builtin_elementwise_abs(v), d = av * 0.2316418882f + 1.0f;
    f32x2 t; t.x = __builtin_amdgcn_rcpf(d.x); t.y = __builtin_amdgcn_rcpf(d.y);
    f32x2 q = t * 0.5307027145f + (-0.7265760135f); q = q * t + 0.7107068705f; q = q * t + (-0.142248368f); q = q * t + 0.127414796f; q = q * t;
    const f32x2 s = (v * v) * (-0.72134752044f);
    f32x2 e; e.x = __builtin_amdgcn_exp2f(s.x); e.y = __builtin_amdgcn_exp2f(s.y);
    const f32x2 m = v * (q * e), r = v - m;
    f32x2 o; o.x = v.x < 0.f ? m.x : r.x; o.y = v.y < 0.f ? m.y : r.y; return o;
}
template <int ACT> __device__ __forceinline__ f32x4 act4(f32x4 v) {
    if (ACT == 1) { f32x2 a = gelu_pk((f32x2){v[0], v[1]}), b = gelu_pk((f32x2){v[2], v[3]}); return (f32x4){a.x, a.y, b.x, b.y}; }
    if (ACT == 2) return (f32x4){siluf_(v[0]), siluf_(v[1]), siluf_(v[2]), siluf_(v[3])};
    if (ACT == 3) return (f32x4){sigmoidf_(v[0]), sigmoidf_(v[1]), sigmoidf_(v[2]), sigmoidf_(v[3])};
    return v;
}
__device__ __forceinline__ u32x4 pack8(f32x4 a, f32x4 b) { u32x4 w; w.x = cvt_pk_bf16(a[0], a[1]); w.y = cvt_pk_bf16(a[2], a[3]); w.z = cvt_pk_bf16(b[0], b[1]); w.w = cvt_pk_bf16(b[2], b[3]); return w; }
__device__ __forceinline__ void unpack8(u32x4 w, float (&f)[8]) {
    f[0] = bf2f(w.x); f[1] = bf2f(w.x >> 16); f[2] = bf2f(w.y); f[3] = bf2f(w.y >> 16); f[4] = bf2f(w.z); f[5] = bf2f(w.z >> 16); f[6] = bf2f(w.w); f[7] = bf2f(w.w >> 16);
}

#define XB_TMO      128
#define XB_XCNT(j)  (256  + 64 * (j))
#define XB_XSUB(j)  (1280 + 64 * (j))
#define XB_XGEN(j)  (2304 + 64 * (j))
#define XB_TOP      3328
#define XB_TOPGEN   3392
#define XCD_BAR_WORDS 3456
#define XB_SPIN_CAP (1u << 20)
__device__ __forceinline__ unsigned xb_ld(unsigned* p)              { return __hip_atomic_load(p, __ATOMIC_RELAXED, __HIP_MEMORY_SCOPE_AGENT); }
__device__ __forceinline__ unsigned xb_add(unsigned* p, unsigned v) { return __hip_atomic_fetch_add(p, v, __ATOMIC_RELAXED, __HIP_MEMORY_SCOPE_AGENT); }
__device__ __forceinline__ unsigned xb_xcc_id() { return (unsigned)__builtin_amdgcn_s_getreg((3 << 11) | 20) & 0xFu; }
#define XB_SPIN(cond, bar) do { unsigned _sp = 0; while (cond) { __builtin_amdgcn_s_sleep(1); \
    if ((++_sp & 255u) == 0u) { if (xb_ld(&(bar)[XB_TMO])) break; if (_sp > XB_SPIN_CAP) { atomicAdd(&(bar)[XB_TMO], 1u); break; } } } } while (0)
struct XcdBarrier { unsigned* bar; unsigned x; volatile LAS unsigned* st; };
__device__ __forceinline__ XcdBarrier xcd_barrier_post(unsigned* bar, volatile LAS unsigned* st) {
    XcdBarrier b; b.bar = bar; b.x = xb_xcc_id(); b.st = st;
    if (threadIdx.x == 0) (void)xb_add(&bar[XB_XCNT(b.x)], 1u);
    return b;
}
__device__ __forceinline__ void xcd_barrier_complete(unsigned* bar, unsigned x, unsigned& nloc, unsigned& nx) {
    const unsigned G = gridDim.x * gridDim.y * gridDim.z;
    unsigned sum, cnt, mine, sp = 0u;
    for (;;) {
        sum = 0u; cnt = 0u; mine = 0u;
#pragma unroll
        for (unsigned j = 0; j < 16; ++j) { const unsigned c = xb_ld(&bar[XB_XCNT(j)]); sum += c; cnt += (c > 0u) ? 1u : 0u; mine = (j == x) ? c : mine; }
        if (sum == G) break;
        __builtin_amdgcn_s_sleep(1);
        if ((++sp & 255u) == 0u) { if (xb_ld(&bar[XB_TMO])) break; if (sp > XB_SPIN_CAP) { atomicAdd(&bar[XB_TMO], 1u); break; } }
    }
    nloc = mine > 0u ? mine : 1u; nx = cnt > 0u ? cnt : 1u;
}
__device__ __forceinline__ void xcd_barrier(const XcdBarrier& b) {
    asm volatile("s_waitcnt vmcnt(0)" ::: "memory");
    __syncthreads();
    if (threadIdx.x == 0) {
        unsigned* bar = b.bar; asm volatile("" : "+s"(bar));
        __builtin_amdgcn_s_waitcnt(0);
        unsigned nloc = b.st[0], nx = b.st[1];
        if (nloc == 0u) { xcd_barrier_complete(bar, b.x, nloc, nx); b.st[0] = nloc; b.st[1] = nx; }
        const unsigned old = xb_add(&bar[XB_XSUB(b.x)], 1u);
        const unsigned gen = old / nloc;
        if (old + 1u == (gen + 1u) * nloc) {
            __builtin_amdgcn_fence(__ATOMIC_RELEASE, "agent");
            asm volatile("s_waitcnt vmcnt(0)" ::: "memory");
            const unsigned og = xb_add(&bar[XB_TOP], 1u);
            const unsigned tg = og / nx;
            if (og + 1u == (tg + 1u) * nx) xb_add(&bar[XB_TOPGEN], 1u);
            else XB_SPIN(xb_ld(&bar[XB_TOPGEN]) == tg, bar);
            __builtin_amdgcn_fence(__ATOMIC_ACQUIRE, "agent");
            xb_add(&bar[XB_XGEN(b.x)], 1u);
            asm volatile("s_waitcnt vmcnt(0)" ::: "memory");
        } else {
            XB_SPIN(xb_ld(&bar[XB_XGEN(b.x)]) == gen, bar);
            __builtin_amdgcn_fence(__ATOMIC_ACQUIRE, "agent");
            asm volatile("s_waitcnt vmcnt(0)" ::: "memory");
        }
    }
    __syncthreads();
}

namespace pg8 {
constexpr int BM = 256, BK = 64, HALF = 128, HTB = HALF * BK * 2, STAGE_BYTES = 8 * HTB, NXCD = 8, WGM = 8;
__host__ __device__ __forceinline__ int lds_byte(int r, int c) { const int st = (r >> 4) * 2 + (c >> 5), rr = r & 15, cc = c & 31, ob = rr * 64 + cc * 2; return st * 1024 + (ob ^ (((ob >> 9) & 1) << 5)); }
__host__ __device__ __forceinline__ void stage_rc(int b, int& R, int& C) { const int st = b / 1024, sb = b % 1024, swz = sb ^ (((sb >> 9) & 1) << 5); R = (st >> 1) * 16 + swz / 64; C = (st & 1) * 32 + (swz % 64) / 2; }
__host__ __device__ __forceinline__ int perm32(int rho) { const int n = rho >> 4, i = rho & 15; return 8 * (i >> 2) + 4 * n + (i & 3); }

struct Unit { int pm, pn; long aoff, boff; };
struct Gemm { const bf16_t* A; const bf16_t* Bt; int lda, ldb, K; };

struct OrderMN {
    int nM, nN, nwg, G, c, ashift; long astep, bstep, abytes;
    __device__ __forceinline__ int gather_row(const Unit&, int) const { return 0; }
    __device__ void init(int nM_, int nN_, int G_, int c_, long astep_, long bstep_, int ashift_ = 0, long abytes_ = 0) { nM = nM_; nN = nN_; nwg = nM * nN; G = G_; c = c_; astep = astep_; bstep = bstep_; ashift = ashift_; abytes = abytes_; }
    __device__ bool next(int i, Unit& u) const {
        const long L = (long)i * G + c; if (L >= nwg) return false;
        int wgid = (int)L; { const int q = nwg / NXCD, r = nwg % NXCD, xcd = wgid % NXCD, off = wgid / NXCD; wgid = (xcd < r ? xcd * (q + 1) : r * (q + 1) + (xcd - r) * q) + off; }
        const int nig = WGM * nN, gid = wgid / nig, fm = gid * WGM, gsz = (nM - fm) < WGM ? (nM - fm) : WGM;
        u.pm = fm + ((wgid % nig) % gsz); u.pn = (wgid % nig) / gsz;
        u.aoff = (long)u.pm * astep + (long)(u.pn >> ashift) * abytes; u.boff = (long)u.pn * bstep; return true;
    }
};
struct OrderMoE {
    const volatile LAS int* te; int Mt, nN, G, c; long astep, bstep, estep; const int* list;
    __device__ __forceinline__ int gather_row(const Unit& u, int r) const { const int e = te[u.pm], rb = te[160 + u.pm] + r; return rb < te[320 + u.pm] ? list[(size_t)e * T + rb] : 0; }
    __device__ bool next(int i, Unit& u) const {
        const long L = (long)i * G + c; if (L >= (long)Mt * nN) return false;
        u.pm = (int)(L / nN); u.pn = (int)(L % nN);
        u.aoff = (long)u.pm * astep; u.boff = (long)te[u.pm] * estep + (long)u.pn * bstep; return true;
    }
};

template <class Epi, class Sched, bool GATH = false, bool KEEPACC = false, bool ALIGN_EPI = true, bool SP2 = true>
__device__ __forceinline__ void gemm_phase(LAS unsigned char* lds, const Gemm g, const Sched& S, const Epi& E) {
    int tid_ = threadIdx.x; asm volatile("" : "+v"(tid_));
    const GAS bf16_t* gA = (const GAS bf16_t*)g.A; const GAS bf16_t* gB = (const GAS bf16_t*)g.Bt; asm volatile("" : "+s"(gA), "+s"(gB));
    const int tid = tid_, wid = __builtin_amdgcn_readfirstlane(tid >> 6), lane = tid & 63, wr = wid >> 2, wc = wid & 3, fr = lane & 15, fq = lane >> 4;
    const int K = g.K, nt = K / BK;
    unsigned voffA[2], voffB[2];
#pragma unroll
    for (int i = 0; i < 2; ++i) { int R, C; stage_rc(tid * 16 + i * 8192, R, C); const int Rb = Epi::PERM ? ((R & ~31) + perm32(R & 31)) : R;
        voffA[i] = (unsigned)(R * g.lda + C) * 2u; voffB[i] = (unsigned)(Rb * g.ldb + C) * 2u; }
    const size_t kstep = (size_t)(BK * 2);
    const size_t hstepA = GATH ? (size_t)0 : (size_t)HALF * g.lda * 2, hstepB = (size_t)HALF * g.ldb * 2;
    unsigned gAc[2][2], gAn[2][2]; int gR[2], gC[2];
#pragma unroll
    for (int i = 0; i < 2; ++i) { stage_rc(tid * 16 + i * 8192, gR[i], gC[i]); gAc[0][i] = gAc[1][i] = gAn[0][i] = gAn[1][i] = 0u; }
#define PG8_GLOAD(dst, un) do { _Pragma("unroll") for (int h_ = 0; h_ < 2; ++h_) _Pragma("unroll") for (int i_ = 0; i_ < 2; ++i_) \
        dst[h_][i_] = (unsigned)S.gather_row(un, h_ * HALF + gR[i_]) * (unsigned)(g.lda * 2) + (unsigned)(gC[i_] * 2); } while (0)
#define PG8_STAGE_A(bufoff, kptr, h, nx) do { if (GATH) { unsigned vo_[2]; vo_[0] = (nx) ? gAn[h][0] : gAc[h][0]; vo_[1] = (nx) ? gAn[h][1] : gAc[h][1]; PG8_STAGE(bufoff, kptr, vo_); } \
        else PG8_STAGE(bufoff, (kptr) + (h) * hstepA, voffA); } while (0)
    const unsigned ldsw = (unsigned)wid * 1024u;
    const int aoff = lds_byte(wr * 64 + fr, fq * 8), boff = lds_byte(wc * 32 + fr, fq * 8);
#define PG8_SA(b, h) (((b) * 2 + (h)) * HTB)
#define PG8_SB(b, h) ((4 + (b) * 2 + (h)) * HTB)
#define PG8_STAGE(bufoff, gbase, voff) do { _Pragma("unroll") for (int _i = 0; _i < 2; ++_i) \
        __builtin_amdgcn_global_load_lds((const GAS unsigned*)((gbase) + (voff)[_i]), (LAS unsigned*)(lds + (bufoff) + ldsw + _i * 8192), 16, 0, 0); } while (0)
#define PG8_LDA(dst, b, h) do { _Pragma("unroll") for (int m = 0; m < 4; ++m) _Pragma("unroll") for (int k = 0; k < 2; ++k) dst[m][k] = *(const LAS bf16x8*)(lds + PG8_SA(b, h) + aoff + m * 2048 + k * 1024); } while (0)
#define PG8_LDB(dst, b, h) do { _Pragma("unroll") for (int n = 0; n < 2; ++n) _Pragma("unroll") for (int k = 0; k < 2; ++k) dst[n][k] = *(const LAS bf16x8*)(lds + PG8_SB(b, h) + boff + n * 2048 + k * 1024); } while (0)
#define PG8_MMA(ai, bj, At, Bt) do { __builtin_amdgcn_s_setprio(1); _Pragma("unroll") for (int m = 0; m < 4; ++m) _Pragma("unroll") for (int n = 0; n < 2; ++n) _Pragma("unroll") for (int k = 0; k < 2; ++k) \
        acc[ai][bj][m][n] = __builtin_amdgcn_mfma_f32_16x16x32_bf16(Bt[n][k], At[m][k], acc[ai][bj][m][n], 0, 0, 0); __builtin_amdgcn_s_setprio(0); } while (0)
#define PG8_WAIT_V(n) asm volatile("s_waitcnt vmcnt(" #n ")" ::: "memory")
#define PG8_WAIT_L(n) asm volatile("s_waitcnt lgkmcnt(" #n ")" ::: "memory")
#define PG8_BAR __builtin_amdgcn_s_barrier()
#define PG8_SCHED __builtin_amdgcn_sched_barrier(0)
    Unit cur, nxt; int ui = 0;
    if (!S.next(0, cur)) return;
    f32x4 acc[2][2][4][2];
#pragma unroll
    for (int a = 0; a < 2; ++a)
#pragma unroll
        for (int b = 0; b < 2; ++b)
#pragma unroll
            for (int m = 0; m < 4; ++m)
#pragma unroll
                for (int n = 0; n < 2; ++n) acc[a][b][m][n] = (f32x4){0.f, 0.f, 0.f, 0.f};
    bf16x8 At[4][2], B0[2][2], B1[2][2];
    const GAS char* cA = (const GAS char*)gA + (GATH ? 0L : cur.aoff); const GAS char* cB = (const GAS char*)gB + cur.boff;
    if (GATH) PG8_GLOAD(gAc, cur);
    if constexpr (SP2) {
        PG8_STAGE(PG8_SB(0, 0), cB, voffB); PG8_STAGE(PG8_SB(0, 1), cB + hstepB, voffB); PG8_STAGE_A(PG8_SA(0, 0), cA, 0, false); PG8_STAGE_A(PG8_SA(0, 1), cA, 1, false);
        if (wr == 1) PG8_BAR;
        PG8_WAIT_V(2); PG8_BAR;
        PG8_STAGE(PG8_SB(1, 0), cB + kstep, voffB); PG8_STAGE_A(PG8_SA(1, 0), cA + kstep, 0, false); PG8_STAGE(PG8_SB(1, 1), cB + hstepB + kstep, voffB);
        PG8_WAIT_V(6); PG8_BAR;
    } else {
    PG8_STAGE(PG8_SB(0, 0), cB, voffB); PG8_STAGE_A(PG8_SA(0, 0), cA, 0, false); PG8_STAGE(PG8_SB(0, 1), cB + hstepB, voffB); PG8_STAGE_A(PG8_SA(0, 1), cA, 1, false);
    if (wr == 1) PG8_BAR;
    PG8_WAIT_V(4); PG8_BAR;
    PG8_STAGE(PG8_SB(1, 0), cB + kstep, voffB); PG8_STAGE_A(PG8_SA(1, 0), cA + kstep, 0, false); PG8_STAGE(PG8_SB(1, 1), cB + hstepB + kstep, voffB);
    PG8_WAIT_V(6); PG8_BAR;
    }
    for (;;) {
        const bool has_next = S.next(ui + 1, nxt);
        const GAS char* nA = (has_next && !GATH) ? (const GAS char*)gA + nxt.aoff : cA; const GAS char* nB = has_next ? (const GAS char*)gB + nxt.boff : cB;
        if (GATH) { if (has_next) PG8_GLOAD(gAn, nxt); else { gAn[0][0] = gAc[0][0]; gAn[0][1] = gAc[0][1]; gAn[1][0] = gAc[1][0]; gAn[1][1] = gAc[1][1]; } }
        for (int t = 0; t < nt; t += 2) {
            const bool last = (t == nt - 2);
            const GAS char* a1 = cA + (size_t)(t + 1) * kstep;
            const GAS char* a2 = last ? nA : cA + (size_t)(t + 2) * kstep; const GAS char* b2 = last ? nB : cB + (size_t)(t + 2) * kstep;
            const GAS char* a3 = a2 + kstep; const GAS char* b3 = b2 + kstep;
            if constexpr (SP2) {
            PG8_LDB(B0, 0, 0); PG8_LDB(B1, 0, 1); PG8_SCHED; PG8_LDA(At, 0, 0); PG8_STAGE_A(PG8_SA(1, 1), a1, 1, false);
            PG8_WAIT_V(8); PG8_WAIT_L(0); PG8_BAR; PG8_MMA(0, 0, At, B0); PG8_MMA(0, 1, At, B1); PG8_BAR; PG8_SCHED;
            PG8_LDA(At, 0, 1); PG8_STAGE(PG8_SB(0, 0), b2, voffB); PG8_STAGE(PG8_SB(0, 1), b2 + hstepB, voffB); PG8_STAGE_A(PG8_SA(0, 0), a2, 0, last);
            PG8_WAIT_V(8); PG8_WAIT_L(0); PG8_BAR; PG8_MMA(1, 0, At, B0); PG8_MMA(1, 1, At, B1); PG8_BAR; PG8_SCHED;
            PG8_LDB(B0, 1, 0); PG8_LDB(B1, 1, 1); PG8_SCHED; PG8_LDA(At, 1, 0); PG8_STAGE_A(PG8_SA(0, 1), a2, 1, last);
            PG8_WAIT_V(8); PG8_WAIT_L(0); PG8_BAR; PG8_MMA(0, 0, At, B0); PG8_MMA(0, 1, At, B1); PG8_BAR; PG8_SCHED;
            PG8_LDA(At, 1, 1); PG8_STAGE(PG8_SB(1, 0), b3, voffB); PG8_STAGE(PG8_SB(1, 1), b3 + hstepB, voffB); PG8_STAGE_A(PG8_SA(1, 0), a3, 0, last);
            PG8_WAIT_V(8); PG8_WAIT_L(0); PG8_BAR; PG8_MMA(1, 0, At, B0); PG8_MMA(1, 1, At, B1); PG8_BAR; PG8_SCHED;
            } else {
            PG8_LDB(B0, 0, 0); PG8_SCHED; PG8_LDA(At, 0, 0); PG8_STAGE_A(PG8_SA(1, 1), a1, 1, false);
            PG8_WAIT_L(8); PG8_BAR; PG8_WAIT_L(0); PG8_MMA(0, 0, At, B0); PG8_BAR; PG8_SCHED;
            PG8_LDB(B1, 0, 1); PG8_STAGE(PG8_SB(0, 0), b2, voffB);
            PG8_BAR; PG8_WAIT_L(0); PG8_MMA(0, 1, At, B1); PG8_BAR;
            PG8_LDA(At, 0, 1); PG8_STAGE_A(PG8_SA(0, 0), a2, 0, last);
            PG8_BAR; PG8_WAIT_L(0); PG8_MMA(1, 0, At, B0); PG8_BAR; PG8_SCHED;
            PG8_STAGE(PG8_SB(0, 1), b2 + hstepB, voffB);
            PG8_WAIT_V(6); PG8_BAR; PG8_MMA(1, 1, At, B1); PG8_BAR;
            PG8_LDB(B0, 1, 0); PG8_SCHED; PG8_LDA(At, 1, 0); PG8_STAGE_A(PG8_SA(0, 1), a2, 1, last);
            PG8_WAIT_L(8); PG8_BAR; PG8_WAIT_L(0); PG8_MMA(0, 0, At, B0); PG8_BAR; PG8_SCHED;
            PG8_LDB(B1, 1, 1); PG8_STAGE(PG8_SB(1, 0), b3, voffB);
            PG8_BAR; PG8_WAIT_L(0); PG8_MMA(0, 1, At, B1); PG8_BAR;
            PG8_LDA(At, 1, 1); PG8_STAGE_A(PG8_SA(1, 0), a3, 0, last);
            PG8_BAR; PG8_WAIT_L(0); PG8_MMA(1, 0, At, B0); PG8_BAR; PG8_SCHED;
            PG8_STAGE(PG8_SB(1, 1), b3 + hstepB, voffB);
            PG8_WAIT_V(6); PG8_BAR; PG8_MMA(1, 1, At, B1); PG8_BAR;
            }
        }
        if constexpr (ALIGN_EPI) { if (wr == 0) PG8_BAR; }
        bool zero_acc = true;
        if constexpr (KEEPACC) zero_acc = E.run(acc, cur, wr, wc, fr, fq);
        else E(acc, cur, wr, wc, fr, fq);
        if (!has_next) break;
        if (zero_acc)
#pragma unroll
        for (int a = 0; a < 2; ++a)
#pragma unroll
            for (int b = 0; b < 2; ++b)
#pragma unroll
                for (int m = 0; m < 4; ++m)
#pragma unroll
                    for (int n = 0; n < 2; ++n) acc[a][b][m][n] = (f32x4){0.f, 0.f, 0.f, 0.f};
        cur = nxt; cA = nA; cB = nB; ++ui;
        if (GATH) { gAc[0][0] = gAn[0][0]; gAc[0][1] = gAn[0][1]; gAc[1][0] = gAn[1][0]; gAc[1][1] = gAn[1][1]; }
        if constexpr (ALIGN_EPI) { if (wr == 1) PG8_BAR; }
    }
    PG8_WAIT_V(0);
    if constexpr (!ALIGN_EPI) { if (wr == 0) PG8_BAR; }
    PG8_BAR;
#undef PG8_SA
#undef PG8_SB
#undef PG8_STAGE
#undef PG8_STAGE_A
#undef PG8_GLOAD
#undef PG8_LDA
#undef PG8_LDB
#undef PG8_MMA
#undef PG8_WAIT_V
#undef PG8_WAIT_L
#undef PG8_BAR
#undef PG8_SCHED
}

typedef const f32x4 (&AccT)[2][2][4][2];
template <int ACT> __device__ __forceinline__ void store_tile_bf16(AccT acc, bf16_t* O, int ld, int row0, int colb, float scale) {
#pragma unroll
    for (int ai = 0; ai < 2; ++ai)
#pragma unroll
        for (int m = 0; m < 4; ++m) { bf16_t* rowp = O + (size_t)(row0 + ai * HALF + m * 16) * ld + colb;
#pragma unroll
            for (int bj = 0; bj < 2; ++bj) { const f32x4 v0 = act4<ACT>(acc[ai][bj][m][0] * scale), v1 = act4<ACT>(acc[ai][bj][m][1] * scale);
                *(u32x4*)(rowp + bj * HALF) = pack8(v0, v1); }
            asm volatile("" ::: "memory"); }
}
template <int ACT> struct EpiStore {
    static constexpr bool PERM = true;
    bf16_t* O; int ld; float scale;
    __device__ __forceinline__ void operator()(AccT acc, const Unit& u, int wr, int wc, int fr, int fq) const {
        store_tile_bf16<ACT>(acc, O, ld, u.pm * BM + wr * 64 + fr, u.pn * BM + wc * 32 + 8 * fq, scale);
    }
};
struct EpiInProj {
    static constexpr bool PERM = true;
    unsigned char* ws;
    __device__ __forceinline__ void operator()(AccT acc, const Unit& u, int wr, int wc, int fr, int fq) const {
        const int pn = u.pn, row0 = u.pm * BM + wr * 64 + fr, cw = wc * 32 + 8 * fq;
        unsigned char* pj = ws + WS_PROJ;
        bf16_t *rq = (bf16_t*)(pj + P_RQ), *rk = (bf16_t*)(pj + P_RK), *rv = (bf16_t*)(pj + P_RV), *rg = (bf16_t*)(pj + P_RG), *gu = (bf16_t*)(pj + P_GU), *gv = (bf16_t*)(pj + P_GV), *dq = (bf16_t*)(pj + P_DQ),
               *iq = (bf16_t*)(pj + P_IQ), *ik = (bf16_t*)(pj + P_IK), *ga = (bf16_t*)(pj + P_GA), *gb = (bf16_t*)(pj + P_GB), *gc = (bf16_t*)(pj + P_GC);
        float *dcraw = (float*)(pj + P_DC), *iw = (float*)(pj + P_IW), *gvstats = (float*)(ws + WS_STATS); const float* rope = (const float*)(ws + WS_ROPE);
        if (pn < 8) {
            const bool isk = pn >= 4; bf16_t* dst = (isk ? rk : rq) + (pn & 3) * 256 + cw; const float sc = isk ? 0.0625f : 1.0f;
#pragma unroll
            for (int ai = 0; ai < 2; ++ai) { f32x4 csq[4][4];
#pragma unroll
                for (int m = 0; m < 4; ++m) { const int pos = (row0 + ai * HALF + m * 16) & (SEQ - 1); const f32x4* cs = (const f32x4*)(rope + ((size_t)pos * 128 + cw) * 2);
#pragma unroll
                    for (int q4 = 0; q4 < 4; ++q4) csq[m][q4] = cs[q4]; }
                asm volatile("" ::: "memory");
#pragma unroll
                for (int m = 0; m < 4; ++m) { const int row = row0 + ai * HALF + m * 16;
                    f32x4 o1[2], o2[2];
#pragma unroll
                    for (int n = 0; n < 2; ++n) { const f32x4 c01 = csq[m][2 * n], c23 = csq[m][2 * n + 1]; const f32x4 x1 = acc[ai][0][m][n], x2 = acc[ai][1][m][n];
                        const float co[4] = {c01[0], c01[2], c23[0], c23[2]}, si[4] = {c01[1], c01[3], c23[1], c23[3]};
#pragma unroll
                        for (int j = 0; j < 4; ++j) { o1[n][j] = (x1[j] * co[j] - x2[j] * si[j]) * sc; o2[n][j] = (x1[j] * si[j] + x2[j] * co[j]) * sc; } }
                    bf16_t* rp = dst + (size_t)row * 1024;
                    *(u32x4*)rp = pack8(o1[0], o1[1]); *(u32x4*)(rp + 128) = pack8(o2[0], o2[1]); }
                asm volatile("" ::: "memory"); }
        } else if (pn < 12) { store_tile_bf16<0>(acc, rv, 1024, row0, (pn - 8) * 256 + cw, 1.f);
        } else if (pn < 16) { store_tile_bf16<2>(acc, rg, 1024, row0, (pn - 12) * 256 + cw, 1.f);
        } else if (pn < 20) { store_tile_bf16<1>(acc, gu, 1024, row0, (pn - 16) * 256 + cw, 1.f);
        } else if (pn < 24) {
            const int t4 = pn - 20; bf16_t* dst = gv + t4 * 256 + cw;
#pragma unroll
            for (int ai = 0; ai < 2; ++ai)
#pragma unroll
                for (int m = 0; m < 4; ++m) { const int row = row0 + ai * HALF + m * 16; float s = 0.f, q = 0.f;
#pragma unroll
                    for (int bj = 0; bj < 2; ++bj) { const f32x4 v0 = act4<1>(acc[ai][bj][m][0]), v1 = act4<1>(acc[ai][bj][m][1]);
                        *(u32x4*)(dst + (size_t)row * 1024 + bj * HALF) = pack8(v0, v1);
#pragma unroll
                        for (int j = 0; j < 4; ++j) { s += v0[j] + v1[j]; q += v0[j] * v0[j] + v1[j] * v1[j]; } }
                    s = quad_sum(s); q = quad_sum(q);
                    if (fq == 0) *(f32x2*)(gvstats + ((size_t)row * 16 + t4 * 4 + wc) * 2) = (f32x2){s, q}; asm volatile("" ::: "memory"); }
        } else if (pn < 28) { store_tile_bf16<0>(acc, dq, 1024, row0, (pn - 24) * 256 + cw, 1.f);
        } else if (pn == 28) {
#pragma unroll
            for (int ai = 0; ai < 2; ++ai)
#pragma unroll
                for (int m = 0; m < 4; ++m) { float* rp = dcraw + (size_t)(row0 + ai * HALF + m * 16) * 256 + cw;
#pragma unroll
                    for (int bj = 0; bj < 2; ++bj) { *(f32x4*)(rp + bj * HALF) = acc[ai][bj][m][0]; *(f32x4*)(rp + bj * HALF + 4) = acc[ai][bj][m][1]; } }
        } else if (pn < 31) { store_tile_bf16<0>(acc, iq, 512, row0, (pn - 29) * 256 + cw, 1.f);
        } else if (pn == 31) {
#pragma unroll
            for (int ai = 0; ai < 2; ++ai)
#pragma unroll
                for (int m = 0; m < 4; ++m) { const int row = row0 + ai * HALF + m * 16;
                    if (wc < 2) *(u32x4*)(ik + (size_t)row * 64 + cw) = pack8(acc[ai][0][m][0], acc[ai][0][m][1]);
                    if (wc == 2 && fq == 0) { *(f32x4*)(iw + (size_t)row * 8) = acc[ai][0][m][0] * 0.35355339059f; *(f32x4*)(iw + (size_t)row * 8 + 4) = acc[ai][0][m][1] * 0.35355339059f; } }
        } else { const int gi = (pn - 32) >> 3; bf16_t* dst = gi == 0 ? ga : (gi == 1 ? gb : gc);
            store_tile_bf16<3>(acc, dst, 2048, row0, ((pn - 32) & 7) * 256 + cw, 1.f); }
    }
};
typedef f32x4 (&AccM)[2][2][4][2];
struct EpiBranch {
    static constexpr bool PERM = true;
    const bf16_t* gate0; bf16_t* merged;
    __device__ __forceinline__ bool run(AccM acc, const Unit& u, int wr, int wc, int fr, int fq) const {
        const int br = u.pn >> 8; const bf16_t* gate = gate0 + (size_t)br * (32u << 20); const bf16_t* gnx = gate + (32u << 20);
        const int row0 = u.pm * BM + wr * 64 + fr, colb = (u.pn & 255) * BM + wc * 32 + 8 * fq;
#pragma unroll
        for (int ai = 0; ai < 2; ++ai) {
            u32x4 gq[4][2], nq[4][2];
#pragma unroll
            for (int m = 0; m < 4; ++m)
#pragma unroll
                for (int bj = 0; bj < 2; ++bj) { const size_t ro = (size_t)(row0 + ai * HALF + m * 16) * 2048 + colb + bj * HALF; gq[m][bj] = *(const u32x4*)(gate + ro); nq[m][bj] = *(const u32x4*)((br < 2 ? gnx : gate) + ro); }
            asm volatile("" ::: "memory");
#pragma unroll
            for (int m = 0; m < 4; ++m)
#pragma unroll
                for (int bj = 0; bj < 2; ++bj) { float g8[8], n8[8]; unpack8(gq[m][bj], g8); unpack8(nq[m][bj], n8);
                    f32x4 a0 = acc[ai][bj][m][0], a1 = acc[ai][bj][m][1];
                    if (br < 2) {
#pragma unroll
                        for (int j = 0; j < 4; ++j) { a0[j] *= g8[j] * __builtin_amdgcn_rcpf(fmaxf(n8[j], 1e-30f)); a1[j] *= g8[4 + j] * __builtin_amdgcn_rcpf(fmaxf(n8[4 + j], 1e-30f)); }
                        acc[ai][bj][m][0] = a0; acc[ai][bj][m][1] = a1;
                    } else {
#pragma unroll
                        for (int j = 0; j < 4; ++j) { a0[j] *= g8[j]; a1[j] *= g8[4 + j]; }
                        *(u32x4*)(merged + (size_t)(row0 + ai * HALF + m * 16) * 2048 + colb + bj * HALF) = pack8(a0, a1); } }
            asm volatile("" ::: "memory");
        }
        return br == 2;
    }
};
struct EpiResid {
    static constexpr bool PERM = false;
    const float* xsrc; float* xdst;
    __device__ __forceinline__ void operator()(AccT acc, const Unit& u, int wr, int wc, int fr, int fq) const {
        const int row0 = u.pm * BM + wr * 64 + fr, col0 = u.pn * BM + wc * 32 + 4 * fq;
#pragma unroll
        for (int ai = 0; ai < 2; ++ai)
#pragma unroll
            for (int mp = 0; mp < 2; ++mp) { f32x4 xv[2][2][2];
#pragma unroll
                for (int mm = 0; mm < 2; ++mm)
#pragma unroll
                    for (int bj = 0; bj < 2; ++bj)
#pragma unroll
                        for (int n = 0; n < 2; ++n) xv[mm][bj][n] = *(const f32x4*)(xsrc + (size_t)(row0 + ai * HALF + (2 * mp + mm) * 16) * DM + col0 + bj * HALF + n * 16);
                asm volatile("" ::: "memory");
#pragma unroll
                for (int mm = 0; mm < 2; ++mm)
#pragma unroll
                    for (int bj = 0; bj < 2; ++bj)
#pragma unroll
                        for (int n = 0; n < 2; ++n) *(f32x4*)(xdst + (size_t)(row0 + ai * HALF + (2 * mp + mm) * 16) * DM + col0 + bj * HALF + n * 16) = xv[mm][bj][n] + acc[ai][bj][2 * mp + mm][n];
                asm volatile("" ::: "memory"); }
    }
};
struct EpiMoeUp {
    static constexpr bool PERM = true;
    bf16_t* hid;
    __device__ __forceinline__ void operator()(AccT acc, const Unit& u, int wr, int wc, int fr, int fq) const {
        const int row0 = u.pm * BM + wr * 64 + fr, colb = u.pn * 128 + wc * 32 + 8 * fq;
#pragma unroll
        for (int ai = 0; ai < 2; ++ai)
#pragma unroll
            for (int m = 0; m < 4; ++m) { f32x4 r0, r1; const f32x4 a0 = acc[ai][0][m][0], a1 = acc[ai][0][m][1], b0 = acc[ai][1][m][0], b1 = acc[ai][1][m][1];
#pragma unroll
                for (int j = 0; j < 4; ++j) { r0[j] = siluf_(a0[j]) * b0[j]; r1[j] = siluf_(a1[j]) * b1[j]; }
                *(u32x4*)(hid + (size_t)(row0 + ai * HALF + m * 16) * FF + colb) = pack8(r0, r1); }
    }
};
struct OrderBranch {
    OrderMN base; long astride, bstride;
    __device__ __forceinline__ int gather_row(const Unit&, int) const { return 0; }
    __device__ bool next(int i, Unit& u) const { if (!base.next(i / 3, u)) return false; const int br = i % 3; u.aoff += br * astride; u.boff += br * bstride; u.pn |= br << 8; return true; }
};
struct OrderRouter {
    int G, c; long hlo_off;
    __device__ __forceinline__ int gather_row(const Unit&, int) const { return 0; }
    __device__ bool next(int i, Unit& u) const { const int L = i * G + c; if (L >= 256) return false; const int pm = L >> 2, which = (L >> 1) & 1, kh = L & 1;
        u.pm = pm; u.pn = which * 2 + kh; u.aoff = (long)pm * 256 * DM * 2 + (long)which * hlo_off + (long)kh * 1024 * 2; u.boff = (long)kh * 1024 * 2; return true; }
};
struct EpiRouter {
    static constexpr bool PERM = false;
    float* LOG;
    __device__ __forceinline__ void operator()(AccT acc, const Unit& u, int wr, int wc, int fr, int fq) const {
        float* base = LOG + ((size_t)u.pn * T + (size_t)u.pm * BM + wr * 64 + fr) * 128 + wc * 32 + 4 * fq;
#pragma unroll
        for (int ai = 0; ai < 2; ++ai)
#pragma unroll
            for (int m = 0; m < 4; ++m)
#pragma unroll
                for (int n = 0; n < 2; ++n) *(f32x4*)(base + (size_t)(ai * HALF + m * 16) * 128 + n * 16) = acc[ai][0][m][n];
    }
};
}

struct Args { const float* in[23]; float* out; unsigned char* ws; int ph_lo, ph_hi; };
enum { I_X = 0, I_NMIX, I_WIN, I_WRET, I_LNG, I_LNB, I_WS, I_BS, I_WGM, I_KVG, I_WUK, I_WUV, I_WDS, I_WOUT, I_NFFN, I_WGRP, I_BGRP, I_WEXP, I_BEXP, I_W1, I_W3, I_W2, I_FNG };
struct Ctx {
    LAS unsigned char* lds; volatile LAS int* misc; unsigned* ctl; GAS unsigned char* ws;
    int tid, lane, wave, G, bid, gw, NGW;
    const float* const* in; float* out;
};
#define WSP(T_, off) ((T_*)(C.ws + (off)))
__device__ __forceinline__ void refresh(Ctx& C) { int t = threadIdx.x; asm volatile("" : "+v"(t)); C.tid = t; C.lane = t & 63;
    GAS unsigned char* w = C.ws; asm volatile("" : "+s"(w)); C.ws = w; C.ctl = (unsigned*)w; }

__device__ __forceinline__ void ph_rope(const Ctx& C) {
    float* rope = WSP(float, WS_ROPE);
    const double r1 = 0.9305720409296989;
    for (int idx = C.bid * 512 + C.tid; idx < SEQ * 128; idx += C.G * 512) {
        const int pos = idx >> 7, i = idx & 127;
        double inv = 1.0, b = r1; int e = i;
        while (e) { if (e & 1) inv *= b; b *= b; e >>= 1; }
        const double ang = (double)pos * inv;
        const double n = __builtin_rint(ang * 0.15915494309189533577);
        const double x = ang - n * 6.283185307179586476925;
        const double x2 = x * x;
        double s = 0.0, c = 0.0;
#pragma unroll 1
        for (int k = 14; k >= 1; --k) { s = (s + 1.0) * (-x2 / (double)((2 * k) * (2 * k + 1))); c = (c + 1.0) * (-x2 / (double)((2 * k - 1) * (2 * k))); }
        s = (s + 1.0) * x; c = c + 1.0;
        *(f32x2*)(rope + (size_t)idx * 2) = (f32x2){(float)c, (float)s};
    }
}

template <class Map>
__device__ __forceinline__ void tr_item(const float* W, long srcld, bf16_t* WT, long dstld, int k0, int n0, LAS float* scr, int lane, const Map& map) {
    const int nn = n0 + (lane & 31); const long sc = map(nn);
#pragma unroll 8
    for (int i = 0; i < 32; ++i) { const int kk = 2 * i + (lane >> 5); scr[kk * 33 + (lane & 31)] = sc >= 0 ? W[(size_t)(k0 + kk) * srcld + sc] : 0.f; }
    asm volatile("s_waitcnt lgkmcnt(0)" ::: "memory");
    const int c = lane & 7;
#pragma unroll
    for (int j = 0; j < 4; ++j) { const int n = (lane >> 3) + 8 * j; const LAS float* s = scr + (8 * c) * 33 + n;
        u32x4 o; o.x = cvt_pk_bf16(s[0 * 33], s[1 * 33]); o.y = cvt_pk_bf16(s[2 * 33], s[3 * 33]); o.z = cvt_pk_bf16(s[4 * 33], s[5 * 33]); o.w = cvt_pk_bf16(s[6 * 33], s[7 * 33]);
        *(u32x4*)(WT + (size_t)(n0 + n) * dstld + k0 + 8 * c) = o; }
    asm volatile("s_waitcnt lgkmcnt(0)" ::: "memory");
}
struct MapId { __device__ long operator()(int n) const { return n; } };
struct MapIn { __device__ long operator()(int n) const { return n < GATE_SRC0 ? n : (n < GATE_DST0 ? -1 : n - (GATE_DST0 - GATE_SRC0)); } };
struct MapOff { long off; __device__ long operator()(int n) const { return n + off; } };

struct WItem { const float* src; bf16_t* dst; int srcld, dstld, k0, n0, mode; long off; };
__device__ __forceinline__ WItem w_item(const Ctx& C, int l, int r) {
    unsigned char* wb = (unsigned char*)(C.ws + WS_W); WItem w; w.mode = 0; w.off = 0;
    constexpr int N_IN = 32 * 224, N_BR = 16 * 32, N_OUT = 32 * 32, N_13 = 32 * 32 * 16, N_2 = 32 * 8 * 32;
    if (r < N_IN) { const int kb = r / 224, nb = r % 224; w.src = C.in[I_WIN] + (size_t)l * DM * INW; w.srcld = INW; w.dst = (bf16_t*)(wb + W_IN); w.dstld = DM; w.k0 = kb * 64; w.n0 = nb * 64; w.mode = 1; return w; } r -= N_IN;
    if (r < 3 * N_BR) { const int ww = r / N_BR, q = r % N_BR, kb = q / 32, nb = q % 32; w.src = C.in[ww == 0 ? I_WRET : (ww == 1 ? I_WGM : I_WDS)] + (size_t)l * 1024 * DM; w.srcld = DM;
        w.dst = (bf16_t*)(wb + (ww == 0 ? W_RET : (ww == 1 ? W_GM : W_DS))); w.dstld = 1024; w.k0 = kb * 64; w.n0 = nb * 64; return w; } r -= 3 * N_BR;
    if (r < N_OUT) { const int kb = r / 32, nb = r % 32; w.src = C.in[I_WOUT] + (size_t)l * DM * DM; w.srcld = DM; w.dst = (bf16_t*)(wb + W_OUT); w.dstld = DM; w.k0 = kb * 64; w.n0 = nb * 64; return w; } r -= N_OUT;
    if (r < N_13) { const int e = r / 512, q = r % 512, kb = q / 16, nb = q % 16, row0 = nb * 64, j = row0 >> 8, sft = (row0 >> 7) & 1, fp = row0 & 127;
        w.src = C.in[sft ? I_W3 : I_W1] + ((size_t)l * NEXP + e) * DM * FF; w.srcld = FF; w.dst = (bf16_t*)(wb + W_13) + (size_t)e * 1024 * DM; w.dstld = DM; w.k0 = kb * 64; w.n0 = row0; w.off = (long)(128 * j + fp) - row0; return w; } r -= N_13;
    if (r < N_2) { const int e = r / 256, q = r % 256, kb = q / 32, nb = q % 32; w.src = C.in[I_W2] + ((size_t)l * NEXP + e) * FF * DM; w.srcld = DM; w.dst = (bf16_t*)(wb + W_2) + (size_t)e * DM * FF; w.dstld = FF; w.k0 = kb * 64; w.n0 = nb * 64; return w; } r -= N_2;
    { const int h = r / 8, q = r % 8, kb = q / 2, nb = q % 2;
      w.src = C.in[I_WUV] + ((size_t)l * 8 + h) * 256 * 128; w.srcld = 128; w.dst = (bf16_t*)(wb + W_UV) + (size_t)(h * 128) * 512 + (h & 1) * 256; w.dstld = 512; w.k0 = kb * 64; w.n0 = nb * 64; return w; }
}
__device__ __forceinline__ void w_load(const WItem& w, int lane, f32x4 (&R)[16]) {
    const int nq = lane & 15, kq = lane >> 4, n = w.n0 + 4 * nq;
    const long sc = (w.mode == 1) ? (n < GATE_SRC0 ? (long)n : (n < GATE_DST0 ? -1L : (long)(n - (GATE_DST0 - GATE_SRC0)))) : (long)n + w.off;
    const float* p = w.src + (size_t)(w.k0 + 2 * kq) * w.srcld + (sc >= 0 ? sc : 0);
#pragma unroll
    for (int i = 0; i < 8; ++i)
#pragma unroll
        for (int s2 = 0; s2 < 2; ++s2) { f32x4 v = __builtin_nontemporal_load((const f32x4*)(p + (size_t)(8 * i + s2) * w.srcld)); if (sc < 0) v = (f32x4){0.f, 0.f, 0.f, 0.f}; R[2 * i + s2] = v; }
}
__device__ __forceinline__ void w_store(const WItem& w, int lane, const f32x4 (&R)[16], LAS unsigned* scr) {
    const int nq = lane & 15, kq = lane >> 4;
#pragma unroll
    for (int i = 0; i < 8; ++i)
#pragma unroll
        for (int e = 0; e < 4; ++e) scr[(4 * nq + e) * 33 + 4 * i + kq] = cvt_pk_bf16(R[2 * i][e], R[2 * i + 1][e]);
    asm volatile("s_waitcnt lgkmcnt(0)" ::: "memory");
    const int c = lane & 7;
#pragma unroll
    for (int j = 0; j < 8; ++j) { const int n = (lane >> 3) + 8 * j; const LAS unsigned* sp = scr + n * 33 + 4 * c;
        u32x4 o; o.x = sp[0]; o.y = sp[1]; o.z = sp[2]; o.w = sp[3];
        *(u32x4*)(w.dst + (size_t)(w.n0 + n) * w.dstld + w.k0 + 8 * c) = o; }
    asm volatile("s_waitcnt lgkmcnt(0)" ::: "memory");
}
__device__ __forceinline__ void ph_weights(const Ctx& C, int l) {
    LAS unsigned* scr = (LAS unsigned*)(C.lds + C.wave * 16384);
    unsigned char* wb = (unsigned char*)(C.ws + WS_W);
    constexpr int NITEMS = 32 * 224 + 3 * 16 * 32 + 32 * 32 + 32 * 32 * 16 + 32 * 8 * 32 + 8 * 8;
    { int it = C.gw; f32x4 R[16], Rn[16]; WItem w, wn;
      if (it < NITEMS) { w = w_item(C, l, it); w_load(w, C.lane, R); }
#pragma unroll 1
      while (it < NITEMS) { const int itn = it + C.NGW;
          if (itn < NITEMS) { wn = w_item(C, l, itn); w_load(wn, C.lane, Rn); }
          w_store(w, C.lane, R, scr);
#pragma unroll
          for (int i = 0; i < 16; ++i) R[i] = Rn[i];
          w = wn; it = itn; } }
    bf16_t* uv = (bf16_t*)(wb + W_UV); bf16_t* uk = (bf16_t*)(wb + W_UK); const float* wuk = C.in[I_WUK] + (size_t)l * 8 * 256 * 128;
    for (int idx = C.bid * 512 + C.tid; idx < 1024 * 256 / 8; idx += C.G * 512) { const int row = idx >> 5, c8 = (idx & 31) * 8, h = row >> 7;
        *(u32x4*)(uv + (size_t)row * 512 + (1 - (h & 1)) * 256 + c8) = (u32x4){0u, 0u, 0u, 0u}; }
    for (int idx = C.bid * 512 + C.tid; idx < 2048 * 256 / 8; idx += C.G * 512) { const int row = idx >> 5, c8 = (idx & 31) * 8, h = row >> 8, half = c8 >> 7;
        u32x4 o = (u32x4){0u, 0u, 0u, 0u};
        if (half == (h & 1)) { const float* s = wuk + (size_t)row * 128 + (c8 & 127); const f32x4 a = *(const f32x4*)s, b = *(const f32x4*)(s + 4); o = pack8(a, b); }
        *(u32x4*)(uk + (size_t)row * 256 + c8) = o; }
    bf16_t* rt = (bf16_t*)(wb + W_RT); const float* wgr = C.in[I_WGRP] + (size_t)l * DM * 4; const float* wex = C.in[I_WEXP] + (size_t)l * 4 * DM * 8;
    for (int idx = C.bid * 512 + C.tid; idx < 256 * 256; idx += C.G * 512) { const int r = idx >> 8, k8 = (idx & 255) * 8, c = r & 63, part = r >> 6;
        u32x4 o = (u32x4){0u, 0u, 0u, 0u};
        if (part < 2 && c < 36) { float v[8];
#pragma unroll
            for (int j = 0; j < 8; ++j) { const float wv = (c < 4) ? wgr[(size_t)(k8 + j) * 4 + c] : wex[((size_t)((c - 4) >> 3) * DM + (k8 + j)) * 8 + ((c - 4) & 7)];
                const float hi = bf2f(f2bf(wv)); v[j] = part == 0 ? hi : (wv - hi); }
            o = pack8((f32x4){v[0], v[1], v[2], v[3]}, (f32x4){v[4], v[5], v[6], v[7]}); }
        *(u32x4*)(rt + (size_t)r * DM + k8) = o; }
}

__device__ __forceinline__ void ph_norm(const Ctx& C, const float* x, const float* g, bf16_t* H) {
    for (int row = C.gw; row < T; row += C.NGW) {
        const f32x4* xr = (const f32x4*)(x + (size_t)row * DM) + C.lane; f32x4 v[8]; float ss = 0.f;
#pragma unroll
        for (int j = 0; j < 8; ++j) { v[j] = xr[64 * j]; ss += v[j][0] * v[j][0] + v[j][1] * v[j][1] + v[j][2] * v[j][2] + v[j][3] * v[j][3]; }
        const float rstd = rsqrtf(wave_sum(ss, C.lane) * (1.f / DM) + EPS);
        u32x2* o = (u32x2*)(H + (size_t)row * DM) + C.lane;
#pragma unroll
        for (int j = 0; j < 8; ++j) { const f32x4 gg = ((const f32x4*)g)[64 * j + C.lane]; const f32x4 y = v[j] * rstd * gg; u32x2 w; w.x = cvt_pk_bf16(y[0], y[1]); w.y = cvt_pk_bf16(y[2], y[3]); o[64 * j] = w; }
    }
}
__device__ __forceinline__ void ph_ckv(const Ctx& C, const float* dcraw, const float* g, bf16_t* ckv) {
    for (int row = C.gw; row < T; row += C.NGW) {
        const f32x4 v = ((const f32x4*)(dcraw + (size_t)row * 256))[C.lane];
        const float ss = wave_sum(v[0] * v[0] + v[1] * v[1] + v[2] * v[2] + v[3] * v[3], C.lane);
        const float rstd = rsqrtf(ss * (1.f / 256.f) + EPS); const f32x4 y = v * rstd * ((const f32x4*)g)[C.lane];
        u32x2 w; w.x = cvt_pk_bf16(y[0], y[1]); w.y = cvt_pk_bf16(y[2], y[3]); ((u32x2*)(ckv + (size_t)row * 256))[C.lane] = w;
    }
}

__device__ __forceinline__ void ph_gmlp_naive(const Ctx& C, int l) {
    const bf16_t* gu = WSP(bf16_t, WS_PROJ + P_GU); const bf16_t* gv = WSP(bf16_t, WS_PROJ + P_GV); const float* stats = WSP(float, WS_STATS); bf16_t* gm = WSP(bf16_t, WS_GM);
    const float* lng = C.in[I_LNG] + l * 1024; const float* lnb = C.in[I_LNB] + l * 1024; const float* Wsp = C.in[I_WS] + (size_t)l * 4 * 128 * 128; const float* bs = C.in[I_BS] + l * 4 * 128;
    LAS float* smean = (LAS float*)C.lds; LAS float* srstd = smean + 128; LAS float* lv = srstd + 128;
    for (int u = C.bid; u < 512; u += C.G) {
        const int g = u & 3, bn = u >> 2, t0 = bn * 128;
        __syncthreads();
        if (C.tid < 128) { const float* sp = stats + (size_t)(t0 + C.tid) * 32; float s = 0.f, q = 0.f;
            for (int k = 0; k < 16; ++k) { s += sp[2 * k]; q += sp[2 * k + 1]; }
            const float mean = s * (1.f / 1024.f), var = q * (1.f / 1024.f) - mean * mean; smean[C.tid] = mean; srstd[C.tid] = rsqrtf(var + EPS); }
        __syncthreads();
        for (int idx = C.tid; idx < 128 * 256; idx += 512) { const int j = idx >> 8, c = idx & 255, ch = g * 256 + c;
            lv[idx] = (bf2f(gv[(size_t)(t0 + j) * 1024 + ch]) - smean[j]) * srstd[j] * lng[ch] + lnb[ch]; }
        __syncthreads();
        for (int idx = C.tid; idx < 128 * 256; idx += 512) { const int i = idx >> 8, c = idx & 255; const float* wr = Wsp + ((size_t)g * 128 + i) * 128; float a = 0.f;
            for (int j = 0; j <= i; ++j) a += wr[j] * lv[j * 256 + c];
            a += bs[g * 128 + i];
            const size_t o = (size_t)(t0 + i) * 1024 + g * 256 + c; gm[o] = (bf16_t)f2bf(bf2f(gu[o]) * a); }
    }
}
__device__ __forceinline__ void ph_ret_naive(const Ctx& C) {
    const bf16_t* rq = WSP(bf16_t, WS_PROJ + P_RQ); const bf16_t* rk = WSP(bf16_t, WS_PROJ + P_RK); const bf16_t* rv = WSP(bf16_t, WS_PROJ + P_RV); const bf16_t* rg = WSP(bf16_t, WS_PROJ + P_RG); bf16_t* ret = WSP(bf16_t, WS_RET);
    LAS float* sq = (LAS float*)C.lds; LAS float* sa = sq + 256; LAS float* red = sa + 4096;
    for (int u = C.bid; u < NB * 4 * SEQ; u += C.G) {
        const int t = (SEQ - 1) - (u / 16), bh = u % 16, b = bh >> 2, h = bh & 3; const size_t rowb = (size_t)b * SEQ;
        const float lg2 = log2f(1.0f - exp2f(-5.0f - (float)h));
        __syncthreads();
        if (C.tid < 256) sq[C.tid] = bf2f(rq[(rowb + t) * 1024 + h * 256 + C.tid]);
        __syncthreads();
        for (int s = C.tid; s <= t; s += 512) { const u32x4* kp = (const u32x4*)(rk + (rowb + s) * 1024 + h * 256); float a = 0.f;
            for (int d8 = 0; d8 < 32; ++d8) { float f[8]; unpack8(kp[d8], f);
#pragma unroll
                for (int j = 0; j < 8; ++j) a += sq[d8 * 8 + j] * f[j]; }
            sa[s] = a * exp2f(lg2 * (float)(t - s)); }
        __syncthreads();
        float o = 0.f;
        if (C.tid < 256) { const bf16_t* vp = rv + rowb * 1024 + h * 256 + C.tid; for (int s = 0; s <= t; ++s) o += sa[s] * bf2f(vp[(size_t)s * 1024]); }
        const float ss = wave_sum(o * o, C.lane); if (C.lane == 0) red[C.wave] = ss;
        __syncthreads();
        if (C.tid < 256) { const float tot = red[0] + red[1] + red[2] + red[3]; const float y = o * rsqrtf(tot * (1.f / 256.f) + EPS);
            const size_t oi = (rowb + t) * 1024 + h * 256 + C.tid; ret[oi] = (bf16_t)f2bf(bf2f(rg[oi]) * y); }
    }
}
__device__ __forceinline__ void ph_idx_naive(const Ctx& C) {
    const bf16_t* iq = WSP(bf16_t, WS_PROJ + P_IQ); const bf16_t* ik = WSP(bf16_t, WS_PROJ + P_IK); const float* iw = WSP(float, WS_PROJ + P_IW); unsigned short* sel = WSP(unsigned short, WS_SEL);
    LAS float* sq = (LAS float*)C.lds; LAS float* sw = sq + 512; LAS float* sc = sw + 8;
    for (int u = C.bid; u < T; u += C.G) {
        const int tq = (T - 1) - u; const int b = tq >> 12, q = tq & (SEQ - 1), n = q + 1;
        __syncthreads();
        sq[C.tid] = bf2f(iq[(size_t)tq * 512 + C.tid]); if (C.tid < 8) sw[C.tid] = iw[(size_t)tq * 8 + C.tid];
        for (int r = C.tid; r < 256; r += 512) sel[(size_t)tq * 256 + r] = 0xFFFFu;
        __syncthreads();
        for (int s = C.tid; s < n; s += 512) { const u32x4* kp = (const u32x4*)(ik + ((size_t)b * SEQ + s) * 64); float kf[64];
#pragma unroll
            for (int d8 = 0; d8 < 8; ++d8) { float f[8]; unpack8(kp[d8], f);
#pragma unroll
                for (int j = 0; j < 8; ++j) kf[d8 * 8 + j] = f[j]; }
            float score = 0.f;
#pragma unroll 1
            for (int h = 0; h < 8; ++h) { float a = 0.f;
#pragma unroll
                for (int d = 0; d < 64; ++d) a += sq[h * 64 + d] * kf[d];
                score += sw[h] * fmaxf(a * 0.125f, 0.f); }
            sc[s] = score; }
        __syncthreads();
        for (int s = C.tid; s < n; s += 512) { const float v = sc[s]; int rank = 0;
            for (int s2 = 0; s2 < n; ++s2) { const float w = sc[s2]; rank += (w > v || (w == v && s2 < s)) ? 1 : 0; }
            if (rank < 256) sel[(size_t)tq * 256 + rank] = (unsigned short)s; }
    }
}
__device__ __forceinline__ void ph_att_naive(const Ctx& C) {
    const bf16_t* qabs = WSP(bf16_t, WS_QABS); const bf16_t* ckv = WSP(bf16_t, WS_CKV); const unsigned short* sel = WSP(unsigned short, WS_SEL); bf16_t* olat = WSP(bf16_t, WS_OLAT);
    LAS float* sqa = (LAS float*)C.lds; LAS float* sp = sqa + 2048; LAS int* ssel = (LAS int*)(sp + 2048);
    for (int tq = C.bid; tq < T; tq += C.G) {
        const int b = tq >> 12, q = tq & (SEQ - 1);
        __syncthreads();
        for (int i = C.tid; i < 2048; i += 512) sqa[i] = bf2f(qabs[(size_t)tq * 2048 + i]);
        if (C.tid < 256) { const int s = sel[(size_t)tq * 256 + C.tid]; ssel[C.tid] = (s <= q) ? s : -1; }
        __syncthreads();
        const int h = C.wave; float sv[4]; float mx = -INFINITY;
#pragma unroll
        for (int j = 0; j < 4; ++j) { const int k = C.lane + 64 * j, s = ssel[k]; float a = -INFINITY;
            if (s >= 0) { const u32x4* cp = (const u32x4*)(ckv + ((size_t)b * SEQ + s) * 256); a = 0.f;
                for (int c8 = 0; c8 < 32; ++c8) { float f[8]; unpack8(cp[c8], f);
#pragma unroll
                    for (int jj = 0; jj < 8; ++jj) a += sqa[h * 256 + c8 * 8 + jj] * f[jj]; } }
            sv[j] = a; mx = fmaxf(mx, a); }
        mx = wave_max(mx, C.lane); float sum = 0.f;
#pragma unroll
        for (int j = 0; j < 4; ++j) { sv[j] = __expf(sv[j] - mx); sum += sv[j]; }
        sum = wave_sum(sum, C.lane); const float inv = 1.f / sum;
#pragma unroll
        for (int j = 0; j < 4; ++j) sp[h * 256 + C.lane + 64 * j] = sv[j] * inv;
        __syncthreads();
        float o[4] = {0.f, 0.f, 0.f, 0.f};
        for (int k = 0; k < 256; ++k) { const int s = ssel[k]; if (s < 0) continue; const float p = sp[h * 256 + k]; const bf16_t* cp = ckv + ((size_t)b * SEQ + s) * 256 + C.lane;
#pragma unroll
            for (int j = 0; j < 4; ++j) o[j] += p * bf2f(cp[64 * j]); }
#pragma unroll
        for (int j = 0; j < 4; ++j) olat[(size_t)tq * 2048 + h * 256 + C.lane + 64 * j] = (bf16_t)f2bf(o[j]);
    }
}

typedef short v4i16_t __attribute__((ext_vector_type(4)));
__device__ __forceinline__ s16x4 tr_read(const LAS unsigned char* p) { return __builtin_bit_cast(s16x4, __builtin_amdgcn_ds_read_tr16_b64_v4i16((LAS v4i16_t*)p)); }
__device__ __forceinline__ bf16x8 tr_frag(const LAS unsigned char* X, int LDX, int rowA, int rowB, int n0, int lane) {
    const int q = (lane & 15) >> 2, p = lane & 3;
    const s16x4 lo = tr_read(X + (rowA + q) * LDX + (n0 + 4 * p) * 2), hi = tr_read(X + (rowB + q) * LDX + (n0 + 4 * p) * 2);
    return (bf16x8){lo[0], lo[1], lo[2], lo[3], hi[0], hi[1], hi[2], hi[3]};
}
constexpr int TLD = 544;
__device__ __forceinline__ bf16x8 as_bf16x8(u32x4 w) { return __builtin_bit_cast(bf16x8, w); }

__device__ __forceinline__ void ph_ret_kv(const Ctx& C) {
    const bf16_t* rk = WSP(bf16_t, WS_PROJ + P_RK); const bf16_t* rv = WSP(bf16_t, WS_PROJ + P_RV); bf16_t* KV = WSP(bf16_t, WS_KV);
    const LAS unsigned char* Vt = C.lds; const LAS unsigned char* Kt = C.lds + 128 * TLD;
    const int g = C.lane >> 4, fr = C.lane & 15, wr = C.wave >> 2, wc = C.wave & 3;
    for (int u = C.bid; u < 512; u += C.G) {
        const int n = u & 31, h = (u >> 5) & 3, b = u >> 7; const size_t row0 = (size_t)b * SEQ + n * 128;
        const float lg2 = log2f(1.0f - exp2f(-5.0f - (float)h));
        __syncthreads();
#pragma unroll
        for (int p = 0; p < 8; ++p) { const int idx = p * 512 + C.tid, row = idx >> 5, ch = idx & 31; const size_t go = (row0 + row) * 1024 + h * 256 + ch * 8;
            const u32x4 vv = *(const u32x4*)(rv + go); *(LAS u32x4*)(C.lds + row * TLD + ch * 16) = vv;
            float f[8]; unpack8(*(const u32x4*)(rk + go), f); const float z = exp2f(lg2 * (float)(127 - row));
            *(LAS u32x4*)(C.lds + 128 * TLD + row * TLD + ch * 16) = pack8((f32x4){f[0] * z, f[1] * z, f[2] * z, f[3] * z}, (f32x4){f[4] * z, f[5] * z, f[6] * z, f[7] * z}); }
        __syncthreads();
        f32x4 acc[8][4];
#pragma unroll
        for (int m = 0; m < 8; ++m)
#pragma unroll
            for (int nn = 0; nn < 4; ++nn) acc[m][nn] = (f32x4){0.f, 0.f, 0.f, 0.f};
#pragma unroll 1
        for (int ks = 0; ks < 4; ++ks) { bf16x8 Bv[4];
#pragma unroll
            for (int nn = 0; nn < 4; ++nn) Bv[nn] = tr_frag(Vt, TLD, 32 * ks + 8 * g, 32 * ks + 8 * g + 4, 64 * wc + 16 * nn, C.lane);
#pragma unroll
            for (int m = 0; m < 8; ++m) { const bf16x8 Ak = tr_frag(Kt, TLD, 32 * ks + 8 * g, 32 * ks + 8 * g + 4, 128 * wr + 16 * m, C.lane);
#pragma unroll
                for (int nn = 0; nn < 4; ++nn) acc[m][nn] = __builtin_amdgcn_mfma_f32_16x16x32_bf16(Ak, Bv[nn], acc[m][nn], 0, 0, 0); } }
        bf16_t* out = KV + (size_t)u * 65536;
#pragma unroll
        for (int m = 0; m < 8; ++m)
#pragma unroll
            for (int nn = 0; nn < 4; ++nn) { const int e = 64 * wc + 16 * nn + fr, d = 128 * wr + 16 * m + 4 * g; u32x2 w; w.x = cvt_pk_bf16(acc[m][nn][0], acc[m][nn][1]); w.y = cvt_pk_bf16(acc[m][nn][2], acc[m][nn][3]);
                *(u32x2*)(out + e * 256 + d) = w; }
    }
}
__device__ __forceinline__ void ph_ret_scan(const Ctx& C) {
    const bf16_t* KV = WSP(bf16_t, WS_KV); bf16_t* Rb = WSP(bf16_t, WS_R);
    for (int idx = C.bid * 512 + C.tid; idx < 16 * 8192; idx += C.G * 512) {
        const int bh = idx >> 13, off = (idx & 8191) * 8, h = bh & 3; const float gc = exp2f(128.0f * log2f(1.0f - exp2f(-5.0f - (float)h)));
        float R[8] = {0.f, 0.f, 0.f, 0.f, 0.f, 0.f, 0.f, 0.f};
#pragma unroll 4
        for (int n = 0; n < 32; ++n) { const size_t o = ((size_t)bh * 32 + n) * 65536 + off;
            *(u32x4*)(Rb + o) = pack8((f32x4){R[0], R[1], R[2], R[3]}, (f32x4){R[4], R[5], R[6], R[7]});
            float f[8]; unpack8(*(const u32x4*)(KV + o), f);
#pragma unroll
            for (int j = 0; j < 8; ++j) R[j] = R[j] * gc + f[j]; }
    }
}
__device__ __forceinline__ void ph_ret_out(const Ctx& C) {
    const bf16_t* rq = WSP(bf16_t, WS_PROJ + P_RQ); const bf16_t* rk = WSP(bf16_t, WS_PROJ + P_RK); const bf16_t* rv = WSP(bf16_t, WS_PROJ + P_RV); const bf16_t* rg = WSP(bf16_t, WS_PROJ + P_RG);
    const bf16_t* Rb = WSP(bf16_t, WS_R); bf16_t* ret = WSP(bf16_t, WS_RET);
    const LAS unsigned char* Vt = C.lds;
    const int w = C.wave;
    for (int u = C.bid; u < 512; u += C.G) {
        int tid_ = C.tid; asm volatile("" : "+v"(tid_));
        const int tid = tid_, lane = tid & 63, g = lane >> 4, fr = lane & 15;
        const int n = u & 31, h = (u >> 5) & 3, b = u >> 7; const size_t row0 = (size_t)b * SEQ + n * 128;
        const float lg2 = log2f(1.0f - exp2f(-5.0f - (float)h));
        constexpr int R_OFF = 128 * TLD, RLD = 272;
        u32x4 Vr[8], Rr[8];
#pragma unroll
        for (int p = 0; p < 8; ++p) { const int idx = p * 512 + tid, row = idx >> 5, ch = idx & 31; Vr[p] = *(const u32x4*)(rv + (row0 + row) * 1024 + h * 256 + ch * 8); }
        if (n > 0) {
#pragma unroll
            for (int p = 0; p < 8; ++p) { const int idx = p * 512 + tid, e = idx >> 4, c16 = idx & 15; Rr[p] = *(const u32x4*)(Rb + (size_t)u * 65536 + (size_t)e * 256 + c16 * 8); } }
        const int i = 16 * w + fr;
        bf16x8 Bq[8];
        { const bf16_t* qp = rq + (row0 + i) * 1024 + h * 256 + 8 * g;
#pragma unroll
          for (int ks = 0; ks < 8; ++ks) Bq[ks] = as_bf16x8(*(const u32x4*)(qp + 32 * ks)); }
        f32x4 acc[16];
#pragma unroll
        for (int nt = 0; nt < 16; ++nt) acc[nt] = (f32x4){0.f, 0.f, 0.f, 0.f};
        __syncthreads();
#pragma unroll
        for (int p = 0; p < 8; ++p) { const int idx = p * 512 + tid, row = idx >> 5, ch = idx & 31; *(LAS u32x4*)(C.lds + row * TLD + ch * 16) = Vr[p]; }
        if (n > 0) {
#pragma unroll
            for (int p = 0; p < 8; ++p) { const int idx = p * 512 + tid, e = idx >> 4, c16 = idx & 15; *(LAS u32x4*)(C.lds + R_OFF + e * RLD + c16 * 16) = Rr[p]; }
#pragma unroll
            for (int p = 0; p < 8; ++p) { const int idx = p * 512 + tid, e = idx >> 4, c16 = idx & 15; Rr[p] = *(const u32x4*)(Rb + (size_t)u * 65536 + (size_t)e * 256 + 128 + c16 * 8); }
#pragma unroll
            for (int dh = 0; dh < 2; ++dh) {
                if (dh) { __syncthreads();
#pragma unroll
                    for (int p = 0; p < 8; ++p) { const int idx = p * 512 + tid, e = idx >> 4, c16 = idx & 15; *(LAS u32x4*)(C.lds + R_OFF + e * RLD + c16 * 16) = Rr[p]; } }
                __syncthreads();
#pragma unroll
                for (int k4 = 0; k4 < 4; ++k4)
#pragma unroll
                    for (int nt = 0; nt < 16; ++nt) { const bf16x8 Ar = as_bf16x8(*(const LAS u32x4*)(C.lds + R_OFF + (16 * nt + fr) * RLD + (32 * k4 + 8 * g) * 2));
                        acc[nt] = __builtin_amdgcn_mfma_f32_16x16x32_bf16(Ar, Bq[4 * dh + k4], acc[nt], 0, 0, 0); }
            }
            const float xi = exp2f(lg2 * (float)(i + 1));
#pragma unroll
            for (int nt = 0; nt < 16; ++nt) acc[nt] = acc[nt] * xi;
        } else __syncthreads();
        f32x4 ST[8];
#pragma unroll
        for (int jt = 0; jt < 8; ++jt) { ST[jt] = (f32x4){0.f, 0.f, 0.f, 0.f};
            if (jt <= w) { const bf16_t* kp = rk + (row0 + 16 * jt + fr) * 1024 + h * 256 + 8 * g;
#pragma unroll
                for (int ks = 0; ks < 8; ++ks) { const bf16x8 Ak = as_bf16x8(*(const u32x4*)(kp + 32 * ks)); ST[jt] = __builtin_amdgcn_mfma_f32_16x16x32_bf16(Ak, Bq[ks], ST[jt], 0, 0, 0); }
#pragma unroll
                for (int r = 0; r < 4; ++r) { const int j = 16 * jt + 4 * g + r; ST[jt][r] = (i >= j) ? ST[jt][r] * exp2f(lg2 * (float)(i - j)) : 0.f; }
                asm volatile("" ::: "memory"); } }
#pragma unroll
        for (int t = 0; t < 4; ++t) if (2 * t <= w) {
            u32x4 sw; sw.x = cvt_pk_bf16(ST[2 * t][0], ST[2 * t][1]); sw.y = cvt_pk_bf16(ST[2 * t][2], ST[2 * t][3]); sw.z = cvt_pk_bf16(ST[2 * t + 1][0], ST[2 * t + 1][1]); sw.w = cvt_pk_bf16(ST[2 * t + 1][2], ST[2 * t + 1][3]);
            const bf16x8 Bs = as_bf16x8(sw);
#pragma unroll
            for (int nt = 0; nt < 16; ++nt) { const bf16x8 Av = tr_frag(Vt, TLD, 32 * t + 4 * g, 32 * t + 16 + 4 * g, 16 * nt, lane); acc[nt] = __builtin_amdgcn_mfma_f32_16x16x32_bf16(Av, Bs, acc[nt], 0, 0, 0); } }
        float ss = 0.f;
#pragma unroll
        for (int nt = 0; nt < 16; ++nt) ss += acc[nt][0] * acc[nt][0] + acc[nt][1] * acc[nt][1] + acc[nt][2] * acc[nt][2] + acc[nt][3] * acc[nt][3];
        ss = quad_sum(ss);
        const float rstd = rsqrtf(ss * (1.f / 256.f) + EPS);
        const size_t ob = (row0 + i) * 1024 + h * 256 + 4 * g;
#pragma unroll
        for (int nt = 0; nt < 16; ++nt) { const u32x2 gw = *(const u32x2*)(rg + ob + 16 * nt); u32x2 o;
            o.x = cvt_pk_bf16(acc[nt][0] * rstd * bf2f(gw.x), acc[nt][1] * rstd * bf2f(gw.x >> 16)); o.y = cvt_pk_bf16(acc[nt][2] * rstd * bf2f(gw.y), acc[nt][3] * rstd * bf2f(gw.y >> 16));
            *(u32x2*)(ret + ob + 16 * nt) = o; }
    }
}
__device__ __forceinline__ void ph_gmlp(const Ctx& C, int l) {
    const bf16_t* gu = WSP(bf16_t, WS_PROJ + P_GU); const bf16_t* gv = WSP(bf16_t, WS_PROJ + P_GV); const float* stats = WSP(float, WS_STATS); bf16_t* gm = WSP(bf16_t, WS_GM);
    const float* lng = C.in[I_LNG] + l * 1024; const float* lnb = C.in[I_LNB] + l * 1024; const float* Wsp = C.in[I_WS] + (size_t)l * 4 * 128 * 128; const float* bs = C.in[I_BS] + l * 4 * 128;
    constexpr int WLD = 272, W_OFF = 128 * TLD, ST_OFF = W_OFF + 128 * WLD;
    const LAS unsigned char* Lt = C.lds; LAS float* sst = (LAS float*)(C.lds + ST_OFF);
    const int g4 = C.lane >> 4, fr = C.lane & 15, w = C.wave;
    for (int u = C.bid; u < 512; u += C.G) {
        const int gg = u & 3, bn = u >> 2, t0 = bn * 128;
        __syncthreads();
        if (C.tid < 128) { const float* sp = stats + (size_t)(t0 + C.tid) * 32; float s = 0.f, q = 0.f;
#pragma unroll
            for (int k = 0; k < 16; ++k) { s += sp[2 * k]; q += sp[2 * k + 1]; }
            const float mean = s * (1.f / 1024.f), var = q * (1.f / 1024.f) - mean * mean; sst[2 * C.tid] = mean; sst[2 * C.tid + 1] = rsqrtf(var + EPS); }
#pragma unroll
        for (int p = 0; p < 4; ++p) { const int idx = p * 512 + C.tid, i = idx >> 4, j8 = (idx & 15) * 8; const float* wp = Wsp + ((size_t)gg * 128 + i) * 128 + j8;
            f32x4 a = *(const f32x4*)wp, b2 = *(const f32x4*)(wp + 4);
#pragma unroll
            for (int j = 0; j < 4; ++j) { if (j8 + j > i) a[j] = 0.f; if (j8 + 4 + j > i) b2[j] = 0.f; }
            *(LAS u32x4*)(C.lds + W_OFF + i * WLD + j8 * 2) = pack8(a, b2); }
        __syncthreads();
#pragma unroll
        for (int p = 0; p < 8; ++p) { const int idx = p * 512 + C.tid, row = idx >> 5, ch = idx & 31, cg = gg * 256 + ch * 8;
            float f[8]; unpack8(*(const u32x4*)(gv + (size_t)(t0 + row) * 1024 + cg), f); const float mean = sst[2 * row], rstd = sst[2 * row + 1];
            const f32x4 g0 = *(const f32x4*)(lng + cg), g1 = *(const f32x4*)(lng + cg + 4), b0 = *(const f32x4*)(lnb + cg), b1 = *(const f32x4*)(lnb + cg + 4);
            f32x4 y0, y1;
#pragma unroll
            for (int j = 0; j < 4; ++j) { y0[j] = (f[j] - mean) * rstd * g0[j] + b0[j]; y1[j] = (f[4 + j] - mean) * rstd * g1[j] + b1[j]; }
            *(LAS u32x4*)(C.lds + row * TLD + ch * 16) = pack8(y0, y1); }
        __syncthreads();
        f32x4 acc[16];
#pragma unroll
        for (int nt = 0; nt < 16; ++nt) acc[nt] = (f32x4){0.f, 0.f, 0.f, 0.f};
#pragma unroll
        for (int ks = 0; ks < 4; ++ks) if (2 * ks <= w) {
            const bf16x8 Bw = as_bf16x8(*(const LAS u32x4*)(C.lds + W_OFF + (16 * w + fr) * WLD + (32 * ks + 8 * g4) * 2));
#pragma unroll
            for (int nt = 0; nt < 16; ++nt) { const bf16x8 Av = tr_frag(Lt, TLD, 32 * ks + 8 * g4, 32 * ks + 8 * g4 + 4, 16 * nt, C.lane); acc[nt] = __builtin_amdgcn_mfma_f32_16x16x32_bf16(Av, Bw, acc[nt], 0, 0, 0); } }
        const int i = 16 * w + fr; const float bias = bs[gg * 128 + i]; const size_t ob = (size_t)(t0 + i) * 1024 + gg * 256 + 4 * g4;
#pragma unroll
        for (int nt = 0; nt < 16; ++nt) { const u32x2 uw = *(const u32x2*)(gu + ob + 16 * nt); u32x2 o;
            o.x = cvt_pk_bf16((acc[nt][0] + bias) * bf2f(uw.x), (acc[nt][1] + bias) * bf2f(uw.x >> 16)); o.y = cvt_pk_bf16((acc[nt][2] + bias) * bf2f(uw.y), (acc[nt][3] + bias) * bf2f(uw.y >> 16));
            *(u32x2*)(gm + ob + 16 * nt) = o; }
    }
}

__device__ __forceinline__ void ph_idx(const Ctx& C) {
    const bf16_t* iq = WSP(bf16_t, WS_PROJ + P_IQ); const bf16_t* ik = WSP(bf16_t, WS_PROJ + P_IK); const float* iw = WSP(float, WS_PROJ + P_IW); unsigned short* sel = WSP(unsigned short, WS_SEL);
    LAS unsigned* sc = (LAS unsigned*)C.lds;
    const int lane = C.lane, n32 = lane & 31, hh = lane >> 5, w = C.wave;
    for (int u = C.bid; u < T / 8; u += C.G) {
        const int b = u & 3, q0 = (SEQ / 8 - 1 - (u >> 2)) * 8, tq0 = b * SEQ + q0, nk = q0 + 8, nkt = (nk + 31) >> 5;
        __syncthreads();
        bf16x8 Aq[2][4]; float wq[2][16];
        { const int r = n32, qi = 2 * ((r >> 2) & 1) + (r >> 4), hd = (r & 3) + 4 * ((r >> 3) & 1);
#pragma unroll
          for (int mt = 0; mt < 2; ++mt) { const bf16_t* qp = iq + (size_t)(tq0 + 4 * mt + qi) * 512 + hd * 64 + 8 * hh;
#pragma unroll
              for (int ks = 0; ks < 4; ++ks) Aq[mt][ks] = as_bf16x8(*(const u32x4*)(qp + 16 * ks));
#pragma unroll
              for (int a = 0; a < 2; ++a) { const float* wp = iw + (size_t)(tq0 + 4 * mt + 2 * hh + a) * 8; const f32x4 w0 = *(const f32x4*)wp, w1 = *(const f32x4*)(wp + 4);
#pragma unroll
                  for (int j = 0; j < 4; ++j) { wq[mt][8 * a + j] = w0[j] * 0.125f; wq[mt][8 * a + 4 + j] = w1[j] * 0.125f; } } } }
        u32x4 Bn[4];
        { const bf16_t* kp = ik + ((size_t)b * SEQ + 32 * (w < nkt ? w : 0) + n32) * 64 + 8 * hh;
#pragma unroll
          for (int ks = 0; ks < 4; ++ks) Bn[ks] = *(const u32x4*)(kp + 16 * ks); }
        for (int kt = w; kt < nkt; kt += 8) {
            bf16x8 Bk[4];
#pragma unroll
            for (int ks = 0; ks < 4; ++ks) Bk[ks] = as_bf16x8(Bn[ks]);
            { const int k2 = (kt + 8 < nkt) ? kt + 8 : kt; const bf16_t* kp = ik + ((size_t)b * SEQ + 32 * k2 + n32) * 64 + 8 * hh;
#pragma unroll
              for (int ks = 0; ks < 4; ++ks) Bn[ks] = *(const u32x4*)(kp + 16 * ks); }
#pragma unroll
            for (int mt = 0; mt < 2; ++mt) { f32x16 acc;
#pragma unroll
                for (int j = 0; j < 16; ++j) acc[j] = 0.f;
#pragma unroll
                for (int ks = 0; ks < 4; ++ks) acc = __builtin_amdgcn_mfma_f32_32x32x16_bf16(Aq[mt][ks], Bk[ks], acc, 0, 0, 0);
#pragma unroll
                for (int a = 0; a < 2; ++a) { float s = 0.f;
#pragma unroll
                    for (int rr = 0; rr < 8; ++rr) s += wq[mt][8 * a + rr] * fmaxf(acc[8 * a + rr], 0.f);
                    const int qu = 4 * mt + 2 * hh + a, key = 32 * kt + n32; unsigned bits = __builtin_bit_cast(unsigned, s);
                    bits = (bits & 0x80000000u) ? ~bits : (bits | 0x80000000u);
                    sc[qu * 4096 + key] = (key <= q0 + qu) ? bits : 0u; } }
        }
        __syncthreads();
        { const int q = q0 + w, n = q + 1; const size_t so = (size_t)(tq0 + w) * 256;
          if (n <= 256) { for (int r = lane; r < 256; r += 64) sel[so + r] = (r < n) ? (unsigned short)r : (unsigned short)0xFFFFu; }
          else {
            const int ni = (n + 63) >> 6;
            unsigned uu[64];
#pragma unroll
            for (int i = 0; i < 64; ++i) uu[i] = (i < ni && 64 * i + lane < nkt * 32) ? sc[w * 4096 + 64 * i + lane] : 0u;
            const int nact = (ni + 15) >> 4, below_const = (4 - nact) * 1024;
            LAS unsigned* slot = sc + w * 4096;
            unsigned Hp[32];
#pragma unroll
            for (int j = 0; j < 32; ++j) Hp[j] = (uu[2 * j] >> 16) | (uu[2 * j + 1] & 0xffff0000u);
#define IDX_BELOW(dst, cval) do { const unsigned cm1_ = ((cval) - 1u) * 0x00010001u; unsigned cnt_ = 0u; \
            _Pragma("unroll") for (int g4 = 0; g4 < 4; ++g4) if (g4 < nact) { _Pragma("unroll") for (int j = 8 * g4; j < 8 * g4 + 8; ++j) cnt_ = pk_below(Hp[j], cm1_, cnt_); } \
            (dst) = wave_total_dpp((int)((cnt_ & 0xffffu) + (cnt_ >> 16))) + below_const; } while (0)
            unsigned Th = 0u; int geT = 4096;
#pragma unroll 1
            for (int bit = 15; bit >= 0; --bit) { const unsigned c = Th | (1u << bit); int bl; IDX_BELOW(bl, c); if (4096 - bl >= 256) { Th = c; geT = 4096 - bl; } }
            int gtT = 0; if (Th != 0xffffu) { int bl; IDX_BELOW(bl, Th + 1u); gtT = 4096 - bl; }
            const int krem = 256 - gtT, nc = geT - gtT;
            unsigned Tv; int need; bool simple;
            if (nc <= 64) {
                int base = 0; const unsigned long long lt = (1ull << lane) - 1ull;
#pragma unroll
                for (int i = 0; i < 64; ++i) { const bool eq = (uu[i] >> 16) == Th; const unsigned long long em = __ballot(eq);
                    if (em) { if (eq) slot[base + __builtin_popcountll(em & lt)] = (uu[i] & 0xffffu) + 1u; base += __builtin_popcountll(em); } }
                asm volatile("s_waitcnt lgkmcnt(0)" ::: "memory");
                const unsigned tv = (lane < nc) ? slot[lane] : 0u;
                unsigned Tl = 0u;
#pragma unroll 1
                for (int bit = 16; bit >= 0; --bit) { const unsigned c = Tl | (1u << bit); if (__builtin_popcountll(__ballot(tv >= c)) >= krem) Tl = c; }
                need = krem - __builtin_popcountll(__ballot(tv > Tl)); simple = (need == __builtin_popcountll(__ballot(tv == Tl)));
                Tv = (Th << 16) | (Tl - 1u);
                asm volatile("s_waitcnt lgkmcnt(0)" ::: "memory");
            } else {
#pragma unroll
                for (int j = 0; j < 32; ++j) { const unsigned a = uu[2 * j], b2 = uu[2 * j + 1]; Hp[j] = (((a >> 16) == Th) ? (a & 0xffffu) : 0u) | (((b2 >> 16) == Th) ? (b2 << 16) : 0u); }
                unsigned Tl = 0u;
#pragma unroll 1
                for (int bit = 15; bit >= 0; --bit) { const unsigned c = Tl | (1u << bit); int bl; IDX_BELOW(bl, c); if (4096 - bl >= krem) Tl = c; }
                Tv = (Th << 16) | Tl; int cg = 0;
#pragma unroll
                for (int i = 0; i < 64; ++i) cg += (uu[i] > Tv) ? 1 : 0;
                need = 256 - wave_total_dpp(cg); simple = false;
            }
#undef IDX_BELOW
            if (simple) {
                int base = 0;
#pragma unroll
                for (int i = 0; i < 64; ++i) if (16 * (i >> 4) < ni) { const bool take = uu[i] >= Tv; const unsigned long long tm = __ballot(take);
                    const int pos = base + (int)__builtin_amdgcn_mbcnt_hi((unsigned)(tm >> 32), __builtin_amdgcn_mbcnt_lo((unsigned)tm, 0u));
                    if (take) sel[so + pos] = (unsigned short)(64 * i + lane);
                    base += __builtin_popcountll(tm); }
            } else {
                int base = 0, eqs = 0; const unsigned long long lt = (1ull << lane) - 1ull;
#pragma unroll
                for (int i = 0; i < 64; ++i) if (16 * (i >> 4) < ni) { const bool gt = uu[i] > Tv, eq = uu[i] == Tv; const unsigned long long em = __ballot(eq);
                    const bool take = gt || (eq && (eqs + __builtin_popcountll(em & lt)) < need); const unsigned long long tm = __ballot(take);
                    if (take) sel[so + base + __builtin_popcountll(tm & lt)] = (unsigned short)(64 * i + lane);
                    base += __builtin_popcountll(tm); eqs += __builtin_popcountll(em); }
            }
          } }
    }
}
__device__ __forceinline__ void ph_att(const Ctx& C) {
    const bf16_t* qabs = WSP(bf16_t, WS_QABS); const bf16_t* ckv = WSP(bf16_t, WS_CKV); const unsigned short* sel = WSP(unsigned short, WS_SEL); bf16_t* olat = WSP(bf16_t, WS_OLAT);
    const int lane = C.lane, g = lane >> 4, fr = lane & 15;
    LAS unsigned char* ch = C.lds + C.wave * (32 * TLD + 512);
    LAS unsigned short* ssel = (LAS unsigned short*)(ch + 32 * TLD);
    for (int tq = C.gw; tq < T; tq += C.NGW) {
        const int b = tq >> 12, q = tq & (SEQ - 1), nv = (q + 1) < 256 ? (q + 1) : 256, nch = (nv + 31) >> 5;
        const bf16_t* cb = ckv + (size_t)b * SEQ * 256;
        { u32x2 sv = *(const u32x2*)(sel + (size_t)tq * 256 + 4 * lane);
          unsigned s0 = sv.x & 0xffffu, s1 = sv.x >> 16, s2_ = sv.y & 0xffffu, s3 = sv.y >> 16;
          if (4 * lane + 0 >= nv) s0 = 0; if (4 * lane + 1 >= nv) s1 = 0; if (4 * lane + 2 >= nv) s2_ = 0; if (4 * lane + 3 >= nv) s3 = 0;
          *(LAS u32x2*)(ssel + 4 * lane) = (u32x2){s0 | (s1 << 16), s2_ | (s3 << 16)}; }
        bf16x8 Bqa[8];
        { const bf16_t* qp = qabs + (size_t)tq * 2048 + (fr & 7) * 256 + 8 * g;
#pragma unroll
          for (int ks = 0; ks < 8; ++ks) { u32x4 v = *(const u32x4*)(qp + 32 * ks); if (fr >= 8) v = (u32x4){0u, 0u, 0u, 0u}; Bqa[ks] = as_bf16x8(v); } }
        f32x4 acc[16];
#pragma unroll
        for (int nt = 0; nt < 16; ++nt) acc[nt] = (f32x4){0.f, 0.f, 0.f, 0.f};
        float mrun = -INFINITY, lrun = 0.f;
        asm volatile("s_waitcnt lgkmcnt(0)" ::: "memory");
        u32x4 G[16];
#pragma unroll
        for (int p = 0; p < 16; ++p) { const int s = ssel[2 * p + (lane >> 5)]; G[p] = *(const u32x4*)(cb + (size_t)s * 256 + (lane & 31) * 8); }
#pragma unroll 1
        for (int t = 0; t < nch; ++t) {
#pragma unroll
            for (int p = 0; p < 16; ++p) *(LAS u32x4*)(ch + (2 * p + (lane >> 5)) * TLD + (lane & 31) * 16) = G[p];
            if (t + 1 < nch) {
#pragma unroll
                for (int p = 0; p < 16; ++p) { const int s = ssel[32 * (t + 1) + 2 * p + (lane >> 5)]; G[p] = *(const u32x4*)(cb + (size_t)s * 256 + (lane & 31) * 8); } }
            asm volatile("s_waitcnt lgkmcnt(0)" ::: "memory");
            f32x4 s2[2];
#pragma unroll
            for (int hf = 0; hf < 2; ++hf) { s2[hf] = (f32x4){0.f, 0.f, 0.f, 0.f};
#pragma unroll
                for (int ks = 0; ks < 8; ++ks) { const bf16x8 Ac = as_bf16x8(*(const LAS u32x4*)(ch + (16 * hf + fr) * TLD + (32 * ks + 8 * g) * 2)); s2[hf] = __builtin_amdgcn_mfma_f32_16x16x32_bf16(Ac, Bqa[ks], s2[hf], 0, 0, 0); } }
            float cm = -INFINITY;
#pragma unroll
            for (int hf = 0; hf < 2; ++hf)
#pragma unroll
                for (int r = 0; r < 4; ++r) { const int ki = 32 * t + 16 * hf + 4 * g + r; if (ki >= nv) s2[hf][r] = -INFINITY; cm = fmaxf(cm, s2[hf][r]); }
            cm = quad_max(cm);
            const float mnew = fmaxf(mrun, cm), scale = __expf(mrun - mnew); float ps = 0.f;
#pragma unroll
            for (int hf = 0; hf < 2; ++hf)
#pragma unroll
                for (int r = 0; r < 4; ++r) { s2[hf][r] = __expf(s2[hf][r] - mnew); ps += s2[hf][r]; }
            ps = quad_sum(ps);
            lrun = lrun * scale + ps; mrun = mnew;
            u32x4 pw; pw.x = cvt_pk_bf16(s2[0][0], s2[0][1]); pw.y = cvt_pk_bf16(s2[0][2], s2[0][3]); pw.z = cvt_pk_bf16(s2[1][0], s2[1][1]); pw.w = cvt_pk_bf16(s2[1][2], s2[1][3]);
            const bf16x8 Bp = as_bf16x8(pw);
#pragma unroll
            for (int nt = 0; nt < 16; ++nt) { const bf16x8 Av = tr_frag(ch, TLD, 4 * g, 16 + 4 * g, 16 * nt, lane); acc[nt] = __builtin_amdgcn_mfma_f32_16x16x32_bf16(Av, Bp, acc[nt] * scale, 0, 0, 0); }
            asm volatile("s_waitcnt lgkmcnt(0)" ::: "memory");
        }
        const float inv = 1.0f / lrun;
        if (fr < 8) { bf16_t* op = olat + (size_t)tq * 2048 + fr * 256 + 4 * g;
#pragma unroll
            for (int nt = 0; nt < 16; ++nt) { u32x2 o; o.x = cvt_pk_bf16(acc[nt][0] * inv, acc[nt][1] * inv); o.y = cvt_pk_bf16(acc[nt][2] * inv, acc[nt][3] * inv); *(u32x2*)(op + 16 * nt) = o; } }
    }
}

__device__ __forceinline__ void ph_norm_hilo(const Ctx& C, const float* x, const float* g, bf16_t* H, bf16_t* HLO) {
    for (int row = C.gw; row < T; row += C.NGW) {
        const f32x4* xr = (const f32x4*)(x + (size_t)row * DM) + C.lane; f32x4 v[8]; float ss = 0.f;
#pragma unroll
        for (int j = 0; j < 8; ++j) { v[j] = xr[64 * j]; ss += v[j][0] * v[j][0] + v[j][1] * v[j][1] + v[j][2] * v[j][2] + v[j][3] * v[j][3]; }
        const float rstd = rsqrtf(wave_sum(ss, C.lane) * (1.f / DM) + EPS);
        u32x2* oh = (u32x2*)(H + (size_t)row * DM) + C.lane; u32x2* ol = (u32x2*)(HLO + (size_t)row * DM) + C.lane;
#pragma unroll
        for (int j = 0; j < 8; ++j) { const f32x4 gg = ((const f32x4*)g)[64 * j + C.lane]; const f32x4 y = v[j] * rstd * gg; u32x2 wh; wh.x = cvt_pk_bf16(y[0], y[1]); wh.y = cvt_pk_bf16(y[2], y[3]);
            u32x2 wl; wl.x = cvt_pk_bf16(y[0] - bf2f(wh.x), y[1] - bf2f(wh.x >> 16)); wl.y = cvt_pk_bf16(y[2] - bf2f(wh.y), y[3] - bf2f(wh.y >> 16)); oh[64 * j] = wh; ol[64 * j] = wl; }
    }
}
__device__ __forceinline__ void ph_route(const Ctx& C, int l) {
    const float* LOG = WSP(float, WS_OLAT); const float* bg = C.in[I_BGRP] + l * 4; const float* be = C.in[I_BEXP] + l * 32;
    int* rinfo = WSP(int, WS_ROUTE); float* rw = (float*)(rinfo + T * 4); unsigned* cnt = C.ctl + CW_CNT + l * 64;
    for (int t0 = C.gw * 8; t0 < T; t0 += C.NGW * 8) if (C.lane < 8) {
        const int t = t0 + C.lane;
        float lg[36];
#pragma unroll
        for (int c = 0; c < 36; ++c) lg[c] = 0.f;
#pragma unroll
        for (int part = 0; part < 4; ++part) { const f32x4* p = (const f32x4*)(LOG + ((size_t)part * T + t) * 128);
#pragma unroll
            for (int c4 = 0; c4 < 9; ++c4) { const f32x4 a = p[c4];
#pragma unroll
                for (int j = 0; j < 4; ++j) lg[4 * c4 + j] += a[j];
                if (part < 2) { const f32x4 b2 = p[16 + c4];
#pragma unroll
                    for (int j = 0; j < 4; ++j) lg[4 * c4 + j] += b2[j]; } } }
        int gsel = 0; float gmax = -INFINITY, gv4[4];
#pragma unroll
        for (int k = 0; k < 4; ++k) { gv4[k] = lg[k] + bg[k]; if (gv4[k] > gmax) { gmax = gv4[k]; gsel = k; } }
        float gden = 0.f;
#pragma unroll
        for (int k = 0; k < 4; ++k) gden += __expf(gv4[k] - gmax);
        const float pg = 1.f / gden;
        float el[8], emax = -INFINITY;
#pragma unroll
        for (int k = 0; k < 8; ++k) { const float v0 = lg[4 + k] + be[k], v1 = lg[12 + k] + be[8 + k], v2 = lg[20 + k] + be[16 + k], v3 = lg[28 + k] + be[24 + k];
            el[k] = gsel == 0 ? v0 : (gsel == 1 ? v1 : (gsel == 2 ? v2 : v3)); emax = fmaxf(emax, el[k]); }
        float eden = 0.f, ep[8];
#pragma unroll
        for (int k = 0; k < 8; ++k) { ep[k] = __expf(el[k] - emax); eden += ep[k]; }
        int i0 = 0; float p0 = -1.f;
#pragma unroll
        for (int k = 0; k < 8; ++k) { ep[k] = ep[k] / eden; if (ep[k] > p0) { p0 = ep[k]; i0 = k; } }
        int i1 = 0; float p1 = -1.f;
#pragma unroll
        for (int k = 0; k < 8; ++k) if (k != i0 && ep[k] > p1) { p1 = ep[k]; i1 = k; }
        const float den = p0 + p1; const int e0 = gsel * 8 + i0, e1 = gsel * 8 + i1;
        const unsigned r0 = atomicAdd(&cnt[e0], 1u), r1 = atomicAdd(&cnt[e1], 1u);
        int* list = WSP(int, WS_LIST); list[(size_t)e0 * T + r0] = t; list[(size_t)e1 * T + r1] = t;
        *(int4*)(rinfo + (size_t)t * 4) = make_int4(e0, e1, (int)r0, (int)r1); *(f32x2*)(rw + (size_t)t * 2) = (f32x2){pg * (p0 / den), pg * (p1 / den)};
    }
}
__device__ __forceinline__ int moe_offsets(const unsigned* cnt, int lane, int& total_tiles) {
    const int c = lane < NEXP ? (int)__hip_atomic_load(cnt + lane, __ATOMIC_RELAXED, __HIP_MEMORY_SCOPE_AGENT) : 0; const int tiles = (c + 255) >> 8;
    int incl = tiles;
#pragma unroll
    for (int o = 1; o < 64; o <<= 1) { const int t = shi(incl, (lane - o) & 63); if (lane >= o) incl += t; }
    total_tiles = shi(incl, 63);
    return (incl - tiles) * 256;
}
__device__ __forceinline__ void ph_permute(const Ctx& C, int l) {
    const bf16_t* H = WSP(bf16_t, WS_H); bf16_t* hperm = WSP(bf16_t, WS_PROJ + M_HPERM); int* rinfo = WSP(int, WS_ROUTE); int* rpos = rinfo + T * 6;
    int tt; const int myoff = moe_offsets(C.ctl + CW_CNT + l * 64 + CNT_BANK, C.lane, tt);
    for (int row = C.gw; row < T; row += C.NGW) {
        const int4 ri = *(const int4*)(rinfo + (size_t)row * 4);
        const int p0 = shi(myoff, ri.x) + ri.z, p1 = shi(myoff, ri.y) + ri.w;
        const u32x4* src = (const u32x4*)(H + (size_t)row * DM) + C.lane; u32x4* d0 = (u32x4*)(hperm + (size_t)p0 * DM) + C.lane; u32x4* d1 = (u32x4*)(hperm + (size_t)p1 * DM) + C.lane;
#pragma unroll
        for (int j = 0; j < 4; ++j) { const u32x4 w = src[64 * j]; d0[64 * j] = w; d1[64 * j] = w; }
        if (C.lane == 0) { rpos[(size_t)row * 2] = p0; rpos[(size_t)row * 2 + 1] = p1; }
    }
}
__device__ __forceinline__ int moe_table(const Ctx& C, int l) {
    __syncthreads();
    if (C.wave == 0) { int tt; const int off = moe_offsets(C.ctl + CW_CNT + l * 64 + CNT_BANK, C.lane, tt); const int nxt = shi(off, (C.lane + 1) & 63);
        if (C.lane < NEXP) { const int t0 = off >> 8, t1 = (C.lane == NEXP - 1) ? tt : (nxt >> 8); const int cn = (int)__hip_atomic_load(C.ctl + CW_CNT + l * 64 + CNT_BANK + C.lane, __ATOMIC_RELAXED, __HIP_MEMORY_SCOPE_AGENT);
            for (int t = t0; t < t1; ++t) { C.misc[16 + t] = C.lane; C.misc[176 + t] = (t - t0) * 256; C.misc[336 + t] = cn; } }
        if (C.lane == 0) C.misc[500] = tt; }
    __syncthreads();
    return C.misc[500];
}
__device__ __forceinline__ void ph_combine(const Ctx& C, int l, float* x, bool last, const float* gnext, bf16_t* Hn) {
    const bf16_t* yc = WSP(bf16_t, WS_PROJ + M_YC); const int* rinfo = WSP(int, WS_ROUTE); const float* rw = (const float*)(rinfo + T * 4); const int* rpos = rinfo + T * 6; const float* gf = C.in[I_FNG];
    int tt_; const int myoff = moe_offsets(C.ctl + CW_CNT + l * 64 + CNT_BANK, C.lane, tt_);
    for (int row = C.gw; row < T; row += C.NGW) {
        const int4 ri = *(const int4*)(rinfo + (size_t)row * 4); const int p0 = shi(myoff, ri.x) + ri.z, p1 = shi(myoff, ri.y) + ri.w; const float w0 = rw[(size_t)row * 2], w1 = rw[(size_t)row * 2 + 1];
        f32x4* xr = (f32x4*)(x + (size_t)row * DM) + C.lane; const u32x2* y0 = (const u32x2*)(yc + (size_t)p0 * DM) + C.lane; const u32x2* y1 = (const u32x2*)(yc + (size_t)p1 * DM) + C.lane;
        f32x4 v[8]; float ss = 0.f;
#pragma unroll
        for (int j = 0; j < 8; ++j) { const u32x2 a = y0[64 * j], b = y1[64 * j]; f32x4 xv = xr[64 * j];
            xv[0] += w0 * bf2f(a.x) + w1 * bf2f(b.x); xv[1] += w0 * bf2f(a.x >> 16) + w1 * bf2f(b.x >> 16); xv[2] += w0 * bf2f(a.y) + w1 * bf2f(b.y); xv[3] += w0 * bf2f(a.y >> 16) + w1 * bf2f(b.y >> 16);
            v[j] = xv; ss += xv[0] * xv[0] + xv[1] * xv[1] + xv[2] * xv[2] + xv[3] * xv[3]; }
        if (last) { const float rstd = rsqrtf(wave_sum(ss, C.lane) * (1.f / DM) + EPS);
#pragma unroll
            for (int j = 0; j < 8; ++j) xr[64 * j] = v[j] * rstd * ((const f32x4*)gf)[64 * j + C.lane]; }
        else { const float rstd = rsqrtf(wave_sum(ss, C.lane) * (1.f / DM) + EPS); u32x2* o = (u32x2*)(Hn + (size_t)row * DM) + C.lane;
#pragma unroll
            for (int j = 0; j < 8; ++j) { xr[64 * j] = v[j]; const f32x4 y = v[j] * rstd * ((const f32x4*)gnext)[64 * j + C.lane]; u32x2 w; w.x = cvt_pk_bf16(y[0], y[1]); w.y = cvt_pk_bf16(y[2], y[3]); o[64 * j] = w; } }
    }
}

constexpr int NPL = 14, NPHASES = 1 + DEPTH * NPL;
#if MK_PER_PHASE
#define IN(k) (lo <= (k) && (k) < hi)
#else
#define IN(k) true
#endif
#if MK_PER_PHASE
#define SEAM(k) do { } while (0)
#else
#define SEAM(k) xcd_barrier(bar)
#endif
template <int l> __device__ __forceinline__ void run_layer(Ctx& C, const XcdBarrier& bar, const int lo, const int hi) {
    unsigned char* wb = (unsigned char*)(C.ws + WS_W);
    bf16_t* H = WSP(bf16_t, WS_H);
        const int pb = 1 + l * NPL;
        const float* xin = (l == 0) ? C.in[I_X] : (const float*)C.out;
        if (l == 0) { if (IN(pb + 0)) { refresh(C); ph_rope(C); refresh(C); REP(1) ph_weights(C, 0); REP(2) ph_norm(C, xin, C.in[I_NMIX], H); }
            SEAM(pb + 0); }
        if (IN(pb + 1)) { refresh(C);
            pg8::Gemm g{H, (const bf16_t*)(wb + W_IN), DM, DM, DM}; pg8::OrderMN S; S.init(T / 256, NP / 256, C.G, C.bid, 256L * DM * 2, 256L * DM * 2);
            pg8::EpiInProj E{(unsigned char*)C.ws};
            REP(3) pg8::gemm_phase(C.lds, g, S, E);
        }
        SEAM(pb + 1);
        if (IN(pb + 2)) { refresh(C);
            ph_ckv(C, WSP(float, WS_PROJ + P_DC), C.in[I_KVG] + l * 256, WSP(bf16_t, WS_CKV));
            { pg8::Gemm g{WSP(bf16_t, WS_PROJ + P_DQ), (const bf16_t*)(wb + W_UK), 1024, 256, 256}; pg8::OrderMN S; S.init(T / 256, 8, C.G, C.bid, 256L * 1024 * 2, 256L * 256 * 2, 1, 256L * 2);
              pg8::EpiStore<0> E{WSP(bf16_t, WS_QABS), 2048, 0.08838834764831845f}; REP(4) pg8::gemm_phase(C.lds, g, S, E); }
            refresh(C);
#if NAIVE_GMLP
            ph_gmlp_naive(C, l);
#else
            REP(5) ph_gmlp(C, l);
#endif
            refresh(C);
#if !NAIVE_RET
            REP(6) ph_ret_kv(C);
#endif
            refresh(C);
#if NAIVE_IDX
            ph_idx_naive(C);
#else
            REP(7) ph_idx(C);
#endif
        }
        SEAM(pb + 2);
        if (IN(pb + 3)) { refresh(C);
#if !NAIVE_RET
            REP(8) ph_ret_scan(C);
#endif
#if NAIVE_ATT
            ph_att_naive(C);
#else
            REP(9) ph_att(C);
#endif
        }
        SEAM(pb + 3);
        if (IN(pb + 4)) { refresh(C);
            { pg8::Gemm g{WSP(bf16_t, WS_OLAT), (const bf16_t*)(wb + W_UV), 2048, 512, 512}; pg8::OrderMN S; S.init(T / 256, 4, C.G, C.bid, 256L * 2048 * 2, 256L * 512 * 2, 0, 512L * 2);
              pg8::EpiStore<0> E{WSP(bf16_t, WS_DS), 1024, 1.0f}; REP(10) pg8::gemm_phase(C.lds, g, S, E); }
#if NAIVE_RET
            ph_ret_naive(C);
#else
            REP(11) ph_ret_out(C);
#endif
        }
        SEAM(pb + 4);
        if (IN(pb + 5)) { refresh(C);
            pg8::Gemm g{WSP(bf16_t, WS_RET), (const bf16_t*)(wb + W_RET), 1024, 1024, 1024}; pg8::OrderBranch S; S.base.init(T / 256, 8, C.G, C.bid, 256L * 1024 * 2, 256L * 1024 * 2); S.astride = 32L << 20; S.bstride = 4L << 20;
            pg8::EpiBranch E{WSP(bf16_t, WS_PROJ + P_GA), H}; REP(12) pg8::gemm_phase<pg8::EpiBranch, pg8::OrderBranch, false, true>(C.lds, g, S, E);
        }
        SEAM(pb + 5);
        if (IN(pb + 6)) { refresh(C);
            pg8::Gemm g{H, (const bf16_t*)(wb + W_OUT), DM, DM, DM}; pg8::OrderMN S; S.init(T / 256, 8, C.G, C.bid, 256L * DM * 2, 256L * DM * 2);
            pg8::EpiResid E{xin, C.out}; for (int rep_ = 0; rep_ <= ((l == 0) ? ((PROBE_MASK >> 17) & 1) : 0); ++rep_) pg8::gemm_phase(C.lds, g, S, E);
        }
        SEAM(pb + 6);
        if (IN(pb + 7)) { refresh(C); ph_norm_hilo(C, C.out, C.in[I_NFFN] + l * DM, H, WSP(bf16_t, WS_QABS)); }
        SEAM(pb + 7);
        if (IN(pb + 8)) { refresh(C);
            pg8::Gemm g{H, (const bf16_t*)(wb + W_RT), DM, DM, 1024}; pg8::OrderRouter S{C.G, C.bid, (long)(WS_QABS - WS_H)};
            pg8::EpiRouter E{WSP(float, WS_OLAT)}; pg8::gemm_phase(C.lds, g, S, E);
        }
        SEAM(pb + 8);
        if (IN(pb + 9)) { refresh(C); ph_route(C, l); }
        SEAM(pb + 9);
        if (IN(pb + 11)) { refresh(C);
            const int Mt = moe_table(C, l);
            pg8::Gemm g{H, (const bf16_t*)(wb + W_13), DM, DM, DM};
            pg8::OrderMoE S{C.misc + 16, Mt, 4, C.G, C.bid, 256L * DM * 2, 256L * DM * 2, 1024L * DM * 2, WSP(int, WS_LIST)};
            pg8::EpiMoeUp E{WSP(bf16_t, WS_PROJ + M_HID)}; REP(14) pg8::gemm_phase<pg8::EpiMoeUp, pg8::OrderMoE, true>(C.lds, g, S, E);
        }
        SEAM(pb + 11);
        if (IN(pb + 12)) { refresh(C);
            const int Mt = moe_table(C, l);
            pg8::Gemm g{WSP(bf16_t, WS_PROJ + M_HID), (const bf16_t*)(wb + W_2), FF, FF, FF};
            pg8::OrderMoE S{C.misc + 16, Mt, 8, C.G, C.bid, 256L * FF * 2, 256L * FF * 2, (long)DM * FF * 2, nullptr};
            pg8::EpiStore<0> E{WSP(bf16_t, WS_PROJ + M_YC), DM, 1.0f}; REP(15) pg8::gemm_phase(C.lds, g, S, E);
        }
        SEAM(pb + 12);
        if (IN(pb + 13)) { refresh(C); ph_combine(C, l, C.out, l == DEPTH - 1, C.in[I_NMIX] + (l + 1 < DEPTH ? l + 1 : l) * DM, H); if (l + 1 < DEPTH) { refresh(C); ph_weights(C, l + 1); } }
        if (l + 1 < DEPTH) SEAM(pb + 13);

}
__global__ void __launch_bounds__(512, 2) mk_fwd(Args a) {
    extern __shared__ __attribute__((aligned(16))) unsigned char lds_raw[];
    Ctx C;
    C.lds = (LAS unsigned char*)lds_raw; C.misc = (volatile LAS int*)(C.lds + MISC_OFF); C.ws = (GAS unsigned char*)a.ws; C.ctl = (unsigned*)(a.ws + WS_CTL);
    C.tid = threadIdx.x; C.lane = C.tid & 63; C.wave = __builtin_amdgcn_readfirstlane(C.tid >> 6); C.G = gridDim.x; C.bid = blockIdx.x;
    C.gw = C.bid * 8 + C.wave; C.NGW = C.G * 8; C.in = a.in; C.out = a.out;
    for (int i = C.tid; i < 1024; i += 512) C.misc[i] = 0;
    __syncthreads();
#if MK_PER_PHASE
    XcdBarrier bar; bar.bar = C.ctl + CW_BAR; bar.x = 0; bar.st = (volatile LAS unsigned*)C.misc;
#else
    XcdBarrier bar = xcd_barrier_post(C.ctl + CW_BAR, (volatile LAS unsigned*)C.misc);
#endif
    const int lo = a.ph_lo, hi = a.ph_hi;
    run_layer<0>(C, bar, lo, hi);
    run_layer<1>(C, bar, lo, hi);
}

extern "C" void kernel_launch(void* const* d_in, const int* in_sizes, int n_in, void* d_out, int out_size, void* d_ws, size_t ws_size, hipStream_t stream) {
    static int grid = 0;
    if (grid == 0) {
        if (n_in != 23 || out_size != T * DM || ws_size < WS_END) { fprintf(stderr, "kernel_launch: unexpected shapes / workspace (n_in %d out %d ws %zu need %zu)\n", n_in, out_size, ws_size, (size_t)WS_END); grid = -1; return; }
        int dev = 0, cus = 0, per_cu = 0;
        if (hipGetDevice(&dev) != hipSuccess || hipDeviceGetAttribute(&cus, hipDeviceAttributeMultiprocessorCount, dev) != hipSuccess) { grid = -1; return; }
        if (hipFuncSetAttribute((const void*)mk_fwd, hipFuncAttributeMaxDynamicSharedMemorySize, LDS_BYTES) != hipSuccess) { fprintf(stderr, "kernel_launch: hipFuncSetAttribute failed\n"); grid = -1; return; }
        if (hipOccupancyMaxActiveBlocksPerMultiprocessor(&per_cu, (const void*)mk_fwd, 512, LDS_BYTES) != hipSuccess || per_cu < 1) { fprintf(stderr, "kernel_launch: occupancy query says %d\n", per_cu); (void)hipGetLastError(); grid = -1; return; }
        grid = cus;
    }
    if (grid < 0) return;
    (void)hipMemsetAsync((char*)d_ws + WS_CTL, 0, CTL_BYTES, stream);
    Args a{};
    for (int i = 0; i < 23; ++i) a.in[i] = (const float*)d_in[i];
    a.out = (float*)d_out; a.ws = (unsigned char*)d_ws;
#if MK_PER_PHASE
    for (int p = 0; p < NPHASES; ++p) { a.ph_lo = p; a.ph_hi = p + 1; hipLaunchKernelGGL(mk_fwd, dim3(grid), dim3(512), LDS_BYTES, stream, a); }
#else
    a.ph_lo = 0; a.ph_hi = NPHASES;
    hipLaunchKernelGGL(mk_fwd, dim3(grid), dim3(512), LDS_BYTES, stream, a);
#endif
}
```

```cpp
#include <hip/hip_runtime.h>
#include <stdint.h>
#include <stdio.h>

#ifndef MK_PER_PHASE
#define MK_PER_PHASE 0
#endif
#ifndef PROBE_MASK
#define PROBE_MASK 0
#endif
#define CNT_BANK (((PROBE_MASK >> 16) & 1) * 128)
#define REP(k) for (int rep_ = 0; rep_ <= ((PROBE_MASK >> (k)) & 1); ++rep_)

#define LAS __attribute__((address_space(3)))
#define GAS __attribute__((address_space(1)))
typedef unsigned short bf16_t;
typedef short bf16x8 __attribute__((ext_vector_type(8)));
typedef short s16x4 __attribute__((ext_vector_type(4)));
typedef float f32x4 __attribute__((ext_vector_type(4)));
typedef float f32x2 __attribute__((ext_vector_type(2)));
typedef float f32x16 __attribute__((ext_vector_type(16)));
typedef unsigned u32x4 __attribute__((ext_vector_type(4)));
typedef unsigned u32x2 __attribute__((ext_vector_type(2)));

constexpr int DM = 2048, NB = 4, SEQ = 4096, T = NB * SEQ, DEPTH = 2;
constexpr int INW = 14152, NP = 14336;
constexpr int GATE_SRC0 = 8008, GATE_DST0 = 8192;
constexpr int NEXP = 32, FF = 512, MOE_ROWS = 40960;
constexpr float EPS = 1e-6f;

constexpr size_t MiB = 1u << 20;
constexpr size_t WS_CTL = 0, CTL_BYTES = 1 * MiB;
constexpr size_t WS_ROPE = 1 * MiB;
constexpr size_t WS_W = 5 * MiB;
constexpr size_t W_IN = 0, W_RET = 56 * MiB, W_GM = 60 * MiB, W_DS = 64 * MiB, W_OUT = 68 * MiB, W_13 = 76 * MiB, W_2 = 204 * MiB, W_UK = 268 * MiB, W_UV = 269 * MiB, W_RT = 270 * MiB  , W_END = 271 * MiB;
constexpr size_t WS_H = WS_W + W_END;
constexpr size_t WS_PROJ = WS_H + 64 * MiB;
constexpr size_t P_RQ = 0, P_RK = 32 * MiB, P_RV = 64 * MiB, P_RG = 96 * MiB, P_GU = 128 * MiB, P_GV = 160 * MiB, P_DQ = 192 * MiB, P_DC = 224 * MiB  ,
                 P_IQ = 240 * MiB  , P_IK = 256 * MiB  , P_IW = 258 * MiB  , P_GA = 260 * MiB, P_GB = 324 * MiB, P_GC = 388 * MiB, P_END = 452 * MiB;
constexpr size_t M_HPERM = 0, M_HID = 160 * MiB, M_YC = 200 * MiB;
constexpr size_t WS_KV = WS_PROJ + P_END;
constexpr size_t WS_R = WS_KV + 64 * MiB;
constexpr size_t WS_QABS = WS_R + 64 * MiB;
constexpr size_t WS_OLAT = WS_QABS + 64 * MiB;
constexpr size_t WS_RET = WS_OLAT + 64 * MiB;
constexpr size_t WS_GM = WS_RET + 32 * MiB, WS_DS = WS_GM + 32 * MiB;
constexpr size_t WS_SEL = WS_DS + 32 * MiB;
constexpr size_t WS_CKV = WS_SEL + 8 * MiB;
constexpr size_t WS_STATS = WS_CKV + 8 * MiB;
constexpr size_t WS_ROUTE = WS_STATS + 2 * MiB;
constexpr size_t WS_LIST = WS_ROUTE + 1 * MiB;
constexpr size_t WS_END = WS_LIST + 2 * MiB;
constexpr int CW_BAR = 4096, CW_CNT = 16384;

constexpr int LDS_BYTES = 147456, MISC_OFF = LDS_BYTES - 4096;

__device__ __forceinline__ unsigned f2bf(float f) { unsigned u = __builtin_bit_cast(unsigned, f); return (u + 0x7fffu + ((u >> 16) & 1u)) >> 16; }
__device__ __forceinline__ float bf2f(unsigned b) { return __builtin_bit_cast(float, (b & 0xffffu) << 16); }
typedef __bf16 bf16x2_t __attribute__((ext_vector_type(2)));
__device__ __forceinline__ unsigned cvt_pk_bf16(float lo, float hi) { const f32x2 v = {lo, hi}; return __builtin_bit_cast(unsigned, __builtin_convertvector(v, bf16x2_t)); }
__device__ __forceinline__ float shx(float v, int k, int lane) { return __builtin_bit_cast(float, __builtin_amdgcn_ds_bpermute((lane ^ k) << 2, __builtin_bit_cast(int, v))); }
__device__ __forceinline__ void swap32_(float& a, float& b) { asm volatile("v_nop\n\tv_nop\n\tv_permlane32_swap_b32 %0, %1\n\tv_nop" : "+v"(a), "+v"(b)); }
__device__ __forceinline__ void swap16_(float& a, float& b) { asm volatile("v_nop\n\tv_nop\n\tv_permlane16_swap_b32 %0, %1\n\tv_nop" : "+v"(a), "+v"(b)); }
__device__ __forceinline__ float quad_sum(float v) { float a = v, b = v; swap32_(a, b); v = a + b; a = v; b = v; swap16_(a, b); return a + b; }
__device__ __forceinline__ float quad_max(float v) { float a = v, b = v; swap32_(a, b); v = fmaxf(a, b); a = v; b = v; swap16_(a, b); return fmaxf(a, b); }
__device__ __forceinline__ int shi(int v, int src) { return __builtin_amdgcn_ds_bpermute(src << 2, v); }
typedef unsigned short u16x2 __attribute__((ext_vector_type(2)));
__device__ __forceinline__ unsigned pk_below(unsigned x, unsigned cm1, unsigned cnt) {
    u16x2 r = __builtin_elementwise_sub_sat(__builtin_bit_cast(u16x2, x), __builtin_bit_cast(u16x2, cm1)); unsigned ru = __builtin_bit_cast(unsigned, r); asm volatile("" : "+v"(ru));
    r = __builtin_elementwise_sub_sat((u16x2){1, 1}, __builtin_bit_cast(u16x2, ru)); ru = __builtin_bit_cast(unsigned, r); asm volatile("" : "+v"(ru));
    return __builtin_bit_cast(unsigned, (u16x2)(__builtin_bit_cast(u16x2, cnt) + __builtin_bit_cast(u16x2, ru)));
}
__device__ __forceinline__ int wave_total_dpp(int x) {
    x += __builtin_amdgcn_update_dpp(0, x, 0x111, 0xf, 0xf, false);
    x += __builtin_amdgcn_update_dpp(0, x, 0x112, 0xf, 0xf, false);
    x += __builtin_amdgcn_update_dpp(0, x, 0x114, 0xf, 0xf, false);
    x += __builtin_amdgcn_update_dpp(0, x, 0x118, 0xf, 0xf, false);
    x += __builtin_amdgcn_update_dpp(0, x, 0x142, 0xa, 0xf, false);
    x += __builtin_amdgcn_update_dpp(0, x, 0x143, 0xc, 0xf, false);
    return __builtin_amdgcn_readlane(x, 63);
}
__device__ __forceinline__ float wave_sum(float v, int lane) {
#pragma unroll
    for (int o = 1; o < 64; o <<= 1) v += shx(v, o, lane);
    return v;
}
__device__ __forceinline__ float wave_max(float v, int lane) {
#pragma unroll
    for (int o = 1; o < 64; o <<= 1) v = fmaxf(v, shx(v, o, lane));
    return v;
}
__device__ __forceinline__ float sigmoidf_(float x) { return __builtin_amdgcn_rcpf(1.0f + __builtin_amdgcn_exp2f(x * -1.44269504089f)); }
__device__ __forceinline__ float siluf_(float x) { return x * sigmoidf_(x); }
__device__ __forceinline__ f32x2 gelu_pk(f32x2 v) {
    const f32x2 av = __builtin_elementwise_abs(v), d = av * 0.2316418882f + 1.0f;
    f32x2 t; t.x = __builtin_amdgcn_rcpf(d.x); t.y = __builtin_amdgcn_rcpf(d.y);
    f32x2 q = t * 0.5307027145f + (-0.7265760135f); q = q * t + 0.7107068705f; q = q * t + (-0.142248368f); q = q * t + 0.127414796f; q = q * t;
    const f32x2 s = (v * v) * (-0.72134752044f);
    f32x2 e; e.x = __builtin_amdgcn_exp2f(s.x); e.y = __builtin_amdgcn_exp2f(s.y);
    const f32x2 m = v * (q * e), r = v - m;
    f32x2 o; o.x = v.x < 0.f ? m.x : r.x; o.y = v.y < 0.f ? m.y : r.y; return o;
}
template <int ACT> __device__ __forceinline__ f32x4 act4(f32x4 v) {
    if (ACT == 1) { f32x2 a = gelu_pk((f32x2){v[0], v[1]}), b = gelu_pk((f32x2){v[2], v[3]}); return (f32x4){a.x, a.y, b.x, b.y}; }
    if (ACT == 2) return (f32x4){siluf_(v[0]), siluf_(v[1]), siluf_(v[2]), siluf_(v[3])};
    if (ACT == 3) return (f32x4){sigmoidf_(v[0]), sigmoidf_(v[1]), sigmoidf_(v[2]), sigmoidf_(v[3])};
    return v;
}
__device__ __forceinline__ u32x4 pack8(f32x4 a, f32x4 b) { u32x4 w; w.x = cvt_pk_bf16(a[0], a[1]); w.y = cvt_pk_bf16(a[2], a[3]); w.z = cvt_pk_bf16(b[0], b[1]); w.w = cvt_pk_bf16(b[2], b[3]); return w; }
__device__ __forceinline__ void unpack8(u32x4 w, float (&f)[8]) {
    f[0] = bf2f(w.x); f[1] = bf2f(w.x >> 16); f[2] = bf2f(w.y); f[3] = bf2f(w.y >> 16); f[4] = bf2f(w.z); f[5] = bf2f(w.z >> 16); f[6] = bf2f(w.w); f[7] = bf2f(w.w >> 16);
}

#define XB_TMO      128
#define XB_XCNT(j)  (256  + 64 * (j))
#define XB_XSUB(j)  (1280 + 64 * (j))
#define XB_XGEN(j)  (2304 + 64 * (j))
#define XB_TOP      3328
#define XB_TOPGEN   3392
#define XCD_BAR_WORDS 3456
#define XB_SPIN_CAP (1u << 20)
__device__ __forceinline__ unsigned xb_ld(unsigned* p)              { return __hip_atomic_load(p, __ATOMIC_RELAXED, __HIP_MEMORY_SCOPE_AGENT); }
__device__ __forceinline__ unsigned xb_add(unsigned* p, unsigned v) { return __hip_atomic_fetch_add(p, v, __ATOMIC_RELAXED, __HIP_MEMORY_SCOPE_AGENT); }
__device__ __forceinline__ unsigned xb_xcc_id() { return (unsigned)__builtin_amdgcn_s_getreg((3 << 11) | 20) & 0xFu; }
#define XB_SPIN(cond, bar) do { unsigned _sp = 0; while (cond) { __builtin_amdgcn_s_sleep(1); \
    if ((++_sp & 255u) == 0u) { if (xb_ld(&(bar)[XB_TMO])) break; if (_sp > XB_SPIN_CAP) { atomicAdd(&(bar)[XB_TMO], 1u); break; } } } } while (0)
struct XcdBarrier { unsigned* bar; unsigned x; volatile LAS unsigned* st; };
__device__ __forceinline__ XcdBarrier xcd_barrier_post(unsigned* bar, volatile LAS unsigned* st) {
    XcdBarrier b; b.bar = bar; b.x = xb_xcc_id(); b.st = st;
    if (threadIdx.x == 0) (void)xb_add(&bar[XB_XCNT(b.x)], 1u);
    return b;
}
__device__ __forceinline__ void xcd_barrier_complete(unsigned* bar, unsigned x, unsigned& nloc, unsigned& nx) {
    const unsigned G = gridDim.x * gridDim.y * gridDim.z;
    unsigned sum, cnt, mine, sp = 0u;
    for (;;) {
        sum = 0u; cnt = 0u; mine = 0u;
#pragma unroll
        for (unsigned j = 0; j < 16; ++j) { const unsigned c = xb_ld(&bar[XB_XCNT(j)]); sum += c; cnt += (c > 0u) ? 1u : 0u; mine = (j == x) ? c : mine; }
        if (sum == G) break;
        __builtin_amdgcn_s_sleep(1);
        if ((++sp & 255u) == 0u) { if (xb_ld(&bar[XB_TMO])) break; if (sp > XB_SPIN_CAP) { atomicAdd(&bar[XB_TMO], 1u); break; } }
    }
    nloc = mine > 0u ? mine : 1u; nx = cnt > 0u ? cnt : 1u;
}
__device__ __forceinline__ void xcd_barrier(const XcdBarrier& b) {
    asm volatile("s_waitcnt vmcnt(0)" ::: "memory");
    __syncthreads();
    if (threadIdx.x == 0) {
        unsigned* bar = b.bar; asm volatile("" : "+s"(bar));
        __builtin_amdgcn_s_waitcnt(0);
        unsigned nloc = b.st[0], nx = b.st[1];
        if (nloc == 0u) { xcd_barrier_complete(bar, b.x, nloc, nx); b.st[0] = nloc; b.st[1] = nx; }
        const unsigned old = xb_add(&bar[XB_XSUB(b.x)], 1u);
        const unsigned gen = old / nloc;
        if (old + 1u == (gen + 1u) * nloc) {
            __builtin_amdgcn_fence(__ATOMIC_RELEASE, "agent");
            asm volatile("s_waitcnt vmcnt(0)" ::: "memory");
            const unsigned og = xb_add(&bar[XB_TOP], 1u);
            const unsigned tg = og / nx;
            if (og + 1u == (tg + 1u) * nx) xb_add(&bar[XB_TOPGEN], 1u);
            else XB_SPIN(xb_ld(&bar[XB_TOPGEN]) == tg, bar);
            __builtin_amdgcn_fence(__ATOMIC_ACQUIRE, "agent");
            xb_add(&bar[XB_XGEN(b.x)], 1u);
            asm volatile("s_waitcnt vmcnt(0)" ::: "memory");
        } else {
            XB_SPIN(xb_ld(&bar[XB_XGEN(b.x)]) == gen, bar);
            __builtin_amdgcn_fence(__ATOMIC_ACQUIRE, "agent");
            asm volatile("s_waitcnt vmcnt(0)" ::: "memory");
        }
    }
    __syncthreads();
}

namespace pg8 {
constexpr int BM = 256, BK = 64, HALF = 128, HTB = HALF * BK * 2, STAGE_BYTES = 8 * HTB, NXCD = 8, WGM = 8;
__host__ __device__ __forceinline__ int lds_byte(int r, int c) { const int st = (r >> 4) * 2 + (c >> 5), rr = r & 15, cc = c & 31, ob = rr * 64 + cc * 2; return st * 1024 + (ob ^ (((ob >> 9) & 1) << 5)); }
__host__ __device__ __forceinline__ void stage_rc(int b, int& R, int& C) { const int st = b / 1024, sb = b % 1024, swz = sb ^ (((sb >> 9) & 1) << 5); R = (st >> 1) * 16 + swz / 64; C = (st & 1) * 32 + (swz % 64) / 2; }
__host__ __device__ __forceinline__ int perm32(int rho) { const int n = rho >> 4, i = rho & 15; return 8 * (i >> 2) + 4 * n + (i & 3); }

struct Unit { int pm, pn; long aoff, boff; };
struct Gemm { const bf16_t* A; const bf16_t* Bt; int lda, ldb, K; };

struct OrderMN {
    int nM, nN, nwg, G, c, ashift; long astep, bstep, abytes;
    __device__ __forceinline__ int gather_row(const Unit&, int) const { return 0; }
    __device__ void init(int nM_, int nN_, int G_, int c_, long astep_, long bstep_, int ashift_ = 0, long abytes_ = 0) { nM = nM_; nN = nN_; nwg = nM * nN; G = G_; c = c_; astep = astep_; bstep = bstep_; ashift = ashift_; abytes = abytes_; }
    __device__ bool next(int i, Unit& u) const {
        const long L = (long)i * G + c; if (L >= nwg) return false;
        int wgid = (int)L; { const int q = nwg / NXCD, r = nwg % NXCD, xcd = wgid % NXCD, off = wgid / NXCD; wgid = (xcd < r ? xcd * (q + 1) : r * (q + 1) + (xcd - r) * q) + off; }
        const int nig = WGM * nN, gid = wgid / nig, fm = gid * WGM, gsz = (nM - fm) < WGM ? (nM - fm) : WGM;
        u.pm = fm + ((wgid % nig) % gsz); u.pn = (wgid % nig) / gsz;
        u.aoff = (long)u.pm * astep + (long)(u.pn >> ashift) * abytes; u.boff = (long)u.pn * bstep; return true;
    }
};
struct OrderMoE {
    const volatile LAS int* te; int Mt, nN, G, c; long astep, bstep, estep; const int* list;
    __device__ __forceinline__ int gather_row(const Unit& u, int r) const { const int e = te[u.pm], rb = te[160 + u.pm] + r; return rb < te[320 + u.pm] ? list[(size_t)e * T + rb] : 0; }
    __device__ bool next(int i, Unit& u) const {
        const long L = (long)i * G + c; if (L >= (long)Mt * nN) return false;
        u.pm = (int)(L / nN); u.pn = (int)(L % nN);
        u.aoff = (long)u.pm * astep; u.boff = (long)te[u.pm] * estep + (long)u.pn * bstep; return true;
    }
};

template <class Epi, class Sched, bool GATH = false, bool KEEPACC = false, bool ALIGN_EPI = true, bool SP2 = true>
__device__ __forceinline__ void gemm_phase(LAS unsigned char* lds, const Gemm g, const Sched& S, const Epi& E) {
    int tid_ = threadIdx.x; asm volatile("" : "+v"(tid_));
    const GAS bf16_t* gA = (const GAS bf16_t*)g.A; const GAS bf16_t* gB = (const GAS bf16_t*)g.Bt; asm volatile("" : "+s"(gA), "+s"(gB));
    const int tid = tid_, wid = __builtin_amdgcn_readfirstlane(tid >> 6), lane = tid & 63, wr = wid >> 2, wc = wid & 3, fr = lane & 15, fq = lane >> 4;
    const int K = g.K, nt = K / BK;
    unsigned voffA[2], voffB[2];
#pragma unroll
    for (int i = 0; i < 2; ++i) { int R, C; stage_rc(tid * 16 + i * 8192, R, C); const int Rb = Epi::PERM ? ((R & ~31) + perm32(R & 31)) : R;
        voffA[i] = (unsigned)(R * g.lda + C) * 2u; voffB[i] = (unsigned)(Rb * g.ldb + C) * 2u; }
    const size_t kstep = (size_t)(BK * 2);
    const size_t hstepA = GATH ? (size_t)0 : (size_t)HALF * g.lda * 2, hstepB = (size_t)HALF * g.ldb * 2;
    unsigned gAc[2][2], gAn[2][2]; int gR[2], gC[2];
#pragma unroll
    for (int i = 0; i < 2; ++i) { stage_rc(tid * 16 + i * 8192, gR[i], gC[i]); gAc[0][i] = gAc[1][i] = gAn[0][i] = gAn[1][i] = 0u; }
#define PG8_GLOAD(dst, un) do { _Pragma("unroll") for (int h_ = 0; h_ < 2; ++h_) _Pragma("unroll") for (int i_ = 0; i_ < 2; ++i_) \
        dst[h_][i_] = (unsigned)S.gather_row(un, h_ * HALF + gR[i_]) * (unsigned)(g.lda * 2) + (unsigned)(gC[i_] * 2); } while (0)
#define PG8_STAGE_A(bufoff, kptr, h, nx) do { if (GATH) { unsigned vo_[2]; vo_[0] = (nx) ? gAn[h][0] : gAc[h][0]; vo_[1] = (nx) ? gAn[h][1] : gAc[h][1]; PG8_STAGE(bufoff, kptr, vo_); } \
        else PG8_STAGE(bufoff, (kptr) + (h) * hstepA, voffA); } while (0)
    const unsigned ldsw = (unsigned)wid * 1024u;
    const int aoff = lds_byte(wr * 64 + fr, fq * 8), boff = lds_byte(wc * 32 + fr, fq * 8);
#define PG8_SA(b, h) (((b) * 2 + (h)) * HTB)
#define PG8_SB(b, h) ((4 + (b) * 2 + (h)) * HTB)
#define PG8_STAGE(bufoff, gbase, voff) do { _Pragma("unroll") for (int _i = 0; _i < 2; ++_i) \
        __builtin_amdgcn_global_load_lds((const GAS unsigned*)((gbase) + (voff)[_i]), (LAS unsigned*)(lds + (bufoff) + ldsw + _i * 8192), 16, 0, 0); } while (0)
#define PG8_LDA(dst, b, h) do { _Pragma("unroll") for (int m = 0; m < 4; ++m) _Pragma("unroll") for (int k = 0; k < 2; ++k) dst[m][k] = *(const LAS bf16x8*)(lds + PG8_SA(b, h) + aoff + m * 2048 + k * 1024); } while (0)
#define PG8_LDB(dst, b, h) do { _Pragma("unroll") for (int n = 0; n < 2; ++n) _Pragma("unroll") for (int k = 0; k < 2; ++k) dst[n][k] = *(const LAS bf16x8*)(lds + PG8_SB(b, h) + boff + n * 2048 + k * 1024); } while (0)
#define PG8_MMA(ai, bj, At, Bt) do { __builtin_amdgcn_s_setprio(1); _Pragma("unroll") for (int m = 0; m < 4; ++m) _Pragma("unroll") for (int n = 0; n < 2; ++n) _Pragma("unroll") for (int k = 0; k < 2; ++k) \
        acc[ai][bj][m][n] = __builtin_amdgcn_mfma_f32_16x16x32_bf16(Bt[n][k], At[m][k], acc[ai][bj][m][n], 0, 0, 0); __builtin_amdgcn_s_setprio(0); } while (0)
#define PG8_WAIT_V(n) asm volatile("s_waitcnt vmcnt(" #n ")" ::: "memory")
#define PG8_WAIT_L(n) asm volatile("s_waitcnt lgkmcnt(" #n ")" ::: "memory")
#define PG8_BAR __builtin_amdgcn_s_barrier()
#define PG8_SCHED __builtin_amdgcn_sched_barrier(0)
    Unit cur, nxt; int ui = 0;
    if (!S.next(0, cur)) return;
    f32x4 acc[2][2][4][2];
#pragma unroll
    for (int a = 0; a < 2; ++a)
#pragma unroll
        for (int b = 0; b < 2; ++b)
#pragma unroll
            for (int m = 0; m < 4; ++m)
#pragma unroll
                for (int n = 0; n < 2; ++n) acc[a][b][m][n] = (f32x4){0.f, 0.f, 0.f, 0.f};
    bf16x8 At[4][2], B0[2][2], B1[2][2];
    const GAS char* cA = (const GAS char*)gA + (GATH ? 0L : cur.aoff); const GAS char* cB = (const GAS char*)gB + cur.boff;
    if (GATH) PG8_GLOAD(gAc, cur);
    if constexpr (SP2) {
        PG8_STAGE(PG8_SB(0, 0), cB, voffB); PG8_STAGE(PG8_SB(0, 1), cB + hstepB, voffB); PG8_STAGE_A(PG8_SA(0, 0), cA, 0, false); PG8_STAGE_A(PG8_SA(0, 1), cA, 1, false);
        if (wr == 1) PG8_BAR;
        PG8_WAIT_V(2); PG8_BAR;
        PG8_STAGE(PG8_SB(1, 0), cB + kstep, voffB); PG8_STAGE_A(PG8_SA(1, 0), cA + kstep, 0, false); PG8_STAGE(PG8_SB(1, 1), cB + hstepB + kstep, voffB);
        PG8_WAIT_V(6); PG8_BAR;
    } else {
    PG8_STAGE(PG8_SB(0, 0), cB, voffB); PG8_STAGE_A(PG8_SA(0, 0), cA, 0, false); PG8_STAGE(PG8_SB(0, 1), cB + hstepB, voffB); PG8_STAGE_A(PG8_SA(0, 1), cA, 1, false);
    if (wr == 1) PG8_BAR;
    PG8_WAIT_V(4); PG8_BAR;
    PG8_STAGE(PG8_SB(1, 0), cB + kstep, voffB); PG8_STAGE_A(PG8_SA(1, 0), cA + kstep, 0, false); PG8_STAGE(PG8_SB(1, 1), cB + hstepB + kstep, voffB);
    PG8_WAIT_V(6); PG8_BAR;
    }
    for (;;) {
        const bool has_next = S.next(ui + 1, nxt);
        const GAS char* nA = (has_next && !GATH) ? (const GAS char*)gA + nxt.aoff : cA; const GAS char* nB = has_next ? (const GAS char*)gB + nxt.boff : cB;
        if (GATH) { if (has_next) PG8_GLOAD(gAn, nxt); else { gAn[0][0] = gAc[0][0]; gAn[0][1] = gAc[0][1]; gAn[1][0] = gAc[1][0]; gAn[1][1] = gAc[1][1]; } }
        for (int t = 0; t < nt; t += 2) {
            const bool last = (t == nt - 2);
            const GAS char* a1 = cA + (size_t)(t + 1) * kstep;
            const GAS char* a2 = last ? nA : cA + (size_t)(t + 2) * kstep; const GAS char* b2 = last ? nB : cB + (size_t)(t + 2) * kstep;
            const GAS char* a3 = a2 + kstep; const GAS char* b3 = b2 + kstep;
            if constexpr (SP2) {
            PG8_LDB(B0, 0, 0); PG8_LDB(B1, 0, 1); PG8_SCHED; PG8_LDA(At, 0, 0); PG8_STAGE_A(PG8_SA(1, 1), a1, 1, false);
            PG8_WAIT_V(8); PG8_WAIT_L(0); PG8_BAR; PG8_MMA(0, 0, At, B0); PG8_MMA(0, 1, At, B1); PG8_BAR; PG8_SCHED;
            PG8_LDA(At, 0, 1); PG8_STAGE(PG8_SB(0, 0), b2, voffB); PG8_STAGE(PG8_SB(0, 1), b2 + hstepB, voffB); PG8_STAGE_A(PG8_SA(0, 0), a2, 0, last);
            PG8_WAIT_V(8); PG8_WAIT_L(0); PG8_BAR; PG8_MMA(1, 0, At, B0); PG8_MMA(1, 1, At, B1); PG8_BAR; PG8_SCHED;
            PG8_LDB(B0, 1, 0); PG8_LDB(B1, 1, 1); PG8_SCHED; PG8_LDA(At, 1, 0); PG8_STAGE_A(PG8_SA(0, 1), a2, 1, last);
            PG8_WAIT_V(8); PG8_WAIT_L(0); PG8_BAR; PG8_MMA(0, 0, At, B0); PG8_MMA(0, 1, At, B1); PG8_BAR; PG8_SCHED;
            PG8_LDA(At, 1, 1); PG8_STAGE(PG8_SB(1, 0), b3, voffB); PG8_STAGE(PG8_SB(1, 1), b3 + hstepB, voffB); PG8_STAGE_A(PG8_SA(1, 0), a3, 0, last);
            PG8_WAIT_V(8); PG8_WAIT_L(0); PG8_BAR; PG8_MMA(1, 0, At, B0); PG8_MMA(1, 1, At, B1); PG8_BAR; PG8_SCHED;
            } else {
            PG8_LDB(B0, 0, 0); PG8_SCHED; PG8_LDA(At, 0, 0); PG8_STAGE_A(PG8_SA(1, 1), a1, 1, false);
            PG8_WAIT_L(8); PG8_BAR; PG8_WAIT_L(0); PG8_MMA(0, 0, At, B0); PG8_BAR; PG8_SCHED;
            PG8_LDB(B1, 0, 1); PG8_STAGE(PG8_SB(0, 0), b2, voffB);
            PG8_BAR; PG8_WAIT_L(0); PG8_MMA(0, 1, At, B1); PG8_BAR;
            PG8_LDA(At, 0, 1); PG8_STAGE_A(PG8_SA(0, 0), a2, 0, last);
            PG8_BAR; PG8_WAIT_L(0); PG8_MMA(1, 0, At, B0); PG8_BAR; PG8_SCHED;
            PG8_STAGE(PG8_SB(0, 1), b2 + hstepB, voffB);
            PG8_WAIT_V(6); PG8_BAR; PG8_MMA(1, 1, At, B1); PG8_BAR;
            PG8_LDB(B0, 1, 0); PG8_SCHED; PG8_LDA(At, 1, 0); PG8_STAGE_A(PG8_SA(0, 1), a2, 1, last);
            PG8_WAIT_L(8); PG8_BAR; PG8_WAIT_L(0); PG8_MMA(0, 0, At, B0); PG8_BAR; PG8_SCHED;
            PG8_LDB(B1, 1, 1); PG8_STAGE(PG8_SB(1, 0), b3, voffB);
            PG8_BAR; PG8_WAIT_L(0); PG8_MMA(0, 1, At, B1); PG8_BAR;
            PG8_LDA(At, 1, 1); PG8_STAGE_A(PG8_SA(1, 0), a3, 0, last);
            PG8_BAR; PG8_WAIT_L(0); PG8_MMA(1, 0, At, B0); PG8_BAR; PG8_SCHED;
            PG8_STAGE(PG8_SB(1, 1), b3 + hstepB, voffB);
            PG8_WAIT_V(6); PG8_BAR; PG8_MMA(1, 1, At, B1); PG8_BAR;
            }
        }
        if constexpr (ALIGN_EPI) { if (wr == 0) PG8_BAR; }
        bool zero_acc = true;
        if constexpr (KEEPACC) zero_acc = E.run(acc, cur, wr, wc, fr, fq);
        else E(acc, cur, wr, wc, fr, fq);
        if (!has_next) break;
        if (zero_acc)
#pragma unroll
        for (int a = 0; a < 2; ++a)
#pragma unroll
            for (int b = 0; b < 2; ++b)
#pragma unroll
                for (int m = 0; m < 4; ++m)
#pragma unroll
                    for (int n = 0; n < 2; ++n) acc[a][b][m][n] = (f32x4){0.f, 0.f, 0.f, 0.f};
        cur = nxt; cA = nA; cB = nB; ++ui;
        if (GATH) { gAc[0][0] = gAn[0][0]; gAc[0][1] = gAn[0][1]; gAc[1][0] = gAn[1][0]; gAc[1][1] = gAn[1][1]; }
        if constexpr (ALIGN_EPI) { if (wr == 1) PG8_BAR; }
    }
    PG8_WAIT_V(0);
    if constexpr (!ALIGN_EPI) { if (wr == 0) PG8_BAR; }
    PG8_BAR;
#undef PG8_SA
#undef PG8_SB
#undef PG8_STAGE
#undef PG8_STAGE_A
#undef PG8_GLOAD
#undef PG8_LDA
#undef PG8_LDB
#undef PG8_MMA
#undef PG8_WAIT_V
#undef PG8_WAIT_L
#undef PG8_BAR
#undef PG8_SCHED
}

typedef const f32x4 (&AccT)[2][2][4][2];
template <int ACT> __device__ __forceinline__ void store_tile_bf16(AccT acc, bf16_t* O, int ld, int row0, int colb, float scale) {
#pragma unroll
    for (int ai = 0; ai < 2; ++ai)
#pragma unroll
        for (int m = 0; m < 4; ++m) { bf16_t* rowp = O + (size_t)(row0 + ai * HALF + m * 16) * ld + colb;
#pragma unroll
            for (int bj = 0; bj < 2; ++bj) { const f32x4 v0 = act4<ACT>(acc[ai][bj][m][0] * scale), v1 = act4<ACT>(acc[ai][bj][m][1] * scale);
                *(u32x4*)(rowp + bj * HALF) = pack8(v0, v1); }
            asm volatile("" ::: "memory"); }
}
template <int ACT> struct EpiStore {
    static constexpr bool PERM = true;
    bf16_t* O; int ld; float scale;
    __device__ __forceinline__ void operator()(AccT acc, const Unit& u, int wr, int wc, int fr, int fq) const {
        store_tile_bf16<ACT>(acc, O, ld, u.pm * BM + wr * 64 + fr, u.pn * BM + wc * 32 + 8 * fq, scale);
    }
};
struct EpiInProj {
    static constexpr bool PERM = true;
    unsigned char* ws;
    __device__ __forceinline__ void operator()(AccT acc, const Unit& u, int wr, int wc, int fr, int fq) const {
        const int pn = u.pn, row0 = u.pm * BM + wr * 64 + fr, cw = wc * 32 + 8 * fq;
        unsigned char* pj = ws + WS_PROJ;
        bf16_t *rq = (bf16_t*)(pj + P_RQ), *rk = (bf16_t*)(pj + P_RK), *rv = (bf16_t*)(pj + P_RV), *rg = (bf16_t*)(pj + P_RG), *gu = (bf16_t*)(pj + P_GU), *gv = (bf16_t*)(pj + P_GV), *dq = (bf16_t*)(pj + P_DQ),
               *iq = (bf16_t*)(pj + P_IQ), *ik = (bf16_t*)(pj + P_IK), *ga = (bf16_t*)(pj + P_GA), *gb = (bf16_t*)(pj + P_GB), *gc = (bf16_t*)(pj + P_GC);
        float *dcraw = (float*)(pj + P_DC), *iw = (float*)(pj + P_IW), *gvstats = (float*)(ws + WS_STATS); const float* rope = (const float*)(ws + WS_ROPE);
        if (pn < 8) {
            const bool isk = pn >= 4; bf16_t* dst = (isk ? rk : rq) + (pn & 3) * 256 + cw; const float sc = isk ? 0.0625f : 1.0f;
#pragma unroll
            for (int ai = 0; ai < 2; ++ai) { f32x4 csq[4][4];
#pragma unroll
                for (int m = 0; m < 4; ++m) { const int pos = (row0 + ai * HALF + m * 16) & (SEQ - 1); const f32x4* cs = (const f32x4*)(rope + ((size_t)pos * 128 + cw) * 2);
#pragma unroll
                    for (int q4 = 0; q4 < 4; ++q4) csq[m][q4] = cs[q4]; }
                asm volatile("" ::: "memory");
#pragma unroll
                for (int m = 0; m < 4; ++m) { const int row = row0 + ai * HALF + m * 16;
                    f32x4 o1[2], o2[2];
#pragma unroll
                    for (int n = 0; n < 2; ++n) { const f32x4 c01 = csq[m][2 * n], c23 = csq[m][2 * n + 1]; const f32x4 x1 = acc[ai][0][m][n], x2 = acc[ai][1][m][n];
                        const float co[4] = {c01[0], c01[2], c23[0], c23[2]}, si[4] = {c01[1], c01[3], c23[1], c23[3]};
#pragma unroll
                        for (int j = 0; j < 4; ++j) { o1[n][j] = (x1[j] * co[j] - x2[j] * si[j]) * sc; o2[n][j] = (x1[j] * si[j] + x2[j] * co[j]) * sc; } }
                    bf16_t* rp = dst + (size_t)row * 1024;
                    *(u32x4*)rp = pack8(o1[0], o1[1]); *(u32x4*)(rp + 128) = pack8(o2[0], o2[1]); }
                asm volatile("" ::: "memory"); }
        } else if (pn < 12) { store_tile_bf16<0>(acc, rv, 1024, row0, (pn - 8) * 256 + cw, 1.f);
        } else if (pn < 16) { store_tile_bf16<2>(acc, rg, 1024, row0, (pn - 12) * 256 + cw, 1.f);
        } else if (pn < 20) { store_tile_bf16<1>(acc, gu, 1024, row0, (pn - 16) * 256 + cw, 1.f);
        } else if (pn < 24) {
            const int t4 = pn - 20; bf16_t* dst = gv + t4 * 256 + cw;
#pragma unroll
            for (int ai = 0; ai < 2; ++ai)
#pragma unroll
                for (int m = 0; m < 4; ++m) { const int row = row0 + ai * HALF + m * 16; float s = 0.f, q = 0.f;
#pragma unroll
                    for (int bj = 0; bj < 2; ++bj) { const f32x4 v0 = act4<1>(acc[ai][bj][m][0]), v1 = act4<1>(acc[ai][bj][m][1]);
                        *(u32x4*)(dst + (size_t)row * 1024 + bj * HALF) = pack8(v0, v1);
#pragma unroll
                        for (int j = 0; j < 4; ++j) { s += v0[j] + v1[j]; q += v0[j] * v0[j] + v1[j] * v1[j]; } }
                    s = quad_sum(s); q = quad_sum(q);
                    if (fq == 0) *(f32x2*)(gvstats + ((size_t)row * 16 + t4 * 4 + wc) * 2) = (f32x2){s, q}; asm volatile("" ::: "memory"); }
        } else if (pn < 28) { store_tile_bf16<0>(acc, dq, 1024, row0, (pn - 24) * 256 + cw, 1.f);
        } else if (pn == 28) {
#pragma unroll
            for (int ai = 0; ai < 2; ++ai)
#pragma unroll
                for (int m = 0; m < 4; ++m) { float* rp = dcraw + (size_t)(row0 + ai * HALF + m * 16) * 256 + cw;
#pragma unroll
                    for (int bj = 0; bj < 2; ++bj) { *(f32x4*)(rp + bj * HALF) = acc[ai][bj][m][0]; *(f32x4*)(rp + bj * HALF + 4) = acc[ai][bj][m][1]; } }
        } else if (pn < 31) { store_tile_bf16<0>(acc, iq, 512, row0, (pn - 29) * 256 + cw, 1.f);
        } else if (pn == 31) {
#pragma unroll
            for (int ai = 0; ai < 2; ++ai)
#pragma unroll
                for (int m = 0; m < 4; ++m) { const int row = row0 + ai * HALF + m * 16;
                    if (wc < 2) *(u32x4*)(ik + (size_t)row * 64 + cw) = pack8(acc[ai][0][m][0], acc[ai][0][m][1]);
                    if (wc == 2 && fq == 0) { *(f32x4*)(iw + (size_t)row * 8) = acc[ai][0][m][0] * 0.35355339059f; *(f32x4*)(iw + (size_t)row * 8 + 4) = acc[ai][0][m][1] * 0.35355339059f; } }
        } else { const int gi = (pn - 32) >> 3; bf16_t* dst = gi == 0 ? ga : (gi == 1 ? gb : gc);
            store_tile_bf16<3>(acc, dst, 2048, row0, ((pn - 32) & 7) * 256 + cw, 1.f); }
    }
};
typedef f32x4 (&AccM)[2][2][4][2];
struct EpiBranch {
    static constexpr bool PERM = true;
    const bf16_t* gate0; bf16_t* merged;
    __device__ __forceinline__ bool run(AccM acc, const Unit& u, int wr, int wc, int fr, int fq) const {
        const int br = u.pn >> 8; const bf16_t* gate = gate0 + (size_t)br * (32u << 20); const bf16_t* gnx = gate + (32u << 20);
        const int row0 = u.pm * BM + wr * 64 + fr, colb = (u.pn & 255) * BM + wc * 32 + 8 * fq;
#pragma unroll
        for (int ai = 0; ai < 2; ++ai) {
            u32x4 gq[4][2], nq[4][2];
#pragma unroll
            for (int m = 0; m < 4; ++m)
#pragma unroll
                for (int bj = 0; bj < 2; ++bj) { const size_t ro = (size_t)(row0 + ai * HALF + m * 16) * 2048 + colb + bj * HALF; gq[m][bj] = *(const u32x4*)(gate + ro); nq[m][bj] = *(const u32x4*)((br < 2 ? gnx : gate) + ro); }
            asm volatile("" ::: "memory");
#pragma unroll
            for (int m = 0; m < 4; ++m)
#pragma unroll
                for (int bj = 0; bj < 2; ++bj) { float g8[8], n8[8]; unpack8(gq[m][bj], g8); unpack8(nq[m][bj], n8);
                    f32x4 a0 = acc[ai][bj][m][0], a1 = acc[ai][bj][m][1];
                    if (br < 2) {
#pragma unroll
                        for (int j = 0; j < 4; ++j) { a0[j] *= g8[j] * __builtin_amdgcn_rcpf(fmaxf(n8[j], 1e-30f)); a1[j] *= g8[4 + j] * __builtin_amdgcn_rcpf(fmaxf(n8[4 + j], 1e-30f)); }
                        acc[ai][bj][m][0] = a0; acc[ai][bj][m][1] = a1;
                    } else {
#pragma unroll
                        for (int j = 0; j < 4; ++j) { a0[j] *= g8[j]; a1[j] *= g8[4 + j]; }
                        *(u32x4*)(merged + (size_t)(row0 + ai * HALF + m * 16) * 2048 + colb + bj * HALF) = pack8(a0, a1); } }
            asm volatile("" ::: "memory");
        }
        return br == 2;
    }
};
struct EpiResid {
    static constexpr bool PERM = false;
    const float* xsrc; float* xdst;
    __device__ __forceinline__ void operator()(AccT acc, const Unit& u, int wr, int wc, int fr, int fq) const {
        const int row0 = u.pm * BM + wr * 64 + fr, col0 = u.pn * BM + wc * 32 + 4 * fq;
#pragma unroll
        for (int ai = 0; ai < 2; ++ai)
#pragma unroll
            for (int mp = 0; mp < 2; ++mp) { f32x4 xv[2][2][2];
#pragma unroll
                for (int mm = 0; mm < 2; ++mm)
#pragma unroll
                    for (int bj = 0; bj < 2; ++bj)
#pragma unroll
                        for (int n = 0; n < 2; ++n) xv[mm][bj][n] = *(const f32x4*)(xsrc + (size_t)(row0 + ai * HALF + (2 * mp + mm) * 16) * DM + col0 + bj * HALF + n * 16);
                asm volatile("" ::: "memory");
#pragma unroll
                for (int mm = 0; mm < 2; ++mm)
#pragma unroll
                    for (int bj = 0; bj < 2; ++bj)
#pragma unroll
                        for (int n = 0; n < 2; ++n) *(f32x4*)(xdst + (size_t)(row0 + ai * HALF + (2 * mp + mm) * 16) * DM + col0 + bj * HALF + n * 16) = xv[mm][bj][n] + acc[ai][bj][2 * mp + mm][n];
                asm volatile("" ::: "memory"); }
    }
};
struct EpiMoeUp {
    static constexpr bool PERM = true;
    bf16_t* hid;
    __device__ __forceinline__ void operator()(AccT acc, const Unit& u, int wr, int wc, int fr, int fq) const {
        const int row0 = u.pm * BM + wr * 64 + fr, colb = u.pn * 128 + wc * 32 + 8 * fq;
#pragma unroll
        for (int ai = 0; ai < 2; ++ai)
#pragma unroll
            for (int m = 0; m < 4; ++m) { f32x4 r0, r1; const f32x4 a0 = acc[ai][0][m][0], a1 = acc[ai][0][m][1], b0 = acc[ai][1][m][0], b1 = acc[ai][1][m][1];
#pragma unroll
                for (int j = 0; j < 4; ++j) { r0[j] = siluf_(a0[j]) * b0[j]; r1[j] = siluf_(a1[j]) * b1[j]; }
                *(u32x4*)(hid + (size_t)(row0 + ai * HALF + m * 16) * FF + colb) = pack8(r0, r1); }
    }
};
struct OrderBranch {
    OrderMN base; long astride, bstride;
    __device__ __forceinline__ int gather_row(const Unit&, int) const { return 0; }
    __device__ bool next(int i, Unit& u) const { if (!base.next(i / 3, u)) return false; const int br = i % 3; u.aoff += br * astride; u.boff += br * bstride; u.pn |= br << 8; return true; }
};
struct OrderRouter {
    int G, c; long hlo_off;
    __device__ __forceinline__ int gather_row(const Unit&, int) const { return 0; }
    __device__ bool next(int i, Unit& u) const { const int L = i * G + c; if (L >= 256) return false; const int pm = L >> 2, which = (L >> 1) & 1, kh = L & 1;
        u.pm = pm; u.pn = which * 2 + kh; u.aoff = (long)pm * 256 * DM * 2 + (long)which * hlo_off + (long)kh * 1024 * 2; u.boff = (long)kh * 1024 * 2; return true; }
};
struct EpiRouter {
    static constexpr bool PERM = false;
    float* LOG;
    __device__ __forceinline__ void operator()(AccT acc, const Unit& u, int wr, int wc, int fr, int fq) const {
        float* base = LOG + ((size_t)u.pn * T + (size_t)u.pm * BM + wr * 64 + fr) * 128 + wc * 32 + 4 * fq;
#pragma unroll
        for (int ai = 0; ai < 2; ++ai)
#pragma unroll
            for (int m = 0; m < 4; ++m)
#pragma unroll
                for (int n = 0; n < 2; ++n) *(f32x4*)(base + (size_t)(ai * HALF + m * 16) * 128 + n * 16) = acc[ai][0][m][n];
    }
};
}

struct Args { const float* in[23]; float* out; unsigned char* ws; int ph_lo, ph_hi; };
enum { I_X = 0, I_NMIX, I_WIN, I_WRET, I_LNG, I_LNB, I_WS, I_BS, I_WGM, I_KVG, I_WUK, I_WUV, I_WDS, I_WOUT, I_NFFN, I_WGRP, I_BGRP, I_WEXP, I_BEXP, I_W1, I_W3, I_W2, I_FNG };
struct Ctx {
    LAS unsigned char* lds; volatile LAS int* misc; unsigned* ctl; GAS unsigned char* ws;
    int tid, lane, wave, G, bid, gw, NGW;
    const float* const* in; float* out;
};
#define WSP(T_, off) ((T_*)(C.ws + (off)))
__device__ __forceinline__ void refresh(Ctx& C) { int t = threadIdx.x; asm volatile("" : "+v"(t)); C.tid = t; C.lane = t & 63;
    GAS unsigned char* w = C.ws; asm volatile("" : "+s"(w)); C.ws = w; C.ctl = (unsigned*)w; }

__device__ __forceinline__ void ph_rope(const Ctx& C) {
    float* rope = WSP(float, WS_ROPE);
    const double r1 = 0.9305720409296989;
    for (int idx = C.bid * 512 + C.tid; idx < SEQ * 128; idx += C.G * 512) {
        const int pos = idx >> 7, i = idx & 127;
        double inv = 1.0, b = r1; int e = i;
        while (e) { if (e & 1) inv *= b; b *= b; e >>= 1; }
        const double ang = (double)pos * inv;
        const double n = __builtin_rint(ang * 0.15915494309189533577);
        const double x = ang - n * 6.283185307179586476925;
        const double x2 = x * x;
        double s = 0.0, c = 0.0;
#pragma unroll 1
        for (int k = 14; k >= 1; --k) { s = (s + 1.0) * (-x2 / (double)((2 * k) * (2 * k + 1))); c = (c + 1.0) * (-x2 / (double)((2 * k - 1) * (2 * k))); }
        s = (s + 1.0) * x; c = c + 1.0;
        *(f32x2*)(rope + (size_t)idx * 2) = (f32x2){(float)c, (float)s};
    }
}

struct WItem { const float* src; bf16_t* dst; int srcld, dstld, k0, n0, mode; long off; };
__device__ __forceinline__ WItem w_item(const Ctx& C, int l, int r) {
    unsigned char* wb = (unsigned char*)(C.ws + WS_W); WItem w; w.mode = 0; w.off = 0;
    constexpr int N_IN = 32 * 224, N_BR = 16 * 32, N_OUT = 32 * 32, N_13 = 32 * 32 * 16, N_2 = 32 * 8 * 32;
    if (r < N_IN) { const int kb = r / 224, nb = r % 224; w.src = C.in[I_WIN] + (size_t)l * DM * INW; w.srcld = INW; w.dst = (bf16_t*)(wb + W_IN); w.dstld = DM; w.k0 = kb * 64; w.n0 = nb * 64; w.mode = 1; return w; } r -= N_IN;
    if (r < 3 * N_BR) { const int ww = r / N_BR, q = r % N_BR, kb = q / 32, nb = q % 32; w.src = C.in[ww == 0 ? I_WRET : (ww == 1 ? I_WGM : I_WDS)] + (size_t)l * 1024 * DM; w.srcld = DM;
        w.dst = (bf16_t*)(wb + (ww == 0 ? W_RET : (ww == 1 ? W_GM : W_DS))); w.dstld = 1024; w.k0 = kb * 64; w.n0 = nb * 64; return w; } r -= 3 * N_BR;
    if (r < N_OUT) { const int kb = r / 32, nb = r % 32; w.src = C.in[I_WOUT] + (size_t)l * DM * DM; w.srcld = DM; w.dst = (bf16_t*)(wb + W_OUT); w.dstld = DM; w.k0 = kb * 64; w.n0 = nb * 64; return w; } r -= N_OUT;
    if (r < N_13) { const int e = r / 512, q = r % 512, kb = q / 16, nb = q % 16, row0 = nb * 64, j = row0 >> 8, sft = (row0 >> 7) & 1, fp = row0 & 127;
        w.src = C.in[sft ? I_W3 : I_W1] + ((size_t)l * NEXP + e) * DM * FF; w.srcld = FF; w.dst = (bf16_t*)(wb + W_13) + (size_t)e * 1024 * DM; w.dstld = DM; w.k0 = kb * 64; w.n0 = row0; w.off = (long)(128 * j + fp) - row0; return w; } r -= N_13;
    if (r < N_2) { const int e = r / 256, q = r % 256, kb = q / 32, nb = q % 32; w.src = C.in[I_W2] + ((size_t)l * NEXP + e) * FF * DM; w.srcld = DM; w.dst = (bf16_t*)(wb + W_2) + (size_t)e * DM * FF; w.dstld = FF; w.k0 = kb * 64; w.n0 = nb * 64; return w; } r -= N_2;
    { const int h = r / 8, q = r % 8, kb = q / 2, nb = q % 2;
      w.src = C.in[I_WUV] + ((size_t)l * 8 + h) * 256 * 128; w.srcld = 128; w.dst = (bf16_t*)(wb + W_UV) + (size_t)(h * 128) * 512 + (h & 1) * 256; w.dstld = 512; w.k0 = kb * 64; w.n0 = nb * 64; return w; }
}
__device__ __forceinline__ void w_load(const WItem& w, int lane, f32x4 (&R)[16]) {
    const int nq = lane & 15, kq = lane >> 4, n = w.n0 + 4 * nq;
    const long sc = (w.mode == 1) ? (n < GATE_SRC0 ? (long)n : (n < GATE_DST0 ? -1L : (long)(n - (GATE_DST0 - GATE_SRC0)))) : (long)n + w.off;
    const float* p = w.src + (size_t)(w.k0 + 2 * kq) * w.srcld + (sc >= 0 ? sc : 0);
#pragma unroll
    for (int i = 0; i < 8; ++i)
#pragma unroll
        for (int s2 = 0; s2 < 2; ++s2) { f32x4 v = __builtin_nontemporal_load((const f32x4*)(p + (size_t)(8 * i + s2) * w.srcld)); if (sc < 0) v = (f32x4){0.f, 0.f, 0.f, 0.f}; R[2 * i + s2] = v; }
}
__device__ __forceinline__ void w_store(const WItem& w, int lane, const f32x4 (&R)[16], LAS unsigned* scr) {
    const int nq = lane & 15, kq = lane >> 4;
#pragma unroll
    for (int i = 0; i < 8; ++i)
#pragma unroll
        for (int e = 0; e < 4; ++e) scr[(4 * nq + e) * 33 + 4 * i + kq] = cvt_pk_bf16(R[2 * i][e], R[2 * i + 1][e]);
    asm volatile("s_waitcnt lgkmcnt(0)" ::: "memory");
    const int c = lane & 7;
#pragma unroll
    for (int j = 0; j < 8; ++j) { const int n = (lane >> 3) + 8 * j; const LAS unsigned* sp = scr + n * 33 + 4 * c;
        u32x4 o; o.x = sp[0]; o.y = sp[1]; o.z = sp[2]; o.w = sp[3];
        *(u32x4*)(w.dst + (size_t)(w.n0 + n) * w.dstld + w.k0 + 8 * c) = o; }
    asm volatile("s_waitcnt lgkmcnt(0)" ::: "memory");
}
__device__ __forceinline__ void ph_weights(const Ctx& C, int l) {
    LAS unsigned* scr = (LAS unsigned*)(C.lds + C.wave * 16384);
    unsigned char* wb = (unsigned char*)(C.ws + WS_W);
    constexpr int NITEMS = 32 * 224 + 3 * 16 * 32 + 32 * 32 + 32 * 32 * 16 + 32 * 8 * 32 + 8 * 8;
    { int it = C.gw; f32x4 R[16], Rn[16]; WItem w, wn;
      if (it < NITEMS) { w = w_item(C, l, it); w_load(w, C.lane, R); }
#pragma unroll 1
      while (it < NITEMS) { const int itn = it + C.NGW;
          if (itn < NITEMS) { wn = w_item(C, l, itn); w_load(wn, C.lane, Rn); }
          w_store(w, C.lane, R, scr);
#pragma unroll
          for (int i = 0; i < 16; ++i) R[i] = Rn[i];
          w = wn; it = itn; } }
    bf16_t* uv = (bf16_t*)(wb + W_UV); bf16_t* uk = (bf16_t*)(wb + W_UK); const float* wuk = C.in[I_WUK] + (size_t)l * 8 * 256 * 128;
    for (int idx = C.bid * 512 + C.tid; idx < 1024 * 256 / 8; idx += C.G * 512) { const int row = idx >> 5, c8 = (idx & 31) * 8, h = row >> 7;
        *(u32x4*)(uv + (size_t)row * 512 + (1 - (h & 1)) * 256 + c8) = (u32x4){0u, 0u, 0u, 0u}; }
    for (int idx = C.bid * 512 + C.tid; idx < 2048 * 256 / 8; idx += C.G * 512) { const int row = idx >> 5, c8 = (idx & 31) * 8, h = row >> 8, half = c8 >> 7;
        u32x4 o = (u32x4){0u, 0u, 0u, 0u};
        if (half == (h & 1)) { const float* s = wuk + (size_t)row * 128 + (c8 & 127); const f32x4 a = *(const f32x4*)s, b = *(const f32x4*)(s + 4); o = pack8(a, b); }
        *(u32x4*)(uk + (size_t)row * 256 + c8) = o; }
    bf16_t* rt = (bf16_t*)(wb + W_RT); const float* wgr = C.in[I_WGRP] + (size_t)l * DM * 4; const float* wex = C.in[I_WEXP] + (size_t)l * 4 * DM * 8;
    for (int idx = C.bid * 512 + C.tid; idx < 256 * 256; idx += C.G * 512) { const int r = idx >> 8, k8 = (idx & 255) * 8, c = r & 63, part = r >> 6;
        u32x4 o = (u32x4){0u, 0u, 0u, 0u};
        if (part < 2 && c < 36) { float v[8];
#pragma unroll
            for (int j = 0; j < 8; ++j) { const float wv = (c < 4) ? wgr[(size_t)(k8 + j) * 4 + c] : wex[((size_t)((c - 4) >> 3) * DM + (k8 + j)) * 8 + ((c - 4) & 7)];
                const float hi = bf2f(f2bf(wv)); v[j] = part == 0 ? hi : (wv - hi); }
            o = pack8((f32x4){v[0], v[1], v[2], v[3]}, (f32x4){v[4], v[5], v[6], v[7]}); }
        *(u32x4*)(rt + (size_t)r * DM + k8) = o; }
}

__device__ __forceinline__ void ph_norm(const Ctx& C, const float* x, const float* g, bf16_t* H) {
    for (int row = C.gw; row < T; row += C.NGW) {
        const f32x4* xr = (const f32x4*)(x + (size_t)row * DM) + C.lane; f32x4 v[8]; float ss = 0.f;
#pragma unroll
        for (int j = 0; j < 8; ++j) { v[j] = xr[64 * j]; ss += v[j][0] * v[j][0] + v[j][1] * v[j][1] + v[j][2] * v[j][2] + v[j][3] * v[j][3]; }
        const float rstd = rsqrtf(wave_sum(ss, C.lane) * (1.f / DM) + EPS);
        u32x2* o = (u32x2*)(H + (size_t)row * DM) + C.lane;
#pragma unroll
        for (int j = 0; j < 8; ++j) { const f32x4 gg = ((const f32x4*)g)[64 * j + C.lane]; const f32x4 y = v[j] * rstd * gg; u32x2 w; w.x = cvt_pk_bf16(y[0], y[1]); w.y = cvt_pk_bf16(y[2], y[3]); o[64 * j] = w; }
    }
}
__device__ __forceinline__ void ph_ckv(const Ctx& C, const float* dcraw, const float* g, bf16_t* ckv) {
    for (int row = C.gw; row < T; row += C.NGW) {
        const f32x4 v = ((const f32x4*)(dcraw + (size_t)row * 256))[C.lane];
        const float ss = wave_sum(v[0] * v[0] + v[1] * v[1] + v[2] * v[2] + v[3] * v[3], C.lane);
        const float rstd = rsqrtf(ss * (1.f / 256.f) + EPS); const f32x4 y = v * rstd * ((const f32x4*)g)[C.lane];
        u32x2 w; w.x = cvt_pk_bf16(y[0], y[1]); w.y = cvt_pk_bf16(y[2], y[3]); ((u32x2*)(ckv + (size_t)row * 256))[C.lane] = w;
    }
}

typedef short v4i16_t __attribute__((ext_vector_type(4)));
__device__ __forceinline__ s16x4 tr_read(const LAS unsigned char* p) { return __builtin_bit_cast(s16x4, __builtin_amdgcn_ds_read_tr16_b64_v4i16((LAS v4i16_t*)p)); }
__device__ __forceinline__ bf16x8 tr_frag(const LAS unsigned char* X, int LDX, int rowA, int rowB, int n0, int lane) {
    const int q = (lane & 15) >> 2, p = lane & 3;
    const s16x4 lo = tr_read(X + (rowA + q) * LDX + (n0 + 4 * p) * 2), hi = tr_read(X + (rowB + q) * LDX + (n0 + 4 * p) * 2);
    return (bf16x8){lo[0], lo[1], lo[2], lo[3], hi[0], hi[1], hi[2], hi[3]};
}
constexpr int TLD = 544;
__device__ __forceinline__ bf16x8 as_bf16x8(u32x4 w) { return __builtin_bit_cast(bf16x8, w); }

__device__ __forceinline__ void ph_ret_kv(const Ctx& C) {
    const bf16_t* rk = WSP(bf16_t, WS_PROJ + P_RK); const bf16_t* rv = WSP(bf16_t, WS_PROJ + P_RV); bf16_t* KV = WSP(bf16_t, WS_KV);
    const LAS unsigned char* Vt = C.lds; const LAS unsigned char* Kt = C.lds + 128 * TLD;
    const int g = C.lane >> 4, fr = C.lane & 15, wr = C.wave >> 2, wc = C.wave & 3;
    for (int u = C.bid; u < 512; u += C.G) {
        const int n = u & 31, h = (u >> 5) & 3, b = u >> 7; const size_t row0 = (size_t)b * SEQ + n * 128;
        const float lg2 = log2f(1.0f - exp2f(-5.0f - (float)h));
        __syncthreads();
#pragma unroll
        for (int p = 0; p < 8; ++p) { const int idx = p * 512 + C.tid, row = idx >> 5, ch = idx & 31; const size_t go = (row0 + row) * 1024 + h * 256 + ch * 8;
            const u32x4 vv = *(const u32x4*)(rv + go); *(LAS u32x4*)(C.lds + row * TLD + ch * 16) = vv;
            float f[8]; unpack8(*(const u32x4*)(rk + go), f); const float z = exp2f(lg2 * (float)(127 - row));
            *(LAS u32x4*)(C.lds + 128 * TLD + row * TLD + ch * 16) = pack8((f32x4){f[0] * z, f[1] * z, f[2] * z, f[3] * z}, (f32x4){f[4] * z, f[5] * z, f[6] * z, f[7] * z}); }
        __syncthreads();
        f32x4 acc[8][4];
#pragma unroll
        for (int m = 0; m < 8; ++m)
#pragma unroll
            for (int nn = 0; nn < 4; ++nn) acc[m][nn] = (f32x4){0.f, 0.f, 0.f, 0.f};
#pragma unroll 1
        for (int ks = 0; ks < 4; ++ks) { bf16x8 Bv[4];
#pragma unroll
            for (int nn = 0; nn < 4; ++nn) Bv[nn] = tr_frag(Vt, TLD, 32 * ks + 8 * g, 32 * ks + 8 * g + 4, 64 * wc + 16 * nn, C.lane);
#pragma unroll
            for (int m = 0; m < 8; ++m) { const bf16x8 Ak = tr_frag(Kt, TLD, 32 * ks + 8 * g, 32 * ks + 8 * g + 4, 128 * wr + 16 * m, C.lane);
#pragma unroll
                for (int nn = 0; nn < 4; ++nn) acc[m][nn] = __builtin_amdgcn_mfma_f32_16x16x32_bf16(Ak, Bv[nn], acc[m][nn], 0, 0, 0); } }
        bf16_t* out = KV + (size_t)u * 65536;
#pragma unroll
        for (int m = 0; m < 8; ++m)
#pragma unroll
            for (int nn = 0; nn < 4; ++nn) { const int e = 64 * wc + 16 * nn + fr, d = 128 * wr + 16 * m + 4 * g; u32x2 w; w.x = cvt_pk_bf16(acc[m][nn][0], acc[m][nn][1]); w.y = cvt_pk_bf16(acc[m][nn][2], acc[m][nn][3]);
                *(u32x2*)(out + e * 256 + d) = w; }
    }
}
__device__ __forceinline__ void ph_ret_scan(const Ctx& C) {
    const bf16_t* KV = WSP(bf16_t, WS_KV); bf16_t* Rb = WSP(bf16_t, WS_R);
    for (int idx = C.bid * 512 + C.tid; idx < 16 * 8192; idx += C.G * 512) {
        const int bh = idx >> 13, off = (idx & 8191) * 8, h = bh & 3; const float gc = exp2f(128.0f * log2f(1.0f - exp2f(-5.0f - (float)h)));
        float R[8] = {0.f, 0.f, 0.f, 0.f, 0.f, 0.f, 0.f, 0.f};
#pragma unroll 4
        for (int n = 0; n < 32; ++n) { const size_t o = ((size_t)bh * 32 + n) * 65536 + off;
            *(u32x4*)(Rb + o) = pack8((f32x4){R[0], R[1], R[2], R[3]}, (f32x4){R[4], R[5], R[6], R[7]});
            float f[8]; unpack8(*(const u32x4*)(KV + o), f);
#pragma unroll
            for (int j = 0; j < 8; ++j) R[j] = R[j] * gc + f[j]; }
    }
}
__device__ __forceinline__ void ph_ret_out(const Ctx& C) {
    const bf16_t* rq = WSP(bf16_t, WS_PROJ + P_RQ); const bf16_t* rk = WSP(bf16_t, WS_PROJ + P_RK); const bf16_t* rv = WSP(bf16_t, WS_PROJ + P_RV); const bf16_t* rg = WSP(bf16_t, WS_PROJ + P_RG);
    const bf16_t* Rb = WSP(bf16_t, WS_R); bf16_t* ret = WSP(bf16_t, WS_RET);
    const LAS unsigned char* Vt = C.lds;
    const int w = C.wave;
    for (int u = C.bid; u < 512; u += C.G) {
        int tid_ = C.tid; asm volatile("" : "+v"(tid_));
        const int tid = tid_, lane = tid & 63, g = lane >> 4, fr = lane & 15;
        const int n = u & 31, h = (u >> 5) & 3, b = u >> 7; const size_t row0 = (size_t)b * SEQ + n * 128;
        const float lg2 = log2f(1.0f - exp2f(-5.0f - (float)h));
        constexpr int R_OFF = 128 * TLD, RLD = 272;
        u32x4 Vr[8], Rr[8];
#pragma unroll
        for (int p = 0; p < 8; ++p) { const int idx = p * 512 + tid, row = idx >> 5, ch = idx & 31; Vr[p] = *(const u32x4*)(rv + (row0 + row) * 1024 + h * 256 + ch * 8); }
        if (n > 0) {
#pragma unroll
            for (int p = 0; p < 8; ++p) { const int idx = p * 512 + tid, e = idx >> 4, c16 = idx & 15; Rr[p] = *(const u32x4*)(Rb + (size_t)u * 65536 + (size_t)e * 256 + c16 * 8); } }
        const int i = 16 * w + fr;
        bf16x8 Bq[8];
        { const bf16_t* qp = rq + (row0 + i) * 1024 + h * 256 + 8 * g;
#pragma unroll
          for (int ks = 0; ks < 8; ++ks) Bq[ks] = as_bf16x8(*(const u32x4*)(qp + 32 * ks)); }
        f32x4 acc[16];
#pragma unroll
        for (int nt = 0; nt < 16; ++nt) acc[nt] = (f32x4){0.f, 0.f, 0.f, 0.f};
        __syncthreads();
#pragma unroll
        for (int p = 0; p < 8; ++p) { const int idx = p * 512 + tid, row = idx >> 5, ch = idx & 31; *(LAS u32x4*)(C.lds + row * TLD + ch * 16) = Vr[p]; }
        if (n > 0) {
#pragma unroll
            for (int p = 0; p < 8; ++p) { const int idx = p * 512 + tid, e = idx >> 4, c16 = idx & 15; *(LAS u32x4*)(C.lds + R_OFF + e * RLD + c16 * 16) = Rr[p]; }
#pragma unroll
            for (int p = 0; p < 8; ++p) { const int idx = p * 512 + tid, e = idx >> 4, c16 = idx & 15; Rr[p] = *(const u32x4*)(Rb + (size_t)u * 65536 + (size_t)e * 256 + 128 + c16 * 8); }
#pragma unroll
            for (int dh = 0; dh < 2; ++dh) {
                if (dh) { __syncthreads();
#pragma unroll
                    for (int p = 0; p < 8; ++p) { const int idx = p * 512 + tid, e = idx >> 4, c16 = idx & 15; *(LAS u32x4*)(C.lds + R_OFF + e * RLD + c16 * 16) = Rr[p]; } }
                __syncthreads();
#pragma unroll
                for (int k4 = 0; k4 < 4; ++k4)
#pragma unroll
                    for (int nt = 0; nt < 16; ++nt) { const bf16x8 Ar = as_bf16x8(*(const LAS u32x4*)(C.lds + R_OFF + (16 * nt + fr) * RLD + (32 * k4 + 8 * g) * 2));
                        acc[nt] = __builtin_amdgcn_mfma_f32_16x16x32_bf16(Ar, Bq[4 * dh + k4], acc[nt], 0, 0, 0); }
            }
            const float xi = exp2f(lg2 * (float)(i + 1));
#pragma unroll
            for (int nt = 0; nt < 16; ++nt) acc[nt] = acc[nt] * xi;
        } else __syncthreads();
        f32x4 ST[8];
#pragma unroll
        for (int jt = 0; jt < 8; ++jt) { ST[jt] = (f32x4){0.f, 0.f, 0.f, 0.f};
            if (jt <= w) { const bf16_t* kp = rk + (row0 + 16 * jt + fr) * 1024 + h * 256 + 8 * g;
#pragma unroll
                for (int ks = 0; ks < 8; ++ks) { const bf16x8 Ak = as_bf16x8(*(const u32x4*)(kp + 32 * ks)); ST[jt] = __builtin_amdgcn_mfma_f32_16x16x32_bf16(Ak, Bq[ks], ST[jt], 0, 0, 0); }
#pragma unroll
                for (int r = 0; r < 4; ++r) { const int j = 16 * jt + 4 * g + r; ST[jt][r] = (i >= j) ? ST[jt][r] * exp2f(lg2 * (float)(i - j)) : 0.f; }
                asm volatile("" ::: "memory"); } }
#pragma unroll
        for (int t = 0; t < 4; ++t) if (2 * t <= w) {
            u32x4 sw; sw.x = cvt_pk_bf16(ST[2 * t][0], ST[2 * t][1]); sw.y = cvt_pk_bf16(ST[2 * t][2], ST[2 * t][3]); sw.z = cvt_pk_bf16(ST[2 * t + 1][0], ST[2 * t + 1][1]); sw.w = cvt_pk_bf16(ST[2 * t + 1][2], ST[2 * t + 1][3]);
            const bf16x8 Bs = as_bf16x8(sw);
#pragma unroll
            for (int nt = 0; nt < 16; ++nt) { const bf16x8 Av = tr_frag(Vt, TLD, 32 * t + 4 * g, 32 * t + 16 + 4 * g, 16 * nt, lane); acc[nt] = __builtin_amdgcn_mfma_f32_16x16x32_bf16(Av, Bs, acc[nt], 0, 0, 0); } }
        float ss = 0.f;
#pragma unroll
        for (int nt = 0; nt < 16; ++nt) ss += acc[nt][0] * acc[nt][0] + acc[nt][1] * acc[nt][1] + acc[nt][2] * acc[nt][2] + acc[nt][3] * acc[nt][3];
        ss = quad_sum(ss);
        const float rstd = rsqrtf(ss * (1.f / 256.f) + EPS);
        const size_t ob = (row0 + i) * 1024 + h * 256 + 4 * g;
#pragma unroll
        for (int nt = 0; nt < 16; ++nt) { const u32x2 gw = *(const u32x2*)(rg + ob + 16 * nt); u32x2 o;
            o.x = cvt_pk_bf16(acc[nt][0] * rstd * bf2f(gw.x), acc[nt][1] * rstd * bf2f(gw.x >> 16)); o.y = cvt_pk_bf16(acc[nt][2] * rstd * bf2f(gw.y), acc[nt][3] * rstd * bf2f(gw.y >> 16));
            *(u32x2*)(ret + ob + 16 * nt) = o; }
    }
}
__device__ __forceinline__ void ph_gmlp(const Ctx& C, int l) {
    const bf16_t* gu = WSP(bf16_t, WS_PROJ + P_GU); const bf16_t* gv = WSP(bf16_t, WS_PROJ + P_GV); const float* stats = WSP(float, WS_STATS); bf16_t* gm = WSP(bf16_t, WS_GM);
    const float* lng = C.in[I_LNG] + l * 1024; const float* lnb = C.in[I_LNB] + l * 1024; const float* Wsp = C.in[I_WS] + (size_t)l * 4 * 128 * 128; const float* bs = C.in[I_BS] + l * 4 * 128;
    constexpr int WLD = 272, W_OFF = 128 * TLD, ST_OFF = W_OFF + 128 * WLD;
    const LAS unsigned char* Lt = C.lds; LAS float* sst = (LAS float*)(C.lds + ST_OFF);
    const int g4 = C.lane >> 4, fr = C.lane & 15, w = C.wave;
    for (int u = C.bid; u < 512; u += C.G) {
        const int gg = u & 3, bn = u >> 2, t0 = bn * 128;
        __syncthreads();
        if (C.tid < 128) { const float* sp = stats + (size_t)(t0 + C.tid) * 32; float s = 0.f, q = 0.f;
#pragma unroll
            for (int k = 0; k < 16; ++k) { s += sp[2 * k]; q += sp[2 * k + 1]; }
            const float mean = s * (1.f / 1024.f), var = q * (1.f / 1024.f) - mean * mean; sst[2 * C.tid] = mean; sst[2 * C.tid + 1] = rsqrtf(var + EPS); }
#pragma unroll
        for (int p = 0; p < 4; ++p) { const int idx = p * 512 + C.tid, i = idx >> 4, j8 = (idx & 15) * 8; const float* wp = Wsp + ((size_t)gg * 128 + i) * 128 + j8;
            f32x4 a = *(const f32x4*)wp, b2 = *(const f32x4*)(wp + 4);
#pragma unroll
            for (int j = 0; j < 4; ++j) { if (j8 + j > i) a[j] = 0.f; if (j8 + 4 + j > i) b2[j] = 0.f; }
            *(LAS u32x4*)(C.lds + W_OFF + i * WLD + j8 * 2) = pack8(a, b2); }
        __syncthreads();
#pragma unroll
        for (int p = 0; p < 8; ++p) { const int idx = p * 512 + C.tid, row = idx >> 5, ch = idx & 31, cg = gg * 256 + ch * 8;
            float f[8]; unpack8(*(const u32x4*)(gv + (size_t)(t0 + row) * 1024 + cg), f); const float mean = sst[2 * row], rstd = sst[2 * row + 1];
            const f32x4 g0 = *(const f32x4*)(lng + cg), g1 = *(const f32x4*)(lng + cg + 4), b0 = *(const f32x4*)(lnb + cg), b1 = *(const f32x4*)(lnb + cg + 4);
            f32x4 y0, y1;
#pragma unroll
            for (int j = 0; j < 4; ++j) { y0[j] = (f[j] - mean) * rstd * g0[j] + b0[j]; y1[j] = (f[4 + j] - mean) * rstd * g1[j] + b1[j]; }
            *(LAS u32x4*)(C.lds + row * TLD + ch * 16) = pack8(y0, y1); }
        __syncthreads();
        f32x4 acc[16];
#pragma unroll
        for (int nt = 0; nt < 16; ++nt) acc[nt] = (f32x4){0.f, 0.f, 0.f, 0.f};
#pragma unroll
        for (int ks = 0; ks < 4; ++ks) if (2 * ks <= w) {
            const bf16x8 Bw = as_bf16x8(*(const LAS u32x4*)(C.lds + W_OFF + (16 * w + fr) * WLD + (32 * ks + 8 * g4) * 2));
#pragma unroll
            for (int nt = 0; nt < 16; ++nt) { const bf16x8 Av = tr_frag(Lt, TLD, 32 * ks + 8 * g4, 32 * ks + 8 * g4 + 4, 16 * nt, C.lane); acc[nt] = __builtin_amdgcn_mfma_f32_16x16x32_bf16(Av, Bw, acc[nt], 0, 0, 0); } }
        const int i = 16 * w + fr; const float bias = bs[gg * 128 + i]; const size_t ob = (size_t)(t0 + i) * 1024 + gg * 256 + 4 * g4;
#pragma unroll
        for (int nt = 0; nt < 16; ++nt) { const u32x2 uw = *(const u32x2*)(gu + ob + 16 * nt); u32x2 o;
            o.x = cvt_pk_bf16((acc[nt][0] + bias) * bf2f(uw.x), (acc[nt][1] + bias) * bf2f(uw.x >> 16)); o.y = cvt_pk_bf16((acc[nt][2] + bias) * bf2f(uw.y), (acc[nt][3] + bias) * bf2f(uw.y >> 16));
            *(u32x2*)(gm + ob + 16 * nt) = o; }
    }
}

__device__ __forceinline__ void ph_idx(const Ctx& C) {
    const bf16_t* iq = WSP(bf16_t, WS_PROJ + P_IQ); const bf16_t* ik = WSP(bf16_t, WS_PROJ + P_IK); const float* iw = WSP(float, WS_PROJ + P_IW); unsigned short* sel = WSP(unsigned short, WS_SEL);
    LAS unsigned* sc = (LAS unsigned*)C.lds;
    const int lane = C.lane, n32 = lane & 31, hh = lane >> 5, w = C.wave;
    for (int u = C.bid; u < T / 8; u += C.G) {
        const int b = u & 3, q0 = (SEQ / 8 - 1 - (u >> 2)) * 8, tq0 = b * SEQ + q0, nk = q0 + 8, nkt = (nk + 31) >> 5;
        __syncthreads();
        bf16x8 Aq[2][4]; float wq[2][16];
        { const int r = n32, qi = 2 * ((r >> 2) & 1) + (r >> 4), hd = (r & 3) + 4 * ((r >> 3) & 1);
#pragma unroll
          for (int mt = 0; mt < 2; ++mt) { const bf16_t* qp = iq + (size_t)(tq0 + 4 * mt + qi) * 512 + hd * 64 + 8 * hh;
#pragma unroll
              for (int ks = 0; ks < 4; ++ks) Aq[mt][ks] = as_bf16x8(*(const u32x4*)(qp + 16 * ks));
#pragma unroll
              for (int a = 0; a < 2; ++a) { const float* wp = iw + (size_t)(tq0 + 4 * mt + 2 * hh + a) * 8; const f32x4 w0 = *(const f32x4*)wp, w1 = *(const f32x4*)(wp + 4);
#pragma unroll
                  for (int j = 0; j < 4; ++j) { wq[mt][8 * a + j] = w0[j] * 0.125f; wq[mt][8 * a + 4 + j] = w1[j] * 0.125f; } } } }
        u32x4 Bn[4];
        { const bf16_t* kp = ik + ((size_t)b * SEQ + 32 * (w < nkt ? w : 0) + n32) * 64 + 8 * hh;
#pragma unroll
          for (int ks = 0; ks < 4; ++ks) Bn[ks] = *(const u32x4*)(kp + 16 * ks); }
        for (int kt = w; kt < nkt; kt += 8) {
            bf16x8 Bk[4];
#pragma unroll
            for (int ks = 0; ks < 4; ++ks) Bk[ks] = as_bf16x8(Bn[ks]);
            { const int k2 = (kt + 8 < nkt) ? kt + 8 : kt; const bf16_t* kp = ik + ((size_t)b * SEQ + 32 * k2 + n32) * 64 + 8 * hh;
#pragma unroll
              for (int ks = 0; ks < 4; ++ks) Bn[ks] = *(const u32x4*)(kp + 16 * ks); }
#pragma unroll
            for (int mt = 0; mt < 2; ++mt) { f32x16 acc;
#pragma unroll
                for (int j = 0; j < 16; ++j) acc[j] = 0.f;
#pragma unroll
                for (int ks = 0; ks < 4; ++ks) acc = __builtin_amdgcn_mfma_f32_32x32x16_bf16(Aq[mt][ks], Bk[ks], acc, 0, 0, 0);
#pragma unroll
                for (int a = 0; a < 2; ++a) { float s = 0.f;
#pragma unroll
                    for (int rr = 0; rr < 8; ++rr) s += wq[mt][8 * a + rr] * fmaxf(acc[8 * a + rr], 0.f);
                    const int qu = 4 * mt + 2 * hh + a, key = 32 * kt + n32; unsigned bits = __builtin_bit_cast(unsigned, s);
                    bits = (bits & 0x80000000u) ? ~bits : (bits | 0x80000000u);
                    sc[qu * 4096 + key] = (key <= q0 + qu) ? bits : 0u; } }
        }
        __syncthreads();
        { const int q = q0 + w, n = q + 1; const size_t so = (size_t)(tq0 + w) * 256;
          if (n <= 256) { for (int r = lane; r < 256; r += 64) sel[so + r] = (r < n) ? (unsigned short)r : (unsigned short)0xFFFFu; }
          else {
            const int ni = (n + 63) >> 6;
            unsigned uu[64];
#pragma unroll
            for (int i = 0; i < 64; ++i) uu[i] = (i < ni && 64 * i + lane < nkt * 32) ? sc[w * 4096 + 64 * i + lane] : 0u;
            const int nact = (ni + 15) >> 4, below_const = (4 - nact) * 1024;
            LAS unsigned* slot = sc + w * 4096;
            unsigned Hp[32];
#pragma unroll
            for (int j = 0; j < 32; ++j) Hp[j] = (uu[2 * j] >> 16) | (uu[2 * j + 1] & 0xffff0000u);
#define IDX_BELOW(dst, cval) do { const unsigned cm1_ = ((cval) - 1u) * 0x00010001u; unsigned cnt_ = 0u; \
            _Pragma("unroll") for (int g4 = 0; g4 < 4; ++g4) if (g4 < nact) { _Pragma("unroll") for (int j = 8 * g4; j < 8 * g4 + 8; ++j) cnt_ = pk_below(Hp[j], cm1_, cnt_); } \
            (dst) = wave_total_dpp((int)((cnt_ & 0xffffu) + (cnt_ >> 16))) + below_const; } while (0)
            unsigned Th = 0u; int geT = 4096;
#pragma unroll 1
            for (int bit = 15; bit >= 0; --bit) { const unsigned c = Th | (1u << bit); int bl; IDX_BELOW(bl, c); if (4096 - bl >= 256) { Th = c; geT = 4096 - bl; } }
            int gtT = 0; if (Th != 0xffffu) { int bl; IDX_BELOW(bl, Th + 1u); gtT = 4096 - bl; }
            const int krem = 256 - gtT, nc = geT - gtT;
            unsigned Tv; int need; bool simple;
            if (nc <= 64) {
                int base = 0; const unsigned long long lt = (1ull << lane) - 1ull;
#pragma unroll
                for (int i = 0; i < 64; ++i) { const bool eq = (uu[i] >> 16) == Th; const unsigned long long em = __ballot(eq);
                    if (em) { if (eq) slot[base + __builtin_popcountll(em & lt)] = (uu[i] & 0xffffu) + 1u; base += __builtin_popcountll(em); } }
                asm volatile("s_waitcnt lgkmcnt(0)" ::: "memory");
                const unsigned tv = (lane < nc) ? slot[lane] : 0u;
                unsigned Tl = 0u;
#pragma unroll 1
                for (int bit = 16; bit >= 0; --bit) { const unsigned c = Tl | (1u << bit); if (__builtin_popcountll(__ballot(tv >= c)) >= krem) Tl = c; }
                need = krem - __builtin_popcountll(__ballot(tv > Tl)); simple = (need == __builtin_popcountll(__ballot(tv == Tl)));
                Tv = (Th << 16) | (Tl - 1u);
                asm volatile("s_waitcnt lgkmcnt(0)" ::: "memory");
            } else {
#pragma unroll
                for (int j = 0; j < 32; ++j) { const unsigned a = uu[2 * j], b2 = uu[2 * j + 1]; Hp[j] = (((a >> 16) == Th) ? (a & 0xffffu) : 0u) | (((b2 >> 16) == Th) ? (b2 << 16) : 0u); }
                unsigned Tl = 0u;
#pragma unroll 1
                for (int bit = 15; bit >= 0; --bit) { const unsigned c = Tl | (1u << bit); int bl; IDX_BELOW(bl, c); if (4096 - bl >= krem) Tl = c; }
                Tv = (Th << 16) | Tl; int cg = 0;
#pragma unroll
                for (int i = 0; i < 64; ++i) cg += (uu[i] > Tv) ? 1 : 0;
                need = 256 - wave_total_dpp(cg); simple = false;
            }
#undef IDX_BELOW
            if (simple) {
                int base = 0;
#pragma unroll
                for (int i = 0; i < 64; ++i) if (16 * (i >> 4) < ni) { const bool take = uu[i] >= Tv; const unsigned long long tm = __ballot(take);
                    const int pos = base + (int)__builtin_amdgcn_mbcnt_hi((unsigned)(tm >> 32), __builtin_amdgcn_mbcnt_lo((unsigned)tm, 0u));
                    if (take) sel[so + pos] = (unsigned short)(64 * i + lane);
                    base += __builtin_popcountll(tm); }
            } else {
                int base = 0, eqs = 0; const unsigned long long lt = (1ull << lane) - 1ull;
#pragma unroll
                for (int i = 0; i < 64; ++i) if (16 * (i >> 4) < ni) { const bool gt = uu[i] > Tv, eq = uu[i] == Tv; const unsigned long long em = __ballot(eq);
                    const bool take = gt || (eq && (eqs + __builtin_popcountll(em & lt)) < need); const unsigned long long tm = __ballot(take);
                    if (take) sel[so + base + __builtin_popcountll(tm & lt)] = (unsigned short)(64 * i + lane);
                    base += __builtin_popcountll(tm); eqs += __builtin_popcountll(em); }
            }
          } }
    }
}
__device__ __forceinline__ void ph_att(const Ctx& C) {
    const bf16_t* qabs = WSP(bf16_t, WS_QABS); const bf16_t* ckv = WSP(bf16_t, WS_CKV); const unsigned short* sel = WSP(unsigned short, WS_SEL); bf16_t* olat = WSP(bf16_t, WS_OLAT);
    const int lane = C.lane, g = lane >> 4, fr = lane & 15;
    LAS unsigned char* ch = C.lds + C.wave * (32 * TLD + 512);
    LAS unsigned short* ssel = (LAS unsigned short*)(ch + 32 * TLD);
    for (int tq = C.gw; tq < T; tq += C.NGW) {
        const int b = tq >> 12, q = tq & (SEQ - 1), nv = (q + 1) < 256 ? (q + 1) : 256, nch = (nv + 31) >> 5;
        const bf16_t* cb = ckv + (size_t)b * SEQ * 256;
        { u32x2 sv = *(const u32x2*)(sel + (size_t)tq * 256 + 4 * lane);
          unsigned s0 = sv.x & 0xffffu, s1 = sv.x >> 16, s2_ = sv.y & 0xffffu, s3 = sv.y >> 16;
          if (4 * lane + 0 >= nv) s0 = 0; if (4 * lane + 1 >= nv) s1 = 0; if (4 * lane + 2 >= nv) s2_ = 0; if (4 * lane + 3 >= nv) s3 = 0;
          *(LAS u32x2*)(ssel + 4 * lane) = (u32x2){s0 | (s1 << 16), s2_ | (s3 << 16)}; }
        bf16x8 Bqa[8];
        { const bf16_t* qp = qabs + (size_t)tq * 2048 + (fr & 7) * 256 + 8 * g;
#pragma unroll
          for (int ks = 0; ks < 8; ++ks) { u32x4 v = *(const u32x4*)(qp + 32 * ks); if (fr >= 8) v = (u32x4){0u, 0u, 0u, 0u}; Bqa[ks] = as_bf16x8(v); } }
        f32x4 acc[16];
#pragma unroll
        for (int nt = 0; nt < 16; ++nt) acc[nt] = (f32x4){0.f, 0.f, 0.f, 0.f};
        float mrun = -INFINITY, lrun = 0.f;
        asm volatile("s_waitcnt lgkmcnt(0)" ::: "memory");
        u32x4 G[16];
#pragma unroll
        for (int p = 0; p < 16; ++p) { const int s = ssel[2 * p + (lane >> 5)]; G[p] = *(const u32x4*)(cb + (size_t)s * 256 + (lane & 31) * 8); }
#pragma unroll 1
        for (int t = 0; t < nch; ++t) {
#pragma unroll
            for (int p = 0; p < 16; ++p) *(LAS u32x4*)(ch + (2 * p + (lane >> 5)) * TLD + (lane & 31) * 16) = G[p];
            if (t + 1 < nch) {
#pragma unroll
                for (int p = 0; p < 16; ++p) { const int s = ssel[32 * (t + 1) + 2 * p + (lane >> 5)]; G[p] = *(const u32x4*)(cb + (size_t)s * 256 + (lane & 31) * 8); } }
            asm volatile("s_waitcnt lgkmcnt(0)" ::: "memory");
            f32x4 s2[2];
#pragma unroll
            for (int hf = 0; hf < 2; ++hf) { s2[hf] = (f32x4){0.f, 0.f, 0.f, 0.f};
#pragma unroll
                for (int ks = 0; ks < 8; ++ks) { const bf16x8 Ac = as_bf16x8(*(const LAS u32x4*)(ch + (16 * hf + fr) * TLD + (32 * ks + 8 * g) * 2)); s2[hf] = __builtin_amdgcn_mfma_f32_16x16x32_bf16(Ac, Bqa[ks], s2[hf], 0, 0, 0); } }
            float cm = -INFINITY;
#pragma unroll
            for (int hf = 0; hf < 2; ++hf)
#pragma unroll
                for (int r = 0; r < 4; ++r) { const int ki = 32 * t + 16 * hf + 4 * g + r; if (ki >= nv) s2[hf][r] = -INFINITY; cm = fmaxf(cm, s2[hf][r]); }
            cm = quad_max(cm);
            const float mnew = fmaxf(mrun, cm), scale = __expf(mrun - mnew); float ps = 0.f;
#pragma unroll
            for (int hf = 0; hf < 2; ++hf)
#pragma unroll
                for (int r = 0; r < 4; ++r) { s2[hf][r] = __expf(s2[hf][r] - mnew); ps += s2[hf][r]; }
            ps = quad_sum(ps);
            lrun = lrun * scale + ps; mrun = mnew;
            u32x4 pw; pw.x = cvt_pk_bf16(s2[0][0], s2[0][1]); pw.y = cvt_pk_bf16(s2[0][2], s2[0][3]); pw.z = cvt_pk_bf16(s2[1][0], s2[1][1]); pw.w = cvt_pk_bf16(s2[1][2], s2[1][3]);
            const bf16x8 Bp = as_bf16x8(pw);
#pragma unroll
            for (int nt = 0; nt < 16; ++nt) { const bf16x8 Av = tr_frag(ch, TLD, 4 * g, 16 + 4 * g, 16 * nt, lane); acc[nt] = __builtin_amdgcn_mfma_f32_16x16x32_bf16(Av, Bp, acc[nt] * scale, 0, 0, 0); }
            asm volatile("s_waitcnt lgkmcnt(0)" ::: "memory");
        }
        const float inv = 1.0f / lrun;
        if (fr < 8) { bf16_t* op = olat + (size_t)tq * 2048 + fr * 256 + 4 * g;
#pragma unroll
            for (int nt = 0; nt < 16; ++nt) { u32x2 o; o.x = cvt_pk_bf16(acc[nt][0] * inv, acc[nt][1] * inv); o.y = cvt_pk_bf16(acc[nt][2] * inv, acc[nt][3] * inv); *(u32x2*)(op + 16 * nt) = o; } }
    }
}

__device__ __forceinline__ void ph_norm_hilo(const Ctx& C, const float* x, const float* g, bf16_t* H, bf16_t* HLO) {
    for (int row = C.gw; row < T; row += C.NGW) {
        const f32x4* xr = (const f32x4*)(x + (size_t)row * DM) + C.lane; f32x4 v[8]; float ss = 0.f;
#pragma unroll
        for (int j = 0; j < 8; ++j) { v[j] = xr[64 * j]; ss += v[j][0] * v[j][0] + v[j][1] * v[j][1] + v[j][2] * v[j][2] + v[j][3] * v[j][3]; }
        const float rstd = rsqrtf(wave_sum(ss, C.lane) * (1.f / DM) + EPS);
        u32x2* oh = (u32x2*)(H + (size_t)row * DM) + C.lane; u32x2* ol = (u32x2*)(HLO + (size_t)row * DM) + C.lane;
#pragma unroll
        for (int j = 0; j < 8; ++j) { const f32x4 gg = ((const f32x4*)g)[64 * j + C.lane]; const f32x4 y = v[j] * rstd * gg; u32x2 wh; wh.x = cvt_pk_bf16(y[0], y[1]); wh.y = cvt_pk_bf16(y[2], y[3]);
            u32x2 wl; wl.x = cvt_pk_bf16(y[0] - bf2f(wh.x), y[1] - bf2f(wh.x >> 16)); wl.y = cvt_pk_bf16(y[2] - bf2f(wh.y), y[3] - bf2f(wh.y >> 16)); oh[64 * j] = wh; ol[64 * j] = wl; }
    }
}
__device__ __forceinline__ void ph_route(const Ctx& C, int l) {
    const float* LOG = WSP(float, WS_OLAT); const float* bg = C.in[I_BGRP] + l * 4; const float* be = C.in[I_BEXP] + l * 32;
    int* rinfo = WSP(int, WS_ROUTE); float* rw = (float*)(rinfo + T * 4); unsigned* cnt = C.ctl + CW_CNT + l * 64;
    for (int t0 = C.gw * 8; t0 < T; t0 += C.NGW * 8) if (C.lane < 8) {
        const int t = t0 + C.lane;
        float lg[36];
#pragma unroll
        for (int c = 0; c < 36; ++c) lg[c] = 0.f;
#pragma unroll
        for (int part = 0; part < 4; ++part) { const f32x4* p = (const f32x4*)(LOG + ((size_t)part * T + t) * 128);
#pragma unroll
            for (int c4 = 0; c4 < 9; ++c4) { const f32x4 a = p[c4];
#pragma unroll
                for (int j = 0; j < 4; ++j) lg[4 * c4 + j] += a[j];
                if (part < 2) { const f32x4 b2 = p[16 + c4];
#pragma unroll
                    for (int j = 0; j < 4; ++j) lg[4 * c4 + j] += b2[j]; } } }
        int gsel = 0; float gmax = -INFINITY, gv4[4];
#pragma unroll
        for (int k = 0; k < 4; ++k) { gv4[k] = lg[k] + bg[k]; if (gv4[k] > gmax) { gmax = gv4[k]; gsel = k; } }
        float gden = 0.f;
#pragma unroll
        for (int k = 0; k < 4; ++k) gden += __expf(gv4[k] - gmax);
        const float pg = 1.f / gden;
        float el[8], emax = -INFINITY;
#pragma unroll
        for (int k = 0; k < 8; ++k) { const float v0 = lg[4 + k] + be[k], v1 = lg[12 + k] + be[8 + k], v2 = lg[20 + k] + be[16 + k], v3 = lg[28 + k] + be[24 + k];
            el[k] = gsel == 0 ? v0 : (gsel == 1 ? v1 : (gsel == 2 ? v2 : v3)); emax = fmaxf(emax, el[k]); }
        float eden = 0.f, ep[8];
#pragma unroll
        for (int k = 0; k < 8; ++k) { ep[k] = __expf(el[k] - emax); eden += ep[k]; }
        int i0 = 0; float p0 = -1.f;
#pragma unroll
        for (int k = 0; k < 8; ++k) { ep[k] = ep[k] / eden; if (ep[k] > p0) { p0 = ep[k]; i0 = k; } }
        int i1 = 0; float p1 = -1.f;
#pragma unroll
        for (int k = 0; k < 8; ++k) if (k != i0 && ep[k] > p1) { p1 = ep[k]; i1 = k; }
        const float den = p0 + p1; const int e0 = gsel * 8 + i0, e1 = gsel * 8 + i1;
        const unsigned r0 = atomicAdd(&cnt[e0], 1u), r1 = atomicAdd(&cnt[e1], 1u);
        int* list = WSP(int, WS_LIST); list[(size_t)e0 * T + r0] = t; list[(size_t)e1 * T + r1] = t;
        *(int4*)(rinfo + (size_t)t * 4) = make_int4(e0, e1, (int)r0, (int)r1); *(f32x2*)(rw + (size_t)t * 2) = (f32x2){pg * (p0 / den), pg * (p1 / den)};
    }
}
__device__ __forceinline__ int moe_offsets(const unsigned* cnt, int lane, int& total_tiles) {
    const int c = lane < NEXP ? (int)__hip_atomic_load(cnt + lane, __ATOMIC_RELAXED, __HIP_MEMORY_SCOPE_AGENT) : 0; const int tiles = (c + 255) >> 8;
    int incl = tiles;
#pragma unroll
    for (int o = 1; o < 64; o <<= 1) { const int t = shi(incl, (lane - o) & 63); if (lane >= o) incl += t; }
    total_tiles = shi(incl, 63);
    return (incl - tiles) * 256;
}
__device__ __forceinline__ int moe_table(const Ctx& C, int l) {
    __syncthreads();
    if (C.wave == 0) { int tt; const int off = moe_offsets(C.ctl + CW_CNT + l * 64 + CNT_BANK, C.lane, tt); const int nxt = shi(off, (C.lane + 1) & 63);
        if (C.lane < NEXP) { const int t0 = off >> 8, t1 = (C.lane == NEXP - 1) ? tt : (nxt >> 8); const int cn = (int)__hip_atomic_load(C.ctl + CW_CNT + l * 64 + CNT_BANK + C.lane, __ATOMIC_RELAXED, __HIP_MEMORY_SCOPE_AGENT);
            for (int t = t0; t < t1; ++t) { C.misc[16 + t] = C.lane; C.misc[176 + t] = (t - t0) * 256; C.misc[336 + t] = cn; } }
        if (C.lane == 0) C.misc[500] = tt; }
    __syncthreads();
    return C.misc[500];
}
__device__ __forceinline__ void ph_combine(const Ctx& C, int l, float* x, bool last, const float* gnext, bf16_t* Hn) {
    const bf16_t* yc = WSP(bf16_t, WS_PROJ + M_YC); const int* rinfo = WSP(int, WS_ROUTE); const float* rw = (const float*)(rinfo + T * 4); const int* rpos = rinfo + T * 6; const float* gf = C.in[I_FNG];
    int tt_; const int myoff = moe_offsets(C.ctl + CW_CNT + l * 64 + CNT_BANK, C.lane, tt_);
    for (int row = C.gw; row < T; row += C.NGW) {
        const int4 ri = *(const int4*)(rinfo + (size_t)row * 4); const int p0 = shi(myoff, ri.x) + ri.z, p1 = shi(myoff, ri.y) + ri.w; const float w0 = rw[(size_t)row * 2], w1 = rw[(size_t)row * 2 + 1];
        f32x4* xr = (f32x4*)(x + (size_t)row * DM) + C.lane; const u32x2* y0 = (const u32x2*)(yc + (size_t)p0 * DM) + C.lane; const u32x2* y1 = (const u32x2*)(yc + (size_t)p1 * DM) + C.lane;
        f32x4 v[8]; float ss = 0.f;
#pragma unroll
        for (int j = 0; j < 8; ++j) { const u32x2 a = y0[64 * j], b = y1[64 * j]; f32x4 xv = xr[64 * j];
            xv[0] += w0 * bf2f(a.x) + w1 * bf2f(b.x); xv[1] += w0 * bf2f(a.x >> 16) + w1 * bf2f(b.x >> 16); xv[2] += w0 * bf2f(a.y) + w1 * bf2f(b.y); xv[3] += w0 * bf2f(a.y >> 16) + w1 * bf2f(b.y >> 16);
            v[j] = xv; ss += xv[0] * xv[0] + xv[1] * xv[1] + xv[2] * xv[2] + xv[3] * xv[3]; }
        if (last) { const float rstd = rsqrtf(wave_sum(ss, C.lane) * (1.f / DM) + EPS);
#pragma unroll
            for (int j = 0; j < 8; ++j) xr[64 * j] = v[j] * rstd * ((const f32x4*)gf)[64 * j + C.lane]; }
        else { const float rstd = rsqrtf(wave_sum(ss, C.lane) * (1.f / DM) + EPS); u32x2* o = (u32x2*)(Hn + (size_t)row * DM) + C.lane;
#pragma unroll
            for (int j = 0; j < 8; ++j) { xr[64 * j] = v[j]; const f32x4 y = v[j] * rstd * ((const f32x4*)gnext)[64 * j + C.lane]; u32x2 w; w.x = cvt_pk_bf16(y[0], y[1]); w.y = cvt_pk_bf16(y[2], y[3]); o[64 * j] = w; } }
    }
}

constexpr int NPL = 14, NPHASES = 1 + DEPTH * NPL;
#if MK_PER_PHASE
#define IN(k) (lo <= (k) && (k) < hi)
#else
#define IN(k) true
#endif
#if MK_PER_PHASE
#define SEAM(k) do { } while (0)
#else
#define SEAM(k) xcd_barrier(bar)
#endif
template <int l> __device__ __forceinline__ void run_layer(Ctx& C, const XcdBarrier& bar, const int lo, const int hi) {
    unsigned char* wb = (unsigned char*)(C.ws + WS_W);
    bf16_t* H = WSP(bf16_t, WS_H);
        const int pb = 1 + l * NPL;
        const float* xin = (l == 0) ? C.in[I_X] : (const float*)C.out;
        if (l == 0) { if (IN(pb + 0)) { refresh(C); ph_rope(C); refresh(C); REP(1) ph_weights(C, 0); REP(2) ph_norm(C, xin, C.in[I_NMIX], H); }
            SEAM(pb + 0); }
        if (IN(pb + 1)) { refresh(C);
            pg8::Gemm g{H, (const bf16_t*)(wb + W_IN), DM, DM, DM}; pg8::OrderMN S; S.init(T / 256, NP / 256, C.G, C.bid, 256L * DM * 2, 256L * DM * 2);
            pg8::EpiInProj E{(unsigned char*)C.ws};
            REP(3) pg8::gemm_phase(C.lds, g, S, E);
        }
        SEAM(pb + 1);
        if (IN(pb + 2)) { refresh(C);
            ph_ckv(C, WSP(float, WS_PROJ + P_DC), C.in[I_KVG] + l * 256, WSP(bf16_t, WS_CKV));
            { pg8::Gemm g{WSP(bf16_t, WS_PROJ + P_DQ), (const bf16_t*)(wb + W_UK), 1024, 256, 256}; pg8::OrderMN S; S.init(T / 256, 8, C.G, C.bid, 256L * 1024 * 2, 256L * 256 * 2, 1, 256L * 2);
              pg8::EpiStore<0> E{WSP(bf16_t, WS_QABS), 2048, 0.08838834764831845f}; REP(4) pg8::gemm_phase(C.lds, g, S, E); }
            refresh(C);
            REP(5) ph_gmlp(C, l);
            refresh(C);
            REP(6) ph_ret_kv(C);
            refresh(C);
            REP(7) ph_idx(C);
        }
        SEAM(pb + 2);
        if (IN(pb + 3)) { refresh(C);
            REP(8) ph_ret_scan(C);
            REP(9) ph_att(C);
        }
        SEAM(pb + 3);
        if (IN(pb + 4)) { refresh(C);
            { pg8::Gemm g{WSP(bf16_t, WS_OLAT), (const bf16_t*)(wb + W_UV), 2048, 512, 512}; pg8::OrderMN S; S.init(T / 256, 4, C.G, C.bid, 256L * 2048 * 2, 256L * 512 * 2, 0, 512L * 2);
              pg8::EpiStore<0> E{WSP(bf16_t, WS_DS), 1024, 1.0f}; REP(10) pg8::gemm_phase(C.lds, g, S, E); }
            REP(11) ph_ret_out(C);
        }
        SEAM(pb + 4);
        if (IN(pb + 5)) { refresh(C);
            pg8::Gemm g{WSP(bf16_t, WS_RET), (const bf16_t*)(wb + W_RET), 1024, 1024, 1024}; pg8::OrderBranch S; S.base.init(T / 256, 8, C.G, C.bid, 256L * 1024 * 2, 256L * 1024 * 2); S.astride = 32L << 20; S.bstride = 4L << 20;
            pg8::EpiBranch E{WSP(bf16_t, WS_PROJ + P_GA), H}; REP(12) pg8::gemm_phase<pg8::EpiBranch, pg8::OrderBranch, false, true>(C.lds, g, S, E);
        }
        SEAM(pb + 5);
        if (IN(pb + 6)) { refresh(C);
            pg8::Gemm g{H, (const bf16_t*)(wb + W_OUT), DM, DM, DM}; pg8::OrderMN S; S.init(T / 256, 8, C.G, C.bid, 256L * DM * 2, 256L * DM * 2);
            pg8::EpiResid E{xin, C.out}; for (int rep_ = 0; rep_ <= ((l == 0) ? ((PROBE_MASK >> 17) & 1) : 0); ++rep_) pg8::gemm_phase(C.lds, g, S, E);
        }
        SEAM(pb + 6);
        if (IN(pb + 7)) { refresh(C); ph_norm_hilo(C, C.out, C.in[I_NFFN] + l * DM, H, WSP(bf16_t, WS_QABS)); }
        SEAM(pb + 7);
        if (IN(pb + 8)) { refresh(C);
            pg8::Gemm g{H, (const bf16_t*)(wb + W_RT), DM, DM, 1024}; pg8::OrderRouter S{C.G, C.bid, (long)(WS_QABS - WS_H)};
            pg8::EpiRouter E{WSP(float, WS_OLAT)}; pg8::gemm_phase(C.lds, g, S, E);
        }
        SEAM(pb + 8);
        if (IN(pb + 9)) { refresh(C); ph_route(C, l); }
        SEAM(pb + 9);
        if (IN(pb + 11)) { refresh(C);
            const int Mt = moe_table(C, l);
            pg8::Gemm g{H, (const bf16_t*)(wb + W_13), DM, DM, DM};
            pg8::OrderMoE S{C.misc + 16, Mt, 4, C.G, C.bid, 256L * DM * 2, 256L * DM * 2, 1024L * DM * 2, WSP(int, WS_LIST)};
            pg8::EpiMoeUp E{WSP(bf16_t, WS_PROJ + M_HID)}; REP(14) pg8::gemm_phase<pg8::EpiMoeUp, pg8::OrderMoE, true>(C.lds, g, S, E);
        }
        SEAM(pb + 11);
        if (IN(pb + 12)) { refresh(C);
            const int Mt = moe_table(C, l);
            pg8::Gemm g{WSP(bf16_t, WS_PROJ + M_HID), (const bf16_t*)(wb + W_2), FF, FF, FF};
            pg8::OrderMoE S{C.misc + 16, Mt, 8, C.G, C.bid, 256L * FF * 2, 256L * FF * 2, (long)DM * FF * 2, nullptr};
            pg8::EpiStore<0> E{WSP(bf16_t, WS_PROJ + M_YC), DM, 1.0f}; REP(15) pg8::gemm_phase(C.lds, g, S, E);
        }
        SEAM(pb + 12);
        if (IN(pb + 13)) { refresh(C); ph_combine(C, l, C.out, l == DEPTH - 1, C.in[I_NMIX] + (l + 1 < DEPTH ? l + 1 : l) * DM, H); if (l + 1 < DEPTH) { refresh(C); ph_weights(C, l + 1); } }
        if (l + 1 < DEPTH) SEAM(pb + 13);

}
__global__ void __launch_bounds__(512, 2) mk_fwd(Args a) {
    extern __shared__ __attribute__((aligned(16))) unsigned char lds_raw[];
    Ctx C;
    C.lds = (LAS unsigned char*)lds_raw; C.misc = (volatile LAS int*)(C.lds + MISC_OFF); C.ws = (GAS unsigned char*)a.ws; C.ctl = (unsigned*)(a.ws + WS_CTL);
    C.tid = threadIdx.x; C.lane = C.tid & 63; C.wave = __builtin_amdgcn_readfirstlane(C.tid >> 6); C.G = gridDim.x; C.bid = blockIdx.x;
    C.gw = C.bid * 8 + C.wave; C.NGW = C.G * 8; C.in = a.in; C.out = a.out;
    for (int i = C.tid; i < 1024; i += 512) C.misc[i] = 0;
    __syncthreads();
#if MK_PER_PHASE
    XcdBarrier bar; bar.bar = C.ctl + CW_BAR; bar.x = 0; bar.st = (volatile LAS unsigned*)C.misc;
#else
    XcdBarrier bar = xcd_barrier_post(C.ctl + CW_BAR, (volatile LAS unsigned*)C.misc);
#endif
    const int lo = a.ph_lo, hi = a.ph_hi;
    run_layer<0>(C, bar, lo, hi);
    run_layer<1>(C, bar, lo, hi);
}

extern "C" void kernel_launch(void* const* d_in, const int* in_sizes, int n_in, void* d_out, int out_size, void* d_ws, size_t ws_size, hipStream_t stream) {
    static int grid = 0;
    if (grid == 0) {
        if (n_in != 23 || out_size != T * DM || ws_size < WS_END) { fprintf(stderr, "kernel_launch: unexpected shapes / workspace (n_in %d out %d ws %zu need %zu)\n", n_in, out_size, ws_size, (size_t)WS_END); grid = -1; return; }
        int dev = 0, cus = 0, per_cu = 0;
        if (hipGetDevice(&dev) != hipSuccess || hipDeviceGetAttribute(&cus, hipDeviceAttributeMultiprocessorCount, dev) != hipSuccess) { grid = -1; return; }
        if (hipFuncSetAttribute((const void*)mk_fwd, hipFuncAttributeMaxDynamicSharedMemorySize, LDS_BYTES) != hipSuccess) { fprintf(stderr, "kernel_launch: hipFuncSetAttribute failed\n"); grid = -1; return; }
        if (hipOccupancyMaxActiveBlocksPerMultiprocessor(&per_cu, (const void*)mk_fwd, 512, LDS_BYTES) != hipSuccess || per_cu < 1) { fprintf(stderr, "kernel_launch: occupancy query says %d\n", per_cu); (void)hipGetLastError(); grid = -1; return; }
        grid = cus;
    }
    if (grid < 0) return;
    (void)hipMemsetAsync((char*)d_ws + WS_CTL, 0, CTL_BYTES, stream);
    Args a{};
    for (int i = 0; i < 23; ++i) a.in[i] = (const float*)d_in[i];
    a.out = (float*)d_out; a.ws = (unsigned char*)d_ws;
#if MK_PER_PHASE
    for (int p = 0; p < NPHASES; ++p) { a.ph_lo = p; a.ph_hi = p + 1; hipLaunchKernelGGL(mk_fwd, dim3(grid), dim3(512), LDS_BYTES, stream, a); }
#else
    a.ph_lo = 0; a.ph_hi = NPHASES;
    hipLaunchKernelGGL(mk_fwd, dim3(grid), dim3(512), LDS_BYTES, stream, a);
#endif
}
```

```cpp
#include <hip/hip_runtime.h>
#include <stdint.h>
#include <stdio.h>

#ifndef MK_PER_PHASE
#define MK_PER_PHASE 0
#endif
#ifndef PROBE_MASK
#define PROBE_MASK 0
#endif
#define CNT_BANK (((PROBE_MASK >> 16) & 1) * 128)
#define REP(k) for (int rep_ = 0; rep_ <= ((PROBE_MASK >> (k)) & 1); ++rep_)

#define LAS __attribute__((address_space(3)))
#define GAS __attribute__((address_space(1)))
typedef unsigned short bf16_t;
typedef short bf16x8 __attribute__((ext_vector_type(8)));
typedef short s16x4 __attribute__((ext_vector_type(4)));
typedef float f32x4 __attribute__((ext_vector_type(4)));
typedef float f32x2 __attribute__((ext_vector_type(2)));
typedef float f32x16 __attribute__((ext_vector_type(16)));
typedef unsigned u32x4 __attribute__((ext_vector_type(4)));
typedef unsigned u32x2 __attribute__((ext_vector_type(2)));

constexpr int DM = 2048, NB = 4, SEQ = 4096, T = NB * SEQ, DEPTH = 2;
constexpr int INW = 14152, NP = 14336;
constexpr int GATE_SRC0 = 8008, GATE_DST0 = 8192;
constexpr int NEXP = 32, FF = 512, MOE_ROWS = 40960;
constexpr float EPS = 1e-6f;

constexpr size_t MiB = 1u << 20;
constexpr size_t WS_CTL = 0, CTL_BYTES = 1 * MiB;
constexpr size_t WS_ROPE = 1 * MiB;
constexpr size_t WS_W = 5 * MiB;
constexpr size_t W_IN = 0, W_RET = 56 * MiB, W_GM = 60 * MiB, W_DS = 64 * MiB, W_OUT = 68 * MiB, W_13 = 76 * MiB, W_2 = 204 * MiB, W_UK = 268 * MiB, W_UV = 269 * MiB, W_RT = 270 * MiB  , W_END = 271 * MiB;
constexpr size_t WS_H = WS_W + W_END;
constexpr size_t WS_PROJ = WS_H + 64 * MiB;
constexpr size_t P_RQ = 0, P_RK = 32 * MiB, P_RV = 64 * MiB, P_RG = 96 * MiB, P_GU = 128 * MiB, P_GV = 160 * MiB, P_DQ = 192 * MiB, P_DC = 224 * MiB  ,
                 P_IQ = 240 * MiB  , P_IK = 256 * MiB  , P_IW = 258 * MiB  , P_GA = 260 * MiB, P_GB = 324 * MiB, P_GC = 388 * MiB, P_END = 452 * MiB;
constexpr size_t M_HPERM = 0, M_HID = 160 * MiB, M_YC = 200 * MiB;
constexpr size_t WS_KV = WS_PROJ + P_END;
constexpr size_t WS_R = WS_KV + 64 * MiB;
constexpr size_t WS_QABS = WS_R + 64 * MiB;
constexpr size_t WS_OLAT = WS_QABS + 64 * MiB;
constexpr size_t WS_RET = WS_OLAT + 64 * MiB;
constexpr size_t WS_GM = WS_RET + 32 * MiB, WS_DS = WS_GM + 32 * MiB;
constexpr size_t WS_SEL = WS_DS + 32 * MiB;
constexpr size_t WS_CKV = WS_SEL + 8 * MiB;
constexpr size_t WS_STATS = WS_CKV + 8 * MiB;
constexpr size_t WS_ROUTE = WS_STATS + 2 * MiB;
constexpr size_t WS_LIST = WS_ROUTE + 1 * MiB;
constexpr size_t WS_END = WS_LIST + 2 * MiB;
constexpr int CW_BAR = 4096, CW_CNT = 16384;
constexpr int CW_Q = 32768;

constexpr int LDS_BYTES = 147456, MISC_OFF = LDS_BYTES - 4096;

__device__ __forceinline__ unsigned f2bf(float f) { unsigned u = __builtin_bit_cast(unsigned, f); return (u + 0x7fffu + ((u >> 16) & 1u)) >> 16; }
__device__ __forceinline__ float bf2f(unsigned b) { return __builtin_bit_cast(float, (b & 0xffffu) << 16); }
typedef __bf16 bf16x2_t __attribute__((ext_vector_type(2)));
__device__ __forceinline__ unsigned cvt_pk_bf16(float lo, float hi) { const f32x2 v = {lo, hi}; return __builtin_bit_cast(unsigned, __builtin_convertvector(v, bf16x2_t)); }
__device__ __forceinline__ float shx(float v, int k, int lane) { return __builtin_bit_cast(float, __builtin_amdgcn_ds_bpermute((lane ^ k) << 2, __builtin_bit_cast(int, v))); }
__device__ __forceinline__ void swap32_(float& a, float& b) { asm volatile("v_nop\n\tv_nop\n\tv_permlane32_swap_b32 %0, %1\n\tv_nop" : "+v"(a), "+v"(b)); }
__device__ __forceinline__ void swap16_(float& a, float& b) { asm volatile("v_nop\n\tv_nop\n\tv_permlane16_swap_b32 %0, %1\n\tv_nop" : "+v"(a), "+v"(b)); }
__device__ __forceinline__ float quad_sum(float v) { float a = v, b = v; swap32_(a, b); v = a + b; a = v; b = v; swap16_(a, b); return a + b; }
__device__ __forceinline__ float quad_max(float v) { float a = v, b = v; swap32_(a, b); v = fmaxf(a, b); a = v; b = v; swap16_(a, b); return fmaxf(a, b); }
__device__ __forceinline__ int shi(int v, int src) { return __builtin_amdgcn_ds_bpermute(src << 2, v); }
typedef unsigned short u16x2 __attribute__((ext_vector_type(2)));
__device__ __forceinline__ unsigned pk_below(unsigned x, unsigned cm1, unsigned cnt) {
    u16x2 r = __builtin_elementwise_sub_sat(__builtin_bit_cast(u16x2, x), __builtin_bit_cast(u16x2, cm1)); unsigned ru = __builtin_bit_cast(unsigned, r); asm volatile("" : "+v"(ru));
    r = __builtin_elementwise_sub_sat((u16x2){1, 1}, __builtin_bit_cast(u16x2, ru)); ru = __builtin_bit_cast(unsigned, r); asm volatile("" : "+v"(ru));
    return __builtin_bit_cast(unsigned, (u16x2)(__builtin_bit_cast(u16x2, cnt) + __builtin_bit_cast(u16x2, ru)));
}
__device__ __forceinline__ int wave_total_dpp(int x) {
    x += __builtin_amdgcn_update_dpp(0, x, 0x111, 0xf, 0xf, false);
    x += __builtin_amdgcn_update_dpp(0, x, 0x112, 0xf, 0xf, false);
    x += __builtin_amdgcn_update_dpp(0, x, 0x114, 0xf, 0xf, false);
    x += __builtin_amdgcn_update_dpp(0, x, 0x118, 0xf, 0xf, false);
    x += __builtin_amdgcn_update_dpp(0, x, 0x142, 0xa, 0xf, false);
    x += __builtin_amdgcn_update_dpp(0, x, 0x143, 0xc, 0xf, false);
    return __builtin_amdgcn_readlane(x, 63);
}
__device__ __forceinline__ float wave_sum(float v, int lane) {
#pragma unroll
    for (int o = 1; o < 64; o <<= 1) v += shx(v, o, lane);
    return v;
}
__device__ __forceinline__ float wave_max(float v, int lane) {
#pragma unroll
    for (int o = 1; o < 64; o <<= 1) v = fmaxf(v, shx(v, o, lane));
    return v;
}
__device__ __forceinline__ float sigmoidf_(float x) { return __builtin_amdgcn_rcpf(1.0f + __builtin_amdgcn_exp2f(x * -1.44269504089f)); }
__device__ __forceinline__ float siluf_(float x) { return x * sigmoidf_(x); }
__device__ __forceinline__ f32x2 gelu_pk(f32x2 v) {
    const f32x2 av = __builtin_elementwise_abs(v), d = av * 0.2316418882f + 1.0f;
    f32x2 t; t.x = __builtin_amdgcn_rcpf(d.x); t.y = __builtin_amdgcn_rcpf(d.y);
    f32x2 q = t * 0.5307027145f + (-0.7265760135f); q = q * t + 0.7107068705f; q = q * t + (-0.142248368f); q = q * t + 0.127414796f; q = q * t;
    const f32x2 s = (v * v) * (-0.72134752044f);
    f32x2 e; e.x = __builtin_amdgcn_exp2f(s.x); e.y = __builtin_amdgcn_exp2f(s.y);
    const f32x2 m = v * (q * e), r = v - m;
    f32x2 o; o.x = v.x < 0.f ? m.x : r.x; o.y = v.y < 0.f ? m.y : r.y; return o;
}
template <int ACT> __device__ __forceinline__ f32x4 act4(f32x4 v) {
    if (ACT == 1) { f32x2 a = gelu_pk((f32x2){v[0], v[1]}), b = gelu_pk((f32x2){v[2], v[3]}); return (f32x4){a.x, a.y, b.x, b.y}; }
    if (ACT == 2) return (f32x4){siluf_(v[0]), siluf_(v[1]), siluf_(v[2]), siluf_(v[3])};
    if (ACT == 3) return (f32x4){sigmoidf_(v[0]), sigmoidf_(v[1]), sigmoidf_(v[2]), sigmoidf_(v[3])};
    return v;
}
__device__ __forceinline__ u32x4 pack8(f32x4 a, f32x4 b) { u32x4 w; w.x = cvt_pk_bf16(a[0], a[1]); w.y = cvt_pk_bf16(a[2], a[3]); w.z = cvt_pk_bf16(b[0], b[1]); w.w = cvt_pk_bf16(b[2], b[3]); return w; }
__device__ __forceinline__ void unpack8(u32x4 w, float (&f)[8]) {
    f[0] = bf2f(w.x); f[1] = bf2f(w.x >> 16); f[2] = bf2f(w.y); f[3] = bf2f(w.y >> 16); f[4] = bf2f(w.z); f[5] = bf2f(w.z >> 16); f[6] = bf2f(w.w); f[7] = bf2f(w.w >> 16);
}

#define XB_TMO      128
#define XB_XCNT(j)  (256  + 64 * (j))
#define XB_XSUB(j)  (1280 + 64 * (j))
#define XB_XGEN(j)  (2304 + 64 * (j))
#define XB_TOP      3328
#define XB_TOPGEN   3392
#define XCD_BAR_WORDS 3456
#define XB_SPIN_CAP (1u << 20)
__device__ __forceinline__ unsigned xb_ld(unsigned* p)              { return __hip_atomic_load(p, __ATOMIC_RELAXED, __HIP_MEMORY_SCOPE_AGENT); }
__device__ __forceinline__ unsigned xb_add(unsigned* p, unsigned v) { return __hip_atomic_fetch_add(p, v, __ATOMIC_RELAXED, __HIP_MEMORY_SCOPE_AGENT); }
__device__ __forceinline__ unsigned xb_xcc_id() { return (unsigned)__builtin_amdgcn_s_getreg((3 << 11) | 20) & 0xFu; }
#define XB_SPIN(cond, bar) do { unsigned _sp = 0; while (cond) { __builtin_amdgcn_s_sleep(1); \
    if ((++_sp & 255u) == 0u) { if (xb_ld(&(bar)[XB_TMO])) break; if (_sp > XB_SPIN_CAP) { atomicAdd(&(bar)[XB_TMO], 1u); break; } } } } while (0)
struct XcdBarrier { unsigned* bar; unsigned x; volatile LAS unsigned* st; };
__device__ __forceinline__ XcdBarrier xcd_barrier_post(unsigned* bar, volatile LAS unsigned* st) {
    XcdBarrier b; b.bar = bar; b.x = xb_xcc_id(); b.st = st;
    if (threadIdx.x == 0) (void)xb_add(&bar[XB_XCNT(b.x)], 1u);
    return b;
}
__device__ __forceinline__ void xcd_barrier_complete(unsigned* bar, unsigned x, unsigned& nloc, unsigned& nx) {
    const unsigned G = gridDim.x * gridDim.y * gridDim.z;
    unsigned sum, cnt, mine, sp = 0u;
    for (;;) {
        sum = 0u; cnt = 0u; mine = 0u;
#pragma unroll
        for (unsigned j = 0; j < 16; ++j) { const unsigned c = xb_ld(&bar[XB_XCNT(j)]); sum += c; cnt += (c > 0u) ? 1u : 0u; mine = (j == x) ? c : mine; }
        if (sum == G) break;
        __builtin_amdgcn_s_sleep(1);
        if ((++sp & 255u) == 0u) { if (xb_ld(&bar[XB_TMO])) break; if (sp > XB_SPIN_CAP) { atomicAdd(&bar[XB_TMO], 1u); break; } }
    }
    nloc = mine > 0u ? mine : 1u; nx = cnt > 0u ? cnt : 1u;
}
__device__ __forceinline__ void xcd_barrier(const XcdBarrier& b) {
    asm volatile("s_waitcnt vmcnt(0)" ::: "memory");
    __syncthreads();
    if (threadIdx.x == 0) {
        unsigned* bar = b.bar; asm volatile("" : "+s"(bar));
        __builtin_amdgcn_s_waitcnt(0);
        unsigned nloc = b.st[0], nx = b.st[1];
        if (nloc == 0u) { xcd_barrier_complete(bar, b.x, nloc, nx); b.st[0] = nloc; b.st[1] = nx; }
        const unsigned old = xb_add(&bar[XB_XSUB(b.x)], 1u);
        const unsigned gen = old / nloc;
        if (old + 1u == (gen + 1u) * nloc) {
            __builtin_amdgcn_fence(__ATOMIC_RELEASE, "agent");
            asm volatile("s_waitcnt vmcnt(0)" ::: "memory");
            const unsigned og = xb_add(&bar[XB_TOP], 1u);
            const unsigned tg = og / nx;
            if (og + 1u == (tg + 1u) * nx) xb_add(&bar[XB_TOPGEN], 1u);
            else XB_SPIN(xb_ld(&bar[XB_TOPGEN]) == tg, bar);
            __builtin_amdgcn_fence(__ATOMIC_ACQUIRE, "agent");
            xb_add(&bar[XB_XGEN(b.x)], 1u);
            asm volatile("s_waitcnt vmcnt(0)" ::: "memory");
        } else {
            XB_SPIN(xb_ld(&bar[XB_XGEN(b.x)]) == gen, bar);
            __builtin_amdgcn_fence(__ATOMIC_ACQUIRE, "agent");
            asm volatile("s_waitcnt vmcnt(0)" ::: "memory");
        }
    }
    __syncthreads();
}

namespace pg8 {
constexpr int BM = 256, BK = 64, HALF = 128, HTB = HALF * BK * 2, STAGE_BYTES = 8 * HTB, NXCD = 8, WGM = 8;
__host__ __device__ __forceinline__ int lds_byte(int r, int c) { const int st = (r >> 4) * 2 + (c >> 5), rr = r & 15, cc = c & 31, ob = rr * 64 + cc * 2; return st * 1024 + (ob ^ (((ob >> 9) & 1) << 5)); }
__host__ __device__ __forceinline__ void stage_rc(int b, int& R, int& C) { const int st = b / 1024, sb = b % 1024, swz = sb ^ (((sb >> 9) & 1) << 5); R = (st >> 1) * 16 + swz / 64; C = (st & 1) * 32 + (swz % 64) / 2; }
__host__ __device__ __forceinline__ int perm32(int rho) { const int n = rho >> 4, i = rho & 15; return 8 * (i >> 2) + 4 * n + (i & 3); }

struct Unit { int pm, pn; long aoff, boff; };
struct Gemm { const bf16_t* A; const bf16_t* Bt; int lda, ldb, K; };

struct OrderMN {
    int nM, nN, nwg, G, c, ashift; long astep, bstep, abytes;
    __device__ __forceinline__ int gather_row(const Unit&, int) const { return 0; }
    __device__ void init(int nM_, int nN_, int G_, int c_, long astep_, long bstep_, int ashift_ = 0, long abytes_ = 0) { nM = nM_; nN = nN_; nwg = nM * nN; G = G_; c = c_; astep = astep_; bstep = bstep_; ashift = ashift_; abytes = abytes_; }
    __device__ bool next(int i, Unit& u) const {
        const long L = (long)i * G + c; if (L >= nwg) return false;
        int wgid = (int)L; { const int q = nwg / NXCD, r = nwg % NXCD, xcd = wgid % NXCD, off = wgid / NXCD; wgid = (xcd < r ? xcd * (q + 1) : r * (q + 1) + (xcd - r) * q) + off; }
        const int nig = WGM * nN, gid = wgid / nig, fm = gid * WGM, gsz = (nM - fm) < WGM ? (nM - fm) : WGM;
        u.pm = fm + ((wgid % nig) % gsz); u.pn = (wgid % nig) / gsz;
        u.aoff = (long)u.pm * astep + (long)(u.pn >> ashift) * abytes; u.boff = (long)u.pn * bstep; return true;
    }
};
struct OrderMoE {
    const volatile LAS int* te; int Mt, nN, G, c; long astep, bstep, estep; const int* list;
    __device__ __forceinline__ int gather_row(const Unit& u, int r) const { const int e = te[u.pm], rb = te[160 + u.pm] + r; return rb < te[320 + u.pm] ? list[(size_t)e * T + rb] : 0; }
    __device__ bool next(int i, Unit& u) const {
        const long L = (long)i * G + c; if (L >= (long)Mt * nN) return false;
        u.pm = (int)(L / nN); u.pn = (int)(L % nN);
        u.aoff = (long)u.pm * astep; u.boff = (long)te[u.pm] * estep + (long)u.pn * bstep; return true;
    }
};

template <class Epi, class Sched, bool GATH = false, bool KEEPACC = false, bool ALIGN_EPI = true, bool SP2 = true>
__device__ __forceinline__ void gemm_phase(LAS unsigned char* lds, const Gemm g, const Sched& S, const Epi& E) {
    int tid_ = threadIdx.x; asm volatile("" : "+v"(tid_));
    const GAS bf16_t* gA = (const GAS bf16_t*)g.A; const GAS bf16_t* gB = (const GAS bf16_t*)g.Bt; asm volatile("" : "+s"(gA), "+s"(gB));
    const int tid = tid_, wid = __builtin_amdgcn_readfirstlane(tid >> 6), lane = tid & 63, wr = wid >> 2, wc = wid & 3, fr = lane & 15, fq = lane >> 4;
    const int K = g.K, nt = K / BK;
    unsigned voffA[2], voffB[2];
#pragma unroll
    for (int i = 0; i < 2; ++i) { int R, C; stage_rc(tid * 16 + i * 8192, R, C); const int Rb = Epi::PERM ? ((R & ~31) + perm32(R & 31)) : R;
        voffA[i] = (unsigned)(R * g.lda + C) * 2u; voffB[i] = (unsigned)(Rb * g.ldb + C) * 2u; }
    const size_t kstep = (size_t)(BK * 2);
    const size_t hstepA = GATH ? (size_t)0 : (size_t)HALF * g.lda * 2, hstepB = (size_t)HALF * g.ldb * 2;
    unsigned gAc[2][2], gAn[2][2]; int gR[2], gC[2];
#pragma unroll
    for (int i = 0; i < 2; ++i) { stage_rc(tid * 16 + i * 8192, gR[i], gC[i]); gAc[0][i] = gAc[1][i] = gAn[0][i] = gAn[1][i] = 0u; }
#define PG8_GLOAD(dst, un) do { _Pragma("unroll") for (int h_ = 0; h_ < 2; ++h_) _Pragma("unroll") for (int i_ = 0; i_ < 2; ++i_) \
        dst[h_][i_] = (unsigned)S.gather_row(un, h_ * HALF + gR[i_]) * (unsigned)(g.lda * 2) + (unsigned)(gC[i_] * 2); } while (0)
#define PG8_STAGE_A(bufoff, kptr, h, nx) do { if (GATH) { unsigned vo_[2]; vo_[0] = (nx) ? gAn[h][0] : gAc[h][0]; vo_[1] = (nx) ? gAn[h][1] : gAc[h][1]; PG8_STAGE(bufoff, kptr, vo_); } \
        else PG8_STAGE(bufoff, (kptr) + (h) * hstepA, voffA); } while (0)
    const unsigned ldsw = (unsigned)wid * 1024u;
    const int aoff = lds_byte(wr * 64 + fr, fq * 8), boff = lds_byte(wc * 32 + fr, fq * 8);
#define PG8_SA(b, h) (((b) * 2 + (h)) * HTB)
#define PG8_SB(b, h) ((4 + (b) * 2 + (h)) * HTB)
#define PG8_STAGE(bufoff, gbase, voff) do { _Pragma("unroll") for (int _i = 0; _i < 2; ++_i) \
        __builtin_amdgcn_global_load_lds((const GAS unsigned*)((gbase) + (voff)[_i]), (LAS unsigned*)(lds + (bufoff) + ldsw + _i * 8192), 16, 0, 0); } while (0)
#define PG8_LDA(dst, b, h) do { _Pragma("unroll") for (int m = 0; m < 4; ++m) _Pragma("unroll") for (int k = 0; k < 2; ++k) dst[m][k] = *(const LAS bf16x8*)(lds + PG8_SA(b, h) + aoff + m * 2048 + k * 1024); } while (0)
#define PG8_LDB(dst, b, h) do { _Pragma("unroll") for (int n = 0; n < 2; ++n) _Pragma("unroll") for (int k = 0; k < 2; ++k) dst[n][k] = *(const LAS bf16x8*)(lds + PG8_SB(b, h) + boff + n * 2048 + k * 1024); } while (0)
#define PG8_MMA(ai, bj, At, Bt) do { __builtin_amdgcn_s_setprio(1); _Pragma("unroll") for (int m = 0; m < 4; ++m) _Pragma("unroll") for (int n = 0; n < 2; ++n) _Pragma("unroll") for (int k = 0; k < 2; ++k) \
        acc[ai][bj][m][n] = __builtin_amdgcn_mfma_f32_16x16x32_bf16(Bt[n][k], At[m][k], acc[ai][bj][m][n], 0, 0, 0); __builtin_amdgcn_s_setprio(0); } while (0)
#define PG8_WAIT_V(n) asm volatile("s_waitcnt vmcnt(" #n ")" ::: "memory")
#define PG8_WAIT_L(n) asm volatile("s_waitcnt lgkmcnt(" #n ")" ::: "memory")
#define PG8_BAR __builtin_amdgcn_s_barrier()
#define PG8_SCHED __builtin_amdgcn_sched_barrier(0)
    Unit cur, nxt; int ui = 0;
    if (!S.next(0, cur)) return;
    f32x4 acc[2][2][4][2];
#pragma unroll
    for (int a = 0; a < 2; ++a)
#pragma unroll
        for (int b = 0; b < 2; ++b)
#pragma unroll
            for (int m = 0; m < 4; ++m)
#pragma unroll
                for (int n = 0; n < 2; ++n) acc[a][b][m][n] = (f32x4){0.f, 0.f, 0.f, 0.f};
    bf16x8 At[4][2], B0[2][2], B1[2][2];
    const GAS char* cA = (const GAS char*)gA + (GATH ? 0L : cur.aoff); const GAS char* cB = (const GAS char*)gB + cur.boff;
    if (GATH) PG8_GLOAD(gAc, cur);
    if constexpr (SP2) {
        PG8_STAGE(PG8_SB(0, 0), cB, voffB); PG8_STAGE(PG8_SB(0, 1), cB + hstepB, voffB); PG8_STAGE_A(PG8_SA(0, 0), cA, 0, false); PG8_STAGE_A(PG8_SA(0, 1), cA, 1, false);
        if (wr == 1) PG8_BAR;
        PG8_WAIT_V(2); PG8_BAR;
        PG8_STAGE(PG8_SB(1, 0), cB + kstep, voffB); PG8_STAGE_A(PG8_SA(1, 0), cA + kstep, 0, false); PG8_STAGE(PG8_SB(1, 1), cB + hstepB + kstep, voffB);
        PG8_WAIT_V(6); PG8_BAR;
    } else {
    PG8_STAGE(PG8_SB(0, 0), cB, voffB); PG8_STAGE_A(PG8_SA(0, 0), cA, 0, false); PG8_STAGE(PG8_SB(0, 1), cB + hstepB, voffB); PG8_STAGE_A(PG8_SA(0, 1), cA, 1, false);
    if (wr == 1) PG8_BAR;
    PG8_WAIT_V(4); PG8_BAR;
    PG8_STAGE(PG8_SB(1, 0), cB + kstep, voffB); PG8_STAGE_A(PG8_SA(1, 0), cA + kstep, 0, false); PG8_STAGE(PG8_SB(1, 1), cB + hstepB + kstep, voffB);
    PG8_WAIT_V(6); PG8_BAR;
    }
    for (;;) {
        const bool has_next = S.next(ui + 1, nxt);
        const GAS char* nA = (has_next && !GATH) ? (const GAS char*)gA + nxt.aoff : cA; const GAS char* nB = has_next ? (const GAS char*)gB + nxt.boff : cB;
        if (GATH) { if (has_next) PG8_GLOAD(gAn, nxt); else { gAn[0][0] = gAc[0][0]; gAn[0][1] = gAc[0][1]; gAn[1][0] = gAc[1][0]; gAn[1][1] = gAc[1][1]; } }
        for (int t = 0; t < nt; t += 2) {
            const bool last = (t == nt - 2);
            const GAS char* a1 = cA + (size_t)(t + 1) * kstep;
            const GAS char* a2 = last ? nA : cA + (size_t)(t + 2) * kstep; const GAS char* b2 = last ? nB : cB + (size_t)(t + 2) * kstep;
            const GAS char* a3 = a2 + kstep; const GAS char* b3 = b2 + kstep;
            if constexpr (SP2) {
            PG8_LDB(B0, 0, 0); PG8_LDB(B1, 0, 1); PG8_SCHED; PG8_LDA(At, 0, 0); PG8_STAGE_A(PG8_SA(1, 1), a1, 1, false);
            PG8_WAIT_V(8); PG8_WAIT_L(0); PG8_BAR; PG8_MMA(0, 0, At, B0); PG8_MMA(0, 1, At, B1); PG8_BAR; PG8_SCHED;
            PG8_LDA(At, 0, 1); PG8_STAGE(PG8_SB(0, 0), b2, voffB); PG8_STAGE(PG8_SB(0, 1), b2 + hstepB, voffB); PG8_STAGE_A(PG8_SA(0, 0), a2, 0, last);
            PG8_WAIT_V(8); PG8_WAIT_L(0); PG8_BAR; PG8_MMA(1, 0, At, B0); PG8_MMA(1, 1, At, B1); PG8_BAR; PG8_SCHED;
            PG8_LDB(B0, 1, 0); PG8_LDB(B1, 1, 1); PG8_SCHED; PG8_LDA(At, 1, 0); PG8_STAGE_A(PG8_SA(0, 1), a2, 1, last);
            PG8_WAIT_V(8); PG8_WAIT_L(0); PG8_BAR; PG8_MMA(0, 0, At, B0); PG8_MMA(0, 1, At, B1); PG8_BAR; PG8_SCHED;
            PG8_LDA(At, 1, 1); PG8_STAGE(PG8_SB(1, 0), b3, voffB); PG8_STAGE(PG8_SB(1, 1), b3 + hstepB, voffB); PG8_STAGE_A(PG8_SA(1, 0), a3, 0, last);
            PG8_WAIT_V(8); PG8_WAIT_L(0); PG8_BAR; PG8_MMA(1, 0, At, B0); PG8_MMA(1, 1, At, B1); PG8_BAR; PG8_SCHED;
            } else {
            PG8_LDB(B0, 0, 0); PG8_SCHED; PG8_LDA(At, 0, 0); PG8_STAGE_A(PG8_SA(1, 1), a1, 1, false);
            PG8_WAIT_L(8); PG8_BAR; PG8_WAIT_L(0); PG8_MMA(0, 0, At, B0); PG8_BAR; PG8_SCHED;
            PG8_LDB(B1, 0, 1); PG8_STAGE(PG8_SB(0, 0), b2, voffB);
            PG8_BAR; PG8_WAIT_L(0); PG8_MMA(0, 1, At, B1); PG8_BAR;
            PG8_LDA(At, 0, 1); PG8_STAGE_A(PG8_SA(0, 0), a2, 0, last);
            PG8_BAR; PG8_WAIT_L(0); PG8_MMA(1, 0, At, B0); PG8_BAR; PG8_SCHED;
            PG8_STAGE(PG8_SB(0, 1), b2 + hstepB, voffB);
            PG8_WAIT_V(6); PG8_BAR; PG8_MMA(1, 1, At, B1); PG8_BAR;
            PG8_LDB(B0, 1, 0); PG8_SCHED; PG8_LDA(At, 1, 0); PG8_STAGE_A(PG8_SA(0, 1), a2, 1, last);
            PG8_WAIT_L(8); PG8_BAR; PG8_WAIT_L(0); PG8_MMA(0, 0, At, B0); PG8_BAR; PG8_SCHED;
            PG8_LDB(B1, 1, 1); PG8_STAGE(PG8_SB(1, 0), b3, voffB);
            PG8_BAR; PG8_WAIT_L(0); PG8_MMA(0, 1, At, B1); PG8_BAR;
            PG8_LDA(At, 1, 1); PG8_STAGE_A(PG8_SA(1, 0), a3, 0, last);
            PG8_BAR; PG8_WAIT_L(0); PG8_MMA(1, 0, At, B0); PG8_BAR; PG8_SCHED;
            PG8_STAGE(PG8_SB(1, 1), b3 + hstepB, voffB);
            PG8_WAIT_V(6); PG8_BAR; PG8_MMA(1, 1, At, B1); PG8_BAR;
            }
        }
        if constexpr (ALIGN_EPI) { if (wr == 0) PG8_BAR; }
        bool zero_acc = true;
        if constexpr (KEEPACC) zero_acc = E.run(acc, cur, wr, wc, fr, fq);
        else E(acc, cur, wr, wc, fr, fq);
        if (!has_next) break;
        if (zero_acc)
#pragma unroll
        for (int a = 0; a < 2; ++a)
#pragma unroll
            for (int b = 0; b < 2; ++b)
#pragma unroll
                for (int m = 0; m < 4; ++m)
#pragma unroll
                    for (int n = 0; n < 2; ++n) acc[a][b][m][n] = (f32x4){0.f, 0.f, 0.f, 0.f};
        cur = nxt; cA = nA; cB = nB; ++ui;
        if (GATH) { gAc[0][0] = gAn[0][0]; gAc[0][1] = gAn[0][1]; gAc[1][0] = gAn[1][0]; gAc[1][1] = gAn[1][1]; }
        if constexpr (ALIGN_EPI) { if (wr == 1) PG8_BAR; }
    }
    PG8_WAIT_V(0);
    if constexpr (!ALIGN_EPI) { if (wr == 0) PG8_BAR; }
    PG8_BAR;
#undef PG8_SA
#undef PG8_SB
#undef PG8_STAGE
#undef PG8_STAGE_A
#undef PG8_GLOAD
#undef PG8_LDA
#undef PG8_LDB
#undef PG8_MMA
#undef PG8_WAIT_V
#undef PG8_WAIT_L
#undef PG8_BAR
#undef PG8_SCHED
}

typedef const f32x4 (&AccT)[2][2][4][2];
template <int ACT> __device__ __forceinline__ void store_tile_bf16(AccT acc, bf16_t* O, int ld, int row0, int colb, float scale) {
#pragma unroll
    for (int ai = 0; ai < 2; ++ai)
#pragma unroll
        for (int m = 0; m < 4; ++m) { bf16_t* rowp = O + (size_t)(row0 + ai * HALF + m * 16) * ld + colb;
#pragma unroll
            for (int bj = 0; bj < 2; ++bj) { const f32x4 v0 = act4<ACT>(acc[ai][bj][m][0] * scale), v1 = act4<ACT>(acc[ai][bj][m][1] * scale);
                *(u32x4*)(rowp + bj * HALF) = pack8(v0, v1); }
            asm volatile("" ::: "memory"); }
}
template <int ACT> struct EpiStore {
    static constexpr bool PERM = true;
    bf16_t* O; int ld; float scale;
    __device__ __forceinline__ void operator()(AccT acc, const Unit& u, int wr, int wc, int fr, int fq) const {
        store_tile_bf16<ACT>(acc, O, ld, u.pm * BM + wr * 64 + fr, u.pn * BM + wc * 32 + 8 * fq, scale);
    }
};
struct EpiInProj {
    static constexpr bool PERM = true;
    unsigned char* ws;
    __device__ __forceinline__ void operator()(AccT acc, const Unit& u, int wr, int wc, int fr, int fq) const {
        const int pn = u.pn, row0 = u.pm * BM + wr * 64 + fr, cw = wc * 32 + 8 * fq;
        unsigned char* pj = ws + WS_PROJ;
        bf16_t *rq = (bf16_t*)(pj + P_RQ), *rk = (bf16_t*)(pj + P_RK), *rv = (bf16_t*)(pj + P_RV), *rg = (bf16_t*)(pj + P_RG), *gu = (bf16_t*)(pj + P_GU), *gv = (bf16_t*)(pj + P_GV), *dq = (bf16_t*)(pj + P_DQ),
               *iq = (bf16_t*)(pj + P_IQ), *ik = (bf16_t*)(pj + P_IK), *ga = (bf16_t*)(pj + P_GA), *gb = (bf16_t*)(pj + P_GB), *gc = (bf16_t*)(pj + P_GC);
        float *dcraw = (float*)(pj + P_DC), *iw = (float*)(pj + P_IW), *gvstats = (float*)(ws + WS_STATS); const float* rope = (const float*)(ws + WS_ROPE);
        if (pn < 8) {
            const bool isk = pn >= 4; bf16_t* dst = (isk ? rk : rq) + (pn & 3) * 256 + cw; const float sc = isk ? 0.0625f : 1.0f;
#pragma unroll
            for (int ai = 0; ai < 2; ++ai) { f32x4 csq[4][4];
#pragma unroll
                for (int m = 0; m < 4; ++m) { const int pos = (row0 + ai * HALF + m * 16) & (SEQ - 1); const f32x4* cs = (const f32x4*)(rope + ((size_t)pos * 128 + cw) * 2);
#pragma unroll
                    for (int q4 = 0; q4 < 4; ++q4) csq[m][q4] = cs[q4]; }
                asm volatile("" ::: "memory");
#pragma unroll
                for (int m = 0; m < 4; ++m) { const int row = row0 + ai * HALF + m * 16;
                    f32x4 o1[2], o2[2];
#pragma unroll
                    for (int n = 0; n < 2; ++n) { const f32x4 c01 = csq[m][2 * n], c23 = csq[m][2 * n + 1]; const f32x4 x1 = acc[ai][0][m][n], x2 = acc[ai][1][m][n];
                        const float co[4] = {c01[0], c01[2], c23[0], c23[2]}, si[4] = {c01[1], c01[3], c23[1], c23[3]};
#pragma unroll
                        for (int j = 0; j < 4; ++j) { o1[n][j] = (x1[j] * co[j] - x2[j] * si[j]) * sc; o2[n][j] = (x1[j] * si[j] + x2[j] * co[j]) * sc; } }
                    bf16_t* rp = dst + (size_t)row * 1024;
                    *(u32x4*)rp = pack8(o1[0], o1[1]); *(u32x4*)(rp + 128) = pack8(o2[0], o2[1]); }
                asm volatile("" ::: "memory"); }
        } else if (pn < 12) { store_tile_bf16<0>(acc, rv, 1024, row0, (pn - 8) * 256 + cw, 1.f);
        } else if (pn < 16) { store_tile_bf16<2>(acc, rg, 1024, row0, (pn - 12) * 256 + cw, 1.f);
        } else if (pn < 20) { store_tile_bf16<1>(acc, gu, 1024, row0, (pn - 16) * 256 + cw, 1.f);
        } else if (pn < 24) {
            const int t4 = pn - 20; bf16_t* dst = gv + t4 * 256 + cw;
#pragma unroll
            for (int ai = 0; ai < 2; ++ai)
#pragma unroll
                for (int m = 0; m < 4; ++m) { const int row = row0 + ai * HALF + m * 16; float s = 0.f, q = 0.f;
#pragma unroll
                    for (int bj = 0; bj < 2; ++bj) { const f32x4 v0 = act4<1>(acc[ai][bj][m][0]), v1 = act4<1>(acc[ai][bj][m][1]);
                        *(u32x4*)(dst + (size_t)row * 1024 + bj * HALF) = pack8(v0, v1);
#pragma unroll
                        for (int j = 0; j < 4; ++j) { s += v0[j] + v1[j]; q += v0[j] * v0[j] + v1[j] * v1[j]; } }
                    s = quad_sum(s); q = quad_sum(q);
                    if (fq == 0) *(f32x2*)(gvstats + ((size_t)row * 16 + t4 * 4 + wc) * 2) = (f32x2){s, q}; asm volatile("" ::: "memory"); }
        } else if (pn < 28) { store_tile_bf16<0>(acc, dq, 1024, row0, (pn - 24) * 256 + cw, 1.f);
        } else if (pn == 28) {
#pragma unroll
            for (int ai = 0; ai < 2; ++ai)
#pragma unroll
                for (int m = 0; m < 4; ++m) { float* rp = dcraw + (size_t)(row0 + ai * HALF + m * 16) * 256 + cw;
#pragma unroll
                    for (int bj = 0; bj < 2; ++bj) { *(f32x4*)(rp + bj * HALF) = acc[ai][bj][m][0]; *(f32x4*)(rp + bj * HALF + 4) = acc[ai][bj][m][1]; } }
        } else if (pn < 31) { store_tile_bf16<0>(acc, iq, 512, row0, (pn - 29) * 256 + cw, 1.f);
        } else if (pn == 31) {
#pragma unroll
            for (int ai = 0; ai < 2; ++ai)
#pragma unroll
                for (int m = 0; m < 4; ++m) { const int row = row0 + ai * HALF + m * 16;
                    if (wc < 2) *(u32x4*)(ik + (size_t)row * 64 + cw) = pack8(acc[ai][0][m][0], acc[ai][0][m][1]);
                    if (wc == 2 && fq == 0) { *(f32x4*)(iw + (size_t)row * 8) = acc[ai][0][m][0] * 0.35355339059f; *(f32x4*)(iw + (size_t)row * 8 + 4) = acc[ai][0][m][1] * 0.35355339059f; } }
        } else { const int gi = (pn - 32) >> 3; bf16_t* dst = gi == 0 ? ga : (gi == 1 ? gb : gc);
            store_tile_bf16<3>(acc, dst, 2048, row0, ((pn - 32) & 7) * 256 + cw, 1.f); }
    }
};
typedef f32x4 (&AccM)[2][2][4][2];
struct EpiBranch {
    static constexpr bool PERM = true;
    const bf16_t* gate0; bf16_t* merged;
    __device__ __forceinline__ bool run(AccM acc, const Unit& u, int wr, int wc, int fr, int fq) const {
        const int br = u.pn >> 8; const bf16_t* gate = gate0 + (size_t)br * (32u << 20); const bf16_t* gnx = gate + (32u << 20);
        const int row0 = u.pm * BM + wr * 64 + fr, colb = (u.pn & 255) * BM + wc * 32 + 8 * fq;
#pragma unroll
        for (int ai = 0; ai < 2; ++ai) {
            u32x4 gq[4][2], nq[4][2];
#pragma unroll
            for (int m = 0; m < 4; ++m)
#pragma unroll
                for (int bj = 0; bj < 2; ++bj) { const size_t ro = (size_t)(row0 + ai * HALF + m * 16) * 2048 + colb + bj * HALF; gq[m][bj] = *(const u32x4*)(gate + ro); nq[m][bj] = *(const u32x4*)((br < 2 ? gnx : gate) + ro); }
            asm volatile("" ::: "memory");
#pragma unroll
            for (int m = 0; m < 4; ++m)
#pragma unroll
                for (int bj = 0; bj < 2; ++bj) { float g8[8], n8[8]; unpack8(gq[m][bj], g8); unpack8(nq[m][bj], n8);
                    f32x4 a0 = acc[ai][bj][m][0], a1 = acc[ai][bj][m][1];
                    if (br < 2) {
#pragma unroll
                        for (int j = 0; j < 4; ++j) { a0[j] *= g8[j] * __builtin_amdgcn_rcpf(fmaxf(n8[j], 1e-30f)); a1[j] *= g8[4 + j] * __builtin_amdgcn_rcpf(fmaxf(n8[4 + j], 1e-30f)); }
                        acc[ai][bj][m][0] = a0; acc[ai][bj][m][1] = a1;
                    } else {
#pragma unroll
                        for (int j = 0; j < 4; ++j) { a0[j] *= g8[j]; a1[j] *= g8[4 + j]; }
                        *(u32x4*)(merged + (size_t)(row0 + ai * HALF + m * 16) * 2048 + colb + bj * HALF) = pack8(a0, a1); } }
            asm volatile("" ::: "memory");
        }
        return br == 2;
    }
};
struct EpiResid {
    static constexpr bool PERM = false;
    const float* xsrc; float* xdst;
    __device__ __forceinline__ void operator()(AccT acc, const Unit& u, int wr, int wc, int fr, int fq) const {
        const int row0 = u.pm * BM + wr * 64 + fr, col0 = u.pn * BM + wc * 32 + 4 * fq;
#pragma unroll
        for (int ai = 0; ai < 2; ++ai)
#pragma unroll
            for (int mp = 0; mp < 2; ++mp) { f32x4 xv[2][2][2];
#pragma unroll
                for (int mm = 0; mm < 2; ++mm)
#pragma unroll
                    for (int bj = 0; bj < 2; ++bj)
#pragma unroll
                        for (int n = 0; n < 2; ++n) xv[mm][bj][n] = *(const f32x4*)(xsrc + (size_t)(row0 + ai * HALF + (2 * mp + mm) * 16) * DM + col0 + bj * HALF + n * 16);
                asm volatile("" ::: "memory");
#pragma unroll
                for (int mm = 0; mm < 2; ++mm)
#pragma unroll
                    for (int bj = 0; bj < 2; ++bj)
#pragma unroll
                        for (int n = 0; n < 2; ++n) *(f32x4*)(xdst + (size_t)(row0 + ai * HALF + (2 * mp + mm) * 16) * DM + col0 + bj * HALF + n * 16) = xv[mm][bj][n] + acc[ai][bj][2 * mp + mm][n];
                asm volatile("" ::: "memory"); }
    }
};
struct EpiMoeUp {
    static constexpr bool PERM = true;
    bf16_t* hid;
    __device__ __forceinline__ void operator()(AccT acc, const Unit& u, int wr, int wc, int fr, int fq) const {
        const int row0 = u.pm * BM + wr * 64 + fr, colb = u.pn * 128 + wc * 32 + 8 * fq;
#pragma unroll
        for (int ai = 0; ai < 2; ++ai)
#pragma unroll
            for (int m = 0; m < 4; ++m) { f32x4 r0, r1; const f32x4 a0 = acc[ai][0][m][0], a1 = acc[ai][0][m][1], b0 = acc[ai][1][m][0], b1 = acc[ai][1][m][1];
#pragma unroll
                for (int j = 0; j < 4; ++j) { r0[j] = siluf_(a0[j]) * b0[j]; r1[j] = siluf_(a1[j]) * b1[j]; }
                *(u32x4*)(hid + (size_t)(row0 + ai * HALF + m * 16) * FF + colb) = pack8(r0, r1); }
    }
};
struct OrderBranch {
    OrderMN base; long astride, bstride;
    __device__ __forceinline__ int gather_row(const Unit&, int) const { return 0; }
    __device__ bool next(int i, Unit& u) const { if (!base.next(i / 3, u)) return false; const int br = i % 3; u.aoff += br * astride; u.boff += br * bstride; u.pn |= br << 8; return true; }
};
struct OrderRouter {
    int G, c; long hlo_off;
    __device__ __forceinline__ int gather_row(const Unit&, int) const { return 0; }
    __device__ bool next(int i, Unit& u) const { const int L = i * G + c; if (L >= 256) return false; const int pm = L >> 2, which = (L >> 1) & 1, kh = L & 1;
        u.pm = pm; u.pn = which * 2 + kh; u.aoff = (long)pm * 256 * DM * 2 + (long)which * hlo_off + (long)kh * 1024 * 2; u.boff = (long)kh * 1024 * 2; return true; }
};
struct EpiRouter {
    static constexpr bool PERM = false;
    float* LOG;
    __device__ __forceinline__ void operator()(AccT acc, const Unit& u, int wr, int wc, int fr, int fq) const {
        float* base = LOG + ((size_t)u.pn * T + (size_t)u.pm * BM + wr * 64 + fr) * 128 + wc * 32 + 4 * fq;
#pragma unroll
        for (int ai = 0; ai < 2; ++ai)
#pragma unroll
            for (int m = 0; m < 4; ++m)
#pragma unroll
                for (int n = 0; n < 2; ++n) *(f32x4*)(base + (size_t)(ai * HALF + m * 16) * 128 + n * 16) = acc[ai][0][m][n];
    }
};
}

struct Args { const float* in[23]; float* out; unsigned char* ws; int ph_lo, ph_hi; };
enum { I_X = 0, I_NMIX, I_WIN, I_WRET, I_LNG, I_LNB, I_WS, I_BS, I_WGM, I_KVG, I_WUK, I_WUV, I_WDS, I_WOUT, I_NFFN, I_WGRP, I_BGRP, I_WEXP, I_BEXP, I_W1, I_W3, I_W2, I_FNG };
struct Ctx {
    LAS unsigned char* lds; volatile LAS int* misc; unsigned* ctl; GAS unsigned char* ws;
    int tid, lane, wave, G, bid, gw, NGW;
    const float* const* in; float* out;
};
#define WSP(T_, off) ((T_*)(C.ws + (off)))
__device__ __forceinline__ void refresh(Ctx& C) { int t = threadIdx.x; asm volatile("" : "+v"(t)); C.tid = t; C.lane = t & 63;
    GAS unsigned char* w = C.ws; asm volatile("" : "+s"(w)); C.ws = w; C.ctl = (unsigned*)w; }

__device__ __forceinline__ void ph_rope(const Ctx& C) {
    float* rope = WSP(float, WS_ROPE);
    const double r1 = 0.9305720409296989;
    for (int idx = C.bid * 512 + C.tid; idx < SEQ * 128; idx += C.G * 512) {
        const int pos = idx >> 7, i = idx & 127;
        double inv = 1.0, b = r1; int e = i;
        while (e) { if (e & 1) inv *= b; b *= b; e >>= 1; }
        const double ang = (double)pos * inv;
        const double n = __builtin_rint(ang * 0.15915494309189533577);
        const double x = ang - n * 6.283185307179586476925;
        const double x2 = x * x;
        double s = 0.0, c = 0.0;
#pragma unroll 1
        for (int k = 14; k >= 1; --k) { s = (s + 1.0) * (-x2 / (double)((2 * k) * (2 * k + 1))); c = (c + 1.0) * (-x2 / (double)((2 * k - 1) * (2 * k))); }
        s = (s + 1.0) * x; c = c + 1.0;
        *(f32x2*)(rope + (size_t)idx * 2) = (f32x2){(float)c, (float)s};
    }
}

struct WItem { const float* src; bf16_t* dst; int srcld, dstld, k0, n0, mode; long off; };
__device__ __forceinline__ WItem w_item(const Ctx& C, int l, int r) {
    unsigned char* wb = (unsigned char*)(C.ws + WS_W); WItem w; w.mode = 0; w.off = 0;
    constexpr int N_IN = 32 * 224, N_BR = 16 * 32, N_OUT = 32 * 32, N_13 = 32 * 32 * 16, N_2 = 32 * 8 * 32;
    if (r < N_IN) { const int kb = r / 224, nb = r % 224; w.src = C.in[I_WIN] + (size_t)l * DM * INW; w.srcld = INW; w.dst = (bf16_t*)(wb + W_IN); w.dstld = DM; w.k0 = kb * 64; w.n0 = nb * 64; w.mode = 1; return w; } r -= N_IN;
    if (r < 3 * N_BR) { const int ww = r / N_BR, q = r % N_BR, kb = q / 32, nb = q % 32; w.src = C.in[ww == 0 ? I_WRET : (ww == 1 ? I_WGM : I_WDS)] + (size_t)l * 1024 * DM; w.srcld = DM;
        w.dst = (bf16_t*)(wb + (ww == 0 ? W_RET : (ww == 1 ? W_GM : W_DS))); w.dstld = 1024; w.k0 = kb * 64; w.n0 = nb * 64; return w; } r -= 3 * N_BR;
    if (r < N_OUT) { const int kb = r / 32, nb = r % 32; w.src = C.in[I_WOUT] + (size_t)l * DM * DM; w.srcld = DM; w.dst = (bf16_t*)(wb + W_OUT); w.dstld = DM; w.k0 = kb * 64; w.n0 = nb * 64; return w; } r -= N_OUT;
    if (r < N_13) { const int e = r / 512, q = r % 512, kb = q / 16, nb = q % 16, row0 = nb * 64, j = row0 >> 8, sft = (row0 >> 7) & 1, fp = row0 & 127;
        w.src = C.in[sft ? I_W3 : I_W1] + ((size_t)l * NEXP + e) * DM * FF; w.srcld = FF; w.dst = (bf16_t*)(wb + W_13) + (size_t)e * 1024 * DM; w.dstld = DM; w.k0 = kb * 64; w.n0 = row0; w.off = (long)(128 * j + fp) - row0; return w; } r -= N_13;
    if (r < N_2) { const int e = r / 256, q = r % 256, kb = q / 32, nb = q % 32; w.src = C.in[I_W2] + ((size_t)l * NEXP + e) * FF * DM; w.srcld = DM; w.dst = (bf16_t*)(wb + W_2) + (size_t)e * DM * FF; w.dstld = FF; w.k0 = kb * 64; w.n0 = nb * 64; return w; } r -= N_2;
    { const int h = r / 8, q = r % 8, kb = q / 2, nb = q % 2;
      w.src = C.in[I_WUV] + ((size_t)l * 8 + h) * 256 * 128; w.srcld = 128; w.dst = (bf16_t*)(wb + W_UV) + (size_t)(h * 128) * 512 + (h & 1) * 256; w.dstld = 512; w.k0 = kb * 64; w.n0 = nb * 64; return w; }
}
__device__ __forceinline__ void w_load(const WItem& w, int lane, f32x4 (&R)[16]) {
    const int nq = lane & 15, kq = lane >> 4, n = w.n0 + 4 * nq;
    const long sc = (w.mode == 1) ? (n < GATE_SRC0 ? (long)n : (n < GATE_DST0 ? -1L : (long)(n - (GATE_DST0 - GATE_SRC0)))) : (long)n + w.off;
    const float* p = w.src + (size_t)(w.k0 + 2 * kq) * w.srcld + (sc >= 0 ? sc : 0);
#pragma unroll
    for (int i = 0; i < 8; ++i)
#pragma unroll
        for (int s2 = 0; s2 < 2; ++s2) { f32x4 v = __builtin_nontemporal_load((const f32x4*)(p + (size_t)(8 * i + s2) * w.srcld)); if (sc < 0) v = (f32x4){0.f, 0.f, 0.f, 0.f}; R[2 * i + s2] = v; }
}
__device__ __forceinline__ void w_store(const WItem& w, int lane, const f32x4 (&R)[16], LAS unsigned* scr) {
    const int nq = lane & 15, kq = lane >> 4;
#pragma unroll
    for (int i = 0; i < 8; ++i)
#pragma unroll
        for (int e = 0; e < 4; ++e) scr[(4 * nq + e) * 33 + 4 * i + kq] = cvt_pk_bf16(R[2 * i][e], R[2 * i + 1][e]);
    asm volatile("s_waitcnt lgkmcnt(0)" ::: "memory");
    const int c = lane & 7;
#pragma unroll
    for (int j = 0; j < 8; ++j) { const int n = (lane >> 3) + 8 * j; const LAS unsigned* sp = scr + n * 33 + 4 * c;
        u32x4 o; o.x = sp[0]; o.y = sp[1]; o.z = sp[2]; o.w = sp[3];
        *(u32x4*)(w.dst + (size_t)(w.n0 + n) * w.dstld + w.k0 + 8 * c) = o; }
    asm volatile("s_waitcnt lgkmcnt(0)" ::: "memory");
}
__device__ __forceinline__ void ph_weights(const Ctx& C, int l) {
    LAS unsigned* scr = (LAS unsigned*)(C.lds + C.wave * 16384);
    unsigned char* wb = (unsigned char*)(C.ws + WS_W);
    constexpr int NITEMS = 32 * 224 + 3 * 16 * 32 + 32 * 32 + 32 * 32 * 16 + 32 * 8 * 32 + 8 * 8;
    { int it = C.gw; f32x4 R[16], Rn[16]; WItem w, wn;
      if (it < NITEMS) { w = w_item(C, l, it); w_load(w, C.lane, R); }
#pragma unroll 1
      while (it < NITEMS) { const int itn = it + C.NGW;
          if (itn < NITEMS) { wn = w_item(C, l, itn); w_load(wn, C.lane, Rn); }
          w_store(w, C.lane, R, scr);
#pragma unroll
          for (int i = 0; i < 16; ++i) R[i] = Rn[i];
          w = wn; it = itn; } }
    bf16_t* uv = (bf16_t*)(wb + W_UV); bf16_t* uk = (bf16_t*)(wb + W_UK); const float* wuk = C.in[I_WUK] + (size_t)l * 8 * 256 * 128;
    for (int idx = C.bid * 512 + C.tid; idx < 1024 * 256 / 8; idx += C.G * 512) { const int row = idx >> 5, c8 = (idx & 31) * 8, h = row >> 7;
        *(u32x4*)(uv + (size_t)row * 512 + (1 - (h & 1)) * 256 + c8) = (u32x4){0u, 0u, 0u, 0u}; }
    for (int idx = C.bid * 512 + C.tid; idx < 2048 * 256 / 8; idx += C.G * 512) { const int row = idx >> 5, c8 = (idx & 31) * 8, h = row >> 8, half = c8 >> 7;
        u32x4 o = (u32x4){0u, 0u, 0u, 0u};
        if (half == (h & 1)) { const float* s = wuk + (size_t)row * 128 + (c8 & 127); const f32x4 a = *(const f32x4*)s, b = *(const f32x4*)(s + 4); o = pack8(a, b); }
        *(u32x4*)(uk + (size_t)row * 256 + c8) = o; }
    bf16_t* rt = (bf16_t*)(wb + W_RT); const float* wgr = C.in[I_WGRP] + (size_t)l * DM * 4; const float* wex = C.in[I_WEXP] + (size_t)l * 4 * DM * 8;
    for (int idx = C.bid * 512 + C.tid; idx < 256 * 256; idx += C.G * 512) { const int r = idx >> 8, k8 = (idx & 255) * 8, c = r & 63, part = r >> 6;
        u32x4 o = (u32x4){0u, 0u, 0u, 0u};
        if (part < 2 && c < 36) { float v[8];
#pragma unroll
            for (int j = 0; j < 8; ++j) { const float wv = (c < 4) ? wgr[(size_t)(k8 + j) * 4 + c] : wex[((size_t)((c - 4) >> 3) * DM + (k8 + j)) * 8 + ((c - 4) & 7)];
                const float hi = bf2f(f2bf(wv)); v[j] = part == 0 ? hi : (wv - hi); }
            o = pack8((f32x4){v[0], v[1], v[2], v[3]}, (f32x4){v[4], v[5], v[6], v[7]}); }
        *(u32x4*)(rt + (size_t)r * DM + k8) = o; }
}

__device__ __forceinline__ void ph_norm(const Ctx& C, const float* x, const float* g, bf16_t* H) {
    for (int row = C.gw; row < T; row += C.NGW) {
        const f32x4* xr = (const f32x4*)(x + (size_t)row * DM) + C.lane; f32x4 v[8]; float ss = 0.f;
#pragma unroll
        for (int j = 0; j < 8; ++j) { v[j] = xr[64 * j]; ss += v[j][0] * v[j][0] + v[j][1] * v[j][1] + v[j][2] * v[j][2] + v[j][3] * v[j][3]; }
        const float rstd = rsqrtf(wave_sum(ss, C.lane) * (1.f / DM) + EPS);
        u32x2* o = (u32x2*)(H + (size_t)row * DM) + C.lane;
#pragma unroll
        for (int j = 0; j < 8; ++j) { const f32x4 gg = ((const f32x4*)g)[64 * j + C.lane]; const f32x4 y = v[j] * rstd * gg; u32x2 w; w.x = cvt_pk_bf16(y[0], y[1]); w.y = cvt_pk_bf16(y[2], y[3]); o[64 * j] = w; }
    }
}
__device__ __forceinline__ void ph_ckv(const Ctx& C, const float* dcraw, const float* g, bf16_t* ckv) {
    for (int row = C.gw; row < T; row += C.NGW) {
        const f32x4 v = ((const f32x4*)(dcraw + (size_t)row * 256))[C.lane];
        const float ss = wave_sum(v[0] * v[0] + v[1] * v[1] + v[2] * v[2] + v[3] * v[3], C.lane);
        const float rstd = rsqrtf(ss * (1.f / 256.f) + EPS); const f32x4 y = v * rstd * ((const f32x4*)g)[C.lane];
        u32x2 w; w.x = cvt_pk_bf16(y[0], y[1]); w.y = cvt_pk_bf16(y[2], y[3]); ((u32x2*)(ckv + (size_t)row * 256))[C.lane] = w;
    }
}

typedef short v4i16_t __attribute__((ext_vector_type(4)));
__device__ __forceinline__ s16x4 tr_read(const LAS unsigned char* p) { return __builtin_bit_cast(s16x4, __builtin_amdgcn_ds_read_tr16_b64_v4i16((LAS v4i16_t*)p)); }
__device__ __forceinline__ bf16x8 tr_frag(const LAS unsigned char* X, int LDX, int rowA, int rowB, int n0, int lane) {
    const int q = (lane & 15) >> 2, p = lane & 3;
    const s16x4 lo = tr_read(X + (rowA + q) * LDX + (n0 + 4 * p) * 2), hi = tr_read(X + (rowB + q) * LDX + (n0 + 4 * p) * 2);
    return (bf16x8){lo[0], lo[1], lo[2], lo[3], hi[0], hi[1], hi[2], hi[3]};
}
constexpr int TLD = 544;
__device__ __forceinline__ bf16x8 as_bf16x8(u32x4 w) { return __builtin_bit_cast(bf16x8, w); }

__device__ __forceinline__ void ph_ret_kv(const Ctx& C) {
    const bf16_t* rk = WSP(bf16_t, WS_PROJ + P_RK); const bf16_t* rv = WSP(bf16_t, WS_PROJ + P_RV); bf16_t* KV = WSP(bf16_t, WS_KV);
    const LAS unsigned char* Vt = C.lds; const LAS unsigned char* Kt = C.lds + 128 * TLD;
    const int g = C.lane >> 4, fr = C.lane & 15, wr = C.wave >> 2, wc = C.wave & 3;
    for (int u = C.bid; u < 512; u += C.G) {
        const int n = u & 31, h = (u >> 5) & 3, b = u >> 7; const size_t row0 = (size_t)b * SEQ + n * 128;
        const float lg2 = log2f(1.0f - exp2f(-5.0f - (float)h));
        __syncthreads();
#pragma unroll
        for (int p = 0; p < 8; ++p) { const int idx = p * 512 + C.tid, row = idx >> 5, ch = idx & 31; const size_t go = (row0 + row) * 1024 + h * 256 + ch * 8;
            const u32x4 vv = *(const u32x4*)(rv + go); *(LAS u32x4*)(C.lds + row * TLD + ch * 16) = vv;
            float f[8]; unpack8(*(const u32x4*)(rk + go), f); const float z = exp2f(lg2 * (float)(127 - row));
            *(LAS u32x4*)(C.lds + 128 * TLD + row * TLD + ch * 16) = pack8((f32x4){f[0] * z, f[1] * z, f[2] * z, f[3] * z}, (f32x4){f[4] * z, f[5] * z, f[6] * z, f[7] * z}); }
        __syncthreads();
        f32x4 acc[8][4];
#pragma unroll
        for (int m = 0; m < 8; ++m)
#pragma unroll
            for (int nn = 0; nn < 4; ++nn) acc[m][nn] = (f32x4){0.f, 0.f, 0.f, 0.f};
#pragma unroll 1
        for (int ks = 0; ks < 4; ++ks) { bf16x8 Bv[4];
#pragma unroll
            for (int nn = 0; nn < 4; ++nn) Bv[nn] = tr_frag(Vt, TLD, 32 * ks + 8 * g, 32 * ks + 8 * g + 4, 64 * wc + 16 * nn, C.lane);
#pragma unroll
            for (int m = 0; m < 8; ++m) { const bf16x8 Ak = tr_frag(Kt, TLD, 32 * ks + 8 * g, 32 * ks + 8 * g + 4, 128 * wr + 16 * m, C.lane);
#pragma unroll
                for (int nn = 0; nn < 4; ++nn) acc[m][nn] = __builtin_amdgcn_mfma_f32_16x16x32_bf16(Ak, Bv[nn], acc[m][nn], 0, 0, 0); } }
        bf16_t* out = KV + (size_t)u * 65536;
#pragma unroll
        for (int m = 0; m < 8; ++m)
#pragma unroll
            for (int nn = 0; nn < 4; ++nn) { const int e = 64 * wc + 16 * nn + fr, d = 128 * wr + 16 * m + 4 * g; u32x2 w; w.x = cvt_pk_bf16(acc[m][nn][0], acc[m][nn][1]); w.y = cvt_pk_bf16(acc[m][nn][2], acc[m][nn][3]);
                *(u32x2*)(out + e * 256 + d) = w; }
    }
}
__device__ __forceinline__ void ph_ret_scan(const Ctx& C) {
    const bf16_t* KV = WSP(bf16_t, WS_KV); bf16_t* Rb = WSP(bf16_t, WS_R);
    for (int idx = C.bid * 512 + C.tid; idx < 16 * 8192; idx += C.G * 512) {
        const int bh = idx >> 13, off = (idx & 8191) * 8, h = bh & 3; const float gc = exp2f(128.0f * log2f(1.0f - exp2f(-5.0f - (float)h)));
        float R[8] = {0.f, 0.f, 0.f, 0.f, 0.f, 0.f, 0.f, 0.f};
#pragma unroll 4
        for (int n = 0; n < 32; ++n) { const size_t o = ((size_t)bh * 32 + n) * 65536 + off;
            *(u32x4*)(Rb + o) = pack8((f32x4){R[0], R[1], R[2], R[3]}, (f32x4){R[4], R[5], R[6], R[7]});
            float f[8]; unpack8(*(const u32x4*)(KV + o), f);
#pragma unroll
            for (int j = 0; j < 8; ++j) R[j] = R[j] * gc + f[j]; }
    }
}
__device__ __forceinline__ void ph_ret_out(const Ctx& C) {
    const bf16_t* rq = WSP(bf16_t, WS_PROJ + P_RQ); const bf16_t* rk = WSP(bf16_t, WS_PROJ + P_RK); const bf16_t* rv = WSP(bf16_t, WS_PROJ + P_RV); const bf16_t* rg = WSP(bf16_t, WS_PROJ + P_RG);
    const bf16_t* Rb = WSP(bf16_t, WS_R); bf16_t* ret = WSP(bf16_t, WS_RET);
    const LAS unsigned char* Vt = C.lds;
    const int w = C.wave;
    for (int u = C.bid; u < 512; u += C.G) {
        int tid_ = C.tid; asm volatile("" : "+v"(tid_));
        const int tid = tid_, lane = tid & 63, g = lane >> 4, fr = lane & 15;
        const int n = u & 31, h = (u >> 5) & 3, b = u >> 7; const size_t row0 = (size_t)b * SEQ + n * 128;
        const float lg2 = log2f(1.0f - exp2f(-5.0f - (float)h));
        constexpr int R_OFF = 128 * TLD, RLD = 272;
        u32x4 Vr[8], Rr[8];
#pragma unroll
        for (int p = 0; p < 8; ++p) { const int idx = p * 512 + tid, row = idx >> 5, ch = idx & 31; Vr[p] = *(const u32x4*)(rv + (row0 + row) * 1024 + h * 256 + ch * 8); }
        if (n > 0) {
#pragma unroll
            for (int p = 0; p < 8; ++p) { const int idx = p * 512 + tid, e = idx >> 4, c16 = idx & 15; Rr[p] = *(const u32x4*)(Rb + (size_t)u * 65536 + (size_t)e * 256 + c16 * 8); } }
        const int i = 16 * w + fr;
        bf16x8 Bq[8];
        { const bf16_t* qp = rq + (row0 + i) * 1024 + h * 256 + 8 * g;
#pragma unroll
          for (int ks = 0; ks < 8; ++ks) Bq[ks] = as_bf16x8(*(const u32x4*)(qp + 32 * ks)); }
        f32x4 acc[16];
#pragma unroll
        for (int nt = 0; nt < 16; ++nt) acc[nt] = (f32x4){0.f, 0.f, 0.f, 0.f};
        __syncthreads();
#pragma unroll
        for (int p = 0; p < 8; ++p) { const int idx = p * 512 + tid, row = idx >> 5, ch = idx & 31; *(LAS u32x4*)(C.lds + row * TLD + ch * 16) = Vr[p]; }
        if (n > 0) {
#pragma unroll
            for (int p = 0; p < 8; ++p) { const int idx = p * 512 + tid, e = idx >> 4, c16 = idx & 15; *(LAS u32x4*)(C.lds + R_OFF + e * RLD + c16 * 16) = Rr[p]; }
#pragma unroll
            for (int p = 0; p < 8; ++p) { const int idx = p * 512 + tid, e = idx >> 4, c16 = idx & 15; Rr[p] = *(const u32x4*)(Rb + (size_t)u * 65536 + (size_t)e * 256 + 128 + c16 * 8); }
#pragma unroll
            for (int dh = 0; dh < 2; ++dh) {
                if (dh) { __syncthreads();
#pragma unroll
                    for (int p = 0; p < 8; ++p) { const int idx = p * 512 + tid, e = idx >> 4, c16 = idx & 15; *(LAS u32x4*)(C.lds + R_OFF + e * RLD + c16 * 16) = Rr[p]; } }
                __syncthreads();
#pragma unroll
                for (int k4 = 0; k4 < 4; ++k4)
#pragma unroll
                    for (int nt = 0; nt < 16; ++nt) { const bf16x8 Ar = as_bf16x8(*(const LAS u32x4*)(C.lds + R_OFF + (16 * nt + fr) * RLD + (32 * k4 + 8 * g) * 2));
                        acc[nt] = __builtin_amdgcn_mfma_f32_16x16x32_bf16(Ar, Bq[4 * dh + k4], acc[nt], 0, 0, 0); }
            }
            const float xi = exp2f(lg2 * (float)(i + 1));
#pragma unroll
            for (int nt = 0; nt < 16; ++nt) acc[nt] = acc[nt] * xi;
        } else __syncthreads();
        f32x4 ST[8];
#pragma unroll
        for (int jt = 0; jt < 8; ++jt) { ST[jt] = (f32x4){0.f, 0.f, 0.f, 0.f};
            if (jt <= w) { const bf16_t* kp = rk + (row0 + 16 * jt + fr) * 1024 + h * 256 + 8 * g;
#pragma unroll
                for (int ks = 0; ks < 8; ++ks) { const bf16x8 Ak = as_bf16x8(*(const u32x4*)(kp + 32 * ks)); ST[jt] = __builtin_amdgcn_mfma_f32_16x16x32_bf16(Ak, Bq[ks], ST[jt], 0, 0, 0); }
#pragma unroll
                for (int r = 0; r < 4; ++r) { const int j = 16 * jt + 4 * g + r; ST[jt][r] = (i >= j) ? ST[jt][r] * exp2f(lg2 * (float)(i - j)) : 0.f; }
                asm volatile("" ::: "memory"); } }
#pragma unroll
        for (int t = 0; t < 4; ++t) if (2 * t <= w) {
            u32x4 sw; sw.x = cvt_pk_bf16(ST[2 * t][0], ST[2 * t][1]); sw.y = cvt_pk_bf16(ST[2 * t][2], ST[2 * t][3]); sw.z = cvt_pk_bf16(ST[2 * t + 1][0], ST[2 * t + 1][1]); sw.w = cvt_pk_bf16(ST[2 * t + 1][2], ST[2 * t + 1][3]);
            const bf16x8 Bs = as_bf16x8(sw);
#pragma unroll
            for (int nt = 0; nt < 16; ++nt) { const bf16x8 Av = tr_frag(Vt, TLD, 32 * t + 4 * g, 32 * t + 16 + 4 * g, 16 * nt, lane); acc[nt] = __builtin_amdgcn_mfma_f32_16x16x32_bf16(Av, Bs, acc[nt], 0, 0, 0); } }
        float ss = 0.f;
#pragma unroll
        for (int nt = 0; nt < 16; ++nt) ss += acc[nt][0] * acc[nt][0] + acc[nt][1] * acc[nt][1] + acc[nt][2] * acc[nt][2] + acc[nt][3] * acc[nt][3];
        ss = quad_sum(ss);
        const float rstd = rsqrtf(ss * (1.f / 256.f) + EPS);
        const size_t ob = (row0 + i) * 1024 + h * 256 + 4 * g;
#pragma unroll
        for (int nt = 0; nt < 16; ++nt) { const u32x2 gw = *(const u32x2*)(rg + ob + 16 * nt); u32x2 o;
            o.x = cvt_pk_bf16(acc[nt][0] * rstd * bf2f(gw.x), acc[nt][1] * rstd * bf2f(gw.x >> 16)); o.y = cvt_pk_bf16(acc[nt][2] * rstd * bf2f(gw.y), acc[nt][3] * rstd * bf2f(gw.y >> 16));
            *(u32x2*)(ret + ob + 16 * nt) = o; }
    }
}
__device__ __forceinline__ void ph_gmlp(const Ctx& C, int l) {
    const bf16_t* gu = WSP(bf16_t, WS_PROJ + P_GU); const bf16_t* gv = WSP(bf16_t, WS_PROJ + P_GV); const float* stats = WSP(float, WS_STATS); bf16_t* gm = WSP(bf16_t, WS_GM);
    const float* lng = C.in[I_LNG] + l * 1024; const float* lnb = C.in[I_LNB] + l * 1024; const float* Wsp = C.in[I_WS] + (size_t)l * 4 * 128 * 128; const float* bs = C.in[I_BS] + l * 4 * 128;
    constexpr int WLD = 272, W_OFF = 128 * TLD, ST_OFF = W_OFF + 128 * WLD;
    const LAS unsigned char* Lt = C.lds; LAS float* sst = (LAS float*)(C.lds + ST_OFF);
    const int g4 = C.lane >> 4, fr = C.lane & 15, w = C.wave;
    for (int u = C.bid; u < 512; u += C.G) {
        const int gg = u & 3, bn = u >> 2, t0 = bn * 128;
        __syncthreads();
        if (C.tid < 128) { const float* sp = stats + (size_t)(t0 + C.tid) * 32; float s = 0.f, q = 0.f;
#pragma unroll
            for (int k = 0; k < 16; ++k) { s += sp[2 * k]; q += sp[2 * k + 1]; }
            const float mean = s * (1.f / 1024.f), var = q * (1.f / 1024.f) - mean * mean; sst[2 * C.tid] = mean; sst[2 * C.tid + 1] = rsqrtf(var + EPS); }
#pragma unroll
        for (int p = 0; p < 4; ++p) { const int idx = p * 512 + C.tid, i = idx >> 4, j8 = (idx & 15) * 8; const float* wp = Wsp + ((size_t)gg * 128 + i) * 128 + j8;
            f32x4 a = *(const f32x4*)wp, b2 = *(const f32x4*)(wp + 4);
#pragma unroll
            for (int j = 0; j < 4; ++j) { if (j8 + j > i) a[j] = 0.f; if (j8 + 4 + j > i) b2[j] = 0.f; }
            *(LAS u32x4*)(C.lds + W_OFF + i * WLD + j8 * 2) = pack8(a, b2); }
        __syncthreads();
#pragma unroll
        for (int p = 0; p < 8; ++p) { const int idx = p * 512 + C.tid, row = idx >> 5, ch = idx & 31, cg = gg * 256 + ch * 8;
            float f[8]; unpack8(*(const u32x4*)(gv + (size_t)(t0 + row) * 1024 + cg), f); const float mean = sst[2 * row], rstd = sst[2 * row + 1];
            const f32x4 g0 = *(const f32x4*)(lng + cg), g1 = *(const f32x4*)(lng + cg + 4), b0 = *(const f32x4*)(lnb + cg), b1 = *(const f32x4*)(lnb + cg + 4);
            f32x4 y0, y1;
#pragma unroll
            for (int j = 0; j < 4; ++j) { y0[j] = (f[j] - mean) * rstd * g0[j] + b0[j]; y1[j] = (f[4 + j] - mean) * rstd * g1[j] + b1[j]; }
            *(LAS u32x4*)(C.lds + row * TLD + ch * 16) = pack8(y0, y1); }
        __syncthreads();
        f32x4 acc[16];
#pragma unroll
        for (int nt = 0; nt < 16; ++nt) acc[nt] = (f32x4){0.f, 0.f, 0.f, 0.f};
#pragma unroll
        for (int ks = 0; ks < 4; ++ks) if (2 * ks <= w) {
            const bf16x8 Bw = as_bf16x8(*(const LAS u32x4*)(C.lds + W_OFF + (16 * w + fr) * WLD + (32 * ks + 8 * g4) * 2));
#pragma unroll
            for (int nt = 0; nt < 16; ++nt) { const bf16x8 Av = tr_frag(Lt, TLD, 32 * ks + 8 * g4, 32 * ks + 8 * g4 + 4, 16 * nt, C.lane); acc[nt] = __builtin_amdgcn_mfma_f32_16x16x32_bf16(Av, Bw, acc[nt], 0, 0, 0); } }
        const int i = 16 * w + fr; const float bias = bs[gg * 128 + i]; const size_t ob = (size_t)(t0 + i) * 1024 + gg * 256 + 4 * g4;
#pragma unroll
        for (int nt = 0; nt < 16; ++nt) { const u32x2 uw = *(const u32x2*)(gu + ob + 16 * nt); u32x2 o;
            o.x = cvt_pk_bf16((acc[nt][0] + bias) * bf2f(uw.x), (acc[nt][1] + bias) * bf2f(uw.x >> 16)); o.y = cvt_pk_bf16((acc[nt][2] + bias) * bf2f(uw.y), (acc[nt][3] + bias) * bf2f(uw.y >> 16));
            *(u32x2*)(gm + ob + 16 * nt) = o; }
    }
}

__device__ __forceinline__ void ph_idx(const Ctx& C, int l) {
    const bf16_t* iq = WSP(bf16_t, WS_PROJ + P_IQ); const bf16_t* ik = WSP(bf16_t, WS_PROJ + P_IK); const float* iw = WSP(float, WS_PROJ + P_IW); unsigned short* sel = WSP(unsigned short, WS_SEL);
    LAS unsigned* sc = (LAS unsigned*)C.lds;
    const int lane = C.lane, n32 = lane & 31, hh = lane >> 5, w = C.wave;
    unsigned* qh = C.ctl + CW_Q + (l * 8 + 1) * 64;
    __syncthreads();
    if (C.tid == 0) C.misc[510] = (int)__hip_atomic_fetch_add(qh, 1u, __ATOMIC_RELAXED, __HIP_MEMORY_SCOPE_AGENT);
    __syncthreads();
    int un = C.misc[510];
    for (int u = un; u < T / 8; u = un) {
        const int b = u & 3, q0 = (SEQ / 8 - 1 - (u >> 2)) * 8, tq0 = b * SEQ + q0, nk = q0 + 8, nkt = (nk + 31) >> 5;
        __syncthreads();
        if (C.tid == 0) C.misc[510] = (int)__hip_atomic_fetch_add(qh, 1u, __ATOMIC_RELAXED, __HIP_MEMORY_SCOPE_AGENT);
        bf16x8 Aq[2][4]; float wq[2][16];
        { const int r = n32, qi = 2 * ((r >> 2) & 1) + (r >> 4), hd = (r & 3) + 4 * ((r >> 3) & 1);
#pragma unroll
          for (int mt = 0; mt < 2; ++mt) { const bf16_t* qp = iq + (size_t)(tq0 + 4 * mt + qi) * 512 + hd * 64 + 8 * hh;
#pragma unroll
              for (int ks = 0; ks < 4; ++ks) Aq[mt][ks] = as_bf16x8(*(const u32x4*)(qp + 16 * ks));
#pragma unroll
              for (int a = 0; a < 2; ++a) { const float* wp = iw + (size_t)(tq0 + 4 * mt + 2 * hh + a) * 8; const f32x4 w0 = *(const f32x4*)wp, w1 = *(const f32x4*)(wp + 4);
#pragma unroll
                  for (int j = 0; j < 4; ++j) { wq[mt][8 * a + j] = w0[j] * 0.125f; wq[mt][8 * a + 4 + j] = w1[j] * 0.125f; } } } }
        u32x4 Bn[4];
        { const bf16_t* kp = ik + ((size_t)b * SEQ + 32 * (w < nkt ? w : 0) + n32) * 64 + 8 * hh;
#pragma unroll
          for (int ks = 0; ks < 4; ++ks) Bn[ks] = *(const u32x4*)(kp + 16 * ks); }
        for (int kt = w; kt < nkt; kt += 8) {
            bf16x8 Bk[4];
#pragma unroll
            for (int ks = 0; ks < 4; ++ks) Bk[ks] = as_bf16x8(Bn[ks]);
            { const int k2 = (kt + 8 < nkt) ? kt + 8 : kt; const bf16_t* kp = ik + ((size_t)b * SEQ + 32 * k2 + n32) * 64 + 8 * hh;
#pragma unroll
              for (int ks = 0; ks < 4; ++ks) Bn[ks] = *(const u32x4*)(kp + 16 * ks); }
#pragma unroll
            for (int mt = 0; mt < 2; ++mt) { f32x16 acc;
#pragma unroll
                for (int j = 0; j < 16; ++j) acc[j] = 0.f;
#pragma unroll
                for (int ks = 0; ks < 4; ++ks) acc = __builtin_amdgcn_mfma_f32_32x32x16_bf16(Aq[mt][ks], Bk[ks], acc, 0, 0, 0);
#pragma unroll
                for (int a = 0; a < 2; ++a) { float s = 0.f;
#pragma unroll
                    for (int rr = 0; rr < 8; ++rr) s += wq[mt][8 * a + rr] * fmaxf(acc[8 * a + rr], 0.f);
                    const int qu = 4 * mt + 2 * hh + a, key = 32 * kt + n32; unsigned bits = __builtin_bit_cast(unsigned, s);
                    bits = (bits & 0x80000000u) ? ~bits : (bits | 0x80000000u);
                    sc[qu * 4096 + key] = (key <= q0 + qu) ? bits : 0u; } }
        }
        __syncthreads();
        un = C.misc[510];
        { const int q = q0 + w, n = q + 1; const size_t so = (size_t)(tq0 + w) * 256;
          if (n <= 256) { for (int r = lane; r < 256; r += 64) sel[so + r] = (r < n) ? (unsigned short)r : (unsigned short)0xFFFFu; }
          else {
            const int ni = (n + 63) >> 6;
            unsigned uu[64];
#pragma unroll
            for (int i = 0; i < 64; ++i) uu[i] = (i < ni && 64 * i + lane < nkt * 32) ? sc[w * 4096 + 64 * i + lane] : 0u;
            const int nact = (ni + 15) >> 4, below_const = (4 - nact) * 1024;
            LAS unsigned* slot = sc + w * 4096;
            unsigned Hp[32];
#pragma unroll
            for (int j = 0; j < 32; ++j) Hp[j] = (uu[2 * j] >> 16) | (uu[2 * j + 1] & 0xffff0000u);
#define IDX_BELOW(dst, cval) do { const unsigned cm1_ = ((cval) - 1u) * 0x00010001u; unsigned cnt_ = 0u; \
            _Pragma("unroll") for (int g4 = 0; g4 < 4; ++g4) if (g4 < nact) { _Pragma("unroll") for (int j = 8 * g4; j < 8 * g4 + 8; ++j) cnt_ = pk_below(Hp[j], cm1_, cnt_); } \
            (dst) = wave_total_dpp((int)((cnt_ & 0xffffu) + (cnt_ >> 16))) + below_const; } while (0)
            unsigned Th = 0u; int geT = 4096;
#pragma unroll 1
            for (int bit = 15; bit >= 0; --bit) { const unsigned c = Th | (1u << bit); int bl; IDX_BELOW(bl, c); if (4096 - bl >= 256) { Th = c; geT = 4096 - bl; } }
            int gtT = 0; if (Th != 0xffffu) { int bl; IDX_BELOW(bl, Th + 1u); gtT = 4096 - bl; }
            const int krem = 256 - gtT, nc = geT - gtT;
            unsigned Tv; int need; bool simple;
            if (nc <= 64) {
                int base = 0; const unsigned long long lt = (1ull << lane) - 1ull;
#pragma unroll
                for (int i = 0; i < 64; ++i) { const bool eq = (uu[i] >> 16) == Th; const unsigned long long em = __ballot(eq);
                    if (em) { if (eq) slot[base + __builtin_popcountll(em & lt)] = (uu[i] & 0xffffu) + 1u; base += __builtin_popcountll(em); } }
                asm volatile("s_waitcnt lgkmcnt(0)" ::: "memory");
                const unsigned tv = (lane < nc) ? slot[lane] : 0u;
                unsigned Tl = 0u;
#pragma unroll 1
                for (int bit = 16; bit >= 0; --bit) { const unsigned c = Tl | (1u << bit); if (__builtin_popcountll(__ballot(tv >= c)) >= krem) Tl = c; }
                need = krem - __builtin_popcountll(__ballot(tv > Tl)); simple = (need == __builtin_popcountll(__ballot(tv == Tl)));
                Tv = (Th << 16) | (Tl - 1u);
                asm volatile("s_waitcnt lgkmcnt(0)" ::: "memory");
            } else {
#pragma unroll
                for (int j = 0; j < 32; ++j) { const unsigned a = uu[2 * j], b2 = uu[2 * j + 1]; Hp[j] = (((a >> 16) == Th) ? (a & 0xffffu) : 0u) | (((b2 >> 16) == Th) ? (b2 << 16) : 0u); }
                unsigned Tl = 0u;
#pragma unroll 1
                for (int bit = 15; bit >= 0; --bit) { const unsigned c = Tl | (1u << bit); int bl; IDX_BELOW(bl, c); if (4096 - bl >= krem) Tl = c; }
                Tv = (Th << 16) | Tl; int cg = 0;
#pragma unroll
                for (int i = 0; i < 64; ++i) cg += (uu[i] > Tv) ? 1 : 0;
                need = 256 - wave_total_dpp(cg); simple = false;
            }
#undef IDX_BELOW
            if (simple) {
                int base = 0;
#pragma unroll
                for (int i = 0; i < 64; ++i) if (16 * (i >> 4) < ni) { const bool take = uu[i] >= Tv; const unsigned long long tm = __ballot(take);
                    const int pos = base + (int)__builtin_amdgcn_mbcnt_hi((unsigned)(tm >> 32), __builtin_amdgcn_mbcnt_lo((unsigned)tm, 0u));
                    if (take) sel[so + pos] = (unsigned short)(64 * i + lane);
                    base += __builtin_popcountll(tm); }
            } else {
                int base = 0, eqs = 0; const unsigned long long lt = (1ull << lane) - 1ull;
#pragma unroll
                for (int i = 0; i < 64; ++i) if (16 * (i >> 4) < ni) { const bool gt = uu[i] > Tv, eq = uu[i] == Tv; const unsigned long long em = __ballot(eq);
                    const bool take = gt || (eq && (eqs + __builtin_popcountll(em & lt)) < need); const unsigned long long tm = __ballot(take);
                    if (take) sel[so + base + __builtin_popcountll(tm & lt)] = (unsigned short)(64 * i + lane);
                    base += __builtin_popcountll(tm); eqs += __builtin_popcountll(em); }
            }
          } }
    }
}
__device__ __forceinline__ void ph_att(const Ctx& C) {
    const bf16_t* qabs = WSP(bf16_t, WS_QABS); const bf16_t* ckv = WSP(bf16_t, WS_CKV); const unsigned short* sel = WSP(unsigned short, WS_SEL); bf16_t* olat = WSP(bf16_t, WS_OLAT);
    const int lane = C.lane, g = lane >> 4, fr = lane & 15;
    LAS unsigned char* ch = C.lds + C.wave * (32 * TLD + 512);
    LAS unsigned short* ssel = (LAS unsigned short*)(ch + 32 * TLD);
    for (int tq = C.gw; tq < T; tq += C.NGW) {
        const int b = tq >> 12, q = tq & (SEQ - 1), nv = (q + 1) < 256 ? (q + 1) : 256, nch = (nv + 31) >> 5;
        const bf16_t* cb = ckv + (size_t)b * SEQ * 256;
        { u32x2 sv = *(const u32x2*)(sel + (size_t)tq * 256 + 4 * lane);
          unsigned s0 = sv.x & 0xffffu, s1 = sv.x >> 16, s2_ = sv.y & 0xffffu, s3 = sv.y >> 16;
          if (4 * lane + 0 >= nv) s0 = 0; if (4 * lane + 1 >= nv) s1 = 0; if (4 * lane + 2 >= nv) s2_ = 0; if (4 * lane + 3 >= nv) s3 = 0;
          *(LAS u32x2*)(ssel + 4 * lane) = (u32x2){s0 | (s1 << 16), s2_ | (s3 << 16)}; }
        bf16x8 Bqa[8];
        { const bf16_t* qp = qabs + (size_t)tq * 2048 + (fr & 7) * 256 + 8 * g;
#pragma unroll
          for (int ks = 0; ks < 8; ++ks) { u32x4 v = *(const u32x4*)(qp + 32 * ks); if (fr >= 8) v = (u32x4){0u, 0u, 0u, 0u}; Bqa[ks] = as_bf16x8(v); } }
        f32x4 acc[16];
#pragma unroll
        for (int nt = 0; nt < 16; ++nt) acc[nt] = (f32x4){0.f, 0.f, 0.f, 0.f};
        float mrun = -INFINITY, lrun = 0.f;
        asm volatile("s_waitcnt lgkmcnt(0)" ::: "memory");
        u32x4 G[16];
#pragma unroll
        for (int p = 0; p < 16; ++p) { const int s = ssel[2 * p + (lane >> 5)]; G[p] = *(const u32x4*)(cb + (size_t)s * 256 + (lane & 31) * 8); }
#pragma unroll 1
        for (int t = 0; t < nch; ++t) {
#pragma unroll
            for (int p = 0; p < 16; ++p) *(LAS u32x4*)(ch + (2 * p + (lane >> 5)) * TLD + (lane & 31) * 16) = G[p];
            if (t + 1 < nch) {
#pragma unroll
                for (int p = 0; p < 16; ++p) { const int s = ssel[32 * (t + 1) + 2 * p + (lane >> 5)]; G[p] = *(const u32x4*)(cb + (size_t)s * 256 + (lane & 31) * 8); } }
            asm volatile("s_waitcnt lgkmcnt(0)" ::: "memory");
            f32x4 s2[2];
#pragma unroll
            for (int hf = 0; hf < 2; ++hf) { s2[hf] = (f32x4){0.f, 0.f, 0.f, 0.f};
#pragma unroll
                for (int ks = 0; ks < 8; ++ks) { const bf16x8 Ac = as_bf16x8(*(const LAS u32x4*)(ch + (16 * hf + fr) * TLD + (32 * ks + 8 * g) * 2)); s2[hf] = __builtin_amdgcn_mfma_f32_16x16x32_bf16(Ac, Bqa[ks], s2[hf], 0, 0, 0); } }
            float cm = -INFINITY;
#pragma unroll
            for (int hf = 0; hf < 2; ++hf)
#pragma unroll
                for (int r = 0; r < 4; ++r) { const int ki = 32 * t + 16 * hf + 4 * g + r; if (ki >= nv) s2[hf][r] = -INFINITY; cm = fmaxf(cm, s2[hf][r]); }
            cm = quad_max(cm);
            const float mnew = fmaxf(mrun, cm), scale = __expf(mrun - mnew); float ps = 0.f;
#pragma unroll
            for (int hf = 0; hf < 2; ++hf)
#pragma unroll
                for (int r = 0; r < 4; ++r) { s2[hf][r] = __expf(s2[hf][r] - mnew); ps += s2[hf][r]; }
            ps = quad_sum(ps);
            lrun = lrun * scale + ps; mrun = mnew;
            u32x4 pw; pw.x = cvt_pk_bf16(s2[0][0], s2[0][1]); pw.y = cvt_pk_bf16(s2[0][2], s2[0][3]); pw.z = cvt_pk_bf16(s2[1][0], s2[1][1]); pw.w = cvt_pk_bf16(s2[1][2], s2[1][3]);
            const bf16x8 Bp = as_bf16x8(pw);
#pragma unroll
            for (int nt = 0; nt < 16; ++nt) { const bf16x8 Av = tr_frag(ch, TLD, 4 * g, 16 + 4 * g, 16 * nt, lane); acc[nt] = __builtin_amdgcn_mfma_f32_16x16x32_bf16(Av, Bp, acc[nt] * scale, 0, 0, 0); }
            asm volatile("s_waitcnt lgkmcnt(0)" ::: "memory");
        }
        const float inv = 1.0f / lrun;
        if (fr < 8) { bf16_t* op = olat + (size_t)tq * 2048 + fr * 256 + 4 * g;
#pragma unroll
            for (int nt = 0; nt < 16; ++nt) { u32x2 o; o.x = cvt_pk_bf16(acc[nt][0] * inv, acc[nt][1] * inv); o.y = cvt_pk_bf16(acc[nt][2] * inv, acc[nt][3] * inv); *(u32x2*)(op + 16 * nt) = o; } }
    }
}

__device__ __forceinline__ void ph_norm_hilo(const Ctx& C, const float* x, const float* g, bf16_t* H, bf16_t* HLO) {
    for (int row = C.gw; row < T; row += C.NGW) {
        const f32x4* xr = (const f32x4*)(x + (size_t)row * DM) + C.lane; f32x4 v[8]; float ss = 0.f;
#pragma unroll
        for (int j = 0; j < 8; ++j) { v[j] = xr[64 * j]; ss += v[j][0] * v[j][0] + v[j][1] * v[j][1] + v[j][2] * v[j][2] + v[j][3] * v[j][3]; }
        const float rstd = rsqrtf(wave_sum(ss, C.lane) * (1.f / DM) + EPS);
        u32x2* oh = (u32x2*)(H + (size_t)row * DM) + C.lane; u32x2* ol = (u32x2*)(HLO + (size_t)row * DM) + C.lane;
#pragma unroll
        for (int j = 0; j < 8; ++j) { const f32x4 gg = ((const f32x4*)g)[64 * j + C.lane]; const f32x4 y = v[j] * rstd * gg; u32x2 wh; wh.x = cvt_pk_bf16(y[0], y[1]); wh.y = cvt_pk_bf16(y[2], y[3]);
            u32x2 wl; wl.x = cvt_pk_bf16(y[0] - bf2f(wh.x), y[1] - bf2f(wh.x >> 16)); wl.y = cvt_pk_bf16(y[2] - bf2f(wh.y), y[3] - bf2f(wh.y >> 16)); oh[64 * j] = wh; ol[64 * j] = wl; }
    }
}
__device__ __forceinline__ void ph_route(const Ctx& C, int l) {
    const float* LOG = WSP(float, WS_OLAT); const float* bg = C.in[I_BGRP] + l * 4; const float* be = C.in[I_BEXP] + l * 32;
    int* rinfo = WSP(int, WS_ROUTE); float* rw = (float*)(rinfo + T * 4); unsigned* cnt = C.ctl + CW_CNT + l * 64;
    for (int t0 = C.gw * 8; t0 < T; t0 += C.NGW * 8) if (C.lane < 8) {
        const int t = t0 + C.lane;
        float lg[36];
#pragma unroll
        for (int c = 0; c < 36; ++c) lg[c] = 0.f;
#pragma unroll
        for (int part = 0; part < 4; ++part) { const f32x4* p = (const f32x4*)(LOG + ((size_t)part * T + t) * 128);
#pragma unroll
            for (int c4 = 0; c4 < 9; ++c4) { const f32x4 a = p[c4];
#pragma unroll
                for (int j = 0; j < 4; ++j) lg[4 * c4 + j] += a[j];
                if (part < 2) { const f32x4 b2 = p[16 + c4];
#pragma unroll
                    for (int j = 0; j < 4; ++j) lg[4 * c4 + j] += b2[j]; } } }
        int gsel = 0; float gmax = -INFINITY, gv4[4];
#pragma unroll
        for (int k = 0; k < 4; ++k) { gv4[k] = lg[k] + bg[k]; if (gv4[k] > gmax) { gmax = gv4[k]; gsel = k; } }
        float gden = 0.f;
#pragma unroll
        for (int k = 0; k < 4; ++k) gden += __expf(gv4[k] - gmax);
        const float pg = 1.f / gden;
        float el[8], emax = -INFINITY;
#pragma unroll
        for (int k = 0; k < 8; ++k) { const float v0 = lg[4 + k] + be[k], v1 = lg[12 + k] + be[8 + k], v2 = lg[20 + k] + be[16 + k], v3 = lg[28 + k] + be[24 + k];
            el[k] = gsel == 0 ? v0 : (gsel == 1 ? v1 : (gsel == 2 ? v2 : v3)); emax = fmaxf(emax, el[k]); }
        float eden = 0.f, ep[8];
#pragma unroll
        for (int k = 0; k < 8; ++k) { ep[k] = __expf(el[k] - emax); eden += ep[k]; }
        int i0 = 0; float p0 = -1.f;
#pragma unroll
        for (int k = 0; k < 8; ++k) { ep[k] = ep[k] / eden; if (ep[k] > p0) { p0 = ep[k]; i0 = k; } }
        int i1 = 0; float p1 = -1.f;
#pragma unroll
        for (int k = 0; k < 8; ++k) if (k != i0 && ep[k] > p1) { p1 = ep[k]; i1 = k; }
        const float den = p0 + p1; const int e0 = gsel * 8 + i0, e1 = gsel * 8 + i1;
        const unsigned r0 = atomicAdd(&cnt[e0], 1u), r1 = atomicAdd(&cnt[e1], 1u);
        int* list = WSP(int, WS_LIST); list[(size_t)e0 * T + r0] = t; list[(size_t)e1 * T + r1] = t;
        *(int4*)(rinfo + (size_t)t * 4) = make_int4(e0, e1, (int)r0, (int)r1); *(f32x2*)(rw + (size_t)t * 2) = (f32x2){pg * (p0 / den), pg * (p1 / den)};
    }
}
__device__ __forceinline__ int moe_offsets(const unsigned* cnt, int lane, int& total_tiles) {
    const int c = lane < NEXP ? (int)__hip_atomic_load(cnt + lane, __ATOMIC_RELAXED, __HIP_MEMORY_SCOPE_AGENT) : 0; const int tiles = (c + 255) >> 8;
    int incl = tiles;
#pragma unroll
    for (int o = 1; o < 64; o <<= 1) { const int t = shi(incl, (lane - o) & 63); if (lane >= o) incl += t; }
    total_tiles = shi(incl, 63);
    return (incl - tiles) * 256;
}
__device__ __forceinline__ int moe_table(const Ctx& C, int l) {
    __syncthreads();
    if (C.wave == 0) { int tt; const int off = moe_offsets(C.ctl + CW_CNT + l * 64 + CNT_BANK, C.lane, tt); const int nxt = shi(off, (C.lane + 1) & 63);
        if (C.lane < NEXP) { const int t0 = off >> 8, t1 = (C.lane == NEXP - 1) ? tt : (nxt >> 8); const int cn = (int)__hip_atomic_load(C.ctl + CW_CNT + l * 64 + CNT_BANK + C.lane, __ATOMIC_RELAXED, __HIP_MEMORY_SCOPE_AGENT);
            for (int t = t0; t < t1; ++t) { C.misc[16 + t] = C.lane; C.misc[176 + t] = (t - t0) * 256; C.misc[336 + t] = cn; } }
        if (C.lane == 0) C.misc[500] = tt; }
    __syncthreads();
    return C.misc[500];
}
__device__ __forceinline__ void ph_combine(const Ctx& C, int l, float* x, bool last, const float* gnext, bf16_t* Hn) {
    const bf16_t* yc = WSP(bf16_t, WS_PROJ + M_YC); const int* rinfo = WSP(int, WS_ROUTE); const float* rw = (const float*)(rinfo + T * 4); const int* rpos = rinfo + T * 6; const float* gf = C.in[I_FNG];
    int tt_; const int myoff = moe_offsets(C.ctl + CW_CNT + l * 64 + CNT_BANK, C.lane, tt_);
    for (int row = C.gw; row < T; row += C.NGW) {
        const int4 ri = *(const int4*)(rinfo + (size_t)row * 4); const int p0 = shi(myoff, ri.x) + ri.z, p1 = shi(myoff, ri.y) + ri.w; const float w0 = rw[(size_t)row * 2], w1 = rw[(size_t)row * 2 + 1];
        f32x4* xr = (f32x4*)(x + (size_t)row * DM) + C.lane; const u32x2* y0 = (const u32x2*)(yc + (size_t)p0 * DM) + C.lane; const u32x2* y1 = (const u32x2*)(yc + (size_t)p1 * DM) + C.lane;
        f32x4 v[8]; float ss = 0.f;
#pragma unroll
        for (int j = 0; j < 8; ++j) { const u32x2 a = y0[64 * j], b = y1[64 * j]; f32x4 xv = xr[64 * j];
            xv[0] += w0 * bf2f(a.x) + w1 * bf2f(b.x); xv[1] += w0 * bf2f(a.x >> 16) + w1 * bf2f(b.x >> 16); xv[2] += w0 * bf2f(a.y) + w1 * bf2f(b.y); xv[3] += w0 * bf2f(a.y >> 16) + w1 * bf2f(b.y >> 16);
            v[j] = xv; ss += xv[0] * xv[0] + xv[1] * xv[1] + xv[2] * xv[2] + xv[3] * xv[3]; }
        if (last) { const float rstd = rsqrtf(wave_sum(ss, C.lane) * (1.f / DM) + EPS);
#pragma unroll
            for (int j = 0; j < 8; ++j) xr[64 * j] = v[j] * rstd * ((const f32x4*)gf)[64 * j + C.lane]; }
        else { const float rstd = rsqrtf(wave_sum(ss, C.lane) * (1.f / DM) + EPS); u32x2* o = (u32x2*)(Hn + (size_t)row * DM) + C.lane;
#pragma unroll
            for (int j = 0; j < 8; ++j) { xr[64 * j] = v[j]; const f32x4 y = v[j] * rstd * ((const f32x4*)gnext)[64 * j + C.lane]; u32x2 w; w.x = cvt_pk_bf16(y[0], y[1]); w.y = cvt_pk_bf16(y[2], y[3]); o[64 * j] = w; } }
    }
}

constexpr int NPL = 14, NPHASES = 1 + DEPTH * NPL;
#if MK_PER_PHASE
#define IN(k) (lo <= (k) && (k) < hi)
#else
#define IN(k) true
#endif
#if MK_PER_PHASE
#define SEAM(k) do { } while (0)
#else
#define SEAM(k) xcd_barrier(bar)
#endif
template <int l> __device__ __forceinline__ void run_layer(Ctx& C, const XcdBarrier& bar, const int lo, const int hi) {
    unsigned char* wb = (unsigned char*)(C.ws + WS_W);
    bf16_t* H = WSP(bf16_t, WS_H);
        const int pb = 1 + l * NPL;
        const float* xin = (l == 0) ? C.in[I_X] : (const float*)C.out;
        if (l == 0) { if (IN(pb + 0)) { refresh(C); ph_rope(C); refresh(C); REP(1) ph_weights(C, 0); REP(2) ph_norm(C, xin, C.in[I_NMIX], H); }
            SEAM(pb + 0); }
        if (IN(pb + 1)) { refresh(C);
            pg8::Gemm g{H, (const bf16_t*)(wb + W_IN), DM, DM, DM}; pg8::OrderMN S; S.init(T / 256, NP / 256, C.G, C.bid, 256L * DM * 2, 256L * DM * 2);
            pg8::EpiInProj E{(unsigned char*)C.ws};
            REP(3) pg8::gemm_phase(C.lds, g, S, E);
        }
        SEAM(pb + 1);
        if (IN(pb + 2)) { refresh(C);
            ph_ckv(C, WSP(float, WS_PROJ + P_DC), C.in[I_KVG] + l * 256, WSP(bf16_t, WS_CKV));
            { pg8::Gemm g{WSP(bf16_t, WS_PROJ + P_DQ), (const bf16_t*)(wb + W_UK), 1024, 256, 256}; pg8::OrderMN S; S.init(T / 256, 8, C.G, C.bid, 256L * 1024 * 2, 256L * 256 * 2, 1, 256L * 2);
              pg8::EpiStore<0> E{WSP(bf16_t, WS_QABS), 2048, 0.08838834764831845f}; REP(4) pg8::gemm_phase(C.lds, g, S, E); }
            refresh(C);
            REP(5) ph_gmlp(C, l);
            refresh(C);
            REP(6) ph_ret_kv(C);
            refresh(C);
            REP(7) ph_idx(C, l);
        }
        SEAM(pb + 2);
        if (IN(pb + 3)) { refresh(C);
            REP(8) ph_ret_scan(C);
            REP(9) ph_att(C);
        }
        SEAM(pb + 3);
        if (IN(pb + 4)) { refresh(C);
            { pg8::Gemm g{WSP(bf16_t, WS_OLAT), (const bf16_t*)(wb + W_UV), 2048, 512, 512}; pg8::OrderMN S; S.init(T / 256, 4, C.G, C.bid, 256L * 2048 * 2, 256L * 512 * 2, 0, 512L * 2);
              pg8::EpiStore<0> E{WSP(bf16_t, WS_DS), 1024, 1.0f}; REP(10) pg8::gemm_phase(C.lds, g, S, E); }
            REP(11) ph_ret_out(C);
        }
        SEAM(pb + 4);
        if (IN(pb + 5)) { refresh(C);
            pg8::Gemm g{WSP(bf16_t, WS_RET), (const bf16_t*)(wb + W_RET), 1024, 1024, 1024}; pg8::OrderBranch S; S.base.init(T / 256, 8, C.G, C.bid, 256L * 1024 * 2, 256L * 1024 * 2); S.astride = 32L << 20; S.bstride = 4L << 20;
            pg8::EpiBranch E{WSP(bf16_t, WS_PROJ + P_GA), H}; REP(12) pg8::gemm_phase<pg8::EpiBranch, pg8::OrderBranch, false, true>(C.lds, g, S, E);
        }
        SEAM(pb + 5);
        if (IN(pb + 6)) { refresh(C);
            pg8::Gemm g{H, (const bf16_t*)(wb + W_OUT), DM, DM, DM}; pg8::OrderMN S; S.init(T / 256, 8, C.G, C.bid, 256L * DM * 2, 256L * DM * 2);
            pg8::EpiResid E{xin, C.out}; for (int rep_ = 0; rep_ <= ((l == 0) ? ((PROBE_MASK >> 17) & 1) : 0); ++rep_) pg8::gemm_phase(C.lds, g, S, E);
        }
        SEAM(pb + 6);
        if (IN(pb + 7)) { refresh(C); ph_norm_hilo(C, C.out, C.in[I_NFFN] + l * DM, H, WSP(bf16_t, WS_QABS)); }
        SEAM(pb + 7);
        if (IN(pb + 8)) { refresh(C);
            pg8::Gemm g{H, (const bf16_t*)(wb + W_RT), DM, DM, 1024}; pg8::OrderRouter S{C.G, C.bid, (long)(WS_QABS - WS_H)};
            pg8::EpiRouter E{WSP(float, WS_OLAT)}; pg8::gemm_phase(C.lds, g, S, E);
        }
        SEAM(pb + 8);
        if (IN(pb + 9)) { refresh(C); ph_route(C, l); }
        SEAM(pb + 9);
        if (IN(pb + 11)) { refresh(C);
            const int Mt = moe_table(C, l);
            pg8::Gemm g{H, (const bf16_t*)(wb + W_13), DM, DM, DM};
            pg8::OrderMoE S{C.misc + 16, Mt, 4, C.G, C.bid, 256L * DM * 2, 256L * DM * 2, 1024L * DM * 2, WSP(int, WS_LIST)};
            pg8::EpiMoeUp E{WSP(bf16_t, WS_PROJ + M_HID)}; REP(14) pg8::gemm_phase<pg8::EpiMoeUp, pg8::OrderMoE, true>(C.lds, g, S, E);
        }
        SEAM(pb + 11);
        if (IN(pb + 12)) { refresh(C);
            const int Mt = moe_table(C, l);
            pg8::Gemm g{WSP(bf16_t, WS_PROJ + M_HID), (const bf16_t*)(wb + W_2), FF, FF, FF};
            pg8::OrderMoE S{C.misc + 16, Mt, 8, C.G, C.bid, 256L * FF * 2, 256L * FF * 2, (long)DM * FF * 2, nullptr};
            pg8::EpiStore<0> E{WSP(bf16_t, WS_PROJ + M_YC), DM, 1.0f}; REP(15) pg8::gemm_phase(C.lds, g, S, E);
        }
        SEAM(pb + 12);
        if (IN(pb + 13)) { refresh(C); ph_combine(C, l, C.out, l == DEPTH - 1, C.in[I_NMIX] + (l + 1 < DEPTH ? l + 1 : l) * DM, H); if (l + 1 < DEPTH) { refresh(C); ph_weights(C, l + 1); } }
        if (l + 1 < DEPTH) SEAM(pb + 13);

}
__global__ void __launch_bounds__(512, 2) mk_fwd(Args a) {
    extern __shared__ __attribute__((aligned(16))) unsigned char lds_raw[];
    Ctx C;
    C.lds = (LAS unsigned char*)lds_raw; C.misc = (volatile LAS int*)(C.lds + MISC_OFF); C.ws = (GAS unsigned char*)a.ws; C.ctl = (unsigned*)(a.ws + WS_CTL);
    C.tid = threadIdx.x; C.lane = C.tid & 63; C.wave = __builtin_amdgcn_readfirstlane(C.tid >> 6); C.G = gridDim.x; C.bid = blockIdx.x;
    C.gw = C.bid * 8 + C.wave; C.NGW = C.G * 8; C.in = a.in; C.out = a.out;
    for (int i = C.tid; i < 1024; i += 512) C.misc[i] = 0;
    __syncthreads();
#if MK_PER_PHASE
    XcdBarrier bar; bar.bar = C.ctl + CW_BAR; bar.x = 0; bar.st = (volatile LAS unsigned*)C.misc;
#else
    XcdBarrier bar = xcd_barrier_post(C.ctl + CW_BAR, (volatile LAS unsigned*)C.misc);
#endif
    const int lo = a.ph_lo, hi = a.ph_hi;
    run_layer<0>(C, bar, lo, hi);
    run_layer<1>(C, bar, lo, hi);
}

extern "C" void kernel_launch(void* const* d_in, const int* in_sizes, int n_in, void* d_out, int out_size, void* d_ws, size_t ws_size, hipStream_t stream) {
    static int grid = 0;
    if (grid == 0) {
        if (n_in != 23 || out_size != T * DM || ws_size < WS_END) { fprintf(stderr, "kernel_launch: unexpected shapes / workspace (n_in %d out %d ws %zu need %zu)\n", n_in, out_size, ws_size, (size_t)WS_END); grid = -1; return; }
        int dev = 0, cus = 0, per_cu = 0;
        if (hipGetDevice(&dev) != hipSuccess || hipDeviceGetAttribute(&cus, hipDeviceAttributeMultiprocessorCount, dev) != hipSuccess) { grid = -1; return; }
        if (hipFuncSetAttribute((const void*)mk_fwd, hipFuncAttributeMaxDynamicSharedMemorySize, LDS_BYTES) != hipSuccess) { fprintf(stderr, "kernel_launch: hipFuncSetAttribute failed\n"); grid = -1; return; }
        if (hipOccupancyMaxActiveBlocksPerMultiprocessor(&per_cu, (const void*)mk_fwd, 512, LDS_BYTES) != hipSuccess || per_cu < 1) { fprintf(stderr, "kernel_launch: occupancy query says %d\n", per_cu); (void)hipGetLastError(); grid = -1; return; }
        grid = cus;
    }
    if (grid < 0) return;
    (void)hipMemsetAsync((char*)d_ws + WS_CTL, 0, CTL_BYTES, stream);
    Args a{};
    for (int i = 0; i < 23; ++i) a.in[i] = (const float*)d_in[i];
    a.out = (float*)d_out; a.ws = (unsigned char*)d_ws;
#if MK_PER_PHASE
    for (int p = 0; p < NPHASES; ++p) { a.ph_lo = p; a.ph_hi = p + 1; hipLaunchKernelGGL(mk_fwd, dim3(grid), dim3(512), LDS_BYTES, stream, a); }
#else
    a.ph_lo = 0; a.ph_hi = NPHASES;
    hipLaunchKernelGGL(mk_fwd, dim3(grid), dim3(512), LDS_BYTES, stream, a);
#endif
}
```

```cpp
#include <hip/hip_runtime.h>
#include <stdint.h>
#include <stdio.h>

#ifndef MK_PER_PHASE
#define MK_PER_PHASE 0
#endif
#ifndef PROBE_MASK
#define PROBE_MASK 0
#endif
#define CNT_BANK (((PROBE_MASK >> 16) & 1) * 128)
#define REP(k) for (int rep_ = 0; rep_ <= ((PROBE_MASK >> (k)) & 1); ++rep_)

#define LAS __attribute__((address_space(3)))
#define GAS __attribute__((address_space(1)))
typedef unsigned short bf16_t;
typedef short bf16x8 __attribute__((ext_vector_type(8)));
typedef short s16x4 __attribute__((ext_vector_type(4)));
typedef float f32x4 __attribute__((ext_vector_type(4)));
typedef float f32x2 __attribute__((ext_vector_type(2)));
typedef float f32x16 __attribute__((ext_vector_type(16)));
typedef unsigned u32x4 __attribute__((ext_vector_type(4)));
typedef unsigned u32x2 __attribute__((ext_vector_type(2)));

constexpr int DM = 2048, NB = 4, SEQ = 4096, T = NB * SEQ, DEPTH = 2;
constexpr int INW = 14152, NP = 14336;
constexpr int GATE_SRC0 = 8008, GATE_DST0 = 8192;
constexpr int NEXP = 32, FF = 512, MOE_ROWS = 40960;
constexpr float EPS = 1e-6f;

constexpr size_t MiB = 1u << 20;
constexpr size_t WS_CTL = 0, CTL_BYTES = 1 * MiB;
constexpr size_t WS_ROPE = 1 * MiB;
constexpr size_t WS_W = 5 * MiB;
constexpr size_t W_IN = 0, W_RET = 56 * MiB, W_GM = 60 * MiB, W_DS = 64 * MiB, W_OUT = 68 * MiB, W_13 = 76 * MiB, W_2 = 204 * MiB, W_UK = 268 * MiB, W_UV = 269 * MiB, W_RT = 270 * MiB  , W_END = 271 * MiB;
constexpr size_t WS_H = WS_W + W_END;
constexpr size_t WS_PROJ = WS_H + 64 * MiB;
constexpr size_t P_RQ = 0, P_RK = 32 * MiB, P_RV = 64 * MiB, P_RG = 96 * MiB, P_GU = 128 * MiB, P_GV = 160 * MiB, P_DQ = 192 * MiB, P_DC = 224 * MiB  ,
                 P_IQ = 240 * MiB  , P_IK = 256 * MiB  , P_IW = 258 * MiB  , P_GA = 260 * MiB, P_GB = 324 * MiB, P_GC = 388 * MiB, P_END = 452 * MiB;
constexpr size_t M_HPERM = 0, M_HID = 160 * MiB, M_YC = 200 * MiB;
constexpr size_t WS_KV = WS_PROJ + P_END;
constexpr size_t WS_R = WS_KV + 64 * MiB;
constexpr size_t WS_QABS = WS_R + 64 * MiB;
constexpr size_t WS_OLAT = WS_QABS + 64 * MiB;
constexpr size_t WS_RET = WS_OLAT + 64 * MiB;
constexpr size_t WS_GM = WS_RET + 32 * MiB, WS_DS = WS_GM + 32 * MiB;
constexpr size_t WS_SEL = WS_DS + 32 * MiB;
constexpr size_t WS_CKV = WS_SEL + 8 * MiB;
constexpr size_t WS_STATS = WS_CKV + 8 * MiB;
constexpr size_t WS_ROUTE = WS_STATS + 2 * MiB;
constexpr size_t WS_LIST = WS_ROUTE + 1 * MiB;
constexpr size_t WS_END = WS_LIST + 2 * MiB;
constexpr int CW_BAR = 4096, CW_CNT = 16384;
constexpr int CW_Q = 32768;

constexpr int LDS_BYTES = 147456, MISC_OFF = LDS_BYTES - 4096;

__device__ __forceinline__ unsigned f2bf(float f) { unsigned u = __builtin_bit_cast(unsigned, f); return (u + 0x7fffu + ((u >> 16) & 1u)) >> 16; }
__device__ __forceinline__ float bf2f(unsigned b) { return __builtin_bit_cast(float, (b & 0xffffu) << 16); }
typedef __bf16 bf16x2_t __attribute__((ext_vector_type(2)));
__device__ __forceinline__ unsigned cvt_pk_bf16(float lo, float hi) { const f32x2 v = {lo, hi}; return __builtin_bit_cast(unsigned, __builtin_convertvector(v, bf16x2_t)); }
__device__ __forceinline__ float shx(float v, int k, int lane) { return __builtin_bit_cast(float, __builtin_amdgcn_ds_bpermute((lane ^ k) << 2, __builtin_bit_cast(int, v))); }
__device__ __forceinline__ void swap32_(float& a, float& b) { asm volatile("v_nop\n\tv_nop\n\tv_permlane32_swap_b32 %0, %1\n\tv_nop" : "+v"(a), "+v"(b)); }
__device__ __forceinline__ void swap16_(float& a, float& b) { asm volatile("v_nop\n\tv_nop\n\tv_permlane16_swap_b32 %0, %1\n\tv_nop" : "+v"(a), "+v"(b)); }
__device__ __forceinline__ float quad_sum(float v) { float a = v, b = v; swap32_(a, b); v = a + b; a = v; b = v; swap16_(a, b); return a + b; }
__device__ __forceinline__ float quad_max(float v) { float a = v, b = v; swap32_(a, b); v = fmaxf(a, b); a = v; b = v; swap16_(a, b); return fmaxf(a, b); }
__device__ __forceinline__ int shi(int v, int src) { return __builtin_amdgcn_ds_bpermute(src << 2, v); }
typedef unsigned short u16x2 __attribute__((ext_vector_type(2)));
__device__ __forceinline__ unsigned pk_below(unsigned x, unsigned cm1, unsigned cnt) {
    u16x2 r = __builtin_elementwise_sub_sat(__builtin_bit_cast(u16x2, x), __builtin_bit_cast(u16x2, cm1)); unsigned ru = __builtin_bit_cast(unsigned, r); asm volatile("" : "+v"(ru));
    r = __builtin_elementwise_sub_sat((u16x2){1, 1}, __builtin_bit_cast(u16x2, ru)); ru = __builtin_bit_cast(unsigned, r); asm volatile("" : "+v"(ru));
    return __builtin_bit_cast(unsigned, (u16x2)(__builtin_bit_cast(u16x2, cnt) + __builtin_bit_cast(u16x2, ru)));
}
__device__ __forceinline__ int wave_total_dpp(int x) {
    x += __builtin_amdgcn_update_dpp(0, x, 0x111, 0xf, 0xf, false);
    x += __builtin_amdgcn_update_dpp(0, x, 0x112, 0xf, 0xf, false);
    x += __builtin_amdgcn_update_dpp(0, x, 0x114, 0xf, 0xf, false);
    x += __builtin_amdgcn_update_dpp(0, x, 0x118, 0xf, 0xf, false);
    x += __builtin_amdgcn_update_dpp(0, x, 0x142, 0xa, 0xf, false);
    x += __builtin_amdgcn_update_dpp(0, x, 0x143, 0xc, 0xf, false);
    return __builtin_amdgcn_readlane(x, 63);
}
__device__ __forceinline__ float wave_sum(float v, int lane) {
#pragma unroll
    for (int o = 1; o < 64; o <<= 1) v += shx(v, o, lane);
    return v;
}
__device__ __forceinline__ float wave_max(float v, int lane) {
#pragma unroll
    for (int o = 1; o < 64; o <<= 1) v = fmaxf(v, shx(v, o, lane));
    return v;
}
__device__ __forceinline__ float sigmoidf_(float x) { return __builtin_amdgcn_rcpf(1.0f + __builtin_amdgcn_exp2f(x * -1.44269504089f)); }
__device__ __forceinline__ float siluf_(float x) { return x * sigmoidf_(x); }
__device__ __forceinline__ f32x2 gelu_pk(f32x2 v) {
    const f32x2 av = __builtin_elementwise_abs(v), d = av * 0.2316418882f + 1.0f;
    f32x2 t; t.x = __builtin_amdgcn_rcpf(d.x); t.y = __builtin_amdgcn_rcpf(d.y);
    f32x2 q = t * 0.5307027145f + (-0.7265760135f); q = q * t + 0.7107068705f; q = q * t + (-0.142248368f); q = q * t + 0.127414796f; q = q * t;
    const f32x2 s = (v * v) * (-0.72134752044f);
    f32x2 e; e.x = __builtin_amdgcn_exp2f(s.x); e.y = __builtin_amdgcn_exp2f(s.y);
    const f32x2 m = v * (q * e), r = v - m;
    f32x2 o; o.x = v.x < 0.f ? m.x : r.x; o.y = v.y < 0.f ? m.y : r.y; return o;
}
template <int ACT> __device__ __forceinline__ f32x4 act4(f32x4 v) {
    if (ACT == 1) { f32x2 a = gelu_pk((f32x2){v[0], v[1]}), b = gelu_pk((f32x2){v[2], v[3]}); return (f32x4){a.x, a.y, b.x, b.y}; }
    if (ACT == 2) return (f32x4){siluf_(v[0]), siluf_(v[1]), siluf_(v[2]), siluf_(v[3])};
    if (ACT == 3) return (f32x4){sigmoidf_(v[0]), sigmoidf_(v[1]), sigmoidf_(v[2]), sigmoidf_(v[3])};
    return v;
}
__device__ __forceinline__ u32x4 pack8(f32x4 a, f32x4 b) { u32x4 w; w.x = cvt_pk_bf16(a[0], a[1]); w.y = cvt_pk_bf16(a[2], a[3]); w.z = cvt_pk_bf16(b[0], b[1]); w.w = cvt_pk_bf16(b[2], b[3]); return w; }
__device__ __forceinline__ void unpack8(u32x4 w, float (&f)[8]) {
    f[0] = bf2f(w.x); f[1] = bf2f(w.x >> 16); f[2] = bf2f(w.y); f[3] = bf2f(w.y >> 16); f[4] = bf2f(w.z); f[5] = bf2f(w.z >> 16); f[6] = bf2f(w.w); f[7] = bf2f(w.w >> 16);
}

#define XB_TMO      128
#define XB_XCNT(j)  (256  + 64 * (j))
#define XB_XSUB(j)  (1280 + 64 * (j))
#define XB_XGEN(j)  (2304 + 64 * (j))
#define XB_TOP      3328
#define XB_TOPGEN   3392
#define XCD_BAR_WORDS 3456
#define XB_SPIN_CAP (1u << 20)
__device__ __forceinline__ unsigned xb_ld(unsigned* p)              { return __hip_atomic_load(p, __ATOMIC_RELAXED, __HIP_MEMORY_SCOPE_AGENT); }
__device__ __forceinline__ unsigned xb_add(unsigned* p, unsigned v) { return __hip_atomic_fetch_add(p, v, __ATOMIC_RELAXED, __HIP_MEMORY_SCOPE_AGENT); }
__device__ __forceinline__ unsigned xb_xcc_id() { return (unsigned)__builtin_amdgcn_s_getreg((3 << 11) | 20) & 0xFu; }
#define XB_SPIN(cond, bar) do { unsigned _sp = 0; while (cond) { __builtin_amdgcn_s_sleep(1); \
    if ((++_sp & 255u) == 0u) { if (xb_ld(&(bar)[XB_TMO])) break; if (_sp > XB_SPIN_CAP) { atomicAdd(&(bar)[XB_TMO], 1u); break; } } } } while (0)
struct XcdBarrier { unsigned* bar; unsigned x; volatile LAS unsigned* st; };
__device__ __forceinline__ XcdBarrier xcd_barrier_post(unsigned* bar, volatile LAS unsigned* st) {
    XcdBarrier b; b.bar = bar; b.x = xb_xcc_id(); b.st = st;
    if (threadIdx.x == 0) (void)xb_add(&bar[XB_XCNT(b.x)], 1u);
    return b;
}
__device__ __forceinline__ void xcd_barrier_complete(unsigned* bar, unsigned x, unsigned& nloc, unsigned& nx) {
    const unsigned G = gridDim.x * gridDim.y * gridDim.z;
    unsigned sum, cnt, mine, sp = 0u;
    for (;;) {
        sum = 0u; cnt = 0u; mine = 0u;
#pragma unroll
        for (unsigned j = 0; j < 16; ++j) { const unsigned c = xb_ld(&bar[XB_XCNT(j)]); sum += c; cnt += (c > 0u) ? 1u : 0u; mine = (j == x) ? c : mine; }
        if (sum == G) break;
        __builtin_amdgcn_s_sleep(1);
        if ((++sp & 255u) == 0u) { if (xb_ld(&bar[XB_TMO])) break; if (sp > XB_SPIN_CAP) { atomicAdd(&bar[XB_TMO], 1u); break; } }
    }
    nloc = mine > 0u ? mine : 1u; nx = cnt > 0u ? cnt : 1u;
}
__device__ __forceinline__ void xcd_barrier(const XcdBarrier& b) {
    asm volatile("s_waitcnt vmcnt(0)" ::: "memory");
    __syncthreads();
    if (threadIdx.x == 0) {
        unsigned* bar = b.bar; asm volatile("" : "+s"(bar));
        __builtin_amdgcn_s_waitcnt(0);
        unsigned nloc = b.st[0], nx = b.st[1];
        if (nloc == 0u) { xcd_barrier_complete(bar, b.x, nloc, nx); b.st[0] = nloc; b.st[1] = nx; }
        const unsigned old = xb_add(&bar[XB_XSUB(b.x)], 1u);
        const unsigned gen = old / nloc;
        if (old + 1u == (gen + 1u) * nloc) {
            __builtin_amdgcn_fence(__ATOMIC_RELEASE, "agent");
            asm volatile("s_waitcnt vmcnt(0)" ::: "memory");
            const unsigned og = xb_add(&bar[XB_TOP], 1u);
            const unsigned tg = og / nx;
            if (og + 1u == (tg + 1u) * nx) xb_add(&bar[XB_TOPGEN], 1u);
            else XB_SPIN(xb_ld(&bar[XB_TOPGEN]) == tg, bar);
            __builtin_amdgcn_fence(__ATOMIC_ACQUIRE, "agent");
            xb_add(&bar[XB_XGEN(b.x)], 1u);
            asm volatile("s_waitcnt vmcnt(0)" ::: "memory");
        } else {
            XB_SPIN(xb_ld(&bar[XB_XGEN(b.x)]) == gen, bar);
            __builtin_amdgcn_fence(__ATOMIC_ACQUIRE, "agent");
            asm volatile("s_waitcnt vmcnt(0)" ::: "memory");
        }
    }
    __syncthreads();
}

namespace pg8 {
constexpr int BM = 256, BK = 64, HALF = 128, HTB = HALF * BK * 2, STAGE_BYTES = 8 * HTB, NXCD = 8, WGM = 8;
__host__ __device__ __forceinline__ int lds_byte(int r, int c) { const int st = (r >> 4) * 2 + (c >> 5), rr = r & 15, cc = c & 31, ob = rr * 64 + cc * 2; return st * 1024 + (ob ^ (((ob >> 9) & 1) << 5)); }
__host__ __device__ __forceinline__ void stage_rc(int b, int& R, int& C) { const int st = b / 1024, sb = b % 1024, swz = sb ^ (((sb >> 9) & 1) << 5); R = (st >> 1) * 16 + swz / 64; C = (st & 1) * 32 + (swz % 64) / 2; }
__host__ __device__ __forceinline__ int perm32(int rho) { const int n = rho >> 4, i = rho & 15; return 8 * (i >> 2) + 4 * n + (i & 3); }

struct Unit { int pm, pn; long aoff, boff; };
struct Gemm { const bf16_t* A; const bf16_t* Bt; int lda, ldb, K; };

struct OrderMN {
    int nM, nN, nwg, G, c, ashift; long astep, bstep, abytes;
    __device__ __forceinline__ int gather_row(const Unit&, int) const { return 0; }
    __device__ void init(int nM_, int nN_, int G_, int c_, long astep_, long bstep_, int ashift_ = 0, long abytes_ = 0) { nM = nM_; nN = nN_; nwg = nM * nN; G = G_; c = c_; astep = astep_; bstep = bstep_; ashift = ashift_; abytes = abytes_; }
    __device__ bool next(int i, Unit& u) const {
        const long L = (long)i * G + c; if (L >= nwg) return false;
        int wgid = (int)L; { const int q = nwg / NXCD, r = nwg % NXCD, xcd = wgid % NXCD, off = wgid / NXCD; wgid = (xcd < r ? xcd * (q + 1) : r * (q + 1) + (xcd - r) * q) + off; }
        const int nig = WGM * nN, gid = wgid / nig, fm = gid * WGM, gsz = (nM - fm) < WGM ? (nM - fm) : WGM;
        u.pm = fm + ((wgid % nig) % gsz); u.pn = (wgid % nig) / gsz;
        u.aoff = (long)u.pm * astep + (long)(u.pn >> ashift) * abytes; u.boff = (long)u.pn * bstep; return true;
    }
};
struct OrderMoE {
    const volatile LAS int* te; int Mt, nN, G, c; long astep, bstep, estep; const int* list;
    __device__ __forceinline__ int gather_row(const Unit& u, int r) const { const int e = te[u.pm], rb = te[160 + u.pm] + r; return rb < te[320 + u.pm] ? list[(size_t)e * T + rb] : 0; }
    __device__ bool next(int i, Unit& u) const {
        const long L = (long)i * G + c; if (L >= (long)Mt * nN) return false;
        u.pm = (int)(L / nN); u.pn = (int)(L % nN);
        u.aoff = (long)u.pm * astep; u.boff = (long)te[u.pm] * estep + (long)u.pn * bstep; return true;
    }
};

template <class Epi, class Sched, bool GATH = false, bool KEEPACC = false, bool ALIGN_EPI = true, bool SP2 = true>
__device__ __forceinline__ void gemm_phase(LAS unsigned char* lds, const Gemm g, const Sched& S, const Epi& E) {
    int tid_ = threadIdx.x; asm volatile("" : "+v"(tid_));
    const GAS bf16_t* gA = (const GAS bf16_t*)g.A; const GAS bf16_t* gB = (const GAS bf16_t*)g.Bt; asm volatile("" : "+s"(gA), "+s"(gB));
    const int tid = tid_, wid = __builtin_amdgcn_readfirstlane(tid >> 6), lane = tid & 63, wr = wid >> 2, wc = wid & 3, fr = lane & 15, fq = lane >> 4;
    const int K = g.K, nt = K / BK;
    unsigned voffA[2], voffB[2];
#pragma unroll
    for (int i = 0; i < 2; ++i) { int R, C; stage_rc(tid * 16 + i * 8192, R, C); const int Rb = Epi::PERM ? ((R & ~31) + perm32(R & 31)) : R;
        voffA[i] = (unsigned)(R * g.lda + C) * 2u; voffB[i] = (unsigned)(Rb * g.ldb + C) * 2u; }
    const size_t kstep = (size_t)(BK * 2);
    const size_t hstepA = GATH ? (size_t)0 : (size_t)HALF * g.lda * 2, hstepB = (size_t)HALF * g.ldb * 2;
    unsigned gAc[2][2], gAn[2][2]; int gR[2], gC[2];
#pragma unroll
    for (int i = 0; i < 2; ++i) { stage_rc(tid * 16 + i * 8192, gR[i], gC[i]); gAc[0][i] = gAc[1][i] = gAn[0][i] = gAn[1][i] = 0u; }
#define PG8_GLOAD(dst, un) do { _Pragma("unroll") for (int h_ = 0; h_ < 2; ++h_) _Pragma("unroll") for (int i_ = 0; i_ < 2; ++i_) \
        dst[h_][i_] = (unsigned)S.gather_row(un, h_ * HALF + gR[i_]) * (unsigned)(g.lda * 2) + (unsigned)(gC[i_] * 2); } while (0)
#define PG8_STAGE_A(bufoff, kptr, h, nx) do { if (GATH) { unsigned vo_[2]; vo_[0] = (nx) ? gAn[h][0] : gAc[h][0]; vo_[1] = (nx) ? gAn[h][1] : gAc[h][1]; PG8_STAGE(bufoff, kptr, vo_); } \
        else PG8_STAGE(bufoff, (kptr) + (h) * hstepA, voffA); } while (0)
    const unsigned ldsw = (unsigned)wid * 1024u;
    const int aoff = lds_byte(wr * 64 + fr, fq * 8), boff = lds_byte(wc * 32 + fr, fq * 8);
#define PG8_SA(b, h) (((b) * 2 + (h)) * HTB)
#define PG8_SB(b, h) ((4 + (b) * 2 + (h)) * HTB)
#define PG8_STAGE(bufoff, gbase, voff) do { _Pragma("unroll") for (int _i = 0; _i < 2; ++_i) \
        __builtin_amdgcn_global_load_lds((const GAS unsigned*)((gbase) + (voff)[_i]), (LAS unsigned*)(lds + (bufoff) + ldsw + _i * 8192), 16, 0, 0); } while (0)
#define PG8_LDA(dst, b, h) do { _Pragma("unroll") for (int m = 0; m < 4; ++m) _Pragma("unroll") for (int k = 0; k < 2; ++k) dst[m][k] = *(const LAS bf16x8*)(lds + PG8_SA(b, h) + aoff + m * 2048 + k * 1024); } while (0)
#define PG8_LDB(dst, b, h) do { _Pragma("unroll") for (int n = 0; n < 2; ++n) _Pragma("unroll") for (int k = 0; k < 2; ++k) dst[n][k] = *(const LAS bf16x8*)(lds + PG8_SB(b, h) + boff + n * 2048 + k * 1024); } while (0)
#define PG8_MMA(ai, bj, At, Bt) do { __builtin_amdgcn_s_setprio(1); _Pragma("unroll") for (int m = 0; m < 4; ++m) _Pragma("unroll") for (int n = 0; n < 2; ++n) _Pragma("unroll") for (int k = 0; k < 2; ++k) \
        acc[ai][bj][m][n] = __builtin_amdgcn_mfma_f32_16x16x32_bf16(Bt[n][k], At[m][k], acc[ai][bj][m][n], 0, 0, 0); __builtin_amdgcn_s_setprio(0); } while (0)
#define PG8_WAIT_V(n) asm volatile("s_waitcnt vmcnt(" #n ")" ::: "memory")
#define PG8_WAIT_L(n) asm volatile("s_waitcnt lgkmcnt(" #n ")" ::: "memory")
#define PG8_BAR __builtin_amdgcn_s_barrier()
#define PG8_SCHED __builtin_amdgcn_sched_barrier(0)
    Unit cur, nxt; int ui = 0;
    if (!S.next(0, cur)) return;
    f32x4 acc[2][2][4][2];
#pragma unroll
    for (int a = 0; a < 2; ++a)
#pragma unroll
        for (int b = 0; b < 2; ++b)
#pragma unroll
            for (int m = 0; m < 4; ++m)
#pragma unroll
                for (int n = 0; n < 2; ++n) acc[a][b][m][n] = (f32x4){0.f, 0.f, 0.f, 0.f};
    bf16x8 At[4][2], B0[2][2], B1[2][2];
    const GAS char* cA = (const GAS char*)gA + (GATH ? 0L : cur.aoff); const GAS char* cB = (const GAS char*)gB + cur.boff;
    if (GATH) PG8_GLOAD(gAc, cur);
    if constexpr (SP2) {
        PG8_STAGE(PG8_SB(0, 0), cB, voffB); PG8_STAGE(PG8_SB(0, 1), cB + hstepB, voffB); PG8_STAGE_A(PG8_SA(0, 0), cA, 0, false); PG8_STAGE_A(PG8_SA(0, 1), cA, 1, false);
        if (wr == 1) PG8_BAR;
        PG8_WAIT_V(2); PG8_BAR;
        PG8_STAGE(PG8_SB(1, 0), cB + kstep, voffB); PG8_STAGE_A(PG8_SA(1, 0), cA + kstep, 0, false); PG8_STAGE(PG8_SB(1, 1), cB + hstepB + kstep, voffB);
        PG8_WAIT_V(6); PG8_BAR;
    } else {
    PG8_STAGE(PG8_SB(0, 0), cB, voffB); PG8_STAGE_A(PG8_SA(0, 0), cA, 0, false); PG8_STAGE(PG8_SB(0, 1), cB + hstepB, voffB); PG8_STAGE_A(PG8_SA(0, 1), cA, 1, false);
    if (wr == 1) PG8_BAR;
    PG8_WAIT_V(4); PG8_BAR;
    PG8_STAGE(PG8_SB(1, 0), cB + kstep, voffB); PG8_STAGE_A(PG8_SA(1, 0), cA + kstep, 0, false); PG8_STAGE(PG8_SB(1, 1), cB + hstepB + kstep, voffB);
    PG8_WAIT_V(6); PG8_BAR;
    }
    for (;;) {
        const bool has_next = S.next(ui + 1, nxt);
        const GAS char* nA = (has_next && !GATH) ? (const GAS char*)gA + nxt.aoff : cA; const GAS char* nB = has_next ? (const GAS char*)gB + nxt.boff : cB;
        if (GATH) { if (has_next) PG8_GLOAD(gAn, nxt); else { gAn[0][0] = gAc[0][0]; gAn[0][1] = gAc[0][1]; gAn[1][0] = gAc[1][0]; gAn[1][1] = gAc[1][1]; } }
        for (int t = 0; t < nt; t += 2) {
            const bool last = (t == nt - 2);
            const GAS char* a1 = cA + (size_t)(t + 1) * kstep;
            const GAS char* a2 = last ? nA : cA + (size_t)(t + 2) * kstep; const GAS char* b2 = last ? nB : cB + (size_t)(t + 2) * kstep;
            const GAS char* a3 = a2 + kstep; const GAS char* b3 = b2 + kstep;
            if constexpr (SP2) {
            PG8_LDB(B0, 0, 0); PG8_LDB(B1, 0, 1); PG8_SCHED; PG8_LDA(At, 0, 0); PG8_STAGE_A(PG8_SA(1, 1), a1, 1, false);
            PG8_WAIT_V(8); PG8_WAIT_L(0); PG8_BAR; PG8_MMA(0, 0, At, B0); PG8_MMA(0, 1, At, B1); PG8_BAR; PG8_SCHED;
            PG8_LDA(At, 0, 1); PG8_STAGE(PG8_SB(0, 0), b2, voffB); PG8_STAGE(PG8_SB(0, 1), b2 + hstepB, voffB); PG8_STAGE_A(PG8_SA(0, 0), a2, 0, last);
            PG8_WAIT_V(8); PG8_WAIT_L(0); PG8_BAR; PG8_MMA(1, 0, At, B0); PG8_MMA(1, 1, At, B1); PG8_BAR; PG8_SCHED;
            PG8_LDB(B0, 1, 0); PG8_LDB(B1, 1, 1); PG8_SCHED; PG8_LDA(At, 1, 0); PG8_STAGE_A(PG8_SA(0, 1), a2, 1, last);
            PG8_WAIT_V(8); PG8_WAIT_L(0); PG8_BAR; PG8_MMA(0, 0, At, B0); PG8_MMA(0, 1, At, B1); PG8_BAR; PG8_SCHED;
            PG8_LDA(At, 1, 1); PG8_STAGE(PG8_SB(1, 0), b3, voffB); PG8_STAGE(PG8_SB(1, 1), b3 + hstepB, voffB); PG8_STAGE_A(PG8_SA(1, 0), a3, 0, last);
            PG8_WAIT_V(8); PG8_WAIT_L(0); PG8_BAR; PG8_MMA(1, 0, At, B0); PG8_MMA(1, 1, At, B1); PG8_BAR; PG8_SCHED;
            } else {
            PG8_LDB(B0, 0, 0); PG8_SCHED; PG8_LDA(At, 0, 0); PG8_STAGE_A(PG8_SA(1, 1), a1, 1, false);
            PG8_WAIT_L(8); PG8_BAR; PG8_WAIT_L(0); PG8_MMA(0, 0, At, B0); PG8_BAR; PG8_SCHED;
            PG8_LDB(B1, 0, 1); PG8_STAGE(PG8_SB(0, 0), b2, voffB);
            PG8_BAR; PG8_WAIT_L(0); PG8_MMA(0, 1, At, B1); PG8_BAR;
            PG8_LDA(At, 0, 1); PG8_STAGE_A(PG8_SA(0, 0), a2, 0, last);
            PG8_BAR; PG8_WAIT_L(0); PG8_MMA(1, 0, At, B0); PG8_BAR; PG8_SCHED;
            PG8_STAGE(PG8_SB(0, 1), b2 + hstepB, voffB);
            PG8_WAIT_V(6); PG8_BAR; PG8_MMA(1, 1, At, B1); PG8_BAR;
            PG8_LDB(B0, 1, 0); PG8_SCHED; PG8_LDA(At, 1, 0); PG8_STAGE_A(PG8_SA(0, 1), a2, 1, last);
            PG8_WAIT_L(8); PG8_BAR; PG8_WAIT_L(0); PG8_MMA(0, 0, At, B0); PG8_BAR; PG8_SCHED;
            PG8_LDB(B1, 1, 1); PG8_STAGE(PG8_SB(1, 0), b3, voffB);
            PG8_BAR; PG8_WAIT_L(0); PG8_MMA(0, 1, At, B1); PG8_BAR;
            PG8_LDA(At, 1, 1); PG8_STAGE_A(PG8_SA(1, 0), a3, 0, last);
            PG8_BAR; PG8_WAIT_L(0); PG8_MMA(1, 0, At, B0); PG8_BAR; PG8_SCHED;
            PG8_STAGE(PG8_SB(1, 1), b3 + hstepB, voffB);
            PG8_WAIT_V(6); PG8_BAR; PG8_MMA(1, 1, At, B1); PG8_BAR;
            }
        }
        if constexpr (ALIGN_EPI) { if (wr == 0) PG8_BAR; }
        bool zero_acc = true;
        if constexpr (KEEPACC) zero_acc = E.run(acc, cur, wr, wc, fr, fq);
        else E(acc, cur, wr, wc, fr, fq);
        if (!has_next) break;
        if (zero_acc)
#pragma unroll
        for (int a = 0; a < 2; ++a)
#pragma unroll
            for (int b = 0; b < 2; ++b)
#pragma unroll
                for (int m = 0; m < 4; ++m)
#pragma unroll
                    for (int n = 0; n < 2; ++n) acc[a][b][m][n] = (f32x4){0.f, 0.f, 0.f, 0.f};
        cur = nxt; cA = nA; cB = nB; ++ui;
        if (GATH) { gAc[0][0] = gAn[0][0]; gAc[0][1] = gAn[0][1]; gAc[1][0] = gAn[1][0]; gAc[1][1] = gAn[1][1]; }
        if constexpr (ALIGN_EPI) { if (wr == 1) PG8_BAR; }
    }
    PG8_WAIT_V(0);
    if constexpr (!ALIGN_EPI) { if (wr == 0) PG8_BAR; }
    PG8_BAR;
#undef PG8_SA
#undef PG8_SB
#undef PG8_STAGE
#undef PG8_STAGE_A
#undef PG8_GLOAD
#undef PG8_LDA
#undef PG8_LDB
#undef PG8_MMA
#undef PG8_WAIT_V
#undef PG8_WAIT_L
#undef PG8_BAR
#undef PG8_SCHED
}

typedef const f32x4 (&AccT)[2][2][4][2];
template <int ACT> __device__ __forceinline__ void store_tile_bf16(AccT acc, bf16_t* O, int ld, int row0, int colb, float scale) {
#pragma unroll
    for (int ai = 0; ai < 2; ++ai)
#pragma unroll
        for (int m = 0; m < 4; ++m) { bf16_t* rowp = O + (size_t)(row0 + ai * HALF + m * 16) * ld + colb;
#pragma unroll
            for (int bj = 0; bj < 2; ++bj) { const f32x4 v0 = act4<ACT>(acc[ai][bj][m][0] * scale), v1 = act4<ACT>(acc[ai][bj][m][1] * scale);
                *(u32x4*)(rowp + bj * HALF) = pack8(v0, v1); }
            asm volatile("" ::: "memory"); }
}
template <int ACT> struct EpiStore {
    static constexpr bool PERM = true;
    bf16_t* O; int ld; float scale;
    __device__ __forceinline__ void operator()(AccT acc, const Unit& u, int wr, int wc, int fr, int fq) const {
        store_tile_bf16<ACT>(acc, O, ld, u.pm * BM + wr * 64 + fr, u.pn * BM + wc * 32 + 8 * fq, scale);
    }
};
struct EpiInProj {
    static constexpr bool PERM = true;
    unsigned char* ws;
    __device__ __forceinline__ void operator()(AccT acc, const Unit& u, int wr, int wc, int fr, int fq) const {
        const int pn = u.pn, row0 = u.pm * BM + wr * 64 + fr, cw = wc * 32 + 8 * fq;
        unsigned char* pj = ws + WS_PROJ;
        bf16_t *rq = (bf16_t*)(pj + P_RQ), *rk = (bf16_t*)(pj + P_RK), *rv = (bf16_t*)(pj + P_RV), *rg = (bf16_t*)(pj + P_RG), *gu = (bf16_t*)(pj + P_GU), *gv = (bf16_t*)(pj + P_GV), *dq = (bf16_t*)(pj + P_DQ),
               *iq = (bf16_t*)(pj + P_IQ), *ik = (bf16_t*)(pj + P_IK), *ga = (bf16_t*)(pj + P_GA), *gb = (bf16_t*)(pj + P_GB), *gc = (bf16_t*)(pj + P_GC);
        float *dcraw = (float*)(pj + P_DC), *iw = (float*)(pj + P_IW), *gvstats = (float*)(ws + WS_STATS); const float* rope = (const float*)(ws + WS_ROPE);
        if (pn < 8) {
            const bool isk = pn >= 4; bf16_t* dst = (isk ? rk : rq) + (pn & 3) * 256 + cw; const float sc = isk ? 0.0625f : 1.0f;
#pragma unroll
            for (int ai = 0; ai < 2; ++ai) { f32x4 csq[4][4];
#pragma unroll
                for (int m = 0; m < 4; ++m) { const int pos = (row0 + ai * HALF + m * 16) & (SEQ - 1); const f32x4* cs = (const f32x4*)(rope + ((size_t)pos * 128 + cw) * 2);
#pragma unroll
                    for (int q4 = 0; q4 < 4; ++q4) csq[m][q4] = cs[q4]; }
                asm volatile("" ::: "memory");
#pragma unroll
                for (int m = 0; m < 4; ++m) { const int row = row0 + ai * HALF + m * 16;
                    f32x4 o1[2], o2[2];
#pragma unroll
                    for (int n = 0; n < 2; ++n) { const f32x4 c01 = csq[m][2 * n], c23 = csq[m][2 * n + 1]; const f32x4 x1 = acc[ai][0][m][n], x2 = acc[ai][1][m][n];
                        const float co[4] = {c01[0], c01[2], c23[0], c23[2]}, si[4] = {c01[1], c01[3], c23[1], c23[3]};
#pragma unroll
                        for (int j = 0; j < 4; ++j) { o1[n][j] = (x1[j] * co[j] - x2[j] * si[j]) * sc; o2[n][j] = (x1[j] * si[j] + x2[j] * co[j]) * sc; } }
                    bf16_t* rp = dst + (size_t)row * 1024;
                    *(u32x4*)rp = pack8(o1[0], o1[1]); *(u32x4*)(rp + 128) = pack8(o2[0], o2[1]); }
                asm volatile("" ::: "memory"); }
        } else if (pn < 12) { store_tile_bf16<0>(acc, rv, 1024, row0, (pn - 8) * 256 + cw, 1.f);
        } else if (pn < 16) { store_tile_bf16<2>(acc, rg, 1024, row0, (pn - 12) * 256 + cw, 1.f);
        } else if (pn < 20) { store_tile_bf16<1>(acc, gu, 1024, row0, (pn - 16) * 256 + cw, 1.f);
        } else if (pn < 24) {
            const int t4 = pn - 20; bf16_t* dst = gv + t4 * 256 + cw;
#pragma unroll
            for (int ai = 0; ai < 2; ++ai)
#pragma unroll
                for (int m = 0; m < 4; ++m) { const int row = row0 + ai * HALF + m * 16; float s = 0.f, q = 0.f;
#pragma unroll
                    for (int bj = 0; bj < 2; ++bj) { const f32x4 v0 = act4<1>(acc[ai][bj][m][0]), v1 = act4<1>(acc[ai][bj][m][1]);
                        *(u32x4*)(dst + (size_t)row * 1024 + bj * HALF) = pack8(v0, v1);
#pragma unroll
                        for (int j = 0; j < 4; ++j) { s += v0[j] + v1[j]; q += v0[j] * v0[j] + v1[j] * v1[j]; } }
                    s = quad_sum(s); q = quad_sum(q);
                    if (fq == 0) *(f32x2*)(gvstats + ((size_t)row * 16 + t4 * 4 + wc) * 2) = (f32x2){s, q}; asm volatile("" ::: "memory"); }
        } else if (pn < 28) { store_tile_bf16<0>(acc, dq, 1024, row0, (pn - 24) * 256 + cw, 1.f);
        } else if (pn == 28) {
#pragma unroll
            for (int ai = 0; ai < 2; ++ai)
#pragma unroll
                for (int m = 0; m < 4; ++m) { float* rp = dcraw + (size_t)(row0 + ai * HALF + m * 16) * 256 + cw;
#pragma unroll
                    for (int bj = 0; bj < 2; ++bj) { *(f32x4*)(rp + bj * HALF) = acc[ai][bj][m][0]; *(f32x4*)(rp + bj * HALF + 4) = acc[ai][bj][m][1]; } }
        } else if (pn < 31) { store_tile_bf16<0>(acc, iq, 512, row0, (pn - 29) * 256 + cw, 1.f);
        } else if (pn == 31) {
#pragma unroll
            for (int ai = 0; ai < 2; ++ai)
#pragma unroll
                for (int m = 0; m < 4; ++m) { const int row = row0 + ai * HALF + m * 16;
                    if (wc < 2) *(u32x4*)(ik + (size_t)row * 64 + cw) = pack8(acc[ai][0][m][0], acc[ai][0][m][1]);
                    if (wc == 2 && fq == 0) { *(f32x4*)(iw + (size_t)row * 8) = acc[ai][0][m][0] * 0.35355339059f; *(f32x4*)(iw + (size_t)row * 8 + 4) = acc[ai][0][m][1] * 0.35355339059f; } }
        } else { const int gi = (pn - 32) >> 3; bf16_t* dst = gi == 0 ? ga : (gi == 1 ? gb : gc);
            store_tile_bf16<3>(acc, dst, 2048, row0, ((pn - 32) & 7) * 256 + cw, 1.f); }
    }
};
typedef f32x4 (&AccM)[2][2][4][2];
struct EpiBranch {
    static constexpr bool PERM = true;
    const bf16_t* gate0; bf16_t* merged;
    __device__ __forceinline__ bool run(AccM acc, const Unit& u, int wr, int wc, int fr, int fq) const {
        const int br = u.pn >> 8; const bf16_t* gate = gate0 + (size_t)br * (32u << 20); const bf16_t* gnx = gate + (32u << 20);
        const int row0 = u.pm * BM + wr * 64 + fr, colb = (u.pn & 255) * BM + wc * 32 + 8 * fq;
#pragma unroll
        for (int ai = 0; ai < 2; ++ai) {
            u32x4 gq[4][2], nq[4][2];
#pragma unroll
            for (int m = 0; m < 4; ++m)
#pragma unroll
                for (int bj = 0; bj < 2; ++bj) { const size_t ro = (size_t)(row0 + ai * HALF + m * 16) * 2048 + colb + bj * HALF; gq[m][bj] = *(const u32x4*)(gate + ro); nq[m][bj] = *(const u32x4*)((br < 2 ? gnx : gate) + ro); }
            asm volatile("" ::: "memory");
#pragma unroll
            for (int m = 0; m < 4; ++m)
#pragma unroll
                for (int bj = 0; bj < 2; ++bj) { float g8[8], n8[8]; unpack8(gq[m][bj], g8); unpack8(nq[m][bj], n8);
                    f32x4 a0 = acc[ai][bj][m][0], a1 = acc[ai][bj][m][1];
                    if (br < 2) {
#pragma unroll
                        for (int j = 0; j < 4; ++j) { a0[j] *= g8[j] * __builtin_amdgcn_rcpf(fmaxf(n8[j], 1e-30f)); a1[j] *= g8[4 + j] * __builtin_amdgcn_rcpf(fmaxf(n8[4 + j], 1e-30f)); }
                        acc[ai][bj][m][0] = a0; acc[ai][bj][m][1] = a1;
                    } else {
#pragma unroll
                        for (int j = 0; j < 4; ++j) { a0[j] *= g8[j]; a1[j] *= g8[4 + j]; }
                        *(u32x4*)(merged + (size_t)(row0 + ai * HALF + m * 16) * 2048 + colb + bj * HALF) = pack8(a0, a1); } }
            asm volatile("" ::: "memory");
        }
        return br == 2;
    }
};
struct EpiResid {
    static constexpr bool PERM = false;
    const float* xsrc; float* xdst;
    __device__ __forceinline__ void operator()(AccT acc, const Unit& u, int wr, int wc, int fr, int fq) const {
        const int row0 = u.pm * BM + wr * 64 + fr, col0 = u.pn * BM + wc * 32 + 4 * fq;
#pragma unroll
        for (int ai = 0; ai < 2; ++ai)
#pragma unroll
            for (int mp = 0; mp < 2; ++mp) { f32x4 xv[2][2][2];
#pragma unroll
                for (int mm = 0; mm < 2; ++mm)
#pragma unroll
                    for (int bj = 0; bj < 2; ++bj)
#pragma unroll
                        for (int n = 0; n < 2; ++n) xv[mm][bj][n] = *(const f32x4*)(xsrc + (size_t)(row0 + ai * HALF + (2 * mp + mm) * 16) * DM + col0 + bj * HALF + n * 16);
                asm volatile("" ::: "memory");
#pragma unroll
                for (int mm = 0; mm < 2; ++mm)
#pragma unroll
                    for (int bj = 0; bj < 2; ++bj)
#pragma unroll
                        for (int n = 0; n < 2; ++n) *(f32x4*)(xdst + (size_t)(row0 + ai * HALF + (2 * mp + mm) * 16) * DM + col0 + bj * HALF + n * 16) = xv[mm][bj][n] + acc[ai][bj][2 * mp + mm][n];
                asm volatile("" ::: "memory"); }
    }
};
struct EpiMoeUp {
    static constexpr bool PERM = true;
    bf16_t* hid;
    __device__ __forceinline__ void operator()(AccT acc, const Unit& u, int wr, int wc, int fr, int fq) const {
        const int row0 = u.pm * BM + wr * 64 + fr, colb = u.pn * 128 + wc * 32 + 8 * fq;
#pragma unroll
        for (int ai = 0; ai < 2; ++ai)
#pragma unroll
            for (int m = 0; m < 4; ++m) { f32x4 r0, r1; const f32x4 a0 = acc[ai][0][m][0], a1 = acc[ai][0][m][1], b0 = acc[ai][1][m][0], b1 = acc[ai][1][m][1];
#pragma unroll
                for (int j = 0; j < 4; ++j) { r0[j] = siluf_(a0[j]) * b0[j]; r1[j] = siluf_(a1[j]) * b1[j]; }
                *(u32x4*)(hid + (size_t)(row0 + ai * HALF + m * 16) * FF + colb) = pack8(r0, r1); }
    }
};
struct OrderBranch {
    OrderMN base; long astride, bstride;
    __device__ __forceinline__ int gather_row(const Unit&, int) const { return 0; }
    __device__ bool next(int i, Unit& u) const { if (!base.next(i / 3, u)) return false; const int br = i % 3; u.aoff += br * astride; u.boff += br * bstride; u.pn |= br << 8; return true; }
};
struct OrderRouter {
    int G, c; long hlo_off;
    __device__ __forceinline__ int gather_row(const Unit&, int) const { return 0; }
    __device__ bool next(int i, Unit& u) const { const int L = i * G + c; if (L >= 256) return false; const int pm = L >> 2, which = (L >> 1) & 1, kh = L & 1;
        u.pm = pm; u.pn = which * 2 + kh; u.aoff = (long)pm * 256 * DM * 2 + (long)which * hlo_off + (long)kh * 1024 * 2; u.boff = (long)kh * 1024 * 2; return true; }
};
struct EpiRouter {
    static constexpr bool PERM = false;
    float* LOG;
    __device__ __forceinline__ void operator()(AccT acc, const Unit& u, int wr, int wc, int fr, int fq) const {
        float* base = LOG + ((size_t)u.pn * T + (size_t)u.pm * BM + wr * 64 + fr) * 128 + wc * 32 + 4 * fq;
#pragma unroll
        for (int ai = 0; ai < 2; ++ai)
#pragma unroll
            for (int m = 0; m < 4; ++m)
#pragma unroll
                for (int n = 0; n < 2; ++n) *(f32x4*)(base + (size_t)(ai * HALF + m * 16) * 128 + n * 16) = acc[ai][0][m][n];
    }
};
}

struct Args { const float* in[23]; float* out; unsigned char* ws; int ph_lo, ph_hi; };
enum { I_X = 0, I_NMIX, I_WIN, I_WRET, I_LNG, I_LNB, I_WS, I_BS, I_WGM, I_KVG, I_WUK, I_WUV, I_WDS, I_WOUT, I_NFFN, I_WGRP, I_BGRP, I_WEXP, I_BEXP, I_W1, I_W3, I_W2, I_FNG };
struct Ctx {
    LAS unsigned char* lds; volatile LAS int* misc; unsigned* ctl; GAS unsigned char* ws;
    int tid, lane, wave, G, bid, gw, NGW;
    const float* const* in; float* out;
};
#define WSP(T_, off) ((T_*)(C.ws + (off)))
__device__ __forceinline__ void refresh(Ctx& C) { int t = threadIdx.x; asm volatile("" : "+v"(t)); C.tid = t; C.lane = t & 63;
    GAS unsigned char* w = C.ws; asm volatile("" : "+s"(w)); C.ws = w; C.ctl = (unsigned*)w; }

__device__ __forceinline__ void ph_rope(const Ctx& C) {
    float* rope = WSP(float, WS_ROPE);
    const double r1 = 0.9305720409296989;
    for (int idx = C.bid * 512 + C.tid; idx < SEQ * 128; idx += C.G * 512) {
        const int pos = idx >> 7, i = idx & 127;
        double inv = 1.0, b = r1; int e = i;
        while (e) { if (e & 1) inv *= b; b *= b; e >>= 1; }
        const double ang = (double)pos * inv;
        const double n = __builtin_rint(ang * 0.15915494309189533577);
        const double x = ang - n * 6.283185307179586476925;
        const double x2 = x * x;
        double s = 0.0, c = 0.0;
#pragma unroll 1
        for (int k = 14; k >= 1; --k) { s = (s + 1.0) * (-x2 / (double)((2 * k) * (2 * k + 1))); c = (c + 1.0) * (-x2 / (double)((2 * k - 1) * (2 * k))); }
        s = (s + 1.0) * x; c = c + 1.0;
        *(f32x2*)(rope + (size_t)idx * 2) = (f32x2){(float)c, (float)s};
    }
}

struct WItem { const float* src; bf16_t* dst; int srcld, dstld, k0, n0, mode; long off; };
__device__ __forceinline__ WItem w_item(const Ctx& C, int l, int r) {
    unsigned char* wb = (unsigned char*)(C.ws + WS_W); WItem w; w.mode = 0; w.off = 0;
    constexpr int N_IN = 32 * 224, N_BR = 16 * 32, N_OUT = 32 * 32, N_13 = 32 * 32 * 16, N_2 = 32 * 8 * 32;
    if (r < N_IN) { const int kb = r / 224, nb = r % 224; w.src = C.in[I_WIN] + (size_t)l * DM * INW; w.srcld = INW; w.dst = (bf16_t*)(wb + W_IN); w.dstld = DM; w.k0 = kb * 64; w.n0 = nb * 64; w.mode = 1; return w; } r -= N_IN;
    if (r < 3 * N_BR) { const int ww = r / N_BR, q = r % N_BR, kb = q / 32, nb = q % 32; w.src = C.in[ww == 0 ? I_WRET : (ww == 1 ? I_WGM : I_WDS)] + (size_t)l * 1024 * DM; w.srcld = DM;
        w.dst = (bf16_t*)(wb + (ww == 0 ? W_RET : (ww == 1 ? W_GM : W_DS))); w.dstld = 1024; w.k0 = kb * 64; w.n0 = nb * 64; return w; } r -= 3 * N_BR;
    if (r < N_OUT) { const int kb = r / 32, nb = r % 32; w.src = C.in[I_WOUT] + (size_t)l * DM * DM; w.srcld = DM; w.dst = (bf16_t*)(wb + W_OUT); w.dstld = DM; w.k0 = kb * 64; w.n0 = nb * 64; return w; } r -= N_OUT;
    if (r < N_13) { const int e = r / 512, q = r % 512, kb = q / 16, nb = q % 16, row0 = nb * 64, j = row0 >> 8, sft = (row0 >> 7) & 1, fp = row0 & 127;
        w.src = C.in[sft ? I_W3 : I_W1] + ((size_t)l * NEXP + e) * DM * FF; w.srcld = FF; w.dst = (bf16_t*)(wb + W_13) + (size_t)e * 1024 * DM; w.dstld = DM; w.k0 = kb * 64; w.n0 = row0; w.off = (long)(128 * j + fp) - row0; return w; } r -= N_13;
    if (r < N_2) { const int e = r / 256, q = r % 256, kb = q / 32, nb = q % 32; w.src = C.in[I_W2] + ((size_t)l * NEXP + e) * FF * DM; w.srcld = DM; w.dst = (bf16_t*)(wb + W_2) + (size_t)e * DM * FF; w.dstld = FF; w.k0 = kb * 64; w.n0 = nb * 64; return w; } r -= N_2;
    { const int h = r / 8, q = r % 8, kb = q / 2, nb = q % 2;
      w.src = C.in[I_WUV] + ((size_t)l * 8 + h) * 256 * 128; w.srcld = 128; w.dst = (bf16_t*)(wb + W_UV) + (size_t)(h * 128) * 512 + (h & 1) * 256; w.dstld = 512; w.k0 = kb * 64; w.n0 = nb * 64; return w; }
}
__device__ __forceinline__ void w_load(const WItem& w, int lane, f32x4 (&R)[16]) {
    const int nq = lane & 15, kq = lane >> 4, n = w.n0 + 4 * nq;
    const long sc = (w.mode == 1) ? (n < GATE_SRC0 ? (long)n : (n < GATE_DST0 ? -1L : (long)(n - (GATE_DST0 - GATE_SRC0)))) : (long)n + w.off;
    const float* p = w.src + (size_t)(w.k0 + 2 * kq) * w.srcld + (sc >= 0 ? sc : 0);
#pragma unroll
    for (int i = 0; i < 8; ++i)
#pragma unroll
        for (int s2 = 0; s2 < 2; ++s2) { f32x4 v = __builtin_nontemporal_load((const f32x4*)(p + (size_t)(8 * i + s2) * w.srcld)); if (sc < 0) v = (f32x4){0.f, 0.f, 0.f, 0.f}; R[2 * i + s2] = v; }
}
__device__ __forceinline__ void w_store(const WItem& w, int lane, const f32x4 (&R)[16], LAS unsigned* scr) {
    const int nq = lane & 15, kq = lane >> 4;
#pragma unroll
    for (int i = 0; i < 8; ++i)
#pragma unroll
        for (int e = 0; e < 4; ++e) scr[(4 * nq + e) * 33 + 4 * i + kq] = cvt_pk_bf16(R[2 * i][e], R[2 * i + 1][e]);
    asm volatile("s_waitcnt lgkmcnt(0)" ::: "memory");
    const int c = lane & 7;
#pragma unroll
    for (int j = 0; j < 8; ++j) { const int n = (lane >> 3) + 8 * j; const LAS unsigned* sp = scr + n * 33 + 4 * c;
        u32x4 o; o.x = sp[0]; o.y = sp[1]; o.z = sp[2]; o.w = sp[3];
        *(u32x4*)(w.dst + (size_t)(w.n0 + n) * w.dstld + w.k0 + 8 * c) = o; }
    asm volatile("s_waitcnt lgkmcnt(0)" ::: "memory");
}
__device__ __forceinline__ void ph_weights(const Ctx& C, int l) {
    LAS unsigned* scr = (LAS unsigned*)(C.lds + C.wave * 16384);
    unsigned char* wb = (unsigned char*)(C.ws + WS_W);
    constexpr int NITEMS = 32 * 224 + 3 * 16 * 32 + 32 * 32 + 32 * 32 * 16 + 32 * 8 * 32 + 8 * 8;
    { int it = C.gw; f32x4 R[16], Rn[16]; WItem w, wn;
      if (it < NITEMS) { w = w_item(C, l, it); w_load(w, C.lane, R); }
#pragma unroll 1
      while (it < NITEMS) { const int itn = it + C.NGW;
          if (itn < NITEMS) { wn = w_item(C, l, itn); w_load(wn, C.lane, Rn); }
          w_store(w, C.lane, R, scr);
#pragma unroll
          for (int i = 0; i < 16; ++i) R[i] = Rn[i];
          w = wn; it = itn; } }
    bf16_t* uv = (bf16_t*)(wb + W_UV); bf16_t* uk = (bf16_t*)(wb + W_UK); const float* wuk = C.in[I_WUK] + (size_t)l * 8 * 256 * 128;
    for (int idx = C.bid * 512 + C.tid; idx < 1024 * 256 / 8; idx += C.G * 512) { const int row = idx >> 5, c8 = (idx & 31) * 8, h = row >> 7;
        *(u32x4*)(uv + (size_t)row * 512 + (1 - (h & 1)) * 256 + c8) = (u32x4){0u, 0u, 0u, 0u}; }
    for (int idx = C.bid * 512 + C.tid; idx < 2048 * 256 / 8; idx += C.G * 512) { const int row = idx >> 5, c8 = (idx & 31) * 8, h = row >> 8, half = c8 >> 7;
        u32x4 o = (u32x4){0u, 0u, 0u, 0u};
        if (half == (h & 1)) { const float* s = wuk + (size_t)row * 128 + (c8 & 127); const f32x4 a = *(const f32x4*)s, b = *(const f32x4*)(s + 4); o = pack8(a, b); }
        *(u32x4*)(uk + (size_t)row * 256 + c8) = o; }
    bf16_t* rt = (bf16_t*)(wb + W_RT); const float* wgr = C.in[I_WGRP] + (size_t)l * DM * 4; const float* wex = C.in[I_WEXP] + (size_t)l * 4 * DM * 8;
    for (int idx = C.bid * 512 + C.tid; idx < 256 * 256; idx += C.G * 512) { const int r = idx >> 8, k8 = (idx & 255) * 8, c = r & 63, part = r >> 6;
        u32x4 o = (u32x4){0u, 0u, 0u, 0u};
        if (part < 2 && c < 36) { float v[8];
#pragma unroll
            for (int j = 0; j < 8; ++j) { const float wv = (c < 4) ? wgr[(size_t)(k8 + j) * 4 + c] : wex[((size_t)((c - 4) >> 3) * DM + (k8 + j)) * 8 + ((c - 4) & 7)];
                const float hi = bf2f(f2bf(wv)); v[j] = part == 0 ? hi : (wv - hi); }
            o = pack8((f32x4){v[0], v[1], v[2], v[3]}, (f32x4){v[4], v[5], v[6], v[7]}); }
        *(u32x4*)(rt + (size_t)r * DM + k8) = o; }
}

__device__ __forceinline__ void ph_norm(const Ctx& C, const float* x, const float* g, bf16_t* H) {
    for (int row = C.gw; row < T; row += C.NGW) {
        const f32x4* xr = (const f32x4*)(x + (size_t)row * DM) + C.lane; f32x4 v[8]; float ss = 0.f;
#pragma unroll
        for (int j = 0; j < 8; ++j) { v[j] = xr[64 * j]; ss += v[j][0] * v[j][0] + v[j][1] * v[j][1] + v[j][2] * v[j][2] + v[j][3] * v[j][3]; }
        const float rstd = rsqrtf(wave_sum(ss, C.lane) * (1.f / DM) + EPS);
        u32x2* o = (u32x2*)(H + (size_t)row * DM) + C.lane;
#pragma unroll
        for (int j = 0; j < 8; ++j) { const f32x4 gg = ((const f32x4*)g)[64 * j + C.lane]; const f32x4 y = v[j] * rstd * gg; u32x2 w; w.x = cvt_pk_bf16(y[0], y[1]); w.y = cvt_pk_bf16(y[2], y[3]); o[64 * j] = w; }
    }
}
__device__ __forceinline__ void ph_ckv(const Ctx& C, const float* dcraw, const float* g, bf16_t* ckv) {
    for (int row = C.gw; row < T; row += C.NGW) {
        const f32x4 v = ((const f32x4*)(dcraw + (size_t)row * 256))[C.lane];
        const float ss = wave_sum(v[0] * v[0] + v[1] * v[1] + v[2] * v[2] + v[3] * v[3], C.lane);
        const float rstd = rsqrtf(ss * (1.f / 256.f) + EPS); const f32x4 y = v * rstd * ((const f32x4*)g)[C.lane];
        u32x2 w; w.x = cvt_pk_bf16(y[0], y[1]); w.y = cvt_pk_bf16(y[2], y[3]); ((u32x2*)(ckv + (size_t)row * 256))[C.lane] = w;
    }
}

typedef short v4i16_t __attribute__((ext_vector_type(4)));
__device__ __forceinline__ s16x4 tr_read(const LAS unsigned char* p) { return __builtin_bit_cast(s16x4, __builtin_amdgcn_ds_read_tr16_b64_v4i16((LAS v4i16_t*)p)); }
__device__ __forceinline__ bf16x8 tr_frag(const LAS unsigned char* X, int LDX, int rowA, int rowB, int n0, int lane) {
    const int q = (lane & 15) >> 2, p = lane & 3;
    const s16x4 lo = tr_read(X + (rowA + q) * LDX + (n0 + 4 * p) * 2), hi = tr_read(X + (rowB + q) * LDX + (n0 + 4 * p) * 2);
    return (bf16x8){lo[0], lo[1], lo[2], lo[3], hi[0], hi[1], hi[2], hi[3]};
}
constexpr int TLD = 544;
__device__ __forceinline__ bf16x8 as_bf16x8(u32x4 w) { return __builtin_bit_cast(bf16x8, w); }

__device__ __forceinline__ void ph_ret_kv(const Ctx& C) {
    const bf16_t* rk = WSP(bf16_t, WS_PROJ + P_RK); const bf16_t* rv = WSP(bf16_t, WS_PROJ + P_RV); bf16_t* KV = WSP(bf16_t, WS_KV);
    const LAS unsigned char* Vt = C.lds; const LAS unsigned char* Kt = C.lds + 128 * TLD;
    const int g = C.lane >> 4, fr = C.lane & 15, wr = C.wave >> 2, wc = C.wave & 3;
    for (int u = C.bid; u < 512; u += C.G) {
        const int n = u & 31, h = (u >> 5) & 3, b = u >> 7; const size_t row0 = (size_t)b * SEQ + n * 128;
        const float lg2 = log2f(1.0f - exp2f(-5.0f - (float)h));
        __syncthreads();
#pragma unroll
        for (int p = 0; p < 8; ++p) { const int idx = p * 512 + C.tid, row = idx >> 5, ch = idx & 31; const size_t go = (row0 + row) * 1024 + h * 256 + ch * 8;
            const u32x4 vv = *(const u32x4*)(rv + go); *(LAS u32x4*)(C.lds + row * TLD + ch * 16) = vv;
            float f[8]; unpack8(*(const u32x4*)(rk + go), f); const float z = exp2f(lg2 * (float)(127 - row));
            *(LAS u32x4*)(C.lds + 128 * TLD + row * TLD + ch * 16) = pack8((f32x4){f[0] * z, f[1] * z, f[2] * z, f[3] * z}, (f32x4){f[4] * z, f[5] * z, f[6] * z, f[7] * z}); }
        __syncthreads();
        f32x4 acc[8][4];
#pragma unroll
        for (int m = 0; m < 8; ++m)
#pragma unroll
            for (int nn = 0; nn < 4; ++nn) acc[m][nn] = (f32x4){0.f, 0.f, 0.f, 0.f};
#pragma unroll 1
        for (int ks = 0; ks < 4; ++ks) { bf16x8 Bv[4];
#pragma unroll
            for (int nn = 0; nn < 4; ++nn) Bv[nn] = tr_frag(Vt, TLD, 32 * ks + 8 * g, 32 * ks + 8 * g + 4, 64 * wc + 16 * nn, C.lane);
#pragma unroll
            for (int m = 0; m < 8; ++m) { const bf16x8 Ak = tr_frag(Kt, TLD, 32 * ks + 8 * g, 32 * ks + 8 * g + 4, 128 * wr + 16 * m, C.lane);
#pragma unroll
                for (int nn = 0; nn < 4; ++nn) acc[m][nn] = __builtin_amdgcn_mfma_f32_16x16x32_bf16(Ak, Bv[nn], acc[m][nn], 0, 0, 0); } }
        bf16_t* out = KV + (size_t)u * 65536;
#pragma unroll
        for (int m = 0; m < 8; ++m)
#pragma unroll
            for (int nn = 0; nn < 4; ++nn) { const int e = 64 * wc + 16 * nn + fr, d = 128 * wr + 16 * m + 4 * g; u32x2 w; w.x = cvt_pk_bf16(acc[m][nn][0], acc[m][nn][1]); w.y = cvt_pk_bf16(acc[m][nn][2], acc[m][nn][3]);
                *(u32x2*)(out + e * 256 + d) = w; }
    }
}
__device__ __forceinline__ void ph_ret_scan(const Ctx& C) {
    const bf16_t* KV = WSP(bf16_t, WS_KV); bf16_t* Rb = WSP(bf16_t, WS_R);
    for (int idx = C.bid * 512 + C.tid; idx < 16 * 8192; idx += C.G * 512) {
        const int bh = idx >> 13, off = (idx & 8191) * 8, h = bh & 3; const float gc = exp2f(128.0f * log2f(1.0f - exp2f(-5.0f - (float)h)));
        float R[8] = {0.f, 0.f, 0.f, 0.f, 0.f, 0.f, 0.f, 0.f};
#pragma unroll 4
        for (int n = 0; n < 32; ++n) { const size_t o = ((size_t)bh * 32 + n) * 65536 + off;
            *(u32x4*)(Rb + o) = pack8((f32x4){R[0], R[1], R[2], R[3]}, (f32x4){R[4], R[5], R[6], R[7]});
            float f[8]; unpack8(*(const u32x4*)(KV + o), f);
#pragma unroll
            for (int j = 0; j < 8; ++j) R[j] = R[j] * gc + f[j]; }
    }
}
__device__ __forceinline__ void ph_ret_out(const Ctx& C) {
    const bf16_t* rq = WSP(bf16_t, WS_PROJ + P_RQ); const bf16_t* rk = WSP(bf16_t, WS_PROJ + P_RK); const bf16_t* rv = WSP(bf16_t, WS_PROJ + P_RV); const bf16_t* rg = WSP(bf16_t, WS_PROJ + P_RG);
    const bf16_t* Rb = WSP(bf16_t, WS_R); bf16_t* ret = WSP(bf16_t, WS_RET);
    const LAS unsigned char* Vt = C.lds;
    const int w = C.wave;
    for (int u = C.bid; u < 512; u += C.G) {
        int tid_ = C.tid; asm volatile("" : "+v"(tid_));
        const int tid = tid_, lane = tid & 63, g = lane >> 4, fr = lane & 15;
        const int n = u & 31, h = (u >> 5) & 3, b = u >> 7; const size_t row0 = (size_t)b * SEQ + n * 128;
        const float lg2 = log2f(1.0f - exp2f(-5.0f - (float)h));
        constexpr int R_OFF = 128 * TLD, RLD = 272;
        u32x4 Vr[8], Rr[8];
#pragma unroll
        for (int p = 0; p < 8; ++p) { const int idx = p * 512 + tid, row = idx >> 5, ch = idx & 31; Vr[p] = *(const u32x4*)(rv + (row0 + row) * 1024 + h * 256 + ch * 8); }
        if (n > 0) {
#pragma unroll
            for (int p = 0; p < 8; ++p) { const int idx = p * 512 + tid, e = idx >> 4, c16 = idx & 15; Rr[p] = *(const u32x4*)(Rb + (size_t)u * 65536 + (size_t)e * 256 + c16 * 8); } }
        const int i = 16 * w + fr;
        bf16x8 Bq[8];
        { const bf16_t* qp = rq + (row0 + i) * 1024 + h * 256 + 8 * g;
#pragma unroll
          for (int ks = 0; ks < 8; ++ks) Bq[ks] = as_bf16x8(*(const u32x4*)(qp + 32 * ks)); }
        f32x4 acc[16];
#pragma unroll
        for (int nt = 0; nt < 16; ++nt) acc[nt] = (f32x4){0.f, 0.f, 0.f, 0.f};
        __syncthreads();
#pragma unroll
        for (int p = 0; p < 8; ++p) { const int idx = p * 512 + tid, row = idx >> 5, ch = idx & 31; *(LAS u32x4*)(C.lds + row * TLD + ch * 16) = Vr[p]; }
        if (n > 0) {
#pragma unroll
            for (int p = 0; p < 8; ++p) { const int idx = p * 512 + tid, e = idx >> 4, c16 = idx & 15; *(LAS u32x4*)(C.lds + R_OFF + e * RLD + c16 * 16) = Rr[p]; }
#pragma unroll
            for (int p = 0; p < 8; ++p) { const int idx = p * 512 + tid, e = idx >> 4, c16 = idx & 15; Rr[p] = *(const u32x4*)(Rb + (size_t)u * 65536 + (size_t)e * 256 + 128 + c16 * 8); }
#pragma unroll
            for (int dh = 0; dh < 2; ++dh) {
                if (dh) { __syncthreads();
#pragma unroll
                    for (int p = 0; p < 8; ++p) { const int idx = p * 512 + tid, e = idx >> 4, c16 = idx & 15; *(LAS u32x4*)(C.lds + R_OFF + e * RLD + c16 * 16) = Rr[p]; } }
                __syncthreads();
#pragma unroll
                for (int k4 = 0; k4 < 4; ++k4)
#pragma unroll
                    for (int nt = 0; nt < 16; ++nt) { const bf16x8 Ar = as_bf16x8(*(const LAS u32x4*)(C.lds + R_OFF + (16 * nt + fr) * RLD + (32 * k4 + 8 * g) * 2));
                        acc[nt] = __builtin_amdgcn_mfma_f32_16x16x32_bf16(Ar, Bq[4 * dh + k4], acc[nt], 0, 0, 0); }
            }
            const float xi = exp2f(lg2 * (float)(i + 1));
#pragma unroll
            for (int nt = 0; nt < 16; ++nt) acc[nt] = acc[nt] * xi;
        } else __syncthreads();
        f32x4 ST[8];
#pragma unroll
        for (int jt = 0; jt < 8; ++jt) { ST[jt] = (f32x4){0.f, 0.f, 0.f, 0.f};
            if (jt <= w) { const bf16_t* kp = rk + (row0 + 16 * jt + fr) * 1024 + h * 256 + 8 * g;
#pragma unroll
                for (int ks = 0; ks < 8; ++ks) { const bf16x8 Ak = as_bf16x8(*(const u32x4*)(kp + 32 * ks)); ST[jt] = __builtin_amdgcn_mfma_f32_16x16x32_bf16(Ak, Bq[ks], ST[jt], 0, 0, 0); }
#pragma unroll
                for (int r = 0; r < 4; ++r) { const int j = 16 * jt + 4 * g + r; ST[jt][r] = (i >= j) ? ST[jt][r] * exp2f(lg2 * (float)(i - j)) : 0.f; }
                asm volatile("" ::: "memory"); } }
#pragma unroll
        for (int t = 0; t < 4; ++t) if (2 * t <= w) {
            u32x4 sw; sw.x = cvt_pk_bf16(ST[2 * t][0], ST[2 * t][1]); sw.y = cvt_pk_bf16(ST[2 * t][2], ST[2 * t][3]); sw.z = cvt_pk_bf16(ST[2 * t + 1][0], ST[2 * t + 1][1]); sw.w = cvt_pk_bf16(ST[2 * t + 1][2], ST[2 * t + 1][3]);
            const bf16x8 Bs = as_bf16x8(sw);
#pragma unroll
            for (int nt = 0; nt < 16; ++nt) { const bf16x8 Av = tr_frag(Vt, TLD, 32 * t + 4 * g, 32 * t + 16 + 4 * g, 16 * nt, lane); acc[nt] = __builtin_amdgcn_mfma_f32_16x16x32_bf16(Av, Bs, acc[nt], 0, 0, 0); } }
        float ss = 0.f;
#pragma unroll
        for (int nt = 0; nt < 16; ++nt) ss += acc[nt][0] * acc[nt][0] + acc[nt][1] * acc[nt][1] + acc[nt][2] * acc[nt][2] + acc[nt][3] * acc[nt][3];
        ss = quad_sum(ss);
        const float rstd = rsqrtf(ss * (1.f / 256.f) + EPS);
        const size_t ob = (row0 + i) * 1024 + h * 256 + 4 * g;
#pragma unroll
        for (int nt = 0; nt < 16; ++nt) { const u32x2 gw = *(const u32x2*)(rg + ob + 16 * nt); u32x2 o;
            o.x = cvt_pk_bf16(acc[nt][0] * rstd * bf2f(gw.x), acc[nt][1] * rstd * bf2f(gw.x >> 16)); o.y = cvt_pk_bf16(acc[nt][2] * rstd * bf2f(gw.y), acc[nt][3] * rstd * bf2f(gw.y >> 16));
            *(u32x2*)(ret + ob + 16 * nt) = o; }
    }
}
__device__ __forceinline__ void ph_gmlp(const Ctx& C, int l) {
    const bf16_t* gu = WSP(bf16_t, WS_PROJ + P_GU); const bf16_t* gv = WSP(bf16_t, WS_PROJ + P_GV); const float* stats = WSP(float, WS_STATS); bf16_t* gm = WSP(bf16_t, WS_GM);
    const float* lng = C.in[I_LNG] + l * 1024; const float* lnb = C.in[I_LNB] + l * 1024; const float* Wsp = C.in[I_WS] + (size_t)l * 4 * 128 * 128; const float* bs = C.in[I_BS] + l * 4 * 128;
    constexpr int WLD = 272, W_OFF = 128 * TLD, ST_OFF = W_OFF + 128 * WLD;
    const LAS unsigned char* Lt = C.lds; LAS float* sst = (LAS float*)(C.lds + ST_OFF);
    const int g4 = C.lane >> 4, fr = C.lane & 15, w = C.wave;
    for (int u = C.bid; u < 512; u += C.G) {
        const int gg = u & 3, bn = u >> 2, t0 = bn * 128;
        __syncthreads();
        if (C.tid < 128) { const float* sp = stats + (size_t)(t0 + C.tid) * 32; float s = 0.f, q = 0.f;
#pragma unroll
            for (int k = 0; k < 16; ++k) { s += sp[2 * k]; q += sp[2 * k + 1]; }
            const float mean = s * (1.f / 1024.f), var = q * (1.f / 1024.f) - mean * mean; sst[2 * C.tid] = mean; sst[2 * C.tid + 1] = rsqrtf(var + EPS); }
#pragma unroll
        for (int p = 0; p < 4; ++p) { const int idx = p * 512 + C.tid, i = idx >> 4, j8 = (idx & 15) * 8; const float* wp = Wsp + ((size_t)gg * 128 + i) * 128 + j8;
            f32x4 a = *(const f32x4*)wp, b2 = *(const f32x4*)(wp + 4);
#pragma unroll
            for (int j = 0; j < 4; ++j) { if (j8 + j > i) a[j] = 0.f; if (j8 + 4 + j > i) b2[j] = 0.f; }
            *(LAS u32x4*)(C.lds + W_OFF + i * WLD + j8 * 2) = pack8(a, b2); }
        __syncthreads();
#pragma unroll
        for (int p = 0; p < 8; ++p) { const int idx = p * 512 + C.tid, row = idx >> 5, ch = idx & 31, cg = gg * 256 + ch * 8;
            float f[8]; unpack8(*(const u32x4*)(gv + (size_t)(t0 + row) * 1024 + cg), f); const float mean = sst[2 * row], rstd = sst[2 * row + 1];
            const f32x4 g0 = *(const f32x4*)(lng + cg), g1 = *(const f32x4*)(lng + cg + 4), b0 = *(const f32x4*)(lnb + cg), b1 = *(const f32x4*)(lnb + cg + 4);
            f32x4 y0, y1;
#pragma unroll
            for (int j = 0; j < 4; ++j) { y0[j] = (f[j] - mean) * rstd * g0[j] + b0[j]; y1[j] = (f[4 + j] - mean) * rstd * g1[j] + b1[j]; }
            *(LAS u32x4*)(C.lds + row * TLD + ch * 16) = pack8(y0, y1); }
        __syncthreads();
        f32x4 acc[16];
#pragma unroll
        for (int nt = 0; nt < 16; ++nt) acc[nt] = (f32x4){0.f, 0.f, 0.f, 0.f};
#pragma unroll
        for (int ks = 0; ks < 4; ++ks) if (2 * ks <= w) {
            const bf16x8 Bw = as_bf16x8(*(const LAS u32x4*)(C.lds + W_OFF + (16 * w + fr) * WLD + (32 * ks + 8 * g4) * 2));
#pragma unroll
            for (int nt = 0; nt < 16; ++nt) { const bf16x8 Av = tr_frag(Lt, TLD, 32 * ks + 8 * g4, 32 * ks + 8 * g4 + 4, 16 * nt, C.lane); acc[nt] = __builtin_amdgcn_mfma_f32_16x16x32_bf16(Av, Bw, acc[nt], 0, 0, 0); } }
        const int i = 16 * w + fr; const float bias = bs[gg * 128 + i]; const size_t ob = (size_t)(t0 + i) * 1024 + gg * 256 + 4 * g4;
#pragma unroll
        for (int nt = 0; nt < 16; ++nt) { const u32x2 uw = *(const u32x2*)(gu + ob + 16 * nt); u32x2 o;
            o.x = cvt_pk_bf16((acc[nt][0] + bias) * bf2f(uw.x), (acc[nt][1] + bias) * bf2f(uw.x >> 16)); o.y = cvt_pk_bf16((acc[nt][2] + bias) * bf2f(uw.y), (acc[nt][3] + bias) * bf2f(uw.y >> 16));
            *(u32x2*)(gm + ob + 16 * nt) = o; }
    }
}

__device__ __forceinline__ void ph_idx(const Ctx& C, int l) {
    const bf16_t* iq = WSP(bf16_t, WS_PROJ + P_IQ); const bf16_t* ik = WSP(bf16_t, WS_PROJ + P_IK); const float* iw = WSP(float, WS_PROJ + P_IW); unsigned short* sel = WSP(unsigned short, WS_SEL);
    LAS unsigned* sc = (LAS unsigned*)C.lds;
    const int lane = C.lane, n32 = lane & 31, hh = lane >> 5, w = C.wave;
    unsigned* qh = C.ctl + CW_Q + (l * 8 + 1) * 64;
    __syncthreads();
    if (C.tid == 0) C.misc[510] = (int)__hip_atomic_fetch_add(qh, 1u, __ATOMIC_RELAXED, __HIP_MEMORY_SCOPE_AGENT);
    __syncthreads();
    int un = C.misc[510];
    for (int u = un; u < T / 8; u = un) {
        const int b = u & 3, q0 = (SEQ / 8 - 1 - (u >> 2)) * 8, tq0 = b * SEQ + q0, nk = q0 + 8, nkt = (nk + 31) >> 5;
        __syncthreads();
        if (C.tid == 0) C.misc[510] = (int)__hip_atomic_fetch_add(qh, 1u, __ATOMIC_RELAXED, __HIP_MEMORY_SCOPE_AGENT);
        bf16x8 Aq[2][4]; float wq[2][16];
        { const int r = n32, qi = 2 * ((r >> 2) & 1) + (r >> 4), hd = (r & 3) + 4 * ((r >> 3) & 1);
#pragma unroll
          for (int mt = 0; mt < 2; ++mt) { const bf16_t* qp = iq + (size_t)(tq0 + 4 * mt + qi) * 512 + hd * 64 + 8 * hh;
#pragma unroll
              for (int ks = 0; ks < 4; ++ks) Aq[mt][ks] = as_bf16x8(*(const u32x4*)(qp + 16 * ks));
#pragma unroll
              for (int a = 0; a < 2; ++a) { const float* wp = iw + (size_t)(tq0 + 4 * mt + 2 * hh + a) * 8; const f32x4 w0 = *(const f32x4*)wp, w1 = *(const f32x4*)(wp + 4);
#pragma unroll
                  for (int j = 0; j < 4; ++j) { wq[mt][8 * a + j] = w0[j] * 0.125f; wq[mt][8 * a + 4 + j] = w1[j] * 0.125f; } } } }
        u32x4 Bn[4];
        { const bf16_t* kp = ik + ((size_t)b * SEQ + 32 * (w < nkt ? w : 0) + n32) * 64 + 8 * hh;
#pragma unroll
          for (int ks = 0; ks < 4; ++ks) Bn[ks] = *(const u32x4*)(kp + 16 * ks); }
        for (int kt = w; kt < nkt; kt += 8) {
            bf16x8 Bk[4];
#pragma unroll
            for (int ks = 0; ks < 4; ++ks) Bk[ks] = as_bf16x8(Bn[ks]);
            { const int k2 = (kt + 8 < nkt) ? kt + 8 : kt; const bf16_t* kp = ik + ((size_t)b * SEQ + 32 * k2 + n32) * 64 + 8 * hh;
#pragma unroll
              for (int ks = 0; ks < 4; ++ks) Bn[ks] = *(const u32x4*)(kp + 16 * ks); }
#pragma unroll
            for (int mt = 0; mt < 2; ++mt) { f32x16 acc;
#pragma unroll
                for (int j = 0; j < 16; ++j) acc[j] = 0.f;
#pragma unroll
                for (int ks = 0; ks < 4; ++ks) acc = __builtin_amdgcn_mfma_f32_32x32x16_bf16(Aq[mt][ks], Bk[ks], acc, 0, 0, 0);
#pragma unroll
                for (int a = 0; a < 2; ++a) { float s = 0.f;
#pragma unroll
                    for (int rr = 0; rr < 8; ++rr) s += wq[mt][8 * a + rr] * fmaxf(acc[8 * a + rr], 0.f);
                    const int qu = 4 * mt + 2 * hh + a, key = 32 * kt + n32; unsigned bits = __builtin_bit_cast(unsigned, s);
                    bits = (bits & 0x80000000u) ? ~bits : (bits | 0x80000000u);
                    sc[qu * 4096 + key] = (key <= q0 + qu) ? bits : 0u; } }
        }
        __syncthreads();
        un = C.misc[510];
        { const int q = q0 + w, n = q + 1; const size_t so = (size_t)(tq0 + w) * 256;
          if (n <= 256) { for (int r = lane; r < 256; r += 64) sel[so + r] = (r < n) ? (unsigned short)r : (unsigned short)0xFFFFu; }
          else {
            const int ni = (n + 63) >> 6;
            unsigned uu[64];
#pragma unroll
            for (int i = 0; i < 64; ++i) uu[i] = (i < ni && 64 * i + lane < nkt * 32) ? sc[w * 4096 + 64 * i + lane] : 0u;
            const int nact = (ni + 15) >> 4, below_const = (4 - nact) * 1024;
            LAS unsigned* slot = sc + w * 4096;
            unsigned Hp[32];
#pragma unroll
            for (int j = 0; j < 32; ++j) Hp[j] = (uu[2 * j] >> 16) | (uu[2 * j + 1] & 0xffff0000u);
#define IDX_BELOW(dst, cval) do { const unsigned cm1_ = ((cval) - 1u) * 0x00010001u; unsigned cnt_ = 0u; \
            _Pragma("unroll") for (int g4 = 0; g4 < 4; ++g4) if (g4 < nact) { _Pragma("unroll") for (int j = 8 * g4; j < 8 * g4 + 8; ++j) cnt_ = pk_below(Hp[j], cm1_, cnt_); } \
            (dst) = wave_total_dpp((int)((cnt_ & 0xffffu) + (cnt_ >> 16))) + below_const; } while (0)
            unsigned Th = 0u; int geT = 4096;
#pragma unroll 1
            for (int bit = 15; bit >= 0; --bit) { const unsigned c = Th | (1u << bit); int bl; IDX_BELOW(bl, c); if (4096 - bl >= 256) { Th = c; geT = 4096 - bl; } }
            int gtT = 0; if (Th != 0xffffu) { int bl; IDX_BELOW(bl, Th + 1u); gtT = 4096 - bl; }
            const int krem = 256 - gtT, nc = geT - gtT;
            unsigned Tv; int need; bool simple;
            if (nc <= 64) {
                int base = 0; const unsigned long long lt = (1ull << lane) - 1ull;
#pragma unroll
                for (int i = 0; i < 64; ++i) { const bool eq = (uu[i] >> 16) == Th; const unsigned long long em = __ballot(eq);
                    if (em) { if (eq) slot[base + __builtin_popcountll(em & lt)] = (uu[i] & 0xffffu) + 1u; base += __builtin_popcountll(em); } }
                asm volatile("s_waitcnt lgkmcnt(0)" ::: "memory");
                const unsigned tv = (lane < nc) ? slot[lane] : 0u;
                unsigned Tl = 0u;
#pragma unroll 1
                for (int bit = 16; bit >= 0; --bit) { const unsigned c = Tl | (1u << bit); if (__builtin_popcountll(__ballot(tv >= c)) >= krem) Tl = c; }
                need = krem - __builtin_popcountll(__ballot(tv > Tl)); simple = (need == __builtin_popcountll(__ballot(tv == Tl)));
                Tv = (Th << 16) | (Tl - 1u);
                asm volatile("s_waitcnt lgkmcnt(0)" ::: "memory");
            } else {
#pragma unroll
                for (int j = 0; j < 32; ++j) { const unsigned a = uu[2 * j], b2 = uu[2 * j + 1]; Hp[j] = (((a >> 16) == Th) ? (a & 0xffffu) : 0u) | (((b2 >> 16) == Th) ? (b2 << 16) : 0u); }
                unsigned Tl = 0u;
#pragma unroll 1
                for (int bit = 15; bit >= 0; --bit) { const unsigned c = Tl | (1u << bit); int bl; IDX_BELOW(bl, c); if (4096 - bl >= krem) Tl = c; }
                Tv = (Th << 16) | Tl; int cg = 0;
#pragma unroll
                for (int i = 0; i < 64; ++i) cg += (uu[i] > Tv) ? 1 : 0;
                need = 256 - wave_total_dpp(cg); simple = false;
            }
#undef IDX_BELOW
            if (simple) {
                int base = 0;
#pragma unroll
                for (int i = 0; i < 64; ++i) if (16 * (i >> 4) < ni) { const bool take = uu[i] >= Tv; const unsigned long long tm = __ballot(take);
                    const int pos = base + (int)__builtin_amdgcn_mbcnt_hi((unsigned)(tm >> 32), __builtin_amdgcn_mbcnt_lo((unsigned)tm, 0u));
                    if (take) sel[so + pos] = (unsigned short)(64 * i + lane);
                    base += __builtin_popcountll(tm); }
            } else {
                int base = 0, eqs = 0; const unsigned long long lt = (1ull << lane) - 1ull;
#pragma unroll
                for (int i = 0; i < 64; ++i) if (16 * (i >> 4) < ni) { const bool gt = uu[i] > Tv, eq = uu[i] == Tv; const unsigned long long em = __ballot(eq);
                    const bool take = gt || (eq && (eqs + __builtin_popcountll(em & lt)) < need); const unsigned long long tm = __ballot(take);
                    if (take) sel[so + base + __builtin_popcountll(tm & lt)] = (unsigned short)(64 * i + lane);
                    base += __builtin_popcountll(tm); eqs += __builtin_popcountll(em); }
            }
          } }
    }
}
__device__ __forceinline__ void ph_att(const Ctx& C) {
    const bf16_t* qabs = WSP(bf16_t, WS_QABS); const bf16_t* ckv = WSP(bf16_t, WS_CKV); const unsigned short* sel = WSP(unsigned short, WS_SEL); bf16_t* olat = WSP(bf16_t, WS_OLAT);
    const int lane = C.lane, g = lane >> 4, fr = lane & 15;
    LAS unsigned char* ch = C.lds + C.wave * (32 * TLD + 512);
    LAS unsigned short* ssel = (LAS unsigned short*)(ch + 32 * TLD);
    for (int tq = C.gw; tq < T; tq += C.NGW) {
        const int b = tq >> 12, q = tq & (SEQ - 1), nv = (q + 1) < 256 ? (q + 1) : 256, nch = (nv + 31) >> 5;
        const bf16_t* cb = ckv + (size_t)b * SEQ * 256;
        { u32x2 sv = *(const u32x2*)(sel + (size_t)tq * 256 + 4 * lane);
          unsigned s0 = sv.x & 0xffffu, s1 = sv.x >> 16, s2_ = sv.y & 0xffffu, s3 = sv.y >> 16;
          if (4 * lane + 0 >= nv) s0 = 0; if (4 * lane + 1 >= nv) s1 = 0; if (4 * lane + 2 >= nv) s2_ = 0; if (4 * lane + 3 >= nv) s3 = 0;
          *(LAS u32x2*)(ssel + 4 * lane) = (u32x2){s0 | (s1 << 16), s2_ | (s3 << 16)}; }
        bf16x8 Bqa[8];
        { const bf16_t* qp = qabs + (size_t)tq * 2048 + (fr & 7) * 256 + 8 * g;
#pragma unroll
          for (int ks = 0; ks < 8; ++ks) { u32x4 v = *(const u32x4*)(qp + 32 * ks); if (fr >= 8) v = (u32x4){0u, 0u, 0u, 0u}; Bqa[ks] = as_bf16x8(v); } }
        f32x4 acc[16];
#pragma unroll
        for (int nt = 0; nt < 16; ++nt) acc[nt] = (f32x4){0.f, 0.f, 0.f, 0.f};
        float mrun = -INFINITY, lrun = 0.f;
        asm volatile("s_waitcnt lgkmcnt(0)" ::: "memory");
        u32x4 G[16];
#pragma unroll
        for (int p = 0; p < 16; ++p) { const int s = ssel[2 * p + (lane >> 5)]; G[p] = *(const u32x4*)(cb + (size_t)s * 256 + (lane & 31) * 8); }
#pragma unroll 1
        for (int t = 0; t < nch; ++t) {
#pragma unroll
            for (int p = 0; p < 16; ++p) *(LAS u32x4*)(ch + (2 * p + (lane >> 5)) * TLD + (lane & 31) * 16) = G[p];
            if (t + 1 < nch) {
#pragma unroll
                for (int p = 0; p < 16; ++p) { const int s = ssel[32 * (t + 1) + 2 * p + (lane >> 5)]; G[p] = *(const u32x4*)(cb + (size_t)s * 256 + (lane & 31) * 8); } }
            asm volatile("s_waitcnt lgkmcnt(0)" ::: "memory");
            f32x4 s2[2];
#pragma unroll
            for (int hf = 0; hf < 2; ++hf) { s2[hf] = (f32x4){0.f, 0.f, 0.f, 0.f};
#pragma unroll
                for (int ks = 0; ks < 8; ++ks) { const bf16x8 Ac = as_bf16x8(*(const LAS u32x4*)(ch + (16 * hf + fr) * TLD + (32 * ks + 8 * g) * 2)); s2[hf] = __builtin_amdgcn_mfma_f32_16x16x32_bf16(Ac, Bqa[ks], s2[hf], 0, 0, 0); } }
            float cm = -INFINITY;
#pragma unroll
            for (int hf = 0; hf < 2; ++hf)
#pragma unroll
                for (int r = 0; r < 4; ++r) { const int ki = 32 * t + 16 * hf + 4 * g + r; if (ki >= nv) s2[hf][r] = -INFINITY; cm = fmaxf(cm, s2[hf][r]); }
            cm = quad_max(cm);
            const float mnew = fmaxf(mrun, cm), scale = __expf(mrun - mnew); float ps = 0.f;
#pragma unroll
            for (int hf = 0; hf < 2; ++hf)
#pragma unroll
                for (int r = 0; r < 4; ++r) { s2[hf][r] = __expf(s2[hf][r] - mnew); ps += s2[hf][r]; }
            ps = quad_sum(ps);
            lrun = lrun * scale + ps; mrun = mnew;
            u32x4 pw; pw.x = cvt_pk_bf16(s2[0][0], s2[0][1]); pw.y = cvt_pk_bf16(s2[0][2], s2[0][3]); pw.z = cvt_pk_bf16(s2[1][0], s2[1][1]); pw.w = cvt_pk_bf16(s2[1][2], s2[1][3]);
            const bf16x8 Bp = as_bf16x8(pw);
#pragma unroll
            for (int nt = 0; nt < 16; ++nt) { const bf16x8 Av = tr_frag(ch, TLD, 4 * g, 16 + 4 * g, 16 * nt, lane); acc[nt] = __builtin_amdgcn_mfma_f32_16x16x32_bf16(Av, Bp, acc[nt] * scale, 0, 0, 0); }
            asm volatile("s_waitcnt lgkmcnt(0)" ::: "memory");
        }
        const float inv = 1.0f / lrun;
        if (fr < 8) { bf16_t* op = olat + (size_t)tq * 2048 + fr * 256 + 4 * g;
#pragma unroll
            for (int nt = 0; nt < 16; ++nt) { u32x2 o; o.x = cvt_pk_bf16(acc[nt][0] * inv, acc[nt][1] * inv); o.y = cvt_pk_bf16(acc[nt][2] * inv, acc[nt][3] * inv); *(u32x2*)(op + 16 * nt) = o; } }
    }
}

__device__ __forceinline__ void ph_norm_hilo(const Ctx& C, const float* x, const float* g, bf16_t* H, bf16_t* HLO) {
    for (int row = C.gw; row < T; row += C.NGW) {
        const f32x4* xr = (const f32x4*)(x + (size_t)row * DM) + C.lane; f32x4 v[8]; float ss = 0.f;
#pragma unroll
        for (int j = 0; j < 8; ++j) { v[j] = xr[64 * j]; ss += v[j][0] * v[j][0] + v[j][1] * v[j][1] + v[j][2] * v[j][2] + v[j][3] * v[j][3]; }
        const float rstd = rsqrtf(wave_sum(ss, C.lane) * (1.f / DM) + EPS);
        u32x2* oh = (u32x2*)(H + (size_t)row * DM) + C.lane; u32x2* ol = (u32x2*)(HLO + (size_t)row * DM) + C.lane;
#pragma unroll
        for (int j = 0; j < 8; ++j) { const f32x4 gg = ((const f32x4*)g)[64 * j + C.lane]; const f32x4 y = v[j] * rstd * gg; u32x2 wh; wh.x = cvt_pk_bf16(y[0], y[1]); wh.y = cvt_pk_bf16(y[2], y[3]);
            u32x2 wl; wl.x = cvt_pk_bf16(y[0] - bf2f(wh.x), y[1] - bf2f(wh.x >> 16)); wl.y = cvt_pk_bf16(y[2] - bf2f(wh.y), y[3] - bf2f(wh.y >> 16)); oh[64 * j] = wh; ol[64 * j] = wl; }
    }
}
__device__ __forceinline__ void ph_route(const Ctx& C, int l) {
    const float* LOG = WSP(float, WS_OLAT); const float* bg = C.in[I_BGRP] + l * 4; const float* be = C.in[I_BEXP] + l * 32;
    int* rinfo = WSP(int, WS_ROUTE); float* rw = (float*)(rinfo + T * 4); unsigned* cnt = C.ctl + CW_CNT + l * 64;
    LAS int* lcnt = (LAS int*)(C.misc + 600); LAS int* gbase = (LAS int*)(C.misc + 640);
    for (int blk = C.bid; blk < T / 256; blk += C.G) {
        __syncthreads();
        if (C.tid < 32) lcnt[C.tid] = 0;
        __syncthreads();
        const bool act = C.tid < 256; const int t = blk * 256 + (C.tid & 255);
        int e0 = 0, e1 = 0, lr0 = 0, lr1 = 0; float w0 = 0.f, w1 = 0.f;
        if (act) {
        float lg[36];
#pragma unroll
        for (int c = 0; c < 36; ++c) lg[c] = 0.f;
#pragma unroll
        for (int part = 0; part < 4; ++part) { const f32x4* p = (const f32x4*)(LOG + ((size_t)part * T + t) * 128);
#pragma unroll
            for (int c4 = 0; c4 < 9; ++c4) { const f32x4 a = p[c4];
#pragma unroll
                for (int j = 0; j < 4; ++j) lg[4 * c4 + j] += a[j];
                if (part < 2) { const f32x4 b2 = p[16 + c4];
#pragma unroll
                    for (int j = 0; j < 4; ++j) lg[4 * c4 + j] += b2[j]; } } }
        int gsel = 0; float gmax = -INFINITY, gv4[4];
#pragma unroll
        for (int k = 0; k < 4; ++k) { gv4[k] = lg[k] + bg[k]; if (gv4[k] > gmax) { gmax = gv4[k]; gsel = k; } }
        float gden = 0.f;
#pragma unroll
        for (int k = 0; k < 4; ++k) gden += __expf(gv4[k] - gmax);
        const float pg = 1.f / gden;
        float el[8], emax = -INFINITY;
#pragma unroll
        for (int k = 0; k < 8; ++k) { const float v0 = lg[4 + k] + be[k], v1 = lg[12 + k] + be[8 + k], v2 = lg[20 + k] + be[16 + k], v3 = lg[28 + k] + be[24 + k];
            el[k] = gsel == 0 ? v0 : (gsel == 1 ? v1 : (gsel == 2 ? v2 : v3)); emax = fmaxf(emax, el[k]); }
        float eden = 0.f, ep[8];
#pragma unroll
        for (int k = 0; k < 8; ++k) { ep[k] = __expf(el[k] - emax); eden += ep[k]; }
        int i0 = 0; float p0 = -1.f;
#pragma unroll
        for (int k = 0; k < 8; ++k) { ep[k] = ep[k] / eden; if (ep[k] > p0) { p0 = ep[k]; i0 = k; } }
        int i1 = 0; float p1 = -1.f;
#pragma unroll
        for (int k = 0; k < 8; ++k) if (k != i0 && ep[k] > p1) { p1 = ep[k]; i1 = k; }
        const float den = p0 + p1; const int e0_ = gsel * 8 + i0, e1_ = gsel * 8 + i1;
            e0 = e0_; e1 = e1_; w0 = pg * (p0 / den); w1 = pg * (p1 / den);
            lr0 = __hip_atomic_fetch_add(lcnt + e0, 1, __ATOMIC_RELAXED, __HIP_MEMORY_SCOPE_WORKGROUP); lr1 = __hip_atomic_fetch_add(lcnt + e1, 1, __ATOMIC_RELAXED, __HIP_MEMORY_SCOPE_WORKGROUP);
        }
        __syncthreads();
        if (C.tid < 32) { const int c = lcnt[C.tid]; gbase[C.tid] = c ? (int)atomicAdd(&cnt[C.tid], (unsigned)c) : 0; }
        __syncthreads();
        if (act) { const int r0 = gbase[e0] + lr0, r1 = gbase[e1] + lr1;
            int* list = WSP(int, WS_LIST); list[(size_t)e0 * T + r0] = t; list[(size_t)e1 * T + r1] = t;
            *(int4*)(rinfo + (size_t)t * 4) = make_int4(e0, e1, r0, r1); *(f32x2*)(rw + (size_t)t * 2) = (f32x2){w0, w1}; }
    }
}
__device__ __forceinline__ int moe_offsets(const unsigned* cnt, int lane, int& total_tiles) {
    const int c = lane < NEXP ? (int)__hip_atomic_load(cnt + lane, __ATOMIC_RELAXED, __HIP_MEMORY_SCOPE_AGENT) : 0; const int tiles = (c + 255) >> 8;
    int incl = tiles;
#pragma unroll
    for (int o = 1; o < 64; o <<= 1) { const int t = shi(incl, (lane - o) & 63); if (lane >= o) incl += t; }
    total_tiles = shi(incl, 63);
    return (incl - tiles) * 256;
}
__device__ __forceinline__ int moe_table(const Ctx& C, int l) {
    __syncthreads();
    if (C.wave == 0) { int tt; const int off = moe_offsets(C.ctl + CW_CNT + l * 64 + CNT_BANK, C.lane, tt); const int nxt = shi(off, (C.lane + 1) & 63);
        if (C.lane < NEXP) { const int t0 = off >> 8, t1 = (C.lane == NEXP - 1) ? tt : (nxt >> 8); const int cn = (int)__hip_atomic_load(C.ctl + CW_CNT + l * 64 + CNT_BANK + C.lane, __ATOMIC_RELAXED, __HIP_MEMORY_SCOPE_AGENT);
            for (int t = t0; t < t1; ++t) { C.misc[16 + t] = C.lane; C.misc[176 + t] = (t - t0) * 256; C.misc[336 + t] = cn; } }
        if (C.lane == 0) C.misc[500] = tt; }
    __syncthreads();
    return C.misc[500];
}
__device__ __forceinline__ void ph_combine(const Ctx& C, int l, float* x, bool last, const float* gnext, bf16_t* Hn) {
    const bf16_t* yc = WSP(bf16_t, WS_PROJ + M_YC); const int* rinfo = WSP(int, WS_ROUTE); const float* rw = (const float*)(rinfo + T * 4); const int* rpos = rinfo + T * 6; const float* gf = C.in[I_FNG];
    int tt_; const int myoff = moe_offsets(C.ctl + CW_CNT + l * 64 + CNT_BANK, C.lane, tt_);
    for (int row = C.gw; row < T; row += C.NGW) {
        const int4 ri = *(const int4*)(rinfo + (size_t)row * 4); const int p0 = shi(myoff, ri.x) + ri.z, p1 = shi(myoff, ri.y) + ri.w; const float w0 = rw[(size_t)row * 2], w1 = rw[(size_t)row * 2 + 1];
        f32x4* xr = (f32x4*)(x + (size_t)row * DM) + C.lane; const u32x2* y0 = (const u32x2*)(yc + (size_t)p0 * DM) + C.lane; const u32x2* y1 = (const u32x2*)(yc + (size_t)p1 * DM) + C.lane;
        f32x4 v[8]; float ss = 0.f;
#pragma unroll
        for (int j = 0; j < 8; ++j) { const u32x2 a = y0[64 * j], b = y1[64 * j]; f32x4 xv = xr[64 * j];
            xv[0] += w0 * bf2f(a.x) + w1 * bf2f(b.x); xv[1] += w0 * bf2f(a.x >> 16) + w1 * bf2f(b.x >> 16); xv[2] += w0 * bf2f(a.y) + w1 * bf2f(b.y); xv[3] += w0 * bf2f(a.y >> 16) + w1 * bf2f(b.y >> 16);
            v[j] = xv; ss += xv[0] * xv[0] + xv[1] * xv[1] + xv[2] * xv[2] + xv[3] * xv[3]; }
        if (last) { const float rstd = rsqrtf(wave_sum(ss, C.lane) * (1.f / DM) + EPS);
#pragma unroll
            for (int j = 0; j < 8; ++j) xr[64 * j] = v[j] * rstd * ((const f32x4*)gf)[64 * j + C.lane]; }
        else { const float rstd = rsqrtf(wave_sum(ss, C.lane) * (1.f / DM) + EPS); u32x2* o = (u32x2*)(Hn + (size_t)row * DM) + C.lane;
#pragma unroll
            for (int j = 0; j < 8; ++j) { xr[64 * j] = v[j]; const f32x4 y = v[j] * rstd * ((const f32x4*)gnext)[64 * j + C.lane]; u32x2 w; w.x = cvt_pk_bf16(y[0], y[1]); w.y = cvt_pk_bf16(y[2], y[3]); o[64 * j] = w; } }
    }
}

constexpr int NPL = 14, NPHASES = 1 + DEPTH * NPL;
#if MK_PER_PHASE
#define IN(k) (lo <= (k) && (k) < hi)
#else
#define IN(k) true
#endif
#if MK_PER_PHASE
#define SEAM(k) do { } while (0)
#else
#define SEAM(k) xcd_barrier(bar)
#endif
template <int l> __device__ __forceinline__ void run_layer(Ctx& C, const XcdBarrier& bar, const int lo, const int hi) {
    unsigned char* wb = (unsigned char*)(C.ws + WS_W);
    bf16_t* H = WSP(bf16_t, WS_H);
        const int pb = 1 + l * NPL;
        const float* xin = (l == 0) ? C.in[I_X] : (const float*)C.out;
        if (l == 0) { if (IN(pb + 0)) { refresh(C); ph_rope(C); refresh(C); REP(1) ph_weights(C, 0); REP(2) ph_norm(C, xin, C.in[I_NMIX], H); }
            SEAM(pb + 0); }
        if (IN(pb + 1)) { refresh(C);
            pg8::Gemm g{H, (const bf16_t*)(wb + W_IN), DM, DM, DM}; pg8::OrderMN S; S.init(T / 256, NP / 256, C.G, C.bid, 256L * DM * 2, 256L * DM * 2);
            pg8::EpiInProj E{(unsigned char*)C.ws};
            REP(3) pg8::gemm_phase(C.lds, g, S, E);
        }
        SEAM(pb + 1);
        if (IN(pb + 2)) { refresh(C);
            ph_ckv(C, WSP(float, WS_PROJ + P_DC), C.in[I_KVG] + l * 256, WSP(bf16_t, WS_CKV));
            { pg8::Gemm g{WSP(bf16_t, WS_PROJ + P_DQ), (const bf16_t*)(wb + W_UK), 1024, 256, 256}; pg8::OrderMN S; S.init(T / 256, 8, C.G, C.bid, 256L * 1024 * 2, 256L * 256 * 2, 1, 256L * 2);
              pg8::EpiStore<0> E{WSP(bf16_t, WS_QABS), 2048, 0.08838834764831845f}; REP(4) pg8::gemm_phase(C.lds, g, S, E); }
            refresh(C);
            REP(5) ph_gmlp(C, l);
            refresh(C);
            REP(6) ph_ret_kv(C);
            refresh(C);
            REP(7) ph_idx(C, l);
        }
        SEAM(pb + 2);
        if (IN(pb + 3)) { refresh(C);
            REP(8) ph_ret_scan(C);
            REP(9) ph_att(C);
        }
        SEAM(pb + 3);
        if (IN(pb + 4)) { refresh(C);
            { pg8::Gemm g{WSP(bf16_t, WS_OLAT), (const bf16_t*)(wb + W_UV), 2048, 512, 512}; pg8::OrderMN S; S.init(T / 256, 4, C.G, C.bid, 256L * 2048 * 2, 256L * 512 * 2, 0, 512L * 2);
              pg8::EpiStore<0> E{WSP(bf16_t, WS_DS), 1024, 1.0f}; REP(10) pg8::gemm_phase(C.lds, g, S, E); }
            REP(11) ph_ret_out(C);
        }
        SEAM(pb + 4);
        if (IN(pb + 5)) { refresh(C);
            pg8::Gemm g{WSP(bf16_t, WS_RET), (const bf16_t*)(wb + W_RET), 1024, 1024, 1024}; pg8::OrderBranch S; S.base.init(T / 256, 8, C.G, C.bid, 256L * 1024 * 2, 256L * 1024 * 2); S.astride = 32L << 20; S.bstride = 4L << 20;
            pg8::EpiBranch E{WSP(bf16_t, WS_PROJ + P_GA), H}; REP(12) pg8::gemm_phase<pg8::EpiBranch, pg8::OrderBranch, false, true>(C.lds, g, S, E);
        }
        SEAM(pb + 5);
        if (IN(pb + 6)) { refresh(C);
            pg8::Gemm g{H, (const bf16_t*)(wb + W_OUT), DM, DM, DM}; pg8::OrderMN S; S.init(T / 256, 8, C.G, C.bid, 256L * DM * 2, 256L * DM * 2);
            pg8::EpiResid E{xin, C.out}; for (int rep_ = 0; rep_ <= ((l == 0) ? ((PROBE_MASK >> 17) & 1) : 0); ++rep_) pg8::gemm_phase(C.lds, g, S, E);
        }
        SEAM(pb + 6);
        if (IN(pb + 7)) { refresh(C); ph_norm_hilo(C, C.out, C.in[I_NFFN] + l * DM, H, WSP(bf16_t, WS_QABS)); }
        SEAM(pb + 7);
        if (IN(pb + 8)) { refresh(C);
            pg8::Gemm g{H, (const bf16_t*)(wb + W_RT), DM, DM, 1024}; pg8::OrderRouter S{C.G, C.bid, (long)(WS_QABS - WS_H)};
            pg8::EpiRouter E{WSP(float, WS_OLAT)}; pg8::gemm_phase(C.lds, g, S, E);
        }
        SEAM(pb + 8);
        if (IN(pb + 9)) { refresh(C); ph_route(C, l); }
        SEAM(pb + 9);
        if (IN(pb + 11)) { refresh(C);
            const int Mt = moe_table(C, l);
            pg8::Gemm g{H, (const bf16_t*)(wb + W_13), DM, DM, DM};
            pg8::OrderMoE S{C.misc + 16, Mt, 4, C.G, C.bid, 256L * DM * 2, 256L * DM * 2, 1024L * DM * 2, WSP(int, WS_LIST)};
            pg8::EpiMoeUp E{WSP(bf16_t, WS_PROJ + M_HID)}; REP(14) pg8::gemm_phase<pg8::EpiMoeUp, pg8::OrderMoE, true>(C.lds, g, S, E);
        }
        SEAM(pb + 11);
        if (IN(pb + 12)) { refresh(C);
            const int Mt = moe_table(C, l);
            pg8::Gemm g{WSP(bf16_t, WS_PROJ + M_HID), (const bf16_t*)(wb + W_2), FF, FF, FF};
            pg8::OrderMoE S{C.misc + 16, Mt, 8, C.G, C.bid, 256L * FF * 2, 256L * FF * 2, (long)DM * FF * 2, nullptr};
            pg8::EpiStore<0> E{WSP(bf16_t, WS_PROJ + M_YC), DM, 1.0f}; REP(15) pg8::gemm_phase(C.lds, g, S, E);
        }
        SEAM(pb + 12);
        if (IN(pb + 13)) { refresh(C); ph_combine(C, l, C.out, l == DEPTH - 1, C.in[I_NMIX] + (l + 1 < DEPTH ? l + 1 : l) * DM, H); if (l + 1 < DEPTH) { refresh(C); ph_weights(C, l + 1); } }
        if (l + 1 < DEPTH) SEAM(pb + 13);

}
__global__ void __launch_bounds__(512, 2) mk_fwd(Args a) {
    extern __shared__ __attribute__((aligned(16))) unsigned char lds_raw[];
    Ctx C;
    C.lds = (LAS unsigned char*)lds_raw; C.misc = (volatile LAS int*)(C.lds + MISC_OFF); C.ws = (GAS unsigned char*)a.ws; C.ctl = (unsigned*)(a.ws + WS_CTL);
    C.tid = threadIdx.x; C.lane = C.tid & 63; C.wave = __builtin_amdgcn_readfirstlane(C.tid >> 6); C.G = gridDim.x; C.bid = blockIdx.x;
    C.gw = C.bid * 8 + C.wave; C.NGW = C.G * 8; C.in = a.in; C.out = a.out;
    for (int i = C.tid; i < 1024; i += 512) C.misc[i] = 0;
    __syncthreads();
#if MK_PER_PHASE
    XcdBarrier bar; bar.bar = C.ctl + CW_BAR; bar.x = 0; bar.st = (volatile LAS unsigned*)C.misc;
#else
    XcdBarrier bar = xcd_barrier_post(C.ctl + CW_BAR, (volatile LAS unsigned*)C.misc);
#endif
    const int lo = a.ph_lo, hi = a.ph_hi;
    run_layer<0>(C, bar, lo, hi);
    run_layer<1>(C, bar, lo, hi);
}

extern "C" void kernel_launch(void* const* d_in, const int* in_sizes, int n_in, void* d_out, int out_size, void* d_ws, size_t ws_size, hipStream_t stream) {
    static int grid = 0;
    if (grid == 0) {
        if (n_in != 23 || out_size != T * DM || ws_size < WS_END) { fprintf(stderr, "kernel_launch: unexpected shapes / workspace (n_in %d out %d ws %zu need %zu)\n", n_in, out_size, ws_size, (size_t)WS_END); grid = -1; return; }
        int dev = 0, cus = 0, per_cu = 0;
        if (hipGetDevice(&dev) != hipSuccess || hipDeviceGetAttribute(&cus, hipDeviceAttributeMultiprocessorCount, dev) != hipSuccess) { grid = -1; return; }
        if (hipFuncSetAttribute((const void*)mk_fwd, hipFuncAttributeMaxDynamicSharedMemorySize, LDS_BYTES) != hipSuccess) { fprintf(stderr, "kernel_launch: hipFuncSetAttribute failed\n"); grid = -1; return; }
        if (hipOccupancyMaxActiveBlocksPerMultiprocessor(&per_cu, (const void*)mk_fwd, 512, LDS_BYTES) != hipSuccess || per_cu < 1) { fprintf(stderr, "kernel_launch: occupancy query says %d\n", per_cu); (void)hipGetLastError(); grid = -1; return; }
        grid = cus;
    }
    if (grid < 0) return;
    (void)hipMemsetAsync((char*)d_ws + WS_CTL, 0, CTL_BYTES, stream);
    Args a{};
    for (int i = 0; i < 23; ++i) a.in[i] = (const float*)d_in[i];
    a.out = (float*)d_out; a.ws = (unsigned char*)d_ws;
#if MK_PER_PHASE
    for (int p = 0; p < NPHASES; ++p) { a.ph_lo = p; a.ph_hi = p + 1; hipLaunchKernelGGL(mk_fwd, dim3(grid), dim3(512), LDS_BYTES, stream, a); }
#else
    a.ph_lo = 0; a.ph_hi = NPHASES;
    hipLaunchKernelGGL(mk_fwd, dim3(grid), dim3(512), LDS_BYTES, stream, a);
#endif
}
```

```cpp
#include <hip/hip_runtime.h>
#include <stdint.h>
#include <stdio.h>

#ifndef MK_PER_PHASE
#define MK_PER_PHASE 0
#endif
#ifndef PROBE_MASK
#define PROBE_MASK 0
#endif
#define CNT_BANK (((PROBE_MASK >> 16) & 1) * 128)
#define REP(k) for (int rep_ = 0; rep_ <= ((PROBE_MASK >> (k)) & 1); ++rep_)

#define LAS __attribute__((address_space(3)))
#define GAS __attribute__((address_space(1)))
typedef unsigned short bf16_t;
typedef short bf16x8 __attribute__((ext_vector_type(8)));
typedef short s16x4 __attribute__((ext_vector_type(4)));
typedef float f32x4 __attribute__((ext_vector_type(4)));
typedef float f32x2 __attribute__((ext_vector_type(2)));
typedef float f32x16 __attribute__((ext_vector_type(16)));
typedef unsigned u32x4 __attribute__((ext_vector_type(4)));
typedef unsigned u32x2 __attribute__((ext_vector_type(2)));

constexpr int DM = 2048, NB = 4, SEQ = 4096, T = NB * SEQ, DEPTH = 2;
constexpr int INW = 14152, NP = 14336;
constexpr int GATE_SRC0 = 8008, GATE_DST0 = 8192;
constexpr int NEXP = 32, FF = 512, MOE_ROWS = 40960;
constexpr float EPS = 1e-6f;

constexpr size_t MiB = 1u << 20;
constexpr size_t WS_CTL = 0, CTL_BYTES = 1 * MiB;
constexpr size_t WS_ROPE = 1 * MiB;
constexpr size_t WS_W = 5 * MiB;
constexpr size_t W_IN = 0, W_RET = 56 * MiB, W_GM = 60 * MiB, W_DS = 64 * MiB, W_OUT = 68 * MiB, W_13 = 76 * MiB, W_2 = 204 * MiB, W_UK = 268 * MiB, W_UV = 269 * MiB, W_RT = 270 * MiB  , W_END = 271 * MiB;
constexpr size_t WS_H = WS_W + W_END;
constexpr size_t WS_PROJ = WS_H + 64 * MiB;
constexpr size_t P_RQ = 0, P_RK = 32 * MiB, P_RV = 64 * MiB, P_RG = 96 * MiB, P_GU = 128 * MiB, P_GV = 160 * MiB, P_DQ = 192 * MiB, P_DC = 224 * MiB  ,
                 P_IQ = 240 * MiB  , P_IK = 256 * MiB  , P_IW = 258 * MiB  , P_GA = 260 * MiB, P_GB = 324 * MiB, P_GC = 388 * MiB, P_END = 452 * MiB;
constexpr size_t M_HPERM = 0, M_HID = 160 * MiB, M_YC = 200 * MiB;
constexpr size_t WS_KV = WS_PROJ + P_END;
constexpr size_t WS_R = WS_KV + 64 * MiB;
constexpr size_t WS_QABS = WS_R + 64 * MiB;
constexpr size_t WS_OLAT = WS_QABS + 64 * MiB;
constexpr size_t WS_RET = WS_OLAT + 64 * MiB;
constexpr size_t WS_GM = WS_RET + 32 * MiB, WS_DS = WS_GM + 32 * MiB;
constexpr size_t WS_SEL = WS_DS + 32 * MiB;
constexpr size_t WS_CKV = WS_SEL + 8 * MiB;
constexpr size_t WS_STATS = WS_CKV + 8 * MiB;
constexpr size_t WS_ROUTE = WS_STATS + 2 * MiB;
constexpr size_t WS_LIST = WS_ROUTE + 1 * MiB;
constexpr size_t WS_END = WS_LIST + 2 * MiB;
constexpr int CW_BAR = 4096, CW_CNT = 16384;
constexpr int CW_Q = 32768;

constexpr int LDS_BYTES = 147456, MISC_OFF = LDS_BYTES - 4096;

__device__ __forceinline__ unsigned f2bf(float f) { unsigned u = __builtin_bit_cast(unsigned, f); return (u + 0x7fffu + ((u >> 16) & 1u)) >> 16; }
__device__ __forceinline__ float bf2f(unsigned b) { return __builtin_bit_cast(float, (b & 0xffffu) << 16); }
typedef __bf16 bf16x2_t __attribute__((ext_vector_type(2)));
__device__ __forceinline__ unsigned cvt_pk_bf16(float lo, float hi) { const f32x2 v = {lo, hi}; return __builtin_bit_cast(unsigned, __builtin_convertvector(v, bf16x2_t)); }
__device__ __forceinline__ float shx(float v, int k, int lane) { return __builtin_bit_cast(float, __builtin_amdgcn_ds_bpermute((lane ^ k) << 2, __builtin_bit_cast(int, v))); }
__device__ __forceinline__ void swap32_(float& a, float& b) { asm volatile("v_nop\n\tv_nop\n\tv_permlane32_swap_b32 %0, %1\n\tv_nop" : "+v"(a), "+v"(b)); }
__device__ __forceinline__ void swap16_(float& a, float& b) { asm volatile("v_nop\n\tv_nop\n\tv_permlane16_swap_b32 %0, %1\n\tv_nop" : "+v"(a), "+v"(b)); }
__device__ __forceinline__ float quad_sum(float v) { float a = v, b = v; swap32_(a, b); v = a + b; a = v; b = v; swap16_(a, b); return a + b; }
__device__ __forceinline__ float quad_max(float v) { float a = v, b = v; swap32_(a, b); v = fmaxf(a, b); a = v; b = v; swap16_(a, b); return fmaxf(a, b); }
__device__ __forceinline__ int shi(int v, int src) { return __builtin_amdgcn_ds_bpermute(src << 2, v); }
typedef unsigned short u16x2 __attribute__((ext_vector_type(2)));
__device__ __forceinline__ unsigned pk_below(unsigned x, unsigned cm1, unsigned cnt) {
    u16x2 r = __builtin_elementwise_sub_sat(__builtin_bit_cast(u16x2, x), __builtin_bit_cast(u16x2, cm1)); unsigned ru = __builtin_bit_cast(unsigned, r); asm volatile("" : "+v"(ru));
    r = __builtin_elementwise_sub_sat((u16x2){1, 1}, __builtin_bit_cast(u16x2, ru)); ru = __builtin_bit_cast(unsigned, r); asm volatile("" : "+v"(ru));
    return __builtin_bit_cast(unsigned, (u16x2)(__builtin_bit_cast(u16x2, cnt) + __builtin_bit_cast(u16x2, ru)));
}
__device__ __forceinline__ int wave_total_dpp(int x) {
    x += __builtin_amdgcn_update_dpp(0, x, 0x111, 0xf, 0xf, false);
    x += __builtin_amdgcn_update_dpp(0, x, 0x112, 0xf, 0xf, false);
    x += __builtin_amdgcn_update_dpp(0, x, 0x114, 0xf, 0xf, false);
    x += __builtin_amdgcn_update_dpp(0, x, 0x118, 0xf, 0xf, false);
    x += __builtin_amdgcn_update_dpp(0, x, 0x142, 0xa, 0xf, false);
    x += __builtin_amdgcn_update_dpp(0, x, 0x143, 0xc, 0xf, false);
    return __builtin_amdgcn_readlane(x, 63);
}
__device__ __forceinline__ float wave_sum(float v, int lane) {
#pragma unroll
    for (int o = 1; o < 64; o <<= 1) v += shx(v, o, lane);
    return v;
}
__device__ __forceinline__ float wave_max(float v, int lane) {
#pragma unroll
    for (int o = 1; o < 64; o <<= 1) v = fmaxf(v, shx(v, o, lane));
    return v;
}
__device__ __forceinline__ float sigmoidf_(float x) { return __builtin_amdgcn_rcpf(1.0f + __builtin_amdgcn_exp2f(x * -1.44269504089f)); }
__device__ __forceinline__ float siluf_(float x) { return x * sigmoidf_(x); }
__device__ __forceinline__ f32x2 gelu_pk(f32x2 v) {
    const f32x2 av = __builtin_elementwise_abs(v), d = av * 0.2316418882f + 1.0f;
    f32x2 t; t.x = __builtin_amdgcn_rcpf(d.x); t.y = __builtin_amdgcn_rcpf(d.y);
    f32x2 q = t * 0.5307027145f + (-0.7265760135f); q = q * t + 0.7107068705f; q = q * t + (-0.142248368f); q = q * t + 0.127414796f; q = q * t;
    const f32x2 s = (v * v) * (-0.72134752044f);
    f32x2 e; e.x = __builtin_amdgcn_exp2f(s.x); e.y = __builtin_amdgcn_exp2f(s.y);
    const f32x2 m = v * (q * e), r = v - m;
    f32x2 o; o.x = v.x < 0.f ? m.x : r.x; o.y = v.y < 0.f ? m.y : r.y; return o;
}
template <int ACT> __device__ __forceinline__ f32x4 act4(f32x4 v) {
    if (ACT == 1) { f32x2 a = gelu_pk((f32x2){v[0], v[1]}), b = gelu_pk((f32x2){v[2], v[3]}); return (f32x4){a.x, a.y, b.x, b.y}; }
    if (ACT == 2) return (f32x4){siluf_(v[0]), siluf_(v[1]), siluf_(v[2]), siluf_(v[3])};
    if (ACT == 3) return (f32x4){sigmoidf_(v[0]), sigmoidf_(v[1]), sigmoidf_(v[2]), sigmoidf_(v[3])};
    return v;
}
__device__ __forceinline__ u32x4 pack8(f32x4 a, f32x4 b) { u32x4 w; w.x = cvt_pk_bf16(a[0], a[1]); w.y = cvt_pk_bf16(a[2], a[3]); w.z = cvt_pk_bf16(b[0], b[1]); w.w = cvt_pk_bf16(b[2], b[3]); return w; }
__device__ __forceinline__ void unpack8(u32x4 w, float (&f)[8]) {
    f[0] = bf2f(w.x); f[1] = bf2f(w.x >> 16); f[2] = bf2f(w.y); f[3] = bf2f(w.y >> 16); f[4] = bf2f(w.z); f[5] = bf2f(w.z >> 16); f[6] = bf2f(w.w); f[7] = bf2f(w.w >> 16);
}

#define XB_TMO      128
#define XB_XCNT(j)  (256  + 64 * (j))
#define XB_XSUB(j)  (1280 + 64 * (j))
#define XB_XGEN(j)  (2304 + 64 * (j))
#define XB_TOP      3328
#define XB_TOPGEN   3392
#define XCD_BAR_WORDS 3456
#define XB_SPIN_CAP (1u << 20)
__device__ __forceinline__ unsigned xb_ld(unsigned* p)              { return __hip_atomic_load(p, __ATOMIC_RELAXED, __HIP_MEMORY_SCOPE_AGENT); }
__device__ __forceinline__ unsigned xb_add(unsigned* p, unsigned v) { return __hip_atomic_fetch_add(p, v, __ATOMIC_RELAXED, __HIP_MEMORY_SCOPE_AGENT); }
__device__ __forceinline__ unsigned xb_xcc_id() { return (unsigned)__builtin_amdgcn_s_getreg((3 << 11) | 20) & 0xFu; }
#define XB_SPIN(cond, bar) do { unsigned _sp = 0; while (cond) { __builtin_amdgcn_s_sleep(1); \
    if ((++_sp & 255u) == 0u) { if (xb_ld(&(bar)[XB_TMO])) break; if (_sp > XB_SPIN_CAP) { atomicAdd(&(bar)[XB_TMO], 1u); break; } } } } while (0)
struct XcdBarrier { unsigned* bar; unsigned x; volatile LAS unsigned* st; };
__device__ __forceinline__ XcdBarrier xcd_barrier_post(unsigned* bar, volatile LAS unsigned* st) {
    XcdBarrier b; b.bar = bar; b.x = xb_xcc_id(); b.st = st;
    if (threadIdx.x == 0) (void)xb_add(&bar[XB_XCNT(b.x)], 1u);
    return b;
}
__device__ __forceinline__ void xcd_barrier_complete(unsigned* bar, unsigned x, unsigned& nloc, unsigned& nx) {
    const unsigned G = gridDim.x * gridDim.y * gridDim.z;
    unsigned sum, cnt, mine, sp = 0u;
    for (;;) {
        sum = 0u; cnt = 0u; mine = 0u;
#pragma unroll
        for (unsigned j = 0; j < 16; ++j) { const unsigned c = xb_ld(&bar[XB_XCNT(j)]); sum += c; cnt += (c > 0u) ? 1u : 0u; mine = (j == x) ? c : mine; }
        if (sum == G) break;
        __builtin_amdgcn_s_sleep(1);
        if ((++sp & 255u) == 0u) { if (xb_ld(&bar[XB_TMO])) break; if (sp > XB_SPIN_CAP) { atomicAdd(&bar[XB_TMO], 1u); break; } }
    }
    nloc = mine > 0u ? mine : 1u; nx = cnt > 0u ? cnt : 1u;
}
__device__ __forceinline__ void xcd_barrier(const XcdBarrier& b) {
    asm volatile("s_waitcnt vmcnt(0)" ::: "memory");
    __syncthreads();
    if (threadIdx.x == 0) {
        unsigned* bar = b.bar; asm volatile("" : "+s"(bar));
        __builtin_amdgcn_s_waitcnt(0);
        unsigned nloc = b.st[0], nx = b.st[1];
        if (nloc == 0u) { xcd_barrier_complete(bar, b.x, nloc, nx); b.st[0] = nloc; b.st[1] = nx; }
        const unsigned old = xb_add(&bar[XB_XSUB(b.x)], 1u);
        const unsigned gen = old / nloc;
        if (old + 1u == (gen + 1u) * nloc) {
            __builtin_amdgcn_fence(__ATOMIC_RELEASE, "agent");
            asm volatile("s_waitcnt vmcnt(0)" ::: "memory");
            const unsigned og = xb_add(&bar[XB_TOP], 1u);
            const unsigned tg = og / nx;
            if (og + 1u == (tg + 1u) * nx) xb_add(&bar[XB_TOPGEN], 1u);
            else XB_SPIN(xb_ld(&bar[XB_TOPGEN]) == tg, bar);
            __builtin_amdgcn_fence(__ATOMIC_ACQUIRE, "agent");
            xb_add(&bar[XB_XGEN(b.x)], 1u);
            asm volatile("s_waitcnt vmcnt(0)" ::: "memory");
        } else {
            XB_SPIN(xb_ld(&bar[XB_XGEN(b.x)]) == gen, bar);
            __builtin_amdgcn_fence(__ATOMIC_ACQUIRE, "agent");
            asm volatile("s_waitcnt vmcnt(0)" ::: "memory");
        }
    }
    __syncthreads();
}

namespace pg8 {
constexpr int BM = 256, BK = 64, HALF = 128, HTB = HALF * BK * 2, STAGE_BYTES = 8 * HTB, NXCD = 8, WGM = 8;
__host__ __device__ __forceinline__ int lds_byte(int r, int c) { const int st = (r >> 4) * 2 + (c >> 5), rr = r & 15, cc = c & 31, ob = rr * 64 + cc * 2; return st * 1024 + (ob ^ (((ob >> 9) & 1) << 5)); }
__host__ __device__ __forceinline__ void stage_rc(int b, int& R, int& C) { const int st = b / 1024, sb = b % 1024, swz = sb ^ (((sb >> 9) & 1) << 5); R = (st >> 1) * 16 + swz / 64; C = (st & 1) * 32 + (swz % 64) / 2; }
__host__ __device__ __forceinline__ int perm32(int rho) { const int n = rho >> 4, i = rho & 15; return 8 * (i >> 2) + 4 * n + (i & 3); }

struct Unit { int pm, pn; long aoff, boff; };
struct Gemm { const bf16_t* A; const bf16_t* Bt; int lda, ldb, K; };

struct OrderMN {
    int nM, nN, nwg, G, c, ashift; long astep, bstep, abytes;
    __device__ __forceinline__ int gather_row(const Unit&, int) const { return 0; }
    __device__ void init(int nM_, int nN_, int G_, int c_, long astep_, long bstep_, int ashift_ = 0, long abytes_ = 0) { nM = nM_; nN = nN_; nwg = nM * nN; G = G_; c = c_; astep = astep_; bstep = bstep_; ashift = ashift_; abytes = abytes_; }
    __device__ bool next(int i, Unit& u) const {
        const long L = (long)i * G + c; if (L >= nwg) return false;
        int wgid = (int)L; { const int q = nwg / NXCD, r = nwg % NXCD, xcd = wgid % NXCD, off = wgid / NXCD; wgid = (xcd < r ? xcd * (q + 1) : r * (q + 1) + (xcd - r) * q) + off; }
        const int nig = WGM * nN, gid = wgid / nig, fm = gid * WGM, gsz = (nM - fm) < WGM ? (nM - fm) : WGM;
        u.pm = fm + ((wgid % nig) % gsz); u.pn = (wgid % nig) / gsz;
        u.aoff = (long)u.pm * astep + (long)(u.pn >> ashift) * abytes; u.boff = (long)u.pn * bstep; return true;
    }
};
struct OrderMoE {
    const volatile LAS int* te; int Mt, nN, G, c; long astep, bstep, estep; const int* list;
    __device__ __forceinline__ int gather_row(const Unit& u, int r) const { const int e = te[u.pm], rb = te[160 + u.pm] + r; return rb < te[320 + u.pm] ? list[(size_t)e * T + rb] : 0; }
    __device__ bool next(int i, Unit& u) const {
        const long L = (long)i * G + c; if (L >= (long)Mt * nN) return false;
        u.pm = (int)(L / nN); u.pn = (int)(L % nN);
        u.aoff = (long)u.pm * astep; u.boff = (long)te[u.pm] * estep + (long)u.pn * bstep; return true;
    }
};

template <class Epi, class Sched, bool GATH = false, bool KEEPACC = false, bool ALIGN_EPI = true, bool SP2 = true>
__device__ __forceinline__ void gemm_phase(LAS unsigned char* lds, const Gemm g, const Sched& S, const Epi& E) {
    int tid_ = threadIdx.x; asm volatile("" : "+v"(tid_));
    const GAS bf16_t* gA = (const GAS bf16_t*)g.A; const GAS bf16_t* gB = (const GAS bf16_t*)g.Bt; asm volatile("" : "+s"(gA), "+s"(gB));
    const int tid = tid_, wid = __builtin_amdgcn_readfirstlane(tid >> 6), lane = tid & 63, wr = wid >> 2, wc = wid & 3, fr = lane & 15, fq = lane >> 4;
    const int K = g.K, nt = K / BK;
    unsigned voffA[2], voffB[2];
#pragma unroll
    for (int i = 0; i < 2; ++i) { int R, C; stage_rc(tid * 16 + i * 8192, R, C); const int Rb = Epi::PERM ? ((R & ~31) + perm32(R & 31)) : R;
        voffA[i] = (unsigned)(R * g.lda + C) * 2u; voffB[i] = (unsigned)(Rb * g.ldb + C) * 2u; }
    const size_t kstep = (size_t)(BK * 2);
    const size_t hstepA = GATH ? (size_t)0 : (size_t)HALF * g.lda * 2, hstepB = (size_t)HALF * g.ldb * 2;
    unsigned gAc[2][2], gAn[2][2]; int gR[2], gC[2];
#pragma unroll
    for (int i = 0; i < 2; ++i) { stage_rc(tid * 16 + i * 8192, gR[i], gC[i]); gAc[0][i] = gAc[1][i] = gAn[0][i] = gAn[1][i] = 0u; }
#define PG8_GLOAD(dst, un) do { _Pragma("unroll") for (int h_ = 0; h_ < 2; ++h_) _Pragma("unroll") for (int i_ = 0; i_ < 2; ++i_) \
        dst[h_][i_] = (unsigned)S.gather_row(un, h_ * HALF + gR[i_]) * (unsigned)(g.lda * 2) + (unsigned)(gC[i_] * 2); } while (0)
#define PG8_STAGE_A(bufoff, kptr, h, nx) do { if (GATH) { unsigned vo_[2]; vo_[0] = (nx) ? gAn[h][0] : gAc[h][0]; vo_[1] = (nx) ? gAn[h][1] : gAc[h][1]; PG8_STAGE(bufoff, kptr, vo_); } \
        else PG8_STAGE(bufoff, (kptr) + (h) * hstepA, voffA); } while (0)
    const unsigned ldsw = (unsigned)wid * 1024u;
    const int aoff = lds_byte(wr * 64 + fr, fq * 8), boff = lds_byte(wc * 32 + fr, fq * 8);
#define PG8_SA(b, h) (((b) * 2 + (h)) * HTB)
#define PG8_SB(b, h) ((4 + (b) * 2 + (h)) * HTB)
#define PG8_STAGE(bufoff, gbase, voff) do { _Pragma("unroll") for (int _i = 0; _i < 2; ++_i) \
        __builtin_amdgcn_global_load_lds((const GAS unsigned*)((gbase) + (voff)[_i]), (LAS unsigned*)(lds + (bufoff) + ldsw + _i * 8192), 16, 0, 0); } while (0)
#define PG8_LDA(dst, b, h) do { _Pragma("unroll") for (int m = 0; m < 4; ++m) _Pragma("unroll") for (int k = 0; k < 2; ++k) dst[m][k] = *(const LAS bf16x8*)(lds + PG8_SA(b, h) + aoff + m * 2048 + k * 1024); } while (0)
#define PG8_LDB(dst, b, h) do { _Pragma("unroll") for (int n = 0; n < 2; ++n) _Pragma("unroll") for (int k = 0; k < 2; ++k) dst[n][k] = *(const LAS bf16x8*)(lds + PG8_SB(b, h) + boff + n * 2048 + k * 1024); } while (0)
#define PG8_MMA(ai, bj, At, Bt) do { __builtin_amdgcn_s_setprio(1); _Pragma("unroll") for (int m = 0; m < 4; ++m) _Pragma("unroll") for (int n = 0; n < 2; ++n) _Pragma("unroll") for (int k = 0; k < 2; ++k) \
        acc[ai][bj][m][n] = __builtin_amdgcn_mfma_f32_16x16x32_bf16(Bt[n][k], At[m][k], acc[ai][bj][m][n], 0, 0, 0); __builtin_amdgcn_s_setprio(0); } while (0)
#define PG8_WAIT_V(n) asm volatile("s_waitcnt vmcnt(" #n ")" ::: "memory")
#define PG8_WAIT_L(n) asm volatile("s_waitcnt lgkmcnt(" #n ")" ::: "memory")
#define PG8_BAR __builtin_amdgcn_s_barrier()
#define PG8_SCHED __builtin_amdgcn_sched_barrier(0)
    Unit cur, nxt; int ui = 0;
    if (!S.next(0, cur)) return;
    f32x4 acc[2][2][4][2];
#pragma unroll
    for (int a = 0; a < 2; ++a)
#pragma unroll
        for (int b = 0; b < 2; ++b)
#pragma unroll
            for (int m = 0; m < 4; ++m)
#pragma unroll
                for (int n = 0; n < 2; ++n) acc[a][b][m][n] = (f32x4){0.f, 0.f, 0.f, 0.f};
    bf16x8 At[4][2], B0[2][2], B1[2][2];
    const GAS char* cA = (const GAS char*)gA + (GATH ? 0L : cur.aoff); const GAS char* cB = (const GAS char*)gB + cur.boff;
    if (GATH) PG8_GLOAD(gAc, cur);
    if constexpr (SP2) {
        PG8_STAGE(PG8_SB(0, 0), cB, voffB); PG8_STAGE(PG8_SB(0, 1), cB + hstepB, voffB); PG8_STAGE_A(PG8_SA(0, 0), cA, 0, false); PG8_STAGE_A(PG8_SA(0, 1), cA, 1, false);
        if (wr == 1) PG8_BAR;
        PG8_WAIT_V(2); PG8_BAR;
        PG8_STAGE(PG8_SB(1, 0), cB + kstep, voffB); PG8_STAGE_A(PG8_SA(1, 0), cA + kstep, 0, false); PG8_STAGE(PG8_SB(1, 1), cB + hstepB + kstep, voffB);
        PG8_WAIT_V(6); PG8_BAR;
    } else {
    PG8_STAGE(PG8_SB(0, 0), cB, voffB); PG8_STAGE_A(PG8_SA(0, 0), cA, 0, false); PG8_STAGE(PG8_SB(0, 1), cB + hstepB, voffB); PG8_STAGE_A(PG8_SA(0, 1), cA, 1, false);
    if (wr == 1) PG8_BAR;
    PG8_WAIT_V(4); PG8_BAR;
    PG8_STAGE(PG8_SB(1, 0), cB + kstep, voffB); PG8_STAGE_A(PG8_SA(1, 0), cA + kstep, 0, false); PG8_STAGE(PG8_SB(1, 1), cB + hstepB + kstep, voffB);
    PG8_WAIT_V(6); PG8_BAR;
    }
    for (;;) {
        const bool has_next = S.next(ui + 1, nxt);
        const GAS char* nA = (has_next && !GATH) ? (const GAS char*)gA + nxt.aoff : cA; const GAS char* nB = has_next ? (const GAS char*)gB + nxt.boff : cB;
        if (GATH) { if (has_next) PG8_GLOAD(gAn, nxt); else { gAn[0][0] = gAc[0][0]; gAn[0][1] = gAc[0][1]; gAn[1][0] = gAc[1][0]; gAn[1][1] = gAc[1][1]; } }
        for (int t = 0; t < nt; t += 2) {
            const bool last = (t == nt - 2);
            const GAS char* a1 = cA + (size_t)(t + 1) * kstep;
            const GAS char* a2 = last ? nA : cA + (size_t)(t + 2) * kstep; const GAS char* b2 = last ? nB : cB + (size_t)(t + 2) * kstep;
            const GAS char* a3 = a2 + kstep; const GAS char* b3 = b2 + kstep;
            if constexpr (SP2) {
            PG8_LDB(B0, 0, 0); PG8_LDB(B1, 0, 1); PG8_SCHED; PG8_LDA(At, 0, 0); PG8_STAGE_A(PG8_SA(1, 1), a1, 1, false);
            PG8_WAIT_V(8); PG8_WAIT_L(0); PG8_BAR; PG8_MMA(0, 0, At, B0); PG8_MMA(0, 1, At, B1); PG8_BAR; PG8_SCHED;
            PG8_LDA(At, 0, 1); PG8_STAGE(PG8_SB(0, 0), b2, voffB); PG8_STAGE(PG8_SB(0, 1), b2 + hstepB, voffB); PG8_STAGE_A(PG8_SA(0, 0), a2, 0, last);
            PG8_WAIT_V(8); PG8_WAIT_L(0); PG8_BAR; PG8_MMA(1, 0, At, B0); PG8_MMA(1, 1, At, B1); PG8_BAR; PG8_SCHED;
            PG8_LDB(B0, 1, 0); PG8_LDB(B1, 1, 1); PG8_SCHED; PG8_LDA(At, 1, 0); PG8_STAGE_A(PG8_SA(0, 1), a2, 1, last);
            PG8_WAIT_V(8); PG8_WAIT_L(0); PG8_BAR; PG8_MMA(0, 0, At, B0); PG8_MMA(0, 1, At, B1); PG8_BAR; PG8_SCHED;
            PG8_LDA(At, 1, 1); PG8_STAGE(PG8_SB(1, 0), b3, voffB); PG8_STAGE(PG8_SB(1, 1), b3 + hstepB, voffB); PG8_STAGE_A(PG8_SA(1, 0), a3, 0, last);
            PG8_WAIT_V(8); PG8_WAIT_L(0); PG8_BAR; PG8_MMA(1, 0, At, B0); PG8_MMA(1, 1, At, B1); PG8_BAR; PG8_SCHED;
            } else {
            PG8_LDB(B0, 0, 0); PG8_SCHED; PG8_LDA(At, 0, 0); PG8_STAGE_A(PG8_SA(1, 1), a1, 1, false);
            PG8_WAIT_L(8); PG8_BAR; PG8_WAIT_L(0); PG8_MMA(0, 0, At, B0); PG8_BAR; PG8_SCHED;
            PG8_LDB(B1, 0, 1); PG8_STAGE(PG8_SB(0, 0), b2, voffB);
            PG8_BAR; PG8_WAIT_L(0); PG8_MMA(0, 1, At, B1); PG8_BAR;
            PG8_LDA(At, 0, 1); PG8_STAGE_A(PG8_SA(0, 0), a2, 0, last);
            PG8_BAR; PG8_WAIT_L(0); PG8_MMA(1, 0, At, B0); PG8_BAR; PG8_SCHED;
            PG8_STAGE(PG8_SB(0, 1), b2 + hstepB, voffB);
            PG8_WAIT_V(6); PG8_BAR; PG8_MMA(1, 1, At, B1); PG8_BAR;
            PG8_LDB(B0, 1, 0); PG8_SCHED; PG8_LDA(At, 1, 0); PG8_STAGE_A(PG8_SA(0, 1), a2, 1, last);
            PG8_WAIT_L(8); PG8_BAR; PG8_WAIT_L(0); PG8_MMA(0, 0, At, B0); PG8_BAR; PG8_SCHED;
            PG8_LDB(B1, 1, 1); PG8_STAGE(PG8_SB(1, 0), b3, voffB);
            PG8_BAR; PG8_WAIT_L(0); PG8_MMA(0, 1, At, B1); PG8_BAR;
            PG8_LDA(At, 1, 1); PG8_STAGE_A(PG8_SA(1, 0), a3, 0, last);
            PG8_BAR; PG8_WAIT_L(0); PG8_MMA(1, 0, At, B0); PG8_BAR; PG8_SCHED;
            PG8_STAGE(PG8_SB(1, 1), b3 + hstepB, voffB);
            PG8_WAIT_V(6); PG8_BAR; PG8_MMA(1, 1, At, B1); PG8_BAR;
            }
        }
        if constexpr (ALIGN_EPI) { if (wr == 0) PG8_BAR; }
        bool zero_acc = true;
        if constexpr (KEEPACC) zero_acc = E.run(acc, cur, wr, wc, fr, fq);
        else E(acc, cur, wr, wc, fr, fq);
        if (!has_next) break;
        if (zero_acc)
#pragma unroll
        for (int a = 0; a < 2; ++a)
#pragma unroll
            for (int b = 0; b < 2; ++b)
#pragma unroll
                for (int m = 0; m < 4; ++m)
#pragma unroll
                    for (int n = 0; n < 2; ++n) acc[a][b][m][n] = (f32x4){0.f, 0.f, 0.f, 0.f};
        cur = nxt; cA = nA; cB = nB; ++ui;
        if (GATH) { gAc[0][0] = gAn[0][0]; gAc[0][1] = gAn[0][1]; gAc[1][0] = gAn[1][0]; gAc[1][1] = gAn[1][1]; }
        if constexpr (ALIGN_EPI) { if (wr == 1) PG8_BAR; }
    }
    PG8_WAIT_V(0);
    if constexpr (!ALIGN_EPI) { if (wr == 0) PG8_BAR; }
    PG8_BAR;
#undef PG8_SA
#undef PG8_SB
#undef PG8_STAGE
#undef PG8_STAGE_A
#undef PG8_GLOAD
#undef PG8_LDA
#undef PG8_LDB
#undef PG8_MMA
#undef PG8_WAIT_V
#undef PG8_WAIT_L
#undef PG8_BAR
#undef PG8_SCHED
}

typedef const f32x4 (&AccT)[2][2][4][2];
template <int ACT> __device__ __forceinline__ void store_tile_bf16(AccT acc, bf16_t* O, int ld, int row0, int colb, float scale) {
#pragma unroll
    for (int ai = 0; ai < 2; ++ai)
#pragma unroll
        for (int m = 0; m < 4; ++m) { bf16_t* rowp = O + (size_t)(row0 + ai * HALF + m * 16) * ld + colb;
#pragma unroll
            for (int bj = 0; bj < 2; ++bj) { const f32x4 v0 = act4<ACT>(acc[ai][bj][m][0] * scale), v1 = act4<ACT>(acc[ai][bj][m][1] * scale);
                *(u32x4*)(rowp + bj * HALF) = pack8(v0, v1); }
            asm volatile("" ::: "memory"); }
}
template <int ACT> struct EpiStore {
    static constexpr bool PERM = true;
    bf16_t* O; int ld; float scale;
    __device__ __forceinline__ void operator()(AccT acc, const Unit& u, int wr, int wc, int fr, int fq) const {
        store_tile_bf16<ACT>(acc, O, ld, u.pm * BM + wr * 64 + fr, u.pn * BM + wc * 32 + 8 * fq, scale);
    }
};
struct EpiInProj {
    static constexpr bool PERM = true;
    unsigned char* ws;
    __device__ __forceinline__ void operator()(AccT acc, const Unit& u, int wr, int wc, int fr, int fq) const {
        const int pn = u.pn, row0 = u.pm * BM + wr * 64 + fr, cw = wc * 32 + 8 * fq;
        unsigned char* pj = ws + WS_PROJ;
        bf16_t *rq = (bf16_t*)(pj + P_RQ), *rk = (bf16_t*)(pj + P_RK), *rv = (bf16_t*)(pj + P_RV), *rg = (bf16_t*)(pj + P_RG), *gu = (bf16_t*)(pj + P_GU), *gv = (bf16_t*)(pj + P_GV), *dq = (bf16_t*)(pj + P_DQ),
               *iq = (bf16_t*)(pj + P_IQ), *ik = (bf16_t*)(pj + P_IK), *ga = (bf16_t*)(pj + P_GA), *gb = (bf16_t*)(pj + P_GB), *gc = (bf16_t*)(pj + P_GC);
        float *dcraw = (float*)(pj + P_DC), *iw = (float*)(pj + P_IW), *gvstats = (float*)(ws + WS_STATS); const float* rope = (const float*)(ws + WS_ROPE);
        if (pn < 8) {
            const bool isk = pn >= 4; bf16_t* dst = (isk ? rk : rq) + (pn & 3) * 256 + cw; const float sc = isk ? 0.0625f : 1.0f;
#pragma unroll
            for (int ai = 0; ai < 2; ++ai) { f32x4 csq[4][4];
#pragma unroll
                for (int m = 0; m < 4; ++m) { const int pos = (row0 + ai * HALF + m * 16) & (SEQ - 1); const f32x4* cs = (const f32x4*)(rope + ((size_t)pos * 128 + cw) * 2);
#pragma unroll
                    for (int q4 = 0; q4 < 4; ++q4) csq[m][q4] = cs[q4]; }
                asm volatile("" ::: "memory");
#pragma unroll
                for (int m = 0; m < 4; ++m) { const int row = row0 + ai * HALF + m * 16;
                    f32x4 o1[2], o2[2];
#pragma unroll
                    for (int n = 0; n < 2; ++n) { const f32x4 c01 = csq[m][2 * n], c23 = csq[m][2 * n + 1]; const f32x4 x1 = acc[ai][0][m][n], x2 = acc[ai][1][m][n];
                        const float co[4] = {c01[0], c01[2], c23[0], c23[2]}, si[4] = {c01[1], c01[3], c23[1], c23[3]};
#pragma unroll
                        for (int j = 0; j < 4; ++j) { o1[n][j] = (x1[j] * co[j] - x2[j] * si[j]) * sc; o2[n][j] = (x1[j] * si[j] + x2[j] * co[j]) * sc; } }
                    bf16_t* rp = dst + (size_t)row * 1024;
                    *(u32x4*)rp = pack8(o1[0], o1[1]); *(u32x4*)(rp + 128) = pack8(o2[0], o2[1]); }
                asm volatile("" ::: "memory"); }
        } else if (pn < 12) { store_tile_bf16<0>(acc, rv, 1024, row0, (pn - 8) * 256 + cw, 1.f);
        } else if (pn < 16) { store_tile_bf16<2>(acc, rg, 1024, row0, (pn - 12) * 256 + cw, 1.f);
        } else if (pn < 20) { store_tile_bf16<1>(acc, gu, 1024, row0, (pn - 16) * 256 + cw, 1.f);
        } else if (pn < 24) {
            const int t4 = pn - 20; bf16_t* dst = gv + t4 * 256 + cw;
#pragma unroll
            for (int ai = 0; ai < 2; ++ai)
#pragma unroll
                for (int m = 0; m < 4; ++m) { const int row = row0 + ai * HALF + m * 16; float s = 0.f, q = 0.f;
#pragma unroll
                    for (int bj = 0; bj < 2; ++bj) { const f32x4 v0 = act4<1>(acc[ai][bj][m][0]), v1 = act4<1>(acc[ai][bj][m][1]);
                        *(u32x4*)(dst + (size_t)row * 1024 + bj * HALF) = pack8(v0, v1);
#pragma unroll
                        for (int j = 0; j < 4; ++j) { s += v0[j] + v1[j]; q += v0[j] * v0[j] + v1[j] * v1[j]; } }
                    s = quad_sum(s); q = quad_sum(q);
                    if (fq == 0) *(f32x2*)(gvstats + ((size_t)row * 16 + t4 * 4 + wc) * 2) = (f32x2){s, q}; asm volatile("" ::: "memory"); }
        } else if (pn < 28) { store_tile_bf16<0>(acc, dq, 1024, row0, (pn - 24) * 256 + cw, 1.f);
        } else if (pn == 28) {
#pragma unroll
            for (int ai = 0; ai < 2; ++ai)
#pragma unroll
                for (int m = 0; m < 4; ++m) { float* rp = dcraw + (size_t)(row0 + ai * HALF + m * 16) * 256 + cw;
#pragma unroll
                    for (int bj = 0; bj < 2; ++bj) { *(f32x4*)(rp + bj * HALF) = acc[ai][bj][m][0]; *(f32x4*)(rp + bj * HALF + 4) = acc[ai][bj][m][1]; } }
        } else if (pn < 31) { store_tile_bf16<0>(acc, iq, 512, row0, (pn - 29) * 256 + cw, 1.f);
        } else if (pn == 31) {
#pragma unroll
            for (int ai = 0; ai < 2; ++ai)
#pragma unroll
                for (int m = 0; m < 4; ++m) { const int row = row0 + ai * HALF + m * 16;
                    if (wc < 2) *(u32x4*)(ik + (size_t)row * 64 + cw) = pack8(acc[ai][0][m][0], acc[ai][0][m][1]);
                    if (wc == 2 && fq == 0) { *(f32x4*)(iw + (size_t)row * 8) = acc[ai][0][m][0] * 0.35355339059f; *(f32x4*)(iw + (size_t)row * 8 + 4) = acc[ai][0][m][1] * 0.35355339059f; } }
        } else { const int gi = (pn - 32) >> 3; bf16_t* dst = gi == 0 ? ga : (gi == 1 ? gb : gc);
            store_tile_bf16<3>(acc, dst, 2048, row0, ((pn - 32) & 7) * 256 + cw, 1.f); }
    }
};
typedef f32x4 (&AccM)[2][2][4][2];
struct EpiBranch {
    static constexpr bool PERM = true;
    const bf16_t* gate0; bf16_t* merged;
    __device__ __forceinline__ bool run(AccM acc, const Unit& u, int wr, int wc, int fr, int fq) const {
        const int br = u.pn >> 8; const bf16_t* gate = gate0 + (size_t)br * (32u << 20); const bf16_t* gnx = gate + (32u << 20);
        const int row0 = u.pm * BM + wr * 64 + fr, colb = (u.pn & 255) * BM + wc * 32 + 8 * fq;
#pragma unroll
        for (int ai = 0; ai < 2; ++ai) {
            u32x4 gq[4][2], nq[4][2];
#pragma unroll
            for (int m = 0; m < 4; ++m)
#pragma unroll
                for (int bj = 0; bj < 2; ++bj) { const size_t ro = (size_t)(row0 + ai * HALF + m * 16) * 2048 + colb + bj * HALF; gq[m][bj] = *(const u32x4*)(gate + ro); nq[m][bj] = *(const u32x4*)((br < 2 ? gnx : gate) + ro); }
            asm volatile("" ::: "memory");
#pragma unroll
            for (int m = 0; m < 4; ++m)
#pragma unroll
                for (int bj = 0; bj < 2; ++bj) { float g8[8], n8[8]; unpack8(gq[m][bj], g8); unpack8(nq[m][bj], n8);
                    f32x4 a0 = acc[ai][bj][m][0], a1 = acc[ai][bj][m][1];
                    if (br < 2) {
#pragma unroll
                        for (int j = 0; j < 4; ++j) { a0[j] *= g8[j] * __builtin_amdgcn_rcpf(fmaxf(n8[j], 1e-30f)); a1[j] *= g8[4 + j] * __builtin_amdgcn_rcpf(fmaxf(n8[4 + j], 1e-30f)); }
                        acc[ai][bj][m][0] = a0; acc[ai][bj][m][1] = a1;
                    } else {
#pragma unroll
                        for (int j = 0; j < 4; ++j) { a0[j] *= g8[j]; a1[j] *= g8[4 + j]; }
                        *(u32x4*)(merged + (size_t)(row0 + ai * HALF + m * 16) * 2048 + colb + bj * HALF) = pack8(a0, a1); } }
            asm volatile("" ::: "memory");
        }
        return br == 2;
    }
};
struct EpiResid {
    static constexpr bool PERM = false;
    const float* xsrc; float* xdst;
    __device__ __forceinline__ void operator()(AccT acc, const Unit& u, int wr, int wc, int fr, int fq) const {
        const int row0 = u.pm * BM + wr * 64 + fr, col0 = u.pn * BM + wc * 32 + 4 * fq;
#pragma unroll
        for (int ai = 0; ai < 2; ++ai)
#pragma unroll
            for (int mp = 0; mp < 2; ++mp) { f32x4 xv[2][2][2];
#pragma unroll
                for (int mm = 0; mm < 2; ++mm)
#pragma unroll
                    for (int bj = 0; bj < 2; ++bj)
#pragma unroll
                        for (int n = 0; n < 2; ++n) xv[mm][bj][n] = *(const f32x4*)(xsrc + (size_t)(row0 + ai * HALF + (2 * mp + mm) * 16) * DM + col0 + bj * HALF + n * 16);
                asm volatile("" ::: "memory");
#pragma unroll
                for (int mm = 0; mm < 2; ++mm)
#pragma unroll
                    for (int bj = 0; bj < 2; ++bj)
#pragma unroll
                        for (int n = 0; n < 2; ++n) *(f32x4*)(xdst + (size_t)(row0 + ai * HALF + (2 * mp + mm) * 16) * DM + col0 + bj * HALF + n * 16) = xv[mm][bj][n] + acc[ai][bj][2 * mp + mm][n];
                asm volatile("" ::: "memory"); }
    }
};
struct EpiMoeUp {
    static constexpr bool PERM = true;
    bf16_t* hid;
    __device__ __forceinline__ void operator()(AccT acc, const Unit& u, int wr, int wc, int fr, int fq) const {
        const int row0 = u.pm * BM + wr * 64 + fr, colb = u.pn * 128 + wc * 32 + 8 * fq;
#pragma unroll
        for (int ai = 0; ai < 2; ++ai)
#pragma unroll
            for (int m = 0; m < 4; ++m) { f32x4 r0, r1; const f32x4 a0 = acc[ai][0][m][0], a1 = acc[ai][0][m][1], b0 = acc[ai][1][m][0], b1 = acc[ai][1][m][1];
#pragma unroll
                for (int j = 0; j < 4; ++j) { r0[j] = siluf_(a0[j]) * b0[j]; r1[j] = siluf_(a1[j]) * b1[j]; }
                *(u32x4*)(hid + (size_t)(row0 + ai * HALF + m * 16) * FF + colb) = pack8(r0, r1); }
    }
};
struct OrderBranch {
    OrderMN base; long astride, bstride;
    __device__ __forceinline__ int gather_row(const Unit&, int) const { return 0; }
    __device__ bool next(int i, Unit& u) const { if (!base.next(i / 3, u)) return false; const int br = i % 3; u.aoff += br * astride; u.boff += br * bstride; u.pn |= br << 8; return true; }
};
struct OrderRouter {
    int G, c; long hlo_off;
    __device__ __forceinline__ int gather_row(const Unit&, int) const { return 0; }
    __device__ bool next(int i, Unit& u) const { const int L = i * G + c; if (L >= 256) return false; const int pm = L >> 2, which = (L >> 1) & 1, kh = L & 1;
        u.pm = pm; u.pn = which * 2 + kh; u.aoff = (long)pm * 256 * DM * 2 + (long)which * hlo_off + (long)kh * 1024 * 2; u.boff = (long)kh * 1024 * 2; return true; }
};
struct EpiRouter {
    static constexpr bool PERM = false;
    float* LOG;
    __device__ __forceinline__ void operator()(AccT acc, const Unit& u, int wr, int wc, int fr, int fq) const {
        float* base = LOG + ((size_t)u.pn * T + (size_t)u.pm * BM + wr * 64 + fr) * 128 + wc * 32 + 4 * fq;
#pragma unroll
        for (int ai = 0; ai < 2; ++ai)
#pragma unroll
            for (int m = 0; m < 4; ++m)
#pragma unroll
                for (int n = 0; n < 2; ++n) *(f32x4*)(base + (size_t)(ai * HALF + m * 16) * 128 + n * 16) = acc[ai][0][m][n];
    }
};
}

struct Args { const float* in[23]; float* out; unsigned char* ws; int ph_lo, ph_hi; };
enum { I_X = 0, I_NMIX, I_WIN, I_WRET, I_LNG, I_LNB, I_WS, I_BS, I_WGM, I_KVG, I_WUK, I_WUV, I_WDS, I_WOUT, I_NFFN, I_WGRP, I_BGRP, I_WEXP, I_BEXP, I_W1, I_W3, I_W2, I_FNG };
struct Ctx {
    LAS unsigned char* lds; volatile LAS int* misc; unsigned* ctl; GAS unsigned char* ws;
    int tid, lane, wave, G, bid, gw, NGW;
    const float* const* in; float* out;
};
#define WSP(T_, off) ((T_*)(C.ws + (off)))
__device__ __forceinline__ void refresh(Ctx& C) { int t = threadIdx.x; asm volatile("" : "+v"(t)); C.tid = t; C.lane = t & 63;
    GAS unsigned char* w = C.ws; asm volatile("" : "+s"(w)); C.ws = w; C.ctl = (unsigned*)w; }

__device__ __forceinline__ void ph_rope(const Ctx& C) {
    float* rope = WSP(float, WS_ROPE);
    const double r1 = 0.9305720409296989;
    for (int idx = C.bid * 512 + C.tid; idx < SEQ * 128; idx += C.G * 512) {
        const int pos = idx >> 7, i = idx & 127;
        double inv = 1.0, b = r1; int e = i;
        while (e) { if (e & 1) inv *= b; b *= b; e >>= 1; }
        const double ang = (double)pos * inv;
        const double n = __builtin_rint(ang * 0.15915494309189533577);
        const double x = ang - n * 6.283185307179586476925;
        const double x2 = x * x;
        double s = 0.0, c = 0.0;
#pragma unroll 1
        for (int k = 14; k >= 1; --k) { s = (s + 1.0) * (-x2 / (double)((2 * k) * (2 * k + 1))); c = (c + 1.0) * (-x2 / (double)((2 * k - 1) * (2 * k))); }
        s = (s + 1.0) * x; c = c + 1.0;
        *(f32x2*)(rope + (size_t)idx * 2) = (f32x2){(float)c, (float)s};
    }
}

struct WItem { const float* src; bf16_t* dst; int srcld, dstld, k0, n0, mode; long off; };
__device__ __forceinline__ WItem w_item(const Ctx& C, int l, int r) {
    unsigned char* wb = (unsigned char*)(C.ws + WS_W); WItem w; w.mode = 0; w.off = 0;
    constexpr int N_IN = 32 * 224, N_BR = 16 * 32, N_OUT = 32 * 32, N_13 = 32 * 32 * 16, N_2 = 32 * 8 * 32;
    if (r < N_IN) { const int kb = r / 224, nb = r % 224; w.src = C.in[I_WIN] + (size_t)l * DM * INW; w.srcld = INW; w.dst = (bf16_t*)(wb + W_IN); w.dstld = DM; w.k0 = kb * 64; w.n0 = nb * 64; w.mode = 1; return w; } r -= N_IN;
    if (r < 3 * N_BR) { const int ww = r / N_BR, q = r % N_BR, kb = q / 32, nb = q % 32; w.src = C.in[ww == 0 ? I_WRET : (ww == 1 ? I_WGM : I_WDS)] + (size_t)l * 1024 * DM; w.srcld = DM;
        w.dst = (bf16_t*)(wb + (ww == 0 ? W_RET : (ww == 1 ? W_GM : W_DS))); w.dstld = 1024; w.k0 = kb * 64; w.n0 = nb * 64; return w; } r -= 3 * N_BR;
    if (r < N_OUT) { const int kb = r / 32, nb = r % 32; w.src = C.in[I_WOUT] + (size_t)l * DM * DM; w.srcld = DM; w.dst = (bf16_t*)(wb + W_OUT); w.dstld = DM; w.k0 = kb * 64; w.n0 = nb * 64; return w; } r -= N_OUT;
    if (r < N_13) { const int e = r / 512, q = r % 512, kb = q / 16, nb = q % 16, row0 = nb * 64, j = row0 >> 8, sft = (row0 >> 7) & 1, fp = row0 & 127;
        w.src = C.in[sft ? I_W3 : I_W1] + ((size_t)l * NEXP + e) * DM * FF; w.srcld = FF; w.dst = (bf16_t*)(wb + W_13) + (size_t)e * 1024 * DM; w.dstld = DM; w.k0 = kb * 64; w.n0 = row0; w.off = (long)(128 * j + fp) - row0; return w; } r -= N_13;
    if (r < N_2) { const int e = r / 256, q = r % 256, kb = q / 32, nb = q % 32; w.src = C.in[I_W2] + ((size_t)l * NEXP + e) * FF * DM; w.srcld = DM; w.dst = (bf16_t*)(wb + W_2) + (size_t)e * DM * FF; w.dstld = FF; w.k0 = kb * 64; w.n0 = nb * 64; return w; } r -= N_2;
    { const int h = r / 8, q = r % 8, kb = q / 2, nb = q % 2;
      w.src = C.in[I_WUV] + ((size_t)l * 8 + h) * 256 * 128; w.srcld = 128; w.dst = (bf16_t*)(wb + W_UV) + (size_t)(h * 128) * 512 + (h & 1) * 256; w.dstld = 512; w.k0 = kb * 64; w.n0 = nb * 64; return w; }
}
__device__ __forceinline__ void w_load(const WItem& w, int lane, f32x4 (&R)[16]) {
    const int nq = lane & 15, kq = lane >> 4, n = w.n0 + 4 * nq;
    const long sc = (w.mode == 1) ? (n < GATE_SRC0 ? (long)n : (n < GATE_DST0 ? -1L : (long)(n - (GATE_DST0 - GATE_SRC0)))) : (long)n + w.off;
    const float* p = w.src + (size_t)(w.k0 + 2 * kq) * w.srcld + (sc >= 0 ? sc : 0);
#pragma unroll
    for (int i = 0; i < 8; ++i)
#pragma unroll
        for (int s2 = 0; s2 < 2; ++s2) { f32x4 v = __builtin_nontemporal_load((const f32x4*)(p + (size_t)(8 * i + s2) * w.srcld)); if (sc < 0) v = (f32x4){0.f, 0.f, 0.f, 0.f}; R[2 * i + s2] = v; }
}
__device__ __forceinline__ void w_store(const WItem& w, int lane, const f32x4 (&R)[16], LAS unsigned* scr) {
    const int nq = lane & 15, kq = lane >> 4;
#pragma unroll
    for (int i = 0; i < 8; ++i)
#pragma unroll
        for (int e = 0; e < 4; ++e) scr[(4 * nq + e) * 33 + 4 * i + kq] = cvt_pk_bf16(R[2 * i][e], R[2 * i + 1][e]);
    asm volatile("s_waitcnt lgkmcnt(0)" ::: "memory");
    const int c = lane & 7;
#pragma unroll
    for (int j = 0; j < 8; ++j) { const int n = (lane >> 3) + 8 * j; const LAS unsigned* sp = scr + n * 33 + 4 * c;
        u32x4 o; o.x = sp[0]; o.y = sp[1]; o.z = sp[2]; o.w = sp[3];
        *(u32x4*)(w.dst + (size_t)(w.n0 + n) * w.dstld + w.k0 + 8 * c) = o; }
    asm volatile("s_waitcnt lgkmcnt(0)" ::: "memory");
}
__device__ __forceinline__ void ph_weights(const Ctx& C, int l) {
    LAS unsigned* scr = (LAS unsigned*)(C.lds + C.wave * 16384);
    unsigned char* wb = (unsigned char*)(C.ws + WS_W);
    constexpr int NITEMS = 32 * 224 + 3 * 16 * 32 + 32 * 32 + 32 * 32 * 16 + 32 * 8 * 32 + 8 * 8;
    { int it = C.gw; f32x4 R[16], Rn[16]; WItem w, wn;
      if (it < NITEMS) { w = w_item(C, l, it); w_load(w, C.lane, R); }
#pragma unroll 1
      while (it < NITEMS) { const int itn = it + C.NGW;
          if (itn < NITEMS) { wn = w_item(C, l, itn); w_load(wn, C.lane, Rn); }
          w_store(w, C.lane, R, scr);
#pragma unroll
          for (int i = 0; i < 16; ++i) R[i] = Rn[i];
          w = wn; it = itn; } }
    bf16_t* uv = (bf16_t*)(wb + W_UV); bf16_t* uk = (bf16_t*)(wb + W_UK); const float* wuk = C.in[I_WUK] + (size_t)l * 8 * 256 * 128;
    for (int idx = C.bid * 512 + C.tid; idx < 1024 * 256 / 8; idx += C.G * 512) { const int row = idx >> 5, c8 = (idx & 31) * 8, h = row >> 7;
        *(u32x4*)(uv + (size_t)row * 512 + (1 - (h & 1)) * 256 + c8) = (u32x4){0u, 0u, 0u, 0u}; }
    for (int idx = C.bid * 512 + C.tid; idx < 2048 * 256 / 8; idx += C.G * 512) { const int row = idx >> 5, c8 = (idx & 31) * 8, h = row >> 8, half = c8 >> 7;
        u32x4 o = (u32x4){0u, 0u, 0u, 0u};
        if (half == (h & 1)) { const float* s = wuk + (size_t)row * 128 + (c8 & 127); const f32x4 a = *(const f32x4*)s, b = *(const f32x4*)(s + 4); o = pack8(a, b); }
        *(u32x4*)(uk + (size_t)row * 256 + c8) = o; }
    bf16_t* rt = (bf16_t*)(wb + W_RT); const float* wgr = C.in[I_WGRP] + (size_t)l * DM * 4; const float* wex = C.in[I_WEXP] + (size_t)l * 4 * DM * 8;
    for (int idx = C.bid * 512 + C.tid; idx < 256 * 256; idx += C.G * 512) { const int r = idx >> 8, k8 = (idx & 255) * 8, c = r & 63, part = r >> 6;
        u32x4 o = (u32x4){0u, 0u, 0u, 0u};
        if (part < 2 && c < 36) { float v[8];
#pragma unroll
            for (int j = 0; j < 8; ++j) { const float wv = (c < 4) ? wgr[(size_t)(k8 + j) * 4 + c] : wex[((size_t)((c - 4) >> 3) * DM + (k8 + j)) * 8 + ((c - 4) & 7)];
                const float hi = bf2f(f2bf(wv)); v[j] = part == 0 ? hi : (wv - hi); }
            o = pack8((f32x4){v[0], v[1], v[2], v[3]}, (f32x4){v[4], v[5], v[6], v[7]}); }
        *(u32x4*)(rt + (size_t)r * DM + k8) = o; }
}

__device__ __forceinline__ void ph_norm(const Ctx& C, const float* x, const float* g, bf16_t* H) {
    for (int row = C.gw; row < T; row += C.NGW) {
        const f32x4* xr = (const f32x4*)(x + (size_t)row * DM) + C.lane; f32x4 v[8]; float ss = 0.f;
#pragma unroll
        for (int j = 0; j < 8; ++j) { v[j] = xr[64 * j]; ss += v[j][0] * v[j][0] + v[j][1] * v[j][1] + v[j][2] * v[j][2] + v[j][3] * v[j][3]; }
        const float rstd = rsqrtf(wave_sum(ss, C.lane) * (1.f / DM) + EPS);
        u32x2* o = (u32x2*)(H + (size_t)row * DM) + C.lane;
#pragma unroll
        for (int j = 0; j < 8; ++j) { const f32x4 gg = ((const f32x4*)g)[64 * j + C.lane]; const f32x4 y = v[j] * rstd * gg; u32x2 w; w.x = cvt_pk_bf16(y[0], y[1]); w.y = cvt_pk_bf16(y[2], y[3]); o[64 * j] = w; }
    }
}
__device__ __forceinline__ void ph_ckv(const Ctx& C, const float* dcraw, const float* g, bf16_t* ckv) {
    for (int row = C.gw; row < T; row += C.NGW) {
        const f32x4 v = ((const f32x4*)(dcraw + (size_t)row * 256))[C.lane];
        const float ss = wave_sum(v[0] * v[0] + v[1] * v[1] + v[2] * v[2] + v[3] * v[3], C.lane);
        const float rstd = rsqrtf(ss * (1.f / 256.f) + EPS); const f32x4 y = v * rstd * ((const f32x4*)g)[C.lane];
        u32x2 w; w.x = cvt_pk_bf16(y[0], y[1]); w.y = cvt_pk_bf16(y[2], y[3]); ((u32x2*)(ckv + (size_t)row * 256))[C.lane] = w;
    }
}

typedef short v4i16_t __attribute__((ext_vector_type(4)));
__device__ __forceinline__ s16x4 tr_read(const LAS unsigned char* p) { return __builtin_bit_cast(s16x4, __builtin_amdgcn_ds_read_tr16_b64_v4i16((LAS v4i16_t*)p)); }
__device__ __forceinline__ bf16x8 tr_frag(const LAS unsigned char* X, int LDX, int rowA, int rowB, int n0, int lane) {
    const int q = (lane & 15) >> 2, p = lane & 3;
    const s16x4 lo = tr_read(X + (rowA + q) * LDX + (n0 + 4 * p) * 2), hi = tr_read(X + (rowB + q) * LDX + (n0 + 4 * p) * 2);
    return (bf16x8){lo[0], lo[1], lo[2], lo[3], hi[0], hi[1], hi[2], hi[3]};
}
constexpr int TLD = 544;
__device__ __forceinline__ bf16x8 as_bf16x8(u32x4 w) { return __builtin_bit_cast(bf16x8, w); }

__device__ __forceinline__ void ph_ret_kv(const Ctx& C) {
    const bf16_t* rk = WSP(bf16_t, WS_PROJ + P_RK); const bf16_t* rv = WSP(bf16_t, WS_PROJ + P_RV); bf16_t* KV = WSP(bf16_t, WS_KV);
    const LAS unsigned char* Vt = C.lds; const LAS unsigned char* Kt = C.lds + 128 * TLD;
    const int g = C.lane >> 4, fr = C.lane & 15, wr = C.wave >> 2, wc = C.wave & 3;
    for (int u = C.bid; u < 512; u += C.G) {
        const int n = u & 31, h = (u >> 5) & 3, b = u >> 7; const size_t row0 = (size_t)b * SEQ + n * 128;
        const float lg2 = log2f(1.0f - exp2f(-5.0f - (float)h));
        __syncthreads();
#pragma unroll
        for (int p = 0; p < 8; ++p) { const int idx = p * 512 + C.tid, row = idx >> 5, ch = idx & 31; const size_t go = (row0 + row) * 1024 + h * 256 + ch * 8;
            const u32x4 vv = *(const u32x4*)(rv + go); *(LAS u32x4*)(C.lds + row * TLD + ch * 16) = vv;
            float f[8]; unpack8(*(const u32x4*)(rk + go), f); const float z = exp2f(lg2 * (float)(127 - row));
            *(LAS u32x4*)(C.lds + 128 * TLD + row * TLD + ch * 16) = pack8((f32x4){f[0] * z, f[1] * z, f[2] * z, f[3] * z}, (f32x4){f[4] * z, f[5] * z, f[6] * z, f[7] * z}); }
        __syncthreads();
        f32x4 acc[8][4];
#pragma unroll
        for (int m = 0; m < 8; ++m)
#pragma unroll
            for (int nn = 0; nn < 4; ++nn) acc[m][nn] = (f32x4){0.f, 0.f, 0.f, 0.f};
#pragma unroll 1
        for (int ks = 0; ks < 4; ++ks) { bf16x8 Bv[4];
#pragma unroll
            for (int nn = 0; nn < 4; ++nn) Bv[nn] = tr_frag(Vt, TLD, 32 * ks + 8 * g, 32 * ks + 8 * g + 4, 64 * wc + 16 * nn, C.lane);
#pragma unroll
            for (int m = 0; m < 8; ++m) { const bf16x8 Ak = tr_frag(Kt, TLD, 32 * ks + 8 * g, 32 * ks + 8 * g + 4, 128 * wr + 16 * m, C.lane);
#pragma unroll
                for (int nn = 0; nn < 4; ++nn) acc[m][nn] = __builtin_amdgcn_mfma_f32_16x16x32_bf16(Ak, Bv[nn], acc[m][nn], 0, 0, 0); } }
        bf16_t* out = KV + (size_t)u * 65536;
#pragma unroll
        for (int m = 0; m < 8; ++m)
#pragma unroll
            for (int nn = 0; nn < 4; ++nn) { const int e = 64 * wc + 16 * nn + fr, d = 128 * wr + 16 * m + 4 * g; u32x2 w; w.x = cvt_pk_bf16(acc[m][nn][0], acc[m][nn][1]); w.y = cvt_pk_bf16(acc[m][nn][2], acc[m][nn][3]);
                *(u32x2*)(out + e * 256 + d) = w; }
    }
}
__device__ __forceinline__ void ph_ret_scan(const Ctx& C) {
    const bf16_t* KV = WSP(bf16_t, WS_KV); bf16_t* Rb = WSP(bf16_t, WS_R);
    for (int idx = C.bid * 512 + C.tid; idx < 16 * 8192; idx += C.G * 512) {
        const int bh = idx >> 13, off = (idx & 8191) * 8, h = bh & 3; const float gc = exp2f(128.0f * log2f(1.0f - exp2f(-5.0f - (float)h)));
        float R[8] = {0.f, 0.f, 0.f, 0.f, 0.f, 0.f, 0.f, 0.f};
#pragma unroll 4
        for (int n = 0; n < 32; ++n) { const size_t o = ((size_t)bh * 32 + n) * 65536 + off;
            *(u32x4*)(Rb + o) = pack8((f32x4){R[0], R[1], R[2], R[3]}, (f32x4){R[4], R[5], R[6], R[7]});
            float f[8]; unpack8(*(const u32x4*)(KV + o), f);
#pragma unroll
            for (int j = 0; j < 8; ++j) R[j] = R[j] * gc + f[j]; }
    }
}
__device__ __forceinline__ void ph_ret_out(const Ctx& C) {
    const bf16_t* rq = WSP(bf16_t, WS_PROJ + P_RQ); const bf16_t* rk = WSP(bf16_t, WS_PROJ + P_RK); const bf16_t* rv = WSP(bf16_t, WS_PROJ + P_RV); const bf16_t* rg = WSP(bf16_t, WS_PROJ + P_RG);
    const bf16_t* Rb = WSP(bf16_t, WS_R); bf16_t* ret = WSP(bf16_t, WS_RET);
    const LAS unsigned char* Vt = C.lds;
    const int w = C.wave;
    for (int u = C.bid; u < 512; u += C.G) {
        int tid_ = C.tid; asm volatile("" : "+v"(tid_));
        const int tid = tid_, lane = tid & 63, g = lane >> 4, fr = lane & 15;
        const int n = u & 31, h = (u >> 5) & 3, b = u >> 7; const size_t row0 = (size_t)b * SEQ + n * 128;
        const float lg2 = log2f(1.0f - exp2f(-5.0f - (float)h));
        constexpr int R_OFF = 128 * TLD, RLD = 272;
        u32x4 Vr[8], Rr[8];
#pragma unroll
        for (int p = 0; p < 8; ++p) { const int idx = p * 512 + tid, row = idx >> 5, ch = idx & 31; Vr[p] = *(const u32x4*)(rv + (row0 + row) * 1024 + h * 256 + ch * 8); }
        if (n > 0) {
#pragma unroll
            for (int p = 0; p < 8; ++p) { const int idx = p * 512 + tid, e = idx >> 4, c16 = idx & 15; Rr[p] = *(const u32x4*)(Rb + (size_t)u * 65536 + (size_t)e * 256 + c16 * 8); } }
        else {
#pragma unroll
            for (int p = 0; p < 8; ++p) { const int idx = p * 512 + tid, row = idx >> 5, ch = idx & 31; Rr[p] = *(const u32x4*)(rk + (row0 + row) * 1024 + h * 256 + ch * 8); } }
        const int i = 16 * w + fr;
        bf16x8 Bq[8];
        { const bf16_t* qp = rq + (row0 + i) * 1024 + h * 256 + 8 * g;
#pragma unroll
          for (int ks = 0; ks < 8; ++ks) Bq[ks] = as_bf16x8(*(const u32x4*)(qp + 32 * ks)); }
        f32x4 acc[16];
#pragma unroll
        for (int nt = 0; nt < 16; ++nt) acc[nt] = (f32x4){0.f, 0.f, 0.f, 0.f};
        __syncthreads();
#pragma unroll
        for (int p = 0; p < 8; ++p) { const int idx = p * 512 + tid, row = idx >> 5, ch = idx & 31; *(LAS u32x4*)(C.lds + row * TLD + ch * 16) = Vr[p]; }
        if (n > 0) {
#pragma unroll
            for (int p = 0; p < 8; ++p) { const int idx = p * 512 + tid, e = idx >> 4, c16 = idx & 15; *(LAS u32x4*)(C.lds + R_OFF + e * RLD + c16 * 16) = Rr[p]; }
#pragma unroll
            for (int p = 0; p < 8; ++p) { const int idx = p * 512 + tid, e = idx >> 4, c16 = idx & 15; Rr[p] = *(const u32x4*)(Rb + (size_t)u * 65536 + (size_t)e * 256 + 128 + c16 * 8); }
#pragma unroll
            for (int dh = 0; dh < 2; ++dh) {
                if (dh) { __syncthreads();
#pragma unroll
                    for (int p = 0; p < 8; ++p) { const int idx = p * 512 + tid, e = idx >> 4, c16 = idx & 15; *(LAS u32x4*)(C.lds + R_OFF + e * RLD + c16 * 16) = Rr[p]; }
#pragma unroll
                    for (int p = 0; p < 8; ++p) { const int idx = p * 512 + tid, row = idx >> 5, ch = idx & 31; Rr[p] = *(const u32x4*)(rk + (row0 + row) * 1024 + h * 256 + ch * 8); } }
                __syncthreads();
#pragma unroll
                for (int k4 = 0; k4 < 4; ++k4)
#pragma unroll
                    for (int nt = 0; nt < 16; ++nt) { const bf16x8 Ar = as_bf16x8(*(const LAS u32x4*)(C.lds + R_OFF + (16 * nt + fr) * RLD + (32 * k4 + 8 * g) * 2));
                        acc[nt] = __builtin_amdgcn_mfma_f32_16x16x32_bf16(Ar, Bq[4 * dh + k4], acc[nt], 0, 0, 0); }
            }
            const float xi = exp2f(lg2 * (float)(i + 1));
#pragma unroll
            for (int nt = 0; nt < 16; ++nt) acc[nt] = acc[nt] * xi;
        }
        __syncthreads();
#pragma unroll
        for (int p = 0; p < 8; ++p) { const int idx = p * 512 + tid, row = idx >> 5, ch = idx & 31; *(LAS u32x4*)(C.lds + R_OFF + row * TLD + ch * 16) = Rr[p]; }
        __syncthreads();
        f32x4 ST[8];
#pragma unroll
        for (int jt = 0; jt < 8; ++jt) { ST[jt] = (f32x4){0.f, 0.f, 0.f, 0.f};
            if (jt <= w) {
#pragma unroll
                for (int ks = 0; ks < 8; ++ks) { const bf16x8 Ak = as_bf16x8(*(const LAS u32x4*)(C.lds + R_OFF + (16 * jt + fr) * TLD + (32 * ks + 8 * g) * 2)); ST[jt] = __builtin_amdgcn_mfma_f32_16x16x32_bf16(Ak, Bq[ks], ST[jt], 0, 0, 0); }
#pragma unroll
                for (int r = 0; r < 4; ++r) { const int j = 16 * jt + 4 * g + r; ST[jt][r] = (i >= j) ? ST[jt][r] * exp2f(lg2 * (float)(i - j)) : 0.f; }
                asm volatile("" ::: "memory"); } }
#pragma unroll
        for (int t = 0; t < 4; ++t) if (2 * t <= w) {
            u32x4 sw; sw.x = cvt_pk_bf16(ST[2 * t][0], ST[2 * t][1]); sw.y = cvt_pk_bf16(ST[2 * t][2], ST[2 * t][3]); sw.z = cvt_pk_bf16(ST[2 * t + 1][0], ST[2 * t + 1][1]); sw.w = cvt_pk_bf16(ST[2 * t + 1][2], ST[2 * t + 1][3]);
            const bf16x8 Bs = as_bf16x8(sw);
#pragma unroll
            for (int nt = 0; nt < 16; ++nt) { const bf16x8 Av = tr_frag(Vt, TLD, 32 * t + 4 * g, 32 * t + 16 + 4 * g, 16 * nt, lane); acc[nt] = __builtin_amdgcn_mfma_f32_16x16x32_bf16(Av, Bs, acc[nt], 0, 0, 0); } }
        float ss = 0.f;
#pragma unroll
        for (int nt = 0; nt < 16; ++nt) ss += acc[nt][0] * acc[nt][0] + acc[nt][1] * acc[nt][1] + acc[nt][2] * acc[nt][2] + acc[nt][3] * acc[nt][3];
        ss = quad_sum(ss);
        const float rstd = rsqrtf(ss * (1.f / 256.f) + EPS);
        const size_t ob = (row0 + i) * 1024 + h * 256 + 4 * g;
#pragma unroll
        for (int nt = 0; nt < 16; ++nt) { const u32x2 gw = *(const u32x2*)(rg + ob + 16 * nt); u32x2 o;
            o.x = cvt_pk_bf16(acc[nt][0] * rstd * bf2f(gw.x), acc[nt][1] * rstd * bf2f(gw.x >> 16)); o.y = cvt_pk_bf16(acc[nt][2] * rstd * bf2f(gw.y), acc[nt][3] * rstd * bf2f(gw.y >> 16));
            *(u32x2*)(ret + ob + 16 * nt) = o; }
    }
}
__device__ __forceinline__ void ph_gmlp(const Ctx& C, int l) {
    const bf16_t* gu = WSP(bf16_t, WS_PROJ + P_GU); const bf16_t* gv = WSP(bf16_t, WS_PROJ + P_GV); const float* stats = WSP(float, WS_STATS); bf16_t* gm = WSP(bf16_t, WS_GM);
    const float* lng = C.in[I_LNG] + l * 1024; const float* lnb = C.in[I_LNB] + l * 1024; const float* Wsp = C.in[I_WS] + (size_t)l * 4 * 128 * 128; const float* bs = C.in[I_BS] + l * 4 * 128;
    constexpr int WLD = 272, W_OFF = 128 * TLD, ST_OFF = W_OFF + 128 * WLD;
    const LAS unsigned char* Lt = C.lds; LAS float* sst = (LAS float*)(C.lds + ST_OFF);
    const int g4 = C.lane >> 4, fr = C.lane & 15, w = C.wave;
    for (int u = C.bid; u < 512; u += C.G) {
        const int gg = u & 3, bn = u >> 2, t0 = bn * 128;
        __syncthreads();
        if (C.tid < 128) { const float* sp = stats + (size_t)(t0 + C.tid) * 32; float s = 0.f, q = 0.f;
#pragma unroll
            for (int k = 0; k < 16; ++k) { s += sp[2 * k]; q += sp[2 * k + 1]; }
            const float mean = s * (1.f / 1024.f), var = q * (1.f / 1024.f) - mean * mean; sst[2 * C.tid] = mean; sst[2 * C.tid + 1] = rsqrtf(var + EPS); }
#pragma unroll
        for (int p = 0; p < 4; ++p) { const int idx = p * 512 + C.tid, i = idx >> 4, j8 = (idx & 15) * 8; const float* wp = Wsp + ((size_t)gg * 128 + i) * 128 + j8;
            f32x4 a = *(const f32x4*)wp, b2 = *(const f32x4*)(wp + 4);
#pragma unroll
            for (int j = 0; j < 4; ++j) { if (j8 + j > i) a[j] = 0.f; if (j8 + 4 + j > i) b2[j] = 0.f; }
            *(LAS u32x4*)(C.lds + W_OFF + i * WLD + j8 * 2) = pack8(a, b2); }
        __syncthreads();
#pragma unroll
        for (int p = 0; p < 8; ++p) { const int idx = p * 512 + C.tid, row = idx >> 5, ch = idx & 31, cg = gg * 256 + ch * 8;
            float f[8]; unpack8(*(const u32x4*)(gv + (size_t)(t0 + row) * 1024 + cg), f); const float mean = sst[2 * row], rstd = sst[2 * row + 1];
            const f32x4 g0 = *(const f32x4*)(lng + cg), g1 = *(const f32x4*)(lng + cg + 4), b0 = *(const f32x4*)(lnb + cg), b1 = *(const f32x4*)(lnb + cg + 4);
            f32x4 y0, y1;
#pragma unroll
            for (int j = 0; j < 4; ++j) { y0[j] = (f[j] - mean) * rstd * g0[j] + b0[j]; y1[j] = (f[4 + j] - mean) * rstd * g1[j] + b1[j]; }
            *(LAS u32x4*)(C.lds + row * TLD + ch * 16) = pack8(y0, y1); }
        __syncthreads();
        f32x4 acc[16];
#pragma unroll
        for (int nt = 0; nt < 16; ++nt) acc[nt] = (f32x4){0.f, 0.f, 0.f, 0.f};
#pragma unroll
        for (int ks = 0; ks < 4; ++ks) if (2 * ks <= w) {
            const bf16x8 Bw = as_bf16x8(*(const LAS u32x4*)(C.lds + W_OFF + (16 * w + fr) * WLD + (32 * ks + 8 * g4) * 2));
#pragma unroll
            for (int nt = 0; nt < 16; ++nt) { const bf16x8 Av = tr_frag(Lt, TLD, 32 * ks + 8 * g4, 32 * ks + 8 * g4 + 4, 16 * nt, C.lane); acc[nt] = __builtin_amdgcn_mfma_f32_16x16x32_bf16(Av, Bw, acc[nt], 0, 0, 0); } }
        const int i = 16 * w + fr; const float bias = bs[gg * 128 + i]; const size_t ob = (size_t)(t0 + i) * 1024 + gg * 256 + 4 * g4;
#pragma unroll
        for (int nt = 0; nt < 16; ++nt) { const u32x2 uw = *(const u32x2*)(gu + ob + 16 * nt); u32x2 o;
            o.x = cvt_pk_bf16((acc[nt][0] + bias) * bf2f(uw.x), (acc[nt][1] + bias) * bf2f(uw.x >> 16)); o.y = cvt_pk_bf16((acc[nt][2] + bias) * bf2f(uw.y), (acc[nt][3] + bias) * bf2f(uw.y >> 16));
            *(u32x2*)(gm + ob + 16 * nt) = o; }
    }
}

__device__ __forceinline__ void ph_idx(const Ctx& C, int l) {
    const bf16_t* iq = WSP(bf16_t, WS_PROJ + P_IQ); const bf16_t* ik = WSP(bf16_t, WS_PROJ + P_IK); const float* iw = WSP(float, WS_PROJ + P_IW); unsigned short* sel = WSP(unsigned short, WS_SEL);
    LAS unsigned* sc = (LAS unsigned*)C.lds;
    const int lane = C.lane, n32 = lane & 31, hh = lane >> 5, w = C.wave;
    unsigned* qh = C.ctl + CW_Q + (l * 8 + 1) * 64;
    __syncthreads();
    if (C.tid == 0) C.misc[510] = (int)__hip_atomic_fetch_add(qh, 1u, __ATOMIC_RELAXED, __HIP_MEMORY_SCOPE_AGENT);
    __syncthreads();
    int un = C.misc[510];
    for (int u = un; u < T / 8; u = un) {
        const int b = u & 3, q0 = (SEQ / 8 - 1 - (u >> 2)) * 8, tq0 = b * SEQ + q0, nk = q0 + 8, nkt = (nk + 31) >> 5;
        __syncthreads();
        if (C.tid == 0) C.misc[510] = (int)__hip_atomic_fetch_add(qh, 1u, __ATOMIC_RELAXED, __HIP_MEMORY_SCOPE_AGENT);
        bf16x8 Aq[2][4]; float wq[2][16];
        { const int r = n32, qi = 2 * ((r >> 2) & 1) + (r >> 4), hd = (r & 3) + 4 * ((r >> 3) & 1);
#pragma unroll
          for (int mt = 0; mt < 2; ++mt) { const bf16_t* qp = iq + (size_t)(tq0 + 4 * mt + qi) * 512 + hd * 64 + 8 * hh;
#pragma unroll
              for (int ks = 0; ks < 4; ++ks) Aq[mt][ks] = as_bf16x8(*(const u32x4*)(qp + 16 * ks));
#pragma unroll
              for (int a = 0; a < 2; ++a) { const float* wp = iw + (size_t)(tq0 + 4 * mt + 2 * hh + a) * 8; const f32x4 w0 = *(const f32x4*)wp, w1 = *(const f32x4*)(wp + 4);
#pragma unroll
                  for (int j = 0; j < 4; ++j) { wq[mt][8 * a + j] = w0[j] * 0.125f; wq[mt][8 * a + 4 + j] = w1[j] * 0.125f; } } } }
        u32x4 Bn[4];
        { const bf16_t* kp = ik + ((size_t)b * SEQ + 32 * (w < nkt ? w : 0) + n32) * 64 + 8 * hh;
#pragma unroll
          for (int ks = 0; ks < 4; ++ks) Bn[ks] = *(const u32x4*)(kp + 16 * ks); }
        for (int kt = w; kt < nkt; kt += 8) {
            bf16x8 Bk[4];
#pragma unroll
            for (int ks = 0; ks < 4; ++ks) Bk[ks] = as_bf16x8(Bn[ks]);
            { const int k2 = (kt + 8 < nkt) ? kt + 8 : kt; const bf16_t* kp = ik + ((size_t)b * SEQ + 32 * k2 + n32) * 64 + 8 * hh;
#pragma unroll
              for (int ks = 0; ks < 4; ++ks) Bn[ks] = *(const u32x4*)(kp + 16 * ks); }
#pragma unroll
            for (int mt = 0; mt < 2; ++mt) { f32x16 acc;
#pragma unroll
                for (int j = 0; j < 16; ++j) acc[j] = 0.f;
#pragma unroll
                for (int ks = 0; ks < 4; ++ks) acc = __builtin_amdgcn_mfma_f32_32x32x16_bf16(Aq[mt][ks], Bk[ks], acc, 0, 0, 0);
#pragma unroll
                for (int a = 0; a < 2; ++a) { float s = 0.f;
#pragma unroll
                    for (int rr = 0; rr < 8; ++rr) s += wq[mt][8 * a + rr] * fmaxf(acc[8 * a + rr], 0.f);
                    const int qu = 4 * mt + 2 * hh + a, key = 32 * kt + n32; unsigned bits = __builtin_bit_cast(unsigned, s);
                    bits = (bits & 0x80000000u) ? ~bits : (bits | 0x80000000u);
                    sc[qu * 4096 + key] = (key <= q0 + qu) ? bits : 0u; } }
        }
        __syncthreads();
        un = C.misc[510];
        { const int q = q0 + w, n = q + 1; const size_t so = (size_t)(tq0 + w) * 256;
          if (n <= 256) { for (int r = lane; r < 256; r += 64) sel[so + r] = (r < n) ? (unsigned short)r : (unsigned short)0xFFFFu; }
          else {
            const int ni = (n + 63) >> 6;
            unsigned uu[64];
#pragma unroll
            for (int i = 0; i < 64; ++i) uu[i] = (i < ni && 64 * i + lane < nkt * 32) ? sc[w * 4096 + 64 * i + lane] : 0u;
            const int nact = (ni + 15) >> 4, below_const = (4 - nact) * 1024;
            LAS unsigned* slot = sc + w * 4096;
            unsigned Hp[32];
#pragma unroll
            for (int j = 0; j < 32; ++j) Hp[j] = (uu[2 * j] >> 16) | (uu[2 * j + 1] & 0xffff0000u);
#define IDX_BELOW(dst, cval) do { const unsigned cm1_ = ((cval) - 1u) * 0x00010001u; unsigned cnt_ = 0u; \
            _Pragma("unroll") for (int g4 = 0; g4 < 4; ++g4) if (g4 < nact) { _Pragma("unroll") for (int j = 8 * g4; j < 8 * g4 + 8; ++j) cnt_ = pk_below(Hp[j], cm1_, cnt_); } \
            (dst) = wave_total_dpp((int)((cnt_ & 0xffffu) + (cnt_ >> 16))) + below_const; } while (0)
#define Pl(g_, b_) Hp[16 * (g_) + (b_)]
#pragma unroll
            for (int g2 = 0; g2 < 2; ++g2) {
#pragma unroll
                for (int d = 8; d >= 1; d >>= 1) { const unsigned m = d == 8 ? 0x00FF00FFu : (d == 4 ? 0x0F0F0F0Fu : (d == 2 ? 0x33333333u : 0x55555555u));
#pragma unroll
                    for (int k = 0; k < 16; ++k) if (!(k & d)) { const unsigned t = ((Pl(g2, k) >> d) ^ Pl(g2, k + d)) & m; Pl(g2, k + d) ^= t; Pl(g2, k) ^= t << d; } } }
            unsigned Th = 0u, eq0 = 0xffffffffu, eq1 = 0xffffffffu, gt0 = 0u, gt1 = 0u; int gcnt = 0;
#pragma unroll
            for (int bit = 15; bit >= 0; --bit) { const unsigned c0 = eq0 & Pl(0, bit), c1 = eq1 & Pl(1, bit); const int pc = __builtin_popcount(c0) + __builtin_popcount(c1);
                if (wave_total_dpp(gcnt + pc) >= 256) { Th |= 1u << bit; eq0 = c0; eq1 = c1; } else { gt0 |= c0; gt1 |= c1; gcnt += pc; eq0 &= ~Pl(0, bit); eq1 &= ~Pl(1, bit); } }
#undef Pl
            const int gtT = wave_total_dpp(gcnt), nc = wave_total_dpp(__builtin_popcount(eq0) + __builtin_popcount(eq1));
            const int krem = 256 - gtT;
            unsigned Tv; int need; bool simple;
            if (nc <= 64) {
                int base = 0; const unsigned long long lt = (1ull << lane) - 1ull;
#pragma unroll
                for (int i = 0; i < 64; ++i) { const bool eq = (((i < 32 ? eq0 : eq1) >> (16 * (i & 1) + ((i & 31) >> 1))) & 1u) != 0u; const unsigned long long em = __ballot(eq);
                    if (em) { if (eq) slot[base + __builtin_popcountll(em & lt)] = (uu[i] & 0xffffu) + 1u; base += __builtin_popcountll(em); } }
                asm volatile("s_waitcnt lgkmcnt(0)" ::: "memory");
                const unsigned tv = (lane < nc) ? slot[lane] : 0u;
                unsigned Tl = 0u;
#pragma unroll 1
                for (int bit = 16; bit >= 0; --bit) { const unsigned c = Tl | (1u << bit); if (__builtin_popcountll(__ballot(tv >= c)) >= krem) Tl = c; }
                need = krem - __builtin_popcountll(__ballot(tv > Tl)); simple = (need == __builtin_popcountll(__ballot(tv == Tl)));
                Tv = (Th << 16) | (Tl - 1u);
                asm volatile("s_waitcnt lgkmcnt(0)" ::: "memory");
            } else {
#pragma unroll
                for (int j = 0; j < 32; ++j) { const unsigned a = uu[2 * j], b2 = uu[2 * j + 1]; Hp[j] = (((a >> 16) == Th) ? (a & 0xffffu) : 0u) | (((b2 >> 16) == Th) ? (b2 << 16) : 0u); }
                unsigned Tl = 0u;
#pragma unroll 1
                for (int bit = 15; bit >= 0; --bit) { const unsigned c = Tl | (1u << bit); int bl; IDX_BELOW(bl, c); if (4096 - bl >= krem) Tl = c; }
                Tv = (Th << 16) | Tl; int cg = 0;
#pragma unroll
                for (int i = 0; i < 64; ++i) cg += (uu[i] > Tv) ? 1 : 0;
                need = 256 - wave_total_dpp(cg); simple = false;
            }
#undef IDX_BELOW
            if (simple) {
                int base = 0;
#pragma unroll
                for (int i = 0; i < 64; ++i) if (16 * (i >> 4) < ni) { const bool take = uu[i] >= Tv; const unsigned long long tm = __ballot(take);
                    const int pos = base + (int)__builtin_amdgcn_mbcnt_hi((unsigned)(tm >> 32), __builtin_amdgcn_mbcnt_lo((unsigned)tm, 0u));
                    if (take) sel[so + pos] = (unsigned short)(64 * i + lane);
                    base += __builtin_popcountll(tm); }
            } else {
                int base = 0, eqs = 0; const unsigned long long lt = (1ull << lane) - 1ull;
#pragma unroll
                for (int i = 0; i < 64; ++i) if (16 * (i >> 4) < ni) { const bool gt = uu[i] > Tv, eq = uu[i] == Tv; const unsigned long long em = __ballot(eq);
                    const bool take = gt || (eq && (eqs + __builtin_popcountll(em & lt)) < need); const unsigned long long tm = __ballot(take);
                    if (take) sel[so + base + __builtin_popcountll(tm & lt)] = (unsigned short)(64 * i + lane);
                    base += __builtin_popcountll(tm); eqs += __builtin_popcountll(em); }
            }
          } }
    }
}
__device__ __forceinline__ void ph_att(const Ctx& C) {
    const bf16_t* qabs = WSP(bf16_t, WS_QABS); const bf16_t* ckv = WSP(bf16_t, WS_CKV); const unsigned short* sel = WSP(unsigned short, WS_SEL); bf16_t* olat = WSP(bf16_t, WS_OLAT);
    const int lane = C.lane, g = lane >> 4, fr = lane & 15;
    LAS unsigned char* ch = C.lds + C.wave * (32 * TLD + 512);
    LAS unsigned short* ssel = (LAS unsigned short*)(ch + 32 * TLD);
    for (int tq = C.gw; tq < T; tq += C.NGW) {
        const int b = tq >> 12, q = tq & (SEQ - 1), nv = (q + 1) < 256 ? (q + 1) : 256, nch = (nv + 31) >> 5;
        const bf16_t* cb = ckv + (size_t)b * SEQ * 256;
        { u32x2 sv = *(const u32x2*)(sel + (size_t)tq * 256 + 4 * lane);
          unsigned s0 = sv.x & 0xffffu, s1 = sv.x >> 16, s2_ = sv.y & 0xffffu, s3 = sv.y >> 16;
          if (4 * lane + 0 >= nv) s0 = 0; if (4 * lane + 1 >= nv) s1 = 0; if (4 * lane + 2 >= nv) s2_ = 0; if (4 * lane + 3 >= nv) s3 = 0;
          *(LAS u32x2*)(ssel + 4 * lane) = (u32x2){s0 | (s1 << 16), s2_ | (s3 << 16)}; }
        bf16x8 Bqa[8];
        { const bf16_t* qp = qabs + (size_t)tq * 2048 + (fr & 7) * 256 + 8 * g;
#pragma unroll
          for (int ks = 0; ks < 8; ++ks) { u32x4 v = *(const u32x4*)(qp + 32 * ks); if (fr >= 8) v = (u32x4){0u, 0u, 0u, 0u}; Bqa[ks] = as_bf16x8(v); } }
        f32x4 acc[16];
#pragma unroll
        for (int nt = 0; nt < 16; ++nt) acc[nt] = (f32x4){0.f, 0.f, 0.f, 0.f};
        float mrun = -INFINITY, lrun = 0.f;
        asm volatile("s_waitcnt lgkmcnt(0)" ::: "memory");
        u32x4 G[16];
#pragma unroll
        for (int p = 0; p < 16; ++p) { const int s = ssel[2 * p + (lane >> 5)]; G[p] = *(const u32x4*)(cb + (size_t)s * 256 + (lane & 31) * 8); }
#pragma unroll 1
        for (int t = 0; t < nch; ++t) {
#pragma unroll
            for (int p = 0; p < 16; ++p) *(LAS u32x4*)(ch + (2 * p + (lane >> 5)) * TLD + (lane & 31) * 16) = G[p];
            if (t + 1 < nch) {
#pragma unroll
                for (int p = 0; p < 16; ++p) { const int s = ssel[32 * (t + 1) + 2 * p + (lane >> 5)]; G[p] = *(const u32x4*)(cb + (size_t)s * 256 + (lane & 31) * 8); } }
            asm volatile("s_waitcnt lgkmcnt(0)" ::: "memory");
            f32x4 s2[2];
#pragma unroll
            for (int hf = 0; hf < 2; ++hf) { s2[hf] = (f32x4){0.f, 0.f, 0.f, 0.f};
#pragma unroll
                for (int ks = 0; ks < 8; ++ks) { const bf16x8 Ac = as_bf16x8(*(const LAS u32x4*)(ch + (16 * hf + fr) * TLD + (32 * ks + 8 * g) * 2)); s2[hf] = __builtin_amdgcn_mfma_f32_16x16x32_bf16(Ac, Bqa[ks], s2[hf], 0, 0, 0); } }
            float cm = -INFINITY;
#pragma unroll
            for (int hf = 0; hf < 2; ++hf)
#pragma unroll
                for (int r = 0; r < 4; ++r) { const int ki = 32 * t + 16 * hf + 4 * g + r; if (ki >= nv) s2[hf][r] = -INFINITY; cm = fmaxf(cm, s2[hf][r]); }
            cm = quad_max(cm);
            const float mnew = fmaxf(mrun, cm), scale = __expf(mrun - mnew); float ps = 0.f;
#pragma unroll
            for (int hf = 0; hf < 2; ++hf)
#pragma unroll
                for (int r = 0; r < 4; ++r) { s2[hf][r] = __expf(s2[hf][r] - mnew); ps += s2[hf][r]; }
            ps = quad_sum(ps);
            lrun = lrun * scale + ps; mrun = mnew;
            u32x4 pw; pw.x = cvt_pk_bf16(s2[0][0], s2[0][1]); pw.y = cvt_pk_bf16(s2[0][2], s2[0][3]); pw.z = cvt_pk_bf16(s2[1][0], s2[1][1]); pw.w = cvt_pk_bf16(s2[1][2], s2[1][3]);
            const bf16x8 Bp = as_bf16x8(pw);
#pragma unroll
            for (int nt = 0; nt < 16; ++nt) { const bf16x8 Av = tr_frag(ch, TLD, 4 * g, 16 + 4 * g, 16 * nt, lane); acc[nt] = __builtin_amdgcn_mfma_f32_16x16x32_bf16(Av, Bp, acc[nt] * scale, 0, 0, 0); }
            asm volatile("s_waitcnt lgkmcnt(0)" ::: "memory");
        }
        const float inv = 1.0f / lrun;
        if (fr < 8) { bf16_t* op = olat + (size_t)tq * 2048 + fr * 256 + 4 * g;
#pragma unroll
            for (int nt = 0; nt < 16; ++nt) { u32x2 o; o.x = cvt_pk_bf16(acc[nt][0] * inv, acc[nt][1] * inv); o.y = cvt_pk_bf16(acc[nt][2] * inv, acc[nt][3] * inv); *(u32x2*)(op + 16 * nt) = o; } }
    }
}

__device__ __forceinline__ void ph_norm_hilo(const Ctx& C, const float* x, const float* g, bf16_t* H, bf16_t* HLO) {
    for (int row = C.gw; row < T; row += C.NGW) {
        const f32x4* xr = (const f32x4*)(x + (size_t)row * DM) + C.lane; f32x4 v[8]; float ss = 0.f;
#pragma unroll
        for (int j = 0; j < 8; ++j) { v[j] = xr[64 * j]; ss += v[j][0] * v[j][0] + v[j][1] * v[j][1] + v[j][2] * v[j][2] + v[j][3] * v[j][3]; }
        const float rstd = rsqrtf(wave_sum(ss, C.lane) * (1.f / DM) + EPS);
        u32x2* oh = (u32x2*)(H + (size_t)row * DM) + C.lane; u32x2* ol = (u32x2*)(HLO + (size_t)row * DM) + C.lane;
#pragma unroll
        for (int j = 0; j < 8; ++j) { const f32x4 gg = ((const f32x4*)g)[64 * j + C.lane]; const f32x4 y = v[j] * rstd * gg; u32x2 wh; wh.x = cvt_pk_bf16(y[0], y[1]); wh.y = cvt_pk_bf16(y[2], y[3]);
            u32x2 wl; wl.x = cvt_pk_bf16(y[0] - bf2f(wh.x), y[1] - bf2f(wh.x >> 16)); wl.y = cvt_pk_bf16(y[2] - bf2f(wh.y), y[3] - bf2f(wh.y >> 16)); oh[64 * j] = wh; ol[64 * j] = wl; }
    }
}
__device__ __forceinline__ void ph_route(const Ctx& C, int l) {
    const float* LOG = WSP(float, WS_OLAT); const float* bg = C.in[I_BGRP] + l * 4; const float* be = C.in[I_BEXP] + l * 32;
    int* rinfo = WSP(int, WS_ROUTE); float* rw = (float*)(rinfo + T * 4); unsigned* cnt = C.ctl + CW_CNT + l * 64;
    LAS int* lcnt = (LAS int*)(C.misc + 600); LAS int* gbase = (LAS int*)(C.misc + 640);
    for (int blk = C.bid; blk < T / 256; blk += C.G) {
        __syncthreads();
        if (C.tid < 32) lcnt[C.tid] = 0;
        __syncthreads();
        const bool act = C.tid < 256; const int t = blk * 256 + (C.tid & 255);
        int e0 = 0, e1 = 0, lr0 = 0, lr1 = 0; float w0 = 0.f, w1 = 0.f;
        if (act) {
        float lg[36];
#pragma unroll
        for (int c = 0; c < 36; ++c) lg[c] = 0.f;
#pragma unroll
        for (int part = 0; part < 4; ++part) { const f32x4* p = (const f32x4*)(LOG + ((size_t)part * T + t) * 128);
#pragma unroll
            for (int c4 = 0; c4 < 9; ++c4) { const f32x4 a = p[c4];
#pragma unroll
                for (int j = 0; j < 4; ++j) lg[4 * c4 + j] += a[j];
                if (part < 2) { const f32x4 b2 = p[16 + c4];
#pragma unroll
                    for (int j = 0; j < 4; ++j) lg[4 * c4 + j] += b2[j]; } } }
        int gsel = 0; float gmax = -INFINITY, gv4[4];
#pragma unroll
        for (int k = 0; k < 4; ++k) { gv4[k] = lg[k] + bg[k]; if (gv4[k] > gmax) { gmax = gv4[k]; gsel = k; } }
        float gden = 0.f;
#pragma unroll
        for (int k = 0; k < 4; ++k) gden += __expf(gv4[k] - gmax);
        const float pg = 1.f / gden;
        float el[8], emax = -INFINITY;
#pragma unroll
        for (int k = 0; k < 8; ++k) { const float v0 = lg[4 + k] + be[k], v1 = lg[12 + k] + be[8 + k], v2 = lg[20 + k] + be[16 + k], v3 = lg[28 + k] + be[24 + k];
            el[k] = gsel == 0 ? v0 : (gsel == 1 ? v1 : (gsel == 2 ? v2 : v3)); emax = fmaxf(emax, el[k]); }
        float eden = 0.f, ep[8];
#pragma unroll
        for (int k = 0; k < 8; ++k) { ep[k] = __expf(el[k] - emax); eden += ep[k]; }
        int i0 = 0; float p0 = -1.f;
#pragma unroll
        for (int k = 0; k < 8; ++k) { ep[k] = ep[k] / eden; if (ep[k] > p0) { p0 = ep[k]; i0 = k; } }
        int i1 = 0; float p1 = -1.f;
#pragma unroll
        for (int k = 0; k < 8; ++k) if (k != i0 && ep[k] > p1) { p1 = ep[k]; i1 = k; }
        const float den = p0 + p1; const int e0_ = gsel * 8 + i0, e1_ = gsel * 8 + i1;
            e0 = e0_; e1 = e1_; w0 = pg * (p0 / den); w1 = pg * (p1 / den);
            lr0 = __hip_atomic_fetch_add(lcnt + e0, 1, __ATOMIC_RELAXED, __HIP_MEMORY_SCOPE_WORKGROUP); lr1 = __hip_atomic_fetch_add(lcnt + e1, 1, __ATOMIC_RELAXED, __HIP_MEMORY_SCOPE_WORKGROUP);
        }
        __syncthreads();
        if (C.tid < 32) { const int c = lcnt[C.tid]; gbase[C.tid] = c ? (int)atomicAdd(&cnt[C.tid], (unsigned)c) : 0; }
        __syncthreads();
        if (act) { const int r0 = gbase[e0] + lr0, r1 = gbase[e1] + lr1;
            int* list = WSP(int, WS_LIST); list[(size_t)e0 * T + r0] = t; list[(size_t)e1 * T + r1] = t;
            *(int4*)(rinfo + (size_t)t * 4) = make_int4(e0, e1, r0, r1); *(f32x2*)(rw + (size_t)t * 2) = (f32x2){w0, w1}; }
    }
}
__device__ __forceinline__ int moe_offsets(const unsigned* cnt, int lane, int& total_tiles) {
    const int c = lane < NEXP ? (int)__hip_atomic_load(cnt + lane, __ATOMIC_RELAXED, __HIP_MEMORY_SCOPE_AGENT) : 0; const int tiles = (c + 255) >> 8;
    int incl = tiles;
#pragma unroll
    for (int o = 1; o < 64; o <<= 1) { const int t = shi(incl, (lane - o) & 63); if (lane >= o) incl += t; }
    total_tiles = shi(incl, 63);
    return (incl - tiles) * 256;
}
__device__ __forceinline__ int moe_table(const Ctx& C, int l) {
    __syncthreads();
    if (C.wave == 0) { int tt; const int off = moe_offsets(C.ctl + CW_CNT + l * 64 + CNT_BANK, C.lane, tt); const int nxt = shi(off, (C.lane + 1) & 63);
        if (C.lane < NEXP) { const int t0 = off >> 8, t1 = (C.lane == NEXP - 1) ? tt : (nxt >> 8); const int cn = (int)__hip_atomic_load(C.ctl + CW_CNT + l * 64 + CNT_BANK + C.lane, __ATOMIC_RELAXED, __HIP_MEMORY_SCOPE_AGENT);
            for (int t = t0; t < t1; ++t) { C.misc[16 + t] = C.lane; C.misc[176 + t] = (t - t0) * 256; C.misc[336 + t] = cn; } }
        if (C.lane == 0) C.misc[500] = tt; }
    __syncthreads();
    return C.misc[500];
}
__device__ __forceinline__ void ph_combine(const Ctx& C, int l, float* x, bool last, const float* gnext, bf16_t* Hn) {
    const bf16_t* yc = WSP(bf16_t, WS_PROJ + M_YC); const int* rinfo = WSP(int, WS_ROUTE); const float* rw = (const float*)(rinfo + T * 4); const int* rpos = rinfo + T * 6; const float* gf = C.in[I_FNG];
    int tt_; const int myoff = moe_offsets(C.ctl + CW_CNT + l * 64 + CNT_BANK, C.lane, tt_);
    for (int row = C.gw; row < T; row += C.NGW) {
        const int4 ri = *(const int4*)(rinfo + (size_t)row * 4); const int p0 = shi(myoff, ri.x) + ri.z, p1 = shi(myoff, ri.y) + ri.w; const float w0 = rw[(size_t)row * 2], w1 = rw[(size_t)row * 2 + 1];
        f32x4* xr = (f32x4*)(x + (size_t)row * DM) + C.lane; const u32x2* y0 = (const u32x2*)(yc + (size_t)p0 * DM) + C.lane; const u32x2* y1 = (const u32x2*)(yc + (size_t)p1 * DM) + C.lane;
        f32x4 v[8]; float ss = 0.f;
#pragma unroll
        for (int j = 0; j < 8; ++j) { const u32x2 a = y0[64 * j], b = y1[64 * j]; f32x4 xv = xr[64 * j];
            xv[0] += w0 * bf2f(a.x) + w1 * bf2f(b.x); xv[1] += w0 * bf2f(a.x >> 16) + w1 * bf2f(b.x >> 16); xv[2] += w0 * bf2f(a.y) + w1 * bf2f(b.y); xv[3] += w0 * bf2f(a.y >> 16) + w1 * bf2f(b.y >> 16);
            v[j] = xv; ss += xv[0] * xv[0] + xv[1] * xv[1] + xv[2] * xv[2] + xv[3] * xv[3]; }
        if (last) { const float rstd = rsqrtf(wave_sum(ss, C.lane) * (1.f / DM) + EPS);
#pragma unroll
            for (int j = 0; j < 8; ++j) xr[64 * j] = v[j] * rstd * ((const f32x4*)gf)[64 * j + C.lane]; }
        else { const float rstd = rsqrtf(wave_sum(ss, C.lane) * (1.f / DM) + EPS); u32x2* o = (u32x2*)(Hn + (size_t)row * DM) + C.lane;
#pragma unroll
            for (int j = 0; j < 8; ++j) { xr[64 * j] = v[j]; const f32x4 y = v[j] * rstd * ((const f32x4*)gnext)[64 * j + C.lane]; u32x2 w; w.x = cvt_pk_bf16(y[0], y[1]); w.y = cvt_pk_bf16(y[2], y[3]); o[64 * j] = w; } }
    }
}

constexpr int NPL = 14, NPHASES = 1 + DEPTH * NPL;
#if MK_PER_PHASE
#define IN(k) (lo <= (k) && (k) < hi)
#else
#define IN(k) true
#endif
#if MK_PER_PHASE
#define SEAM(k) do { } while (0)
#else
#define SEAM(k) xcd_barrier(bar)
#endif
template <int l> __device__ __forceinline__ void run_layer(Ctx& C, const XcdBarrier& bar, const int lo, const int hi) {
    unsigned char* wb = (unsigned char*)(C.ws + WS_W);
    bf16_t* H = WSP(bf16_t, WS_H);
        const int pb = 1 + l * NPL;
        const float* xin = (l == 0) ? C.in[I_X] : (const float*)C.out;
        if (l == 0) { if (IN(pb + 0)) { refresh(C); ph_rope(C); refresh(C); REP(1) ph_weights(C, 0); REP(2) ph_norm(C, xin, C.in[I_NMIX], H); }
            SEAM(pb + 0); }
        if (IN(pb + 1)) { refresh(C);
            pg8::Gemm g{H, (const bf16_t*)(wb + W_IN), DM, DM, DM}; pg8::OrderMN S; S.init(T / 256, NP / 256, C.G, C.bid, 256L * DM * 2, 256L * DM * 2);
            pg8::EpiInProj E{(unsigned char*)C.ws};
            REP(3) pg8::gemm_phase(C.lds, g, S, E);
        }
        SEAM(pb + 1);
        if (IN(pb + 2)) { refresh(C);
            ph_ckv(C, WSP(float, WS_PROJ + P_DC), C.in[I_KVG] + l * 256, WSP(bf16_t, WS_CKV));
            { pg8::Gemm g{WSP(bf16_t, WS_PROJ + P_DQ), (const bf16_t*)(wb + W_UK), 1024, 256, 256}; pg8::OrderMN S; S.init(T / 256, 8, C.G, C.bid, 256L * 1024 * 2, 256L * 256 * 2, 1, 256L * 2);
              pg8::EpiStore<0> E{WSP(bf16_t, WS_QABS), 2048, 0.08838834764831845f}; REP(4) pg8::gemm_phase(C.lds, g, S, E); }
            refresh(C);
            REP(5) ph_gmlp(C, l);
            refresh(C);
            REP(6) ph_ret_kv(C);
            refresh(C);
            REP(7) ph_idx(C, l);
        }
        SEAM(pb + 2);
        if (IN(pb + 3)) { refresh(C);
            REP(8) ph_ret_scan(C);
            REP(9) ph_att(C);
        }
        SEAM(pb + 3);
        if (IN(pb + 4)) { refresh(C);
            { pg8::Gemm g{WSP(bf16_t, WS_OLAT), (const bf16_t*)(wb + W_UV), 2048, 512, 512}; pg8::OrderMN S; S.init(T / 256, 4, C.G, C.bid, 256L * 2048 * 2, 256L * 512 * 2, 0, 512L * 2);
              pg8::EpiStore<0> E{WSP(bf16_t, WS_DS), 1024, 1.0f}; REP(10) pg8::gemm_phase(C.lds, g, S, E); }
            REP(11) ph_ret_out(C);
        }
        SEAM(pb + 4);
        if (IN(pb + 5)) { refresh(C);
            pg8::Gemm g{WSP(bf16_t, WS_RET), (const bf16_t*)(wb + W_RET), 1024, 1024, 1024}; pg8::OrderBranch S; S.base.init(T / 256, 8, C.G, C.bid, 256L * 1024 * 2, 256L * 1024 * 2); S.astride = 32L << 20; S.bstride = 4L << 20;
            pg8::EpiBranch E{WSP(bf16_t, WS_PROJ + P_GA), H}; REP(12) pg8::gemm_phase<pg8::EpiBranch, pg8::OrderBranch, false, true>(C.lds, g, S, E);
        }
        SEAM(pb + 5);
        if (IN(pb + 6)) { refresh(C);
            pg8::Gemm g{H, (const bf16_t*)(wb + W_OUT), DM, DM, DM}; pg8::OrderMN S; S.init(T / 256, 8, C.G, C.bid, 256L * DM * 2, 256L * DM * 2);
            pg8::EpiResid E{xin, C.out}; for (int rep_ = 0; rep_ <= ((l == 0) ? ((PROBE_MASK >> 17) & 1) : 0); ++rep_) pg8::gemm_phase(C.lds, g, S, E);
        }
        SEAM(pb + 6);
        if (IN(pb + 7)) { refresh(C); ph_norm_hilo(C, C.out, C.in[I_NFFN] + l * DM, H, WSP(bf16_t, WS_QABS)); }
        SEAM(pb + 7);
        if (IN(pb + 8)) { refresh(C);
            pg8::Gemm g{H, (const bf16_t*)(wb + W_RT), DM, DM, 1024}; pg8::OrderRouter S{C.G, C.bid, (long)(WS_QABS - WS_H)};
            pg8::EpiRouter E{WSP(float, WS_OLAT)}; pg8::gemm_phase(C.lds, g, S, E);
        }
        SEAM(pb + 8);
        if (IN(pb + 9)) { refresh(C); ph_route(C, l); }
        SEAM(pb + 9);
        if (IN(pb + 11)) { refresh(C);
            const int Mt = moe_table(C, l);
            pg8::Gemm g{H, (const bf16_t*)(wb + W_13), DM, DM, DM};
            pg8::OrderMoE S{C.misc + 16, Mt, 4, C.G, C.bid, 256L * DM * 2, 256L * DM * 2, 1024L * DM * 2, WSP(int, WS_LIST)};
            pg8::EpiMoeUp E{WSP(bf16_t, WS_PROJ + M_HID)}; REP(14) pg8::gemm_phase<pg8::EpiMoeUp, pg8::OrderMoE, true>(C.lds, g, S, E);
        }
        SEAM(pb + 11);
        if (IN(pb + 12)) { refresh(C);
            const int Mt = moe_table(C, l);
            pg8::Gemm g{WSP(bf16_t, WS_PROJ + M_HID), (const bf16_t*)(wb + W_2), FF, FF, FF};
            pg8::OrderMoE S{C.misc + 16, Mt, 8, C.G, C.bid, 256L * FF * 2, 256L * FF * 2, (long)DM * FF * 2, nullptr};
            pg8::EpiStore<0> E{WSP(bf16_t, WS_PROJ + M_YC), DM, 1.0f}; REP(15) pg8::gemm_phase(C.lds, g, S, E);
        }
        SEAM(pb + 12);
        if (IN(pb + 13)) { refresh(C); ph_combine(C, l, C.out, l == DEPTH - 1, C.in[I_NMIX] + (l + 1 < DEPTH ? l + 1 : l) * DM, H); if (l + 1 < DEPTH) { refresh(C); ph_weights(C, l + 1); } }
        if (l + 1 < DEPTH) SEAM(pb + 13);

}
__global__ void __launch_bounds__(512, 2) mk_fwd(Args a) {
    extern __shared__ __attribute__((aligned(16))) unsigned char lds_raw[];
    Ctx C;
    C.lds = (LAS unsigned char*)lds_raw; C.misc = (volatile LAS int*)(C.lds + MISC_OFF); C.ws = (GAS unsigned char*)a.ws; C.ctl = (unsigned*)(a.ws + WS_CTL);
    C.tid = threadIdx.x; C.lane = C.tid & 63; C.wave = __builtin_amdgcn_readfirstlane(C.tid >> 6); C.G = gridDim.x; C.bid = blockIdx.x;
    C.gw = C.bid * 8 + C.wave; C.NGW = C.G * 8; C.in = a.in; C.out = a.out;
    for (int i = C.tid; i < 1024; i += 512) C.misc[i] = 0;
    __syncthreads();
#if MK_PER_PHASE
    XcdBarrier bar; bar.bar = C.ctl + CW_BAR; bar.x = 0; bar.st = (volatile LAS unsigned*)C.misc;
#else
    XcdBarrier bar = xcd_barrier_post(C.ctl + CW_BAR, (volatile LAS unsigned*)C.misc);
#endif
    const int lo = a.ph_lo, hi = a.ph_hi;
    run_layer<0>(C, bar, lo, hi);
    run_layer<1>(C, bar, lo, hi);
}

extern "C" void kernel_launch(void* const* d_in, const int* in_sizes, int n_in, void* d_out, int out_size, void* d_ws, size_t ws_size, hipStream_t stream) {
    static int grid = 0;
    if (grid == 0) {
        if (n_in != 23 || out_size != T * DM || ws_size < WS_END) { fprintf(stderr, "kernel_launch: unexpected shapes / workspace (n_in %d out %d ws %zu need %zu)\n", n_in, out_size, ws_size, (size_t)WS_END); grid = -1; return; }
        int dev = 0, cus = 0, per_cu = 0;
        if (hipGetDevice(&dev) != hipSuccess || hipDeviceGetAttribute(&cus, hipDeviceAttributeMultiprocessorCount, dev) != hipSuccess) { grid = -1; return; }
        if (hipFuncSetAttribute((const void*)mk_fwd, hipFuncAttributeMaxDynamicSharedMemorySize, LDS_BYTES) != hipSuccess) { fprintf(stderr, "kernel_launch: hipFuncSetAttribute failed\n"); grid = -1; return; }
        if (hipOccupancyMaxActiveBlocksPerMultiprocessor(&per_cu, (const void*)mk_fwd, 512, LDS_BYTES) != hipSuccess || per_cu < 1) { fprintf(stderr, "kernel_launch: occupancy query says %d\n", per_cu); (void)hipGetLastError(); grid = -1; return; }
        grid = cus;
    }
    if (grid < 0) return;
    (void)hipMemsetAsync((char*)d_ws + WS_CTL, 0, CTL_BYTES, stream);
    Args a{};
    for (int i = 0; i < 23; ++i) a.in[i] = (const float*)d_in[i];
    a.out = (float*)d_out; a.ws = (unsigned char*)d_ws;
#if MK_PER_PHASE
    for (int p = 0; p < NPHASES; ++p) { a.ph_lo = p; a.ph_hi = p + 1; hipLaunchKernelGGL(mk_fwd, dim3(grid), dim3(512), LDS_BYTES, stream, a); }
#else
    a.ph_lo = 0; a.ph_hi = NPHASES;
    hipLaunchKernelGGL(mk_fwd, dim3(grid), dim3(512), LDS_BYTES, stream, a);
#endif
}
```

```cpp
#include <hip/hip_runtime.h>
#include <stdint.h>
#include <stdio.h>

#ifndef MK_PER_PHASE
#define MK_PER_PHASE 0
#endif
#ifndef PROBE_MASK
#define PROBE_MASK 0
#endif
#define CNT_BANK (((PROBE_MASK >> 16) & 1) * 128)
#define REP(k) for (int rep_ = 0; rep_ <= ((PROBE_MASK >> (k)) & 1); ++rep_)

#define LAS __attribute__((address_space(3)))
#define GAS __attribute__((address_space(1)))
typedef unsigned short bf16_t;
typedef short bf16x8 __attribute__((ext_vector_type(8)));
typedef short s16x4 __attribute__((ext_vector_type(4)));
typedef float f32x4 __attribute__((ext_vector_type(4)));
typedef float f32x2 __attribute__((ext_vector_type(2)));
typedef float f32x16 __attribute__((ext_vector_type(16)));
typedef unsigned u32x4 __attribute__((ext_vector_type(4)));
typedef unsigned u32x2 __attribute__((ext_vector_type(2)));

constexpr int DM = 2048, NB = 4, SEQ = 4096, T = NB * SEQ, DEPTH = 2;
constexpr int INW = 14152, NP = 14336;
constexpr int GATE_SRC0 = 8008, GATE_DST0 = 8192;
constexpr int NEXP = 32, FF = 512, MOE_ROWS = 40960;
constexpr float EPS = 1e-6f;
constexpr int FP8_B0 = 28, FP8_B1 = 32;
constexpr float A8_SCALE = 8.f, W8_SCALE = 64.f;

constexpr size_t MiB = 1u << 20;
constexpr size_t WS_CTL = 0, CTL_BYTES = 1 * MiB;
constexpr size_t WS_ROPE = 1 * MiB;
constexpr size_t WS_W = 5 * MiB;
constexpr size_t W_IN = 0, W_RET = 56 * MiB, W_GM = 60 * MiB, W_DS = 64 * MiB, W_OUT = 68 * MiB, W_13 = 76 * MiB, W_2 = 204 * MiB, W_UK = 268 * MiB, W_UV = 269 * MiB, W_RT = 270 * MiB  , W_END = 271 * MiB;
constexpr size_t WS_H = WS_W + W_END;
constexpr size_t WS_PROJ = WS_H + 64 * MiB;
constexpr size_t P_RQ = 0, P_RK = 32 * MiB, P_RV = 64 * MiB, P_RG = 96 * MiB, P_GU = 128 * MiB, P_GV = 160 * MiB, P_DQ = 192 * MiB, P_DC = 224 * MiB  ,
                 P_IQ = 240 * MiB  , P_IK = 256 * MiB  , P_IW = 258 * MiB  , P_GA = 260 * MiB, P_GB = 324 * MiB, P_GC = 388 * MiB, P_END = 452 * MiB;
constexpr size_t M_HPERM = 0, M_HID = 160 * MiB, M_YC = 200 * MiB;
constexpr size_t WS_KV = WS_PROJ + P_END;
constexpr size_t WS_R = WS_KV + 64 * MiB;
constexpr size_t WS_QABS = WS_R + 64 * MiB;
constexpr size_t WS_OLAT = WS_QABS + 64 * MiB;
constexpr size_t WS_H8 = WS_QABS;
constexpr size_t WS_RET = WS_OLAT + 64 * MiB;
constexpr size_t WS_GM = WS_RET + 32 * MiB, WS_DS = WS_GM + 32 * MiB;
constexpr size_t WS_SEL = WS_DS + 32 * MiB;
constexpr size_t WS_CKV = WS_SEL + 8 * MiB;
constexpr size_t WS_STATS = WS_CKV + 8 * MiB;
constexpr size_t WS_ROUTE = WS_STATS + 2 * MiB;
constexpr size_t WS_LIST = WS_ROUTE + 1 * MiB;
constexpr size_t WS_END = WS_LIST + 2 * MiB;
constexpr int CW_BAR = 4096, CW_CNT = 16384;
constexpr int CW_Q = 32768;

constexpr int LDS_BYTES = 147456, MISC_OFF = LDS_BYTES - 4096;

__device__ __forceinline__ unsigned f2bf(float f) { unsigned u = __builtin_bit_cast(unsigned, f); return (u + 0x7fffu + ((u >> 16) & 1u)) >> 16; }
__device__ __forceinline__ float bf2f(unsigned b) { return __builtin_bit_cast(float, (b & 0xffffu) << 16); }
typedef __bf16 bf16x2_t __attribute__((ext_vector_type(2)));
__device__ __forceinline__ unsigned cvt_pk_bf16(float lo, float hi) { const f32x2 v = {lo, hi}; return __builtin_bit_cast(unsigned, __builtin_convertvector(v, bf16x2_t)); }
__device__ __forceinline__ float clamp448(float v) { return fminf(fmaxf(v, -448.f), 448.f); }
__device__ __forceinline__ unsigned cvt_pk_fp8x2(float a, float b2) { return (unsigned)__builtin_amdgcn_cvt_pk_fp8_f32(clamp448(a), clamp448(b2), 0, false) & 0xffffu; }
__device__ __forceinline__ unsigned cvt_pk_fp8x4(float a, float b2, float c, float d) { int w = __builtin_amdgcn_cvt_pk_fp8_f32(clamp448(a), clamp448(b2), 0, false); w = __builtin_amdgcn_cvt_pk_fp8_f32(clamp448(c), clamp448(d), w, true); return (unsigned)w; }
__device__ __forceinline__ float shx(float v, int k, int lane) { return __builtin_bit_cast(float, __builtin_amdgcn_ds_bpermute((lane ^ k) << 2, __builtin_bit_cast(int, v))); }
__device__ __forceinline__ void swap32_(float& a, float& b) { asm volatile("v_nop\n\tv_nop\n\tv_permlane32_swap_b32 %0, %1\n\tv_nop" : "+v"(a), "+v"(b)); }
__device__ __forceinline__ void swap16_(float& a, float& b) { asm volatile("v_nop\n\tv_nop\n\tv_permlane16_swap_b32 %0, %1\n\tv_nop" : "+v"(a), "+v"(b)); }
__device__ __forceinline__ float quad_sum(float v) { float a = v, b = v; swap32_(a, b); v = a + b; a = v; b = v; swap16_(a, b); return a + b; }
__device__ __forceinline__ float quad_max(float v) { float a = v, b = v; swap32_(a, b); v = fmaxf(a, b); a = v; b = v; swap16_(a, b); return fmaxf(a, b); }
__device__ __forceinline__ int shi(int v, int src) { return __builtin_amdgcn_ds_bpermute(src << 2, v); }
typedef unsigned short u16x2 __attribute__((ext_vector_type(2)));
__device__ __forceinline__ unsigned pk_below(unsigned x, unsigned cm1, unsigned cnt) {
    u16x2 r = __builtin_elementwise_sub_sat(__builtin_bit_cast(u16x2, x), __builtin_bit_cast(u16x2, cm1)); unsigned ru = __builtin_bit_cast(unsigned, r); asm volatile("" : "+v"(ru));
    r = __builtin_elementwise_sub_sat((u16x2){1, 1}, __builtin_bit_cast(u16x2, ru)); ru = __builtin_bit_cast(unsigned, r); asm volatile("" : "+v"(ru));
    return __builtin_bit_cast(unsigned, (u16x2)(__builtin_bit_cast(u16x2, cnt) + __builtin_bit_cast(u16x2, ru)));
}
__device__ __forceinline__ int wave_total_dpp(int x) {
    x += __builtin_amdgcn_update_dpp(0, x, 0x111, 0xf, 0xf, false);
    x += __builtin_amdgcn_update_dpp(0, x, 0x112, 0xf, 0xf, false);
    x += __builtin_amdgcn_update_dpp(0, x, 0x114, 0xf, 0xf, false);
    x += __builtin_amdgcn_update_dpp(0, x, 0x118, 0xf, 0xf, false);
    x += __builtin_amdgcn_update_dpp(0, x, 0x142, 0xa, 0xf, false);
    x += __builtin_amdgcn_update_dpp(0, x, 0x143, 0xc, 0xf, false);
    return __builtin_amdgcn_readlane(x, 63);
}
__device__ __forceinline__ float wave_sum(float v, int lane) {
#pragma unroll
    for (int o = 1; o < 64; o <<= 1) v += shx(v, o, lane);
    return v;
}
__device__ __forceinline__ float wave_max(float v, int lane) {
#pragma unroll
    for (int o = 1; o < 64; o <<= 1) v = fmaxf(v, shx(v, o, lane));
    return v;
}
__device__ __forceinline__ float sigmoidf_(float x) { return __builtin_amdgcn_rcpf(1.0f + __builtin_amdgcn_exp2f(x * -1.44269504089f)); }
__device__ __forceinline__ float siluf_(float x) { return x * sigmoidf_(x); }
__device__ __forceinline__ f32x2 gelu_pk(f32x2 v) {
    const f32x2 av = __builtin_elementwise_abs(v), d = av * 0.2316418882f + 1.0f;
    f32x2 t; t.x = __builtin_amdgcn_rcpf(d.x); t.y = __builtin_amdgcn_rcpf(d.y);
    f32x2 q = t * 0.5307027145f + (-0.7265760135f); q = q * t + 0.7107068705f; q = q * t + (-0.142248368f); q = q * t + 0.127414796f; q = q * t;
    const f32x2 s = (v * v) * (-0.72134752044f);
    f32x2 e; e.x = __builtin_amdgcn_exp2f(s.x); e.y = __builtin_amdgcn_exp2f(s.y);
    const f32x2 m = v * (q * e), r = v - m;
    f32x2 o; o.x = v.x < 0.f ? m.x : r.x; o.y = v.y < 0.f ? m.y : r.y; return o;
}
template <int ACT> __device__ __forceinline__ f32x4 act4(f32x4 v) {
    if (ACT == 1) { f32x2 a = gelu_pk((f32x2){v[0], v[1]}), b = gelu_pk((f32x2){v[2], v[3]}); return (f32x4){a.x, a.y, b.x, b.y}; }
    if (ACT == 2) return (f32x4){siluf_(v[0]), siluf_(v[1]), siluf_(v[2]), siluf_(v[3])};
    if (ACT == 3) return (f32x4){sigmoidf_(v[0]), sigmoidf_(v[1]), sigmoidf_(v[2]), sigmoidf_(v[3])};
    return v;
}
__device__ __forceinline__ u32x4 pack8(f32x4 a, f32x4 b) { u32x4 w; w.x = cvt_pk_bf16(a[0], a[1]); w.y = cvt_pk_bf16(a[2], a[3]); w.z = cvt_pk_bf16(b[0], b[1]); w.w = cvt_pk_bf16(b[2], b[3]); return w; }
__device__ __forceinline__ void unpack8(u32x4 w, float (&f)[8]) {
    f[0] = bf2f(w.x); f[1] = bf2f(w.x >> 16); f[2] = bf2f(w.y); f[3] = bf2f(w.y >> 16); f[4] = bf2f(w.z); f[5] = bf2f(w.z >> 16); f[6] = bf2f(w.w); f[7] = bf2f(w.w >> 16);
}

#define XB_TMO      128
#define XB_XCNT(j)  (256  + 64 * (j))
#define XB_XSUB(j)  (1280 + 64 * (j))
#define XB_XGEN(j)  (2304 + 64 * (j))
#define XB_TOP      3328
#define XB_TOPGEN   3392
#define XCD_BAR_WORDS 3456
#define XB_SPIN_CAP (1u << 20)
__device__ __forceinline__ unsigned xb_ld(unsigned* p)              { return __hip_atomic_load(p, __ATOMIC_RELAXED, __HIP_MEMORY_SCOPE_AGENT); }
__device__ __forceinline__ unsigned xb_add(unsigned* p, unsigned v) { return __hip_atomic_fetch_add(p, v, __ATOMIC_RELAXED, __HIP_MEMORY_SCOPE_AGENT); }
__device__ __forceinline__ unsigned xb_xcc_id() { return (unsigned)__builtin_amdgcn_s_getreg((3 << 11) | 20) & 0xFu; }
#define XB_SPIN(cond, bar) do { unsigned _sp = 0; while (cond) { __builtin_amdgcn_s_sleep(1); \
    if ((++_sp & 255u) == 0u) { if (xb_ld(&(bar)[XB_TMO])) break; if (_sp > XB_SPIN_CAP) { atomicAdd(&(bar)[XB_TMO], 1u); break; } } } } while (0)
struct XcdBarrier { unsigned* bar; unsigned x; volatile LAS unsigned* st; };
__device__ __forceinline__ XcdBarrier xcd_barrier_post(unsigned* bar, volatile LAS unsigned* st) {
    XcdBarrier b; b.bar = bar; b.x = xb_xcc_id(); b.st = st;
    if (threadIdx.x == 0) (void)xb_add(&bar[XB_XCNT(b.x)], 1u);
    return b;
}
__device__ __forceinline__ void xcd_barrier_complete(unsigned* bar, unsigned x, unsigned& nloc, unsigned& nx) {
    const unsigned G = gridDim.x * gridDim.y * gridDim.z;
    unsigned sum, cnt, mine, sp = 0u;
    for (;;) {
        sum = 0u; cnt = 0u; mine = 0u;
#pragma unroll
        for (unsigned j = 0; j < 16; ++j) { const unsigned c = xb_ld(&bar[XB_XCNT(j)]); sum += c; cnt += (c > 0u) ? 1u : 0u; mine = (j == x) ? c : mine; }
        if (sum == G) break;
        __builtin_amdgcn_s_sleep(1);
        if ((++sp & 255u) == 0u) { if (xb_ld(&bar[XB_TMO])) break; if (sp > XB_SPIN_CAP) { atomicAdd(&bar[XB_TMO], 1u); break; } }
    }
    nloc = mine > 0u ? mine : 1u; nx = cnt > 0u ? cnt : 1u;
}
__device__ __forceinline__ void xcd_barrier(const XcdBarrier& b) {
    asm volatile("s_waitcnt vmcnt(0)" ::: "memory");
    __syncthreads();
    if (threadIdx.x == 0) {
        unsigned* bar = b.bar; asm volatile("" : "+s"(bar));
        __builtin_amdgcn_s_waitcnt(0);
        unsigned nloc = b.st[0], nx = b.st[1];
        if (nloc == 0u) { xcd_barrier_complete(bar, b.x, nloc, nx); b.st[0] = nloc; b.st[1] = nx; }
        const unsigned old = xb_add(&bar[XB_XSUB(b.x)], 1u);
        const unsigned gen = old / nloc;
        if (old + 1u == (gen + 1u) * nloc) {
            __builtin_amdgcn_fence(__ATOMIC_RELEASE, "agent");
            asm volatile("s_waitcnt vmcnt(0)" ::: "memory");
            const unsigned og = xb_add(&bar[XB_TOP], 1u);
            const unsigned tg = og / nx;
            if (og + 1u == (tg + 1u) * nx) xb_add(&bar[XB_TOPGEN], 1u);
            else XB_SPIN(xb_ld(&bar[XB_TOPGEN]) == tg, bar);
            __builtin_amdgcn_fence(__ATOMIC_ACQUIRE, "agent");
            xb_add(&bar[XB_XGEN(b.x)], 1u);
            asm volatile("s_waitcnt vmcnt(0)" ::: "memory");
        } else {
            XB_SPIN(xb_ld(&bar[XB_XGEN(b.x)]) == gen, bar);
            __builtin_amdgcn_fence(__ATOMIC_ACQUIRE, "agent");
            asm volatile("s_waitcnt vmcnt(0)" ::: "memory");
        }
    }
    __syncthreads();
}

namespace pg8 {
constexpr int BM = 256, BK = 64, HALF = 128, HTB = HALF * BK * 2, STAGE_BYTES = 8 * HTB, NXCD = 8, WGM = 8;
__host__ __device__ __forceinline__ int lds_byte(int r, int c) { const int st = (r >> 4) * 2 + (c >> 5), rr = r & 15, cc = c & 31, ob = rr * 64 + cc * 2; return st * 1024 + (ob ^ (((ob >> 9) & 1) << 5)); }
__host__ __device__ __forceinline__ void stage_rc(int b, int& R, int& C) { const int st = b / 1024, sb = b % 1024, swz = sb ^ (((sb >> 9) & 1) << 5); R = (st >> 1) * 16 + swz / 64; C = (st & 1) * 32 + (swz % 64) / 2; }
__host__ __device__ __forceinline__ int perm32(int rho) { const int n = rho >> 4, i = rho & 15; return 8 * (i >> 2) + 4 * n + (i & 3); }

struct Unit { int pm, pn; long aoff, boff; };
struct Gemm { const bf16_t* A; const bf16_t* Bt; int lda, ldb, K; };

struct OrderMN {
    int nM, nN, nwg, G, c, ashift; long astep, bstep, abytes; int ps0 = 1 << 30, psn = 0;
    __device__ __forceinline__ int gather_row(const Unit&, int) const { return 0; }
    __device__ void init(int nM_, int nN_, int G_, int c_, long astep_, long bstep_, int ashift_ = 0, long abytes_ = 0) { nM = nM_; nN = nN_; nwg = nM * nN; G = G_; c = c_; astep = astep_; bstep = bstep_; ashift = ashift_; abytes = abytes_; }
    __device__ bool next(int i, Unit& u) const {
        const long L = (long)i * G + c; if (L >= nwg) return false;
        int wgid = (int)L; { const int q = nwg / NXCD, r = nwg % NXCD, xcd = wgid % NXCD, off = wgid / NXCD; wgid = (xcd < r ? xcd * (q + 1) : r * (q + 1) + (xcd - r) * q) + off; }
        const int nig = WGM * nN, gid = wgid / nig, fm = gid * WGM, gsz = (nM - fm) < WGM ? (nM - fm) : WGM;
        u.pm = fm + ((wgid % nig) % gsz); u.pn = (wgid % nig) / gsz; if (u.pn >= ps0) u.pn += psn;
        u.aoff = (long)u.pm * astep + (long)(u.pn >> ashift) * abytes; u.boff = (long)u.pn * bstep; return true;
    }
};
struct OrderMoE {
    const volatile LAS int* te; int Mt, nN, G, c; long astep, bstep, estep; const int* list;
    __device__ __forceinline__ int gather_row(const Unit& u, int r) const { const int e = te[u.pm], rb = te[160 + u.pm] + r; return rb < te[320 + u.pm] ? list[(size_t)e * T + rb] : 0; }
    __device__ bool next(int i, Unit& u) const {
        const long L = (long)i * G + c; if (L >= (long)Mt * nN) return false;
        u.pm = (int)(L / nN); u.pn = (int)(L % nN);
        u.aoff = (long)u.pm * astep; u.boff = (long)te[u.pm] * estep + (long)u.pn * bstep; return true;
    }
};

typedef int i32x8 __attribute__((ext_vector_type(8)));
__device__ __forceinline__ i32x8 cat8(bf16x8 lo, bf16x8 hi) { const u32x4 a = __builtin_bit_cast(u32x4, lo), b = __builtin_bit_cast(u32x4, hi); return (i32x8){(int)a.x, (int)a.y, (int)a.z, (int)a.w, (int)b.x, (int)b.y, (int)b.z, (int)b.w}; }
template <class Epi, class Sched, bool GATH = false, bool KEEPACC = false, bool ALIGN_EPI = true, bool SP2 = true, bool FP8 = false>
__device__ __forceinline__ void gemm_phase(LAS unsigned char* lds, const Gemm g, const Sched& S, const Epi& E) {
    int tid_ = threadIdx.x; asm volatile("" : "+v"(tid_));
    const GAS bf16_t* gA = (const GAS bf16_t*)g.A; const GAS bf16_t* gB = (const GAS bf16_t*)g.Bt; asm volatile("" : "+s"(gA), "+s"(gB));
    const int tid = tid_, wid = __builtin_amdgcn_readfirstlane(tid >> 6), lane = tid & 63, wr = wid >> 2, wc = wid & 3, fr = lane & 15, fq = lane >> 4;
    const int K = g.K, nt = K / BK;
    unsigned voffA[2], voffB[2];
#pragma unroll
    for (int i = 0; i < 2; ++i) { int R, C; stage_rc(tid * 16 + i * 8192, R, C); const int Rb = Epi::PERM ? ((R & ~31) + perm32(R & 31)) : R;
        voffA[i] = (unsigned)(R * g.lda + C) * 2u; voffB[i] = (unsigned)(Rb * g.ldb + C) * 2u; }
    const size_t kstep = (size_t)(BK * 2);
    const size_t hstepA = GATH ? (size_t)0 : (size_t)HALF * g.lda * 2, hstepB = (size_t)HALF * g.ldb * 2;
    unsigned gAc[2][2], gAn[2][2]; int gR[2], gC[2];
#pragma unroll
    for (int i = 0; i < 2; ++i) { stage_rc(tid * 16 + i * 8192, gR[i], gC[i]); gAc[0][i] = gAc[1][i] = gAn[0][i] = gAn[1][i] = 0u; }
#define PG8_GLOAD(dst, un) do { _Pragma("unroll") for (int h_ = 0; h_ < 2; ++h_) _Pragma("unroll") for (int i_ = 0; i_ < 2; ++i_) \
        dst[h_][i_] = (unsigned)S.gather_row(un, h_ * HALF + gR[i_]) * (unsigned)(g.lda * 2) + (unsigned)(gC[i_] * 2); } while (0)
#define PG8_STAGE_A(bufoff, kptr, h, nx) do { if (GATH) { unsigned vo_[2]; vo_[0] = (nx) ? gAn[h][0] : gAc[h][0]; vo_[1] = (nx) ? gAn[h][1] : gAc[h][1]; PG8_STAGE(bufoff, kptr, vo_); } \
        else PG8_STAGE(bufoff, (kptr) + (h) * hstepA, voffA); } while (0)
    const unsigned ldsw = (unsigned)wid * 1024u;
    const int aoff = lds_byte(wr * 64 + fr, fq * 8), boff = lds_byte(wc * 32 + fr, fq * 8);
#define PG8_SA(b, h) (((b) * 2 + (h)) * HTB)
#define PG8_SB(b, h) ((4 + (b) * 2 + (h)) * HTB)
#define PG8_STAGE(bufoff, gbase, voff) do { _Pragma("unroll") for (int _i = 0; _i < 2; ++_i) \
        __builtin_amdgcn_global_load_lds((const GAS unsigned*)((gbase) + (voff)[_i]), (LAS unsigned*)(lds + (bufoff) + ldsw + _i * 8192), 16, 0, 0); } while (0)
#define PG8_LDA(dst, b, h) do { _Pragma("unroll") for (int m = 0; m < 4; ++m) _Pragma("unroll") for (int k = 0; k < 2; ++k) dst[m][k] = *(const LAS bf16x8*)(lds + PG8_SA(b, h) + aoff + m * 2048 + k * 1024); } while (0)
#define PG8_LDB(dst, b, h) do { _Pragma("unroll") for (int n = 0; n < 2; ++n) _Pragma("unroll") for (int k = 0; k < 2; ++k) dst[n][k] = *(const LAS bf16x8*)(lds + PG8_SB(b, h) + boff + n * 2048 + k * 1024); } while (0)
#define PG8_MMA(ai, bj, At, Bt) do { __builtin_amdgcn_s_setprio(1); _Pragma("unroll") for (int m = 0; m < 4; ++m) _Pragma("unroll") for (int n = 0; n < 2; ++n) { \
        if constexpr (FP8) { const i32x8 b8_ = cat8(Bt[n][0], Bt[n][1]), a8_ = cat8(At[m][0], At[m][1]);   \
            asm("v_mfma_scale_f32_16x16x128_f8f6f4 %0, %1, %2, %0, %3, %4 op_sel_hi:[0,0,0]" : "+v"(acc[ai][bj][m][n]) : "v"(b8_), "v"(a8_), "v"(scW), "v"(scA)); } \
        else { _Pragma("unroll") for (int k = 0; k < 2; ++k) acc[ai][bj][m][n] = __builtin_amdgcn_mfma_f32_16x16x32_bf16(Bt[n][k], At[m][k], acc[ai][bj][m][n], 0, 0, 0); } } __builtin_amdgcn_s_setprio(0); } while (0)
#define PG8_WAIT_V(n) asm volatile("s_waitcnt vmcnt(" #n ")" ::: "memory")
#define PG8_WAIT_L(n) asm volatile("s_waitcnt lgkmcnt(" #n ")" ::: "memory")
#define PG8_BAR __builtin_amdgcn_s_barrier()
#define PG8_SCHED __builtin_amdgcn_sched_barrier(0)
    Unit cur, nxt; int ui = 0;
    if (!S.next(0, cur)) return;
    const int scW = 121, scA = 124;
    f32x4 acc[2][2][4][2];
#pragma unroll
    for (int a = 0; a < 2; ++a)
#pragma unroll
        for (int b = 0; b < 2; ++b)
#pragma unroll
            for (int m = 0; m < 4; ++m)
#pragma unroll
                for (int n = 0; n < 2; ++n) acc[a][b][m][n] = (f32x4){0.f, 0.f, 0.f, 0.f};
    bf16x8 At[4][2], B0[2][2], B1[2][2];
    const GAS char* cA = (const GAS char*)gA + (GATH ? 0L : cur.aoff); const GAS char* cB = (const GAS char*)gB + cur.boff;
    if (GATH) PG8_GLOAD(gAc, cur);
    if constexpr (SP2) {
        PG8_STAGE(PG8_SB(0, 0), cB, voffB); PG8_STAGE(PG8_SB(0, 1), cB + hstepB, voffB); PG8_STAGE_A(PG8_SA(0, 0), cA, 0, false); PG8_STAGE_A(PG8_SA(0, 1), cA, 1, false);
        if (wr == 1) PG8_BAR;
        PG8_WAIT_V(2); PG8_BAR;
        PG8_STAGE(PG8_SB(1, 0), cB + kstep, voffB); PG8_STAGE_A(PG8_SA(1, 0), cA + kstep, 0, false); PG8_STAGE(PG8_SB(1, 1), cB + hstepB + kstep, voffB);
        PG8_WAIT_V(6); PG8_BAR;
    } else {
    PG8_STAGE(PG8_SB(0, 0), cB, voffB); PG8_STAGE_A(PG8_SA(0, 0), cA, 0, false); PG8_STAGE(PG8_SB(0, 1), cB + hstepB, voffB); PG8_STAGE_A(PG8_SA(0, 1), cA, 1, false);
    if (wr == 1) PG8_BAR;
    PG8_WAIT_V(4); PG8_BAR;
    PG8_STAGE(PG8_SB(1, 0), cB + kstep, voffB); PG8_STAGE_A(PG8_SA(1, 0), cA + kstep, 0, false); PG8_STAGE(PG8_SB(1, 1), cB + hstepB + kstep, voffB);
    PG8_WAIT_V(6); PG8_BAR;
    }
    for (;;) {
        const bool has_next = S.next(ui + 1, nxt);
        const GAS char* nA = (has_next && !GATH) ? (const GAS char*)gA + nxt.aoff : cA; const GAS char* nB = has_next ? (const GAS char*)gB + nxt.boff : cB;
        if (GATH) { if (has_next) PG8_GLOAD(gAn, nxt); else { gAn[0][0] = gAc[0][0]; gAn[0][1] = gAc[0][1]; gAn[1][0] = gAc[1][0]; gAn[1][1] = gAc[1][1]; } }
        for (int t = 0; t < nt; t += 2) {
            const bool last = (t == nt - 2);
            const GAS char* a1 = cA + (size_t)(t + 1) * kstep;
            const GAS char* a2 = last ? nA : cA + (size_t)(t + 2) * kstep; const GAS char* b2 = last ? nB : cB + (size_t)(t + 2) * kstep;
            const GAS char* a3 = a2 + kstep; const GAS char* b3 = b2 + kstep;
            if constexpr (SP2) {
            PG8_LDB(B0, 0, 0); PG8_LDB(B1, 0, 1); PG8_SCHED; PG8_LDA(At, 0, 0); PG8_STAGE_A(PG8_SA(1, 1), a1, 1, false);
            PG8_WAIT_V(8); PG8_WAIT_L(0); PG8_BAR; PG8_MMA(0, 0, At, B0); PG8_MMA(0, 1, At, B1); PG8_BAR; PG8_SCHED;
            PG8_LDA(At, 0, 1); PG8_STAGE(PG8_SB(0, 0), b2, voffB); PG8_STAGE(PG8_SB(0, 1), b2 + hstepB, voffB); PG8_STAGE_A(PG8_SA(0, 0), a2, 0, last);
            PG8_WAIT_V(8); PG8_WAIT_L(0); PG8_BAR; PG8_MMA(1, 0, At, B0); PG8_MMA(1, 1, At, B1); PG8_BAR; PG8_SCHED;
            PG8_LDB(B0, 1, 0); PG8_LDB(B1, 1, 1); PG8_SCHED; PG8_LDA(At, 1, 0); PG8_STAGE_A(PG8_SA(0, 1), a2, 1, last);
            PG8_WAIT_V(8); PG8_WAIT_L(0); PG8_BAR; PG8_MMA(0, 0, At, B0); PG8_MMA(0, 1, At, B1); PG8_BAR; PG8_SCHED;
            PG8_LDA(At, 1, 1); PG8_STAGE(PG8_SB(1, 0), b3, voffB); PG8_STAGE(PG8_SB(1, 1), b3 + hstepB, voffB); PG8_STAGE_A(PG8_SA(1, 0), a3, 0, last);
            PG8_WAIT_V(8); PG8_WAIT_L(0); PG8_BAR; PG8_MMA(1, 0, At, B0); PG8_MMA(1, 1, At, B1); PG8_BAR; PG8_SCHED;
            } else {
            PG8_LDB(B0, 0, 0); PG8_SCHED; PG8_LDA(At, 0, 0); PG8_STAGE_A(PG8_SA(1, 1), a1, 1, false);
            PG8_WAIT_L(8); PG8_BAR; PG8_WAIT_L(0); PG8_MMA(0, 0, At, B0); PG8_BAR; PG8_SCHED;
            PG8_LDB(B1, 0, 1); PG8_STAGE(PG8_SB(0, 0), b2, voffB);
            PG8_BAR; PG8_WAIT_L(0); PG8_MMA(0, 1, At, B1); PG8_BAR;
            PG8_LDA(At, 0, 1); PG8_STAGE_A(PG8_SA(0, 0), a2, 0, last);
            PG8_BAR; PG8_WAIT_L(0); PG8_MMA(1, 0, At, B0); PG8_BAR; PG8_SCHED;
            PG8_STAGE(PG8_SB(0, 1), b2 + hstepB, voffB);
            PG8_WAIT_V(6); PG8_BAR; PG8_MMA(1, 1, At, B1); PG8_BAR;
            PG8_LDB(B0, 1, 0); PG8_SCHED; PG8_LDA(At, 1, 0); PG8_STAGE_A(PG8_SA(0, 1), a2, 1, last);
            PG8_WAIT_L(8); PG8_BAR; PG8_WAIT_L(0); PG8_MMA(0, 0, At, B0); PG8_BAR; PG8_SCHED;
            PG8_LDB(B1, 1, 1); PG8_STAGE(PG8_SB(1, 0), b3, voffB);
            PG8_BAR; PG8_WAIT_L(0); PG8_MMA(0, 1, At, B1); PG8_BAR;
            PG8_LDA(At, 1, 1); PG8_STAGE_A(PG8_SA(1, 0), a3, 0, last);
            PG8_BAR; PG8_WAIT_L(0); PG8_MMA(1, 0, At, B0); PG8_BAR; PG8_SCHED;
            PG8_STAGE(PG8_SB(1, 1), b3 + hstepB, voffB);
            PG8_WAIT_V(6); PG8_BAR; PG8_MMA(1, 1, At, B1); PG8_BAR;
            }
        }
        if constexpr (FP8) asm volatile("s_nop 15\n\ts_nop 15" ::: "memory");
        if constexpr (ALIGN_EPI) { if (wr == 0) PG8_BAR; }
        bool zero_acc = true;
        if constexpr (KEEPACC) zero_acc = E.run(acc, cur, wr, wc, fr, fq);
        else E(acc, cur, wr, wc, fr, fq);
        if (!has_next) break;
        if (zero_acc)
#pragma unroll
        for (int a = 0; a < 2; ++a)
#pragma unroll
            for (int b = 0; b < 2; ++b)
#pragma unroll
                for (int m = 0; m < 4; ++m)
#pragma unroll
                    for (int n = 0; n < 2; ++n) acc[a][b][m][n] = (f32x4){0.f, 0.f, 0.f, 0.f};
        cur = nxt; cA = nA; cB = nB; ++ui;
        if (GATH) { gAc[0][0] = gAn[0][0]; gAc[0][1] = gAn[0][1]; gAc[1][0] = gAn[1][0]; gAc[1][1] = gAn[1][1]; }
        if constexpr (ALIGN_EPI) { if (wr == 1) PG8_BAR; }
    }
    PG8_WAIT_V(0);
    if constexpr (!ALIGN_EPI) { if (wr == 0) PG8_BAR; }
    PG8_BAR;
#undef PG8_SA
#undef PG8_SB
#undef PG8_STAGE
#undef PG8_STAGE_A
#undef PG8_GLOAD
#undef PG8_LDA
#undef PG8_LDB
#undef PG8_MMA
#undef PG8_WAIT_V
#undef PG8_WAIT_L
#undef PG8_BAR
#undef PG8_SCHED
}

typedef const f32x4 (&AccT)[2][2][4][2];
template <int ACT> __device__ __forceinline__ void store_tile_bf16(AccT acc, bf16_t* O, int ld, int row0, int colb, float scale) {
#pragma unroll
    for (int ai = 0; ai < 2; ++ai)
#pragma unroll
        for (int m = 0; m < 4; ++m) { bf16_t* rowp = O + (size_t)(row0 + ai * HALF + m * 16) * ld + colb;
#pragma unroll
            for (int bj = 0; bj < 2; ++bj) { const f32x4 v0 = act4<ACT>(acc[ai][bj][m][0] * scale), v1 = act4<ACT>(acc[ai][bj][m][1] * scale);
                *(u32x4*)(rowp + bj * HALF) = pack8(v0, v1); }
            asm volatile("" ::: "memory"); }
}
template <int ACT> struct EpiStore {
    static constexpr bool PERM = true;
    bf16_t* O; int ld; float scale;
    __device__ __forceinline__ void operator()(AccT acc, const Unit& u, int wr, int wc, int fr, int fq) const {
        store_tile_bf16<ACT>(acc, O, ld, u.pm * BM + wr * 64 + fr, u.pn * BM + wc * 32 + 8 * fq, scale);
    }
};
struct EpiInProj {
    static constexpr bool PERM = true;
    unsigned char* ws;
    __device__ __forceinline__ void operator()(AccT acc, const Unit& u, int wr, int wc, int fr, int fq) const {
        const int pn = u.pn, row0 = u.pm * BM + wr * 64 + fr, cw = wc * 32 + 8 * fq;
        unsigned char* pj = ws + WS_PROJ;
        bf16_t *rq = (bf16_t*)(pj + P_RQ), *rk = (bf16_t*)(pj + P_RK), *rv = (bf16_t*)(pj + P_RV), *rg = (bf16_t*)(pj + P_RG), *gu = (bf16_t*)(pj + P_GU), *gv = (bf16_t*)(pj + P_GV), *dq = (bf16_t*)(pj + P_DQ),
               *iq = (bf16_t*)(pj + P_IQ), *ik = (bf16_t*)(pj + P_IK), *ga = (bf16_t*)(pj + P_GA), *gb = (bf16_t*)(pj + P_GB), *gc = (bf16_t*)(pj + P_GC);
        float *dcraw = (float*)(pj + P_DC), *iw = (float*)(pj + P_IW), *gvstats = (float*)(ws + WS_STATS); const float* rope = (const float*)(ws + WS_ROPE);
        if (pn < 8) {
            const bool isk = pn >= 4; bf16_t* dst = (isk ? rk : rq) + (pn & 3) * 256 + cw; const float sc = isk ? 0.0625f : 1.0f;
#pragma unroll
            for (int ai = 0; ai < 2; ++ai) { f32x4 csq[4][4];
#pragma unroll
                for (int m = 0; m < 4; ++m) { const int pos = (row0 + ai * HALF + m * 16) & (SEQ - 1); const f32x4* cs = (const f32x4*)(rope + ((size_t)pos * 128 + cw) * 2);
#pragma unroll
                    for (int q4 = 0; q4 < 4; ++q4) csq[m][q4] = cs[q4]; }
                asm volatile("" ::: "memory");
#pragma unroll
                for (int m = 0; m < 4; ++m) { const int row = row0 + ai * HALF + m * 16;
                    f32x4 o1[2], o2[2];
#pragma unroll
                    for (int n = 0; n < 2; ++n) { const f32x4 c01 = csq[m][2 * n], c23 = csq[m][2 * n + 1]; const f32x4 x1 = acc[ai][0][m][n], x2 = acc[ai][1][m][n];
                        const float co[4] = {c01[0], c01[2], c23[0], c23[2]}, si[4] = {c01[1], c01[3], c23[1], c23[3]};
#pragma unroll
                        for (int j = 0; j < 4; ++j) { o1[n][j] = (x1[j] * co[j] - x2[j] * si[j]) * sc; o2[n][j] = (x1[j] * si[j] + x2[j] * co[j]) * sc; } }
                    bf16_t* rp = dst + (size_t)row * 1024;
                    *(u32x4*)rp = pack8(o1[0], o1[1]); *(u32x4*)(rp + 128) = pack8(o2[0], o2[1]); }
                asm volatile("" ::: "memory"); }
        } else if (pn < 12) { store_tile_bf16<0>(acc, rv, 1024, row0, (pn - 8) * 256 + cw, 1.f);
        } else if (pn < 16) { store_tile_bf16<2>(acc, rg, 1024, row0, (pn - 12) * 256 + cw, 1.f);
        } else if (pn < 20) { store_tile_bf16<1>(acc, gu, 1024, row0, (pn - 16) * 256 + cw, 1.f);
        } else if (pn < 24) {
            const int t4 = pn - 20; bf16_t* dst = gv + t4 * 256 + cw;
#pragma unroll
            for (int ai = 0; ai < 2; ++ai)
#pragma unroll
                for (int m = 0; m < 4; ++m) { const int row = row0 + ai * HALF + m * 16; float s = 0.f, q = 0.f;
#pragma unroll
                    for (int bj = 0; bj < 2; ++bj) { const f32x4 v0 = act4<1>(acc[ai][bj][m][0]), v1 = act4<1>(acc[ai][bj][m][1]);
                        *(u32x4*)(dst + (size_t)row * 1024 + bj * HALF) = pack8(v0, v1);
#pragma unroll
                        for (int j = 0; j < 4; ++j) { s += v0[j] + v1[j]; q += v0[j] * v0[j] + v1[j] * v1[j]; } }
                    s = quad_sum(s); q = quad_sum(q);
                    if (fq == 0) *(f32x2*)(gvstats + ((size_t)row * 16 + t4 * 4 + wc) * 2) = (f32x2){s, q}; asm volatile("" ::: "memory"); }
        } else if (pn < 28) { store_tile_bf16<0>(acc, dq, 1024, row0, (pn - 24) * 256 + cw, 1.f);
        } else if (pn == 28) {
#pragma unroll
            for (int ai = 0; ai < 2; ++ai)
#pragma unroll
                for (int m = 0; m < 4; ++m) { float* rp = dcraw + (size_t)(row0 + ai * HALF + m * 16) * 256 + cw;
#pragma unroll
                    for (int bj = 0; bj < 2; ++bj) { *(f32x4*)(rp + bj * HALF) = acc[ai][bj][m][0]; *(f32x4*)(rp + bj * HALF + 4) = acc[ai][bj][m][1]; } }
        } else if (pn < 31) { store_tile_bf16<0>(acc, iq, 512, row0, (pn - 29) * 256 + cw, 1.f);
        } else if (pn == 31) {
#pragma unroll
            for (int ai = 0; ai < 2; ++ai)
#pragma unroll
                for (int m = 0; m < 4; ++m) { const int row = row0 + ai * HALF + m * 16;
                    if (wc < 2) *(u32x4*)(ik + (size_t)row * 64 + cw) = pack8(acc[ai][0][m][0], acc[ai][0][m][1]);
                    if (wc == 2 && fq == 0) { *(f32x4*)(iw + (size_t)row * 8) = acc[ai][0][m][0] * 0.35355339059f; *(f32x4*)(iw + (size_t)row * 8 + 4) = acc[ai][0][m][1] * 0.35355339059f; } }
        } else { const int gi = (pn - 32) >> 3; bf16_t* dst = gi == 0 ? ga : (gi == 1 ? gb : gc);
            store_tile_bf16<3>(acc, dst, 2048, row0, ((pn - 32) & 7) * 256 + cw, 1.f); }
    }
};
typedef f32x4 (&AccM)[2][2][4][2];
struct EpiBranch {
    static constexpr bool PERM = true;
    const bf16_t* gate0; bf16_t* merged;
    __device__ __forceinline__ bool run(AccM acc, const Unit& u, int wr, int wc, int fr, int fq) const {
        const int br = u.pn >> 8; const bf16_t* gate = gate0 + (size_t)br * (32u << 20); const bf16_t* gnx = gate + (32u << 20);
        const int row0 = u.pm * BM + wr * 64 + fr, colb = (u.pn & 255) * BM + wc * 32 + 8 * fq;
#pragma unroll
        for (int ai = 0; ai < 2; ++ai) {
            u32x4 gq[4][2], nq[4][2];
#pragma unroll
            for (int m = 0; m < 4; ++m)
#pragma unroll
                for (int bj = 0; bj < 2; ++bj) { const size_t ro = (size_t)(row0 + ai * HALF + m * 16) * 2048 + colb + bj * HALF; gq[m][bj] = *(const u32x4*)(gate + ro); nq[m][bj] = *(const u32x4*)((br < 2 ? gnx : gate) + ro); }
            asm volatile("" ::: "memory");
#pragma unroll
            for (int m = 0; m < 4; ++m)
#pragma unroll
                for (int bj = 0; bj < 2; ++bj) { float g8[8], n8[8]; unpack8(gq[m][bj], g8); unpack8(nq[m][bj], n8);
                    f32x4 a0 = acc[ai][bj][m][0], a1 = acc[ai][bj][m][1];
                    if (br < 2) {
#pragma unroll
                        for (int j = 0; j < 4; ++j) { a0[j] *= g8[j] * __builtin_amdgcn_rcpf(fmaxf(n8[j], 1e-30f)); a1[j] *= g8[4 + j] * __builtin_amdgcn_rcpf(fmaxf(n8[4 + j], 1e-30f)); }
                        acc[ai][bj][m][0] = a0; acc[ai][bj][m][1] = a1;
                    } else {
#pragma unroll
                        for (int j = 0; j < 4; ++j) { a0[j] *= g8[j]; a1[j] *= g8[4 + j]; }
                        *(u32x4*)(merged + (size_t)(row0 + ai * HALF + m * 16) * 2048 + colb + bj * HALF) = pack8(a0, a1); } }
            asm volatile("" ::: "memory");
        }
        return br == 2;
    }
};
struct EpiResid {
    static constexpr bool PERM = false;
    const float* xsrc; float* xdst;
    __device__ __forceinline__ void operator()(AccT acc, const Unit& u, int wr, int wc, int fr, int fq) const {
        const int row0 = u.pm * BM + wr * 64 + fr, col0 = u.pn * BM + wc * 32 + 4 * fq;
#pragma unroll
        for (int ai = 0; ai < 2; ++ai)
#pragma unroll
            for (int mp = 0; mp < 2; ++mp) { f32x4 xv[2][2][2];
#pragma unroll
                for (int mm = 0; mm < 2; ++mm)
#pragma unroll
                    for (int bj = 0; bj < 2; ++bj)
#pragma unroll
                        for (int n = 0; n < 2; ++n) xv[mm][bj][n] = *(const f32x4*)(xsrc + (size_t)(row0 + ai * HALF + (2 * mp + mm) * 16) * DM + col0 + bj * HALF + n * 16);
                asm volatile("" ::: "memory");
#pragma unroll
                for (int mm = 0; mm < 2; ++mm)
#pragma unroll
                    for (int bj = 0; bj < 2; ++bj)
#pragma unroll
                        for (int n = 0; n < 2; ++n) *(f32x4*)(xdst + (size_t)(row0 + ai * HALF + (2 * mp + mm) * 16) * DM + col0 + bj * HALF + n * 16) = xv[mm][bj][n] + acc[ai][bj][2 * mp + mm][n];
                asm volatile("" ::: "memory"); }
    }
};
struct EpiMoeUp {
    static constexpr bool PERM = true;
    bf16_t* hid;
    __device__ __forceinline__ void operator()(AccT acc, const Unit& u, int wr, int wc, int fr, int fq) const {
        const int row0 = u.pm * BM + wr * 64 + fr, colb = u.pn * 128 + wc * 32 + 8 * fq;
#pragma unroll
        for (int ai = 0; ai < 2; ++ai)
#pragma unroll
            for (int m = 0; m < 4; ++m) { f32x4 r0, r1; const f32x4 a0 = acc[ai][0][m][0], a1 = acc[ai][0][m][1], b0 = acc[ai][1][m][0], b1 = acc[ai][1][m][1];
#pragma unroll
                for (int j = 0; j < 4; ++j) { r0[j] = siluf_(a0[j]) * b0[j]; r1[j] = siluf_(a1[j]) * b1[j]; }
                *(u32x4*)(hid + (size_t)(row0 + ai * HALF + m * 16) * FF + colb) = pack8(r0, r1); }
    }
};
struct OrderBranch {
    OrderMN base; long astride, bstride;
    __device__ __forceinline__ int gather_row(const Unit&, int) const { return 0; }
    __device__ bool next(int i, Unit& u) const { if (!base.next(i / 3, u)) return false; const int br = i % 3; u.aoff += br * astride; u.boff += br * bstride; u.pn |= br << 8; return true; }
};
struct OrderRouter {
    int G, c; long hlo_off;
    __device__ __forceinline__ int gather_row(const Unit&, int) const { return 0; }
    __device__ bool next(int i, Unit& u) const { const int L = i * G + c; if (L >= 256) return false; const int pm = L >> 2, which = (L >> 1) & 1, kh = L & 1;
        u.pm = pm; u.pn = which * 2 + kh; u.aoff = (long)pm * 256 * DM * 2 + (long)which * hlo_off + (long)kh * 1024 * 2; u.boff = (long)kh * 1024 * 2; return true; }
};
struct EpiRouter {
    static constexpr bool PERM = false;
    float* LOG;
    __device__ __forceinline__ void operator()(AccT acc, const Unit& u, int wr, int wc, int fr, int fq) const {
        float* base = LOG + ((size_t)u.pn * T + (size_t)u.pm * BM + wr * 64 + fr) * 128 + wc * 32 + 4 * fq;
#pragma unroll
        for (int ai = 0; ai < 2; ++ai)
#pragma unroll
            for (int m = 0; m < 4; ++m)
#pragma unroll
                for (int n = 0; n < 2; ++n) *(f32x4*)(base + (size_t)(ai * HALF + m * 16) * 128 + n * 16) = acc[ai][0][m][n];
    }
};
}

struct Args { const float* in[23]; float* out; unsigned char* ws; int ph_lo, ph_hi; };
enum { I_X = 0, I_NMIX, I_WIN, I_WRET, I_LNG, I_LNB, I_WS, I_BS, I_WGM, I_KVG, I_WUK, I_WUV, I_WDS, I_WOUT, I_NFFN, I_WGRP, I_BGRP, I_WEXP, I_BEXP, I_W1, I_W3, I_W2, I_FNG };
struct Ctx {
    LAS unsigned char* lds; volatile LAS int* misc; unsigned* ctl; GAS unsigned char* ws;
    int tid, lane, wave, G, bid, gw, NGW;
    const float* const* in; float* out;
};
#define WSP(T_, off) ((T_*)(C.ws + (off)))
__device__ __forceinline__ void refresh(Ctx& C) { int t = threadIdx.x; asm volatile("" : "+v"(t)); C.tid = t; C.lane = t & 63;
    GAS unsigned char* w = C.ws; asm volatile("" : "+s"(w)); C.ws = w; C.ctl = (unsigned*)w; }

__device__ __forceinline__ void ph_rope(const Ctx& C) {
    float* rope = WSP(float, WS_ROPE);
    const double r1 = 0.9305720409296989;
    for (int idx = C.bid * 512 + C.tid; idx < SEQ * 128; idx += C.G * 512) {
        const int pos = idx >> 7, i = idx & 127;
        double inv = 1.0, b = r1; int e = i;
        while (e) { if (e & 1) inv *= b; b *= b; e >>= 1; }
        const double ang = (double)pos * inv;
        const double n = __builtin_rint(ang * 0.15915494309189533577);
        const double x = ang - n * 6.283185307179586476925;
        const double x2 = x * x;
        double s = 0.0, c = 0.0;
#pragma unroll 1
        for (int k = 14; k >= 1; --k) { s = (s + 1.0) * (-x2 / (double)((2 * k) * (2 * k + 1))); c = (c + 1.0) * (-x2 / (double)((2 * k - 1) * (2 * k))); }
        s = (s + 1.0) * x; c = c + 1.0;
        *(f32x2*)(rope + (size_t)idx * 2) = (f32x2){(float)c, (float)s};
    }
}

struct WItem { const float* src; bf16_t* dst; int srcld, dstld, k0, n0, mode; long off; };
__device__ __forceinline__ WItem w_item(const Ctx& C, int l, int r) {
    unsigned char* wb = (unsigned char*)(C.ws + WS_W); WItem w; w.mode = 0; w.off = 0;
    constexpr int N_IN = 32 * 224, N_BR = 16 * 32, N_OUT = 32 * 32, N_13 = 32 * 32 * 16, N_2 = 32 * 8 * 32;
    if (r < N_IN) { const int kb = r / 224, nb = r % 224; w.src = C.in[I_WIN] + (size_t)l * DM * INW; w.srcld = INW; w.dst = (bf16_t*)(wb + W_IN); w.dstld = DM; w.k0 = kb * 64; w.n0 = nb * 64; w.mode = 1; return w; } r -= N_IN;
    if (r < 3 * N_BR) { const int ww = r / N_BR, q = r % N_BR, kb = q / 32, nb = q % 32; w.src = C.in[ww == 0 ? I_WRET : (ww == 1 ? I_WGM : I_WDS)] + (size_t)l * 1024 * DM; w.srcld = DM;
        w.dst = (bf16_t*)(wb + (ww == 0 ? W_RET : (ww == 1 ? W_GM : W_DS))); w.dstld = 1024; w.k0 = kb * 64; w.n0 = nb * 64; return w; } r -= 3 * N_BR;
    if (r < N_OUT) { const int kb = r / 32, nb = r % 32; w.src = C.in[I_WOUT] + (size_t)l * DM * DM; w.srcld = DM; w.dst = (bf16_t*)(wb + W_OUT); w.dstld = DM; w.k0 = kb * 64; w.n0 = nb * 64; return w; } r -= N_OUT;
    if (r < N_13) { const int e = r / 512, q = r % 512, kb = q / 16, nb = q % 16, row0 = nb * 64, j = row0 >> 8, sft = (row0 >> 7) & 1, fp = row0 & 127;
        w.src = C.in[sft ? I_W3 : I_W1] + ((size_t)l * NEXP + e) * DM * FF; w.srcld = FF; w.dst = (bf16_t*)(wb + W_13) + (size_t)e * 1024 * DM; w.dstld = DM; w.k0 = kb * 64; w.n0 = row0; w.off = (long)(128 * j + fp) - row0; return w; } r -= N_13;
    if (r < N_2) { const int e = r / 256, q = r % 256, kb = q / 32, nb = q % 32; w.src = C.in[I_W2] + ((size_t)l * NEXP + e) * FF * DM; w.srcld = DM; w.dst = (bf16_t*)(wb + W_2) + (size_t)e * DM * FF; w.dstld = FF; w.k0 = kb * 64; w.n0 = nb * 64; return w; } r -= N_2;
    { const int h = r / 8, q = r % 8, kb = q / 2, nb = q % 2;
      w.src = C.in[I_WUV] + ((size_t)l * 8 + h) * 256 * 128; w.srcld = 128; w.dst = (bf16_t*)(wb + W_UV) + (size_t)(h * 128) * 512 + (h & 1) * 256; w.dstld = 512; w.k0 = kb * 64; w.n0 = nb * 64; return w; }
}
__device__ __forceinline__ void w_load(const WItem& w, int lane, f32x4 (&R)[16]) {
    const int nq = lane & 15, kq = lane >> 4, n = w.n0 + 4 * nq;
    const long sc = (w.mode == 1) ? (n < GATE_SRC0 ? (long)n : (n < GATE_DST0 ? -1L : (long)(n - (GATE_DST0 - GATE_SRC0)))) : (long)n + w.off;
    const float* p = w.src + (size_t)(w.k0 + 2 * kq) * w.srcld + (sc >= 0 ? sc : 0);
#pragma unroll
    for (int i = 0; i < 8; ++i)
#pragma unroll
        for (int s2 = 0; s2 < 2; ++s2) { f32x4 v = __builtin_nontemporal_load((const f32x4*)(p + (size_t)(8 * i + s2) * w.srcld)); if (sc < 0) v = (f32x4){0.f, 0.f, 0.f, 0.f}; R[2 * i + s2] = v; }
}
__device__ __forceinline__ void w_store(const WItem& w, int lane, const f32x4 (&R)[16], LAS unsigned* scr) {
    const int nq = lane & 15, kq = lane >> 4;
    if (w.mode == 1 && ((w.n0 >> 8) < FP8_B0 || (w.n0 >> 8) >= FP8_B1)) {
#pragma unroll
        for (int i = 0; i < 8; ++i)
#pragma unroll
            for (int e = 0; e < 4; ++e) scr[(4 * nq + e) * 33 + 4 * i + kq] = cvt_pk_fp8x2(R[2 * i][e] * W8_SCALE, R[2 * i + 1][e] * W8_SCALE);
        asm volatile("s_waitcnt lgkmcnt(0)" ::: "memory");
        const int c = lane & 7;
#pragma unroll
        for (int j = 0; j < 8; ++j) { const int n = (lane >> 3) + 8 * j; const LAS unsigned* sp = scr + n * 33 + 4 * c;
            u32x2 o; o.x = sp[0] | (sp[1] << 16); o.y = sp[2] | (sp[3] << 16);
            *(u32x2*)((unsigned char*)w.dst + (size_t)(w.n0 + n) * DM + w.k0 + 8 * c) = o; }
        asm volatile("s_waitcnt lgkmcnt(0)" ::: "memory");
        return; }
#pragma unroll
    for (int i = 0; i < 8; ++i)
#pragma unroll
        for (int e = 0; e < 4; ++e) scr[(4 * nq + e) * 33 + 4 * i + kq] = cvt_pk_bf16(R[2 * i][e], R[2 * i + 1][e]);
    asm volatile("s_waitcnt lgkmcnt(0)" ::: "memory");
    const int c = lane & 7;
#pragma unroll
    for (int j = 0; j < 8; ++j) { const int n = (lane >> 3) + 8 * j; const LAS unsigned* sp = scr + n * 33 + 4 * c;
        u32x4 o; o.x = sp[0]; o.y = sp[1]; o.z = sp[2]; o.w = sp[3];
        *(u32x4*)(w.dst + (size_t)(w.n0 + n) * w.dstld + w.k0 + 8 * c) = o; }
    asm volatile("s_waitcnt lgkmcnt(0)" ::: "memory");
}
__device__ __forceinline__ void ph_weights(const Ctx& C, int l) {
    LAS unsigned* scr = (LAS unsigned*)(C.lds + C.wave * 16384);
    unsigned char* wb = (unsigned char*)(C.ws + WS_W);
    constexpr int NITEMS = 32 * 224 + 3 * 16 * 32 + 32 * 32 + 32 * 32 * 16 + 32 * 8 * 32 + 8 * 8;
    { int it = C.gw; f32x4 R[16], Rn[16]; WItem w, wn;
      if (it < NITEMS) { w = w_item(C, l, it); w_load(w, C.lane, R); }
#pragma unroll 1
      while (it < NITEMS) { const int itn = it + C.NGW;
          if (itn < NITEMS) { wn = w_item(C, l, itn); w_load(wn, C.lane, Rn); }
          w_store(w, C.lane, R, scr);
#pragma unroll
          for (int i = 0; i < 16; ++i) R[i] = Rn[i];
          w = wn; it = itn; } }
    bf16_t* uv = (bf16_t*)(wb + W_UV); bf16_t* uk = (bf16_t*)(wb + W_UK); const float* wuk = C.in[I_WUK] + (size_t)l * 8 * 256 * 128;
    for (int idx = C.bid * 512 + C.tid; idx < 1024 * 256 / 8; idx += C.G * 512) { const int row = idx >> 5, c8 = (idx & 31) * 8, h = row >> 7;
        *(u32x4*)(uv + (size_t)row * 512 + (1 - (h & 1)) * 256 + c8) = (u32x4){0u, 0u, 0u, 0u}; }
    for (int idx = C.bid * 512 + C.tid; idx < 2048 * 256 / 8; idx += C.G * 512) { const int row = idx >> 5, c8 = (idx & 31) * 8, h = row >> 8, half = c8 >> 7;
        u32x4 o = (u32x4){0u, 0u, 0u, 0u};
        if (half == (h & 1)) { const float* s = wuk + (size_t)row * 128 + (c8 & 127); const f32x4 a = *(const f32x4*)s, b = *(const f32x4*)(s + 4); o = pack8(a, b); }
        *(u32x4*)(uk + (size_t)row * 256 + c8) = o; }
    bf16_t* rt = (bf16_t*)(wb + W_RT); const float* wgr = C.in[I_WGRP] + (size_t)l * DM * 4; const float* wex = C.in[I_WEXP] + (size_t)l * 4 * DM * 8;
    for (int idx = C.bid * 512 + C.tid; idx < 256 * 256; idx += C.G * 512) { const int r = idx >> 8, k8 = (idx & 255) * 8, c = r & 63, part = r >> 6;
        u32x4 o = (u32x4){0u, 0u, 0u, 0u};
        if (part < 2 && c < 36) { float v[8];
#pragma unroll
            for (int j = 0; j < 8; ++j) { const float wv = (c < 4) ? wgr[(size_t)(k8 + j) * 4 + c] : wex[((size_t)((c - 4) >> 3) * DM + (k8 + j)) * 8 + ((c - 4) & 7)];
                const float hi = bf2f(f2bf(wv)); v[j] = part == 0 ? hi : (wv - hi); }
            o = pack8((f32x4){v[0], v[1], v[2], v[3]}, (f32x4){v[4], v[5], v[6], v[7]}); }
        *(u32x4*)(rt + (size_t)r * DM + k8) = o; }
}

__device__ __forceinline__ void ph_norm(const Ctx& C, const float* x, const float* g, bf16_t* H) {
    for (int row = C.gw; row < T; row += C.NGW) {
        const f32x4* xr = (const f32x4*)(x + (size_t)row * DM) + C.lane; f32x4 v[8]; float ss = 0.f;
#pragma unroll
        for (int j = 0; j < 8; ++j) { v[j] = xr[64 * j]; ss += v[j][0] * v[j][0] + v[j][1] * v[j][1] + v[j][2] * v[j][2] + v[j][3] * v[j][3]; }
        const float rstd = rsqrtf(wave_sum(ss, C.lane) * (1.f / DM) + EPS);
        u32x2* o = (u32x2*)(H + (size_t)row * DM) + C.lane; unsigned* o8 = (unsigned*)(WSP(unsigned char, WS_H8) + (size_t)row * DM) + C.lane;
#pragma unroll
        for (int j = 0; j < 8; ++j) { const f32x4 gg = ((const f32x4*)g)[64 * j + C.lane]; const f32x4 y = v[j] * rstd * gg; u32x2 w; w.x = cvt_pk_bf16(y[0], y[1]); w.y = cvt_pk_bf16(y[2], y[3]); o[64 * j] = w;
            o8[64 * j] = cvt_pk_fp8x4(y[0] * A8_SCALE, y[1] * A8_SCALE, y[2] * A8_SCALE, y[3] * A8_SCALE); }
    }
}
__device__ __forceinline__ void ph_ckv(const Ctx& C, const float* dcraw, const float* g, bf16_t* ckv) {
    for (int row = C.gw; row < T; row += C.NGW) {
        const f32x4 v = ((const f32x4*)(dcraw + (size_t)row * 256))[C.lane];
        const float ss = wave_sum(v[0] * v[0] + v[1] * v[1] + v[2] * v[2] + v[3] * v[3], C.lane);
        const float rstd = rsqrtf(ss * (1.f / 256.f) + EPS); const f32x4 y = v * rstd * ((const f32x4*)g)[C.lane];
        u32x2 w; w.x = cvt_pk_bf16(y[0], y[1]); w.y = cvt_pk_bf16(y[2], y[3]); ((u32x2*)(ckv + (size_t)row * 256))[C.lane] = w;
    }
}

typedef short v4i16_t __attribute__((ext_vector_type(4)));
__device__ __forceinline__ s16x4 tr_read(const LAS unsigned char* p) { return __builtin_bit_cast(s16x4, __builtin_amdgcn_ds_read_tr16_b64_v4i16((LAS v4i16_t*)p)); }
__device__ __forceinline__ bf16x8 tr_frag(const LAS unsigned char* X, int LDX, int rowA, int rowB, int n0, int lane) {
    const int q = (lane & 15) >> 2, p = lane & 3;
    const s16x4 lo = tr_read(X + (rowA + q) * LDX + (n0 + 4 * p) * 2), hi = tr_read(X + (rowB + q) * LDX + (n0 + 4 * p) * 2);
    return (bf16x8){lo[0], lo[1], lo[2], lo[3], hi[0], hi[1], hi[2], hi[3]};
}
constexpr int TLD = 544;
__device__ __forceinline__ bf16x8 as_bf16x8(u32x4 w) { return __builtin_bit_cast(bf16x8, w); }

__device__ __forceinline__ void ph_ret_kv(const Ctx& C) {
    const bf16_t* rk = WSP(bf16_t, WS_PROJ + P_RK); const bf16_t* rv = WSP(bf16_t, WS_PROJ + P_RV); bf16_t* KV = WSP(bf16_t, WS_KV);
    const LAS unsigned char* Vt = C.lds; const LAS unsigned char* Kt = C.lds + 128 * TLD;
    const int g = C.lane >> 4, fr = C.lane & 15, wr = C.wave >> 2, wc = C.wave & 3;
    for (int u = C.bid; u < 512; u += C.G) {
        const int n = u & 31, h = (u >> 5) & 3, b = u >> 7; const size_t row0 = (size_t)b * SEQ + n * 128;
        const float lg2 = log2f(1.0f - exp2f(-5.0f - (float)h));
        __syncthreads();
#pragma unroll
        for (int p = 0; p < 8; ++p) { const int idx = p * 512 + C.tid, row = idx >> 5, ch = idx & 31; const size_t go = (row0 + row) * 1024 + h * 256 + ch * 8;
            const u32x4 vv = *(const u32x4*)(rv + go); *(LAS u32x4*)(C.lds + row * TLD + ch * 16) = vv;
            float f[8]; unpack8(*(const u32x4*)(rk + go), f); const float z = exp2f(lg2 * (float)(127 - row));
            *(LAS u32x4*)(C.lds + 128 * TLD + row * TLD + ch * 16) = pack8((f32x4){f[0] * z, f[1] * z, f[2] * z, f[3] * z}, (f32x4){f[4] * z, f[5] * z, f[6] * z, f[7] * z}); }
        __syncthreads();
        f32x4 acc[8][4];
#pragma unroll
        for (int m = 0; m < 8; ++m)
#pragma unroll
            for (int nn = 0; nn < 4; ++nn) acc[m][nn] = (f32x4){0.f, 0.f, 0.f, 0.f};
#pragma unroll 1
        for (int ks = 0; ks < 4; ++ks) { bf16x8 Bv[4];
#pragma unroll
            for (int nn = 0; nn < 4; ++nn) Bv[nn] = tr_frag(Vt, TLD, 32 * ks + 8 * g, 32 * ks + 8 * g + 4, 64 * wc + 16 * nn, C.lane);
#pragma unroll
            for (int m = 0; m < 8; ++m) { const bf16x8 Ak = tr_frag(Kt, TLD, 32 * ks + 8 * g, 32 * ks + 8 * g + 4, 128 * wr + 16 * m, C.lane);
#pragma unroll
                for (int nn = 0; nn < 4; ++nn) acc[m][nn] = __builtin_amdgcn_mfma_f32_16x16x32_bf16(Ak, Bv[nn], acc[m][nn], 0, 0, 0); } }
        bf16_t* out = KV + (size_t)u * 65536;
#pragma unroll
        for (int m = 0; m < 8; ++m)
#pragma unroll
            for (int nn = 0; nn < 4; ++nn) { const int e = 64 * wc + 16 * nn + fr, d = 128 * wr + 16 * m + 4 * g; u32x2 w; w.x = cvt_pk_bf16(acc[m][nn][0], acc[m][nn][1]); w.y = cvt_pk_bf16(acc[m][nn][2], acc[m][nn][3]);
                *(u32x2*)(out + e * 256 + d) = w; }
    }
}
__device__ __forceinline__ void ph_ret_scan(const Ctx& C) {
    const bf16_t* KV = WSP(bf16_t, WS_KV); bf16_t* Rb = WSP(bf16_t, WS_R);
    for (int idx = C.bid * 512 + C.tid; idx < 16 * 8192; idx += C.G * 512) {
        const int bh = idx >> 13, off = (idx & 8191) * 8, h = bh & 3; const float gc = exp2f(128.0f * log2f(1.0f - exp2f(-5.0f - (float)h)));
        float R[8] = {0.f, 0.f, 0.f, 0.f, 0.f, 0.f, 0.f, 0.f};
#pragma unroll 4
        for (int n = 0; n < 32; ++n) { const size_t o = ((size_t)bh * 32 + n) * 65536 + off;
            *(u32x4*)(Rb + o) = pack8((f32x4){R[0], R[1], R[2], R[3]}, (f32x4){R[4], R[5], R[6], R[7]});
            float f[8]; unpack8(*(const u32x4*)(KV + o), f);
#pragma unroll
            for (int j = 0; j < 8; ++j) R[j] = R[j] * gc + f[j]; }
    }
}
__device__ __forceinline__ void ph_ret_out(const Ctx& C) {
    const bf16_t* rq = WSP(bf16_t, WS_PROJ + P_RQ); const bf16_t* rk = WSP(bf16_t, WS_PROJ + P_RK); const bf16_t* rv = WSP(bf16_t, WS_PROJ + P_RV); const bf16_t* rg = WSP(bf16_t, WS_PROJ + P_RG);
    const bf16_t* Rb = WSP(bf16_t, WS_R); bf16_t* ret = WSP(bf16_t, WS_RET);
    const LAS unsigned char* Vt = C.lds;
    const int w = C.wave;
    for (int u = C.bid; u < 512; u += C.G) {
        int tid_ = C.tid; asm volatile("" : "+v"(tid_));
        const int tid = tid_, lane = tid & 63, g = lane >> 4, fr = lane & 15;
        const int n = u & 31, h = (u >> 5) & 3, b = u >> 7; const size_t row0 = (size_t)b * SEQ + n * 128;
        const float lg2 = log2f(1.0f - exp2f(-5.0f - (float)h));
        constexpr int R_OFF = 128 * TLD, RLD = 272;
        u32x4 Vr[8], Rr[8];
#pragma unroll
        for (int p = 0; p < 8; ++p) { const int idx = p * 512 + tid, row = idx >> 5, ch = idx & 31; Vr[p] = *(const u32x4*)(rv + (row0 + row) * 1024 + h * 256 + ch * 8); }
        if (n > 0) {
#pragma unroll
            for (int p = 0; p < 8; ++p) { const int idx = p * 512 + tid, e = idx >> 4, c16 = idx & 15; Rr[p] = *(const u32x4*)(Rb + (size_t)u * 65536 + (size_t)e * 256 + c16 * 8); } }
        else {
#pragma unroll
            for (int p = 0; p < 8; ++p) { const int idx = p * 512 + tid, row = idx >> 5, ch = idx & 31; Rr[p] = *(const u32x4*)(rk + (row0 + row) * 1024 + h * 256 + ch * 8); } }
        const int i = 16 * w + fr;
        bf16x8 Bq[8];
        { const bf16_t* qp = rq + (row0 + i) * 1024 + h * 256 + 8 * g;
#pragma unroll
          for (int ks = 0; ks < 8; ++ks) Bq[ks] = as_bf16x8(*(const u32x4*)(qp + 32 * ks)); }
        f32x4 acc[16];
#pragma unroll
        for (int nt = 0; nt < 16; ++nt) acc[nt] = (f32x4){0.f, 0.f, 0.f, 0.f};
        __syncthreads();
#pragma unroll
        for (int p = 0; p < 8; ++p) { const int idx = p * 512 + tid, row = idx >> 5, ch = idx & 31; *(LAS u32x4*)(C.lds + row * TLD + ch * 16) = Vr[p]; }
        if (n > 0) {
#pragma unroll
            for (int p = 0; p < 8; ++p) { const int idx = p * 512 + tid, e = idx >> 4, c16 = idx & 15; *(LAS u32x4*)(C.lds + R_OFF + e * RLD + c16 * 16) = Rr[p]; }
#pragma unroll
            for (int p = 0; p < 8; ++p) { const int idx = p * 512 + tid, e = idx >> 4, c16 = idx & 15; Rr[p] = *(const u32x4*)(Rb + (size_t)u * 65536 + (size_t)e * 256 + 128 + c16 * 8); }
#pragma unroll
            for (int dh = 0; dh < 2; ++dh) {
                if (dh) { __syncthreads();
#pragma unroll
                    for (int p = 0; p < 8; ++p) { const int idx = p * 512 + tid, e = idx >> 4, c16 = idx & 15; *(LAS u32x4*)(C.lds + R_OFF + e * RLD + c16 * 16) = Rr[p]; }
#pragma unroll
                    for (int p = 0; p < 8; ++p) { const int idx = p * 512 + tid, row = idx >> 5, ch = idx & 31; Rr[p] = *(const u32x4*)(rk + (row0 + row) * 1024 + h * 256 + ch * 8); } }
                __syncthreads();
#pragma unroll
                for (int k4 = 0; k4 < 4; ++k4)
#pragma unroll
                    for (int nt = 0; nt < 16; ++nt) { const bf16x8 Ar = as_bf16x8(*(const LAS u32x4*)(C.lds + R_OFF + (16 * nt + fr) * RLD + (32 * k4 + 8 * g) * 2));
                        acc[nt] = __builtin_amdgcn_mfma_f32_16x16x32_bf16(Ar, Bq[4 * dh + k4], acc[nt], 0, 0, 0); }
            }
            const float xi = exp2f(lg2 * (float)(i + 1));
#pragma unroll
            for (int nt = 0; nt < 16; ++nt) acc[nt] = acc[nt] * xi;
        }
        __syncthreads();
#pragma unroll
        for (int p = 0; p < 8; ++p) { const int idx = p * 512 + tid, row = idx >> 5, ch = idx & 31; *(LAS u32x4*)(C.lds + R_OFF + row * TLD + ch * 16) = Rr[p]; }
        __syncthreads();
        f32x4 ST[8];
#pragma unroll
        for (int jt = 0; jt < 8; ++jt) { ST[jt] = (f32x4){0.f, 0.f, 0.f, 0.f};
            if (jt <= w) {
#pragma unroll
                for (int ks = 0; ks < 8; ++ks) { const bf16x8 Ak = as_bf16x8(*(const LAS u32x4*)(C.lds + R_OFF + (16 * jt + fr) * TLD + (32 * ks + 8 * g) * 2)); ST[jt] = __builtin_amdgcn_mfma_f32_16x16x32_bf16(Ak, Bq[ks], ST[jt], 0, 0, 0); }
#pragma unroll
                for (int r = 0; r < 4; ++r) { const int j = 16 * jt + 4 * g + r; ST[jt][r] = (i >= j) ? ST[jt][r] * exp2f(lg2 * (float)(i - j)) : 0.f; }
                asm volatile("" ::: "memory"); } }
#pragma unroll
        for (int t = 0; t < 4; ++t) if (2 * t <= w) {
            u32x4 sw; sw.x = cvt_pk_bf16(ST[2 * t][0], ST[2 * t][1]); sw.y = cvt_pk_bf16(ST[2 * t][2], ST[2 * t][3]); sw.z = cvt_pk_bf16(ST[2 * t + 1][0], ST[2 * t + 1][1]); sw.w = cvt_pk_bf16(ST[2 * t + 1][2], ST[2 * t + 1][3]);
            const bf16x8 Bs = as_bf16x8(sw);
#pragma unroll
            for (int nt = 0; nt < 16; ++nt) { const bf16x8 Av = tr_frag(Vt, TLD, 32 * t + 4 * g, 32 * t + 16 + 4 * g, 16 * nt, lane); acc[nt] = __builtin_amdgcn_mfma_f32_16x16x32_bf16(Av, Bs, acc[nt], 0, 0, 0); } }
        float ss = 0.f;
#pragma unroll
        for (int nt = 0; nt < 16; ++nt) ss += acc[nt][0] * acc[nt][0] + acc[nt][1] * acc[nt][1] + acc[nt][2] * acc[nt][2] + acc[nt][3] * acc[nt][3];
        ss = quad_sum(ss);
        const float rstd = rsqrtf(ss * (1.f / 256.f) + EPS);
        const size_t ob = (row0 + i) * 1024 + h * 256 + 4 * g;
#pragma unroll
        for (int nt = 0; nt < 16; ++nt) { const u32x2 gw = *(const u32x2*)(rg + ob + 16 * nt); u32x2 o;
            o.x = cvt_pk_bf16(acc[nt][0] * rstd * bf2f(gw.x), acc[nt][1] * rstd * bf2f(gw.x >> 16)); o.y = cvt_pk_bf16(acc[nt][2] * rstd * bf2f(gw.y), acc[nt][3] * rstd * bf2f(gw.y >> 16));
            *(u32x2*)(ret + ob + 16 * nt) = o; }
    }
}
__device__ __forceinline__ void ph_gmlp(const Ctx& C, int l) {
    const bf16_t* gu = WSP(bf16_t, WS_PROJ + P_GU); const bf16_t* gv = WSP(bf16_t, WS_PROJ + P_GV); const float* stats = WSP(float, WS_STATS); bf16_t* gm = WSP(bf16_t, WS_GM);
    const float* lng = C.in[I_LNG] + l * 1024; const float* lnb = C.in[I_LNB] + l * 1024; const float* Wsp = C.in[I_WS] + (size_t)l * 4 * 128 * 128; const float* bs = C.in[I_BS] + l * 4 * 128;
    constexpr int WLD = 272, W_OFF = 128 * TLD, ST_OFF = W_OFF + 128 * WLD;
    const LAS unsigned char* Lt = C.lds; LAS float* sst = (LAS float*)(C.lds + ST_OFF);
    const int g4 = C.lane >> 4, fr = C.lane & 15, w = C.wave;
    for (int u = C.bid; u < 512; u += C.G) {
        const int gg = u & 3, bn = u >> 2, t0 = bn * 128;
        __syncthreads();
        if (C.tid < 128) { const float* sp = stats + (size_t)(t0 + C.tid) * 32; float s = 0.f, q = 0.f;
#pragma unroll
            for (int k = 0; k < 16; ++k) { s += sp[2 * k]; q += sp[2 * k + 1]; }
            const float mean = s * (1.f / 1024.f), var = q * (1.f / 1024.f) - mean * mean; sst[2 * C.tid] = mean; sst[2 * C.tid + 1] = rsqrtf(var + EPS); }
#pragma unroll
        for (int p = 0; p < 4; ++p) { const int idx = p * 512 + C.tid, i = idx >> 4, j8 = (idx & 15) * 8; const float* wp = Wsp + ((size_t)gg * 128 + i) * 128 + j8;
            f32x4 a = *(const f32x4*)wp, b2 = *(const f32x4*)(wp + 4);
#pragma unroll
            for (int j = 0; j < 4; ++j) { if (j8 + j > i) a[j] = 0.f; if (j8 + 4 + j > i) b2[j] = 0.f; }
            *(LAS u32x4*)(C.lds + W_OFF + i * WLD + j8 * 2) = pack8(a, b2); }
        __syncthreads();
#pragma unroll
        for (int p = 0; p < 8; ++p) { const int idx = p * 512 + C.tid, row = idx >> 5, ch = idx & 31, cg = gg * 256 + ch * 8;
            float f[8]; unpack8(*(const u32x4*)(gv + (size_t)(t0 + row) * 1024 + cg), f); const float mean = sst[2 * row], rstd = sst[2 * row + 1];
            const f32x4 g0 = *(const f32x4*)(lng + cg), g1 = *(const f32x4*)(lng + cg + 4), b0 = *(const f32x4*)(lnb + cg), b1 = *(const f32x4*)(lnb + cg + 4);
            f32x4 y0, y1;
#pragma unroll
            for (int j = 0; j < 4; ++j) { y0[j] = (f[j] - mean) * rstd * g0[j] + b0[j]; y1[j] = (f[4 + j] - mean) * rstd * g1[j] + b1[j]; }
            *(LAS u32x4*)(C.lds + row * TLD + ch * 16) = pack8(y0, y1); }
        __syncthreads();
        f32x4 acc[16];
#pragma unroll
        for (int nt = 0; nt < 16; ++nt) acc[nt] = (f32x4){0.f, 0.f, 0.f, 0.f};
#pragma unroll
        for (int ks = 0; ks < 4; ++ks) if (2 * ks <= w) {
            const bf16x8 Bw = as_bf16x8(*(const LAS u32x4*)(C.lds + W_OFF + (16 * w + fr) * WLD + (32 * ks + 8 * g4) * 2));
#pragma unroll
            for (int nt = 0; nt < 16; ++nt) { const bf16x8 Av = tr_frag(Lt, TLD, 32 * ks + 8 * g4, 32 * ks + 8 * g4 + 4, 16 * nt, C.lane); acc[nt] = __builtin_amdgcn_mfma_f32_16x16x32_bf16(Av, Bw, acc[nt], 0, 0, 0); } }
        const int i = 16 * w + fr; const float bias = bs[gg * 128 + i]; const size_t ob = (size_t)(t0 + i) * 1024 + gg * 256 + 4 * g4;
#pragma unroll
        for (int nt = 0; nt < 16; ++nt) { const u32x2 uw = *(const u32x2*)(gu + ob + 16 * nt); u32x2 o;
            o.x = cvt_pk_bf16((acc[nt][0] + bias) * bf2f(uw.x), (acc[nt][1] + bias) * bf2f(uw.x >> 16)); o.y = cvt_pk_bf16((acc[nt][2] + bias) * bf2f(uw.y), (acc[nt][3] + bias) * bf2f(uw.y >> 16));
            *(u32x2*)(gm + ob + 16 * nt) = o; }
    }
}

__device__ __forceinline__ void ph_idx(const Ctx& C, int l) {
    const bf16_t* iq = WSP(bf16_t, WS_PROJ + P_IQ); const bf16_t* ik = WSP(bf16_t, WS_PROJ + P_IK); const float* iw = WSP(float, WS_PROJ + P_IW); unsigned short* sel = WSP(unsigned short, WS_SEL);
    LAS unsigned* sc = (LAS unsigned*)C.lds;
    const int lane = C.lane, n32 = lane & 31, hh = lane >> 5, w = C.wave;
    unsigned* qh = C.ctl + CW_Q + (l * 8 + 1) * 64;
    __syncthreads();
    if (C.tid == 0) C.misc[510] = (int)__hip_atomic_fetch_add(qh, 1u, __ATOMIC_RELAXED, __HIP_MEMORY_SCOPE_AGENT);
    __syncthreads();
    int un = C.misc[510];
    for (int u = un; u < T / 8; u = un) {
        const int b = u & 3, q0 = (SEQ / 8 - 1 - (u >> 2)) * 8, tq0 = b * SEQ + q0, nk = q0 + 8, nkt = (nk + 31) >> 5;
        __syncthreads();
        if (C.tid == 0) C.misc[510] = (int)__hip_atomic_fetch_add(qh, 1u, __ATOMIC_RELAXED, __HIP_MEMORY_SCOPE_AGENT);
        bf16x8 Aq[2][4]; float wq[2][16];
        { const int r = n32, qi = 2 * ((r >> 2) & 1) + (r >> 4), hd = (r & 3) + 4 * ((r >> 3) & 1);
#pragma unroll
          for (int mt = 0; mt < 2; ++mt) { const bf16_t* qp = iq + (size_t)(tq0 + 4 * mt + qi) * 512 + hd * 64 + 8 * hh;
#pragma unroll
              for (int ks = 0; ks < 4; ++ks) Aq[mt][ks] = as_bf16x8(*(const u32x4*)(qp + 16 * ks));
#pragma unroll
              for (int a = 0; a < 2; ++a) { const float* wp = iw + (size_t)(tq0 + 4 * mt + 2 * hh + a) * 8; const f32x4 w0 = *(const f32x4*)wp, w1 = *(const f32x4*)(wp + 4);
#pragma unroll
                  for (int j = 0; j < 4; ++j) { wq[mt][8 * a + j] = w0[j] * 0.125f; wq[mt][8 * a + 4 + j] = w1[j] * 0.125f; } } } }
        u32x4 Bn[4];
        { const bf16_t* kp = ik + ((size_t)b * SEQ + 32 * (w < nkt ? w : 0) + n32) * 64 + 8 * hh;
#pragma unroll
          for (int ks = 0; ks < 4; ++ks) Bn[ks] = *(const u32x4*)(kp + 16 * ks); }
        for (int kt = w; kt < nkt; kt += 8) {
            bf16x8 Bk[4];
#pragma unroll
            for (int ks = 0; ks < 4; ++ks) Bk[ks] = as_bf16x8(Bn[ks]);
            { const int k2 = (kt + 8 < nkt) ? kt + 8 : kt; const bf16_t* kp = ik + ((size_t)b * SEQ + 32 * k2 + n32) * 64 + 8 * hh;
#pragma unroll
              for (int ks = 0; ks < 4; ++ks) Bn[ks] = *(const u32x4*)(kp + 16 * ks); }
#pragma unroll
            for (int mt = 0; mt < 2; ++mt) { f32x16 acc;
#pragma unroll
                for (int j = 0; j < 16; ++j) acc[j] = 0.f;
#pragma unroll
                for (int ks = 0; ks < 4; ++ks) acc = __builtin_amdgcn_mfma_f32_32x32x16_bf16(Aq[mt][ks], Bk[ks], acc, 0, 0, 0);
#pragma unroll
                for (int a = 0; a < 2; ++a) { float s = 0.f;
#pragma unroll
                    for (int rr = 0; rr < 8; ++rr) s += wq[mt][8 * a + rr] * fmaxf(acc[8 * a + rr], 0.f);
                    const int qu = 4 * mt + 2 * hh + a, key = 32 * kt + n32; unsigned bits = __builtin_bit_cast(unsigned, s);
                    bits = (bits & 0x80000000u) ? ~bits : (bits | 0x80000000u);
                    sc[qu * 4096 + key] = (key <= q0 + qu) ? bits : 0u; } }
        }
        __syncthreads();
        un = C.misc[510];
        { const int q = q0 + w, n = q + 1; const size_t so = (size_t)(tq0 + w) * 256;
          if (n <= 256) { for (int r = lane; r < 256; r += 64) sel[so + r] = (r < n) ? (unsigned short)r : (unsigned short)0xFFFFu; }
          else {
            const int ni = (n + 63) >> 6;
            unsigned uu[64];
#pragma unroll
            for (int i = 0; i < 64; ++i) uu[i] = (i < ni && 64 * i + lane < nkt * 32) ? sc[w * 4096 + 64 * i + lane] : 0u;
            const int nact = (ni + 15) >> 4, below_const = (4 - nact) * 1024;
            LAS unsigned* slot = sc + w * 4096;
            unsigned Hp[32];
#pragma unroll
            for (int j = 0; j < 32; ++j) Hp[j] = (uu[2 * j] >> 16) | (uu[2 * j + 1] & 0xffff0000u);
#define IDX_BELOW(dst, cval) do { const unsigned cm1_ = ((cval) - 1u) * 0x00010001u; unsigned cnt_ = 0u; \
            _Pragma("unroll") for (int g4 = 0; g4 < 4; ++g4) if (g4 < nact) { _Pragma("unroll") for (int j = 8 * g4; j < 8 * g4 + 8; ++j) cnt_ = pk_below(Hp[j], cm1_, cnt_); } \
            (dst) = wave_total_dpp((int)((cnt_ & 0xffffu) + (cnt_ >> 16))) + below_const; } while (0)
#define Pl(g_, b_) Hp[16 * (g_) + (b_)]
#pragma unroll
            for (int g2 = 0; g2 < 2; ++g2) {
#pragma unroll
                for (int d = 8; d >= 1; d >>= 1) { const unsigned m = d == 8 ? 0x00FF00FFu : (d == 4 ? 0x0F0F0F0Fu : (d == 2 ? 0x33333333u : 0x55555555u));
#pragma unroll
                    for (int k = 0; k < 16; ++k) if (!(k & d)) { const unsigned t = ((Pl(g2, k) >> d) ^ Pl(g2, k + d)) & m; Pl(g2, k + d) ^= t; Pl(g2, k) ^= t << d; } } }
            unsigned Th = 0u, eq0 = 0xffffffffu, eq1 = 0xffffffffu, gt0 = 0u, gt1 = 0u; int gcnt = 0;
#pragma unroll
            for (int bit = 15; bit >= 0; --bit) { const unsigned c0 = eq0 & Pl(0, bit), c1 = eq1 & Pl(1, bit); const int pc = __builtin_popcount(c0) + __builtin_popcount(c1);
                if (wave_total_dpp(gcnt + pc) >= 256) { Th |= 1u << bit; eq0 = c0; eq1 = c1; } else { gt0 |= c0; gt1 |= c1; gcnt += pc; eq0 &= ~Pl(0, bit); eq1 &= ~Pl(1, bit); } }
#undef Pl
            const int gtT = wave_total_dpp(gcnt), nc = wave_total_dpp(__builtin_popcount(eq0) + __builtin_popcount(eq1));
            const int krem = 256 - gtT;
            unsigned Tv; int need; bool simple;
            if (nc <= 64) {
                int base = 0; const unsigned long long lt = (1ull << lane) - 1ull;
#pragma unroll
                for (int i = 0; i < 64; ++i) { const bool eq = (((i < 32 ? eq0 : eq1) >> (16 * (i & 1) + ((i & 31) >> 1))) & 1u) != 0u; const unsigned long long em = __ballot(eq);
                    if (em) { if (eq) slot[base + __builtin_popcountll(em & lt)] = (uu[i] & 0xffffu) + 1u; base += __builtin_popcountll(em); } }
                asm volatile("s_waitcnt lgkmcnt(0)" ::: "memory");
                const unsigned tv = (lane < nc) ? slot[lane] : 0u;
                unsigned Tl = 0u;
#pragma unroll 1
                for (int bit = 16; bit >= 0; --bit) { const unsigned c = Tl | (1u << bit); if (__builtin_popcountll(__ballot(tv >= c)) >= krem) Tl = c; }
                need = krem - __builtin_popcountll(__ballot(tv > Tl)); simple = (need == __builtin_popcountll(__ballot(tv == Tl)));
                Tv = (Th << 16) | (Tl - 1u);
                asm volatile("s_waitcnt lgkmcnt(0)" ::: "memory");
            } else {
#pragma unroll
                for (int j = 0; j < 32; ++j) { const unsigned a = uu[2 * j], b2 = uu[2 * j + 1]; Hp[j] = (((a >> 16) == Th) ? (a & 0xffffu) : 0u) | (((b2 >> 16) == Th) ? (b2 << 16) : 0u); }
                unsigned Tl = 0u;
#pragma unroll 1
                for (int bit = 15; bit >= 0; --bit) { const unsigned c = Tl | (1u << bit); int bl; IDX_BELOW(bl, c); if (4096 - bl >= krem) Tl = c; }
                Tv = (Th << 16) | Tl; int cg = 0;
#pragma unroll
                for (int i = 0; i < 64; ++i) cg += (uu[i] > Tv) ? 1 : 0;
                need = 256 - wave_total_dpp(cg); simple = false;
            }
#undef IDX_BELOW
            if (simple) {
                int base = 0;
#pragma unroll
                for (int i = 0; i < 64; ++i) if (16 * (i >> 4) < ni) { const bool take = uu[i] >= Tv; const unsigned long long tm = __ballot(take);
                    const int pos = base + (int)__builtin_amdgcn_mbcnt_hi((unsigned)(tm >> 32), __builtin_amdgcn_mbcnt_lo((unsigned)tm, 0u));
                    if (take) sel[so + pos] = (unsigned short)(64 * i + lane);
                    base += __builtin_popcountll(tm); }
            } else {
                int base = 0, eqs = 0; const unsigned long long lt = (1ull << lane) - 1ull;
#pragma unroll
                for (int i = 0; i < 64; ++i) if (16 * (i >> 4) < ni) { const bool gt = uu[i] > Tv, eq = uu[i] == Tv; const unsigned long long em = __ballot(eq);
                    const bool take = gt || (eq && (eqs + __builtin_popcountll(em & lt)) < need); const unsigned long long tm = __ballot(take);
                    if (take) sel[so + base + __builtin_popcountll(tm & lt)] = (unsigned short)(64 * i + lane);
                    base += __builtin_popcountll(tm); eqs += __builtin_popcountll(em); }
            }
          } }
    }
}
__device__ __forceinline__ void ph_att(const Ctx& C) {
    const bf16_t* qabs = WSP(bf16_t, WS_QABS); const bf16_t* ckv = WSP(bf16_t, WS_CKV); const unsigned short* sel = WSP(unsigned short, WS_SEL); bf16_t* olat = WSP(bf16_t, WS_OLAT);
    const int lane = C.lane, g = lane >> 4, fr = lane & 15;
    LAS unsigned char* ch = C.lds + C.wave * (32 * TLD + 512);
    LAS unsigned short* ssel = (LAS unsigned short*)(ch + 32 * TLD);
    for (int tq = C.gw; tq < T; tq += C.NGW) {
        const int b = tq >> 12, q = tq & (SEQ - 1), nv = (q + 1) < 256 ? (q + 1) : 256, nch = (nv + 31) >> 5;
        const bf16_t* cb = ckv + (size_t)b * SEQ * 256;
        { u32x2 sv = *(const u32x2*)(sel + (size_t)tq * 256 + 4 * lane);
          unsigned s0 = sv.x & 0xffffu, s1 = sv.x >> 16, s2_ = sv.y & 0xffffu, s3 = sv.y >> 16;
          if (4 * lane + 0 >= nv) s0 = 0; if (4 * lane + 1 >= nv) s1 = 0; if (4 * lane + 2 >= nv) s2_ = 0; if (4 * lane + 3 >= nv) s3 = 0;
          *(LAS u32x2*)(ssel + 4 * lane) = (u32x2){s0 | (s1 << 16), s2_ | (s3 << 16)}; }
        bf16x8 Bqa[8];
        { const bf16_t* qp = qabs + (size_t)tq * 2048 + (fr & 7) * 256 + 8 * g;
#pragma unroll
          for (int ks = 0; ks < 8; ++ks) { u32x4 v = *(const u32x4*)(qp + 32 * ks); if (fr >= 8) v = (u32x4){0u, 0u, 0u, 0u}; Bqa[ks] = as_bf16x8(v); } }
        f32x4 acc[16];
#pragma unroll
        for (int nt = 0; nt < 16; ++nt) acc[nt] = (f32x4){0.f, 0.f, 0.f, 0.f};
        float mrun = -INFINITY, lrun = 0.f;
        asm volatile("s_waitcnt lgkmcnt(0)" ::: "memory");
        u32x4 G[16];
#pragma unroll
        for (int p = 0; p < 16; ++p) { const int s = ssel[2 * p + (lane >> 5)]; G[p] = *(const u32x4*)(cb + (size_t)s * 256 + (lane & 31) * 8); }
#pragma unroll 1
        for (int t = 0; t < nch; ++t) {
#pragma unroll
            for (int p = 0; p < 16; ++p) *(LAS u32x4*)(ch + (2 * p + (lane >> 5)) * TLD + (lane & 31) * 16) = G[p];
            if (t + 1 < nch) {
#pragma unroll
                for (int p = 0; p < 16; ++p) { const int s = ssel[32 * (t + 1) + 2 * p + (lane >> 5)]; G[p] = *(const u32x4*)(cb + (size_t)s * 256 + (lane & 31) * 8); } }
            asm volatile("s_waitcnt lgkmcnt(0)" ::: "memory");
            f32x4 s2[2];
#pragma unroll
            for (int hf = 0; hf < 2; ++hf) { s2[hf] = (f32x4){0.f, 0.f, 0.f, 0.f};
#pragma unroll
                for (int ks = 0; ks < 8; ++ks) { const bf16x8 Ac = as_bf16x8(*(const LAS u32x4*)(ch + (16 * hf + fr) * TLD + (32 * ks + 8 * g) * 2)); s2[hf] = __builtin_amdgcn_mfma_f32_16x16x32_bf16(Ac, Bqa[ks], s2[hf], 0, 0, 0); } }
            float cm = -INFINITY;
#pragma unroll
            for (int hf = 0; hf < 2; ++hf)
#pragma unroll
                for (int r = 0; r < 4; ++r) { const int ki = 32 * t + 16 * hf + 4 * g + r; if (ki >= nv) s2[hf][r] = -INFINITY; cm = fmaxf(cm, s2[hf][r]); }
            cm = quad_max(cm);
            const float mnew = fmaxf(mrun, cm), scale = __expf(mrun - mnew); float ps = 0.f;
#pragma unroll
            for (int hf = 0; hf < 2; ++hf)
#pragma unroll
                for (int r = 0; r < 4; ++r) { s2[hf][r] = __expf(s2[hf][r] - mnew); ps += s2[hf][r]; }
            ps = quad_sum(ps);
            lrun = lrun * scale + ps; mrun = mnew;
            u32x4 pw; pw.x = cvt_pk_bf16(s2[0][0], s2[0][1]); pw.y = cvt_pk_bf16(s2[0][2], s2[0][3]); pw.z = cvt_pk_bf16(s2[1][0], s2[1][1]); pw.w = cvt_pk_bf16(s2[1][2], s2[1][3]);
            const bf16x8 Bp = as_bf16x8(pw);
#pragma unroll
            for (int nt = 0; nt < 16; ++nt) { const bf16x8 Av = tr_frag(ch, TLD, 4 * g, 16 + 4 * g, 16 * nt, lane); acc[nt] = __builtin_amdgcn_mfma_f32_16x16x32_bf16(Av, Bp, acc[nt] * scale, 0, 0, 0); }
            asm volatile("s_waitcnt lgkmcnt(0)" ::: "memory");
        }
        const float inv = 1.0f / lrun;
        if (fr < 8) { bf16_t* op = olat + (size_t)tq * 2048 + fr * 256 + 4 * g;
#pragma unroll
            for (int nt = 0; nt < 16; ++nt) { u32x2 o; o.x = cvt_pk_bf16(acc[nt][0] * inv, acc[nt][1] * inv); o.y = cvt_pk_bf16(acc[nt][2] * inv, acc[nt][3] * inv); *(u32x2*)(op + 16 * nt) = o; } }
    }
}

__device__ __forceinline__ void ph_norm_hilo(const Ctx& C, const float* x, const float* g, bf16_t* H, bf16_t* HLO) {
    for (int row = C.gw; row < T; row += C.NGW) {
        const f32x4* xr = (const f32x4*)(x + (size_t)row * DM) + C.lane; f32x4 v[8]; float ss = 0.f;
#pragma unroll
        for (int j = 0; j < 8; ++j) { v[j] = xr[64 * j]; ss += v[j][0] * v[j][0] + v[j][1] * v[j][1] + v[j][2] * v[j][2] + v[j][3] * v[j][3]; }
        const float rstd = rsqrtf(wave_sum(ss, C.lane) * (1.f / DM) + EPS);
        u32x2* oh = (u32x2*)(H + (size_t)row * DM) + C.lane; u32x2* ol = (u32x2*)(HLO + (size_t)row * DM) + C.lane;
#pragma unroll
        for (int j = 0; j < 8; ++j) { const f32x4 gg = ((const f32x4*)g)[64 * j + C.lane]; const f32x4 y = v[j] * rstd * gg; u32x2 wh; wh.x = cvt_pk_bf16(y[0], y[1]); wh.y = cvt_pk_bf16(y[2], y[3]);
            u32x2 wl; wl.x = cvt_pk_bf16(y[0] - bf2f(wh.x), y[1] - bf2f(wh.x >> 16)); wl.y = cvt_pk_bf16(y[2] - bf2f(wh.y), y[3] - bf2f(wh.y >> 16)); oh[64 * j] = wh; ol[64 * j] = wl; }
    }
}
__device__ __forceinline__ void ph_route(const Ctx& C, int l) {
    const float* LOG = WSP(float, WS_OLAT); const float* bg = C.in[I_BGRP] + l * 4; const float* be = C.in[I_BEXP] + l * 32;
    int* rinfo = WSP(int, WS_ROUTE); float* rw = (float*)(rinfo + T * 4); unsigned* cnt = C.ctl + CW_CNT + l * 64;
    LAS int* lcnt = (LAS int*)(C.misc + 600); LAS int* gbase = (LAS int*)(C.misc + 640);
    for (int blk = C.bid; blk < T / 256; blk += C.G) {
        __syncthreads();
        if (C.tid < 32) lcnt[C.tid] = 0;
        __syncthreads();
        const bool act = C.tid < 256; const int t = blk * 256 + (C.tid & 255);
        int e0 = 0, e1 = 0, lr0 = 0, lr1 = 0; float w0 = 0.f, w1 = 0.f;
        if (act) {
        float lg[36];
#pragma unroll
        for (int c = 0; c < 36; ++c) lg[c] = 0.f;
#pragma unroll
        for (int part = 0; part < 4; ++part) { const f32x4* p = (const f32x4*)(LOG + ((size_t)part * T + t) * 128);
#pragma unroll
            for (int c4 = 0; c4 < 9; ++c4) { const f32x4 a = p[c4];
#pragma unroll
                for (int j = 0; j < 4; ++j) lg[4 * c4 + j] += a[j];
                if (part < 2) { const f32x4 b2 = p[16 + c4];
#pragma unroll
                    for (int j = 0; j < 4; ++j) lg[4 * c4 + j] += b2[j]; } } }
        int gsel = 0; float gmax = -INFINITY, gv4[4];
#pragma unroll
        for (int k = 0; k < 4; ++k) { gv4[k] = lg[k] + bg[k]; if (gv4[k] > gmax) { gmax = gv4[k]; gsel = k; } }
        float gden = 0.f;
#pragma unroll
        for (int k = 0; k < 4; ++k) gden += __expf(gv4[k] - gmax);
        const float pg = 1.f / gden;
        float el[8], emax = -INFINITY;
#pragma unroll
        for (int k = 0; k < 8; ++k) { const float v0 = lg[4 + k] + be[k], v1 = lg[12 + k] + be[8 + k], v2 = lg[20 + k] + be[16 + k], v3 = lg[28 + k] + be[24 + k];
            el[k] = gsel == 0 ? v0 : (gsel == 1 ? v1 : (gsel == 2 ? v2 : v3)); emax = fmaxf(emax, el[k]); }
        float eden = 0.f, ep[8];
#pragma unroll
        for (int k = 0; k < 8; ++k) { ep[k] = __expf(el[k] - emax); eden += ep[k]; }
        int i0 = 0; float p0 = -1.f;
#pragma unroll
        for (int k = 0; k < 8; ++k) { ep[k] = ep[k] / eden; if (ep[k] > p0) { p0 = ep[k]; i0 = k; } }
        int i1 = 0; float p1 = -1.f;
#pragma unroll
        for (int k = 0; k < 8; ++k) if (k != i0 && ep[k] > p1) { p1 = ep[k]; i1 = k; }
        const float den = p0 + p1; const int e0_ = gsel * 8 + i0, e1_ = gsel * 8 + i1;
            e0 = e0_; e1 = e1_; w0 = pg * (p0 / den); w1 = pg * (p1 / den);
            lr0 = __hip_atomic_fetch_add(lcnt + e0, 1, __ATOMIC_RELAXED, __HIP_MEMORY_SCOPE_WORKGROUP); lr1 = __hip_atomic_fetch_add(lcnt + e1, 1, __ATOMIC_RELAXED, __HIP_MEMORY_SCOPE_WORKGROUP);
        }
        __syncthreads();
        if (C.tid < 32) { const int c = lcnt[C.tid]; gbase[C.tid] = c ? (int)atomicAdd(&cnt[C.tid], (unsigned)c) : 0; }
        __syncthreads();
        if (act) { const int r0 = gbase[e0] + lr0, r1 = gbase[e1] + lr1;
            int* list = WSP(int, WS_LIST); list[(size_t)e0 * T + r0] = t; list[(size_t)e1 * T + r1] = t;
            *(int4*)(rinfo + (size_t)t * 4) = make_int4(e0, e1, r0, r1); *(f32x2*)(rw + (size_t)t * 2) = (f32x2){w0, w1}; }
    }
}
__device__ __forceinline__ int moe_offsets(const unsigned* cnt, int lane, int& total_tiles) {
    const int c = lane < NEXP ? (int)__hip_atomic_load(cnt + lane, __ATOMIC_RELAXED, __HIP_MEMORY_SCOPE_AGENT) : 0; const int tiles = (c + 255) >> 8;
    int incl = tiles;
#pragma unroll
    for (int o = 1; o < 64; o <<= 1) { const int t = shi(incl, (lane - o) & 63); if (lane >= o) incl += t; }
    total_tiles = shi(incl, 63);
    return (incl - tiles) * 256;
}
__device__ __forceinline__ int moe_table(const Ctx& C, int l) {
    __syncthreads();
    if (C.wave == 0) { int tt; const int off = moe_offsets(C.ctl + CW_CNT + l * 64 + CNT_BANK, C.lane, tt); const int nxt = shi(off, (C.lane + 1) & 63);
        if (C.lane < NEXP) { const int t0 = off >> 8, t1 = (C.lane == NEXP - 1) ? tt : (nxt >> 8); const int cn = (int)__hip_atomic_load(C.ctl + CW_CNT + l * 64 + CNT_BANK + C.lane, __ATOMIC_RELAXED, __HIP_MEMORY_SCOPE_AGENT);
            for (int t = t0; t < t1; ++t) { C.misc[16 + t] = C.lane; C.misc[176 + t] = (t - t0) * 256; C.misc[336 + t] = cn; } }
        if (C.lane == 0) C.misc[500] = tt; }
    __syncthreads();
    return C.misc[500];
}
__device__ __forceinline__ void ph_combine(const Ctx& C, int l, float* x, bool last, const float* gnext, bf16_t* Hn) {
    const bf16_t* yc = WSP(bf16_t, WS_PROJ + M_YC); const int* rinfo = WSP(int, WS_ROUTE); const float* rw = (const float*)(rinfo + T * 4); const int* rpos = rinfo + T * 6; const float* gf = C.in[I_FNG];
    int tt_; const int myoff = moe_offsets(C.ctl + CW_CNT + l * 64 + CNT_BANK, C.lane, tt_);
    for (int row = C.gw; row < T; row += C.NGW) {
        const int4 ri = *(const int4*)(rinfo + (size_t)row * 4); const int p0 = shi(myoff, ri.x) + ri.z, p1 = shi(myoff, ri.y) + ri.w; const float w0 = rw[(size_t)row * 2], w1 = rw[(size_t)row * 2 + 1];
        f32x4* xr = (f32x4*)(x + (size_t)row * DM) + C.lane; const u32x2* y0 = (const u32x2*)(yc + (size_t)p0 * DM) + C.lane; const u32x2* y1 = (const u32x2*)(yc + (size_t)p1 * DM) + C.lane;
        f32x4 v[8]; float ss = 0.f;
#pragma unroll
        for (int j = 0; j < 8; ++j) { const u32x2 a = y0[64 * j], b = y1[64 * j]; f32x4 xv = xr[64 * j];
            xv[0] += w0 * bf2f(a.x) + w1 * bf2f(b.x); xv[1] += w0 * bf2f(a.x >> 16) + w1 * bf2f(b.x >> 16); xv[2] += w0 * bf2f(a.y) + w1 * bf2f(b.y); xv[3] += w0 * bf2f(a.y >> 16) + w1 * bf2f(b.y >> 16);
            v[j] = xv; ss += xv[0] * xv[0] + xv[1] * xv[1] + xv[2] * xv[2] + xv[3] * xv[3]; }
        if (last) { const float rstd = rsqrtf(wave_sum(ss, C.lane) * (1.f / DM) + EPS);
#pragma unroll
            for (int j = 0; j < 8; ++j) xr[64 * j] = v[j] * rstd * ((const f32x4*)gf)[64 * j + C.lane]; }
        else { const float rstd = rsqrtf(wave_sum(ss, C.lane) * (1.f / DM) + EPS); u32x2* o = (u32x2*)(Hn + (size_t)row * DM) + C.lane; unsigned* o8 = (unsigned*)(WSP(unsigned char, WS_H8) + (size_t)row * DM) + C.lane;
#pragma unroll
            for (int j = 0; j < 8; ++j) { xr[64 * j] = v[j]; const f32x4 y = v[j] * rstd * ((const f32x4*)gnext)[64 * j + C.lane]; u32x2 w; w.x = cvt_pk_bf16(y[0], y[1]); w.y = cvt_pk_bf16(y[2], y[3]); o[64 * j] = w;
                o8[64 * j] = cvt_pk_fp8x4(y[0] * A8_SCALE, y[1] * A8_SCALE, y[2] * A8_SCALE, y[3] * A8_SCALE); } }
    }
}

constexpr int NPL = 14, NPHASES = 1 + DEPTH * NPL;
#if MK_PER_PHASE
#define IN(k) (lo <= (k) && (k) < hi)
#else
#define IN(k) true
#endif
#if MK_PER_PHASE
#define SEAM(k) do { } while (0)
#else
#define SEAM(k) xcd_barrier(bar)
#endif
template <int l> __device__ __forceinline__ void run_layer(Ctx& C, const XcdBarrier& bar, const int lo, const int hi) {
    unsigned char* wb = (unsigned char*)(C.ws + WS_W);
    bf16_t* H = WSP(bf16_t, WS_H);
        const int pb = 1 + l * NPL;
        const float* xin = (l == 0) ? C.in[I_X] : (const float*)C.out;
        if (l == 0) { if (IN(pb + 0)) { refresh(C); ph_rope(C); refresh(C); REP(1) ph_weights(C, 0); REP(2) ph_norm(C, xin, C.in[I_NMIX], H); }
            SEAM(pb + 0); }
        if (IN(pb + 1)) { refresh(C);
            pg8::EpiInProj E{(unsigned char*)C.ws};
            REP(3) {
            { pg8::Gemm g{WSP(bf16_t, WS_H8), (const bf16_t*)(wb + W_IN), DM / 2, DM / 2, DM / 2}; pg8::OrderMN S; S.init(T / 256, NP / 256 - (FP8_B1 - FP8_B0), C.G, C.bid, 256L * DM, 256L * DM); S.ps0 = FP8_B0; S.psn = FP8_B1 - FP8_B0;
              pg8::gemm_phase<pg8::EpiInProj, pg8::OrderMN, false, false, true, true, true>(C.lds, g, S, E); }
            { pg8::Gemm g{H, (const bf16_t*)(wb + W_IN), DM, DM, DM}; pg8::OrderMN S; S.init(T / 256, FP8_B1 - FP8_B0, C.G, C.bid, 256L * DM * 2, 256L * DM * 2); S.ps0 = 0; S.psn = FP8_B0;
              pg8::gemm_phase(C.lds, g, S, E); }
            }
        }
        SEAM(pb + 1);
        if (IN(pb + 2)) { refresh(C);
            ph_ckv(C, WSP(float, WS_PROJ + P_DC), C.in[I_KVG] + l * 256, WSP(bf16_t, WS_CKV));
            { pg8::Gemm g{WSP(bf16_t, WS_PROJ + P_DQ), (const bf16_t*)(wb + W_UK), 1024, 256, 256}; pg8::OrderMN S; S.init(T / 256, 8, C.G, C.bid, 256L * 1024 * 2, 256L * 256 * 2, 1, 256L * 2);
              pg8::EpiStore<0> E{WSP(bf16_t, WS_QABS), 2048, 0.08838834764831845f}; REP(4) pg8::gemm_phase(C.lds, g, S, E); }
            refresh(C);
            REP(5) ph_gmlp(C, l);
            refresh(C);
            REP(6) ph_ret_kv(C);
            refresh(C);
            REP(7) ph_idx(C, l);
        }
        SEAM(pb + 2);
        if (IN(pb + 3)) { refresh(C);
            REP(8) ph_ret_scan(C);
            REP(9) ph_att(C);
        }
        SEAM(pb + 3);
        if (IN(pb + 4)) { refresh(C);
            { pg8::Gemm g{WSP(bf16_t, WS_OLAT), (const bf16_t*)(wb + W_UV), 2048, 512, 512}; pg8::OrderMN S; S.init(T / 256, 4, C.G, C.bid, 256L * 2048 * 2, 256L * 512 * 2, 0, 512L * 2);
              pg8::EpiStore<0> E{WSP(bf16_t, WS_DS), 1024, 1.0f}; REP(10) pg8::gemm_phase(C.lds, g, S, E); }
            REP(11) ph_ret_out(C);
        }
        SEAM(pb + 4);
        if (IN(pb + 5)) { refresh(C);
            pg8::Gemm g{WSP(bf16_t, WS_RET), (const bf16_t*)(wb + W_RET), 1024, 1024, 1024}; pg8::OrderBranch S; S.base.init(T / 256, 8, C.G, C.bid, 256L * 1024 * 2, 256L * 1024 * 2); S.astride = 32L << 20; S.bstride = 4L << 20;
            pg8::EpiBranch E{WSP(bf16_t, WS_PROJ + P_GA), H}; REP(12) pg8::gemm_phase<pg8::EpiBranch, pg8::OrderBranch, false, true>(C.lds, g, S, E);
        }
        SEAM(pb + 5);
        if (IN(pb + 6)) { refresh(C);
            pg8::Gemm g{H, (const bf16_t*)(wb + W_OUT), DM, DM, DM}; pg8::OrderMN S; S.init(T / 256, 8, C.G, C.bid, 256L * DM * 2, 256L * DM * 2);
            pg8::EpiResid E{xin, C.out}; for (int rep_ = 0; rep_ <= ((l == 0) ? ((PROBE_MASK >> 17) & 1) : 0); ++rep_) pg8::gemm_phase(C.lds, g, S, E);
        }
        SEAM(pb + 6);
        if (IN(pb + 7)) { refresh(C); ph_norm_hilo(C, C.out, C.in[I_NFFN] + l * DM, H, WSP(bf16_t, WS_QABS)); }
        SEAM(pb + 7);
        if (IN(pb + 8)) { refresh(C);
            pg8::Gemm g{H, (const bf16_t*)(wb + W_RT), DM, DM, 1024}; pg8::OrderRouter S{C.G, C.bid, (long)(WS_QABS - WS_H)};
            pg8::EpiRouter E{WSP(float, WS_OLAT)}; pg8::gemm_phase(C.lds, g, S, E);
        }
        SEAM(pb + 8);
        if (IN(pb + 9)) { refresh(C); ph_route(C, l); }
        SEAM(pb + 9);
        if (IN(pb + 11)) { refresh(C);
            const int Mt = moe_table(C, l);
            pg8::Gemm g{H, (const bf16_t*)(wb + W_13), DM, DM, DM};
            pg8::OrderMoE S{C.misc + 16, Mt, 4, C.G, C.bid, 256L * DM * 2, 256L * DM * 2, 1024L * DM * 2, WSP(int, WS_LIST)};
            pg8::EpiMoeUp E{WSP(bf16_t, WS_PROJ + M_HID)}; REP(14) pg8::gemm_phase<pg8::EpiMoeUp, pg8::OrderMoE, true>(C.lds, g, S, E);
        }
        SEAM(pb + 11);
        if (IN(pb + 12)) { refresh(C);
            const int Mt = moe_table(C, l);
            pg8::Gemm g{WSP(bf16_t, WS_PROJ + M_HID), (const bf16_t*)(wb + W_2), FF, FF, FF};
            pg8::OrderMoE S{C.misc + 16, Mt, 8, C.G, C.bid, 256L * FF * 2, 256L * FF * 2, (long)DM * FF * 2, nullptr};
            pg8::EpiStore<0> E{WSP(bf16_t, WS_PROJ + M_YC), DM, 1.0f}; REP(15) pg8::gemm_phase(C.lds, g, S, E);
        }
        SEAM(pb + 12);
        if (IN(pb + 13)) { refresh(C); ph_combine(C, l, C.out, l == DEPTH - 1, C.in[I_NMIX] + (l + 1 < DEPTH ? l + 1 : l) * DM, H); if (l + 1 < DEPTH) { refresh(C); ph_weights(C, l + 1); } }
        if (l + 1 < DEPTH) SEAM(pb + 13);

}
__global__ void __launch_bounds__(512, 2) mk_fwd(Args a) {
    extern __shared__ __attribute__((aligned(16))) unsigned char lds_raw[];
    Ctx C;
    C.lds = (LAS unsigned char*)lds_raw; C.misc = (volatile LAS int*)(C.lds + MISC_OFF); C.ws = (GAS unsigned char*)a.ws; C.ctl = (unsigned*)(a.ws + WS_CTL);
    C.tid = threadIdx.x; C.lane = C.tid & 63; C.wave = __builtin_amdgcn_readfirstlane(C.tid >> 6); C.G = gridDim.x; C.bid = blockIdx.x;
    C.gw = C.bid * 8 + C.wave; C.NGW = C.G * 8; C.in = a.in; C.out = a.out;
    for (int i = C.tid; i < 1024; i += 512) C.misc[i] = 0;
    __syncthreads();
#if MK_PER_PHASE
    XcdBarrier bar; bar.bar = C.ctl + CW_BAR; bar.x = 0; bar.st = (volatile LAS unsigned*)C.misc;
#else
    XcdBarrier bar = xcd_barrier_post(C.ctl + CW_BAR, (volatile LAS unsigned*)C.misc);
#endif
    const int lo = a.ph_lo, hi = a.ph_hi;
    run_layer<0>(C, bar, lo, hi);
    run_layer<1>(C, bar, lo, hi);
}

extern "C" void kernel_launch(void* const* d_in, const int* in_sizes, int n_in, void* d_out, int out_size, void* d_ws, size_t ws_size, hipStream_t stream) {
    static int grid = 0;
    if (grid == 0) {
        if (n_in != 23 || out_size != T * DM || ws_size < WS_END) { fprintf(stderr, "kernel_launch: unexpected shapes / workspace (n_in %d out %d ws %zu need %zu)\n", n_in, out_size, ws_size, (size_t)WS_END); grid = -1; return; }
        int dev = 0, cus = 0, per_cu = 0;
        if (hipGetDevice(&dev) != hipSuccess || hipDeviceGetAttribute(&cus, hipDeviceAttributeMultiprocessorCount, dev) != hipSuccess) { grid = -1; return; }
        if (hipFuncSetAttribute((const void*)mk_fwd, hipFuncAttributeMaxDynamicSharedMemorySize, LDS_BYTES) != hipSuccess) { fprintf(stderr, "kernel_launch: hipFuncSetAttribute failed\n"); grid = -1; return; }
        if (hipOccupancyMaxActiveBlocksPerMultiprocessor(&per_cu, (const void*)mk_fwd, 512, LDS_BYTES) != hipSuccess || per_cu < 1) { fprintf(stderr, "kernel_launch: occupancy query says %d\n", per_cu); (void)hipGetLastError(); grid = -1; return; }
        grid = cus;
    }
    if (grid < 0) return;
    (void)hipMemsetAsync((char*)d_ws + WS_CTL, 0, CTL_BYTES, stream);
    Args a{};
    for (int i = 0; i < 23; ++i) a.in[i] = (const float*)d_in[i];
    a.out = (float*)d_out; a.ws = (unsigned char*)d_ws;
#if MK_PER_PHASE
    for (int p = 0; p < NPHASES; ++p) { a.ph_lo = p; a.ph_hi = p + 1; hipLaunchKernelGGL(mk_fwd, dim3(grid), dim3(512), LDS_BYTES, stream, a); }
#else
    a.ph_lo = 0; a.ph_hi = NPHASES;
    hipLaunchKernelGGL(mk_fwd, dim3(grid), dim3(512), LDS_BYTES, stream, a);
#endif
}
```

```cpp
#include <hip/hip_runtime.h>
#include <stdint.h>
#include <stdio.h>

#ifndef MK_PER_PHASE
#define MK_PER_PHASE 0
#endif
#ifndef PROBE_MASK
#define PROBE_MASK 0
#endif
#define CNT_BANK (((PROBE_MASK >> 16) & 1) * 128)
#define REP(k) for (int rep_ = 0; rep_ <= ((PROBE_MASK >> (k)) & 1); ++rep_)

#define LAS __attribute__((address_space(3)))
#define GAS __attribute__((address_space(1)))
typedef unsigned short bf16_t;
typedef short bf16x8 __attribute__((ext_vector_type(8)));
typedef short s16x4 __attribute__((ext_vector_type(4)));
typedef float f32x4 __attribute__((ext_vector_type(4)));
typedef float f32x2 __attribute__((ext_vector_type(2)));
typedef float f32x16 __attribute__((ext_vector_type(16)));
typedef unsigned u32x4 __attribute__((ext_vector_type(4)));
typedef unsigned u32x2 __attribute__((ext_vector_type(2)));

constexpr int DM = 2048, NB = 4, SEQ = 4096, T = NB * SEQ, DEPTH = 2;
constexpr int INW = 14152, NP = 14336;
constexpr int GATE_SRC0 = 8008, GATE_DST0 = 8192;
constexpr int NEXP = 32, FF = 512, MOE_ROWS = 40960;
constexpr float EPS = 1e-6f;
constexpr int FP8_B0 = 28, FP8_B1 = 32;
constexpr float A8_SCALE = 8.f, W8_SCALE = 64.f, YC_SCALE = 16.f;

constexpr size_t MiB = 1u << 20;
constexpr size_t WS_CTL = 0, CTL_BYTES = 1 * MiB;
constexpr size_t WS_ROPE = 1 * MiB;
constexpr size_t WS_W = 5 * MiB;
constexpr size_t W_IN = 0, W_RET = 56 * MiB, W_GM = 60 * MiB, W_DS = 64 * MiB, W_OUT = 68 * MiB, W_13 = 76 * MiB, W_2 = 204 * MiB, W_UK = 268 * MiB, W_UV = 269 * MiB, W_RT = 270 * MiB  , W_END = 271 * MiB;
constexpr size_t WS_H = WS_W + W_END;
constexpr size_t WS_PROJ = WS_H + 64 * MiB;
constexpr size_t P_RQ = 0, P_RK = 32 * MiB, P_RV = 64 * MiB, P_RG = 96 * MiB, P_GU = 128 * MiB, P_GV = 160 * MiB, P_DQ = 192 * MiB, P_DC = 224 * MiB  ,
                 P_IQ = 240 * MiB  , P_IK = 256 * MiB  , P_IW = 258 * MiB  , P_GA = 260 * MiB, P_GB = 324 * MiB, P_GC = 388 * MiB, P_END = 452 * MiB;
constexpr size_t M_HPERM = 0, M_HID = 160 * MiB, M_YC = 200 * MiB;
constexpr size_t WS_KV = WS_PROJ + P_END;
constexpr size_t WS_R = WS_KV + 64 * MiB;
constexpr size_t WS_QABS = WS_R + 64 * MiB;
constexpr size_t WS_OLAT = WS_QABS + 64 * MiB;
constexpr size_t WS_H8 = WS_QABS;
constexpr size_t WS_RET = WS_OLAT + 64 * MiB;
constexpr size_t WS_GM = WS_RET + 32 * MiB, WS_DS = WS_GM + 32 * MiB;
constexpr size_t WS_SEL = WS_DS + 32 * MiB;
constexpr size_t WS_CKV = WS_SEL + 8 * MiB;
constexpr size_t WS_STATS = WS_CKV + 8 * MiB;
constexpr size_t WS_ROUTE = WS_STATS + 2 * MiB;
constexpr size_t WS_LIST = WS_ROUTE + 1 * MiB;
constexpr size_t WS_END = WS_LIST + 2 * MiB;
constexpr int CW_BAR = 4096, CW_CNT = 16384;
constexpr int CW_Q = 32768;

constexpr int LDS_BYTES = 147456, MISC_OFF = LDS_BYTES - 4096;

__device__ __forceinline__ unsigned f2bf(float f) { unsigned u = __builtin_bit_cast(unsigned, f); return (u + 0x7fffu + ((u >> 16) & 1u)) >> 16; }
__device__ __forceinline__ float bf2f(unsigned b) { return __builtin_bit_cast(float, (b & 0xffffu) << 16); }
typedef __bf16 bf16x2_t __attribute__((ext_vector_type(2)));
__device__ __forceinline__ unsigned cvt_pk_bf16(float lo, float hi) { const f32x2 v = {lo, hi}; return __builtin_bit_cast(unsigned, __builtin_convertvector(v, bf16x2_t)); }
__device__ __forceinline__ float clamp448(float v) { return fminf(fmaxf(v, -448.f), 448.f); }
__device__ __forceinline__ unsigned cvt_pk_fp8x2(float a, float b2) { return (unsigned)__builtin_amdgcn_cvt_pk_fp8_f32(clamp448(a), clamp448(b2), 0, false) & 0xffffu; }
__device__ __forceinline__ unsigned cvt_pk_fp8x4(float a, float b2, float c, float d) { int w = __builtin_amdgcn_cvt_pk_fp8_f32(clamp448(a), clamp448(b2), 0, false); w = __builtin_amdgcn_cvt_pk_fp8_f32(clamp448(c), clamp448(d), w, true); return (unsigned)w; }
__device__ __forceinline__ float shx(float v, int k, int lane) { return __builtin_bit_cast(float, __builtin_amdgcn_ds_bpermute((lane ^ k) << 2, __builtin_bit_cast(int, v))); }
__device__ __forceinline__ void swap32_(float& a, float& b) { asm volatile("v_nop\n\tv_nop\n\tv_permlane32_swap_b32 %0, %1\n\tv_nop" : "+v"(a), "+v"(b)); }
__device__ __forceinline__ void swap16_(float& a, float& b) { asm volatile("v_nop\n\tv_nop\n\tv_permlane16_swap_b32 %0, %1\n\tv_nop" : "+v"(a), "+v"(b)); }
__device__ __forceinline__ float quad_sum(float v) { float a = v, b = v; swap32_(a, b); v = a + b; a = v; b = v; swap16_(a, b); return a + b; }
__device__ __forceinline__ float quad_max(float v) { float a = v, b = v; swap32_(a, b); v = fmaxf(a, b); a = v; b = v; swap16_(a, b); return fmaxf(a, b); }
__device__ __forceinline__ int shi(int v, int src) { return __builtin_amdgcn_ds_bpermute(src << 2, v); }
typedef unsigned short u16x2 __attribute__((ext_vector_type(2)));
__device__ __forceinline__ unsigned pk_below(unsigned x, unsigned cm1, unsigned cnt) {
    u16x2 r = __builtin_elementwise_sub_sat(__builtin_bit_cast(u16x2, x), __builtin_bit_cast(u16x2, cm1)); unsigned ru = __builtin_bit_cast(unsigned, r); asm volatile("" : "+v"(ru));
    r = __builtin_elementwise_sub_sat((u16x2){1, 1}, __builtin_bit_cast(u16x2, ru)); ru = __builtin_bit_cast(unsigned, r); asm volatile("" : "+v"(ru));
    return __builtin_bit_cast(unsigned, (u16x2)(__builtin_bit_cast(u16x2, cnt) + __builtin_bit_cast(u16x2, ru)));
}
__device__ __forceinline__ unsigned wave_or_dpp(unsigned x) {
    x |= (unsigned)__builtin_amdgcn_update_dpp(0, (int)x, 0x111, 0xf, 0xf, false);
    x |= (unsigned)__builtin_amdgcn_update_dpp(0, (int)x, 0x112, 0xf, 0xf, false);
    x |= (unsigned)__builtin_amdgcn_update_dpp(0, (int)x, 0x114, 0xf, 0xf, false);
    x |= (unsigned)__builtin_amdgcn_update_dpp(0, (int)x, 0x118, 0xf, 0xf, false);
    x |= (unsigned)__builtin_amdgcn_update_dpp(0, (int)x, 0x142, 0xa, 0xf, false);
    x |= (unsigned)__builtin_amdgcn_update_dpp(0, (int)x, 0x143, 0xc, 0xf, false);
    return (unsigned)__builtin_amdgcn_readlane((int)x, 63);
}
__device__ __forceinline__ int wave_total_dpp(int x) {
    x += __builtin_amdgcn_update_dpp(0, x, 0x111, 0xf, 0xf, false);
    x += __builtin_amdgcn_update_dpp(0, x, 0x112, 0xf, 0xf, false);
    x += __builtin_amdgcn_update_dpp(0, x, 0x114, 0xf, 0xf, false);
    x += __builtin_amdgcn_update_dpp(0, x, 0x118, 0xf, 0xf, false);
    x += __builtin_amdgcn_update_dpp(0, x, 0x142, 0xa, 0xf, false);
    x += __builtin_amdgcn_update_dpp(0, x, 0x143, 0xc, 0xf, false);
    return __builtin_amdgcn_readlane(x, 63);
}
__device__ __forceinline__ float wave_sum(float v, int lane) {
#pragma unroll
    for (int o = 1; o < 64; o <<= 1) v += shx(v, o, lane);
    return v;
}
__device__ __forceinline__ float wave_max(float v, int lane) {
#pragma unroll
    for (int o = 1; o < 64; o <<= 1) v = fmaxf(v, shx(v, o, lane));
    return v;
}
__device__ __forceinline__ float sigmoidf_(float x) { return __builtin_amdgcn_rcpf(1.0f + __builtin_amdgcn_exp2f(x * -1.44269504089f)); }
__device__ __forceinline__ float siluf_(float x) { return x * sigmoidf_(x); }
__device__ __forceinline__ f32x2 gelu_pk(f32x2 v) {
    const f32x2 av = __builtin_elementwise_abs(v), d = av * 0.2316418882f + 1.0f;
    f32x2 t; t.x = __builtin_amdgcn_rcpf(d.x); t.y = __builtin_amdgcn_rcpf(d.y);
    f32x2 q = t * 0.5307027145f + (-0.7265760135f); q = q * t + 0.7107068705f; q = q * t + (-0.142248368f); q = q * t + 0.127414796f; q = q * t;
    const f32x2 s = (v * v) * (-0.72134752044f);
    f32x2 e; e.x = __builtin_amdgcn_exp2f(s.x); e.y = __builtin_amdgcn_exp2f(s.y);
    const f32x2 m = v * (q * e), r = v - m;
    f32x2 o; o.x = v.x < 0.f ? m.x : r.x; o.y = v.y < 0.f ? m.y : r.y; return o;
}
template <int ACT> __device__ __forceinline__ f32x4 act4(f32x4 v) {
    if (ACT == 1) { f32x2 a = gelu_pk((f32x2){v[0], v[1]}), b = gelu_pk((f32x2){v[2], v[3]}); return (f32x4){a.x, a.y, b.x, b.y}; }
    if (ACT == 2) return (f32x4){siluf_(v[0]), siluf_(v[1]), siluf_(v[2]), siluf_(v[3])};
    if (ACT == 3) return (f32x4){sigmoidf_(v[0]), sigmoidf_(v[1]), sigmoidf_(v[2]), sigmoidf_(v[3])};
    return v;
}
__device__ __forceinline__ u32x4 pack8(f32x4 a, f32x4 b) { u32x4 w; w.x = cvt_pk_bf16(a[0], a[1]); w.y = cvt_pk_bf16(a[2], a[3]); w.z = cvt_pk_bf16(b[0], b[1]); w.w = cvt_pk_bf16(b[2], b[3]); return w; }
__device__ __forceinline__ void unpack8(u32x4 w, float (&f)[8]) {
    f[0] = bf2f(w.x); f[1] = bf2f(w.x >> 16); f[2] = bf2f(w.y); f[3] = bf2f(w.y >> 16); f[4] = bf2f(w.z); f[5] = bf2f(w.z >> 16); f[6] = bf2f(w.w); f[7] = bf2f(w.w >> 16);
}

#define XB_TMO      128
#define XB_XCNT(j)  (256  + 64 * (j))
#define XB_XSUB(j)  (1280 + 64 * (j))
#define XB_XGEN(j)  (2304 + 64 * (j))
#define XB_TOP      3328
#define XB_TOPGEN   3392
#define XCD_BAR_WORDS 3456
#define XB_SPIN_CAP (1u << 20)
__device__ __forceinline__ unsigned xb_ld(unsigned* p)              { return __hip_atomic_load(p, __ATOMIC_RELAXED, __HIP_MEMORY_SCOPE_AGENT); }
__device__ __forceinline__ unsigned xb_add(unsigned* p, unsigned v) { return __hip_atomic_fetch_add(p, v, __ATOMIC_RELAXED, __HIP_MEMORY_SCOPE_AGENT); }
__device__ __forceinline__ unsigned xb_xcc_id() { return (unsigned)__builtin_amdgcn_s_getreg((3 << 11) | 20) & 0xFu; }
#define XB_SPIN(cond, bar) do { unsigned _sp = 0; while (cond) { __builtin_amdgcn_s_sleep(1); \
    if ((++_sp & 255u) == 0u) { if (xb_ld(&(bar)[XB_TMO])) break; if (_sp > XB_SPIN_CAP) { atomicAdd(&(bar)[XB_TMO], 1u); break; } } } } while (0)
struct XcdBarrier { unsigned* bar; unsigned x; volatile LAS unsigned* st; };
__device__ __forceinline__ XcdBarrier xcd_barrier_post(unsigned* bar, volatile LAS unsigned* st) {
    XcdBarrier b; b.bar = bar; b.x = xb_xcc_id(); b.st = st;
    if (threadIdx.x == 0) (void)xb_add(&bar[XB_XCNT(b.x)], 1u);
    return b;
}
__device__ __forceinline__ void xcd_barrier_complete(unsigned* bar, unsigned x, unsigned& nloc, unsigned& nx) {
    const unsigned G = gridDim.x * gridDim.y * gridDim.z;
    unsigned sum, cnt, mine, sp = 0u;
    for (;;) {
        sum = 0u; cnt = 0u; mine = 0u;
#pragma unroll
        for (unsigned j = 0; j < 16; ++j) { const unsigned c = xb_ld(&bar[XB_XCNT(j)]); sum += c; cnt += (c > 0u) ? 1u : 0u; mine = (j == x) ? c : mine; }
        if (sum == G) break;
        __builtin_amdgcn_s_sleep(1);
        if ((++sp & 255u) == 0u) { if (xb_ld(&bar[XB_TMO])) break; if (sp > XB_SPIN_CAP) { atomicAdd(&bar[XB_TMO], 1u); break; } }
    }
    nloc = mine > 0u ? mine : 1u; nx = cnt > 0u ? cnt : 1u;
}
__device__ __forceinline__ void xcd_barrier(const XcdBarrier& b) {
    asm volatile("s_waitcnt vmcnt(0)" ::: "memory");
    __syncthreads();
    if (threadIdx.x == 0) {
        unsigned* bar = b.bar; asm volatile("" : "+s"(bar));
        __builtin_amdgcn_s_waitcnt(0);
        unsigned nloc = b.st[0], nx = b.st[1];
        if (nloc == 0u) { xcd_barrier_complete(bar, b.x, nloc, nx); b.st[0] = nloc; b.st[1] = nx; }
        const unsigned old = xb_add(&bar[XB_XSUB(b.x)], 1u);
        const unsigned gen = old / nloc;
        if (old + 1u == (gen + 1u) * nloc) {
            __builtin_amdgcn_fence(__ATOMIC_RELEASE, "agent");
            asm volatile("s_waitcnt vmcnt(0)" ::: "memory");
            const unsigned og = xb_add(&bar[XB_TOP], 1u);
            const unsigned tg = og / nx;
            if (og + 1u == (tg + 1u) * nx) xb_add(&bar[XB_TOPGEN], 1u);
            else XB_SPIN(xb_ld(&bar[XB_TOPGEN]) == tg, bar);
            __builtin_amdgcn_fence(__ATOMIC_ACQUIRE, "agent");
            xb_add(&bar[XB_XGEN(b.x)], 1u);
            asm volatile("s_waitcnt vmcnt(0)" ::: "memory");
        } else {
            XB_SPIN(xb_ld(&bar[XB_XGEN(b.x)]) == gen, bar);
            __builtin_amdgcn_fence(__ATOMIC_ACQUIRE, "agent");
            asm volatile("s_waitcnt vmcnt(0)" ::: "memory");
        }
    }
    __syncthreads();
}

namespace pg8 {
constexpr int BM = 256, BK = 64, HALF = 128, HTB = HALF * BK * 2, STAGE_BYTES = 8 * HTB, NXCD = 8, WGM = 8;
__host__ __device__ __forceinline__ int lds_byte(int r, int c) { const int st = (r >> 4) * 2 + (c >> 5), rr = r & 15, cc = c & 31, ob = rr * 64 + cc * 2; return st * 1024 + (ob ^ (((ob >> 9) & 1) << 5)); }
__host__ __device__ __forceinline__ void stage_rc(int b, int& R, int& C) { const int st = b / 1024, sb = b % 1024, swz = sb ^ (((sb >> 9) & 1) << 5); R = (st >> 1) * 16 + swz / 64; C = (st & 1) * 32 + (swz % 64) / 2; }
__host__ __device__ __forceinline__ int perm32(int rho) { const int n = rho >> 4, i = rho & 15; return 8 * (i >> 2) + 4 * n + (i & 3); }

struct Unit { int pm, pn; long aoff, boff; };
struct Gemm { const bf16_t* A; const bf16_t* Bt; int lda, ldb, K; };

struct OrderMN {
    int nM, nN, nwg, G, c, ashift; long astep, bstep, abytes; int ps0 = 1 << 30, psn = 0;
    __device__ __forceinline__ int gather_row(const Unit&, int) const { return 0; }
    __device__ void init(int nM_, int nN_, int G_, int c_, long astep_, long bstep_, int ashift_ = 0, long abytes_ = 0) { nM = nM_; nN = nN_; nwg = nM * nN; G = G_; c = c_; astep = astep_; bstep = bstep_; ashift = ashift_; abytes = abytes_; }
    __device__ bool next(int i, Unit& u) const {
        const long L = (long)i * G + c; if (L >= nwg) return false;
        int wgid = (int)L; { const int q = nwg / NXCD, r = nwg % NXCD, xcd = wgid % NXCD, off = wgid / NXCD; wgid = (xcd < r ? xcd * (q + 1) : r * (q + 1) + (xcd - r) * q) + off; }
        const int nig = WGM * nN, gid = wgid / nig, fm = gid * WGM, gsz = (nM - fm) < WGM ? (nM - fm) : WGM;
        u.pm = fm + ((wgid % nig) % gsz); u.pn = (wgid % nig) / gsz; if (u.pn >= ps0) u.pn += psn;
        u.aoff = (long)u.pm * astep + (long)(u.pn >> ashift) * abytes; u.boff = (long)u.pn * bstep; return true;
    }
};
struct OrderMoE {
    const volatile LAS int* te; int Mt, nN, G, c; long astep, bstep, estep; const int* list;
    __device__ __forceinline__ int gather_row(const Unit& u, int r) const { const int e = te[u.pm], rb = te[160 + u.pm] + r; return rb < te[320 + u.pm] ? list[(size_t)e * T + rb] : 0; }
    __device__ bool next(int i, Unit& u) const {
        const long L = (long)i * G + c; if (L >= (long)Mt * nN) return false;
        u.pm = (int)(L / nN); u.pn = (int)(L % nN);
        u.aoff = (long)u.pm * astep; u.boff = (long)te[u.pm] * estep + (long)u.pn * bstep; return true;
    }
};

typedef int i32x8 __attribute__((ext_vector_type(8)));
__device__ __forceinline__ i32x8 cat8(bf16x8 lo, bf16x8 hi) { const u32x4 a = __builtin_bit_cast(u32x4, lo), b = __builtin_bit_cast(u32x4, hi); return (i32x8){(int)a.x, (int)a.y, (int)a.z, (int)a.w, (int)b.x, (int)b.y, (int)b.z, (int)b.w}; }
template <class Epi, class Sched, bool GATH = false, bool KEEPACC = false, bool ALIGN_EPI = true, bool SP2 = true, bool FP8 = false>
__device__ __forceinline__ void gemm_phase(LAS unsigned char* lds, const Gemm g, const Sched& S, const Epi& E) {
    int tid_ = threadIdx.x; asm volatile("" : "+v"(tid_));
    const GAS bf16_t* gA = (const GAS bf16_t*)g.A; const GAS bf16_t* gB = (const GAS bf16_t*)g.Bt; asm volatile("" : "+s"(gA), "+s"(gB));
    const int tid = tid_, wid = __builtin_amdgcn_readfirstlane(tid >> 6), lane = tid & 63, wr = wid >> 2, wc = wid & 3, fr = lane & 15, fq = lane >> 4;
    const int K = g.K, nt = K / BK;
    unsigned voffA[2], voffB[2];
#pragma unroll
    for (int i = 0; i < 2; ++i) { int R, C; stage_rc(tid * 16 + i * 8192, R, C); const int Rb = Epi::PERM ? ((R & ~31) + perm32(R & 31)) : R;
        voffA[i] = (unsigned)(R * g.lda + C) * 2u; voffB[i] = (unsigned)(Rb * g.ldb + C) * 2u; }
    const size_t kstep = (size_t)(BK * 2);
    const size_t hstepA = GATH ? (size_t)0 : (size_t)HALF * g.lda * 2, hstepB = (size_t)HALF * g.ldb * 2;
    unsigned gAc[2][2], gAn[2][2]; int gR[2], gC[2];
#pragma unroll
    for (int i = 0; i < 2; ++i) { stage_rc(tid * 16 + i * 8192, gR[i], gC[i]); gAc[0][i] = gAc[1][i] = gAn[0][i] = gAn[1][i] = 0u; }
#define PG8_GLOAD(dst, un) do { _Pragma("unroll") for (int h_ = 0; h_ < 2; ++h_) _Pragma("unroll") for (int i_ = 0; i_ < 2; ++i_) \
        dst[h_][i_] = (unsigned)S.gather_row(un, h_ * HALF + gR[i_]) * (unsigned)(g.lda * 2) + (unsigned)(gC[i_] * 2); } while (0)
#define PG8_STAGE_A(bufoff, kptr, h, nx) do { if (GATH) { unsigned vo_[2]; vo_[0] = (nx) ? gAn[h][0] : gAc[h][0]; vo_[1] = (nx) ? gAn[h][1] : gAc[h][1]; PG8_STAGE(bufoff, kptr, vo_); } \
        else PG8_STAGE(bufoff, (kptr) + (h) * hstepA, voffA); } while (0)
    const unsigned ldsw = (unsigned)wid * 1024u;
    const int aoff = lds_byte(wr * 64 + fr, fq * 8), boff = lds_byte(wc * 32 + fr, fq * 8);
#define PG8_SA(b, h) (((b) * 2 + (h)) * HTB)
#define PG8_SB(b, h) ((4 + (b) * 2 + (h)) * HTB)
#define PG8_STAGE(bufoff, gbase, voff) do { _Pragma("unroll") for (int _i = 0; _i < 2; ++_i) \
        __builtin_amdgcn_global_load_lds((const GAS unsigned*)((gbase) + (voff)[_i]), (LAS unsigned*)(lds + (bufoff) + ldsw + _i * 8192), 16, 0, 0); } while (0)
#define PG8_LDA(dst, b, h) do { _Pragma("unroll") for (int m = 0; m < 4; ++m) _Pragma("unroll") for (int k = 0; k < 2; ++k) dst[m][k] = *(const LAS bf16x8*)(lds + PG8_SA(b, h) + aoff + m * 2048 + k * 1024); } while (0)
#define PG8_LDB(dst, b, h) do { _Pragma("unroll") for (int n = 0; n < 2; ++n) _Pragma("unroll") for (int k = 0; k < 2; ++k) dst[n][k] = *(const LAS bf16x8*)(lds + PG8_SB(b, h) + boff + n * 2048 + k * 1024); } while (0)
#define PG8_MMA(ai, bj, At, Bt) do { __builtin_amdgcn_s_setprio(1); _Pragma("unroll") for (int m = 0; m < 4; ++m) _Pragma("unroll") for (int n = 0; n < 2; ++n) { \
        if constexpr (FP8) { const i32x8 b8_ = cat8(Bt[n][0], Bt[n][1]), a8_ = cat8(At[m][0], At[m][1]);   \
            asm("v_mfma_scale_f32_16x16x128_f8f6f4 %0, %1, %2, %0, %3, %4 op_sel_hi:[0,0,0]" : "+v"(acc[ai][bj][m][n]) : "v"(b8_), "v"(a8_), "v"(scW), "v"(scA)); } \
        else { _Pragma("unroll") for (int k = 0; k < 2; ++k) acc[ai][bj][m][n] = __builtin_amdgcn_mfma_f32_16x16x32_bf16(Bt[n][k], At[m][k], acc[ai][bj][m][n], 0, 0, 0); } } __builtin_amdgcn_s_setprio(0); } while (0)
#define PG8_WAIT_V(n) asm volatile("s_waitcnt vmcnt(" #n ")" ::: "memory")
#define PG8_WAIT_L(n) asm volatile("s_waitcnt lgkmcnt(" #n ")" ::: "memory")
#define PG8_BAR __builtin_amdgcn_s_barrier()
#define PG8_SCHED __builtin_amdgcn_sched_barrier(0)
    Unit cur, nxt; int ui = 0;
    if (!S.next(0, cur)) return;
    const int scW = 121, scA = 124;
    f32x4 acc[2][2][4][2];
#pragma unroll
    for (int a = 0; a < 2; ++a)
#pragma unroll
        for (int b = 0; b < 2; ++b)
#pragma unroll
            for (int m = 0; m < 4; ++m)
#pragma unroll
                for (int n = 0; n < 2; ++n) acc[a][b][m][n] = (f32x4){0.f, 0.f, 0.f, 0.f};
    bf16x8 At[4][2], B0[2][2], B1[2][2];
    const GAS char* cA = (const GAS char*)gA + (GATH ? 0L : cur.aoff); const GAS char* cB = (const GAS char*)gB + cur.boff;
    if (GATH) PG8_GLOAD(gAc, cur);
    if constexpr (SP2) {
        PG8_STAGE(PG8_SB(0, 0), cB, voffB); PG8_STAGE(PG8_SB(0, 1), cB + hstepB, voffB); PG8_STAGE_A(PG8_SA(0, 0), cA, 0, false); PG8_STAGE_A(PG8_SA(0, 1), cA, 1, false);
        if (wr == 1) PG8_BAR;
        PG8_WAIT_V(2); PG8_BAR;
        PG8_STAGE(PG8_SB(1, 0), cB + kstep, voffB); PG8_STAGE_A(PG8_SA(1, 0), cA + kstep, 0, false); PG8_STAGE(PG8_SB(1, 1), cB + hstepB + kstep, voffB);
        PG8_WAIT_V(6); PG8_BAR;
    } else {
    PG8_STAGE(PG8_SB(0, 0), cB, voffB); PG8_STAGE_A(PG8_SA(0, 0), cA, 0, false); PG8_STAGE(PG8_SB(0, 1), cB + hstepB, voffB); PG8_STAGE_A(PG8_SA(0, 1), cA, 1, false);
    if (wr == 1) PG8_BAR;
    PG8_WAIT_V(4); PG8_BAR;
    PG8_STAGE(PG8_SB(1, 0), cB + kstep, voffB); PG8_STAGE_A(PG8_SA(1, 0), cA + kstep, 0, false); PG8_STAGE(PG8_SB(1, 1), cB + hstepB + kstep, voffB);
    PG8_WAIT_V(6); PG8_BAR;
    }
    for (;;) {
        const bool has_next = S.next(ui + 1, nxt);
        const GAS char* nA = (has_next && !GATH) ? (const GAS char*)gA + nxt.aoff : cA; const GAS char* nB = has_next ? (const GAS char*)gB + nxt.boff : cB;
        if (GATH) { if (has_next) PG8_GLOAD(gAn, nxt); else { gAn[0][0] = gAc[0][0]; gAn[0][1] = gAc[0][1]; gAn[1][0] = gAc[1][0]; gAn[1][1] = gAc[1][1]; } }
        for (int t = 0; t < nt; t += 2) {
            const bool last = (t == nt - 2);
            const GAS char* a1 = cA + (size_t)(t + 1) * kstep;
            const GAS char* a2 = last ? nA : cA + (size_t)(t + 2) * kstep; const GAS char* b2 = last ? nB : cB + (size_t)(t + 2) * kstep;
            const GAS char* a3 = a2 + kstep; const GAS char* b3 = b2 + kstep;
            if constexpr (SP2) {
            PG8_LDB(B0, 0, 0); PG8_LDB(B1, 0, 1); PG8_SCHED; PG8_LDA(At, 0, 0); PG8_STAGE_A(PG8_SA(1, 1), a1, 1, false);
            PG8_WAIT_V(8); PG8_WAIT_L(0); PG8_BAR; PG8_MMA(0, 0, At, B0); PG8_MMA(0, 1, At, B1); PG8_BAR; PG8_SCHED;
            PG8_LDA(At, 0, 1); PG8_STAGE(PG8_SB(0, 0), b2, voffB); PG8_STAGE(PG8_SB(0, 1), b2 + hstepB, voffB); PG8_STAGE_A(PG8_SA(0, 0), a2, 0, last);
            PG8_WAIT_V(8); PG8_WAIT_L(0); PG8_BAR; PG8_MMA(1, 0, At, B0); PG8_MMA(1, 1, At, B1); PG8_BAR; PG8_SCHED;
            PG8_LDB(B0, 1, 0); PG8_LDB(B1, 1, 1); PG8_SCHED; PG8_LDA(At, 1, 0); PG8_STAGE_A(PG8_SA(0, 1), a2, 1, last);
            PG8_WAIT_V(8); PG8_WAIT_L(0); PG8_BAR; PG8_MMA(0, 0, At, B0); PG8_MMA(0, 1, At, B1); PG8_BAR; PG8_SCHED;
            PG8_LDA(At, 1, 1); PG8_STAGE(PG8_SB(1, 0), b3, voffB); PG8_STAGE(PG8_SB(1, 1), b3 + hstepB, voffB); PG8_STAGE_A(PG8_SA(1, 0), a3, 0, last);
            PG8_WAIT_V(8); PG8_WAIT_L(0); PG8_BAR; PG8_MMA(1, 0, At, B0); PG8_MMA(1, 1, At, B1); PG8_BAR; PG8_SCHED;
            } else {
            PG8_LDB(B0, 0, 0); PG8_SCHED; PG8_LDA(At, 0, 0); PG8_STAGE_A(PG8_SA(1, 1), a1, 1, false);
            PG8_WAIT_L(8); PG8_BAR; PG8_WAIT_L(0); PG8_MMA(0, 0, At, B0); PG8_BAR; PG8_SCHED;
            PG8_LDB(B1, 0, 1); PG8_STAGE(PG8_SB(0, 0), b2, voffB);
            PG8_BAR; PG8_WAIT_L(0); PG8_MMA(0, 1, At, B1); PG8_BAR;
            PG8_LDA(At, 0, 1); PG8_STAGE_A(PG8_SA(0, 0), a2, 0, last);
            PG8_BAR; PG8_WAIT_L(0); PG8_MMA(1, 0, At, B0); PG8_BAR; PG8_SCHED;
            PG8_STAGE(PG8_SB(0, 1), b2 + hstepB, voffB);
            PG8_WAIT_V(6); PG8_BAR; PG8_MMA(1, 1, At, B1); PG8_BAR;
            PG8_LDB(B0, 1, 0); PG8_SCHED; PG8_LDA(At, 1, 0); PG8_STAGE_A(PG8_SA(0, 1), a2, 1, last);
            PG8_WAIT_L(8); PG8_BAR; PG8_WAIT_L(0); PG8_MMA(0, 0, At, B0); PG8_BAR; PG8_SCHED;
            PG8_LDB(B1, 1, 1); PG8_STAGE(PG8_SB(1, 0), b3, voffB);
            PG8_BAR; PG8_WAIT_L(0); PG8_MMA(0, 1, At, B1); PG8_BAR;
            PG8_LDA(At, 1, 1); PG8_STAGE_A(PG8_SA(1, 0), a3, 0, last);
            PG8_BAR; PG8_WAIT_L(0); PG8_MMA(1, 0, At, B0); PG8_BAR; PG8_SCHED;
            PG8_STAGE(PG8_SB(1, 1), b3 + hstepB, voffB);
            PG8_WAIT_V(6); PG8_BAR; PG8_MMA(1, 1, At, B1); PG8_BAR;
            }
        }
        if constexpr (FP8) asm volatile("s_nop 15\n\ts_nop 15" ::: "memory");
        if constexpr (ALIGN_EPI) { if (wr == 0) PG8_BAR; }
        bool zero_acc = true;
        if constexpr (KEEPACC) zero_acc = E.run(acc, cur, wr, wc, fr, fq);
        else E(acc, cur, wr, wc, fr, fq);
        if (!has_next) break;
        if (zero_acc)
#pragma unroll
        for (int a = 0; a < 2; ++a)
#pragma unroll
            for (int b = 0; b < 2; ++b)
#pragma unroll
                for (int m = 0; m < 4; ++m)
#pragma unroll
                    for (int n = 0; n < 2; ++n) acc[a][b][m][n] = (f32x4){0.f, 0.f, 0.f, 0.f};
        cur = nxt; cA = nA; cB = nB; ++ui;
        if (GATH) { gAc[0][0] = gAn[0][0]; gAc[0][1] = gAn[0][1]; gAc[1][0] = gAn[1][0]; gAc[1][1] = gAn[1][1]; }
        if constexpr (ALIGN_EPI) { if (wr == 1) PG8_BAR; }
    }
    PG8_WAIT_V(0);
    if constexpr (!ALIGN_EPI) { if (wr == 0) PG8_BAR; }
    PG8_BAR;
#undef PG8_SA
#undef PG8_SB
#undef PG8_STAGE
#undef PG8_STAGE_A
#undef PG8_GLOAD
#undef PG8_LDA
#undef PG8_LDB
#undef PG8_MMA
#undef PG8_WAIT_V
#undef PG8_WAIT_L
#undef PG8_BAR
#undef PG8_SCHED
}

typedef const f32x4 (&AccT)[2][2][4][2];
template <int ACT> __device__ __forceinline__ void store_tile_bf16(AccT acc, bf16_t* O, int ld, int row0, int colb, float scale) {
#pragma unroll
    for (int ai = 0; ai < 2; ++ai)
#pragma unroll
        for (int m = 0; m < 4; ++m) { bf16_t* rowp = O + (size_t)(row0 + ai * HALF + m * 16) * ld + colb;
#pragma unroll
            for (int bj = 0; bj < 2; ++bj) { const f32x4 v0 = act4<ACT>(acc[ai][bj][m][0] * scale), v1 = act4<ACT>(acc[ai][bj][m][1] * scale);
                *(u32x4*)(rowp + bj * HALF) = pack8(v0, v1); }
            asm volatile("" ::: "memory"); }
}
template <int ACT> struct EpiStore {
    static constexpr bool PERM = true;
    bf16_t* O; int ld; float scale;
    __device__ __forceinline__ void operator()(AccT acc, const Unit& u, int wr, int wc, int fr, int fq) const {
        store_tile_bf16<ACT>(acc, O, ld, u.pm * BM + wr * 64 + fr, u.pn * BM + wc * 32 + 8 * fq, scale);
    }
};
struct EpiStore8 {
    static constexpr bool PERM = true;
    unsigned char* O; int ld; float scale;
    __device__ __forceinline__ void operator()(AccT acc, const Unit& u, int wr, int wc, int fr, int fq) const {
        const int row0 = u.pm * BM + wr * 64 + fr, colb = u.pn * BM + wc * 32 + 8 * fq;
#pragma unroll
        for (int ai = 0; ai < 2; ++ai)
#pragma unroll
            for (int m = 0; m < 4; ++m) { unsigned char* rowp = O + (size_t)(row0 + ai * HALF + m * 16) * ld + colb;
#pragma unroll
                for (int bj = 0; bj < 2; ++bj) { const f32x4 v0 = acc[ai][bj][m][0] * scale, v1 = acc[ai][bj][m][1] * scale; u32x2 o; o.x = cvt_pk_fp8x4(v0[0], v0[1], v0[2], v0[3]); o.y = cvt_pk_fp8x4(v1[0], v1[1], v1[2], v1[3]);
                    *(u32x2*)(rowp + bj * HALF) = o; }
                asm volatile("" ::: "memory"); }
    }
};
struct EpiInProj {
    static constexpr bool PERM = true;
    unsigned char* ws;
    __device__ __forceinline__ void operator()(AccT acc, const Unit& u, int wr, int wc, int fr, int fq) const {
        const int pn = u.pn, row0 = u.pm * BM + wr * 64 + fr, cw = wc * 32 + 8 * fq;
        unsigned char* pj = ws + WS_PROJ;
        bf16_t *rq = (bf16_t*)(pj + P_RQ), *rk = (bf16_t*)(pj + P_RK), *rv = (bf16_t*)(pj + P_RV), *rg = (bf16_t*)(pj + P_RG), *gu = (bf16_t*)(pj + P_GU), *gv = (bf16_t*)(pj + P_GV), *dq = (bf16_t*)(pj + P_DQ),
               *iq = (bf16_t*)(pj + P_IQ), *ik = (bf16_t*)(pj + P_IK), *ga = (bf16_t*)(pj + P_GA), *gb = (bf16_t*)(pj + P_GB), *gc = (bf16_t*)(pj + P_GC);
        float *dcraw = (float*)(pj + P_DC), *iw = (float*)(pj + P_IW), *gvstats = (float*)(ws + WS_STATS); const float* rope = (const float*)(ws + WS_ROPE);
        if (pn < 8) {
            const bool isk = pn >= 4; bf16_t* dst = (isk ? rk : rq) + (pn & 3) * 256 + cw; const float sc = isk ? 0.0625f : 1.0f;
#pragma unroll
            for (int ai = 0; ai < 2; ++ai) { f32x4 csq[4][4];
#pragma unroll
                for (int m = 0; m < 4; ++m) { const int pos = (row0 + ai * HALF + m * 16) & (SEQ - 1); const f32x4* cs = (const f32x4*)(rope + ((size_t)pos * 128 + cw) * 2);
#pragma unroll
                    for (int q4 = 0; q4 < 4; ++q4) csq[m][q4] = cs[q4]; }
                asm volatile("" ::: "memory");
#pragma unroll
                for (int m = 0; m < 4; ++m) { const int row = row0 + ai * HALF + m * 16;
                    f32x4 o1[2], o2[2];
#pragma unroll
                    for (int n = 0; n < 2; ++n) { const f32x4 c01 = csq[m][2 * n], c23 = csq[m][2 * n + 1]; const f32x4 x1 = acc[ai][0][m][n], x2 = acc[ai][1][m][n];
                        const float co[4] = {c01[0], c01[2], c23[0], c23[2]}, si[4] = {c01[1], c01[3], c23[1], c23[3]};
#pragma unroll
                        for (int j = 0; j < 4; ++j) { o1[n][j] = (x1[j] * co[j] - x2[j] * si[j]) * sc; o2[n][j] = (x1[j] * si[j] + x2[j] * co[j]) * sc; } }
                    bf16_t* rp = dst + (size_t)row * 1024;
                    *(u32x4*)rp = pack8(o1[0], o1[1]); *(u32x4*)(rp + 128) = pack8(o2[0], o2[1]); }
                asm volatile("" ::: "memory"); }
        } else if (pn < 12) { store_tile_bf16<0>(acc, rv, 1024, row0, (pn - 8) * 256 + cw, 1.f);
        } else if (pn < 16) { store_tile_bf16<2>(acc, rg, 1024, row0, (pn - 12) * 256 + cw, 1.f);
        } else if (pn < 20) { store_tile_bf16<1>(acc, gu, 1024, row0, (pn - 16) * 256 + cw, 1.f);
        } else if (pn < 24) {
            const int t4 = pn - 20; bf16_t* dst = gv + t4 * 256 + cw;
#pragma unroll
            for (int ai = 0; ai < 2; ++ai)
#pragma unroll
                for (int m = 0; m < 4; ++m) { const int row = row0 + ai * HALF + m * 16; float s = 0.f, q = 0.f;
#pragma unroll
                    for (int bj = 0; bj < 2; ++bj) { const f32x4 v0 = act4<1>(acc[ai][bj][m][0]), v1 = act4<1>(acc[ai][bj][m][1]);
                        *(u32x4*)(dst + (size_t)row * 1024 + bj * HALF) = pack8(v0, v1);
#pragma unroll
                        for (int j = 0; j < 4; ++j) { s += v0[j] + v1[j]; q += v0[j] * v0[j] + v1[j] * v1[j]; } }
                    s = quad_sum(s); q = quad_sum(q);
                    if (fq == 0) *(f32x2*)(gvstats + ((size_t)row * 16 + t4 * 4 + wc) * 2) = (f32x2){s, q}; asm volatile("" ::: "memory"); }
        } else if (pn < 28) { store_tile_bf16<0>(acc, dq, 1024, row0, (pn - 24) * 256 + cw, 1.f);
        } else if (pn == 28) {
#pragma unroll
            for (int ai = 0; ai < 2; ++ai)
#pragma unroll
                for (int m = 0; m < 4; ++m) { float* rp = dcraw + (size_t)(row0 + ai * HALF + m * 16) * 256 + cw;
#pragma unroll
                    for (int bj = 0; bj < 2; ++bj) { *(f32x4*)(rp + bj * HALF) = acc[ai][bj][m][0]; *(f32x4*)(rp + bj * HALF + 4) = acc[ai][bj][m][1]; } }
        } else if (pn < 31) { store_tile_bf16<0>(acc, iq, 512, row0, (pn - 29) * 256 + cw, 1.f);
        } else if (pn == 31) {
#pragma unroll
            for (int ai = 0; ai < 2; ++ai)
#pragma unroll
                for (int m = 0; m < 4; ++m) { const int row = row0 + ai * HALF + m * 16;
                    if (wc < 2) *(u32x4*)(ik + (size_t)row * 64 + cw) = pack8(acc[ai][0][m][0], acc[ai][0][m][1]);
                    if (wc == 2 && fq == 0) { *(f32x4*)(iw + (size_t)row * 8) = acc[ai][0][m][0] * 0.35355339059f; *(f32x4*)(iw + (size_t)row * 8 + 4) = acc[ai][0][m][1] * 0.35355339059f; } }
        } else { const int gi = (pn - 32) >> 3; bf16_t* dst = gi == 0 ? ga : (gi == 1 ? gb : gc);
            store_tile_bf16<3>(acc, dst, 2048, row0, ((pn - 32) & 7) * 256 + cw, 1.f); }
    }
};
typedef f32x4 (&AccM)[2][2][4][2];
template <bool M8> struct EpiBranchT {
    static constexpr bool PERM = true;
    const bf16_t* gate0; unsigned char* merged;
    __device__ __forceinline__ bool run(AccM acc, const Unit& u, int wr, int wc, int fr, int fq) const {
        const int br = u.pn >> 8; const bf16_t* gate = gate0 + (size_t)br * (32u << 20); const bf16_t* gnx = gate + (32u << 20);
        const int row0 = u.pm * BM + wr * 64 + fr, colb = (u.pn & 255) * BM + wc * 32 + 8 * fq;
#pragma unroll
        for (int ai = 0; ai < 2; ++ai) {
            u32x4 gq[4][2], nq[4][2];
#pragma unroll
            for (int m = 0; m < 4; ++m)
#pragma unroll
                for (int bj = 0; bj < 2; ++bj) { const size_t ro = (size_t)(row0 + ai * HALF + m * 16) * 2048 + colb + bj * HALF; gq[m][bj] = *(const u32x4*)(gate + ro); nq[m][bj] = *(const u32x4*)((br < 2 ? gnx : gate) + ro); }
            asm volatile("" ::: "memory");
#pragma unroll
            for (int m = 0; m < 4; ++m)
#pragma unroll
                for (int bj = 0; bj < 2; ++bj) { float g8[8], n8[8]; unpack8(gq[m][bj], g8); unpack8(nq[m][bj], n8);
                    f32x4 a0 = acc[ai][bj][m][0], a1 = acc[ai][bj][m][1];
                    if (br < 2) {
#pragma unroll
                        for (int j = 0; j < 4; ++j) { a0[j] *= g8[j] * __builtin_amdgcn_rcpf(fmaxf(n8[j], 1e-30f)); a1[j] *= g8[4 + j] * __builtin_amdgcn_rcpf(fmaxf(n8[4 + j], 1e-30f)); }
                        acc[ai][bj][m][0] = a0; acc[ai][bj][m][1] = a1;
                    } else {
#pragma unroll
                        for (int j = 0; j < 4; ++j) { a0[j] *= g8[j]; a1[j] *= g8[4 + j]; }
                        if constexpr (M8) { u32x2 o; o.x = cvt_pk_fp8x4(a0[0] * A8_SCALE, a0[1] * A8_SCALE, a0[2] * A8_SCALE, a0[3] * A8_SCALE); o.y = cvt_pk_fp8x4(a1[0] * A8_SCALE, a1[1] * A8_SCALE, a1[2] * A8_SCALE, a1[3] * A8_SCALE);
                            *(u32x2*)(merged + (size_t)(row0 + ai * HALF + m * 16) * 2048 + colb + bj * HALF) = o; }
                        else *(u32x4*)((bf16_t*)merged + (size_t)(row0 + ai * HALF + m * 16) * 2048 + colb + bj * HALF) = pack8(a0, a1); } }
            asm volatile("" ::: "memory");
        }
        return br == 2;
    }
};
struct EpiResid {
    static constexpr bool PERM = false;
    const float* xsrc; float* xdst;
    __device__ __forceinline__ void operator()(AccT acc, const Unit& u, int wr, int wc, int fr, int fq) const {
        const int row0 = u.pm * BM + wr * 64 + fr, col0 = u.pn * BM + wc * 32 + 4 * fq;
#pragma unroll
        for (int ai = 0; ai < 2; ++ai)
#pragma unroll
            for (int mp = 0; mp < 2; ++mp) { f32x4 xv[2][2][2];
#pragma unroll
                for (int mm = 0; mm < 2; ++mm)
#pragma unroll
                    for (int bj = 0; bj < 2; ++bj)
#pragma unroll
                        for (int n = 0; n < 2; ++n) xv[mm][bj][n] = *(const f32x4*)(xsrc + (size_t)(row0 + ai * HALF + (2 * mp + mm) * 16) * DM + col0 + bj * HALF + n * 16);
                asm volatile("" ::: "memory");
#pragma unroll
                for (int mm = 0; mm < 2; ++mm)
#pragma unroll
                    for (int bj = 0; bj < 2; ++bj)
#pragma unroll
                        for (int n = 0; n < 2; ++n) *(f32x4*)(xdst + (size_t)(row0 + ai * HALF + (2 * mp + mm) * 16) * DM + col0 + bj * HALF + n * 16) = xv[mm][bj][n] + acc[ai][bj][2 * mp + mm][n];
                asm volatile("" ::: "memory"); }
    }
};
struct EpiMoeUp {
    static constexpr bool PERM = true;
    unsigned char* hid;
    __device__ __forceinline__ void operator()(AccT acc, const Unit& u, int wr, int wc, int fr, int fq) const {
        const int row0 = u.pm * BM + wr * 64 + fr, colb = u.pn * 128 + wc * 32 + 8 * fq;
#pragma unroll
        for (int ai = 0; ai < 2; ++ai)
#pragma unroll
            for (int m = 0; m < 4; ++m) { f32x4 r0, r1; const f32x4 a0 = acc[ai][0][m][0], a1 = acc[ai][0][m][1], b0 = acc[ai][1][m][0], b1 = acc[ai][1][m][1];
#pragma unroll
                for (int j = 0; j < 4; ++j) { r0[j] = siluf_(a0[j]) * b0[j]; r1[j] = siluf_(a1[j]) * b1[j]; }
                u32x2 o; o.x = cvt_pk_fp8x4(r0[0] * A8_SCALE, r0[1] * A8_SCALE, r0[2] * A8_SCALE, r0[3] * A8_SCALE); o.y = cvt_pk_fp8x4(r1[0] * A8_SCALE, r1[1] * A8_SCALE, r1[2] * A8_SCALE, r1[3] * A8_SCALE);
                *(u32x2*)(hid + (size_t)(row0 + ai * HALF + m * 16) * FF + colb) = o; }
    }
};
struct OrderBranch {
    OrderMN base; long astride, bstride;
    __device__ __forceinline__ int gather_row(const Unit&, int) const { return 0; }
    __device__ bool next(int i, Unit& u) const { if (!base.next(i / 3, u)) return false; const int br = i % 3; u.aoff += br * astride; u.boff += br * bstride; u.pn |= br << 8; return true; }
};
struct OrderRouter {
    int G, c; long hlo_off;
    __device__ __forceinline__ int gather_row(const Unit&, int) const { return 0; }
    __device__ bool next(int i, Unit& u) const { const int L = i * G + c; if (L >= 256) return false; const int pm = L >> 2, which = (L >> 1) & 1, kh = L & 1;
        u.pm = pm; u.pn = which * 2 + kh; u.aoff = (long)pm * 256 * DM * 2 + (long)which * hlo_off + (long)kh * 1024 * 2; u.boff = (long)kh * 1024 * 2; return true; }
};
struct EpiRouter {
    static constexpr bool PERM = false;
    float* LOG;
    __device__ __forceinline__ void operator()(AccT acc, const Unit& u, int wr, int wc, int fr, int fq) const {
        float* base = LOG + ((size_t)u.pn * T + (size_t)u.pm * BM + wr * 64 + fr) * 128 + wc * 32 + 4 * fq;
#pragma unroll
        for (int ai = 0; ai < 2; ++ai)
#pragma unroll
            for (int m = 0; m < 4; ++m)
#pragma unroll
                for (int n = 0; n < 2; ++n) *(f32x4*)(base + (size_t)(ai * HALF + m * 16) * 128 + n * 16) = acc[ai][0][m][n];
    }
};
}

struct Args { const float* in[23]; float* out; unsigned char* ws; int ph_lo, ph_hi; };
enum { I_X = 0, I_NMIX, I_WIN, I_WRET, I_LNG, I_LNB, I_WS, I_BS, I_WGM, I_KVG, I_WUK, I_WUV, I_WDS, I_WOUT, I_NFFN, I_WGRP, I_BGRP, I_WEXP, I_BEXP, I_W1, I_W3, I_W2, I_FNG };
struct Ctx {
    LAS unsigned char* lds; volatile LAS int* misc; unsigned* ctl; GAS unsigned char* ws;
    int tid, lane, wave, G, bid, gw, NGW;
    const float* const* in; float* out;
};
#define WSP(T_, off) ((T_*)(C.ws + (off)))
__device__ __forceinline__ void refresh(Ctx& C) { int t = threadIdx.x; asm volatile("" : "+v"(t)); C.tid = t; C.lane = t & 63;
    GAS unsigned char* w = C.ws; asm volatile("" : "+s"(w)); C.ws = w; C.ctl = (unsigned*)w; }

__device__ __forceinline__ void ph_rope(const Ctx& C) {
    float* rope = WSP(float, WS_ROPE);
    const double r1 = 0.9305720409296989;
    for (int idx = C.bid * 512 + C.tid; idx < SEQ * 128; idx += C.G * 512) {
        const int pos = idx >> 7, i = idx & 127;
        double inv = 1.0, b = r1; int e = i;
        while (e) { if (e & 1) inv *= b; b *= b; e >>= 1; }
        const double ang = (double)pos * inv;
        const double n = __builtin_rint(ang * 0.15915494309189533577);
        const double x = ang - n * 6.283185307179586476925;
        const double x2 = x * x;
        double s = 0.0, c = 0.0;
#pragma unroll
        for (int k = 14; k >= 1; --k) { s = (s + 1.0) * (x2 * (-1.0 / (double)((2 * k) * (2 * k + 1)))); c = (c + 1.0) * (x2 * (-1.0 / (double)((2 * k - 1) * (2 * k)))); }
        s = (s + 1.0) * x; c = c + 1.0;
        *(f32x2*)(rope + (size_t)idx * 2) = (f32x2){(float)c, (float)s};
    }
}

struct WItem { const float* src; bf16_t* dst; unsigned char* d8; int srcld, dstld, k0, n0, mode; long off; };
__device__ __forceinline__ WItem w_item(const Ctx& C, int l, int r) {
    unsigned char* wb = (unsigned char*)(C.ws + WS_W); WItem w; w.mode = 0; w.off = 0; w.d8 = nullptr;
    constexpr int N_IN = 32 * 224, N_BR = 16 * 32, N_OUT = 32 * 32, N_13 = 32 * 32 * 16, N_2 = 32 * 8 * 32;
    if (r < N_IN) { const int kb = r / 224, nb = r % 224; w.src = C.in[I_WIN] + (size_t)l * DM * INW; w.srcld = INW; w.dst = (bf16_t*)(wb + W_IN); w.dstld = DM; w.k0 = kb * 64; w.n0 = nb * 64; w.mode = 1; if (l == DEPTH - 1 || (w.n0 >> 8) < FP8_B0 || (w.n0 >> 8) >= FP8_B1) w.d8 = wb + W_IN; return w; } r -= N_IN;
    if (r < 3 * N_BR) { const int ww = r / N_BR, q = r % N_BR, kb = q / 32, nb = q % 32; w.src = C.in[ww == 0 ? I_WRET : (ww == 1 ? I_WGM : I_WDS)] + (size_t)l * 1024 * DM; w.srcld = DM;
        w.dst = (bf16_t*)(wb + (ww == 0 ? W_RET : (ww == 1 ? W_GM : W_DS))); w.dstld = 1024; w.k0 = kb * 64; w.n0 = nb * 64; return w; } r -= 3 * N_BR;
    if (r < N_OUT) { const int kb = r / 32, nb = r % 32; w.src = C.in[I_WOUT] + (size_t)l * DM * DM; w.srcld = DM; w.dst = (bf16_t*)(wb + W_OUT); w.dstld = DM; w.k0 = kb * 64; w.n0 = nb * 64; w.d8 = wb + W_OUT; return w; } r -= N_OUT;
    if (r < N_13) { const int e = r / 512, q = r % 512, kb = q / 16, nb = q % 16, row0 = nb * 64, j = row0 >> 8, sft = (row0 >> 7) & 1, fp = row0 & 127;
        w.src = C.in[sft ? I_W3 : I_W1] + ((size_t)l * NEXP + e) * DM * FF; w.srcld = FF; w.dst = (bf16_t*)(wb + W_13) + (size_t)e * 1024 * DM; w.dstld = DM; w.k0 = kb * 64; w.n0 = row0; w.off = (long)(128 * j + fp) - row0; w.d8 = wb + W_13 + (size_t)e * 1024 * DM; return w; } r -= N_13;
    if (r < N_2) { const int e = r / 256, q = r % 256, kb = q / 32, nb = q % 32; w.src = C.in[I_W2] + ((size_t)l * NEXP + e) * FF * DM; w.srcld = DM; w.dst = (bf16_t*)(wb + W_2) + (size_t)e * DM * FF; w.dstld = FF; w.k0 = kb * 64; w.n0 = nb * 64; w.d8 = wb + W_2 + (size_t)e * DM * FF; return w; } r -= N_2;
    { const int h = r / 8, q = r % 8, kb = q / 2, nb = q % 2;
      w.src = C.in[I_WUV] + ((size_t)l * 8 + h) * 256 * 128; w.srcld = 128; w.dst = (bf16_t*)(wb + W_UV) + (size_t)(h * 128) * 512 + (h & 1) * 256; w.dstld = 512; w.k0 = kb * 64; w.n0 = nb * 64; return w; }
}
__device__ __forceinline__ void w_load(const WItem& w, int lane, f32x4 (&R)[16]) {
    const int nq = lane & 15, kq = lane >> 4, n = w.n0 + 4 * nq;
    const long sc = (w.mode == 1) ? (n < GATE_SRC0 ? (long)n : (n < GATE_DST0 ? -1L : (long)(n - (GATE_DST0 - GATE_SRC0)))) : (long)n + w.off;
    const float* p = w.src + (size_t)(w.k0 + 2 * kq) * w.srcld + (sc >= 0 ? sc : 0);
#pragma unroll
    for (int i = 0; i < 8; ++i)
#pragma unroll
        for (int s2 = 0; s2 < 2; ++s2) { f32x4 v = __builtin_nontemporal_load((const f32x4*)(p + (size_t)(8 * i + s2) * w.srcld)); if (sc < 0) v = (f32x4){0.f, 0.f, 0.f, 0.f}; R[2 * i + s2] = v; }
}
__device__ __forceinline__ void w_store(const WItem& w, int lane, const f32x4 (&R)[16], LAS unsigned* scr) {
    const int nq = lane & 15, kq = lane >> 4;
    if (w.d8) {
#pragma unroll
        for (int i = 0; i < 8; ++i)
#pragma unroll
            for (int e = 0; e < 4; ++e) scr[(4 * nq + e) * 33 + 4 * i + kq] = cvt_pk_fp8x2(R[2 * i][e] * W8_SCALE, R[2 * i + 1][e] * W8_SCALE);
        asm volatile("s_waitcnt lgkmcnt(0)" ::: "memory");
        const int c = lane & 7;
#pragma unroll
        for (int j = 0; j < 8; ++j) { const int n = (lane >> 3) + 8 * j; const LAS unsigned* sp = scr + n * 33 + 4 * c;
            u32x2 o; o.x = sp[0] | (sp[1] << 16); o.y = sp[2] | (sp[3] << 16);
            *(u32x2*)(w.d8 + (size_t)(w.n0 + n) * w.dstld + w.k0 + 8 * c) = o; }
        asm volatile("s_waitcnt lgkmcnt(0)" ::: "memory");
        return; }
#pragma unroll
    for (int i = 0; i < 8; ++i)
#pragma unroll
        for (int e = 0; e < 4; ++e) scr[(4 * nq + e) * 33 + 4 * i + kq] = cvt_pk_bf16(R[2 * i][e], R[2 * i + 1][e]);
    asm volatile("s_waitcnt lgkmcnt(0)" ::: "memory");
    const int c = lane & 7;
#pragma unroll
    for (int j = 0; j < 8; ++j) { const int n = (lane >> 3) + 8 * j; const LAS unsigned* sp = scr + n * 33 + 4 * c;
        u32x4 o; o.x = sp[0]; o.y = sp[1]; o.z = sp[2]; o.w = sp[3];
        *(u32x4*)(w.dst + (size_t)(w.n0 + n) * w.dstld + w.k0 + 8 * c) = o; }
    asm volatile("s_waitcnt lgkmcnt(0)" ::: "memory");
}
__device__ __forceinline__ void ph_weights(const Ctx& C, int l) {
    LAS unsigned* scr = (LAS unsigned*)(C.lds + C.wave * 16384);
    unsigned char* wb = (unsigned char*)(C.ws + WS_W);
    constexpr int NITEMS = 32 * 224 + 3 * 16 * 32 + 32 * 32 + 32 * 32 * 16 + 32 * 8 * 32 + 8 * 8;
    { int it = C.gw; f32x4 R[16], Rn[16]; WItem w, wn;
      if (it < NITEMS) { w = w_item(C, l, it); w_load(w, C.lane, R); }
#pragma unroll 1
      while (it < NITEMS) { const int itn = it + C.NGW;
          if (itn < NITEMS) { wn = w_item(C, l, itn); w_load(wn, C.lane, Rn); }
          w_store(w, C.lane, R, scr);
#pragma unroll
          for (int i = 0; i < 16; ++i) R[i] = Rn[i];
          w = wn; it = itn; } }
    bf16_t* uv = (bf16_t*)(wb + W_UV); bf16_t* uk = (bf16_t*)(wb + W_UK); const float* wuk = C.in[I_WUK] + (size_t)l * 8 * 256 * 128;
    for (int idx = C.bid * 512 + C.tid; idx < 1024 * 256 / 8; idx += C.G * 512) { const int row = idx >> 5, c8 = (idx & 31) * 8, h = row >> 7;
        *(u32x4*)(uv + (size_t)row * 512 + (1 - (h & 1)) * 256 + c8) = (u32x4){0u, 0u, 0u, 0u}; }
    for (int idx = C.bid * 512 + C.tid; idx < 2048 * 256 / 8; idx += C.G * 512) { const int row = idx >> 5, c8 = (idx & 31) * 8, h = row >> 8, half = c8 >> 7;
        u32x4 o = (u32x4){0u, 0u, 0u, 0u};
        if (half == (h & 1)) { const float* s = wuk + (size_t)row * 128 + (c8 & 127); const f32x4 a = *(const f32x4*)s, b = *(const f32x4*)(s + 4); o = pack8(a, b); }
        *(u32x4*)(uk + (size_t)row * 256 + c8) = o; }
    bf16_t* rt = (bf16_t*)(wb + W_RT); const float* wgr = C.in[I_WGRP] + (size_t)l * DM * 4; const float* wex = C.in[I_WEXP] + (size_t)l * 4 * DM * 8;
    for (int idx = C.bid * 512 + C.tid; idx < 256 * 256; idx += C.G * 512) { const int r = idx >> 8, k8 = (idx & 255) * 8, c = r & 63, part = r >> 6;
        u32x4 o = (u32x4){0u, 0u, 0u, 0u};
        if (part < 2 && c < 36) { float v[8];
#pragma unroll
            for (int j = 0; j < 8; ++j) { const float wv = (c < 4) ? wgr[(size_t)(k8 + j) * 4 + c] : wex[((size_t)((c - 4) >> 3) * DM + (k8 + j)) * 8 + ((c - 4) & 7)];
                const float hi = bf2f(f2bf(wv)); v[j] = part == 0 ? hi : (wv - hi); }
            o = pack8((f32x4){v[0], v[1], v[2], v[3]}, (f32x4){v[4], v[5], v[6], v[7]}); }
        *(u32x4*)(rt + (size_t)r * DM + k8) = o; }
}

__device__ __forceinline__ void ph_norm(const Ctx& C, const float* x, const float* g, bf16_t* H) {
    for (int row = C.gw; row < T; row += C.NGW) {
        const f32x4* xr = (const f32x4*)(x + (size_t)row * DM) + C.lane; f32x4 v[8]; float ss = 0.f;
#pragma unroll
        for (int j = 0; j < 8; ++j) { v[j] = xr[64 * j]; ss += v[j][0] * v[j][0] + v[j][1] * v[j][1] + v[j][2] * v[j][2] + v[j][3] * v[j][3]; }
        const float rstd = rsqrtf(wave_sum(ss, C.lane) * (1.f / DM) + EPS);
        u32x2* o = (u32x2*)(H + (size_t)row * DM) + C.lane; unsigned* o8 = (unsigned*)(WSP(unsigned char, WS_H8) + (size_t)row * DM) + C.lane;
#pragma unroll
        for (int j = 0; j < 8; ++j) { const f32x4 gg = ((const f32x4*)g)[64 * j + C.lane]; const f32x4 y = v[j] * rstd * gg; u32x2 w; w.x = cvt_pk_bf16(y[0], y[1]); w.y = cvt_pk_bf16(y[2], y[3]); o[64 * j] = w;
            o8[64 * j] = cvt_pk_fp8x4(y[0] * A8_SCALE, y[1] * A8_SCALE, y[2] * A8_SCALE, y[3] * A8_SCALE); }
    }
}
__device__ __forceinline__ void ph_ckv(const Ctx& C, const float* dcraw, const float* g, bf16_t* ckv) {
    for (int row = C.gw; row < T; row += C.NGW) {
        const f32x4 v = ((const f32x4*)(dcraw + (size_t)row * 256))[C.lane];
        const float ss = wave_sum(v[0] * v[0] + v[1] * v[1] + v[2] * v[2] + v[3] * v[3], C.lane);
        const float rstd = rsqrtf(ss * (1.f / 256.f) + EPS); const f32x4 y = v * rstd * ((const f32x4*)g)[C.lane];
        u32x2 w; w.x = cvt_pk_bf16(y[0], y[1]); w.y = cvt_pk_bf16(y[2], y[3]); ((u32x2*)(ckv + (size_t)row * 256))[C.lane] = w;
    }
}

typedef short v4i16_t __attribute__((ext_vector_type(4)));
__device__ __forceinline__ s16x4 tr_read(const LAS unsigned char* p) { return __builtin_bit_cast(s16x4, __builtin_amdgcn_ds_read_tr16_b64_v4i16((LAS v4i16_t*)p)); }
__device__ __forceinline__ bf16x8 tr_frag(const LAS unsigned char* X, int LDX, int rowA, int rowB, int n0, int lane) {
    const int q = (lane & 15) >> 2, p = lane & 3;
    const s16x4 lo = tr_read(X + (rowA + q) * LDX + (n0 + 4 * p) * 2), hi = tr_read(X + (rowB + q) * LDX + (n0 + 4 * p) * 2);
    return (bf16x8){lo[0], lo[1], lo[2], lo[3], hi[0], hi[1], hi[2], hi[3]};
}
constexpr int TLD = 544;
__device__ __forceinline__ bf16x8 as_bf16x8(u32x4 w) { return __builtin_bit_cast(bf16x8, w); }

__device__ __forceinline__ void ph_ret_kv(const Ctx& C) {
    const bf16_t* rk = WSP(bf16_t, WS_PROJ + P_RK); const bf16_t* rv = WSP(bf16_t, WS_PROJ + P_RV); bf16_t* KV = WSP(bf16_t, WS_KV);
    const LAS unsigned char* Vt = C.lds; const LAS unsigned char* Kt = C.lds + 128 * TLD;
    const int g = C.lane >> 4, fr = C.lane & 15, wr = C.wave >> 2, wc = C.wave & 3;
    for (int u = C.bid; u < 512; u += C.G) {
        const int n = u & 31, h = (u >> 5) & 3, b = u >> 7; const size_t row0 = (size_t)b * SEQ + n * 128;
        const float lg2 = log2f(1.0f - exp2f(-5.0f - (float)h));
        __syncthreads();
#pragma unroll
        for (int p = 0; p < 8; ++p) { const int idx = p * 512 + C.tid, row = idx >> 5, ch = idx & 31; const size_t go = (row0 + row) * 1024 + h * 256 + ch * 8;
            const u32x4 vv = *(const u32x4*)(rv + go); *(LAS u32x4*)(C.lds + row * TLD + ch * 16) = vv;
            float f[8]; unpack8(*(const u32x4*)(rk + go), f); const float z = exp2f(lg2 * (float)(127 - row));
            *(LAS u32x4*)(C.lds + 128 * TLD + row * TLD + ch * 16) = pack8((f32x4){f[0] * z, f[1] * z, f[2] * z, f[3] * z}, (f32x4){f[4] * z, f[5] * z, f[6] * z, f[7] * z}); }
        __syncthreads();
        f32x4 acc[8][4];
#pragma unroll
        for (int m = 0; m < 8; ++m)
#pragma unroll
            for (int nn = 0; nn < 4; ++nn) acc[m][nn] = (f32x4){0.f, 0.f, 0.f, 0.f};
#pragma unroll 1
        for (int ks = 0; ks < 4; ++ks) { bf16x8 Bv[4];
#pragma unroll
            for (int nn = 0; nn < 4; ++nn) Bv[nn] = tr_frag(Vt, TLD, 32 * ks + 8 * g, 32 * ks + 8 * g + 4, 64 * wc + 16 * nn, C.lane);
#pragma unroll
            for (int m = 0; m < 8; ++m) { const bf16x8 Ak = tr_frag(Kt, TLD, 32 * ks + 8 * g, 32 * ks + 8 * g + 4, 128 * wr + 16 * m, C.lane);
#pragma unroll
                for (int nn = 0; nn < 4; ++nn) acc[m][nn] = __builtin_amdgcn_mfma_f32_16x16x32_bf16(Ak, Bv[nn], acc[m][nn], 0, 0, 0); } }
        bf16_t* out = KV + (size_t)u * 65536;
#pragma unroll
        for (int m = 0; m < 8; ++m)
#pragma unroll
            for (int nn = 0; nn < 4; ++nn) { const int e = 64 * wc + 16 * nn + fr, d = 128 * wr + 16 * m + 4 * g; u32x2 w; w.x = cvt_pk_bf16(acc[m][nn][0], acc[m][nn][1]); w.y = cvt_pk_bf16(acc[m][nn][2], acc[m][nn][3]);
                *(u32x2*)(out + e * 256 + d) = w; }
    }
}
__device__ __forceinline__ void ph_ret_scan(const Ctx& C) {
    const bf16_t* KV = WSP(bf16_t, WS_KV); bf16_t* Rb = WSP(bf16_t, WS_R);
    for (int idx = C.bid * 512 + C.tid; idx < 16 * 8192; idx += C.G * 512) {
        const int bh = idx >> 13, off = (idx & 8191) * 8, h = bh & 3; const float gc = exp2f(128.0f * log2f(1.0f - exp2f(-5.0f - (float)h)));
        float R[8] = {0.f, 0.f, 0.f, 0.f, 0.f, 0.f, 0.f, 0.f};
#pragma unroll 4
        for (int n = 0; n < 32; ++n) { const size_t o = ((size_t)bh * 32 + n) * 65536 + off;
            *(u32x4*)(Rb + o) = pack8((f32x4){R[0], R[1], R[2], R[3]}, (f32x4){R[4], R[5], R[6], R[7]});
            float f[8]; unpack8(*(const u32x4*)(KV + o), f);
#pragma unroll
            for (int j = 0; j < 8; ++j) R[j] = R[j] * gc + f[j]; }
    }
}
__device__ __forceinline__ void ph_ret_out(const Ctx& C) {
    const bf16_t* rq = WSP(bf16_t, WS_PROJ + P_RQ); const bf16_t* rk = WSP(bf16_t, WS_PROJ + P_RK); const bf16_t* rv = WSP(bf16_t, WS_PROJ + P_RV); const bf16_t* rg = WSP(bf16_t, WS_PROJ + P_RG);
    const bf16_t* Rb = WSP(bf16_t, WS_R); bf16_t* ret = WSP(bf16_t, WS_RET);
    const LAS unsigned char* Vt = C.lds;
    const int w = C.wave;
    for (int u = C.bid; u < 512; u += C.G) {
        int tid_ = C.tid; asm volatile("" : "+v"(tid_));
        const int tid = tid_, lane = tid & 63, g = lane >> 4, fr = lane & 15;
        const int n = u & 31, h = (u >> 5) & 3, b = u >> 7; const size_t row0 = (size_t)b * SEQ + n * 128;
        const float lg2 = log2f(1.0f - exp2f(-5.0f - (float)h));
        constexpr int R_OFF = 128 * TLD, RLD = 272;
        u32x4 Vr[8], Rr[8];
#pragma unroll
        for (int p = 0; p < 8; ++p) { const int idx = p * 512 + tid, row = idx >> 5, ch = idx & 31; Vr[p] = *(const u32x4*)(rv + (row0 + row) * 1024 + h * 256 + ch * 8); }
        if (n > 0) {
#pragma unroll
            for (int p = 0; p < 8; ++p) { const int idx = p * 512 + tid, e = idx >> 4, c16 = idx & 15; Rr[p] = *(const u32x4*)(Rb + (size_t)u * 65536 + (size_t)e * 256 + c16 * 8); } }
        else {
#pragma unroll
            for (int p = 0; p < 8; ++p) { const int idx = p * 512 + tid, row = idx >> 5, ch = idx & 31; Rr[p] = *(const u32x4*)(rk + (row0 + row) * 1024 + h * 256 + ch * 8); } }
        const int i = 16 * w + fr;
        bf16x8 Bq[8];
        { const bf16_t* qp = rq + (row0 + i) * 1024 + h * 256 + 8 * g;
#pragma unroll
          for (int ks = 0; ks < 8; ++ks) Bq[ks] = as_bf16x8(*(const u32x4*)(qp + 32 * ks)); }
        f32x4 acc[16];
#pragma unroll
        for (int nt = 0; nt < 16; ++nt) acc[nt] = (f32x4){0.f, 0.f, 0.f, 0.f};
        __syncthreads();
#pragma unroll
        for (int p = 0; p < 8; ++p) { const int idx = p * 512 + tid, row = idx >> 5, ch = idx & 31; *(LAS u32x4*)(C.lds + row * TLD + ch * 16) = Vr[p]; }
        if (n > 0) {
#pragma unroll
            for (int p = 0; p < 8; ++p) { const int idx = p * 512 + tid, e = idx >> 4, c16 = idx & 15; *(LAS u32x4*)(C.lds + R_OFF + e * RLD + c16 * 16) = Rr[p]; }
#pragma unroll
            for (int p = 0; p < 8; ++p) { const int idx = p * 512 + tid, e = idx >> 4, c16 = idx & 15; Rr[p] = *(const u32x4*)(Rb + (size_t)u * 65536 + (size_t)e * 256 + 128 + c16 * 8); }
#pragma unroll
            for (int dh = 0; dh < 2; ++dh) {
                if (dh) { __syncthreads();
#pragma unroll
                    for (int p = 0; p < 8; ++p) { const int idx = p * 512 + tid, e = idx >> 4, c16 = idx & 15; *(LAS u32x4*)(C.lds + R_OFF + e * RLD + c16 * 16) = Rr[p]; }
#pragma unroll
                    for (int p = 0; p < 8; ++p) { const int idx = p * 512 + tid, row = idx >> 5, ch = idx & 31; Rr[p] = *(const u32x4*)(rk + (row0 + row) * 1024 + h * 256 + ch * 8); } }
                __syncthreads();
#pragma unroll
                for (int k4 = 0; k4 < 4; ++k4)
#pragma unroll
                    for (int nt = 0; nt < 16; ++nt) { const bf16x8 Ar = as_bf16x8(*(const LAS u32x4*)(C.lds + R_OFF + (16 * nt + fr) * RLD + (32 * k4 + 8 * g) * 2));
                        acc[nt] = __builtin_amdgcn_mfma_f32_16x16x32_bf16(Ar, Bq[4 * dh + k4], acc[nt], 0, 0, 0); }
            }
            const float xi = exp2f(lg2 * (float)(i + 1));
#pragma unroll
            for (int nt = 0; nt < 16; ++nt) acc[nt] = acc[nt] * xi;
        }
        __syncthreads();
#pragma unroll
        for (int p = 0; p < 8; ++p) { const int idx = p * 512 + tid, row = idx >> 5, ch = idx & 31; *(LAS u32x4*)(C.lds + R_OFF + row * TLD + ch * 16) = Rr[p]; }
        __syncthreads();
        f32x4 ST[8];
#pragma unroll
        for (int jt = 0; jt < 8; ++jt) { ST[jt] = (f32x4){0.f, 0.f, 0.f, 0.f};
            if (jt <= w) {
#pragma unroll
                for (int ks = 0; ks < 8; ++ks) { const bf16x8 Ak = as_bf16x8(*(const LAS u32x4*)(C.lds + R_OFF + (16 * jt + fr) * TLD + (32 * ks + 8 * g) * 2)); ST[jt] = __builtin_amdgcn_mfma_f32_16x16x32_bf16(Ak, Bq[ks], ST[jt], 0, 0, 0); }
#pragma unroll
                for (int r = 0; r < 4; ++r) { const int j = 16 * jt + 4 * g + r; ST[jt][r] = (i >= j) ? ST[jt][r] * exp2f(lg2 * (float)(i - j)) : 0.f; }
                asm volatile("" ::: "memory"); } }
#pragma unroll
        for (int t = 0; t < 4; ++t) if (2 * t <= w) {
            u32x4 sw; sw.x = cvt_pk_bf16(ST[2 * t][0], ST[2 * t][1]); sw.y = cvt_pk_bf16(ST[2 * t][2], ST[2 * t][3]); sw.z = cvt_pk_bf16(ST[2 * t + 1][0], ST[2 * t + 1][1]); sw.w = cvt_pk_bf16(ST[2 * t + 1][2], ST[2 * t + 1][3]);
            const bf16x8 Bs = as_bf16x8(sw);
#pragma unroll
            for (int nt = 0; nt < 16; ++nt) { const bf16x8 Av = tr_frag(Vt, TLD, 32 * t + 4 * g, 32 * t + 16 + 4 * g, 16 * nt, lane); acc[nt] = __builtin_amdgcn_mfma_f32_16x16x32_bf16(Av, Bs, acc[nt], 0, 0, 0); } }
        float ss = 0.f;
#pragma unroll
        for (int nt = 0; nt < 16; ++nt) ss += acc[nt][0] * acc[nt][0] + acc[nt][1] * acc[nt][1] + acc[nt][2] * acc[nt][2] + acc[nt][3] * acc[nt][3];
        ss = quad_sum(ss);
        const float rstd = rsqrtf(ss * (1.f / 256.f) + EPS);
        const size_t ob = (row0 + i) * 1024 + h * 256 + 4 * g;
#pragma unroll
        for (int nt = 0; nt < 16; ++nt) { const u32x2 gw = *(const u32x2*)(rg + ob + 16 * nt); u32x2 o;
            o.x = cvt_pk_bf16(acc[nt][0] * rstd * bf2f(gw.x), acc[nt][1] * rstd * bf2f(gw.x >> 16)); o.y = cvt_pk_bf16(acc[nt][2] * rstd * bf2f(gw.y), acc[nt][3] * rstd * bf2f(gw.y >> 16));
            *(u32x2*)(ret + ob + 16 * nt) = o; }
    }
}
__device__ __forceinline__ void ph_gmlp(const Ctx& C, int l) {
    const bf16_t* gu = WSP(bf16_t, WS_PROJ + P_GU); const bf16_t* gv = WSP(bf16_t, WS_PROJ + P_GV); const float* stats = WSP(float, WS_STATS); bf16_t* gm = WSP(bf16_t, WS_GM);
    const float* lng = C.in[I_LNG] + l * 1024; const float* lnb = C.in[I_LNB] + l * 1024; const float* Wsp = C.in[I_WS] + (size_t)l * 4 * 128 * 128; const float* bs = C.in[I_BS] + l * 4 * 128;
    constexpr int WLD = 272, W_OFF = 128 * TLD, ST_OFF = W_OFF + 128 * WLD;
    const LAS unsigned char* Lt = C.lds; LAS float* sst = (LAS float*)(C.lds + ST_OFF);
    const int g4 = C.lane >> 4, fr = C.lane & 15, w = C.wave;
    for (int u = C.bid; u < 512; u += C.G) {
        const int gg = u & 3, bn = u >> 2, t0 = bn * 128;
        __syncthreads();
        if (C.tid < 128) { const float* sp = stats + (size_t)(t0 + C.tid) * 32; float s = 0.f, q = 0.f;
#pragma unroll
            for (int k = 0; k < 16; ++k) { s += sp[2 * k]; q += sp[2 * k + 1]; }
            const float mean = s * (1.f / 1024.f), var = q * (1.f / 1024.f) - mean * mean; sst[2 * C.tid] = mean; sst[2 * C.tid + 1] = rsqrtf(var + EPS); }
#pragma unroll
        for (int p = 0; p < 4; ++p) { const int idx = p * 512 + C.tid, i = idx >> 4, j8 = (idx & 15) * 8; const float* wp = Wsp + ((size_t)gg * 128 + i) * 128 + j8;
            f32x4 a = *(const f32x4*)wp, b2 = *(const f32x4*)(wp + 4);
#pragma unroll
            for (int j = 0; j < 4; ++j) { if (j8 + j > i) a[j] = 0.f; if (j8 + 4 + j > i) b2[j] = 0.f; }
            *(LAS u32x4*)(C.lds + W_OFF + i * WLD + j8 * 2) = pack8(a, b2); }
        __syncthreads();
#pragma unroll
        for (int p = 0; p < 8; ++p) { const int idx = p * 512 + C.tid, row = idx >> 5, ch = idx & 31, cg = gg * 256 + ch * 8;
            float f[8]; unpack8(*(const u32x4*)(gv + (size_t)(t0 + row) * 1024 + cg), f); const float mean = sst[2 * row], rstd = sst[2 * row + 1];
            const f32x4 g0 = *(const f32x4*)(lng + cg), g1 = *(const f32x4*)(lng + cg + 4), b0 = *(const f32x4*)(lnb + cg), b1 = *(const f32x4*)(lnb + cg + 4);
            f32x4 y0, y1;
#pragma unroll
            for (int j = 0; j < 4; ++j) { y0[j] = (f[j] - mean) * rstd * g0[j] + b0[j]; y1[j] = (f[4 + j] - mean) * rstd * g1[j] + b1[j]; }
            *(LAS u32x4*)(C.lds + row * TLD + ch * 16) = pack8(y0, y1); }
        __syncthreads();
        f32x4 acc[16];
#pragma unroll
        for (int nt = 0; nt < 16; ++nt) acc[nt] = (f32x4){0.f, 0.f, 0.f, 0.f};
#pragma unroll
        for (int ks = 0; ks < 4; ++ks) if (2 * ks <= w) {
            const bf16x8 Bw = as_bf16x8(*(const LAS u32x4*)(C.lds + W_OFF + (16 * w + fr) * WLD + (32 * ks + 8 * g4) * 2));
#pragma unroll
            for (int nt = 0; nt < 16; ++nt) { const bf16x8 Av = tr_frag(Lt, TLD, 32 * ks + 8 * g4, 32 * ks + 8 * g4 + 4, 16 * nt, C.lane); acc[nt] = __builtin_amdgcn_mfma_f32_16x16x32_bf16(Av, Bw, acc[nt], 0, 0, 0); } }
        const int i = 16 * w + fr; const float bias = bs[gg * 128 + i]; const size_t ob = (size_t)(t0 + i) * 1024 + gg * 256 + 4 * g4;
#pragma unroll
        for (int nt = 0; nt < 16; ++nt) { const u32x2 uw = *(const u32x2*)(gu + ob + 16 * nt); u32x2 o;
            o.x = cvt_pk_bf16((acc[nt][0] + bias) * bf2f(uw.x), (acc[nt][1] + bias) * bf2f(uw.x >> 16)); o.y = cvt_pk_bf16((acc[nt][2] + bias) * bf2f(uw.y), (acc[nt][3] + bias) * bf2f(uw.y >> 16));
            *(u32x2*)(gm + ob + 16 * nt) = o; }
    }
}

__device__ __forceinline__ void ph_idx(const Ctx& C, int l) {
    const bf16_t* iq = WSP(bf16_t, WS_PROJ + P_IQ); const bf16_t* ik = WSP(bf16_t, WS_PROJ + P_IK); const float* iw = WSP(float, WS_PROJ + P_IW); unsigned short* sel = WSP(unsigned short, WS_SEL);
    LAS unsigned* sc = (LAS unsigned*)C.lds;
    const int lane = C.lane, n32 = lane & 31, hh = lane >> 5, w = C.wave;
    unsigned* qh = C.ctl + CW_Q + (l * 8 + 1) * 64;
    __syncthreads();
    if (C.tid == 0) C.misc[510] = (int)__hip_atomic_fetch_add(qh, 1u, __ATOMIC_RELAXED, __HIP_MEMORY_SCOPE_AGENT);
    __syncthreads();
    int un = C.misc[510];
    for (int u = un; u < T / 8; u = un) {
        const int b = u & 3, q0 = (SEQ / 8 - 1 - (u >> 2)) * 8, tq0 = b * SEQ + q0, nk = q0 + 8, nkt = (nk + 31) >> 5;
        __syncthreads();
        if (C.tid == 0) C.misc[510] = (int)__hip_atomic_fetch_add(qh, 1u, __ATOMIC_RELAXED, __HIP_MEMORY_SCOPE_AGENT);
        bf16x8 Aq[2][4]; float wq[2][16];
        { const int r = n32, qi = 2 * ((r >> 2) & 1) + (r >> 4), hd = (r & 3) + 4 * ((r >> 3) & 1);
#pragma unroll
          for (int mt = 0; mt < 2; ++mt) { const bf16_t* qp = iq + (size_t)(tq0 + 4 * mt + qi) * 512 + hd * 64 + 8 * hh;
#pragma unroll
              for (int ks = 0; ks < 4; ++ks) Aq[mt][ks] = as_bf16x8(*(const u32x4*)(qp + 16 * ks));
#pragma unroll
              for (int a = 0; a < 2; ++a) { const float* wp = iw + (size_t)(tq0 + 4 * mt + 2 * hh + a) * 8; const f32x4 w0 = *(const f32x4*)wp, w1 = *(const f32x4*)(wp + 4);
#pragma unroll
                  for (int j = 0; j < 4; ++j) { wq[mt][8 * a + j] = w0[j] * 0.125f; wq[mt][8 * a + 4 + j] = w1[j] * 0.125f; } } } }
        u32x4 Bn[4];
        { const bf16_t* kp = ik + ((size_t)b * SEQ + 32 * (w < nkt ? w : 0) + n32) * 64 + 8 * hh;
#pragma unroll
          for (int ks = 0; ks < 4; ++ks) Bn[ks] = *(const u32x4*)(kp + 16 * ks); }
        for (int kt = w; kt < nkt; kt += 8) {
            bf16x8 Bk[4];
#pragma unroll
            for (int ks = 0; ks < 4; ++ks) Bk[ks] = as_bf16x8(Bn[ks]);
            { const int k2 = (kt + 8 < nkt) ? kt + 8 : kt; const bf16_t* kp = ik + ((size_t)b * SEQ + 32 * k2 + n32) * 64 + 8 * hh;
#pragma unroll
              for (int ks = 0; ks < 4; ++ks) Bn[ks] = *(const u32x4*)(kp + 16 * ks); }
#pragma unroll
            for (int mt = 0; mt < 2; ++mt) { const f32x16 zero16 = {0.f, 0.f, 0.f, 0.f, 0.f, 0.f, 0.f, 0.f, 0.f, 0.f, 0.f, 0.f, 0.f, 0.f, 0.f, 0.f};
                f32x16 acc = __builtin_amdgcn_mfma_f32_32x32x16_bf16(Aq[mt][0], Bk[0], zero16, 0, 0, 0);
#pragma unroll
                for (int ks = 1; ks < 4; ++ks) acc = __builtin_amdgcn_mfma_f32_32x32x16_bf16(Aq[mt][ks], Bk[ks], acc, 0, 0, 0);
#pragma unroll
                for (int a = 0; a < 2; ++a) { float s = 0.f;
#pragma unroll
                    for (int rr = 0; rr < 8; ++rr) s += wq[mt][8 * a + rr] * fmaxf(acc[8 * a + rr], 0.f);
                    const int qu = 4 * mt + 2 * hh + a, key = 32 * kt + n32; unsigned bits = __builtin_bit_cast(unsigned, s);
                    bits = (bits & 0x80000000u) ? ~bits : (bits | 0x80000000u);
                    sc[qu * 4096 + key] = (key <= q0 + qu) ? bits : 0u; } }
        }
        __syncthreads();
        un = C.misc[510];
        { const int q = q0 + w, n = q + 1; const size_t so = (size_t)(tq0 + w) * 256;
          if (n <= 256) { for (int r = lane; r < 256; r += 64) sel[so + r] = (r < n) ? (unsigned short)r : (unsigned short)0xFFFFu; }
          else {
            const int ni = (n + 63) >> 6;
            unsigned uu[64];
#pragma unroll
            for (int i = 0; i < 64; ++i) uu[i] = (i < ni && 64 * i + lane < nkt * 32) ? sc[w * 4096 + 64 * i + lane] : 0u;
            const int nact = (ni + 15) >> 4, below_const = (4 - nact) * 1024;
            LAS unsigned* slot = sc + w * 4096;
            unsigned Hp[32];
#pragma unroll
            for (int j = 0; j < 32; ++j) Hp[j] = (uu[2 * j] >> 16) | (uu[2 * j + 1] & 0xffff0000u);
#define IDX_BELOW(dst, cval) do { const unsigned cm1_ = ((cval) - 1u) * 0x00010001u; unsigned cnt_ = 0u; \
            _Pragma("unroll") for (int g4 = 0; g4 < 4; ++g4) if (g4 < nact) { _Pragma("unroll") for (int j = 8 * g4; j < 8 * g4 + 8; ++j) cnt_ = pk_below(Hp[j], cm1_, cnt_); } \
            (dst) = wave_total_dpp((int)((cnt_ & 0xffffu) + (cnt_ >> 16))) + below_const; } while (0)
#define Pl(g_, b_) Hp[16 * (g_) + (b_)]
#pragma unroll
            for (int g2 = 0; g2 < 2; ++g2) {
#pragma unroll
                for (int d = 8; d >= 1; d >>= 1) { const unsigned m = d == 8 ? 0x00FF00FFu : (d == 4 ? 0x0F0F0F0Fu : (d == 2 ? 0x33333333u : 0x55555555u));
#pragma unroll
                    for (int k = 0; k < 16; ++k) if (!(k & d)) { const unsigned t = ((Pl(g2, k) >> d) ^ Pl(g2, k + d)) & m; Pl(g2, k + d) ^= t; Pl(g2, k) ^= t << d; } } }
            unsigned Th = 0u, eq0 = 0xffffffffu, eq1 = 0xffffffffu, gt0 = 0u, gt1 = 0u; int gcnt = 0;
#pragma unroll
            for (int bit = 15; bit >= 0; --bit) { const unsigned c0 = eq0 & Pl(0, bit), c1 = eq1 & Pl(1, bit); const int pc = __builtin_popcount(c0) + __builtin_popcount(c1);
                if (wave_total_dpp(gcnt + pc) >= 256) { Th |= 1u << bit; eq0 = c0; eq1 = c1; } else { gt0 |= c0; gt1 |= c1; gcnt += pc; eq0 &= ~Pl(0, bit); eq1 &= ~Pl(1, bit); } }
#undef Pl
            const int gtT = wave_total_dpp(gcnt), nc = wave_total_dpp(__builtin_popcount(eq0) + __builtin_popcount(eq1));
            const int krem = 256 - gtT;
            unsigned Tv; int need; bool simple;
            if (nc <= 64) {
                unsigned tv = 0u; int base = 0;
#pragma unroll
                for (int g2 = 0; g2 < 2; ++g2) { const unsigned eqg = g2 ? eq1 : eq0; unsigned W = wave_or_dpp(eqg);
                    while (W) { const int p = __builtin_ctz(W); W &= W - 1u; const int i = 32 * g2 + 2 * (p & 15) + (p >> 4);
                        const unsigned kv = (64 * i + lane < nkt * 32) ? slot[64 * i + lane] : 0u; unsigned long long em = __ballot(((eqg >> p) & 1u) != 0u);
                        while (em) { const int sl = __builtin_ctzll(em); em &= em - 1ull; const unsigned v = (unsigned)__builtin_amdgcn_readlane((int)kv, sl); if (lane == base) tv = (v & 0xffffu) + 1u; ++base; } } }
                unsigned Tl = 0u;
#pragma unroll 1
                for (int bit = 16; bit >= 0; --bit) { const unsigned c = Tl | (1u << bit); if (__builtin_popcountll(__ballot(tv >= c)) >= krem) Tl = c; }
                need = krem - __builtin_popcountll(__ballot(tv > Tl)); simple = (need == __builtin_popcountll(__ballot(tv == Tl)));
                Tv = (Th << 16) | (Tl - 1u);
                asm volatile("s_waitcnt lgkmcnt(0)" ::: "memory");
            } else {
#pragma unroll
                for (int j = 0; j < 32; ++j) { const unsigned a = uu[2 * j], b2 = uu[2 * j + 1]; Hp[j] = (((a >> 16) == Th) ? (a & 0xffffu) : 0u) | (((b2 >> 16) == Th) ? (b2 << 16) : 0u); }
                unsigned Tl = 0u;
#pragma unroll 1
                for (int bit = 15; bit >= 0; --bit) { const unsigned c = Tl | (1u << bit); int bl; IDX_BELOW(bl, c); if (4096 - bl >= krem) Tl = c; }
                Tv = (Th << 16) | Tl; int cg = 0;
#pragma unroll
                for (int i = 0; i < 64; ++i) cg += (uu[i] > Tv) ? 1 : 0;
                need = 256 - wave_total_dpp(cg); simple = false;
            }
#undef IDX_BELOW
            if (simple) {
                LAS unsigned short* o16 = (LAS unsigned short*)slot; int base = 0;
#pragma unroll
                for (int i = 0; i < 64; ++i) if (16 * (i >> 4) < ni) { const bool take = uu[i] >= Tv; const unsigned long long tm = __ballot(take);
                    const int pos = (int)__builtin_amdgcn_mbcnt_hi((unsigned)(tm >> 32), __builtin_amdgcn_mbcnt_lo((unsigned)tm, (unsigned)base));
                    o16[take ? pos : 256 + lane] = (unsigned short)(64 * i + lane);
                    base += __builtin_popcountll(tm); }
                asm volatile("s_waitcnt lgkmcnt(0)" ::: "memory");
                { const u32x2 ov = *(const LAS u32x2*)(o16 + 4 * lane); *(u32x2*)(sel + so + 4 * lane) = ov; }
                asm volatile("s_waitcnt lgkmcnt(0)" ::: "memory");
            } else {
                int base = 0, eqs = 0; const unsigned long long lt = (1ull << lane) - 1ull;
#pragma unroll
                for (int i = 0; i < 64; ++i) if (16 * (i >> 4) < ni) { const bool gt = uu[i] > Tv, eq = uu[i] == Tv; const unsigned long long em = __ballot(eq);
                    const bool take = gt || (eq && (eqs + __builtin_popcountll(em & lt)) < need); const unsigned long long tm = __ballot(take);
                    if (take) sel[so + base + __builtin_popcountll(tm & lt)] = (unsigned short)(64 * i + lane);
                    base += __builtin_popcountll(tm); eqs += __builtin_popcountll(em); }
            }
          } }
    }
}
__device__ __forceinline__ void ph_att(const Ctx& C) {
    const bf16_t* qabs = WSP(bf16_t, WS_QABS); const bf16_t* ckv = WSP(bf16_t, WS_CKV); const unsigned short* sel = WSP(unsigned short, WS_SEL); bf16_t* olat = WSP(bf16_t, WS_OLAT);
    const int lane = C.lane, g = lane >> 4, fr = lane & 15;
    LAS unsigned char* ch = C.lds + C.wave * (32 * TLD + 512);
    LAS unsigned short* ssel = (LAS unsigned short*)(ch + 32 * TLD);
    for (int tq = C.gw; tq < T; tq += C.NGW) {
        const int b = __builtin_amdgcn_readfirstlane(tq >> 12), q = tq & (SEQ - 1), nv = (q + 1) < 256 ? (q + 1) : 256, nch = (nv + 31) >> 5;
        const unsigned char* cb = (const unsigned char*)(ckv + (size_t)b * SEQ * 256); const unsigned lo16 = (unsigned)(lane & 31) * 16u;
        { u32x2 sv = *(const u32x2*)(sel + (size_t)tq * 256 + 4 * lane);
          unsigned s0 = sv.x & 0xffffu, s1 = sv.x >> 16, s2_ = sv.y & 0xffffu, s3 = sv.y >> 16;
          if (4 * lane + 0 >= nv) s0 = 0; if (4 * lane + 1 >= nv) s1 = 0; if (4 * lane + 2 >= nv) s2_ = 0; if (4 * lane + 3 >= nv) s3 = 0;
          *(LAS u32x2*)(ssel + 4 * lane) = (u32x2){s0 | (s1 << 16), s2_ | (s3 << 16)}; }
        bf16x8 Bqa[8];
        { const bf16_t* qp = qabs + (size_t)tq * 2048 + (fr & 7) * 256 + 8 * g;
#pragma unroll
          for (int ks = 0; ks < 8; ++ks) { u32x4 v = *(const u32x4*)(qp + 32 * ks); if (fr >= 8) v = (u32x4){0u, 0u, 0u, 0u}; Bqa[ks] = as_bf16x8(v); } }
        f32x4 acc[16];
#pragma unroll
        for (int nt = 0; nt < 16; ++nt) acc[nt] = (f32x4){0.f, 0.f, 0.f, 0.f};
        float mrun = -INFINITY, lrun = 0.f;
        asm volatile("s_waitcnt lgkmcnt(0)" ::: "memory");
        u32x4 G[16];
#pragma unroll
        for (int p = 0; p < 16; ++p) { const unsigned s = ssel[2 * p + (lane >> 5)]; G[p] = *(const u32x4*)(cb + (s * 512u + lo16)); }
#pragma unroll 1
        for (int t = 0; t < nch; ++t) {
#pragma unroll
            for (int p = 0; p < 16; ++p) *(LAS u32x4*)(ch + (2 * p + (lane >> 5)) * TLD + (lane & 31) * 16) = G[p];
            if (t + 1 < nch) {
#pragma unroll
                for (int p = 0; p < 16; ++p) { const unsigned s = ssel[32 * (t + 1) + 2 * p + (lane >> 5)]; G[p] = *(const u32x4*)(cb + (s * 512u + lo16)); } }
            asm volatile("s_waitcnt lgkmcnt(0)" ::: "memory");
            f32x4 s2[2];
#pragma unroll
            for (int hf = 0; hf < 2; ++hf) {
#pragma unroll
                for (int ks = 0; ks < 8; ++ks) { const bf16x8 Ac = as_bf16x8(*(const LAS u32x4*)(ch + (16 * hf + fr) * TLD + (32 * ks + 8 * g) * 2));
                    s2[hf] = __builtin_amdgcn_mfma_f32_16x16x32_bf16(Ac, Bqa[ks], ks == 0 ? (f32x4){0.f, 0.f, 0.f, 0.f} : s2[hf], 0, 0, 0); } }
            float cm = -INFINITY;
#pragma unroll
            for (int hf = 0; hf < 2; ++hf)
#pragma unroll
                for (int r = 0; r < 4; ++r) { const int ki = 32 * t + 16 * hf + 4 * g + r; if (32 * t + 32 > nv && ki >= nv) s2[hf][r] = -INFINITY; cm = fmaxf(cm, s2[hf][r]); }
            cm = quad_max(cm);
            if (t == 0) mrun = cm;
            else if (__ballot(cm > mrun + 86.f)) { const float mnew = fmaxf(mrun, cm), scale = __builtin_amdgcn_exp2f(mrun - mnew);
#pragma unroll
                for (int nt = 0; nt < 16; ++nt) acc[nt] = acc[nt] * scale;
                lrun *= scale; mrun = mnew; }
            float ps = 0.f;
#pragma unroll
            for (int hf = 0; hf < 2; ++hf)
#pragma unroll
                for (int r = 0; r < 4; ++r) { s2[hf][r] = __builtin_amdgcn_exp2f(s2[hf][r] - mrun); ps += s2[hf][r]; }
            ps = quad_sum(ps);
            lrun += ps;
            u32x4 pw; pw.x = cvt_pk_bf16(s2[0][0], s2[0][1]); pw.y = cvt_pk_bf16(s2[0][2], s2[0][3]); pw.z = cvt_pk_bf16(s2[1][0], s2[1][1]); pw.w = cvt_pk_bf16(s2[1][2], s2[1][3]);
            const bf16x8 Bp = as_bf16x8(pw);
#pragma unroll
            for (int nt = 0; nt < 16; ++nt) { const bf16x8 Av = tr_frag(ch, TLD, 4 * g, 16 + 4 * g, 16 * nt, lane); acc[nt] = __builtin_amdgcn_mfma_f32_16x16x32_bf16(Av, Bp, acc[nt], 0, 0, 0); }
            asm volatile("s_waitcnt lgkmcnt(0)" ::: "memory");
        }
        const float inv = 1.0f / lrun;
        if (fr < 8) { bf16_t* op = olat + (size_t)tq * 2048 + fr * 256 + 4 * g;
#pragma unroll
            for (int nt = 0; nt < 16; ++nt) { u32x2 o; o.x = cvt_pk_bf16(acc[nt][0] * inv, acc[nt][1] * inv); o.y = cvt_pk_bf16(acc[nt][2] * inv, acc[nt][3] * inv); *(u32x2*)(op + 16 * nt) = o; } }
    }
}

__device__ __forceinline__ void ph_norm_hilo(const Ctx& C, const float* x, const float* g, bf16_t* H, bf16_t* HLO, unsigned char* H8) {
    for (int row = C.gw; row < T; row += C.NGW) {
        const f32x4* xr = (const f32x4*)(x + (size_t)row * DM) + C.lane; f32x4 v[8]; float ss = 0.f;
#pragma unroll
        for (int j = 0; j < 8; ++j) { v[j] = xr[64 * j]; ss += v[j][0] * v[j][0] + v[j][1] * v[j][1] + v[j][2] * v[j][2] + v[j][3] * v[j][3]; }
        const float rstd = rsqrtf(wave_sum(ss, C.lane) * (1.f / DM) + EPS);
        u32x2* oh = (u32x2*)(H + (size_t)row * DM) + C.lane; u32x2* ol = (u32x2*)(HLO + (size_t)row * DM) + C.lane;
#pragma unroll
        for (int j = 0; j < 8; ++j) { const f32x4 gg = ((const f32x4*)g)[64 * j + C.lane]; const f32x4 y = v[j] * rstd * gg; u32x2 wh; wh.x = cvt_pk_bf16(y[0], y[1]); wh.y = cvt_pk_bf16(y[2], y[3]);
            u32x2 wl; wl.x = cvt_pk_bf16(y[0] - bf2f(wh.x), y[1] - bf2f(wh.x >> 16)); wl.y = cvt_pk_bf16(y[2] - bf2f(wh.y), y[3] - bf2f(wh.y >> 16)); oh[64 * j] = wh; ol[64 * j] = wl;
            if (H8) ((unsigned*)(H8 + (size_t)row * DM))[64 * j + C.lane] = cvt_pk_fp8x4(y[0] * A8_SCALE, y[1] * A8_SCALE, y[2] * A8_SCALE, y[3] * A8_SCALE); }
    }
}
__device__ __forceinline__ void ph_norm_router(const Ctx& C, int l, const float* x, const float* g, unsigned char* H8, const bf16_t* wrt) {
    constexpr int RS = 4112;
    LAS unsigned char* Ah = C.lds; LAS unsigned char* Al = C.lds + 16 * RS;
    const int lane = C.lane, w = C.wave, fr = lane & 15, fq = lane >> 4;
    LAS float* lgs = (LAS float*)(C.lds + 32 * RS);
    const float* bg = C.in[I_BGRP] + l * 4; const float* be = C.in[I_BEXP] + l * 32;
    int* rinfo = WSP(int, WS_ROUTE); float* rw = (float*)(rinfo + T * 4); unsigned* cnt = C.ctl + CW_CNT + l * 64;
    LAS int* lcnt = (LAS int*)(C.misc + 600); LAS int* gbase = (LAS int*)(C.misc + 640);
    int nb = 0, blk0 = C.bid;
    for (int blk = C.bid; blk < T / 16; blk += C.G) {
        f32x4 v[2][8];
#pragma unroll
        for (int rr = 0; rr < 2; ++rr) { const f32x4* xr = (const f32x4*)(x + (size_t)(blk * 16 + 2 * w + rr) * DM) + lane;
#pragma unroll
            for (int j = 0; j < 8; ++j) v[rr][j] = xr[64 * j]; }
#pragma unroll
        for (int rr = 0; rr < 2; ++rr) { const int r = 2 * w + rr, row = blk * 16 + r; float ss = 0.f;
#pragma unroll
            for (int j = 0; j < 8; ++j) ss += v[rr][j][0] * v[rr][j][0] + v[rr][j][1] * v[rr][j][1] + v[rr][j][2] * v[rr][j][2] + v[rr][j][3] * v[rr][j][3];
            const float rstd = rsqrtf(wave_sum(ss, lane) * (1.f / DM) + EPS);
            unsigned* o8 = (unsigned*)(H8 + (size_t)row * DM) + lane;
#pragma unroll
            for (int j = 0; j < 8; ++j) { const f32x4 gg = ((const f32x4*)g)[64 * j + lane]; const f32x4 y = v[rr][j] * rstd * gg; u32x2 wh; wh.x = cvt_pk_bf16(y[0], y[1]); wh.y = cvt_pk_bf16(y[2], y[3]);
                u32x2 wl; wl.x = cvt_pk_bf16(y[0] - bf2f(wh.x), y[1] - bf2f(wh.x >> 16)); wl.y = cvt_pk_bf16(y[2] - bf2f(wh.y), y[3] - bf2f(wh.y >> 16));
                *(LAS u32x2*)(Ah + r * RS + (64 * j + lane) * 8) = wh; *(LAS u32x2*)(Al + r * RS + (64 * j + lane) * 8) = wl;
                o8[64 * j] = cvt_pk_fp8x4(y[0] * A8_SCALE, y[1] * A8_SCALE, y[2] * A8_SCALE, y[3] * A8_SCALE); } }
        __syncthreads();
        f32x4 acc[3];
#pragma unroll
        for (int nt = 0; nt < 3; ++nt) acc[nt] = (f32x4){0.f, 0.f, 0.f, 0.f};
#pragma unroll
        for (int ks = 0; ks < 8; ++ks) { const int k0 = 256 * w + 32 * ks + 8 * fq;
            const bf16x8 ah = *(const LAS bf16x8*)(Ah + fr * RS + k0 * 2), al = *(const LAS bf16x8*)(Al + fr * RS + k0 * 2);
#pragma unroll
            for (int nt = 0; nt < 3; ++nt) { const bf16x8 bh = as_bf16x8(*(const u32x4*)(wrt + (size_t)(16 * nt + fr) * DM + k0)), bl = as_bf16x8(*(const u32x4*)(wrt + (size_t)(64 + 16 * nt + fr) * DM + k0));
                acc[nt] = __builtin_amdgcn_mfma_f32_16x16x32_bf16(ah, bh, acc[nt], 0, 0, 0); acc[nt] = __builtin_amdgcn_mfma_f32_16x16x32_bf16(ah, bl, acc[nt], 0, 0, 0); acc[nt] = __builtin_amdgcn_mfma_f32_16x16x32_bf16(al, bh, acc[nt], 0, 0, 0); } }
        __syncthreads();
        LAS float* red = (LAS float*)C.lds;
#pragma unroll
        for (int nt = 0; nt < 3; ++nt)
#pragma unroll
            for (int r = 0; r < 4; ++r) red[(w * 16 + 4 * fq + r) * 48 + 16 * nt + fr] = acc[nt][r];
        __syncthreads();
        for (int o = C.tid; o < 16 * 48; o += 512) { float sm = 0.f;
#pragma unroll
            for (int w2 = 0; w2 < 8; ++w2) sm += red[w2 * 768 + o];
            const int r = o / 48, c = o - r * 48; if (c < 36) lgs[(nb * 16 + r) * 36 + c] = sm; }
        ++nb;
        if (nb == 4 || blk + C.G >= T / 16) {
            if (C.tid < 32) lcnt[C.tid] = 0;
            __syncthreads();
            const bool act = C.tid < nb * 16; const int t = (blk0 + (C.tid >> 4) * C.G) * 16 + (C.tid & 15);
            int e0 = 0, e1 = 0, lr0 = 0, lr1 = 0; float w0 = 0.f, w1 = 0.f;
            if (act) {
            float lg[36];
#pragma unroll
            for (int c = 0; c < 36; ++c) lg[c] = lgs[C.tid * 36 + c];
        int gsel = 0; float gmax = -INFINITY, gv4[4];
#pragma unroll
        for (int k = 0; k < 4; ++k) { gv4[k] = lg[k] + bg[k]; if (gv4[k] > gmax) { gmax = gv4[k]; gsel = k; } }
        float gden = 0.f;
#pragma unroll
        for (int k = 0; k < 4; ++k) gden += __expf(gv4[k] - gmax);
        const float pg = 1.f / gden;
        float el[8], emax = -INFINITY;
#pragma unroll
        for (int k = 0; k < 8; ++k) { const float v0 = lg[4 + k] + be[k], v1 = lg[12 + k] + be[8 + k], v2 = lg[20 + k] + be[16 + k], v3 = lg[28 + k] + be[24 + k];
            el[k] = gsel == 0 ? v0 : (gsel == 1 ? v1 : (gsel == 2 ? v2 : v3)); emax = fmaxf(emax, el[k]); }
        float eden = 0.f, ep[8];
#pragma unroll
        for (int k = 0; k < 8; ++k) { ep[k] = __expf(el[k] - emax); eden += ep[k]; }
        int i0 = 0; float p0 = -1.f;
#pragma unroll
        for (int k = 0; k < 8; ++k) { ep[k] = ep[k] / eden; if (ep[k] > p0) { p0 = ep[k]; i0 = k; } }
        int i1 = 0; float p1 = -1.f;
#pragma unroll
        for (int k = 0; k < 8; ++k) if (k != i0 && ep[k] > p1) { p1 = ep[k]; i1 = k; }
        const float den = p0 + p1; const int e0_ = gsel * 8 + i0, e1_ = gsel * 8 + i1;
            e0 = e0_; e1 = e1_; w0 = pg * (p0 / den); w1 = pg * (p1 / den);
            lr0 = __hip_atomic_fetch_add(lcnt + e0, 1, __ATOMIC_RELAXED, __HIP_MEMORY_SCOPE_WORKGROUP); lr1 = __hip_atomic_fetch_add(lcnt + e1, 1, __ATOMIC_RELAXED, __HIP_MEMORY_SCOPE_WORKGROUP);
            }
            __syncthreads();
            if (C.tid < 32) { const int c = lcnt[C.tid]; gbase[C.tid] = c ? (int)atomicAdd(&cnt[C.tid], (unsigned)c) : 0; }
            __syncthreads();
            if (act) { const int r0 = gbase[e0] + lr0, r1 = gbase[e1] + lr1;
                int* list = WSP(int, WS_LIST); list[(size_t)e0 * T + r0] = t; list[(size_t)e1 * T + r1] = t;
                *(int4*)(rinfo + (size_t)t * 4) = make_int4(e0, e1, r0, r1); *(f32x2*)(rw + (size_t)t * 2) = (f32x2){w0, w1}; }
            nb = 0; blk0 = blk + C.G;
        }
        __syncthreads();
    }
}
__device__ __forceinline__ void ph_route(const Ctx& C, int l) {
    const float* LOG = WSP(float, WS_OLAT); const float* bg = C.in[I_BGRP] + l * 4; const float* be = C.in[I_BEXP] + l * 32;
    int* rinfo = WSP(int, WS_ROUTE); float* rw = (float*)(rinfo + T * 4); unsigned* cnt = C.ctl + CW_CNT + l * 64;
    LAS int* lcnt = (LAS int*)(C.misc + 600); LAS int* gbase = (LAS int*)(C.misc + 640);
    for (int blk = C.bid; blk < T / 256; blk += C.G) {
        __syncthreads();
        if (C.tid < 32) lcnt[C.tid] = 0;
        __syncthreads();
        const bool act = C.tid < 256; const int t = blk * 256 + (C.tid & 255);
        int e0 = 0, e1 = 0, lr0 = 0, lr1 = 0; float w0 = 0.f, w1 = 0.f;
        if (act) {
        float lg[36];
#pragma unroll
        for (int c4 = 0; c4 < 9; ++c4) { const f32x4 a = ((const f32x4*)(LOG + (size_t)t * 48))[c4];
#pragma unroll
            for (int j = 0; j < 4; ++j) lg[4 * c4 + j] = a[j]; }
        int gsel = 0; float gmax = -INFINITY, gv4[4];
#pragma unroll
        for (int k = 0; k < 4; ++k) { gv4[k] = lg[k] + bg[k]; if (gv4[k] > gmax) { gmax = gv4[k]; gsel = k; } }
        float gden = 0.f;
#pragma unroll
        for (int k = 0; k < 4; ++k) gden += __expf(gv4[k] - gmax);
        const float pg = 1.f / gden;
        float el[8], emax = -INFINITY;
#pragma unroll
        for (int k = 0; k < 8; ++k) { const float v0 = lg[4 + k] + be[k], v1 = lg[12 + k] + be[8 + k], v2 = lg[20 + k] + be[16 + k], v3 = lg[28 + k] + be[24 + k];
            el[k] = gsel == 0 ? v0 : (gsel == 1 ? v1 : (gsel == 2 ? v2 : v3)); emax = fmaxf(emax, el[k]); }
        float eden = 0.f, ep[8];
#pragma unroll
        for (int k = 0; k < 8; ++k) { ep[k] = __expf(el[k] - emax); eden += ep[k]; }
        int i0 = 0; float p0 = -1.f;
#pragma unroll
        for (int k = 0; k < 8; ++k) { ep[k] = ep[k] / eden; if (ep[k] > p0) { p0 = ep[k]; i0 = k; } }
        int i1 = 0; float p1 = -1.f;
#pragma unroll
        for (int k = 0; k < 8; ++k) if (k != i0 && ep[k] > p1) { p1 = ep[k]; i1 = k; }
        const float den = p0 + p1; const int e0_ = gsel * 8 + i0, e1_ = gsel * 8 + i1;
            e0 = e0_; e1 = e1_; w0 = pg * (p0 / den); w1 = pg * (p1 / den);
            lr0 = __hip_atomic_fetch_add(lcnt + e0, 1, __ATOMIC_RELAXED, __HIP_MEMORY_SCOPE_WORKGROUP); lr1 = __hip_atomic_fetch_add(lcnt + e1, 1, __ATOMIC_RELAXED, __HIP_MEMORY_SCOPE_WORKGROUP);
        }
        __syncthreads();
        if (C.tid < 32) { const int c = lcnt[C.tid]; gbase[C.tid] = c ? (int)atomicAdd(&cnt[C.tid], (unsigned)c) : 0; }
        __syncthreads();
        if (act) { const int r0 = gbase[e0] + lr0, r1 = gbase[e1] + lr1;
            int* list = WSP(int, WS_LIST); list[(size_t)e0 * T + r0] = t; list[(size_t)e1 * T + r1] = t;
            *(int4*)(rinfo + (size_t)t * 4) = make_int4(e0, e1, r0, r1); *(f32x2*)(rw + (size_t)t * 2) = (f32x2){w0, w1}; }
    }
}
__device__ __forceinline__ int moe_offsets(const unsigned* cnt, int lane, int& total_tiles) {
    const int c = lane < NEXP ? (int)__hip_atomic_load(cnt + lane, __ATOMIC_RELAXED, __HIP_MEMORY_SCOPE_AGENT) : 0; const int tiles = (c + 255) >> 8;
    int incl = tiles;
#pragma unroll
    for (int o = 1; o < 64; o <<= 1) { const int t = shi(incl, (lane - o) & 63); if (lane >= o) incl += t; }
    total_tiles = shi(incl, 63);
    return (incl - tiles) * 256;
}
__device__ __forceinline__ int moe_table(const Ctx& C, int l) {
    __syncthreads();
    if (C.wave == 0) { int tt; const int off = moe_offsets(C.ctl + CW_CNT + l * 64 + CNT_BANK, C.lane, tt); const int nxt = shi(off, (C.lane + 1) & 63);
        if (C.lane < NEXP) { const int t0 = off >> 8, t1 = (C.lane == NEXP - 1) ? tt : (nxt >> 8); const int cn = (int)__hip_atomic_load(C.ctl + CW_CNT + l * 64 + CNT_BANK + C.lane, __ATOMIC_RELAXED, __HIP_MEMORY_SCOPE_AGENT);
            for (int t = t0; t < t1; ++t) { C.misc[16 + t] = C.lane; C.misc[176 + t] = (t - t0) * 256; C.misc[336 + t] = cn; } }
        if (C.lane == 0) C.misc[500] = tt; }
    __syncthreads();
    return C.misc[500];
}
__device__ __forceinline__ void ph_combine(const Ctx& C, int l, float* x, bool last, const float* gnext, bf16_t* Hn) {
    const unsigned char* yc = WSP(unsigned char, WS_PROJ + M_YC); const int* rinfo = WSP(int, WS_ROUTE); const float* rw = (const float*)(rinfo + T * 4); const int* rpos = rinfo + T * 6; const float* gf = C.in[I_FNG];
    int tt_; const int myoff = moe_offsets(C.ctl + CW_CNT + l * 64 + CNT_BANK, C.lane, tt_);
    for (int row = C.gw; row < T; row += C.NGW) {
        const int4 ri = *(const int4*)(rinfo + (size_t)row * 4); const int p0 = shi(myoff, ri.x) + ri.z, p1 = shi(myoff, ri.y) + ri.w; const float w0 = rw[(size_t)row * 2] * (1.f / YC_SCALE), w1 = rw[(size_t)row * 2 + 1] * (1.f / YC_SCALE);
        f32x4* xr = (f32x4*)(x + (size_t)row * DM) + C.lane; const unsigned* y0 = (const unsigned*)(yc + (size_t)p0 * DM) + C.lane; const unsigned* y1 = (const unsigned*)(yc + (size_t)p1 * DM) + C.lane;
        f32x4 v[8]; float ss = 0.f;
#pragma unroll
        for (int j = 0; j < 8; ++j) { const int a = (int)y0[64 * j], b = (int)y1[64 * j]; f32x4 xv = xr[64 * j];
            const f32x2 al = __builtin_amdgcn_cvt_pk_f32_fp8(a, false), ah = __builtin_amdgcn_cvt_pk_f32_fp8(a, true), bl = __builtin_amdgcn_cvt_pk_f32_fp8(b, false), bh = __builtin_amdgcn_cvt_pk_f32_fp8(b, true);
            xv[0] += w0 * al[0] + w1 * bl[0]; xv[1] += w0 * al[1] + w1 * bl[1]; xv[2] += w0 * ah[0] + w1 * bh[0]; xv[3] += w0 * ah[1] + w1 * bh[1];
            v[j] = xv; ss += xv[0] * xv[0] + xv[1] * xv[1] + xv[2] * xv[2] + xv[3] * xv[3]; }
        if (last) { const float rstd = rsqrtf(wave_sum(ss, C.lane) * (1.f / DM) + EPS);
#pragma unroll
            for (int j = 0; j < 8; ++j) xr[64 * j] = v[j] * rstd * ((const f32x4*)gf)[64 * j + C.lane]; }
        else { const float rstd = rsqrtf(wave_sum(ss, C.lane) * (1.f / DM) + EPS); u32x2* o = (u32x2*)(Hn + (size_t)row * DM) + C.lane; unsigned* o8 = (unsigned*)(WSP(unsigned char, WS_H8) + (size_t)row * DM) + C.lane;
#pragma unroll
            for (int j = 0; j < 8; ++j) { xr[64 * j] = v[j]; const f32x4 y = v[j] * rstd * ((const f32x4*)gnext)[64 * j + C.lane]; if (Hn) { u32x2 w; w.x = cvt_pk_bf16(y[0], y[1]); w.y = cvt_pk_bf16(y[2], y[3]); o[64 * j] = w; }
                o8[64 * j] = cvt_pk_fp8x4(y[0] * A8_SCALE, y[1] * A8_SCALE, y[2] * A8_SCALE, y[3] * A8_SCALE); } }
    }
}

constexpr int NPL = 14, NPHASES = 1 + DEPTH * NPL;
#if MK_PER_PHASE
#define IN(k) (lo <= (k) && (k) < hi)
#else
#define IN(k) true
#endif
#if MK_PER_PHASE
#define SEAM(k) do { } while (0)
#else
#define SEAM(k) xcd_barrier(bar)
#endif
template <int l> __device__ __forceinline__ void run_layer(Ctx& C, const XcdBarrier& bar, const int lo, const int hi) {
    unsigned char* wb = (unsigned char*)(C.ws + WS_W);
    bf16_t* H = WSP(bf16_t, WS_H);
        const int pb = 1 + l * NPL;
        const float* xin = (l == 0) ? C.in[I_X] : (const float*)C.out;
        if (l == 0) { if (IN(pb + 0)) { refresh(C); ph_rope(C); refresh(C); REP(1) ph_weights(C, 0); REP(2) ph_norm(C, xin, C.in[I_NMIX], H); }
            SEAM(pb + 0); }
        if (IN(pb + 1)) { refresh(C);
            pg8::EpiInProj E{(unsigned char*)C.ws};
            REP(3) {
            constexpr int NB16 = (l == DEPTH - 1) ? 0 : FP8_B1 - FP8_B0;
            { pg8::Gemm g{WSP(bf16_t, WS_H8), (const bf16_t*)(wb + W_IN), DM / 2, DM / 2, DM / 2}; pg8::OrderMN S; S.init(T / 256, NP / 256 - NB16, C.G, C.bid, 256L * DM, 256L * DM); if (NB16) { S.ps0 = FP8_B0; S.psn = NB16; }
              pg8::gemm_phase<pg8::EpiInProj, pg8::OrderMN, false, false, true, true, true>(C.lds, g, S, E); }
            if constexpr (NB16 > 0) { pg8::Gemm g{H, (const bf16_t*)(wb + W_IN), DM, DM, DM}; pg8::OrderMN S; S.init(T / 256, FP8_B1 - FP8_B0, C.G, C.bid, 256L * DM * 2, 256L * DM * 2); S.ps0 = 0; S.psn = FP8_B0;
              pg8::gemm_phase(C.lds, g, S, E); }
            }
        }
        SEAM(pb + 1);
        if (IN(pb + 2)) { refresh(C);
            ph_ckv(C, WSP(float, WS_PROJ + P_DC), C.in[I_KVG] + l * 256, WSP(bf16_t, WS_CKV));
            { pg8::Gemm g{WSP(bf16_t, WS_PROJ + P_DQ), (const bf16_t*)(wb + W_UK), 1024, 256, 256}; pg8::OrderMN S; S.init(T / 256, 8, C.G, C.bid, 256L * 1024 * 2, 256L * 256 * 2, 1, 256L * 2);
              pg8::EpiStore<0> E{WSP(bf16_t, WS_QABS), 2048, 0.08838834764831845f * 1.4426950408889634f};   REP(4) pg8::gemm_phase(C.lds, g, S, E); }
            refresh(C);
            REP(5) ph_gmlp(C, l);
            refresh(C);
            REP(6) ph_ret_kv(C);
            refresh(C);
            REP(7) ph_idx(C, l);
        }
        SEAM(pb + 2);
        if (IN(pb + 3)) { refresh(C);
            REP(8) ph_ret_scan(C);
            REP(9) ph_att(C);
        }
        SEAM(pb + 3);
        if (IN(pb + 4)) { refresh(C);
            { pg8::Gemm g{WSP(bf16_t, WS_OLAT), (const bf16_t*)(wb + W_UV), 2048, 512, 512}; pg8::OrderMN S; S.init(T / 256, 4, C.G, C.bid, 256L * 2048 * 2, 256L * 512 * 2, 0, 512L * 2);
              pg8::EpiStore<0> E{WSP(bf16_t, WS_DS), 1024, 1.0f}; REP(10) pg8::gemm_phase(C.lds, g, S, E); }
            REP(11) ph_ret_out(C);
        }
        SEAM(pb + 4);
        if (IN(pb + 5)) { refresh(C);
            pg8::Gemm g{WSP(bf16_t, WS_RET), (const bf16_t*)(wb + W_RET), 1024, 1024, 1024}; pg8::OrderBranch S; S.base.init(T / 256, 8, C.G, C.bid, 256L * 1024 * 2, 256L * 1024 * 2); S.astride = 32L << 20; S.bstride = 4L << 20;
            constexpr bool W8OUT = true;
            pg8::EpiBranchT<W8OUT> E{WSP(bf16_t, WS_PROJ + P_GA), WSP(unsigned char, WS_H)}; REP(12) pg8::gemm_phase<pg8::EpiBranchT<W8OUT>, pg8::OrderBranch, false, true>(C.lds, g, S, E);
        }
        SEAM(pb + 5);
        if (IN(pb + 6)) { refresh(C);
            pg8::EpiResid E{xin, C.out};
            if constexpr (true) { pg8::Gemm g{H, (const bf16_t*)(wb + W_OUT), DM / 2, DM / 2, DM / 2}; pg8::OrderMN S; S.init(T / 256, 8, C.G, C.bid, 256L * DM, 256L * DM);
                pg8::gemm_phase<pg8::EpiResid, pg8::OrderMN, false, false, true, true, true>(C.lds, g, S, E); }
            else { pg8::Gemm g{H, (const bf16_t*)(wb + W_OUT), DM, DM, DM}; pg8::OrderMN S; S.init(T / 256, 8, C.G, C.bid, 256L * DM * 2, 256L * DM * 2); pg8::gemm_phase(C.lds, g, S, E); }
        }
        SEAM(pb + 6);
        if (IN(pb + 7)) { refresh(C); ph_norm_router(C, l, C.out, C.in[I_NFFN] + l * DM, WSP(unsigned char, WS_KV), (const bf16_t*)(wb + W_RT)); }
        SEAM(pb + 7);
        if (IN(pb + 11)) { refresh(C);
            const int Mt = moe_table(C, l);
            pg8::EpiMoeUp E{WSP(unsigned char, WS_PROJ + M_HID)};
            if constexpr (true) {
                pg8::Gemm g{WSP(bf16_t, WS_KV), (const bf16_t*)(wb + W_13), DM / 2, DM / 2, DM / 2};
                pg8::OrderMoE S{C.misc + 16, Mt, 4, C.G, C.bid, 256L * DM, 256L * DM, 1024L * DM, WSP(int, WS_LIST)};
                pg8::gemm_phase<pg8::EpiMoeUp, pg8::OrderMoE, true, false, true, true, true>(C.lds, g, S, E);
            } else {
            pg8::Gemm g{H, (const bf16_t*)(wb + W_13), DM, DM, DM};
            pg8::OrderMoE S{C.misc + 16, Mt, 4, C.G, C.bid, 256L * DM * 2, 256L * DM * 2, 1024L * DM * 2, WSP(int, WS_LIST)};
            REP(14) pg8::gemm_phase<pg8::EpiMoeUp, pg8::OrderMoE, true>(C.lds, g, S, E); }
        }
        SEAM(pb + 11);
        if (IN(pb + 12)) { refresh(C);
            const int Mt = moe_table(C, l);
            pg8::Gemm g{WSP(bf16_t, WS_PROJ + M_HID), (const bf16_t*)(wb + W_2), FF / 2, FF / 2, FF / 2};
            pg8::OrderMoE S{C.misc + 16, Mt, 8, C.G, C.bid, 256L * FF, 256L * FF, (long)DM * FF, nullptr};
            pg8::EpiStore8 E{WSP(unsigned char, WS_PROJ + M_YC), DM, YC_SCALE}; REP(15) pg8::gemm_phase<pg8::EpiStore8, pg8::OrderMoE, false, false, true, true, true>(C.lds, g, S, E);
        }
        SEAM(pb + 12);
        if (IN(pb + 13)) { refresh(C); ph_combine(C, l, C.out, l == DEPTH - 1, C.in[I_NMIX] + (l + 1 < DEPTH ? l + 1 : l) * DM, (l + 1 == DEPTH - 1) ? (bf16_t*)nullptr : H); if (l + 1 < DEPTH) { refresh(C); ph_weights(C, l + 1); } }
        if (l + 1 < DEPTH) SEAM(pb + 13);

}
__global__ void __launch_bounds__(512, 2) mk_fwd(Args a) {
    extern __shared__ __attribute__((aligned(16))) unsigned char lds_raw[];
    Ctx C;
    C.lds = (LAS unsigned char*)lds_raw; C.misc = (volatile LAS int*)(C.lds + MISC_OFF); C.ws = (GAS unsigned char*)a.ws; C.ctl = (unsigned*)(a.ws + WS_CTL);
    C.tid = threadIdx.x; C.lane = C.tid & 63; C.wave = __builtin_amdgcn_readfirstlane(C.tid >> 6); C.G = gridDim.x; C.bid = blockIdx.x;
    C.gw = C.bid * 8 + C.wave; C.NGW = C.G * 8; C.in = a.in; C.out = a.out;
    for (int i = C.tid; i < 1024; i += 512) C.misc[i] = 0;
    __syncthreads();
#if MK_PER_PHASE
    XcdBarrier bar; bar.bar = C.ctl + CW_BAR; bar.x = 0; bar.st = (volatile LAS unsigned*)C.misc;
#else
    XcdBarrier bar = xcd_barrier_post(C.ctl + CW_BAR, (volatile LAS unsigned*)C.misc);
#endif
    const int lo = a.ph_lo, hi = a.ph_hi;
    run_layer<0>(C, bar, lo, hi);
    run_layer<1>(C, bar, lo, hi);
}

extern "C" void kernel_launch(void* const* d_in, const int* in_sizes, int n_in, void* d_out, int out_size, void* d_ws, size_t ws_size, hipStream_t stream) {
    static int grid = 0;
    if (grid == 0) {
        if (n_in != 23 || out_size != T * DM || ws_size < WS_END) { fprintf(stderr, "kernel_launch: unexpected shapes / workspace (n_in %d out %d ws %zu need %zu)\n", n_in, out_size, ws_size, (size_t)WS_END); grid = -1; return; }
        int dev = 0, cus = 0, per_cu = 0;
        if (hipGetDevice(&dev) != hipSuccess || hipDeviceGetAttribute(&cus, hipDeviceAttributeMultiprocessorCount, dev) != hipSuccess) { grid = -1; return; }
        if (hipFuncSetAttribute((const void*)mk_fwd, hipFuncAttributeMaxDynamicSharedMemorySize, LDS_BYTES) != hipSuccess) { fprintf(stderr, "kernel_launch: hipFuncSetAttribute failed\n"); grid = -1; return; }
        if (hipOccupancyMaxActiveBlocksPerMultiprocessor(&per_cu, (const void*)mk_fwd, 512, LDS_BYTES) != hipSuccess || per_cu < 1) { fprintf(stderr, "kernel_launch: occupancy query says %d\n", per_cu); (void)hipGetLastError(); grid = -1; return; }
        grid = cus;
    }
    if (grid < 0) return;
    (void)hipMemsetAsync((char*)d_ws + WS_CTL, 0, CTL_BYTES, stream);
    Args a{};
    for (int i = 0; i < 23; ++i) a.in[i] = (const float*)d_in[i];
    a.out = (float*)d_out; a.ws = (unsigned char*)d_ws;
#if MK_PER_PHASE
    for (int p = 0; p < NPHASES; ++p) { a.ph_lo = p; a.ph_hi = p + 1; hipLaunchKernelGGL(mk_fwd, dim3(grid), dim3(512), LDS_BYTES, stream, a); }
#else
    a.ph_lo = 0; a.ph_hi = NPHASES;
    hipLaunchKernelGGL(mk_fwd, dim3(grid), dim3(512), LDS_BYTES, stream, a);
#endif
}
```
